# Optimizing an MI355X kernel written in HIP

```python
import math
import jax, jax.numpy as jnp
from jax import lax
import numpy as np

D_MODEL = 1024
BATCH = 2
SEQ = 16384
DEPTH = 1

PLE_DIM = 256
EPS = 1e-6

ATTN_HEADS = 8
ATTN_HEAD_DIM = 64
ATTN_WIDTH = ATTN_HEADS * ATTN_HEAD_DIM
DILATED_PAIRS = ((128, 1), (512, 4), (2048, 16))
ATTN_BLOCK = 128

MLSTM_HEADS = 4
MLSTM_HEAD_DIM = 128
MLSTM_WIDTH = MLSTM_HEADS * MLSTM_HEAD_DIM
MLSTM_CHUNK = 64
CONV_WIDTH = 4

PEER_HEADS = 8
PEER_N_KEYS = 128
PEER_N_EXPERTS = PEER_N_KEYS * PEER_N_KEYS
PEER_QUERY_DIM = 256
PEER_HALF_DIM = PEER_QUERY_DIM // 2
PEER_TOPK = 16
PEER_TOKEN_BLOCK = 128

N_IN = 3 * ATTN_WIDTH + 4 * MLSTM_WIDTH + 2 * MLSTM_HEADS + 2 * D_MODEL
IN_SPLITS = (
    ATTN_WIDTH,
    2 * ATTN_WIDTH,
    3 * ATTN_WIDTH,
    3 * ATTN_WIDTH + 2 * MLSTM_WIDTH,
    3 * ATTN_WIDTH + 3 * MLSTM_WIDTH,
    3 * ATTN_WIDTH + 4 * MLSTM_WIDTH,
    3 * ATTN_WIDTH + 4 * MLSTM_WIDTH + 2 * MLSTM_HEADS,
)

kernel_name = "hybrid_dilated_mlstm_peer_block"


def _rmsnorm(x, g):
    xf = x.astype(jnp.float32)
    y = xf * lax.rsqrt(jnp.mean(xf * xf, axis=-1, keepdims=True) + EPS) * g.astype(jnp.float32)
    return y.astype(x.dtype)


def _dilated_window_attention(q, k, v, window, dilation):
    b, s, h, e = q.shape
    w_sub = window // dilation
    sub_len = s // dilation
    nb = -(-sub_len // ATTN_BLOCK)
    lp = nb * ATTN_BLOCK
    scale = 1.0 / math.sqrt(e)

    def to_sub(t):
        t = t.reshape(b, sub_len, dilation, h, e).transpose(0, 2, 3, 1, 4)
        return jnp.pad(t, ((0, 0), (0, 0), (0, 0), (0, lp - sub_len), (0, 0)))

    def with_prev(t):
        tb = jnp.pad(t, ((0, 0), (0, 0), (0, 0), (ATTN_BLOCK, 0), (0, 0)))
        tb = tb.reshape(b, dilation, h, nb + 1, ATTN_BLOCK, e)
        return jnp.concatenate([tb[:, :, :, :-1], tb[:, :, :, 1:]], axis=4)

    qb = to_sub(q).reshape(b, dilation, h, nb, ATTN_BLOCK, e)
    kb = with_prev(to_sub(k))
    vb = with_prev(to_sub(v))

    scores = jnp.einsum('bdhnqe,bdhnke->bdhnqk', qb, kb).astype(jnp.float32) * scale
    blk = jnp.arange(nb)[:, None, None] * ATTN_BLOCK
    q_pos = blk + jnp.arange(ATTN_BLOCK)[None, :, None]
    k_pos = blk - ATTN_BLOCK + jnp.arange(2 * ATTN_BLOCK)[None, None, :]
    dist = q_pos - k_pos
    mask = (dist >= 0) & (dist <= w_sub) & (k_pos >= 0)
    scores = jnp.where(mask, scores, -jnp.inf)
    m = jnp.max(scores, axis=-1, keepdims=True)
    pr = jnp.exp(scores - m)
    denom = jnp.sum(pr, axis=-1, keepdims=True)
    out = jnp.einsum('bdhnqk,bdhnke->bdhnqe', (pr / denom).astype(v.dtype), vb).astype(jnp.float32)
    lse = (m + jnp.log(denom))[..., 0]

    out = out.reshape(b, dilation, h, lp, e)[:, :, :, :sub_len]
    out = out.transpose(0, 3, 1, 2, 4).reshape(b, s, h, e)
    lse = lse.reshape(b, dilation, h, lp)[:, :, :, :sub_len]
    lse = lse.transpose(0, 3, 1, 2).reshape(b, s, h)
    return out, lse


def _causal_depthwise_conv(x, w):
    c = x.shape[-1]
    return lax.conv_general_dilated(
        x, w.astype(x.dtype)[:, None, :], window_strides=(1,),
        padding=((CONV_WIDTH - 1, 0),), dimension_numbers=('NWC', 'WIO', 'NWC'),
        feature_group_count=c)


def _mlstm_chunkwise(q, k, v, i_pre, log_f):
    b, s, h, e = q.shape
    nc = s // MLSTM_CHUNK

    def chunks(t):
        t = t.astype(jnp.float32).reshape(b, nc, MLSTM_CHUNK, h, *t.shape[3:])
        return jnp.moveaxis(t, (1, 3), (0, 2))

    qc, kc, vc = chunks(q), chunks(k), chunks(v)
    ic, fc = chunks(i_pre), chunks(log_f)
    causal = jnp.tril(jnp.ones((MLSTM_CHUNK, MLSTM_CHUNK), dtype=bool))

    def step(carry, inp):
        c_st, n_st, m_st = carry
        qj, kj, vj, ij, fj = inp
        bcum = jnp.cumsum(fj, axis=-1)
        g = bcum[..., -1]
        d_intra = bcum[..., :, None] - bcum[..., None, :] + ij[..., None, :]
        d_intra = jnp.where(causal, d_intra, -jnp.inf)
        d_inter = bcum + m_st[..., None]
        m_t = jnp.maximum(d_inter, jnp.max(d_intra, axis=-1))
        w_intra = jnp.exp(d_intra - m_t[..., None])
        w_inter = jnp.exp(d_inter - m_t)
        qk = jnp.einsum('bhte,bhse->bhts', qj, kj) * w_intra
        num = (w_inter[..., None] * jnp.einsum('bhte,bhef->bhtf', qj, c_st)
               + jnp.einsum('bhts,bhsf->bhtf', qk, vj))
        den = w_inter * jnp.einsum('bhte,bhe->bht', qj, n_st) + jnp.sum(qk, axis=-1)
        h_out = num / jnp.maximum(jnp.abs(den), jnp.exp(-m_t))[..., None]
        d_state = g[..., None] - bcum + ij
        m_new = jnp.maximum(g + m_st, jnp.max(d_state, axis=-1))
        w_old = jnp.exp(g + m_st - m_new)
        w_s = jnp.exp(d_state - m_new[..., None])
        c_new = w_old[..., None, None] * c_st + jnp.einsum('bhs,bhse,bhsf->bhef', w_s, kj, vj)
        n_new = w_old[..., None] * n_st + jnp.einsum('bhs,bhse->bhe', w_s, kj)
        return (c_new, n_new, m_new), h_out

    init = (jnp.zeros((b, h, e, e), jnp.float32), jnp.zeros((b, h, e), jnp.float32),
            jnp.zeros((b, h), jnp.float32))
    _, hs = lax.scan(step, init, (qc, kc, vc, ic, fc))
    return jnp.moveaxis(hs, (0, 2), (1, 3)).reshape(b, s, h, e)


def _peer(h, w_query, keys1, keys2, expert_u, expert_v):
    b, s, d = h.shape
    q = (h @ w_query).reshape(b, s, PEER_HEADS, 2, PEER_HALF_DIM)
    s1 = jnp.einsum('bshe,hne->bshn', q[..., 0, :], keys1).astype(jnp.float32)
    s2 = jnp.einsum('bshe,hne->bshn', q[..., 1, :], keys2).astype(jnp.float32)
    v1, i1 = lax.top_k(s1, PEER_TOPK)
    v2, i2 = lax.top_k(s2, PEER_TOPK)
    cand_score = (v1[..., :, None] + v2[..., None, :]).reshape(b, s, PEER_HEADS, PEER_TOPK * PEER_TOPK)
    cand_idx = (i1[..., :, None] * PEER_N_KEYS + i2[..., None, :]).reshape(b, s, PEER_HEADS, PEER_TOPK * PEER_TOPK)
    top_score, top_pos = lax.top_k(cand_score, PEER_TOPK)
    idx = jnp.take_along_axis(cand_idx, top_pos, axis=-1)
    gates = jax.nn.softmax(top_score, axis=-1).astype(h.dtype)

    n_blk = (b * s) // PEER_TOKEN_BLOCK
    xt = h.reshape(n_blk, PEER_TOKEN_BLOCK, d)
    it = idx.reshape(n_blk, PEER_TOKEN_BLOCK, PEER_HEADS, PEER_TOPK)
    gt = gates.reshape(n_blk, PEER_TOKEN_BLOCK, PEER_HEADS, PEER_TOPK)

    def block(args):
        xb, ib, gb = args
        u_sel = jnp.take(expert_u, ib, axis=0)
        act = jax.nn.gelu(jnp.einsum('thkd,td->thk', u_sel, xb), approximate=False)
        v_sel = jnp.take(expert_v, ib, axis=0)
        return jnp.einsum('thk,thkd->td', gb * act, v_sel)

    y = lax.map(block, (xt, it, gt))
    return y.reshape(b, s, d)


def setup_inputs(seed: int = 0) -> dict:
    key = jax.random.key(seed)
    ks = jax.random.split(key, 24)
    f32 = jnp.float32

    def nrm(k, shape, scale):
        return jax.random.normal(k, shape, f32) * scale

    def gain(k, shape):
        return 1.0 + 0.05 * jax.random.normal(k, shape, f32)

    i_bias = 0.1 * jax.random.normal(ks[3], (DEPTH, MLSTM_HEADS), f32)
    f_bias = jnp.linspace(3.0, 6.0, MLSTM_HEADS, dtype=f32)[None, :] + 0.01 * jax.random.normal(ks[4], (DEPTH, MLSTM_HEADS), f32)
    return {
        "x": nrm(ks[0], (BATCH, SEQ, D_MODEL), 1.0),
        "p": nrm(ks[1], (DEPTH, BATCH, SEQ, PLE_DIM), 1.0),
        "norm_mix": gain(ks[2], (DEPTH, D_MODEL)),
        "w_in": nrm(ks[5], (DEPTH, D_MODEL, N_IN), D_MODEL ** -0.5),
        "conv_qk": nrm(ks[6], (DEPTH, CONV_WIDTH, 2 * MLSTM_WIDTH), CONV_WIDTH ** -0.5),
        "gate_bias": jnp.concatenate([i_bias, f_bias], axis=-1),
        "mlstm_norm": gain(ks[7], (DEPTH, MLSTM_WIDTH)),
        "w_up_attn": nrm(ks[8], (DEPTH, ATTN_WIDTH, D_MODEL), ATTN_WIDTH ** -0.5),
        "w_up_mlstm": nrm(ks[9], (DEPTH, MLSTM_WIDTH, D_MODEL), MLSTM_WIDTH ** -0.5),
        "w_out": nrm(ks[10], (DEPTH, D_MODEL, D_MODEL), D_MODEL ** -0.5),
        "norm_ffn": gain(ks[11], (DEPTH, D_MODEL)),
        "w_query": nrm(ks[12], (DEPTH, D_MODEL, PEER_HEADS * PEER_QUERY_DIM), D_MODEL ** -0.5),
        "keys1": nrm(ks[13], (DEPTH, PEER_HEADS, PEER_N_KEYS, PEER_HALF_DIM), PEER_HALF_DIM ** -0.5),
        "keys2": nrm(ks[14], (DEPTH, PEER_HEADS, PEER_N_KEYS, PEER_HALF_DIM), PEER_HALF_DIM ** -0.5),
        "expert_u": nrm(ks[15], (DEPTH, PEER_N_EXPERTS, D_MODEL), D_MODEL ** -0.5),
        "expert_v": nrm(ks[16], (DEPTH, PEER_N_EXPERTS, D_MODEL), PEER_HEADS ** -0.5),
        "norm_ple": gain(ks[17], (DEPTH, D_MODEL)),
        "w_ple_gate": nrm(ks[18], (DEPTH, D_MODEL, D_MODEL), D_MODEL ** -0.5),
        "w_ple": nrm(ks[19], (DEPTH, PLE_DIM, D_MODEL), PLE_DIM ** -0.5),
        "norm_final": gain(ks[20], (D_MODEL,)),
    }


def reference(x, p, norm_mix, w_in, conv_qk, gate_bias, mlstm_norm, w_up_attn, w_up_mlstm,
              w_out, norm_ffn, w_query, keys1, keys2, expert_u, expert_v, norm_ple,
              w_ple_gate, w_ple, norm_final):
    b, s, _ = x.shape
    for layer in range(DEPTH):
        h = _rmsnorm(x, norm_mix[layer])
        proj = h @ w_in[layer]
        q_a, k_a, v_a, qk_m, v_m, o_m, if_m, gate_pre = jnp.split(proj, IN_SPLITS, axis=-1)

        qa = q_a.reshape(b, s, ATTN_HEADS, ATTN_HEAD_DIM)
        ka = k_a.reshape(b, s, ATTN_HEADS, ATTN_HEAD_DIM)
        va = v_a.reshape(b, s, ATTN_HEADS, ATTN_HEAD_DIM)
        outs, lses = [], []
        for window, dilation in DILATED_PAIRS:
            o_g, lse_g = _dilated_window_attention(qa, ka, va, window, dilation)
            outs.append(o_g)
            lses.append(lse_g)
        mix_w = jax.nn.softmax(jnp.stack(lses, axis=0), axis=0)
        y_a = jnp.sum(mix_w[..., None] * jnp.stack(outs, axis=0), axis=0)
        y_a = y_a.reshape(b, s, ATTN_WIDTH).astype(x.dtype)

        qk_c = jax.nn.silu(_causal_depthwise_conv(qk_m, conv_qk[layer]))
        q_m, k_m = jnp.split(qk_c, 2, axis=-1)
        q_m = q_m.reshape(b, s, MLSTM_HEADS, MLSTM_HEAD_DIM)
        k_m = k_m.reshape(b, s, MLSTM_HEADS, MLSTM_HEAD_DIM) * (MLSTM_HEAD_DIM ** -0.5)
        vm = v_m.reshape(b, s, MLSTM_HEADS, MLSTM_HEAD_DIM)
        gif = if_m.astype(jnp.float32) + gate_bias[layer].astype(jnp.float32)
        i_pre, f_pre = jnp.split(gif, 2, axis=-1)
        h_m = _mlstm_chunkwise(q_m, k_m, vm, i_pre, jax.nn.log_sigmoid(f_pre))
        h_m = h_m * lax.rsqrt(jnp.mean(h_m * h_m, axis=-1, keepdims=True) + EPS)
        y_m = (h_m.reshape(b, s, MLSTM_WIDTH) * mlstm_norm[layer].astype(jnp.float32)).astype(x.dtype)
        y_m = y_m * jax.nn.sigmoid(o_m)

        g_a, g_m = jnp.split(gate_pre, 2, axis=-1)
        merged = (jax.nn.sigmoid(g_a) * (y_a @ w_up_attn[layer])
                  + jax.nn.sigmoid(g_m) * (y_m @ w_up_mlstm[layer]))
        x = x + merged @ w_out[layer]

        x = x + _peer(_rmsnorm(x, norm_ffn[layer]), w_query[layer], keys1[layer], keys2[layer],
                      expert_u[layer], expert_v[layer])

        ple_gate = jax.nn.sigmoid(_rmsnorm(x, norm_ple[layer]) @ w_ple_gate[layer])
        x = x + ple_gate * (p[layer] @ w_ple[layer])
    return _rmsnorm(x, norm_final)
```

```cpp
#include <hip/hip_runtime.h>
#include <hip/hip_cooperative_groups.h>
#include <cstdio>
#include <cstdint>
namespace cg = cooperative_groups;
namespace pg8 {
#define PG8_LAS __attribute__((address_space(3)))
typedef unsigned short bf16_t;
typedef short bf16x8 __attribute__((ext_vector_type(8)));
typedef float f32x4 __attribute__((ext_vector_type(4)));
typedef unsigned u32x4 __attribute__((ext_vector_type(4)));
constexpr int BM = 256, BK = 64, HALF = 128, HTB = HALF * BK * 2  , STAGE_BYTES = 8 * HTB, NXCD = 8, WGM = 8;

__host__ __device__ __forceinline__ int lds_byte(int r, int c) { const int st = (r >> 4) * 2 + (c >> 5), rr = r & 15, cc = c & 31, ob = rr * 64 + cc * 2; return st * 1024 + (ob ^ (((ob >> 9) & 1) << 5)); }
__host__ __device__ __forceinline__ void stage_rc(int b, int& R, int& C) { const int st = b / 1024, sb = b % 1024, swz = sb ^ (((sb >> 9) & 1) << 5); R = (st >> 1) * 16 + swz / 64; C = (st & 1) * 32 + (swz % 64) / 2; }
__host__ __device__ __forceinline__ int perm32(int rho) { const int n = rho >> 4, i = rho & 15; return 8 * (i >> 2) + 4 * n + (i & 3); }

struct Unit { int pm, pn; };
struct Gemm { const bf16_t* A; const bf16_t* Bt; int M, N, K; };

struct StaticOrder {
    int nM, nN, nwg, G, c;
    __host__ __device__ void init(int M, int N, int G_, int c_) { nM = M / BM; nN = N / BM; nwg = nM * nN; G = G_; c = c_; }
    __host__ __device__ bool next(int i, Unit& u) const {
        const long L = (long)i * G + c; if (L >= nwg) return false;
        int wgid = (int)L; { const int q = nwg / NXCD, r = nwg % NXCD, xcd = wgid % NXCD, off = wgid / NXCD; wgid = (xcd < r ? xcd * (q + 1) : r * (q + 1) + (xcd - r) * q) + off; }
        const int nig = WGM * nN, gid = wgid / nig, fm = gid * WGM, gsz = (nM - fm) < WGM ? (nM - fm) : WGM;
        u.pm = fm + ((wgid % nig) % gsz); u.pn = (wgid % nig) / gsz; return true;
    }
    __device__ __forceinline__ void a_ready(const Unit&) const {}
    __device__ __forceinline__ void done(const Unit&) const {}
};

__device__ __forceinline__ unsigned cvt_pk_bf16(float lo, float hi) { unsigned r; asm volatile("v_cvt_pk_bf16_f32 %0, %1, %2" : "=v"(r) : "v"(lo), "v"(hi)); return r; }
typedef float f32x2 __attribute__((ext_vector_type(2)));

__device__ __forceinline__ float sigm(float x) { return 1.0f / (1.0f + __expf(-x)); }
__device__ __forceinline__ float bf_lo(unsigned w) { return __uint_as_float(w << 16); }
__device__ __forceinline__ float bf_hi(unsigned w) { return __uint_as_float(w & 0xffff0000u); }
__device__ __forceinline__ u32x4 pack8(const f32x4& v0, const f32x4& v1) { u32x4 w; w.x = cvt_pk_bf16(v0[0], v0[1]); w.y = cvt_pk_bf16(v0[2], v0[3]); w.z = cvt_pk_bf16(v1[0], v1[1]); w.w = cvt_pk_bf16(v1[2], v1[3]); return w; }
__device__ __forceinline__ void unpack8(const u32x4& w, f32x4& v0, f32x4& v1) { v0[0] = bf_lo(w.x); v0[1] = bf_hi(w.x); v0[2] = bf_lo(w.y); v0[3] = bf_hi(w.y); v1[0] = bf_lo(w.z); v1[1] = bf_hi(w.z); v1[2] = bf_lo(w.w); v1[3] = bf_hi(w.w); }

#define PG8_EPI_WALK(...) \
    _Pragma("unroll") for (int ai = 0; ai < 2; ++ai) _Pragma("unroll") for (int m = 0; m < 4; ++m) { const int row = u.pm * BM + wr * 64 + fr + ai * HALF + m * 16; \
        _Pragma("unroll") for (int bj = 0; bj < 2; ++bj) { const int ct = bj * HALF + wc * 32 + 8 * fq; f32x4 v0 = acc[ai][bj][m][0], v1 = acc[ai][bj][m][1]; __VA_ARGS__ } }

struct EpiProj {
    static constexpr bool PERM = true, AFTER_DRAIN = false;
    bf16_t *qkva, *qkm, *vm, *om, *g; float c2;
    __device__ __forceinline__ void operator()(const f32x4 (&acc)[2][2][4][2], const Unit& u, int wr, int wc, int fr, int fq) const {
        const int pn = u.pn; bf16_t* base; int ldc, colt, mode = 0; float sc = 1.f;
        if (pn < 6) { base = qkva; ldc = 1536; colt = pn * 256; if (pn < 2) sc = c2; }
        else if (pn < 10) { base = qkm; ldc = 1024; colt = (pn - 6) * 256; }
        else if (pn < 12) { base = vm; ldc = 512; colt = (pn - 10) * 256; }
        else if (pn < 14) { base = om; ldc = 512; colt = (pn - 12) * 256; mode = 1; }
        else { base = g; ldc = 2048; colt = (pn - 14) * 256; mode = 1; }
        PG8_EPI_WALK({
            if (mode == 1) { _Pragma("unroll") for (int i = 0; i < 4; ++i) { v0[i] = sigm(v0[i]); v1[i] = sigm(v1[i]); } }
            else { v0 = v0 * sc; v1 = v1 * sc; }
            *(u32x4*)(base + (size_t)row * ldc + colt + ct) = pack8(v0, v1);
        })
    }
};
struct EpiStore {
    static constexpr bool PERM = true, AFTER_DRAIN = false;
    bf16_t* O; int ldc;
    __device__ __forceinline__ void operator()(const f32x4 (&acc)[2][2][4][2], const Unit& u, int wr, int wc, int fr, int fq) const {
        PG8_EPI_WALK({ *(u32x4*)(O + (size_t)row * ldc + u.pn * BM + ct) = pack8(v0, v1); })
    }
};
template <bool ADD> struct EpiGated {
    static constexpr bool PERM = true, AFTER_DRAIN = false;
    bf16_t* O; const bf16_t* prev; const bf16_t* gate; int gcol0;
    __device__ __forceinline__ void operator()(const f32x4 (&acc)[2][2][4][2], const Unit& u, int wr, int wc, int fr, int fq) const {
        PG8_EPI_WALK({
            const int col = u.pn * BM + ct; f32x4 g0, g1; unpack8(*(const u32x4*)(gate + (size_t)row * 2048 + gcol0 + col), g0, g1);
            v0 = v0 * g0; v1 = v1 * g1;
            if (ADD) { f32x4 p0, p1; unpack8(*(const u32x4*)(prev + (size_t)row * 1024 + col), p0, p1); v0 = v0 + p0; v1 = v1 + p1; }
            *(u32x4*)(O + (size_t)row * 1024 + col) = pack8(v0, v1);
        })
    }
};
struct EpiResidual {
    static constexpr bool PERM = true, AFTER_DRAIN = false;
    const float* res; float* out;
    __device__ __forceinline__ void operator()(const f32x4 (&acc)[2][2][4][2], const Unit& u, int wr, int wc, int fr, int fq) const {
        PG8_EPI_WALK({
            const size_t o = (size_t)row * 1024 + u.pn * BM + ct; const f32x4 r0 = *(const f32x4*)(res + o), r1 = *(const f32x4*)(res + o + 4);
            *(f32x4*)(out + o) = r0 + v0; *(f32x4*)(out + o + 4) = r1 + v1;
        })
    }
};
struct EpiPle {
    static constexpr bool PERM = true, AFTER_DRAIN = false;
    float* xio; const bf16_t* e;
    __device__ __forceinline__ void operator()(const f32x4 (&acc)[2][2][4][2], const Unit& u, int wr, int wc, int fr, int fq) const {
        PG8_EPI_WALK({
            const size_t o = (size_t)row * 1024 + u.pn * BM + ct; f32x4 e0, e1; unpack8(*(const u32x4*)(e + o), e0, e1);
            const f32x4 r0 = *(const f32x4*)(xio + o), r1 = *(const f32x4*)(xio + o + 4);
            _Pragma("unroll") for (int i = 0; i < 4; ++i) { v0[i] = r0[i] + sigm(v0[i]) * e0[i]; v1[i] = r1[i] + sigm(v1[i]) * e1[i]; }
            *(f32x4*)(xio + o) = v0; *(f32x4*)(xio + o + 4) = v1;
        })
    }
};

template <class Epi, class Sched, bool ALIGN_EPI = false, bool SP2 = false>
__device__ __forceinline__ void gemm_phase(PG8_LAS unsigned char* lds, const Gemm g, const Sched& S, const Epi& E) {
    const int tid = threadIdx.x, wid = __builtin_amdgcn_readfirstlane(tid >> 6), lane = tid & 63, wr = wid >> 2, wc = wid & 3, fr = lane & 15, fq = lane >> 4;
    const int K = g.K, nt = K / BK;
    unsigned voffA[2], voffB[2];
#pragma unroll
    for (int i = 0; i < 2; ++i) { int R, C; stage_rc(tid * 16 + i * 8192, R, C); const int Rb = Epi::PERM ? ((R & ~31) + perm32(R & 31)) : R;
        voffA[i] = (unsigned)(R * K + C) * 2u; voffB[i] = (unsigned)(Rb * K + C) * 2u; }
    const size_t kstep = (size_t)(BK * 2);
    const size_t hstep = (size_t)HALF * K * 2;
    const size_t tstep = 2 * hstep;
    const unsigned ldsw = (unsigned)wid * 1024u;
    const int aoff = lds_byte(wr * 64 + fr, fq * 8), boff = lds_byte(wc * 32 + fr, fq * 8);
#define PG8_SA(b, h) (((b) * 2 + (h)) * HTB)
#define PG8_SB(b, h) ((4 + (b) * 2 + (h)) * HTB)
#define PG8_STAGE(bufoff, gbase, voff) do { _Pragma("unroll") for (int _i = 0; _i < 2; ++_i) \
        __builtin_amdgcn_global_load_lds((const unsigned*)((const char*)(gbase) + (voff)[_i]), (PG8_LAS unsigned*)(lds + (bufoff) + ldsw + _i * 8192), 16, 0, 0); } while (0)
#define PG8_LDA(dst, b, h) do { _Pragma("unroll") for (int m = 0; m < 4; ++m) _Pragma("unroll") for (int k = 0; k < 2; ++k) dst[m][k] = *(const PG8_LAS bf16x8*)(lds + PG8_SA(b, h) + aoff + m * 2048 + k * 1024); } while (0)
#define PG8_LDB(dst, b, h) do { _Pragma("unroll") for (int n = 0; n < 2; ++n) _Pragma("unroll") for (int k = 0; k < 2; ++k) dst[n][k] = *(const PG8_LAS bf16x8*)(lds + PG8_SB(b, h) + boff + n * 2048 + k * 1024); } while (0)
#define PG8_MMA(ai, bj, At, Bt) do { __builtin_amdgcn_s_setprio(1); _Pragma("unroll") for (int m = 0; m < 4; ++m) _Pragma("unroll") for (int n = 0; n < 2; ++n) _Pragma("unroll") for (int k = 0; k < 2; ++k) \
        acc[ai][bj][m][n] = __builtin_amdgcn_mfma_f32_16x16x32_bf16(Bt[n][k], At[m][k], acc[ai][bj][m][n], 0, 0, 0); __builtin_amdgcn_s_setprio(0); } while (0)
#define PG8_WAIT_V(n) asm volatile("s_waitcnt vmcnt(" #n ")" ::: "memory")
#define PG8_WAIT_L(n) asm volatile("s_waitcnt lgkmcnt(" #n ")" ::: "memory")
#define PG8_BAR __builtin_amdgcn_s_barrier()
#define PG8_SCHED __builtin_amdgcn_sched_barrier(0)
    Unit cur, nxt; int ui = 0;
    if (!S.next(0, cur)) return;
    f32x4 acc[2][2][4][2];
#pragma unroll
    for (int a = 0; a < 2; ++a)
#pragma unroll
        for (int b = 0; b < 2; ++b)
#pragma unroll
            for (int m = 0; m < 4; ++m)
#pragma unroll
                for (int n = 0; n < 2; ++n) acc[a][b][m][n] = (f32x4){0.f, 0.f, 0.f, 0.f};
    bf16x8 At[4][2], B0[2][2], B1[2][2];
    const char* cA = (const char*)g.A + (size_t)cur.pm * tstep; const char* cB = (const char*)g.Bt + (size_t)cur.pn * tstep;
    S.a_ready(cur);
    if constexpr (SP2) {
        PG8_STAGE(PG8_SB(0, 0), cB, voffB); PG8_STAGE(PG8_SB(0, 1), cB + hstep, voffB); PG8_STAGE(PG8_SA(0, 0), cA, voffA); PG8_STAGE(PG8_SA(0, 1), cA + hstep, voffA);
        if (wr == 1) PG8_BAR;
        PG8_WAIT_V(2); PG8_BAR;
        PG8_STAGE(PG8_SB(1, 0), cB + kstep, voffB); PG8_STAGE(PG8_SA(1, 0), cA + kstep, voffA); PG8_STAGE(PG8_SB(1, 1), cB + hstep + kstep, voffB);
        PG8_WAIT_V(6); PG8_BAR;
    } else {
        PG8_STAGE(PG8_SB(0, 0), cB, voffB); PG8_STAGE(PG8_SA(0, 0), cA, voffA); PG8_STAGE(PG8_SB(0, 1), cB + hstep, voffB); PG8_STAGE(PG8_SA(0, 1), cA + hstep, voffA);
        if (wr == 1) PG8_BAR;
        PG8_WAIT_V(4); PG8_BAR;
        PG8_STAGE(PG8_SB(1, 0), cB + kstep, voffB); PG8_STAGE(PG8_SA(1, 0), cA + kstep, voffA); PG8_STAGE(PG8_SB(1, 1), cB + hstep + kstep, voffB);
        PG8_WAIT_V(6); PG8_BAR;
    }
    for (;;) {
        const bool has_next = S.next(ui + 1, nxt);
        const char* nA = has_next ? (const char*)g.A + (size_t)nxt.pm * tstep : cA; const char* nB = has_next ? (const char*)g.Bt + (size_t)nxt.pn * tstep : cB;
        for (int t = 0; t < nt; t += 2) {
            const bool last = (t == nt - 2);
            const char* a1 = cA + (size_t)(t + 1) * kstep;
            const char* a2 = last ? nA : cA + (size_t)(t + 2) * kstep; const char* b2 = last ? nB : cB + (size_t)(t + 2) * kstep;
            const char* a3 = a2 + kstep; const char* b3 = b2 + kstep;
            if (last && has_next) S.a_ready(nxt);
            if constexpr (SP2) {
            PG8_LDB(B0, 0, 0); PG8_LDB(B1, 0, 1); PG8_SCHED; PG8_LDA(At, 0, 0); PG8_STAGE(PG8_SA(1, 1), a1 + hstep, voffA);
            PG8_WAIT_V(8); PG8_WAIT_L(0); PG8_BAR; PG8_MMA(0, 0, At, B0); PG8_MMA(0, 1, At, B1); PG8_BAR; PG8_SCHED;
            PG8_LDA(At, 0, 1); PG8_STAGE(PG8_SB(0, 0), b2, voffB); PG8_STAGE(PG8_SB(0, 1), b2 + hstep, voffB); PG8_STAGE(PG8_SA(0, 0), a2, voffA);
            PG8_WAIT_V(8); PG8_WAIT_L(0); PG8_BAR; PG8_MMA(1, 0, At, B0); PG8_MMA(1, 1, At, B1); PG8_BAR; PG8_SCHED;
            PG8_LDB(B0, 1, 0); PG8_LDB(B1, 1, 1); PG8_SCHED; PG8_LDA(At, 1, 0); PG8_STAGE(PG8_SA(0, 1), a2 + hstep, voffA);
            PG8_WAIT_V(8); PG8_WAIT_L(0); PG8_BAR; PG8_MMA(0, 0, At, B0); PG8_MMA(0, 1, At, B1); PG8_BAR; PG8_SCHED;
            PG8_LDA(At, 1, 1); PG8_STAGE(PG8_SB(1, 0), b3, voffB); PG8_STAGE(PG8_SB(1, 1), b3 + hstep, voffB); PG8_STAGE(PG8_SA(1, 0), a3, voffA);
            PG8_WAIT_V(8); PG8_WAIT_L(0); PG8_BAR; PG8_MMA(1, 0, At, B0); PG8_MMA(1, 1, At, B1); PG8_BAR; PG8_SCHED;
            } else {
            PG8_LDB(B0, 0, 0); PG8_SCHED; PG8_LDA(At, 0, 0); PG8_STAGE(PG8_SA(1, 1), a1 + hstep, voffA);
            PG8_WAIT_L(8); PG8_BAR; PG8_WAIT_L(0); PG8_MMA(0, 0, At, B0); PG8_BAR; PG8_SCHED;
            PG8_LDB(B1, 0, 1); PG8_STAGE(PG8_SB(0, 0), b2, voffB);
            PG8_BAR; PG8_WAIT_L(0); PG8_MMA(0, 1, At, B1); PG8_BAR;
            PG8_LDA(At, 0, 1); PG8_STAGE(PG8_SA(0, 0), a2, voffA);
            PG8_BAR; PG8_WAIT_L(0); PG8_MMA(1, 0, At, B0); PG8_BAR; PG8_SCHED;
            PG8_STAGE(PG8_SB(0, 1), b2 + hstep, voffB);
            PG8_WAIT_V(6); PG8_BAR; PG8_MMA(1, 1, At, B1); PG8_BAR;
            PG8_LDB(B0, 1, 0); PG8_SCHED; PG8_LDA(At, 1, 0); PG8_STAGE(PG8_SA(0, 1), a2 + hstep, voffA);
            PG8_WAIT_L(8); PG8_BAR; PG8_WAIT_L(0); PG8_MMA(0, 0, At, B0); PG8_BAR; PG8_SCHED;
            PG8_LDB(B1, 1, 1); PG8_STAGE(PG8_SB(1, 0), b3, voffB);
            PG8_BAR; PG8_WAIT_L(0); PG8_MMA(0, 1, At, B1); PG8_BAR;
            PG8_LDA(At, 1, 1); PG8_STAGE(PG8_SA(1, 0), a3, voffA);
            PG8_BAR; PG8_WAIT_L(0); PG8_MMA(1, 0, At, B0); PG8_BAR; PG8_SCHED;
            PG8_STAGE(PG8_SB(1, 1), b3 + hstep, voffB);
            PG8_WAIT_V(6); PG8_BAR; PG8_MMA(1, 1, At, B1); PG8_BAR;
            }
        }
        if constexpr (ALIGN_EPI) { if (wr == 0) PG8_BAR; }
        if constexpr (!Epi::AFTER_DRAIN) { E(acc, cur, wr, wc, fr, fq); S.done(cur); }
        if (!has_next) break;
#pragma unroll
        for (int a = 0; a < 2; ++a)
#pragma unroll
            for (int b = 0; b < 2; ++b)
#pragma unroll
                for (int m = 0; m < 4; ++m)
#pragma unroll
                    for (int n = 0; n < 2; ++n) acc[a][b][m][n] = (f32x4){0.f, 0.f, 0.f, 0.f};
        cur = nxt; cA = nA; cB = nB; ++ui;
        if constexpr (ALIGN_EPI) { if (wr == 1) PG8_BAR; }
    }
    PG8_WAIT_V(0);
    if constexpr (!ALIGN_EPI) { if (wr == 0) PG8_BAR; }
    PG8_BAR;
    if constexpr (Epi::AFTER_DRAIN) { E.fused(acc, cur, wr, wc, fr, fq, lds, wid, lane); S.done(cur); }
#undef PG8_SA
#undef PG8_SB
#undef PG8_STAGE
#undef PG8_LDA
#undef PG8_LDB
#undef PG8_MMA
#undef PG8_WAIT_V
#undef PG8_WAIT_L
#undef PG8_BAR
#undef PG8_SCHED
}
}

#define GAS __attribute__((address_space(1)))
#define LAS __attribute__((address_space(3)))
typedef unsigned short bf16;
typedef unsigned v4u __attribute__((ext_vector_type(4)));
typedef float f32x4 __attribute__((ext_vector_type(4)));
using pg8::bf_lo; using pg8::bf_hi; using pg8::sigm;

constexpr int NTOK = 32768, SEQ = 16384, DM = 1024, NW = 8;
constexpr float EPS = 1e-6f;
constexpr float C2 = 0.125f * 1.4426950408889634f;
constexpr size_t MiB = 1u << 20;
constexpr size_t WS_W1T = 1 * MiB, WS_WAT = 12 * MiB, WS_WMT = 13 * MiB, WS_WOT = 14 * MiB, WS_WQT = 16 * MiB, WS_WGT = 20 * MiB, WS_WPT = 22 * MiB;
constexpr size_t WS_K1B = 22 * MiB + 512 * 1024, WS_K2B = 22 * MiB + 768 * 1024, WS_IF = 23 * MiB, WS_UB = 24 * MiB, WS_VB = 56 * MiB;
constexpr size_t WS_XN = 88 * MiB, WS_YA = 88 * MiB, WS_YM = 120 * MiB, WS_HN = 88 * MiB;
constexpr size_t WS_QKVA = 152 * MiB, WS_QKM = 248 * MiB, WS_VM = 312 * MiB, WS_OM = 344 * MiB, WS_G = 376 * MiB;
constexpr size_t WS_DN = 504 * MiB, WS_NS = 505 * MiB, WS_SC = 506 * MiB;
constexpr size_t WS_MERGED = 152 * MiB, WS_TMP = 216 * MiB, WS_Q2 = 376 * MiB, WS_IDX = 152 * MiB, WS_GATE = 168 * MiB, WS_HN2 = 184 * MiB, WS_PB = 248 * MiB, WS_E = 264 * MiB;
constexpr size_t WS_NEED = 507 * MiB;
constexpr size_t OUT_DC = 0, OUT_CS = 64 * MiB;
constexpr int LDS_BYTES = 147456;

__device__ __forceinline__ unsigned f2bf(float f) { unsigned u = __float_as_uint(f); return (u + 0x7fffu + ((u >> 16) & 1u)) >> 16; }
__device__ __forceinline__ unsigned pk2(float lo, float hi) { return f2bf(lo) | (f2bf(hi) << 16); }
__device__ __forceinline__ float bf2f(bf16 b) { return __uint_as_float((unsigned)b << 16); }
__device__ __forceinline__ float wave_sum(float v) {
#pragma unroll
    for (int o = 1; o < 64; o <<= 1) v += __shfl_xor(v, o);
    return v;
}
__device__ __forceinline__ void unpk8(const v4u w, float* f) { f[0] = bf_lo(w.x); f[1] = bf_hi(w.x); f[2] = bf_lo(w.y); f[3] = bf_hi(w.y); f[4] = bf_lo(w.z); f[5] = bf_hi(w.z); f[6] = bf_lo(w.w); f[7] = bf_hi(w.w); }
__device__ __forceinline__ v4u pk8(const float* f) { v4u w; w.x = pk2(f[0], f[1]); w.y = pk2(f[2], f[3]); w.z = pk2(f[4], f[5]); w.w = pk2(f[6], f[7]); return w; }
typedef __bf16 bf16x2_t __attribute__((ext_vector_type(2)));
__device__ __forceinline__ float dot2bf(unsigned a, unsigned b, float c) { return __builtin_amdgcn_fdot2_f32_bf16(__builtin_bit_cast(bf16x2_t, a), __builtin_bit_cast(bf16x2_t, b), c, false); }
__device__ __forceinline__ float logsigmoid(float x) { return fminf(x, 0.f) - log1pf(__expf(-fabsf(x))); }
__device__ __forceinline__ float silu(float x) { return x / (1.0f + __expf(-x)); }

struct Params { const float* in[20]; float* out; unsigned char* ws; int ph_lo, ph_hi; };

__device__ __forceinline__ void transpose_item(const float* W, int ldw, int col0, int K, bf16* WT, int row0, LAS float* scr, int item, int nblk, int lane) {
    const int kb = item / nblk, nb = item % nblk, k0 = 64 * kb, n0 = 32 * nb;
#pragma unroll 8
    for (int i = 0; i < 32; ++i) { const int kk = 2 * i + (lane >> 5); scr[kk * 33 + (lane & 31)] = W[(size_t)(k0 + kk) * ldw + col0 + n0 + (lane & 31)]; }
    asm volatile("s_waitcnt lgkmcnt(0)" ::: "memory");
    const int c = lane & 7;
#pragma unroll
    for (int j = 0; j < 4; ++j) { const int n = (lane >> 3) + 8 * j; const LAS float* s = scr + (8 * c) * 33 + n;
        v4u o; o.x = pk2(s[0 * 33], s[1 * 33]); o.y = pk2(s[2 * 33], s[3 * 33]); o.z = pk2(s[4 * 33], s[5 * 33]); o.w = pk2(s[6 * 33], s[7 * 33]);
        *(v4u*)(WT + (size_t)(row0 + n0 + n) * K + k0 + 8 * c) = o; }
    asm volatile("s_waitcnt lgkmcnt(0)" ::: "memory");
}
__device__ __forceinline__ void cvt_f32_bf16(const float* src, bf16* dst, size_t n4, size_t gtid, size_t gsz) {
    for (size_t i = gtid; i < n4; i += gsz) { const f32x4 v = ((const f32x4*)src)[i]; uint2 o; o.x = pk2(v[0], v[1]); o.y = pk2(v[2], v[3]); ((uint2*)dst)[i] = o; }
}
__device__ __forceinline__ void rms_row_to_bf16(const float* xrow, const float* gain, bf16* orow, int lane) {
    f32x4 v[4]; float s = 0.f;
#pragma unroll
    for (int j = 0; j < 4; ++j) { v[j] = ((const f32x4*)xrow)[lane + 64 * j]; s += (v[j][0] * v[j][0] + v[j][1] * v[j][1]) + (v[j][2] * v[j][2] + v[j][3] * v[j][3]); }
    const float rstd = rsqrtf(wave_sum(s) * (1.f / 1024.f) + EPS);
#pragma unroll
    for (int j = 0; j < 4; ++j) { const f32x4 g = ((const f32x4*)gain)[lane + 64 * j]; uint2 o; o.x = pk2(v[j][0] * rstd * g[0], v[j][1] * rstd * g[1]); o.y = pk2(v[j][2] * rstd * g[2], v[j][3] * rstd * g[3]); ((uint2*)orow)[lane + 64 * j] = o; }
}
__device__ __forceinline__ void p0_prologue(const Params& P, LAS unsigned char* lds, int tid, int lane, int wave) {
    unsigned char* ws = P.ws;
    const int gw = blockIdx.x * NW + wave, NGW = gridDim.x * NW;
    LAS float* scr = (LAS float*)(lds + wave * 8448);
    LAS float* wif = (LAS float*)(lds + 69632);
    const float* w_in = P.in[3];
    for (int i = tid; i < 8192; i += 512) wif[i] = w_in[(size_t)(i >> 3) * 5640 + 3584 + (i & 7)];
    __syncthreads();
    constexpr int I1A = 16 * 112, I1B = 16 * 64, IUP = 8 * 32, IOUT = 16 * 32, IQ = 16 * 64, IPL = 4 * 32;
    constexpr int NITEMS = I1A + I1B + 2 * IUP + IOUT + IQ + IOUT + IPL;
    for (int it = gw; it < NITEMS; it += NGW) {
        int r = it;
        if (r < I1A) { transpose_item(w_in, 5640, 0, 1024, (bf16*)(ws + WS_W1T), 0, scr, r, 112, lane); continue; } r -= I1A;
        if (r < I1B) { transpose_item(w_in, 5640, 3592, 1024, (bf16*)(ws + WS_W1T), 3584, scr, r, 64, lane); continue; } r -= I1B;
        if (r < IUP) { transpose_item(P.in[7], 1024, 0, 512, (bf16*)(ws + WS_WAT), 0, scr, r, 32, lane); continue; } r -= IUP;
        if (r < IUP) { transpose_item(P.in[8], 1024, 0, 512, (bf16*)(ws + WS_WMT), 0, scr, r, 32, lane); continue; } r -= IUP;
        if (r < IOUT) { transpose_item(P.in[9], 1024, 0, 1024, (bf16*)(ws + WS_WOT), 0, scr, r, 32, lane); continue; } r -= IOUT;
        if (r < IQ) { transpose_item(P.in[11], 2048, 0, 1024, (bf16*)(ws + WS_WQT), 0, scr, r, 64, lane); continue; } r -= IQ;
        if (r < IOUT) { transpose_item(P.in[17], 1024, 0, 1024, (bf16*)(ws + WS_WGT), 0, scr, r, 32, lane); continue; } r -= IOUT;
        transpose_item(P.in[18], 1024, 0, 256, (bf16*)(ws + WS_WPT), 0, scr, r, 32, lane);
    }
    const size_t gtid = (size_t)blockIdx.x * 512 + tid, gsz = (size_t)gridDim.x * 512;
    cvt_f32_bf16(P.in[12], (bf16*)(ws + WS_K1B), 8 * 128 * 128 / 4, gtid, gsz);
    cvt_f32_bf16(P.in[13], (bf16*)(ws + WS_K2B), 8 * 128 * 128 / 4, gtid, gsz);
    cvt_f32_bf16(P.in[14], (bf16*)(ws + WS_UB), (size_t)16384 * 1024 / 4, gtid, gsz);
    cvt_f32_bf16(P.in[15], (bf16*)(ws + WS_VB), (size_t)16384 * 1024 / 4, gtid, gsz);
    const float* x = P.in[0]; const float* gmix = P.in[2]; const float* gbias = P.in[5];
    bf16* XN = (bf16*)(ws + WS_XN); float* IFb = (float*)(ws + WS_IF);
    for (int m = gw; m < NTOK; m += NGW) {
        const float* xrow = x + (size_t)m * 1024;
        f32x4 v[4]; float s = 0.f;
#pragma unroll
        for (int j = 0; j < 4; ++j) { v[j] = ((const f32x4*)xrow)[lane + 64 * j]; s += (v[j][0] * v[j][0] + v[j][1] * v[j][1]) + (v[j][2] * v[j][2] + v[j][3] * v[j][3]); }
        const float rstd = rsqrtf(wave_sum(s) * (1.f / 1024.f) + EPS);
        float a8[8] = {0.f, 0.f, 0.f, 0.f, 0.f, 0.f, 0.f, 0.f};
#pragma unroll
        for (int j = 0; j < 4; ++j) {
            const f32x4 g = ((const f32x4*)gmix)[lane + 64 * j];
#pragma unroll
            for (int i = 0; i < 4; ++i) { v[j][i] = v[j][i] * rstd * g[i]; const int d = 4 * (lane + 64 * j) + i; const f32x4 wa = *(const LAS f32x4*)(wif + d * 8), wb = *(const LAS f32x4*)(wif + d * 8 + 4);
                a8[0] += v[j][i] * wa[0]; a8[1] += v[j][i] * wa[1]; a8[2] += v[j][i] * wa[2]; a8[3] += v[j][i] * wa[3]; a8[4] += v[j][i] * wb[0]; a8[5] += v[j][i] * wb[1]; a8[6] += v[j][i] * wb[2]; a8[7] += v[j][i] * wb[3]; }
            uint2 o; o.x = pk2(v[j][0], v[j][1]); o.y = pk2(v[j][2], v[j][3]); ((uint2*)(XN + (size_t)m * 1024))[lane + 64 * j] = o;
        }
#pragma unroll
        for (int c = 0; c < 8; ++c) a8[c] = wave_sum(a8[c]);
        if (lane == 0) {
#pragma unroll
            for (int c = 0; c < 8; ++c) IFb[(size_t)m * 8 + c] = a8[c] + gbias[c];
        }
    }
}

__device__ __forceinline__ void p2_attention(const Params& P, int lane, int wave) {
    const bf16* QKVA = (const bf16*)(P.ws + WS_QKVA); bf16* YA = (bf16*)(P.ws + WS_YA);
    const int gw = blockIdx.x * NW + wave, NGW = gridDim.x * NW;
    for (int it = gw; it < 16 * 256; it += NGW) {
        const int bh = it >> 8, tg = it & 255, b = bh >> 3, h = bh & 7;
        const int t = tg * 64 + lane; const size_t row = (size_t)b * SEQ + t;
        float q[64], o[64];
#pragma unroll
        for (int c = 0; c < 8; ++c) { const v4u w = *(const v4u*)(QKVA + row * 1536 + h * 64 + c * 8); unpk8(w, q + 8 * c); }
#pragma unroll
        for (int i = 0; i < 64; ++i) o[i] = 0.f;
        float m = -1e30f, l = 0.f;
        for (int dsel = 0; dsel < 3; ++dsel) {
            const int d = dsel == 0 ? 1 : (dsel == 1 ? 4 : 16);
            for (int j = 0; j <= 128; ++j) {
                const int tk = t - j * d;
                if (tk >= 0) {
                    const bf16* kr = QKVA + ((size_t)b * SEQ + tk) * 1536 + 512 + h * 64;
                    float s = 0.f;
#pragma unroll
                    for (int c = 0; c < 8; ++c) { float kf[8]; unpk8(*(const v4u*)(kr + c * 8), kf);
#pragma unroll
                        for (int i = 0; i < 8; ++i) s += q[8 * c + i] * kf[i]; }
                    const float mn = fmaxf(m, s), alpha = exp2f(m - mn), p = exp2f(s - mn);
                    l = l * alpha + p; m = mn;
#pragma unroll
                    for (int c = 0; c < 8; ++c) { float vf[8]; unpk8(*(const v4u*)(kr + 512 + c * 8), vf);
#pragma unroll
                        for (int i = 0; i < 8; ++i) o[8 * c + i] = o[8 * c + i] * alpha + p * vf[i]; }
                }
            }
        }
        const float inv = 1.0f / l;
#pragma unroll
        for (int c = 0; c < 8; ++c) { float f[8];
#pragma unroll
            for (int i = 0; i < 8; ++i) f[i] = o[8 * c + i] * inv;
            *(v4u*)(YA + row * 512 + h * 64 + c * 8) = pk8(f); }
    }
}

__device__ __forceinline__ float conv_silu(const bf16* QKM, const float* cw, int b, int t, int ch) {
    float a = 0.f;
#pragma unroll
    for (int j = 0; j < 4; ++j) { const int tt = t - 3 + j; if (tt >= 0) a += cw[j * 1024 + ch] * bf2f(QKM[((size_t)b * SEQ + tt) * 1024 + ch]); }
    return silu(a);
}

__device__ __forceinline__ void p2_mlstm_local(const Params& P, LAS unsigned char* lds, int tid) {
    const bf16* QKM = (const bf16*)(P.ws + WS_QKM); const bf16* VM = (const bf16*)(P.ws + WS_VM); const float* IFb = (const float*)(P.ws + WS_IF);
    const float* cw = P.in[4];
    bf16* DC = (bf16*)((unsigned char*)P.out + OUT_DC); float* DN = (float*)(P.ws + WS_DN); float* SC = (float*)(P.ws + WS_SC);
    LAS float* KW = (LAS float*)lds; LAS float* VS = (LAS float*)(lds + 32768); LAS float* sm = (LAS float*)(lds + 65536);
    for (int item = blockIdx.x; item < 2048; item += gridDim.x) {
        const int bh = item >> 8, c = item & 255, b = bh >> 2, h = bh & 3;
        if (tid < 64) { const size_t row = (size_t)b * SEQ + c * 64 + tid; sm[tid] = logsigmoid(IFb[row * 8 + 4 + h]); sm[64 + tid] = IFb[row * 8 + h]; }
        __syncthreads();
        if (tid == 0) {
            float bc = 0.f; for (int s = 0; s < 64; ++s) { bc += sm[s]; sm[128 + s] = bc; }
            const float g = bc; float ml = -1e30f;
            for (int s = 0; s < 64; ++s) { const float ds = g - sm[128 + s] + sm[64 + s]; sm[128 + s] = ds; ml = fmaxf(ml, ds); }
            for (int s = 0; s < 64; ++s) sm[128 + s] = __expf(sm[128 + s] - ml);
            SC[item] = ml; SC[2048 + item] = g;
        }
        __syncthreads();
        for (int idx = tid; idx < 64 * 128; idx += 512) { const int s = idx >> 7, e = idx & 127; const int t = c * 64 + s;
            KW[idx] = conv_silu(QKM, cw, b, t, 512 + h * 128 + e) * 0.08838834764831845f * sm[128 + s];
            VS[idx] = bf2f(VM[((size_t)b * SEQ + t) * 512 + h * 128 + e]); }
        __syncthreads();
        { const int f = tid >> 2, e0 = (tid & 3) * 32; float acc[32];
#pragma unroll
          for (int i = 0; i < 32; ++i) acc[i] = 0.f;
          for (int s = 0; s < 64; ++s) { const float vf = VS[s * 128 + f];
#pragma unroll
              for (int i = 0; i < 32; i += 4) { const f32x4 k4 = *(const LAS f32x4*)(KW + s * 128 + e0 + i); acc[i] += vf * k4[0]; acc[i + 1] += vf * k4[1]; acc[i + 2] += vf * k4[2]; acc[i + 3] += vf * k4[3]; } }
          bf16* dst = DC + (size_t)item * 16384 + f * 128 + e0;
#pragma unroll
          for (int i = 0; i < 32; i += 8) *(v4u*)(dst + i) = pk8(acc + i);
        }
        if (tid < 128) { float a = 0.f; for (int s = 0; s < 64; ++s) a += KW[s * 128 + tid]; DN[(size_t)item * 128 + tid] = a; }
        __syncthreads();
    }
}

__device__ __forceinline__ void p3_mlstm_scan(const Params& P, int tid) {
    const bf16* DC = (const bf16*)((unsigned char*)P.out + OUT_DC); bf16* CS = (bf16*)((unsigned char*)P.out + OUT_CS);
    const float* DN = (const float*)(P.ws + WS_DN); float* NS = (float*)(P.ws + WS_NS); float* SC = (float*)(P.ws + WS_SC);
    for (int gid = blockIdx.x * 512 + tid; gid < 8 * 16384; gid += gridDim.x * 512) {
        const int bh = gid >> 14, idx = gid & 16383;
        float C = 0.f, n = 0.f, m = 0.f;
        for (int j = 0; j < 256; ++j) {
            const int item = bh * 256 + j;
            CS[(size_t)item * 16384 + idx] = (bf16)f2bf(C);
            if (idx < 128) NS[(size_t)item * 128 + idx] = n;
            if (idx == 0) SC[4096 + item] = m;
            const float ml = SC[item], g = SC[2048 + item];
            const float mn = fmaxf(g + m, ml), a = __expf(g + m - mn), bb = __expf(ml - mn);
            C = a * C + bb * bf2f(DC[(size_t)item * 16384 + idx]);
            if (idx < 128) n = a * n + bb * DN[(size_t)item * 128 + idx];
            m = mn;
        }
    }
}

__device__ __forceinline__ void p4_mlstm_out(const Params& P, LAS unsigned char* lds, int tid) {
    const bf16* QKM = (const bf16*)(P.ws + WS_QKM); const bf16* VM = (const bf16*)(P.ws + WS_VM); const bf16* OM = (const bf16*)(P.ws + WS_OM); const float* IFb = (const float*)(P.ws + WS_IF);
    const float* cw = P.in[4]; const float* mnorm = P.in[6];
    const bf16* CS = (const bf16*)((unsigned char*)P.out + OUT_CS); const float* NS = (const float*)(P.ws + WS_NS); const float* SC = (const float*)(P.ws + WS_SC);
    bf16* YM = (bf16*)(P.ws + WS_YM);
    LAS bf16* Qs = (LAS bf16*)lds; LAS bf16* Ks = (LAS bf16*)(lds + 16384); LAS bf16* Vs = (LAS bf16*)(lds + 32768); LAS bf16* Cs = (LAS bf16*)(lds + 49152);
    LAS float* Pm = (LAS float*)(lds + 81920); LAS float* sm = (LAS float*)(lds + 98304);
    for (int item = blockIdx.x; item < 2048; item += gridDim.x) {
        const int bh = item >> 8, c = item & 255, b = bh >> 2, h = bh & 3;
        if (tid < 64) { const size_t row = (size_t)b * SEQ + c * 64 + tid; sm[tid] = logsigmoid(IFb[row * 8 + 4 + h]); sm[64 + tid] = IFb[row * 8 + h]; }
        if (tid >= 64 && tid < 192) sm[384 + tid - 64] = NS[(size_t)item * 128 + tid - 64];
        __syncthreads();
        if (tid == 0) {
            const float ms = SC[4096 + item]; float bc = 0.f, pm = -1e30f;
            for (int s = 0; s < 64; ++s) { bc += sm[s]; sm[128 + s] = bc; const float a = sm[64 + s] - bc; sm[s] = a; pm = fmaxf(pm, a); const float M = fmaxf(ms, pm); sm[192 + s] = M; sm[256 + s] = __expf(ms - M); }
        }
        for (int idx = tid; idx < 64 * 128; idx += 512) { const int s = idx >> 7, e = idx & 127; const int t = c * 64 + s;
            Qs[idx] = (bf16)f2bf(conv_silu(QKM, cw, b, t, h * 128 + e));
            Ks[idx] = (bf16)f2bf(conv_silu(QKM, cw, b, t, 512 + h * 128 + e) * 0.08838834764831845f);
            Vs[idx] = VM[((size_t)b * SEQ + t) * 512 + h * 128 + e]; }
        for (int i = tid; i < 2048; i += 512) ((LAS v4u*)Cs)[i] = ((const v4u*)(CS + (size_t)item * 16384))[i];
        __syncthreads();
        { const int t = tid >> 3, s0 = (tid & 7) * 8; float acc[8];
#pragma unroll
          for (int i = 0; i < 8; ++i) acc[i] = 0.f;
          for (int ec = 0; ec < 16; ++ec) { float qf[8]; unpk8(*(const LAS v4u*)(Qs + t * 128 + ec * 8), qf);
#pragma unroll
              for (int i = 0; i < 8; ++i) { float kf[8]; unpk8(*(const LAS v4u*)(Ks + (s0 + i) * 128 + ec * 8), kf);
#pragma unroll
                  for (int k = 0; k < 8; ++k) acc[i] += qf[k] * kf[k]; } }
          const float Mt = sm[192 + t];
#pragma unroll
          for (int i = 0; i < 8; ++i) { const int s = s0 + i; Pm[t * 64 + s] = (s <= t) ? acc[i] * __expf(sm[s] - Mt) : 0.f; }
        }
        __syncthreads();
        if (tid < 64) { const int t = tid; float qn = 0.f; for (int e = 0; e < 128; ++e) qn += bf2f(Qs[t * 128 + e]) * sm[384 + e];
            float sp = 0.f; for (int s = 0; s < 64; ++s) sp += Pm[t * 64 + s];
            const float den = sm[256 + t] * qn + sp; sm[320 + t] = fmaxf(fabsf(den), __expf(-sm[128 + t] - sm[192 + t])); }
        { const int t = tid >> 3, f0 = (tid & 7) * 16; float acc[16];
#pragma unroll
          for (int i = 0; i < 16; ++i) acc[i] = 0.f;
          for (int ec = 0; ec < 16; ++ec) { float qf[8]; unpk8(*(const LAS v4u*)(Qs + t * 128 + ec * 8), qf);
#pragma unroll
              for (int i = 0; i < 16; ++i) { float cf[8]; unpk8(*(const LAS v4u*)(Cs + (f0 + i) * 128 + ec * 8), cf);
#pragma unroll
                  for (int k = 0; k < 8; ++k) acc[i] += qf[k] * cf[k]; } }
          const float wi = sm[256 + t];
#pragma unroll
          for (int i = 0; i < 16; ++i) acc[i] *= wi;
          for (int s = 0; s < 64; ++s) { const float p = Pm[t * 64 + s]; float vf[16]; unpk8(*(const LAS v4u*)(Vs + s * 128 + f0), vf); unpk8(*(const LAS v4u*)(Vs + s * 128 + f0 + 8), vf + 8);
#pragma unroll
              for (int i = 0; i < 16; ++i) acc[i] += p * vf[i]; }
          __syncthreads();
          const float inv = 1.0f / sm[320 + t]; float ss = 0.f;
#pragma unroll
          for (int i = 0; i < 16; ++i) { acc[i] *= inv; ss += acc[i] * acc[i]; }
          ss += __shfl_xor(ss, 1); ss += __shfl_xor(ss, 2); ss += __shfl_xor(ss, 4);
          const float rs = rsqrtf(ss * (1.f / 128.f) + EPS);
          const size_t row = (size_t)b * SEQ + c * 64 + t; float om[16]; unpk8(*(const v4u*)(OM + row * 512 + h * 128 + f0), om); unpk8(*(const v4u*)(OM + row * 512 + h * 128 + f0 + 8), om + 8);
#pragma unroll
          for (int i = 0; i < 16; ++i) acc[i] = acc[i] * rs * mnorm[h * 128 + f0 + i] * om[i];
          *(v4u*)(YM + row * 512 + h * 128 + f0) = pk8(acc); *(v4u*)(YM + row * 512 + h * 128 + f0 + 8) = pk8(acc + 8);
        }
        __syncthreads();
    }
}

#define BUBBLE16(V, I, xv, xi) do { float _x = (xv); int _i = (xi); _Pragma("unroll") for (int _j = 0; _j < 16; ++_j) { const bool _gt = _x > V[_j]; const float _tv = V[_j]; const int _ti = I[_j]; V[_j] = _gt ? _x : _tv; I[_j] = _gt ? _i : _ti; _x = _gt ? _tv : _x; _i = _gt ? _ti : _i; } } while (0)
__device__ __forceinline__ void p10_topk(const Params& P, LAS unsigned char* lds, int tid) {
    const bf16* Q2 = (const bf16*)(P.ws + WS_Q2); const bf16* K1B = (const bf16*)(P.ws + WS_K1B); const bf16* K2B = (const bf16*)(P.ws + WS_K2B);
    int* IDX = (int*)(P.ws + WS_IDX); float* GATE = (float*)(P.ws + WS_GATE);
    LAS bf16* Kl = (LAS bf16*)lds;
    for (int item = blockIdx.x; item < 8 * 64; item += gridDim.x) {
        const int h = item >> 6, grp = item & 63; const size_t row = (size_t)grp * 512 + tid;
        __syncthreads();
        for (int i = tid; i < 2048; i += 512) { ((LAS v4u*)Kl)[i] = ((const v4u*)(K1B + (size_t)h * 16384))[i]; ((LAS v4u*)Kl)[2048 + i] = ((const v4u*)(K2B + (size_t)h * 16384))[i]; }
        __syncthreads();
        float tv[2][16]; int ti[2][16];
#pragma unroll
        for (int half = 0; half < 2; ++half) {
            v4u qw[16];
#pragma unroll
            for (int c = 0; c < 16; ++c) qw[c] = *(const v4u*)(Q2 + row * 2048 + h * 256 + half * 128 + c * 8);
#pragma unroll
            for (int j = 0; j < 16; ++j) { tv[half][j] = -1e30f; ti[half][j] = 0; }
            for (int n = 0; n < 128; ++n) {
                float s = 0.f;
#pragma unroll
                for (int c = 0; c < 16; ++c) { const v4u kw = *(const LAS v4u*)(Kl + half * 16384 + n * 128 + c * 8);
                    s = dot2bf(qw[c].x, kw.x, s); s = dot2bf(qw[c].y, kw.y, s); s = dot2bf(qw[c].z, kw.z, s); s = dot2bf(qw[c].w, kw.w, s); }
                BUBBLE16(tv[half], ti[half], s, n);
            }
        }
        LAS float* Lv = (LAS float*)(lds + 65536); LAS int* Li = (LAS int*)(lds + 65536 + 32768);
#pragma unroll
        for (int j = 0; j < 16; ++j) { Lv[j * 512 + tid] = tv[1][j]; Li[j * 512 + tid] = ti[1][j]; }
        float cv[16]; int ci[16];
#pragma unroll
        for (int j = 0; j < 16; ++j) { cv[j] = -1e30f; ci[j] = 0; }
#pragma unroll
        for (int a = 0; a < 16; ++a) {
            const int nb = 16 / (a + 1);
            for (int bq = 0; bq < nb; ++bq) { const float xv = tv[0][a] + Lv[bq * 512 + tid]; const int xi = ti[0][a] * 128 + Li[bq * 512 + tid]; BUBBLE16(cv, ci, xv, xi); }
        }
        float e[16], sum = 0.f;
#pragma unroll
        for (int j = 0; j < 16; ++j) { e[j] = __expf(cv[j] - cv[0]); sum += e[j]; }
        const float inv = 1.0f / sum;
#pragma unroll
        for (int j = 0; j < 16; ++j) e[j] *= inv;
#pragma unroll
        for (int j = 0; j < 16; j += 4) { *(int4*)(IDX + row * 128 + h * 16 + j) = make_int4(ci[j], ci[j + 1], ci[j + 2], ci[j + 3]); *(float4*)(GATE + row * 128 + h * 16 + j) = make_float4(e[j], e[j + 1], e[j + 2], e[j + 3]); }
    }
}

__device__ __forceinline__ void p11_peer(const Params& P, int lane, int wave) {
    const bf16* HN = (const bf16*)(P.ws + WS_HN); const bf16* UB = (const bf16*)(P.ws + WS_UB); const bf16* VB = (const bf16*)(P.ws + WS_VB);
    const int* IDX = (const int*)(P.ws + WS_IDX); const float* GATE = (const float*)(P.ws + WS_GATE);
    bf16* HN2 = (bf16*)(P.ws + WS_HN2); float* X = P.out; const float* gple = P.in[16];
    const int gw = blockIdx.x * NW + wave, NGW = gridDim.x * NW;
    for (int m = gw; m < NTOK; m += NGW) {
        float hv[16], o[16];
        unpk8(((const v4u*)(HN + (size_t)m * 1024))[lane], hv); unpk8(((const v4u*)(HN + (size_t)m * 1024))[64 + lane], hv + 8);
#pragma unroll
        for (int i = 0; i < 16; ++i) o[i] = 0.f;
        const int id0 = IDX[(size_t)m * 128 + lane], id1 = IDX[(size_t)m * 128 + 64 + lane];
        const float g0 = GATE[(size_t)m * 128 + lane], g1 = GATE[(size_t)m * 128 + 64 + lane];
#pragma unroll 4
        for (int j = 0; j < 128; ++j) {
            const int e = __shfl(j < 64 ? id0 : id1, j & 63); const float gt = __shfl(j < 64 ? g0 : g1, j & 63);
            const v4u* up = (const v4u*)(UB + (size_t)e * 1024); const v4u* vp = (const v4u*)(VB + (size_t)e * 1024);
            const v4u ua = up[lane], ub = up[64 + lane], va = vp[lane], vb = vp[64 + lane];
            float uf[16]; unpk8(ua, uf); unpk8(ub, uf + 8);
            float d = 0.f;
#pragma unroll
            for (int i = 0; i < 16; ++i) d += hv[i] * uf[i];
            d = wave_sum(d);
            const float w = gt * 0.5f * d * (1.0f + erff(d * 0.70710678118654752f));
            float vf[16]; unpk8(va, vf); unpk8(vb, vf + 8);
#pragma unroll
            for (int i = 0; i < 16; ++i) o[i] += w * vf[i];
        }
        float* xr = X + (size_t)m * 1024; float ss = 0.f;
        f32x4 x0 = ((f32x4*)xr)[2 * lane], x1 = ((f32x4*)xr)[2 * lane + 1], x2 = ((f32x4*)xr)[128 + 2 * lane], x3 = ((f32x4*)xr)[128 + 2 * lane + 1];
#pragma unroll
        for (int i = 0; i < 4; ++i) { x0[i] += o[i]; x1[i] += o[4 + i]; x2[i] += o[8 + i]; x3[i] += o[12 + i]; ss += x0[i] * x0[i] + x1[i] * x1[i] + x2[i] * x2[i] + x3[i] * x3[i]; }
        ((f32x4*)xr)[2 * lane] = x0; ((f32x4*)xr)[2 * lane + 1] = x1; ((f32x4*)xr)[128 + 2 * lane] = x2; ((f32x4*)xr)[128 + 2 * lane + 1] = x3;
        const float rstd = rsqrtf(wave_sum(ss) * (1.f / 1024.f) + EPS);
        const f32x4 ga = ((const f32x4*)gple)[2 * lane], gb = ((const f32x4*)gple)[2 * lane + 1], gc = ((const f32x4*)gple)[128 + 2 * lane], gd = ((const f32x4*)gple)[128 + 2 * lane + 1];
        v4u w0, w1;
        w0.x = pk2(x0[0] * rstd * ga[0], x0[1] * rstd * ga[1]); w0.y = pk2(x0[2] * rstd * ga[2], x0[3] * rstd * ga[3]); w0.z = pk2(x1[0] * rstd * gb[0], x1[1] * rstd * gb[1]); w0.w = pk2(x1[2] * rstd * gb[2], x1[3] * rstd * gb[3]);
        w1.x = pk2(x2[0] * rstd * gc[0], x2[1] * rstd * gc[1]); w1.y = pk2(x2[2] * rstd * gc[2], x2[3] * rstd * gc[3]); w1.z = pk2(x3[0] * rstd * gd[0], x3[1] * rstd * gd[1]); w1.w = pk2(x3[2] * rstd * gd[2], x3[3] * rstd * gd[3]);
        ((v4u*)(HN2 + (size_t)m * 1024))[lane] = w0; ((v4u*)(HN2 + (size_t)m * 1024))[64 + lane] = w1;
    }
}

__global__ void __launch_bounds__(512, 2) mk_fwd(Params P) {
    extern __shared__ __attribute__((aligned(16))) unsigned char lds_raw[];
    cg::grid_group grid = cg::this_grid();
    LAS unsigned char* lds = (LAS unsigned char*)lds_raw;
    const int tid = threadIdx.x, lane = tid & 63, wave = __builtin_amdgcn_readfirstlane(tid >> 6);
    const int lo = P.ph_lo, hi = P.ph_hi, G = gridDim.x, bx = blockIdx.x;
    unsigned char* ws = P.ws;
    const int gw = bx * NW + wave, NGW = G * NW;
#ifndef PH_MASK
#define PH_MASK 0xffff
#endif
#define IN(k) (((PH_MASK >> (k)) & 1) && lo <= (k) && (k) < hi)
#define SYNC_AFTER(k) do { if (IN(k) && IN((k) + 1)) grid.sync(); } while (0)
    typedef pg8::bf16_t pb;
    if (IN(0)) p0_prologue(P, lds, tid, lane, wave);
    SYNC_AFTER(0);
    if (IN(1)) {
        pg8::Gemm g{(const pb*)(ws + WS_XN), (const pb*)(ws + WS_W1T), NTOK, 5632, 1024}; pg8::StaticOrder S; S.init(NTOK, 5632, G, bx);
        pg8::EpiProj E{(pb*)(ws + WS_QKVA), (pb*)(ws + WS_QKM), (pb*)(ws + WS_VM), (pb*)(ws + WS_OM), (pb*)(ws + WS_G), C2};
        pg8::gemm_phase<pg8::EpiProj, pg8::StaticOrder, true, true>(lds, g, S, E);
    }
    SYNC_AFTER(1);
    if (IN(2)) { p2_attention(P, lane, wave); __syncthreads(); p2_mlstm_local(P, lds, tid); }
    SYNC_AFTER(2);
    if (IN(3)) p3_mlstm_scan(P, tid);
    SYNC_AFTER(3);
    if (IN(4)) p4_mlstm_out(P, lds, tid);
    SYNC_AFTER(4);
    if (IN(5)) {
        pg8::Gemm g{(const pb*)(ws + WS_YA), (const pb*)(ws + WS_WAT), NTOK, 1024, 512}; pg8::StaticOrder S; S.init(NTOK, 1024, G, bx);
        pg8::EpiGated<false> E{(pb*)(ws + WS_TMP), nullptr, (const pb*)(ws + WS_G), 0};
        pg8::gemm_phase<pg8::EpiGated<false>, pg8::StaticOrder, true, true>(lds, g, S, E);
    }
    if (IN(5) && IN(6)) { asm volatile("s_waitcnt vmcnt(0)" ::: "memory"); __syncthreads(); }
    if (IN(6)) {
        pg8::Gemm g{(const pb*)(ws + WS_YM), (const pb*)(ws + WS_WMT), NTOK, 1024, 512}; pg8::StaticOrder S; S.init(NTOK, 1024, G, bx);
        pg8::EpiGated<true> E{(pb*)(ws + WS_MERGED), (const pb*)(ws + WS_TMP), (const pb*)(ws + WS_G), 1024};
        pg8::gemm_phase<pg8::EpiGated<true>, pg8::StaticOrder, true, true>(lds, g, S, E);
    }
    SYNC_AFTER(6);
    if (IN(7)) {
        pg8::Gemm g{(const pb*)(ws + WS_MERGED), (const pb*)(ws + WS_WOT), NTOK, 1024, 1024}; pg8::StaticOrder S; S.init(NTOK, 1024, G, bx);
        pg8::EpiResidual E{P.in[0], P.out};
        pg8::gemm_phase<pg8::EpiResidual, pg8::StaticOrder, true, true>(lds, g, S, E);
    }
    SYNC_AFTER(7);
    if (IN(8)) {
        for (int m = gw; m < NTOK; m += NGW) rms_row_to_bf16(P.out + (size_t)m * 1024, P.in[10], (bf16*)(ws + WS_HN) + (size_t)m * 1024, lane);
        cvt_f32_bf16(P.in[1], (bf16*)(ws + WS_PB), (size_t)NTOK * 256 / 4, (size_t)bx * 512 + tid, (size_t)G * 512);
    }
    SYNC_AFTER(8);
    if (IN(9)) {
        pg8::Gemm g{(const pb*)(ws + WS_HN), (const pb*)(ws + WS_WQT), NTOK, 2048, 1024}; pg8::StaticOrder S; S.init(NTOK, 2048, G, bx);
        pg8::EpiStore E{(pb*)(ws + WS_Q2), 2048};
        pg8::gemm_phase<pg8::EpiStore, pg8::StaticOrder, true, true>(lds, g, S, E);
    }
    SYNC_AFTER(9);
    if (IN(10)) p10_topk(P, lds, tid);
    SYNC_AFTER(10);
    if (IN(11)) p11_peer(P, lane, wave);
    SYNC_AFTER(11);
    if (IN(12)) {
        pg8::Gemm g{(const pb*)(ws + WS_PB), (const pb*)(ws + WS_WPT), NTOK, 1024, 256}; pg8::StaticOrder S; S.init(NTOK, 1024, G, bx);
        pg8::EpiStore E{(pb*)(ws + WS_E), 1024};
        pg8::gemm_phase<pg8::EpiStore, pg8::StaticOrder, true, true>(lds, g, S, E);
    }
    if (IN(12) && IN(13)) { asm volatile("s_waitcnt vmcnt(0)" ::: "memory"); __syncthreads(); }
    if (IN(13)) {
        pg8::Gemm g{(const pb*)(ws + WS_HN2), (const pb*)(ws + WS_WGT), NTOK, 1024, 1024}; pg8::StaticOrder S; S.init(NTOK, 1024, G, bx);
        pg8::EpiPle E{P.out, (const pb*)(ws + WS_E)};
        pg8::gemm_phase<pg8::EpiPle, pg8::StaticOrder, true, true>(lds, g, S, E);
    }
    SYNC_AFTER(13);
    if (IN(14)) {
        const float* gf = P.in[19];
        for (int m = gw; m < NTOK; m += NGW) {
            float* xr = P.out + (size_t)m * 1024; f32x4 v[4]; float s = 0.f;
#pragma unroll
            for (int j = 0; j < 4; ++j) { v[j] = ((const f32x4*)xr)[lane + 64 * j]; s += (v[j][0] * v[j][0] + v[j][1] * v[j][1]) + (v[j][2] * v[j][2] + v[j][3] * v[j][3]); }
            const float rstd = rsqrtf(wave_sum(s) * (1.f / 1024.f) + EPS);
#pragma unroll
            for (int j = 0; j < 4; ++j) { const f32x4 g = ((const f32x4*)gf)[lane + 64 * j]; ((f32x4*)xr)[lane + 64 * j] = v[j] * rstd * g; }
        }
    }
}

extern "C" void kernel_launch(void* const* d_in, const int* in_sizes, int n_in, void* d_out, int out_size, void* d_ws, size_t ws_size, hipStream_t stream) {
    static int grid_blocks = 0;
    if (!grid_blocks) {
        int dev = 0, cus = 0, per_cu = 0;
        (void)hipGetDevice(&dev);
        (void)hipDeviceGetAttribute(&cus, hipDeviceAttributeMultiprocessorCount, dev);
        (void)hipFuncSetAttribute((const void*)mk_fwd, hipFuncAttributeMaxDynamicSharedMemorySize, LDS_BYTES);
        (void)hipOccupancyMaxActiveBlocksPerMultiprocessor(&per_cu, mk_fwd, 512, LDS_BYTES);
        if (per_cu > 1) per_cu = 1;
        grid_blocks = cus * per_cu;
    }
    if (n_in < 20 || ws_size < WS_NEED || grid_blocks <= 0) { fprintf(stderr, "kernel_launch: bad setup (n_in %d ws %zu grid %d)\n", n_in, ws_size, grid_blocks); return; }
    Params p{};
    for (int i = 0; i < 20; ++i) p.in[i] = (const float*)d_in[i];
    p.out = (float*)d_out; p.ws = (unsigned char*)d_ws; p.ph_lo = 0; p.ph_hi = 15;
    void* args[] = {&p};
    hipError_t e = hipLaunchCooperativeKernel((void*)mk_fwd, dim3(grid_blocks), dim3(512), args, LDS_BYTES, stream);
    if (e != hipSuccess) fprintf(stderr, "cooperative launch failed: %s (grid %d)\n", hipGetErrorString(e), grid_blocks);
}
```

```cpp
#include <hip/hip_runtime.h>
#include <hip/hip_cooperative_groups.h>
#include <cstdio>
#include <cstdint>
namespace cg = cooperative_groups;
namespace pg8 {
#define PG8_LAS __attribute__((address_space(3)))
typedef unsigned short bf16_t;
typedef short bf16x8 __attribute__((ext_vector_type(8)));
typedef float f32x4 __attribute__((ext_vector_type(4)));
typedef unsigned u32x4 __attribute__((ext_vector_type(4)));
constexpr int BM = 256, BK = 64, HALF = 128, HTB = HALF * BK * 2  , STAGE_BYTES = 8 * HTB, NXCD = 8, WGM = 8;

__host__ __device__ __forceinline__ int lds_byte(int r, int c) { const int st = (r >> 4) * 2 + (c >> 5), rr = r & 15, cc = c & 31, ob = rr * 64 + cc * 2; return st * 1024 + (ob ^ (((ob >> 9) & 1) << 5)); }
__host__ __device__ __forceinline__ void stage_rc(int b, int& R, int& C) { const int st = b / 1024, sb = b % 1024, swz = sb ^ (((sb >> 9) & 1) << 5); R = (st >> 1) * 16 + swz / 64; C = (st & 1) * 32 + (swz % 64) / 2; }
__host__ __device__ __forceinline__ int perm32(int rho) { const int n = rho >> 4, i = rho & 15; return 8 * (i >> 2) + 4 * n + (i & 3); }

struct Unit { int pm, pn; };
struct Gemm { const bf16_t* A; const bf16_t* Bt; int M, N, K; };

struct StaticOrder {
    int nM, nN, nwg, G, c;
    __host__ __device__ void init(int M, int N, int G_, int c_) { nM = M / BM; nN = N / BM; nwg = nM * nN; G = G_; c = c_; }
    __host__ __device__ bool next(int i, Unit& u) const {
        const long L = (long)i * G + c; if (L >= nwg) return false;
        int wgid = (int)L; { const int q = nwg / NXCD, r = nwg % NXCD, xcd = wgid % NXCD, off = wgid / NXCD; wgid = (xcd < r ? xcd * (q + 1) : r * (q + 1) + (xcd - r) * q) + off; }
        const int nig = WGM * nN, gid = wgid / nig, fm = gid * WGM, gsz = (nM - fm) < WGM ? (nM - fm) : WGM;
        u.pm = fm + ((wgid % nig) % gsz); u.pn = (wgid % nig) / gsz; return true;
    }
    __device__ __forceinline__ void a_ready(const Unit&) const {}
    __device__ __forceinline__ void done(const Unit&) const {}
};

__device__ __forceinline__ unsigned cvt_pk_bf16(float lo, float hi) { unsigned r; asm volatile("v_cvt_pk_bf16_f32 %0, %1, %2" : "=v"(r) : "v"(lo), "v"(hi)); return r; }
typedef float f32x2 __attribute__((ext_vector_type(2)));

__device__ __forceinline__ float sigm(float x) { return 1.0f / (1.0f + __expf(-x)); }
__device__ __forceinline__ float bf_lo(unsigned w) { return __uint_as_float(w << 16); }
__device__ __forceinline__ float bf_hi(unsigned w) { return __uint_as_float(w & 0xffff0000u); }
__device__ __forceinline__ u32x4 pack8(const f32x4& v0, const f32x4& v1) { u32x4 w; w.x = cvt_pk_bf16(v0[0], v0[1]); w.y = cvt_pk_bf16(v0[2], v0[3]); w.z = cvt_pk_bf16(v1[0], v1[1]); w.w = cvt_pk_bf16(v1[2], v1[3]); return w; }
__device__ __forceinline__ void unpack8(const u32x4& w, f32x4& v0, f32x4& v1) { v0[0] = bf_lo(w.x); v0[1] = bf_hi(w.x); v0[2] = bf_lo(w.y); v0[3] = bf_hi(w.y); v1[0] = bf_lo(w.z); v1[1] = bf_hi(w.z); v1[2] = bf_lo(w.w); v1[3] = bf_hi(w.w); }

#define PG8_EPI_WALK(...) \
    _Pragma("unroll") for (int ai = 0; ai < 2; ++ai) _Pragma("unroll") for (int m = 0; m < 4; ++m) { const int row = u.pm * BM + wr * 64 + fr + ai * HALF + m * 16; \
        _Pragma("unroll") for (int bj = 0; bj < 2; ++bj) { const int ct = bj * HALF + wc * 32 + 8 * fq; f32x4 v0 = acc[ai][bj][m][0], v1 = acc[ai][bj][m][1]; __VA_ARGS__ } }

struct EpiProj {
    static constexpr bool PERM = true, AFTER_DRAIN = false;
    bf16_t *qkva, *qkm, *vm, *om, *g; float c2;
    __device__ __forceinline__ void operator()(const f32x4 (&acc)[2][2][4][2], const Unit& u, int wr, int wc, int fr, int fq) const {
        const int pn = u.pn; bf16_t* base; int ldc, colt, mode = 0; float sc = 1.f;
        if (pn < 6) { base = qkva; ldc = 1536; colt = pn * 256; if (pn < 2) sc = c2; }
        else if (pn < 10) { base = qkm; ldc = 1024; colt = (pn - 6) * 256; }
        else if (pn < 12) { base = vm; ldc = 512; colt = (pn - 10) * 256; }
        else if (pn < 14) { base = om; ldc = 512; colt = (pn - 12) * 256; mode = 1; }
        else { base = g; ldc = 2048; colt = (pn - 14) * 256; mode = 1; }
        PG8_EPI_WALK({
            if (mode == 1) { _Pragma("unroll") for (int i = 0; i < 4; ++i) { v0[i] = sigm(v0[i]); v1[i] = sigm(v1[i]); } }
            else { v0 = v0 * sc; v1 = v1 * sc; }
            *(u32x4*)(base + (size_t)row * ldc + colt + ct) = pack8(v0, v1);
        })
    }
};
struct EpiStore {
    static constexpr bool PERM = true, AFTER_DRAIN = false;
    bf16_t* O; int ldc;
    __device__ __forceinline__ void operator()(const f32x4 (&acc)[2][2][4][2], const Unit& u, int wr, int wc, int fr, int fq) const {
        PG8_EPI_WALK({ *(u32x4*)(O + (size_t)row * ldc + u.pn * BM + ct) = pack8(v0, v1); })
    }
};
template <bool ADD> struct EpiGated {
    static constexpr bool PERM = true, AFTER_DRAIN = false;
    bf16_t* O; const bf16_t* prev; const bf16_t* gate; int gcol0;
    __device__ __forceinline__ void operator()(const f32x4 (&acc)[2][2][4][2], const Unit& u, int wr, int wc, int fr, int fq) const {
        PG8_EPI_WALK({
            const int col = u.pn * BM + ct; f32x4 g0, g1; unpack8(*(const u32x4*)(gate + (size_t)row * 2048 + gcol0 + col), g0, g1);
            v0 = v0 * g0; v1 = v1 * g1;
            if (ADD) { f32x4 p0, p1; unpack8(*(const u32x4*)(prev + (size_t)row * 1024 + col), p0, p1); v0 = v0 + p0; v1 = v1 + p1; }
            *(u32x4*)(O + (size_t)row * 1024 + col) = pack8(v0, v1);
        })
    }
};
struct EpiResidual {
    static constexpr bool PERM = true, AFTER_DRAIN = false;
    const float* res; float* out;
    __device__ __forceinline__ void operator()(const f32x4 (&acc)[2][2][4][2], const Unit& u, int wr, int wc, int fr, int fq) const {
        PG8_EPI_WALK({
            const size_t o = (size_t)row * 1024 + u.pn * BM + ct; const f32x4 r0 = *(const f32x4*)(res + o), r1 = *(const f32x4*)(res + o + 4);
            *(f32x4*)(out + o) = r0 + v0; *(f32x4*)(out + o + 4) = r1 + v1;
        })
    }
};
struct EpiPle {
    static constexpr bool PERM = true, AFTER_DRAIN = false;
    float* xio; const bf16_t* e;
    __device__ __forceinline__ void operator()(const f32x4 (&acc)[2][2][4][2], const Unit& u, int wr, int wc, int fr, int fq) const {
        PG8_EPI_WALK({
            const size_t o = (size_t)row * 1024 + u.pn * BM + ct; f32x4 e0, e1; unpack8(*(const u32x4*)(e + o), e0, e1);
            const f32x4 r0 = *(const f32x4*)(xio + o), r1 = *(const f32x4*)(xio + o + 4);
            _Pragma("unroll") for (int i = 0; i < 4; ++i) { v0[i] = r0[i] + sigm(v0[i]) * e0[i]; v1[i] = r1[i] + sigm(v1[i]) * e1[i]; }
            *(f32x4*)(xio + o) = v0; *(f32x4*)(xio + o + 4) = v1;
        })
    }
};

template <class Epi, class Sched, bool ALIGN_EPI = false, bool SP2 = false>
__device__ __forceinline__ void gemm_phase(PG8_LAS unsigned char* lds, const Gemm g, const Sched& S, const Epi& E) {
    const int tid = threadIdx.x, wid = __builtin_amdgcn_readfirstlane(tid >> 6), lane = tid & 63, wr = wid >> 2, wc = wid & 3, fr = lane & 15, fq = lane >> 4;
    const int K = g.K, nt = K / BK;
    unsigned voffA[2], voffB[2];
#pragma unroll
    for (int i = 0; i < 2; ++i) { int R, C; stage_rc(tid * 16 + i * 8192, R, C); const int Rb = Epi::PERM ? ((R & ~31) + perm32(R & 31)) : R;
        voffA[i] = (unsigned)(R * K + C) * 2u; voffB[i] = (unsigned)(Rb * K + C) * 2u; }
    const size_t kstep = (size_t)(BK * 2);
    const size_t hstep = (size_t)HALF * K * 2;
    const size_t tstep = 2 * hstep;
    const unsigned ldsw = (unsigned)wid * 1024u;
    const int aoff = lds_byte(wr * 64 + fr, fq * 8), boff = lds_byte(wc * 32 + fr, fq * 8);
#define PG8_SA(b, h) (((b) * 2 + (h)) * HTB)
#define PG8_SB(b, h) ((4 + (b) * 2 + (h)) * HTB)
#define PG8_STAGE(bufoff, gbase, voff) do { _Pragma("unroll") for (int _i = 0; _i < 2; ++_i) \
        __builtin_amdgcn_global_load_lds((const unsigned*)((const char*)(gbase) + (voff)[_i]), (PG8_LAS unsigned*)(lds + (bufoff) + ldsw + _i * 8192), 16, 0, 0); } while (0)
#define PG8_LDA(dst, b, h) do { _Pragma("unroll") for (int m = 0; m < 4; ++m) _Pragma("unroll") for (int k = 0; k < 2; ++k) dst[m][k] = *(const PG8_LAS bf16x8*)(lds + PG8_SA(b, h) + aoff + m * 2048 + k * 1024); } while (0)
#define PG8_LDB(dst, b, h) do { _Pragma("unroll") for (int n = 0; n < 2; ++n) _Pragma("unroll") for (int k = 0; k < 2; ++k) dst[n][k] = *(const PG8_LAS bf16x8*)(lds + PG8_SB(b, h) + boff + n * 2048 + k * 1024); } while (0)
#define PG8_MMA(ai, bj, At, Bt) do { __builtin_amdgcn_s_setprio(1); _Pragma("unroll") for (int m = 0; m < 4; ++m) _Pragma("unroll") for (int n = 0; n < 2; ++n) _Pragma("unroll") for (int k = 0; k < 2; ++k) \
        acc[ai][bj][m][n] = __builtin_amdgcn_mfma_f32_16x16x32_bf16(Bt[n][k], At[m][k], acc[ai][bj][m][n], 0, 0, 0); __builtin_amdgcn_s_setprio(0); } while (0)
#define PG8_WAIT_V(n) asm volatile("s_waitcnt vmcnt(" #n ")" ::: "memory")
#define PG8_WAIT_L(n) asm volatile("s_waitcnt lgkmcnt(" #n ")" ::: "memory")
#define PG8_BAR __builtin_amdgcn_s_barrier()
#define PG8_SCHED __builtin_amdgcn_sched_barrier(0)
    Unit cur, nxt; int ui = 0;
    if (!S.next(0, cur)) return;
    f32x4 acc[2][2][4][2];
#pragma unroll
    for (int a = 0; a < 2; ++a)
#pragma unroll
        for (int b = 0; b < 2; ++b)
#pragma unroll
            for (int m = 0; m < 4; ++m)
#pragma unroll
                for (int n = 0; n < 2; ++n) acc[a][b][m][n] = (f32x4){0.f, 0.f, 0.f, 0.f};
    bf16x8 At[4][2], B0[2][2], B1[2][2];
    const char* cA = (const char*)g.A + (size_t)cur.pm * tstep; const char* cB = (const char*)g.Bt + (size_t)cur.pn * tstep;
    S.a_ready(cur);
    if constexpr (SP2) {
        PG8_STAGE(PG8_SB(0, 0), cB, voffB); PG8_STAGE(PG8_SB(0, 1), cB + hstep, voffB); PG8_STAGE(PG8_SA(0, 0), cA, voffA); PG8_STAGE(PG8_SA(0, 1), cA + hstep, voffA);
        if (wr == 1) PG8_BAR;
        PG8_WAIT_V(2); PG8_BAR;
        PG8_STAGE(PG8_SB(1, 0), cB + kstep, voffB); PG8_STAGE(PG8_SA(1, 0), cA + kstep, voffA); PG8_STAGE(PG8_SB(1, 1), cB + hstep + kstep, voffB);
        PG8_WAIT_V(6); PG8_BAR;
    } else {
        PG8_STAGE(PG8_SB(0, 0), cB, voffB); PG8_STAGE(PG8_SA(0, 0), cA, voffA); PG8_STAGE(PG8_SB(0, 1), cB + hstep, voffB); PG8_STAGE(PG8_SA(0, 1), cA + hstep, voffA);
        if (wr == 1) PG8_BAR;
        PG8_WAIT_V(4); PG8_BAR;
        PG8_STAGE(PG8_SB(1, 0), cB + kstep, voffB); PG8_STAGE(PG8_SA(1, 0), cA + kstep, voffA); PG8_STAGE(PG8_SB(1, 1), cB + hstep + kstep, voffB);
        PG8_WAIT_V(6); PG8_BAR;
    }
    for (;;) {
        const bool has_next = S.next(ui + 1, nxt);
        const char* nA = has_next ? (const char*)g.A + (size_t)nxt.pm * tstep : cA; const char* nB = has_next ? (const char*)g.Bt + (size_t)nxt.pn * tstep : cB;
        for (int t = 0; t < nt; t += 2) {
            const bool last = (t == nt - 2);
            const char* a1 = cA + (size_t)(t + 1) * kstep;
            const char* a2 = last ? nA : cA + (size_t)(t + 2) * kstep; const char* b2 = last ? nB : cB + (size_t)(t + 2) * kstep;
            const char* a3 = a2 + kstep; const char* b3 = b2 + kstep;
            if (last && has_next) S.a_ready(nxt);
            if constexpr (SP2) {
            PG8_LDB(B0, 0, 0); PG8_LDB(B1, 0, 1); PG8_SCHED; PG8_LDA(At, 0, 0); PG8_STAGE(PG8_SA(1, 1), a1 + hstep, voffA);
            PG8_WAIT_V(8); PG8_WAIT_L(0); PG8_BAR; PG8_MMA(0, 0, At, B0); PG8_MMA(0, 1, At, B1); PG8_BAR; PG8_SCHED;
            PG8_LDA(At, 0, 1); PG8_STAGE(PG8_SB(0, 0), b2, voffB); PG8_STAGE(PG8_SB(0, 1), b2 + hstep, voffB); PG8_STAGE(PG8_SA(0, 0), a2, voffA);
            PG8_WAIT_V(8); PG8_WAIT_L(0); PG8_BAR; PG8_MMA(1, 0, At, B0); PG8_MMA(1, 1, At, B1); PG8_BAR; PG8_SCHED;
            PG8_LDB(B0, 1, 0); PG8_LDB(B1, 1, 1); PG8_SCHED; PG8_LDA(At, 1, 0); PG8_STAGE(PG8_SA(0, 1), a2 + hstep, voffA);
            PG8_WAIT_V(8); PG8_WAIT_L(0); PG8_BAR; PG8_MMA(0, 0, At, B0); PG8_MMA(0, 1, At, B1); PG8_BAR; PG8_SCHED;
            PG8_LDA(At, 1, 1); PG8_STAGE(PG8_SB(1, 0), b3, voffB); PG8_STAGE(PG8_SB(1, 1), b3 + hstep, voffB); PG8_STAGE(PG8_SA(1, 0), a3, voffA);
            PG8_WAIT_V(8); PG8_WAIT_L(0); PG8_BAR; PG8_MMA(1, 0, At, B0); PG8_MMA(1, 1, At, B1); PG8_BAR; PG8_SCHED;
            } else {
            PG8_LDB(B0, 0, 0); PG8_SCHED; PG8_LDA(At, 0, 0); PG8_STAGE(PG8_SA(1, 1), a1 + hstep, voffA);
            PG8_WAIT_L(8); PG8_BAR; PG8_WAIT_L(0); PG8_MMA(0, 0, At, B0); PG8_BAR; PG8_SCHED;
            PG8_LDB(B1, 0, 1); PG8_STAGE(PG8_SB(0, 0), b2, voffB);
            PG8_BAR; PG8_WAIT_L(0); PG8_MMA(0, 1, At, B1); PG8_BAR;
            PG8_LDA(At, 0, 1); PG8_STAGE(PG8_SA(0, 0), a2, voffA);
            PG8_BAR; PG8_WAIT_L(0); PG8_MMA(1, 0, At, B0); PG8_BAR; PG8_SCHED;
            PG8_STAGE(PG8_SB(0, 1), b2 + hstep, voffB);
            PG8_WAIT_V(6); PG8_BAR; PG8_MMA(1, 1, At, B1); PG8_BAR;
            PG8_LDB(B0, 1, 0); PG8_SCHED; PG8_LDA(At, 1, 0); PG8_STAGE(PG8_SA(0, 1), a2 + hstep, voffA);
            PG8_WAIT_L(8); PG8_BAR; PG8_WAIT_L(0); PG8_MMA(0, 0, At, B0); PG8_BAR; PG8_SCHED;
            PG8_LDB(B1, 1, 1); PG8_STAGE(PG8_SB(1, 0), b3, voffB);
            PG8_BAR; PG8_WAIT_L(0); PG8_MMA(0, 1, At, B1); PG8_BAR;
            PG8_LDA(At, 1, 1); PG8_STAGE(PG8_SA(1, 0), a3, voffA);
            PG8_BAR; PG8_WAIT_L(0); PG8_MMA(1, 0, At, B0); PG8_BAR; PG8_SCHED;
            PG8_STAGE(PG8_SB(1, 1), b3 + hstep, voffB);
            PG8_WAIT_V(6); PG8_BAR; PG8_MMA(1, 1, At, B1); PG8_BAR;
            }
        }
        if constexpr (ALIGN_EPI) { if (wr == 0) PG8_BAR; }
        if constexpr (!Epi::AFTER_DRAIN) { E(acc, cur, wr, wc, fr, fq); S.done(cur); }
        if (!has_next) break;
#pragma unroll
        for (int a = 0; a < 2; ++a)
#pragma unroll
            for (int b = 0; b < 2; ++b)
#pragma unroll
                for (int m = 0; m < 4; ++m)
#pragma unroll
                    for (int n = 0; n < 2; ++n) acc[a][b][m][n] = (f32x4){0.f, 0.f, 0.f, 0.f};
        cur = nxt; cA = nA; cB = nB; ++ui;
        if constexpr (ALIGN_EPI) { if (wr == 1) PG8_BAR; }
    }
    PG8_WAIT_V(0);
    if constexpr (!ALIGN_EPI) { if (wr == 0) PG8_BAR; }
    PG8_BAR;
    if constexpr (Epi::AFTER_DRAIN) { E.fused(acc, cur, wr, wc, fr, fq, lds, wid, lane); S.done(cur); }
#undef PG8_SA
#undef PG8_SB
#undef PG8_STAGE
#undef PG8_LDA
#undef PG8_LDB
#undef PG8_MMA
#undef PG8_WAIT_V
#undef PG8_WAIT_L
#undef PG8_BAR
#undef PG8_SCHED
}
}

#define GAS __attribute__((address_space(1)))
#define LAS __attribute__((address_space(3)))
typedef unsigned short bf16;
typedef unsigned v4u __attribute__((ext_vector_type(4)));
typedef unsigned v2u __attribute__((ext_vector_type(2)));
typedef float f32x4 __attribute__((ext_vector_type(4)));
using pg8::bf_lo; using pg8::bf_hi; using pg8::sigm;

constexpr int NTOK = 32768, SEQ = 16384, DM = 1024, NW = 8;
constexpr float EPS = 1e-6f;
constexpr float C2 = 0.125f * 1.4426950408889634f;
constexpr size_t MiB = 1u << 20;
constexpr size_t WS_W1T = 1 * MiB, WS_WAT = 12 * MiB, WS_WMT = 13 * MiB, WS_WOT = 14 * MiB, WS_WQT = 16 * MiB, WS_WGT = 20 * MiB, WS_WPT = 22 * MiB;
constexpr size_t WS_K1B = 22 * MiB + 512 * 1024, WS_K2B = 22 * MiB + 768 * 1024, WS_IF = 23 * MiB, WS_UB = 24 * MiB, WS_VB = 56 * MiB;
constexpr size_t WS_XN = 88 * MiB, WS_YA = 88 * MiB, WS_YM = 120 * MiB, WS_HN = 88 * MiB;
constexpr size_t WS_QKVA = 152 * MiB, WS_QKM = 248 * MiB, WS_VM = 312 * MiB, WS_OM = 344 * MiB, WS_G = 376 * MiB;
constexpr size_t WS_DN = 504 * MiB, WS_NS = 505 * MiB, WS_SC = 506 * MiB;
constexpr size_t WS_MERGED = 152 * MiB, WS_TMP = 216 * MiB, WS_Q2 = 376 * MiB, WS_IDX = 152 * MiB, WS_GATE = 168 * MiB, WS_HN2 = 184 * MiB, WS_PB = 248 * MiB, WS_E = 264 * MiB;
constexpr size_t WS_NEED = 507 * MiB;
constexpr size_t OUT_DC = 0, OUT_CS = 64 * MiB;
constexpr int LDS_BYTES = 147456;

__device__ __forceinline__ unsigned f2bf(float f) { unsigned u = __float_as_uint(f); return (u + 0x7fffu + ((u >> 16) & 1u)) >> 16; }
__device__ __forceinline__ unsigned pk2(float lo, float hi) { return f2bf(lo) | (f2bf(hi) << 16); }
__device__ __forceinline__ float bf2f(bf16 b) { return __uint_as_float((unsigned)b << 16); }
__device__ __forceinline__ float wave_sum(float v) {
#pragma unroll
    for (int o = 1; o < 64; o <<= 1) v += __shfl_xor(v, o);
    return v;
}
__device__ __forceinline__ void unpk8(const v4u w, float* f) { f[0] = bf_lo(w.x); f[1] = bf_hi(w.x); f[2] = bf_lo(w.y); f[3] = bf_hi(w.y); f[4] = bf_lo(w.z); f[5] = bf_hi(w.z); f[6] = bf_lo(w.w); f[7] = bf_hi(w.w); }
__device__ __forceinline__ v4u pk8(const float* f) { v4u w; w.x = pk2(f[0], f[1]); w.y = pk2(f[2], f[3]); w.z = pk2(f[4], f[5]); w.w = pk2(f[6], f[7]); return w; }
typedef __bf16 bf16x2_t __attribute__((ext_vector_type(2)));
__device__ __forceinline__ float dot2bf(unsigned a, unsigned b, float c) { return __builtin_amdgcn_fdot2_f32_bf16(__builtin_bit_cast(bf16x2_t, a), __builtin_bit_cast(bf16x2_t, b), c, false); }
__device__ __forceinline__ float logsigmoid(float x) { return fminf(x, 0.f) - log1pf(__expf(-fabsf(x))); }
__device__ __forceinline__ float silu(float x) { return x / (1.0f + __expf(-x)); }

struct Params { const float* in[20]; float* out; unsigned char* ws; int ph_lo, ph_hi; };

__device__ __forceinline__ void transpose_item(const float* W, int ldw, int col0, int K, bf16* WT, int row0, LAS float* scr, int item, int nblk, int lane) {
    const int kb = item / nblk, nb = item % nblk, k0 = 64 * kb, n0 = 32 * nb;
#pragma unroll 8
    for (int i = 0; i < 32; ++i) { const int kk = 2 * i + (lane >> 5); scr[kk * 33 + (lane & 31)] = W[(size_t)(k0 + kk) * ldw + col0 + n0 + (lane & 31)]; }
    asm volatile("s_waitcnt lgkmcnt(0)" ::: "memory");
    const int c = lane & 7;
#pragma unroll
    for (int j = 0; j < 4; ++j) { const int n = (lane >> 3) + 8 * j; const LAS float* s = scr + (8 * c) * 33 + n;
        v4u o; o.x = pk2(s[0 * 33], s[1 * 33]); o.y = pk2(s[2 * 33], s[3 * 33]); o.z = pk2(s[4 * 33], s[5 * 33]); o.w = pk2(s[6 * 33], s[7 * 33]);
        *(v4u*)(WT + (size_t)(row0 + n0 + n) * K + k0 + 8 * c) = o; }
    asm volatile("s_waitcnt lgkmcnt(0)" ::: "memory");
}
__device__ __forceinline__ void cvt_f32_bf16(const float* src, bf16* dst, size_t n4, size_t gtid, size_t gsz) {
    for (size_t i = gtid; i < n4; i += gsz) { const f32x4 v = ((const f32x4*)src)[i]; uint2 o; o.x = pk2(v[0], v[1]); o.y = pk2(v[2], v[3]); ((uint2*)dst)[i] = o; }
}
__device__ __forceinline__ void rms_row_to_bf16(const float* xrow, const float* gain, bf16* orow, int lane) {
    f32x4 v[4]; float s = 0.f;
#pragma unroll
    for (int j = 0; j < 4; ++j) { v[j] = ((const f32x4*)xrow)[lane + 64 * j]; s += (v[j][0] * v[j][0] + v[j][1] * v[j][1]) + (v[j][2] * v[j][2] + v[j][3] * v[j][3]); }
    const float rstd = rsqrtf(wave_sum(s) * (1.f / 1024.f) + EPS);
#pragma unroll
    for (int j = 0; j < 4; ++j) { const f32x4 g = ((const f32x4*)gain)[lane + 64 * j]; uint2 o; o.x = pk2(v[j][0] * rstd * g[0], v[j][1] * rstd * g[1]); o.y = pk2(v[j][2] * rstd * g[2], v[j][3] * rstd * g[3]); ((uint2*)orow)[lane + 64 * j] = o; }
}
__device__ __forceinline__ void p0_prologue(const Params& P, LAS unsigned char* lds, int tid, int lane, int wave) {
    unsigned char* ws = P.ws;
    const int gw = blockIdx.x * NW + wave, NGW = gridDim.x * NW;
    LAS float* scr = (LAS float*)(lds + wave * 8448);
    LAS float* wif = (LAS float*)(lds + 69632);
    const float* w_in = P.in[3];
    for (int i = tid; i < 8192; i += 512) wif[i] = w_in[(size_t)(i >> 3) * 5640 + 3584 + (i & 7)];
    __syncthreads();
    constexpr int I1A = 16 * 112, I1B = 16 * 64, IUP = 8 * 32, IOUT = 16 * 32, IQ = 16 * 64, IPL = 4 * 32;
    constexpr int NITEMS = I1A + I1B + 2 * IUP + IOUT + IQ + IOUT + IPL;
    for (int it = gw; it < NITEMS; it += NGW) {
        int r = it;
        if (r < I1A) { transpose_item(w_in, 5640, 0, 1024, (bf16*)(ws + WS_W1T), 0, scr, r, 112, lane); continue; } r -= I1A;
        if (r < I1B) { transpose_item(w_in, 5640, 3592, 1024, (bf16*)(ws + WS_W1T), 3584, scr, r, 64, lane); continue; } r -= I1B;
        if (r < IUP) { transpose_item(P.in[7], 1024, 0, 512, (bf16*)(ws + WS_WAT), 0, scr, r, 32, lane); continue; } r -= IUP;
        if (r < IUP) { transpose_item(P.in[8], 1024, 0, 512, (bf16*)(ws + WS_WMT), 0, scr, r, 32, lane); continue; } r -= IUP;
        if (r < IOUT) { transpose_item(P.in[9], 1024, 0, 1024, (bf16*)(ws + WS_WOT), 0, scr, r, 32, lane); continue; } r -= IOUT;
        if (r < IQ) { transpose_item(P.in[11], 2048, 0, 1024, (bf16*)(ws + WS_WQT), 0, scr, r, 64, lane); continue; } r -= IQ;
        if (r < IOUT) { transpose_item(P.in[17], 1024, 0, 1024, (bf16*)(ws + WS_WGT), 0, scr, r, 32, lane); continue; } r -= IOUT;
        transpose_item(P.in[18], 1024, 0, 256, (bf16*)(ws + WS_WPT), 0, scr, r, 32, lane);
    }
    const size_t gtid = (size_t)blockIdx.x * 512 + tid, gsz = (size_t)gridDim.x * 512;
    cvt_f32_bf16(P.in[12], (bf16*)(ws + WS_K1B), 8 * 128 * 128 / 4, gtid, gsz);
    cvt_f32_bf16(P.in[13], (bf16*)(ws + WS_K2B), 8 * 128 * 128 / 4, gtid, gsz);
    cvt_f32_bf16(P.in[14], (bf16*)(ws + WS_UB), (size_t)16384 * 1024 / 4, gtid, gsz);
    cvt_f32_bf16(P.in[15], (bf16*)(ws + WS_VB), (size_t)16384 * 1024 / 4, gtid, gsz);
    const float* x = P.in[0]; const float* gmix = P.in[2]; const float* gbias = P.in[5];
    bf16* XN = (bf16*)(ws + WS_XN); float* IFb = (float*)(ws + WS_IF);
    for (int m = gw; m < NTOK; m += NGW) {
        const float* xrow = x + (size_t)m * 1024;
        f32x4 v[4]; float s = 0.f;
#pragma unroll
        for (int j = 0; j < 4; ++j) { v[j] = ((const f32x4*)xrow)[lane + 64 * j]; s += (v[j][0] * v[j][0] + v[j][1] * v[j][1]) + (v[j][2] * v[j][2] + v[j][3] * v[j][3]); }
        const float rstd = rsqrtf(wave_sum(s) * (1.f / 1024.f) + EPS);
        float a8[8] = {0.f, 0.f, 0.f, 0.f, 0.f, 0.f, 0.f, 0.f};
#pragma unroll
        for (int j = 0; j < 4; ++j) {
            const f32x4 g = ((const f32x4*)gmix)[lane + 64 * j];
#pragma unroll
            for (int i = 0; i < 4; ++i) { v[j][i] = v[j][i] * rstd * g[i]; const int d = 4 * (lane + 64 * j) + i; const f32x4 wa = *(const LAS f32x4*)(wif + d * 8), wb = *(const LAS f32x4*)(wif + d * 8 + 4);
                a8[0] += v[j][i] * wa[0]; a8[1] += v[j][i] * wa[1]; a8[2] += v[j][i] * wa[2]; a8[3] += v[j][i] * wa[3]; a8[4] += v[j][i] * wb[0]; a8[5] += v[j][i] * wb[1]; a8[6] += v[j][i] * wb[2]; a8[7] += v[j][i] * wb[3]; }
            uint2 o; o.x = pk2(v[j][0], v[j][1]); o.y = pk2(v[j][2], v[j][3]); ((uint2*)(XN + (size_t)m * 1024))[lane + 64 * j] = o;
        }
#pragma unroll
        for (int c = 0; c < 8; ++c) a8[c] = wave_sum(a8[c]);
        if (lane == 0) {
#pragma unroll
            for (int c = 0; c < 8; ++c) IFb[(size_t)m * 8 + c] = a8[c] + gbias[c];
        }
    }
}

typedef short bf16x8 __attribute__((ext_vector_type(8)));
typedef short v4i16 __attribute__((ext_vector_type(4)));
#define MFMA16(a, b, c) __builtin_amdgcn_mfma_f32_16x16x32_bf16((a), (b), (c), 0, 0, 0)
__device__ __forceinline__ void attn_pair_params(int pp, int& d, int& n0, int& sh) {
    if (pp < 5) { d = 16; sh = 4; n0 = -144 + 32 * pp; } else if (pp < 11) { d = 4; sh = 2; n0 = -128 + 32 * (pp - 5); } else { d = 1; sh = 0; n0 = -128 + 32 * (pp - 11); }
}
__device__ __forceinline__ void p2_attention(const Params& P, LAS unsigned char* lds, int lane, int wave) {
    const bf16* QKVA = (const bf16*)(P.ws + WS_QKVA); bf16* YA = (bf16*)(P.ws + WS_YA);
    LAS unsigned char* vbuf = lds + wave * 10240;
    const int r = lane & 15, g = lane >> 4, kk = lane & 31, half = lane >> 5;
    const int trq = (lane >> 2) & 3, trp = lane & 3;
    const int tr_off = (4 * g + trq) * 160 + trp * 8;
    for (int wi = blockIdx.x; wi < 1024; wi += gridDim.x) {
        const int bh = wi >> 6, tb = wi & 63, b = bh >> 3, h = bh & 7;
        const bf16* base = QKVA + (size_t)b * SEQ * 1536 + h * 64;
#pragma unroll 1
        for (int uu = 0; uu < 2; ++uu) {
            const int t0 = tb * 256 + wave * 2 + uu, tq = t0 + 16 * r;
            const bf16x8 qb0 = *(const bf16x8*)(base + (size_t)tq * 1536 + 8 * g), qb1 = *(const bf16x8*)(base + (size_t)tq * 1536 + 32 + 8 * g);
            f32x4 o[4];
#pragma unroll
            for (int i = 0; i < 4; ++i) o[i] = (f32x4){0.f, 0.f, 0.f, 0.f};
            float m = -1e30f, l = 0.f;
            bf16x8 kc[2][2], kn[2][2]; v4u vn[4];
            { int d, n0, sh; attn_pair_params(0, d, n0, sh);
#pragma unroll
              for (int blk = 0; blk < 2; ++blk) { int tok = t0 + d * (n0 + 16 * blk + r); tok = min(max(tok, 0), SEQ - 1); const bf16* kp = base + 512 + (size_t)tok * 1536 + 8 * g; kc[blk][0] = *(const bf16x8*)kp; kc[blk][1] = *(const bf16x8*)(kp + 32); }
              int tokv = t0 + d * (n0 + kk); tokv = min(max(tokv, 0), SEQ - 1); const bf16* vp = base + 1024 + (size_t)tokv * 1536 + 32 * half;
#pragma unroll
              for (int c = 0; c < 4; ++c) vn[c] = *(const v4u*)(vp + 8 * c);
#pragma unroll
              for (int c = 0; c < 4; ++c) *(LAS v4u*)(vbuf + kk * 160 + half * 64 + c * 16) = vn[c];
            }
#pragma unroll 1
            for (int pp = 0; pp < 23; ++pp) {
                int d, n0, sh; attn_pair_params(pp, d, n0, sh);
                { int dn, nn, shn; attn_pair_params(pp < 22 ? pp + 1 : pp, dn, nn, shn);
#pragma unroll
                  for (int blk = 0; blk < 2; ++blk) { int tok = t0 + dn * (nn + 16 * blk + r); tok = min(max(tok, 0), SEQ - 1); const bf16* kp = base + 512 + (size_t)tok * 1536 + 8 * g; kn[blk][0] = *(const bf16x8*)kp; kn[blk][1] = *(const bf16x8*)(kp + 32); }
                  int tokv = t0 + dn * (nn + kk); tokv = min(max(tokv, 0), SEQ - 1); const bf16* vp = base + 1024 + (size_t)tokv * 1536 + 32 * half;
#pragma unroll
                  for (int c = 0; c < 4; ++c) vn[c] = *(const v4u*)(vp + 8 * c);
                }
                const int hi = r << (4 - sh), lo = max(hi - 128, -(t0 >> sh));
                f32x4 s0 = {0.f, 0.f, 0.f, 0.f}, s1 = {0.f, 0.f, 0.f, 0.f};
                s0 = MFMA16(kc[0][0], qb0, s0); s0 = MFMA16(kc[0][1], qb1, s0);
                s1 = MFMA16(kc[1][0], qb0, s1); s1 = MFMA16(kc[1][1], qb1, s1);
                bool v0[4], v1[4]; float mx = -1e30f;
#pragma unroll
                for (int k = 0; k < 4; ++k) { const int na = n0 + 4 * g + k, nb = na + 16; v0[k] = (na >= lo) && (na <= hi); v1[k] = (nb >= lo) && (nb <= hi);
                    mx = fmaxf(mx, v0[k] ? s0[k] : -1e30f); mx = fmaxf(mx, v1[k] ? s1[k] : -1e30f); }
                mx = fmaxf(mx, __shfl_xor(mx, 16)); mx = fmaxf(mx, __shfl_xor(mx, 32));
                const float mn = fmaxf(m, mx), alpha = __builtin_amdgcn_exp2f(m - mn); m = mn;
                float p0[4], p1[4], ps = 0.f;
#pragma unroll
                for (int k = 0; k < 4; ++k) { p0[k] = v0[k] ? __builtin_amdgcn_exp2f(s0[k] - mn) : 0.f; p1[k] = v1[k] ? __builtin_amdgcn_exp2f(s1[k] - mn) : 0.f; ps += p0[k] + p1[k]; }
                l = l * alpha + ps;
#pragma unroll
                for (int i = 0; i < 4; ++i) o[i] = o[i] * alpha;
                bf16x8 pb; { v4u w; w.x = pk2(p0[0], p0[1]); w.y = pk2(p0[2], p0[3]); w.z = pk2(p1[0], p1[1]); w.w = pk2(p1[2], p1[3]); pb = __builtin_bit_cast(bf16x8, w); }
                LAS unsigned char* vb = vbuf + (pp & 1) * 5120 + tr_off;
#pragma unroll
                for (int db = 0; db < 4; ++db) {
                    const v4i16 a0 = __builtin_amdgcn_ds_read_tr16_b64_v4i16((LAS v4i16*)(vb + db * 32)), a1 = __builtin_amdgcn_ds_read_tr16_b64_v4i16((LAS v4i16*)(vb + 16 * 160 + db * 32));
                    bf16x8 va; va[0] = a0[0]; va[1] = a0[1]; va[2] = a0[2]; va[3] = a0[3]; va[4] = a1[0]; va[5] = a1[1]; va[6] = a1[2]; va[7] = a1[3];
                    o[db] = MFMA16(va, pb, o[db]);
                }
                LAS unsigned char* vw = vbuf + ((pp + 1) & 1) * 5120 + kk * 160 + half * 64;
#pragma unroll
                for (int c = 0; c < 4; ++c) *(LAS v4u*)(vw + c * 16) = vn[c];
#pragma unroll
                for (int blk = 0; blk < 2; ++blk) { kc[blk][0] = kn[blk][0]; kc[blk][1] = kn[blk][1]; }
            }
            l += __shfl_xor(l, 16); l += __shfl_xor(l, 32);
            const float inv = 1.0f / l;
            bf16* yo = YA + ((size_t)b * SEQ + tq) * 512 + h * 64 + 4 * g;
#pragma unroll
            for (int db = 0; db < 4; ++db) { uint2 w; w.x = pk2(o[db][0] * inv, o[db][1] * inv); w.y = pk2(o[db][2] * inv, o[db][3] * inv); *(uint2*)(yo + 16 * db) = w; }
        }
    }
}

__device__ __forceinline__ float conv_silu(const bf16* QKM, const float* cw, int b, int t, int ch) {
    float a = 0.f;
#pragma unroll
    for (int j = 0; j < 4; ++j) { const int tt = t - 3 + j; if (tt >= 0) a += cw[j * 1024 + ch] * bf2f(QKM[((size_t)b * SEQ + tt) * 1024 + ch]); }
    return silu(a);
}

__device__ __forceinline__ float scan_add(float v, int lane) {
#pragma unroll
    for (int o = 1; o < 64; o <<= 1) { const float u = __shfl_up(v, o); if (lane >= o) v += u; }
    return v;
}
__device__ __forceinline__ float scan_max(float v, int lane) {
#pragma unroll
    for (int o = 1; o < 64; o <<= 1) { const float u = __shfl_up(v, o); if (lane >= o) v = fmaxf(v, u); }
    return v;
}
__device__ __forceinline__ float wave_max(float v) {
#pragma unroll
    for (int o = 1; o < 64; o <<= 1) v = fmaxf(v, __shfl_xor(v, o));
    return v;
}
__device__ __forceinline__ void conv16(const bf16* QKM, const float* cw, int b, int t0, int chan, float* out) {
    const bf16* src = QKM + (size_t)b * SEQ * 1024 + chan;
    const float w0 = cw[chan], w1 = cw[1024 + chan], w2 = cw[2048 + chan], w3 = cw[3072 + chan];
    float x0 = t0 >= 3 ? bf2f(src[(size_t)(t0 - 3) * 1024]) : 0.f, x1 = t0 >= 2 ? bf2f(src[(size_t)(t0 - 2) * 1024]) : 0.f, x2 = t0 >= 1 ? bf2f(src[(size_t)(t0 - 1) * 1024]) : 0.f;
#pragma unroll
    for (int i = 0; i < 16; ++i) { const float x3 = bf2f(src[(size_t)(t0 + i) * 1024]); out[i] = silu(w0 * x0 + w1 * x1 + w2 * x2 + w3 * x3); x0 = x1; x1 = x2; x2 = x3; }
}

__device__ __forceinline__ void p2_mlstm_local(const Params& P, LAS unsigned char* lds, int tid, int lane, int wave) {
    const bf16* QKM = (const bf16*)(P.ws + WS_QKM); const bf16* VM = (const bf16*)(P.ws + WS_VM); const float* IFb = (const float*)(P.ws + WS_IF);
    const float* cw = P.in[4];
    bf16* DC = (bf16*)((unsigned char*)P.out + OUT_DC); float* DN = (float*)(P.ws + WS_DN); float* SC = (float*)(P.ws + WS_SC);
    LAS bf16* KWT = (LAS bf16*)lds; LAS bf16* VT = (LAS bf16*)(lds + 18432); LAS float* sw = (LAS float*)(lds + 36864);
    const int r = lane & 15, g = lane >> 4;
    for (int item = blockIdx.x; item < 2048; item += gridDim.x) {
        const int bh = item >> 8, c = item & 255, b = bh >> 2, h = bh & 3;
        if (wave == 0) {
            const size_t row = (size_t)b * SEQ + c * 64 + lane;
            const float lf = logsigmoid(IFb[row * 8 + 4 + h]), ip = IFb[row * 8 + h];
            const float bc = scan_add(lf, lane), gg = __shfl(bc, 63), ds = gg - bc + ip, ml = wave_max(ds);
            sw[lane] = __expf(ds - ml);
            if (lane == 0) { SC[item] = ml; SC[2048 + item] = gg; }
        }
        __syncthreads();
        { const int ch = tid & 127, sq = tid >> 7, s0 = sq * 16; float o[16];
          conv16(QKM, cw, b, c * 64 + s0, 512 + h * 128 + ch, o);
#pragma unroll
          for (int i = 0; i < 16; i += 2) *(LAS unsigned*)(KWT + ch * 72 + s0 + i) = pk2(o[i] * 0.08838834764831845f * sw[s0 + i], o[i + 1] * 0.08838834764831845f * sw[s0 + i + 1]);
          const bf16* vsrc = VM + ((size_t)b * SEQ + c * 64 + s0) * 512 + h * 128 + ch;
#pragma unroll
          for (int i = 0; i < 16; i += 2) *(LAS unsigned*)(VT + ch * 72 + s0 + i) = (unsigned)vsrc[(size_t)i * 512] | ((unsigned)vsrc[(size_t)(i + 1) * 512] << 16);
        }
        __syncthreads();
        {
          const bf16x8 vb0 = *(const LAS bf16x8*)(VT + (16 * wave + r) * 72 + 8 * g), vb1 = *(const LAS bf16x8*)(VT + (16 * wave + r) * 72 + 32 + 8 * g);
          bf16* dst = DC + (size_t)item * 16384 + (size_t)(16 * wave + r) * 128 + 4 * g;
#pragma unroll
          for (int eb = 0; eb < 8; ++eb) {
              const bf16x8 ka0 = *(const LAS bf16x8*)(KWT + (16 * eb + r) * 72 + 8 * g), ka1 = *(const LAS bf16x8*)(KWT + (16 * eb + r) * 72 + 32 + 8 * g);
              f32x4 acc = {0.f, 0.f, 0.f, 0.f};
              acc = MFMA16(ka0, vb0, acc); acc = MFMA16(ka1, vb1, acc);
              uint2 o; o.x = pk2(acc[0], acc[1]); o.y = pk2(acc[2], acc[3]); *(uint2*)(dst + 16 * eb) = o;
          }
        }
        if (tid < 128) { float a = 0.f;
#pragma unroll
            for (int cc = 0; cc < 8; ++cc) { float f[8]; unpk8(*(const LAS v4u*)(KWT + tid * 72 + 8 * cc), f);
#pragma unroll
                for (int k = 0; k < 8; ++k) a += f[k]; }
            DN[(size_t)item * 128 + tid] = a; }
        __syncthreads();
    }
}

__device__ __forceinline__ void p3_mlstm_scan(const Params& P, int tid) {
    const unsigned* __restrict__ DC = (const unsigned*)((unsigned char*)P.out + OUT_DC); unsigned* __restrict__ CS = (unsigned*)((unsigned char*)P.out + OUT_CS);
    const float* __restrict__ DN = (const float*)(P.ws + WS_DN); float* __restrict__ NS = (float*)(P.ws + WS_NS); float* SC = (float*)(P.ws + WS_SC);
    for (int gid = blockIdx.x * 512 + tid; gid < 8 * 8192; gid += gridDim.x * 512) {
        const int bh = gid >> 13, idx = gid & 8191;
        float C0 = 0.f, C1 = 0.f, m = 0.f;
        for (int j0 = 0; j0 < 256; j0 += 8) {
            unsigned d[8]; float ml[8], gg[8];
#pragma unroll
            for (int u = 0; u < 8; ++u) { const int item = bh * 256 + j0 + u; d[u] = DC[(size_t)item * 8192 + idx]; ml[u] = SC[item]; gg[u] = SC[2048 + item]; }
#pragma unroll
            for (int u = 0; u < 8; ++u) { const int item = bh * 256 + j0 + u;
                CS[(size_t)item * 8192 + idx] = pk2(C0, C1);
                if (idx == 0) SC[4096 + item] = m;
                const float mn = fmaxf(gg[u] + m, ml[u]), a = __expf(gg[u] + m - mn), bb = __expf(ml[u] - mn);
                C0 = a * C0 + bb * bf_lo(d[u]); C1 = a * C1 + bb * bf_hi(d[u]); m = mn; }
        }
    }
    for (int gid = blockIdx.x * 512 + tid; gid < 8 * 128; gid += gridDim.x * 512) {
        const int bh = gid >> 7, idx = gid & 127; float n = 0.f, m = 0.f;
        for (int j = 0; j < 256; ++j) { const int item = bh * 256 + j; NS[(size_t)item * 128 + idx] = n;
            const float ml = SC[item], gg = SC[2048 + item], mn = fmaxf(gg + m, ml), a = __expf(gg + m - mn), bb = __expf(ml - mn);
            n = a * n + bb * DN[(size_t)item * 128 + idx]; m = mn; }
    }
}

__device__ __forceinline__ void p4_mlstm_out(const Params& P, LAS unsigned char* lds, int tid, int lane, int wave) {
    const bf16* QKM = (const bf16*)(P.ws + WS_QKM); const bf16* VM = (const bf16*)(P.ws + WS_VM); const bf16* OM = (const bf16*)(P.ws + WS_OM); const float* IFb = (const float*)(P.ws + WS_IF);
    const float* cw = P.in[4]; const float* mnorm = P.in[6];
    const bf16* CS = (const bf16*)((unsigned char*)P.out + OUT_CS); const float* NS = (const float*)(P.ws + WS_NS); const float* SC = (const float*)(P.ws + WS_SC);
    bf16* YM = (bf16*)(P.ws + WS_YM);
    LAS bf16* Qs = (LAS bf16*)lds; LAS bf16* Ks = (LAS bf16*)(lds + 17408); LAS bf16* VT = (LAS bf16*)(lds + 34816); LAS bf16* PT = (LAS bf16*)(lds + 53248);
    LAS float* sm = (LAS float*)(lds + 62464);
    const int r = lane & 15, g = lane >> 4;
    for (int item = blockIdx.x; item < 2048; item += gridDim.x) {
        const int bh = item >> 8, c = item & 255, b = bh >> 2, h = bh & 3;
        if (wave == 0) {
            const size_t row = (size_t)b * SEQ + c * 64 + lane;
            const float lf = logsigmoid(IFb[row * 8 + 4 + h]), ip = IFb[row * 8 + h];
            const float bc = scan_add(lf, lane), a = ip - bc, pm = scan_max(a, lane), ms = SC[4096 + item], M = fmaxf(ms, pm);
            sm[lane] = a; sm[64 + lane] = M; sm[128 + lane] = __expf(ms - M); sm[192 + lane] = __expf(-bc - M);
        } else if (wave < 3) sm[320 + tid - 64] = NS[(size_t)item * 128 + tid - 64];
        { const int ch = tid & 127, sq = tid >> 7, s0 = sq * 16; float o[16];
          conv16(QKM, cw, b, c * 64 + s0, h * 128 + ch, o);
#pragma unroll
          for (int i = 0; i < 16; ++i) Qs[(s0 + i) * 136 + ch] = (bf16)f2bf(o[i]);
          conv16(QKM, cw, b, c * 64 + s0, 512 + h * 128 + ch, o);
#pragma unroll
          for (int i = 0; i < 16; ++i) Ks[(s0 + i) * 136 + ch] = (bf16)f2bf(o[i] * 0.08838834764831845f);
          const bf16* vsrc = VM + ((size_t)b * SEQ + c * 64 + s0) * 512 + h * 128 + ch;
#pragma unroll
          for (int i = 0; i < 16; i += 2) *(LAS unsigned*)(VT + ch * 72 + s0 + i) = (unsigned)vsrc[(size_t)i * 512] | ((unsigned)vsrc[(size_t)(i + 1) * 512] << 16);
        }
        __syncthreads();
        {
          const int sb = wave >> 1;
          bf16x8 ka[4];
#pragma unroll
          for (int ks = 0; ks < 4; ++ks) ka[ks] = *(const LAS bf16x8*)(Ks + (16 * sb + r) * 136 + 32 * ks + 8 * g);
#pragma unroll
          for (int tt = 0; tt < 2; ++tt) { const int tb = 2 * (wave & 1) + tt, t = 16 * tb + r;
              f32x4 acc = {0.f, 0.f, 0.f, 0.f};
#pragma unroll
              for (int ks = 0; ks < 4; ++ks) { const bf16x8 qb = *(const LAS bf16x8*)(Qs + t * 136 + 32 * ks + 8 * g); acc = MFMA16(ka[ks], qb, acc); }
              const float Mt = sm[64 + t]; float p[4];
#pragma unroll
              for (int k = 0; k < 4; ++k) { const int s = 16 * sb + 4 * g + k; p[k] = (s <= t) ? acc[k] * __expf(sm[s] - Mt) : 0.f; }
              v2u o; o.x = pk2(p[0], p[1]); o.y = pk2(p[2], p[3]); *(LAS v2u*)(PT + t * 72 + 16 * sb + 4 * g) = o; }
        }
        __syncthreads();
        if (tid < 64) { const int t = tid; float sp = 0.f, qn = 0.f;
#pragma unroll
            for (int cc = 0; cc < 8; ++cc) { float f[8]; unpk8(*(const LAS v4u*)(PT + t * 72 + 8 * cc), f);
#pragma unroll
                for (int k = 0; k < 8; ++k) sp += f[k]; }
#pragma unroll
            for (int cc = 0; cc < 16; ++cc) { float f[8]; unpk8(*(const LAS v4u*)(Qs + t * 136 + 8 * cc), f);
#pragma unroll
                for (int k = 0; k < 8; ++k) qn += f[k] * sm[320 + 8 * cc + k]; }
            sm[256 + t] = fmaxf(fabsf(sm[128 + t] * qn + sp), sm[192 + t]); }
        f32x4 ai[4], ac[4];
#pragma unroll
        for (int tb = 0; tb < 4; ++tb) { ai[tb] = (f32x4){0.f, 0.f, 0.f, 0.f}; ac[tb] = (f32x4){0.f, 0.f, 0.f, 0.f}; }
        {
          const bf16x8 va0 = *(const LAS bf16x8*)(VT + (16 * wave + r) * 72 + 8 * g), va1 = *(const LAS bf16x8*)(VT + (16 * wave + r) * 72 + 32 + 8 * g);
          bf16x8 ca[4];
          const bf16* crow = CS + (size_t)item * 16384 + (size_t)(16 * wave + r) * 128 + 8 * g;
#pragma unroll
          for (int ks = 0; ks < 4; ++ks) ca[ks] = *(const bf16x8*)(crow + 32 * ks);
#pragma unroll
          for (int tb = 0; tb < 4; ++tb) { const int t = 16 * tb + r;
              const bf16x8 pb0 = *(const LAS bf16x8*)(PT + t * 72 + 8 * g), pb1 = *(const LAS bf16x8*)(PT + t * 72 + 32 + 8 * g);
              ai[tb] = MFMA16(va0, pb0, ai[tb]); ai[tb] = MFMA16(va1, pb1, ai[tb]);
#pragma unroll
              for (int ks = 0; ks < 4; ++ks) { const bf16x8 qb = *(const LAS bf16x8*)(Qs + t * 136 + 32 * ks + 8 * g); ac[tb] = MFMA16(ca[ks], qb, ac[tb]); } }
        }
        __syncthreads();
        float ssq[4];
#pragma unroll
        for (int tb = 0; tb < 4; ++tb) { const int t = 16 * tb + r; const float wi = sm[128 + t], inv = 1.0f / sm[256 + t]; float s2 = 0.f;
#pragma unroll
            for (int k = 0; k < 4; ++k) { ai[tb][k] = (wi * ac[tb][k] + ai[tb][k]) * inv; s2 += ai[tb][k] * ai[tb][k]; }
            s2 += __shfl_xor(s2, 16); s2 += __shfl_xor(s2, 32); ssq[tb] = s2;
            if (g == 0) sm[448 + wave * 64 + t] = s2; }
        __syncthreads();
#pragma unroll
        for (int tb = 0; tb < 4; ++tb) { const int t = 16 * tb + r; float tot = 0.f;
#pragma unroll
            for (int w = 0; w < 8; ++w) tot += sm[448 + w * 64 + t];
            const float rs = rsqrtf(tot * (1.f / 128.f) + EPS);
            const size_t row = (size_t)b * SEQ + c * 64 + t; const int col = h * 128 + 16 * wave + 4 * g;
            const uint2 omw = *(const uint2*)(OM + row * 512 + col); const f32x4 gn = *(const f32x4*)(mnorm + col);
            uint2 o; o.x = pk2(ai[tb][0] * rs * gn[0] * bf_lo(omw.x), ai[tb][1] * rs * gn[1] * bf_hi(omw.x)); o.y = pk2(ai[tb][2] * rs * gn[2] * bf_lo(omw.y), ai[tb][3] * rs * gn[3] * bf_hi(omw.y));
            *(uint2*)(YM + row * 512 + col) = o; }
        __syncthreads();
    }
}

#define BUBBLE16(V, I, xv, xi) do { float _x = (xv); int _i = (xi); _Pragma("unroll") for (int _j = 0; _j < 16; ++_j) { const bool _gt = _x > V[_j]; const float _tv = V[_j]; const int _ti = I[_j]; V[_j] = _gt ? _x : _tv; I[_j] = _gt ? _i : _ti; _x = _gt ? _tv : _x; _i = _gt ? _ti : _i; } } while (0)
__device__ __forceinline__ void p10_topk(const Params& P, LAS unsigned char* lds, int tid) {
    const bf16* Q2 = (const bf16*)(P.ws + WS_Q2); const bf16* K1B = (const bf16*)(P.ws + WS_K1B); const bf16* K2B = (const bf16*)(P.ws + WS_K2B);
    int* IDX = (int*)(P.ws + WS_IDX); float* GATE = (float*)(P.ws + WS_GATE);
    LAS bf16* Kl = (LAS bf16*)lds;
    for (int item = blockIdx.x; item < 8 * 64; item += gridDim.x) {
        const int h = item >> 6, grp = item & 63; const size_t row = (size_t)grp * 512 + tid;
        __syncthreads();
        for (int i = tid; i < 2048; i += 512) { ((LAS v4u*)Kl)[i] = ((const v4u*)(K1B + (size_t)h * 16384))[i]; ((LAS v4u*)Kl)[2048 + i] = ((const v4u*)(K2B + (size_t)h * 16384))[i]; }
        __syncthreads();
        float tv[2][16]; int ti[2][16];
#pragma unroll
        for (int half = 0; half < 2; ++half) {
            v4u qw[16];
#pragma unroll
            for (int c = 0; c < 16; ++c) qw[c] = *(const v4u*)(Q2 + row * 2048 + h * 256 + half * 128 + c * 8);
#pragma unroll
            for (int j = 0; j < 16; ++j) { tv[half][j] = -1e30f; ti[half][j] = 0; }
            for (int n = 0; n < 128; ++n) {
                float s = 0.f;
#pragma unroll
                for (int c = 0; c < 16; ++c) { const v4u kw = *(const LAS v4u*)(Kl + half * 16384 + n * 128 + c * 8);
                    s = dot2bf(qw[c].x, kw.x, s); s = dot2bf(qw[c].y, kw.y, s); s = dot2bf(qw[c].z, kw.z, s); s = dot2bf(qw[c].w, kw.w, s); }
                BUBBLE16(tv[half], ti[half], s, n);
            }
        }
        LAS float* Lv = (LAS float*)(lds + 65536); LAS int* Li = (LAS int*)(lds + 65536 + 32768);
#pragma unroll
        for (int j = 0; j < 16; ++j) { Lv[j * 512 + tid] = tv[1][j]; Li[j * 512 + tid] = ti[1][j]; }
        float cv[16]; int ci[16];
#pragma unroll
        for (int j = 0; j < 16; ++j) { cv[j] = -1e30f; ci[j] = 0; }
#pragma unroll
        for (int a = 0; a < 16; ++a) {
            const int nb = 16 / (a + 1);
            for (int bq = 0; bq < nb; ++bq) { const float xv = tv[0][a] + Lv[bq * 512 + tid]; const int xi = ti[0][a] * 128 + Li[bq * 512 + tid]; BUBBLE16(cv, ci, xv, xi); }
        }
        float e[16], sum = 0.f;
#pragma unroll
        for (int j = 0; j < 16; ++j) { e[j] = __expf(cv[j] - cv[0]); sum += e[j]; }
        const float inv = 1.0f / sum;
#pragma unroll
        for (int j = 0; j < 16; ++j) e[j] *= inv;
#pragma unroll
        for (int j = 0; j < 16; j += 4) { *(int4*)(IDX + row * 128 + h * 16 + j) = make_int4(ci[j], ci[j + 1], ci[j + 2], ci[j + 3]); *(float4*)(GATE + row * 128 + h * 16 + j) = make_float4(e[j], e[j + 1], e[j + 2], e[j + 3]); }
    }
}

__device__ __forceinline__ void p11_peer(const Params& P, int lane, int wave) {
    const bf16* HN = (const bf16*)(P.ws + WS_HN); const bf16* UB = (const bf16*)(P.ws + WS_UB); const bf16* VB = (const bf16*)(P.ws + WS_VB);
    const int* IDX = (const int*)(P.ws + WS_IDX); const float* GATE = (const float*)(P.ws + WS_GATE);
    bf16* HN2 = (bf16*)(P.ws + WS_HN2); float* X = P.out; const float* gple = P.in[16];
    const int gw = blockIdx.x * NW + wave, NGW = gridDim.x * NW;
    for (int m = gw; m < NTOK; m += NGW) {
        float hv[16], o[16];
        unpk8(((const v4u*)(HN + (size_t)m * 1024))[lane], hv); unpk8(((const v4u*)(HN + (size_t)m * 1024))[64 + lane], hv + 8);
#pragma unroll
        for (int i = 0; i < 16; ++i) o[i] = 0.f;
        const int id0 = IDX[(size_t)m * 128 + lane], id1 = IDX[(size_t)m * 128 + 64 + lane];
        const float g0 = GATE[(size_t)m * 128 + lane], g1 = GATE[(size_t)m * 128 + 64 + lane];
#pragma unroll 4
        for (int j = 0; j < 128; ++j) {
            const int e = __shfl(j < 64 ? id0 : id1, j & 63); const float gt = __shfl(j < 64 ? g0 : g1, j & 63);
            const v4u* up = (const v4u*)(UB + (size_t)e * 1024); const v4u* vp = (const v4u*)(VB + (size_t)e * 1024);
            const v4u ua = up[lane], ub = up[64 + lane], va = vp[lane], vb = vp[64 + lane];
            float uf[16]; unpk8(ua, uf); unpk8(ub, uf + 8);
            float d = 0.f;
#pragma unroll
            for (int i = 0; i < 16; ++i) d += hv[i] * uf[i];
            d = wave_sum(d);
            const float w = gt * 0.5f * d * (1.0f + erff(d * 0.70710678118654752f));
            float vf[16]; unpk8(va, vf); unpk8(vb, vf + 8);
#pragma unroll
            for (int i = 0; i < 16; ++i) o[i] += w * vf[i];
        }
        float* xr = X + (size_t)m * 1024; float ss = 0.f;
        f32x4 x0 = ((f32x4*)xr)[2 * lane], x1 = ((f32x4*)xr)[2 * lane + 1], x2 = ((f32x4*)xr)[128 + 2 * lane], x3 = ((f32x4*)xr)[128 + 2 * lane + 1];
#pragma unroll
        for (int i = 0; i < 4; ++i) { x0[i] += o[i]; x1[i] += o[4 + i]; x2[i] += o[8 + i]; x3[i] += o[12 + i]; ss += x0[i] * x0[i] + x1[i] * x1[i] + x2[i] * x2[i] + x3[i] * x3[i]; }
        ((f32x4*)xr)[2 * lane] = x0; ((f32x4*)xr)[2 * lane + 1] = x1; ((f32x4*)xr)[128 + 2 * lane] = x2; ((f32x4*)xr)[128 + 2 * lane + 1] = x3;
        const float rstd = rsqrtf(wave_sum(ss) * (1.f / 1024.f) + EPS);
        const f32x4 ga = ((const f32x4*)gple)[2 * lane], gb = ((const f32x4*)gple)[2 * lane + 1], gc = ((const f32x4*)gple)[128 + 2 * lane], gd = ((const f32x4*)gple)[128 + 2 * lane + 1];
        v4u w0, w1;
        w0.x = pk2(x0[0] * rstd * ga[0], x0[1] * rstd * ga[1]); w0.y = pk2(x0[2] * rstd * ga[2], x0[3] * rstd * ga[3]); w0.z = pk2(x1[0] * rstd * gb[0], x1[1] * rstd * gb[1]); w0.w = pk2(x1[2] * rstd * gb[2], x1[3] * rstd * gb[3]);
        w1.x = pk2(x2[0] * rstd * gc[0], x2[1] * rstd * gc[1]); w1.y = pk2(x2[2] * rstd * gc[2], x2[3] * rstd * gc[3]); w1.z = pk2(x3[0] * rstd * gd[0], x3[1] * rstd * gd[1]); w1.w = pk2(x3[2] * rstd * gd[2], x3[3] * rstd * gd[3]);
        ((v4u*)(HN2 + (size_t)m * 1024))[lane] = w0; ((v4u*)(HN2 + (size_t)m * 1024))[64 + lane] = w1;
    }
}

__global__ void __launch_bounds__(512, 2) mk_fwd(Params P) {
    extern __shared__ __attribute__((aligned(16))) unsigned char lds_raw[];
    cg::grid_group grid = cg::this_grid();
    LAS unsigned char* lds = (LAS unsigned char*)lds_raw;
    const int tid = threadIdx.x, lane = tid & 63, wave = __builtin_amdgcn_readfirstlane(tid >> 6);
    const int lo = P.ph_lo, hi = P.ph_hi, G = gridDim.x, bx = blockIdx.x;
    unsigned char* ws = P.ws;
    const int gw = bx * NW + wave, NGW = G * NW;
#ifndef PH_MASK
#define PH_MASK 0xffff
#endif
#define IN(k) (((PH_MASK >> (k)) & 1) && lo <= (k) && (k) < hi)
#define SYNC_AFTER(k) do { if (IN(k) && IN((k) + 1)) grid.sync(); } while (0)
    typedef pg8::bf16_t pb;
    if (IN(0)) p0_prologue(P, lds, tid, lane, wave);
    SYNC_AFTER(0);
    if (IN(1)) {
        pg8::Gemm g{(const pb*)(ws + WS_XN), (const pb*)(ws + WS_W1T), NTOK, 5632, 1024}; pg8::StaticOrder S; S.init(NTOK, 5632, G, bx);
        pg8::EpiProj E{(pb*)(ws + WS_QKVA), (pb*)(ws + WS_QKM), (pb*)(ws + WS_VM), (pb*)(ws + WS_OM), (pb*)(ws + WS_G), C2};
        pg8::gemm_phase<pg8::EpiProj, pg8::StaticOrder, true, true>(lds, g, S, E);
    }
    SYNC_AFTER(1);
    if (IN(2)) { p2_attention(P, lds, lane, wave); __syncthreads(); p2_mlstm_local(P, lds, tid, lane, wave); }
    SYNC_AFTER(2);
    if (IN(3)) p3_mlstm_scan(P, tid);
    SYNC_AFTER(3);
    if (IN(4)) p4_mlstm_out(P, lds, tid, lane, wave);
    SYNC_AFTER(4);
    if (IN(5)) {
        pg8::Gemm g{(const pb*)(ws + WS_YA), (const pb*)(ws + WS_WAT), NTOK, 1024, 512}; pg8::StaticOrder S; S.init(NTOK, 1024, G, bx);
        pg8::EpiGated<false> E{(pb*)(ws + WS_TMP), nullptr, (const pb*)(ws + WS_G), 0};
        pg8::gemm_phase<pg8::EpiGated<false>, pg8::StaticOrder, true, true>(lds, g, S, E);
    }
    if (IN(5) && IN(6)) { asm volatile("s_waitcnt vmcnt(0)" ::: "memory"); __syncthreads(); }
    if (IN(6)) {
        pg8::Gemm g{(const pb*)(ws + WS_YM), (const pb*)(ws + WS_WMT), NTOK, 1024, 512}; pg8::StaticOrder S; S.init(NTOK, 1024, G, bx);
        pg8::EpiGated<true> E{(pb*)(ws + WS_MERGED), (const pb*)(ws + WS_TMP), (const pb*)(ws + WS_G), 1024};
        pg8::gemm_phase<pg8::EpiGated<true>, pg8::StaticOrder, true, true>(lds, g, S, E);
    }
    SYNC_AFTER(6);
    if (IN(7)) {
        pg8::Gemm g{(const pb*)(ws + WS_MERGED), (const pb*)(ws + WS_WOT), NTOK, 1024, 1024}; pg8::StaticOrder S; S.init(NTOK, 1024, G, bx);
        pg8::EpiResidual E{P.in[0], P.out};
        pg8::gemm_phase<pg8::EpiResidual, pg8::StaticOrder, true, true>(lds, g, S, E);
    }
    SYNC_AFTER(7);
    if (IN(8)) {
        for (int m = gw; m < NTOK; m += NGW) rms_row_to_bf16(P.out + (size_t)m * 1024, P.in[10], (bf16*)(ws + WS_HN) + (size_t)m * 1024, lane);
        cvt_f32_bf16(P.in[1], (bf16*)(ws + WS_PB), (size_t)NTOK * 256 / 4, (size_t)bx * 512 + tid, (size_t)G * 512);
    }
    SYNC_AFTER(8);
    if (IN(9)) {
        pg8::Gemm g{(const pb*)(ws + WS_HN), (const pb*)(ws + WS_WQT), NTOK, 2048, 1024}; pg8::StaticOrder S; S.init(NTOK, 2048, G, bx);
        pg8::EpiStore E{(pb*)(ws + WS_Q2), 2048};
        pg8::gemm_phase<pg8::EpiStore, pg8::StaticOrder, true, true>(lds, g, S, E);
    }
    SYNC_AFTER(9);
    if (IN(10)) p10_topk(P, lds, tid);
    SYNC_AFTER(10);
    if (IN(11)) p11_peer(P, lane, wave);
    SYNC_AFTER(11);
    if (IN(12)) {
        pg8::Gemm g{(const pb*)(ws + WS_PB), (const pb*)(ws + WS_WPT), NTOK, 1024, 256}; pg8::StaticOrder S; S.init(NTOK, 1024, G, bx);
        pg8::EpiStore E{(pb*)(ws + WS_E), 1024};
        pg8::gemm_phase<pg8::EpiStore, pg8::StaticOrder, true, true>(lds, g, S, E);
    }
    if (IN(12) && IN(13)) { asm volatile("s_waitcnt vmcnt(0)" ::: "memory"); __syncthreads(); }
    if (IN(13)) {
        pg8::Gemm g{(const pb*)(ws + WS_HN2), (const pb*)(ws + WS_WGT), NTOK, 1024, 1024}; pg8::StaticOrder S; S.init(NTOK, 1024, G, bx);
        pg8::EpiPle E{P.out, (const pb*)(ws + WS_E)};
        pg8::gemm_phase<pg8::EpiPle, pg8::StaticOrder, true, true>(lds, g, S, E);
    }
    SYNC_AFTER(13);
    if (IN(14)) {
        const float* gf = P.in[19];
        for (int m = gw; m < NTOK; m += NGW) {
            float* xr = P.out + (size_t)m * 1024; f32x4 v[4]; float s = 0.f;
#pragma unroll
            for (int j = 0; j < 4; ++j) { v[j] = ((const f32x4*)xr)[lane + 64 * j]; s += (v[j][0] * v[j][0] + v[j][1] * v[j][1]) + (v[j][2] * v[j][2] + v[j][3] * v[j][3]); }
            const float rstd = rsqrtf(wave_sum(s) * (1.f / 1024.f) + EPS);
#pragma unroll
            for (int j = 0; j < 4; ++j) { const f32x4 g = ((const f32x4*)gf)[lane + 64 * j]; ((f32x4*)xr)[lane + 64 * j] = v[j] * rstd * g; }
        }
    }
}

extern "C" void kernel_launch(void* const* d_in, const int* in_sizes, int n_in, void* d_out, int out_size, void* d_ws, size_t ws_size, hipStream_t stream) {
    static int grid_blocks = 0;
    if (!grid_blocks) {
        int dev = 0, cus = 0, per_cu = 0;
        (void)hipGetDevice(&dev);
        (void)hipDeviceGetAttribute(&cus, hipDeviceAttributeMultiprocessorCount, dev);
        (void)hipFuncSetAttribute((const void*)mk_fwd, hipFuncAttributeMaxDynamicSharedMemorySize, LDS_BYTES);
        (void)hipOccupancyMaxActiveBlocksPerMultiprocessor(&per_cu, mk_fwd, 512, LDS_BYTES);
        if (per_cu > 1) per_cu = 1;
        grid_blocks = cus * per_cu;
    }
    if (n_in < 20 || ws_size < WS_NEED || grid_blocks <= 0) { fprintf(stderr, "kernel_launch: bad setup (n_in %d ws %zu grid %d)\n", n_in, ws_size, grid_blocks); return; }
    Params p{};
    for (int i = 0; i < 20; ++i) p.in[i] = (const float*)d_in[i];
    p.out = (float*)d_out; p.ws = (unsigned char*)d_ws; p.ph_lo = 0; p.ph_hi = 15;
    void* args[] = {&p};
    hipError_t e = hipLaunchCooperativeKernel((void*)mk_fwd, dim3(grid_blocks), dim3(512), args, LDS_BYTES, stream);
    if (e != hipSuccess) fprintf(stderr, "cooperative launch failed: %s (grid %d)\n", hipGetErrorString(e), grid_blocks);
}
```

```cpp
#include <hip/hip_runtime.h>
#include <hip/hip_cooperative_groups.h>
#include <cstdio>
#include <cstdint>
namespace cg = cooperative_groups;
namespace pg8 {
#define PG8_LAS __attribute__((address_space(3)))
typedef unsigned short bf16_t;
typedef short bf16x8 __attribute__((ext_vector_type(8)));
typedef float f32x4 __attribute__((ext_vector_type(4)));
typedef unsigned u32x4 __attribute__((ext_vector_type(4)));
constexpr int BM = 256, BK = 64, HALF = 128, HTB = HALF * BK * 2  , STAGE_BYTES = 8 * HTB, NXCD = 8, WGM = 8;

__host__ __device__ __forceinline__ int lds_byte(int r, int c) { const int st = (r >> 4) * 2 + (c >> 5), rr = r & 15, cc = c & 31, ob = rr * 64 + cc * 2; return st * 1024 + (ob ^ (((ob >> 9) & 1) << 5)); }
__host__ __device__ __forceinline__ void stage_rc(int b, int& R, int& C) { const int st = b / 1024, sb = b % 1024, swz = sb ^ (((sb >> 9) & 1) << 5); R = (st >> 1) * 16 + swz / 64; C = (st & 1) * 32 + (swz % 64) / 2; }
__host__ __device__ __forceinline__ int perm32(int rho) { const int n = rho >> 4, i = rho & 15; return 8 * (i >> 2) + 4 * n + (i & 3); }

struct Unit { int pm, pn; };
struct Gemm { const bf16_t* A; const bf16_t* Bt; int M, N, K; };

struct StaticOrder {
    int nM, nN, nwg, G, c;
    __host__ __device__ void init(int M, int N, int G_, int c_) { nM = M / BM; nN = N / BM; nwg = nM * nN; G = G_; c = c_; }
    __host__ __device__ bool next(int i, Unit& u) const {
        const long L = (long)i * G + c; if (L >= nwg) return false;
        int wgid = (int)L; { const int q = nwg / NXCD, r = nwg % NXCD, xcd = wgid % NXCD, off = wgid / NXCD; wgid = (xcd < r ? xcd * (q + 1) : r * (q + 1) + (xcd - r) * q) + off; }
        const int nig = WGM * nN, gid = wgid / nig, fm = gid * WGM, gsz = (nM - fm) < WGM ? (nM - fm) : WGM;
        u.pm = fm + ((wgid % nig) % gsz); u.pn = (wgid % nig) / gsz; return true;
    }
    __device__ __forceinline__ void a_ready(const Unit&) const {}
    __device__ __forceinline__ void done(const Unit&) const {}
};

__device__ __forceinline__ unsigned cvt_pk_bf16(float lo, float hi) { unsigned r; asm volatile("v_cvt_pk_bf16_f32 %0, %1, %2" : "=v"(r) : "v"(lo), "v"(hi)); return r; }
typedef float f32x2 __attribute__((ext_vector_type(2)));

__device__ __forceinline__ float sigm(float x) { return 1.0f / (1.0f + __expf(-x)); }
__device__ __forceinline__ float bf_lo(unsigned w) { return __uint_as_float(w << 16); }
__device__ __forceinline__ float bf_hi(unsigned w) { return __uint_as_float(w & 0xffff0000u); }
__device__ __forceinline__ u32x4 pack8(const f32x4& v0, const f32x4& v1) { u32x4 w; w.x = cvt_pk_bf16(v0[0], v0[1]); w.y = cvt_pk_bf16(v0[2], v0[3]); w.z = cvt_pk_bf16(v1[0], v1[1]); w.w = cvt_pk_bf16(v1[2], v1[3]); return w; }
__device__ __forceinline__ void unpack8(const u32x4& w, f32x4& v0, f32x4& v1) { v0[0] = bf_lo(w.x); v0[1] = bf_hi(w.x); v0[2] = bf_lo(w.y); v0[3] = bf_hi(w.y); v1[0] = bf_lo(w.z); v1[1] = bf_hi(w.z); v1[2] = bf_lo(w.w); v1[3] = bf_hi(w.w); }

#define PG8_EPI_WALK(...) \
    _Pragma("unroll") for (int ai = 0; ai < 2; ++ai) _Pragma("unroll") for (int m = 0; m < 4; ++m) { const int row = u.pm * BM + wr * 64 + fr + ai * HALF + m * 16; \
        _Pragma("unroll") for (int bj = 0; bj < 2; ++bj) { const int ct = bj * HALF + wc * 32 + 8 * fq; f32x4 v0 = acc[ai][bj][m][0], v1 = acc[ai][bj][m][1]; __VA_ARGS__ } }

struct EpiProj {
    static constexpr bool PERM = true, AFTER_DRAIN = false;
    bf16_t *qkva, *qkm, *vm, *om, *g; float c2;
    __device__ __forceinline__ void operator()(const f32x4 (&acc)[2][2][4][2], const Unit& u, int wr, int wc, int fr, int fq) const {
        const int pn = u.pn; bf16_t* base; int ldc, colt, mode = 0; float sc = 1.f;
        if (pn < 6) { base = qkva; ldc = 1536; colt = pn * 256; if (pn < 2) sc = c2; }
        else if (pn < 10) { base = qkm; ldc = 1024; colt = (pn - 6) * 256; }
        else if (pn < 12) { base = vm; ldc = 512; colt = (pn - 10) * 256; }
        else if (pn < 14) { base = om; ldc = 512; colt = (pn - 12) * 256; mode = 1; }
        else { base = g; ldc = 2048; colt = (pn - 14) * 256; mode = 1; }
        PG8_EPI_WALK({
            if (mode == 1) { _Pragma("unroll") for (int i = 0; i < 4; ++i) { v0[i] = sigm(v0[i]); v1[i] = sigm(v1[i]); } }
            else { v0 = v0 * sc; v1 = v1 * sc; }
            *(u32x4*)(base + (size_t)row * ldc + colt + ct) = pack8(v0, v1);
        })
    }
};
struct EpiStore {
    static constexpr bool PERM = true, AFTER_DRAIN = false;
    bf16_t* O; int ldc;
    __device__ __forceinline__ void operator()(const f32x4 (&acc)[2][2][4][2], const Unit& u, int wr, int wc, int fr, int fq) const {
        PG8_EPI_WALK({ *(u32x4*)(O + (size_t)row * ldc + u.pn * BM + ct) = pack8(v0, v1); })
    }
};
template <bool ADD> struct EpiGated {
    static constexpr bool PERM = true, AFTER_DRAIN = false;
    bf16_t* O; const bf16_t* prev; const bf16_t* gate; int gcol0;
    __device__ __forceinline__ void operator()(const f32x4 (&acc)[2][2][4][2], const Unit& u, int wr, int wc, int fr, int fq) const {
        PG8_EPI_WALK({
            const int col = u.pn * BM + ct; f32x4 g0, g1; unpack8(*(const u32x4*)(gate + (size_t)row * 2048 + gcol0 + col), g0, g1);
            v0 = v0 * g0; v1 = v1 * g1;
            if (ADD) { f32x4 p0, p1; unpack8(*(const u32x4*)(prev + (size_t)row * 1024 + col), p0, p1); v0 = v0 + p0; v1 = v1 + p1; }
            *(u32x4*)(O + (size_t)row * 1024 + col) = pack8(v0, v1);
        })
    }
};
struct EpiResidual {
    static constexpr bool PERM = true, AFTER_DRAIN = false;
    const float* res; float* out;
    __device__ __forceinline__ void operator()(const f32x4 (&acc)[2][2][4][2], const Unit& u, int wr, int wc, int fr, int fq) const {
        PG8_EPI_WALK({
            const size_t o = (size_t)row * 1024 + u.pn * BM + ct; const f32x4 r0 = *(const f32x4*)(res + o), r1 = *(const f32x4*)(res + o + 4);
            *(f32x4*)(out + o) = r0 + v0; *(f32x4*)(out + o + 4) = r1 + v1;
        })
    }
};
struct EpiPle {
    static constexpr bool PERM = true, AFTER_DRAIN = false;
    float* xio; const bf16_t* e; const float* ssq;
    __device__ __forceinline__ void operator()(const f32x4 (&acc)[2][2][4][2], const Unit& u, int wr, int wc, int fr, int fq) const {
        PG8_EPI_WALK({
            const float rstd = rsqrtf(ssq[row] * (1.0f / 1024.0f) + 1e-6f); v0 = v0 * rstd; v1 = v1 * rstd;
            const size_t o = (size_t)row * 1024 + u.pn * BM + ct; f32x4 e0, e1; unpack8(*(const u32x4*)(e + o), e0, e1);
            const f32x4 r0 = *(const f32x4*)(xio + o), r1 = *(const f32x4*)(xio + o + 4);
            _Pragma("unroll") for (int i = 0; i < 4; ++i) { v0[i] = r0[i] + sigm(v0[i]) * e0[i]; v1[i] = r1[i] + sigm(v1[i]) * e1[i]; }
            *(f32x4*)(xio + o) = v0; *(f32x4*)(xio + o + 4) = v1;
        })
    }
};

template <class Epi, class Sched, bool ALIGN_EPI = false, bool SP2 = false>
__device__ __forceinline__ void gemm_phase(PG8_LAS unsigned char* lds, const Gemm g, const Sched& S, const Epi& E) {
    const int tid = threadIdx.x, wid = __builtin_amdgcn_readfirstlane(tid >> 6), lane = tid & 63, wr = wid >> 2, wc = wid & 3, fr = lane & 15, fq = lane >> 4;
    const int K = g.K, nt = K / BK;
    unsigned voffA[2], voffB[2];
#pragma unroll
    for (int i = 0; i < 2; ++i) { int R, C; stage_rc(tid * 16 + i * 8192, R, C); const int Rb = Epi::PERM ? ((R & ~31) + perm32(R & 31)) : R;
        voffA[i] = (unsigned)(R * K + C) * 2u; voffB[i] = (unsigned)(Rb * K + C) * 2u; }
    const size_t kstep = (size_t)(BK * 2);
    const size_t hstep = (size_t)HALF * K * 2;
    const size_t tstep = 2 * hstep;
    const unsigned ldsw = (unsigned)wid * 1024u;
    const int aoff = lds_byte(wr * 64 + fr, fq * 8), boff = lds_byte(wc * 32 + fr, fq * 8);
#define PG8_SA(b, h) (((b) * 2 + (h)) * HTB)
#define PG8_SB(b, h) ((4 + (b) * 2 + (h)) * HTB)
#define PG8_STAGE(bufoff, gbase, voff) do { _Pragma("unroll") for (int _i = 0; _i < 2; ++_i) \
        __builtin_amdgcn_global_load_lds((const unsigned*)((const char*)(gbase) + (voff)[_i]), (PG8_LAS unsigned*)(lds + (bufoff) + ldsw + _i * 8192), 16, 0, 0); } while (0)
#define PG8_LDA(dst, b, h) do { _Pragma("unroll") for (int m = 0; m < 4; ++m) _Pragma("unroll") for (int k = 0; k < 2; ++k) dst[m][k] = *(const PG8_LAS bf16x8*)(lds + PG8_SA(b, h) + aoff + m * 2048 + k * 1024); } while (0)
#define PG8_LDB(dst, b, h) do { _Pragma("unroll") for (int n = 0; n < 2; ++n) _Pragma("unroll") for (int k = 0; k < 2; ++k) dst[n][k] = *(const PG8_LAS bf16x8*)(lds + PG8_SB(b, h) + boff + n * 2048 + k * 1024); } while (0)
#define PG8_MMA(ai, bj, At, Bt) do { __builtin_amdgcn_s_setprio(1); _Pragma("unroll") for (int m = 0; m < 4; ++m) _Pragma("unroll") for (int n = 0; n < 2; ++n) _Pragma("unroll") for (int k = 0; k < 2; ++k) \
        acc[ai][bj][m][n] = __builtin_amdgcn_mfma_f32_16x16x32_bf16(Bt[n][k], At[m][k], acc[ai][bj][m][n], 0, 0, 0); __builtin_amdgcn_s_setprio(0); } while (0)
#define PG8_WAIT_V(n) asm volatile("s_waitcnt vmcnt(" #n ")" ::: "memory")
#define PG8_WAIT_L(n) asm volatile("s_waitcnt lgkmcnt(" #n ")" ::: "memory")
#define PG8_BAR __builtin_amdgcn_s_barrier()
#define PG8_SCHED __builtin_amdgcn_sched_barrier(0)
    Unit cur, nxt; int ui = 0;
    if (!S.next(0, cur)) return;
    f32x4 acc[2][2][4][2];
#pragma unroll
    for (int a = 0; a < 2; ++a)
#pragma unroll
        for (int b = 0; b < 2; ++b)
#pragma unroll
            for (int m = 0; m < 4; ++m)
#pragma unroll
                for (int n = 0; n < 2; ++n) acc[a][b][m][n] = (f32x4){0.f, 0.f, 0.f, 0.f};
    bf16x8 At[4][2], B0[2][2], B1[2][2];
    const char* cA = (const char*)g.A + (size_t)cur.pm * tstep; const char* cB = (const char*)g.Bt + (size_t)cur.pn * tstep;
    S.a_ready(cur);
    if constexpr (SP2) {
        PG8_STAGE(PG8_SB(0, 0), cB, voffB); PG8_STAGE(PG8_SB(0, 1), cB + hstep, voffB); PG8_STAGE(PG8_SA(0, 0), cA, voffA); PG8_STAGE(PG8_SA(0, 1), cA + hstep, voffA);
        if (wr == 1) PG8_BAR;
        PG8_WAIT_V(2); PG8_BAR;
        PG8_STAGE(PG8_SB(1, 0), cB + kstep, voffB); PG8_STAGE(PG8_SA(1, 0), cA + kstep, voffA); PG8_STAGE(PG8_SB(1, 1), cB + hstep + kstep, voffB);
        PG8_WAIT_V(6); PG8_BAR;
    } else {
        PG8_STAGE(PG8_SB(0, 0), cB, voffB); PG8_STAGE(PG8_SA(0, 0), cA, voffA); PG8_STAGE(PG8_SB(0, 1), cB + hstep, voffB); PG8_STAGE(PG8_SA(0, 1), cA + hstep, voffA);
        if (wr == 1) PG8_BAR;
        PG8_WAIT_V(4); PG8_BAR;
        PG8_STAGE(PG8_SB(1, 0), cB + kstep, voffB); PG8_STAGE(PG8_SA(1, 0), cA + kstep, voffA); PG8_STAGE(PG8_SB(1, 1), cB + hstep + kstep, voffB);
        PG8_WAIT_V(6); PG8_BAR;
    }
    for (;;) {
        const bool has_next = S.next(ui + 1, nxt);
        const char* nA = has_next ? (const char*)g.A + (size_t)nxt.pm * tstep : cA; const char* nB = has_next ? (const char*)g.Bt + (size_t)nxt.pn * tstep : cB;
        for (int t = 0; t < nt; t += 2) {
            const bool last = (t == nt - 2);
            const char* a1 = cA + (size_t)(t + 1) * kstep;
            const char* a2 = last ? nA : cA + (size_t)(t + 2) * kstep; const char* b2 = last ? nB : cB + (size_t)(t + 2) * kstep;
            const char* a3 = a2 + kstep; const char* b3 = b2 + kstep;
            if (last && has_next) S.a_ready(nxt);
            if constexpr (SP2) {
            PG8_LDB(B0, 0, 0); PG8_LDB(B1, 0, 1); PG8_SCHED; PG8_LDA(At, 0, 0); PG8_STAGE(PG8_SA(1, 1), a1 + hstep, voffA);
            PG8_WAIT_V(8); PG8_WAIT_L(0); PG8_BAR; PG8_MMA(0, 0, At, B0); PG8_MMA(0, 1, At, B1); PG8_BAR; PG8_SCHED;
            PG8_LDA(At, 0, 1); PG8_STAGE(PG8_SB(0, 0), b2, voffB); PG8_STAGE(PG8_SB(0, 1), b2 + hstep, voffB); PG8_STAGE(PG8_SA(0, 0), a2, voffA);
            PG8_WAIT_V(8); PG8_WAIT_L(0); PG8_BAR; PG8_MMA(1, 0, At, B0); PG8_MMA(1, 1, At, B1); PG8_BAR; PG8_SCHED;
            PG8_LDB(B0, 1, 0); PG8_LDB(B1, 1, 1); PG8_SCHED; PG8_LDA(At, 1, 0); PG8_STAGE(PG8_SA(0, 1), a2 + hstep, voffA);
            PG8_WAIT_V(8); PG8_WAIT_L(0); PG8_BAR; PG8_MMA(0, 0, At, B0); PG8_MMA(0, 1, At, B1); PG8_BAR; PG8_SCHED;
            PG8_LDA(At, 1, 1); PG8_STAGE(PG8_SB(1, 0), b3, voffB); PG8_STAGE(PG8_SB(1, 1), b3 + hstep, voffB); PG8_STAGE(PG8_SA(1, 0), a3, voffA);
            PG8_WAIT_V(8); PG8_WAIT_L(0); PG8_BAR; PG8_MMA(1, 0, At, B0); PG8_MMA(1, 1, At, B1); PG8_BAR; PG8_SCHED;
            } else {
            PG8_LDB(B0, 0, 0); PG8_SCHED; PG8_LDA(At, 0, 0); PG8_STAGE(PG8_SA(1, 1), a1 + hstep, voffA);
            PG8_WAIT_L(8); PG8_BAR; PG8_WAIT_L(0); PG8_MMA(0, 0, At, B0); PG8_BAR; PG8_SCHED;
            PG8_LDB(B1, 0, 1); PG8_STAGE(PG8_SB(0, 0), b2, voffB);
            PG8_BAR; PG8_WAIT_L(0); PG8_MMA(0, 1, At, B1); PG8_BAR;
            PG8_LDA(At, 0, 1); PG8_STAGE(PG8_SA(0, 0), a2, voffA);
            PG8_BAR; PG8_WAIT_L(0); PG8_MMA(1, 0, At, B0); PG8_BAR; PG8_SCHED;
            PG8_STAGE(PG8_SB(0, 1), b2 + hstep, voffB);
            PG8_WAIT_V(6); PG8_BAR; PG8_MMA(1, 1, At, B1); PG8_BAR;
            PG8_LDB(B0, 1, 0); PG8_SCHED; PG8_LDA(At, 1, 0); PG8_STAGE(PG8_SA(0, 1), a2 + hstep, voffA);
            PG8_WAIT_L(8); PG8_BAR; PG8_WAIT_L(0); PG8_MMA(0, 0, At, B0); PG8_BAR; PG8_SCHED;
            PG8_LDB(B1, 1, 1); PG8_STAGE(PG8_SB(1, 0), b3, voffB);
            PG8_BAR; PG8_WAIT_L(0); PG8_MMA(0, 1, At, B1); PG8_BAR;
            PG8_LDA(At, 1, 1); PG8_STAGE(PG8_SA(1, 0), a3, voffA);
            PG8_BAR; PG8_WAIT_L(0); PG8_MMA(1, 0, At, B0); PG8_BAR; PG8_SCHED;
            PG8_STAGE(PG8_SB(1, 1), b3 + hstep, voffB);
            PG8_WAIT_V(6); PG8_BAR; PG8_MMA(1, 1, At, B1); PG8_BAR;
            }
        }
        if constexpr (ALIGN_EPI) { if (wr == 0) PG8_BAR; }
        if constexpr (!Epi::AFTER_DRAIN) { E(acc, cur, wr, wc, fr, fq); S.done(cur); }
        if (!has_next) break;
#pragma unroll
        for (int a = 0; a < 2; ++a)
#pragma unroll
            for (int b = 0; b < 2; ++b)
#pragma unroll
                for (int m = 0; m < 4; ++m)
#pragma unroll
                    for (int n = 0; n < 2; ++n) acc[a][b][m][n] = (f32x4){0.f, 0.f, 0.f, 0.f};
        cur = nxt; cA = nA; cB = nB; ++ui;
        if constexpr (ALIGN_EPI) { if (wr == 1) PG8_BAR; }
    }
    PG8_WAIT_V(0);
    if constexpr (!ALIGN_EPI) { if (wr == 0) PG8_BAR; }
    PG8_BAR;
    if constexpr (Epi::AFTER_DRAIN) { E.fused(acc, cur, wr, wc, fr, fq, lds, wid, lane); S.done(cur); }
#undef PG8_SA
#undef PG8_SB
#undef PG8_STAGE
#undef PG8_LDA
#undef PG8_LDB
#undef PG8_MMA
#undef PG8_WAIT_V
#undef PG8_WAIT_L
#undef PG8_BAR
#undef PG8_SCHED
}
}

#define GAS __attribute__((address_space(1)))
#define LAS __attribute__((address_space(3)))
typedef unsigned short bf16;
typedef unsigned v4u __attribute__((ext_vector_type(4)));
typedef unsigned v2u __attribute__((ext_vector_type(2)));
typedef float f32x4 __attribute__((ext_vector_type(4)));
using pg8::bf_lo; using pg8::bf_hi; using pg8::sigm;

constexpr int NTOK = 32768, SEQ = 16384, DM = 1024, NW = 8;
constexpr float EPS = 1e-6f;
constexpr float C2 = 0.125f * 1.4426950408889634f;
constexpr size_t MiB = 1u << 20;
constexpr size_t WS_W1T = 1 * MiB, WS_WAT = 12 * MiB, WS_WMT = 13 * MiB, WS_WOT = 14 * MiB, WS_WQT = 16 * MiB, WS_WGT = 20 * MiB, WS_WPT = 22 * MiB;
constexpr size_t WS_K1B = 22 * MiB + 512 * 1024, WS_K2B = 22 * MiB + 768 * 1024, WS_IF = 23 * MiB, WS_UB = 24 * MiB, WS_VB = 56 * MiB;
constexpr size_t WS_XN = 88 * MiB, WS_YA = 88 * MiB, WS_YM = 120 * MiB, WS_HN = 88 * MiB;
constexpr size_t WS_QKVA = 152 * MiB, WS_QKM = 248 * MiB, WS_VM = 312 * MiB, WS_OM = 344 * MiB, WS_G = 376 * MiB;
constexpr size_t WS_DN = 504 * MiB, WS_NS = 505 * MiB, WS_SC = 506 * MiB;
constexpr size_t WS_MERGED = 152 * MiB, WS_TMP = 216 * MiB, WS_Q2 = 376 * MiB, WS_IDX = 152 * MiB, WS_GATE = 168 * MiB, WS_HN2 = 184 * MiB, WS_PB = 248 * MiB, WS_E = 264 * MiB;
constexpr size_t WS_NEED = 507 * MiB;
constexpr size_t WS_U8 = 24 * MiB, WS_V8 = 40 * MiB, WS_PART = 376 * MiB, WS_SSQ = 506 * MiB + 512 * 1024;
constexpr float SCALE_U = 256.f, SCALE_V = 16.f;
constexpr size_t OUT_DC = 0, OUT_CS = 64 * MiB;
constexpr int LDS_BYTES = 147456;

__device__ __forceinline__ unsigned f2bf(float f) { unsigned u = __float_as_uint(f); return (u + 0x7fffu + ((u >> 16) & 1u)) >> 16; }
__device__ __forceinline__ unsigned pk2(float lo, float hi) { return f2bf(lo) | (f2bf(hi) << 16); }
__device__ __forceinline__ float bf2f(bf16 b) { return __uint_as_float((unsigned)b << 16); }
__device__ __forceinline__ float wave_sum(float v) {
#pragma unroll
    for (int o = 1; o < 64; o <<= 1) v += __shfl_xor(v, o);
    return v;
}
__device__ __forceinline__ void unpk8(const v4u w, float* f) { f[0] = bf_lo(w.x); f[1] = bf_hi(w.x); f[2] = bf_lo(w.y); f[3] = bf_hi(w.y); f[4] = bf_lo(w.z); f[5] = bf_hi(w.z); f[6] = bf_lo(w.w); f[7] = bf_hi(w.w); }
__device__ __forceinline__ v4u pk8(const float* f) { v4u w; w.x = pk2(f[0], f[1]); w.y = pk2(f[2], f[3]); w.z = pk2(f[4], f[5]); w.w = pk2(f[6], f[7]); return w; }
typedef __bf16 bf16x2_t __attribute__((ext_vector_type(2)));
__device__ __forceinline__ float dot2bf(unsigned a, unsigned b, float c) { return __builtin_amdgcn_fdot2_f32_bf16(__builtin_bit_cast(bf16x2_t, a), __builtin_bit_cast(bf16x2_t, b), c, false); }
__device__ __forceinline__ float logsigmoid(float x) { return fminf(x, 0.f) - log1pf(__expf(-fabsf(x))); }
__device__ __forceinline__ float silu(float x) { return x / (1.0f + __expf(-x)); }

struct Params { const float* in[20]; float* out; unsigned char* ws; int ph_lo, ph_hi; };

__device__ __forceinline__ void transpose_item(const float* W, int ldw, int col0, int K, bf16* WT, int row0, LAS float* scr, int item, int nblk, int lane) {
    const int kb = item / nblk, nb = item % nblk, k0 = 64 * kb, n0 = 32 * nb;
#pragma unroll 8
    for (int i = 0; i < 32; ++i) { const int kk = 2 * i + (lane >> 5); scr[kk * 33 + (lane & 31)] = W[(size_t)(k0 + kk) * ldw + col0 + n0 + (lane & 31)]; }
    asm volatile("s_waitcnt lgkmcnt(0)" ::: "memory");
    const int c = lane & 7;
#pragma unroll
    for (int j = 0; j < 4; ++j) { const int n = (lane >> 3) + 8 * j; const LAS float* s = scr + (8 * c) * 33 + n;
        v4u o; o.x = pk2(s[0 * 33], s[1 * 33]); o.y = pk2(s[2 * 33], s[3 * 33]); o.z = pk2(s[4 * 33], s[5 * 33]); o.w = pk2(s[6 * 33], s[7 * 33]);
        *(v4u*)(WT + (size_t)(row0 + n0 + n) * K + k0 + 8 * c) = o; }
    asm volatile("s_waitcnt lgkmcnt(0)" ::: "memory");
}
__device__ __forceinline__ void cvt_f32_bf16(const float* src, bf16* dst, size_t n4, size_t gtid, size_t gsz) {
    for (size_t i = gtid; i < n4; i += gsz) { const f32x4 v = ((const f32x4*)src)[i]; uint2 o; o.x = pk2(v[0], v[1]); o.y = pk2(v[2], v[3]); ((uint2*)dst)[i] = o; }
}
__device__ __forceinline__ void cvt_f32_fp8(const float* src, unsigned* dst, size_t n4, float sc, size_t gtid, size_t gsz) {
    for (size_t i = gtid; i < n4; i += gsz) { const f32x4 v = ((const f32x4*)src)[i]; int w = __builtin_amdgcn_cvt_pk_fp8_f32(v[0] * sc, v[1] * sc, 0, false); w = __builtin_amdgcn_cvt_pk_fp8_f32(v[2] * sc, v[3] * sc, w, true); dst[i] = (unsigned)w; }
}
__device__ __forceinline__ void rms_row_to_bf16(const float* xrow, const float* gain, bf16* orow, int lane) {
    f32x4 v[4]; float s = 0.f;
#pragma unroll
    for (int j = 0; j < 4; ++j) { v[j] = ((const f32x4*)xrow)[lane + 64 * j]; s += (v[j][0] * v[j][0] + v[j][1] * v[j][1]) + (v[j][2] * v[j][2] + v[j][3] * v[j][3]); }
    const float rstd = rsqrtf(wave_sum(s) * (1.f / 1024.f) + EPS);
#pragma unroll
    for (int j = 0; j < 4; ++j) { const f32x4 g = ((const f32x4*)gain)[lane + 64 * j]; uint2 o; o.x = pk2(v[j][0] * rstd * g[0], v[j][1] * rstd * g[1]); o.y = pk2(v[j][2] * rstd * g[2], v[j][3] * rstd * g[3]); ((uint2*)orow)[lane + 64 * j] = o; }
}
__device__ __forceinline__ void p0_prologue(const Params& P, LAS unsigned char* lds, int tid, int lane, int wave) {
    unsigned char* ws = P.ws;
    const int gw = blockIdx.x * NW + wave, NGW = gridDim.x * NW;
    LAS float* scr = (LAS float*)(lds + wave * 8448);
    LAS float* wif = (LAS float*)(lds + 69632);
    const float* w_in = P.in[3];
    for (int i = tid; i < 8192; i += 512) wif[i] = w_in[(size_t)(i >> 3) * 5640 + 3584 + (i & 7)];
    __syncthreads();
    constexpr int I1A = 16 * 112, I1B = 16 * 64, IUP = 8 * 32, IOUT = 16 * 32, IQ = 16 * 64, IPL = 4 * 32;
    constexpr int NITEMS = I1A + I1B + 2 * IUP + IOUT + IQ + IOUT + IPL;
    for (int it = gw; it < NITEMS; it += NGW) {
        int r = it;
        if (r < I1A) { transpose_item(w_in, 5640, 0, 1024, (bf16*)(ws + WS_W1T), 0, scr, r, 112, lane); continue; } r -= I1A;
        if (r < I1B) { transpose_item(w_in, 5640, 3592, 1024, (bf16*)(ws + WS_W1T), 3584, scr, r, 64, lane); continue; } r -= I1B;
        if (r < IUP) { transpose_item(P.in[7], 1024, 0, 512, (bf16*)(ws + WS_WAT), 0, scr, r, 32, lane); continue; } r -= IUP;
        if (r < IUP) { transpose_item(P.in[8], 1024, 0, 512, (bf16*)(ws + WS_WMT), 0, scr, r, 32, lane); continue; } r -= IUP;
        if (r < IOUT) { transpose_item(P.in[9], 1024, 0, 1024, (bf16*)(ws + WS_WOT), 0, scr, r, 32, lane); continue; } r -= IOUT;
        if (r < IQ) { transpose_item(P.in[11], 2048, 0, 1024, (bf16*)(ws + WS_WQT), 0, scr, r, 64, lane); continue; } r -= IQ;
        if (r < IOUT) { transpose_item(P.in[17], 1024, 0, 1024, (bf16*)(ws + WS_WGT), 0, scr, r, 32, lane); continue; } r -= IOUT;
        transpose_item(P.in[18], 1024, 0, 256, (bf16*)(ws + WS_WPT), 0, scr, r, 32, lane);
    }
    const size_t gtid = (size_t)blockIdx.x * 512 + tid, gsz = (size_t)gridDim.x * 512;
    cvt_f32_bf16(P.in[12], (bf16*)(ws + WS_K1B), 8 * 128 * 128 / 4, gtid, gsz);
    cvt_f32_bf16(P.in[13], (bf16*)(ws + WS_K2B), 8 * 128 * 128 / 4, gtid, gsz);
    cvt_f32_fp8(P.in[14], (unsigned*)(ws + WS_U8), (size_t)16384 * 1024 / 4, SCALE_U, gtid, gsz);
    cvt_f32_fp8(P.in[15], (unsigned*)(ws + WS_V8), (size_t)16384 * 1024 / 4, SCALE_V, gtid, gsz);
    const float* x = P.in[0]; const float* gmix = P.in[2]; const float* gbias = P.in[5];
    bf16* XN = (bf16*)(ws + WS_XN); float* IFb = (float*)(ws + WS_IF);
    for (int m = gw; m < NTOK; m += NGW) {
        const float* xrow = x + (size_t)m * 1024;
        f32x4 v[4]; float s = 0.f;
#pragma unroll
        for (int j = 0; j < 4; ++j) { v[j] = ((const f32x4*)xrow)[lane + 64 * j]; s += (v[j][0] * v[j][0] + v[j][1] * v[j][1]) + (v[j][2] * v[j][2] + v[j][3] * v[j][3]); }
        const float rstd = rsqrtf(wave_sum(s) * (1.f / 1024.f) + EPS);
        float a8[8] = {0.f, 0.f, 0.f, 0.f, 0.f, 0.f, 0.f, 0.f};
#pragma unroll
        for (int j = 0; j < 4; ++j) {
            const f32x4 g = ((const f32x4*)gmix)[lane + 64 * j];
#pragma unroll
            for (int i = 0; i < 4; ++i) { v[j][i] = v[j][i] * rstd * g[i]; const int d = 4 * (lane + 64 * j) + i; const f32x4 wa = *(const LAS f32x4*)(wif + d * 8), wb = *(const LAS f32x4*)(wif + d * 8 + 4);
                a8[0] += v[j][i] * wa[0]; a8[1] += v[j][i] * wa[1]; a8[2] += v[j][i] * wa[2]; a8[3] += v[j][i] * wa[3]; a8[4] += v[j][i] * wb[0]; a8[5] += v[j][i] * wb[1]; a8[6] += v[j][i] * wb[2]; a8[7] += v[j][i] * wb[3]; }
            uint2 o; o.x = pk2(v[j][0], v[j][1]); o.y = pk2(v[j][2], v[j][3]); ((uint2*)(XN + (size_t)m * 1024))[lane + 64 * j] = o;
        }
#pragma unroll
        for (int c = 0; c < 8; ++c) a8[c] = wave_sum(a8[c]);
        if (lane == 0) {
#pragma unroll
            for (int c = 0; c < 8; ++c) IFb[(size_t)m * 8 + c] = a8[c] + gbias[c];
        }
    }
}

typedef short bf16x8 __attribute__((ext_vector_type(8)));
typedef short v4i16 __attribute__((ext_vector_type(4)));
#define MFMA16(a, b, c) __builtin_amdgcn_mfma_f32_16x16x32_bf16((a), (b), (c), 0, 0, 0)
__device__ __forceinline__ void attn_pair_params(int pp, int& d, int& n0, int& sh) {
    if (pp < 5) { d = 16; sh = 4; n0 = -144 + 32 * pp; } else if (pp < 11) { d = 4; sh = 2; n0 = -128 + 32 * (pp - 5); } else { d = 1; sh = 0; n0 = -128 + 32 * (pp - 11); }
}
__device__ __forceinline__ void p2_attention(const Params& P, LAS unsigned char* lds, int lane, int wave) {
    const bf16* QKVA = (const bf16*)(P.ws + WS_QKVA); bf16* YA = (bf16*)(P.ws + WS_YA);
    LAS unsigned char* vbuf = lds + wave * 10240;
    const int r = lane & 15, g = lane >> 4, kk = lane & 31, half = lane >> 5;
    const int trq = (lane >> 2) & 3, trp = lane & 3;
    const int tr_off = (4 * g + trq) * 160 + trp * 8;
    for (int wi = blockIdx.x; wi < 1024; wi += gridDim.x) {
        const int bh = wi >> 6, tb = wi & 63, b = bh >> 3, h = bh & 7;
        const bf16* base = QKVA + (size_t)b * SEQ * 1536 + h * 64;
#pragma unroll 1
        for (int uu = 0; uu < 2; ++uu) {
            const int t0 = tb * 256 + wave * 2 + uu, tq = t0 + 16 * r;
            const bf16x8 qb0 = *(const bf16x8*)(base + (size_t)tq * 1536 + 8 * g), qb1 = *(const bf16x8*)(base + (size_t)tq * 1536 + 32 + 8 * g);
            f32x4 o[4];
#pragma unroll
            for (int i = 0; i < 4; ++i) o[i] = (f32x4){0.f, 0.f, 0.f, 0.f};
            float m = -1e30f, l = 0.f;
            bf16x8 kc[2][2], kn[2][2]; v4u vn[4];
            { int d, n0, sh; attn_pair_params(0, d, n0, sh);
#pragma unroll
              for (int blk = 0; blk < 2; ++blk) { int tok = t0 + d * (n0 + 16 * blk + r); tok = min(max(tok, 0), SEQ - 1); const bf16* kp = base + 512 + (size_t)tok * 1536 + 8 * g; kc[blk][0] = *(const bf16x8*)kp; kc[blk][1] = *(const bf16x8*)(kp + 32); }
              int tokv = t0 + d * (n0 + kk); tokv = min(max(tokv, 0), SEQ - 1); const bf16* vp = base + 1024 + (size_t)tokv * 1536 + 32 * half;
#pragma unroll
              for (int c = 0; c < 4; ++c) vn[c] = *(const v4u*)(vp + 8 * c);
#pragma unroll
              for (int c = 0; c < 4; ++c) *(LAS v4u*)(vbuf + kk * 160 + half * 64 + c * 16) = vn[c];
            }
#pragma unroll 1
            for (int pp = 0; pp < 23; ++pp) {
                int d, n0, sh; attn_pair_params(pp, d, n0, sh);
                { int dn, nn, shn; attn_pair_params(pp < 22 ? pp + 1 : pp, dn, nn, shn);
#pragma unroll
                  for (int blk = 0; blk < 2; ++blk) { int tok = t0 + dn * (nn + 16 * blk + r); tok = min(max(tok, 0), SEQ - 1); const bf16* kp = base + 512 + (size_t)tok * 1536 + 8 * g; kn[blk][0] = *(const bf16x8*)kp; kn[blk][1] = *(const bf16x8*)(kp + 32); }
                  int tokv = t0 + dn * (nn + kk); tokv = min(max(tokv, 0), SEQ - 1); const bf16* vp = base + 1024 + (size_t)tokv * 1536 + 32 * half;
#pragma unroll
                  for (int c = 0; c < 4; ++c) vn[c] = *(const v4u*)(vp + 8 * c);
                }
                const int hi = r << (4 - sh), lo = max(hi - 128, -(t0 >> sh));
                f32x4 s0 = {0.f, 0.f, 0.f, 0.f}, s1 = {0.f, 0.f, 0.f, 0.f};
                s0 = MFMA16(kc[0][0], qb0, s0); s0 = MFMA16(kc[0][1], qb1, s0);
                s1 = MFMA16(kc[1][0], qb0, s1); s1 = MFMA16(kc[1][1], qb1, s1);
                bool v0[4], v1[4]; float mx = -1e30f;
#pragma unroll
                for (int k = 0; k < 4; ++k) { const int na = n0 + 4 * g + k, nb = na + 16; v0[k] = (na >= lo) && (na <= hi); v1[k] = (nb >= lo) && (nb <= hi);
                    mx = fmaxf(mx, v0[k] ? s0[k] : -1e30f); mx = fmaxf(mx, v1[k] ? s1[k] : -1e30f); }
                mx = fmaxf(mx, __shfl_xor(mx, 16)); mx = fmaxf(mx, __shfl_xor(mx, 32));
                const float mn = fmaxf(m, mx), alpha = __builtin_amdgcn_exp2f(m - mn); m = mn;
                float p0[4], p1[4], ps = 0.f;
#pragma unroll
                for (int k = 0; k < 4; ++k) { p0[k] = v0[k] ? __builtin_amdgcn_exp2f(s0[k] - mn) : 0.f; p1[k] = v1[k] ? __builtin_amdgcn_exp2f(s1[k] - mn) : 0.f; ps += p0[k] + p1[k]; }
                l = l * alpha + ps;
#pragma unroll
                for (int i = 0; i < 4; ++i) o[i] = o[i] * alpha;
                bf16x8 pb; { v4u w; w.x = pk2(p0[0], p0[1]); w.y = pk2(p0[2], p0[3]); w.z = pk2(p1[0], p1[1]); w.w = pk2(p1[2], p1[3]); pb = __builtin_bit_cast(bf16x8, w); }
                LAS unsigned char* vb = vbuf + (pp & 1) * 5120 + tr_off;
#pragma unroll
                for (int db = 0; db < 4; ++db) {
                    const v4i16 a0 = __builtin_amdgcn_ds_read_tr16_b64_v4i16((LAS v4i16*)(vb + db * 32)), a1 = __builtin_amdgcn_ds_read_tr16_b64_v4i16((LAS v4i16*)(vb + 16 * 160 + db * 32));
                    bf16x8 va; va[0] = a0[0]; va[1] = a0[1]; va[2] = a0[2]; va[3] = a0[3]; va[4] = a1[0]; va[5] = a1[1]; va[6] = a1[2]; va[7] = a1[3];
                    o[db] = MFMA16(va, pb, o[db]);
                }
                LAS unsigned char* vw = vbuf + ((pp + 1) & 1) * 5120 + kk * 160 + half * 64;
#pragma unroll
                for (int c = 0; c < 4; ++c) *(LAS v4u*)(vw + c * 16) = vn[c];
#pragma unroll
                for (int blk = 0; blk < 2; ++blk) { kc[blk][0] = kn[blk][0]; kc[blk][1] = kn[blk][1]; }
            }
            l += __shfl_xor(l, 16); l += __shfl_xor(l, 32);
            const float inv = 1.0f / l;
            bf16* yo = YA + ((size_t)b * SEQ + tq) * 512 + h * 64 + 4 * g;
#pragma unroll
            for (int db = 0; db < 4; ++db) { uint2 w; w.x = pk2(o[db][0] * inv, o[db][1] * inv); w.y = pk2(o[db][2] * inv, o[db][3] * inv); *(uint2*)(yo + 16 * db) = w; }
        }
    }
}

__device__ __forceinline__ float conv_silu(const bf16* QKM, const float* cw, int b, int t, int ch) {
    float a = 0.f;
#pragma unroll
    for (int j = 0; j < 4; ++j) { const int tt = t - 3 + j; if (tt >= 0) a += cw[j * 1024 + ch] * bf2f(QKM[((size_t)b * SEQ + tt) * 1024 + ch]); }
    return silu(a);
}

__device__ __forceinline__ float scan_add(float v, int lane) {
#pragma unroll
    for (int o = 1; o < 64; o <<= 1) { const float u = __shfl_up(v, o); if (lane >= o) v += u; }
    return v;
}
__device__ __forceinline__ float scan_max(float v, int lane) {
#pragma unroll
    for (int o = 1; o < 64; o <<= 1) { const float u = __shfl_up(v, o); if (lane >= o) v = fmaxf(v, u); }
    return v;
}
__device__ __forceinline__ float wave_max(float v) {
#pragma unroll
    for (int o = 1; o < 64; o <<= 1) v = fmaxf(v, __shfl_xor(v, o));
    return v;
}
__device__ __forceinline__ void conv16(const bf16* QKM, const float* cw, int b, int t0, int chan, float* out) {
    const bf16* src = QKM + (size_t)b * SEQ * 1024 + chan;
    const float w0 = cw[chan], w1 = cw[1024 + chan], w2 = cw[2048 + chan], w3 = cw[3072 + chan];
    float x0 = t0 >= 3 ? bf2f(src[(size_t)(t0 - 3) * 1024]) : 0.f, x1 = t0 >= 2 ? bf2f(src[(size_t)(t0 - 2) * 1024]) : 0.f, x2 = t0 >= 1 ? bf2f(src[(size_t)(t0 - 1) * 1024]) : 0.f;
#pragma unroll
    for (int i = 0; i < 16; ++i) { const float x3 = bf2f(src[(size_t)(t0 + i) * 1024]); out[i] = silu(w0 * x0 + w1 * x1 + w2 * x2 + w3 * x3); x0 = x1; x1 = x2; x2 = x3; }
}

__device__ __forceinline__ void p2_mlstm_local(const Params& P, LAS unsigned char* lds, int tid, int lane, int wave) {
    const bf16* QKM = (const bf16*)(P.ws + WS_QKM); const bf16* VM = (const bf16*)(P.ws + WS_VM); const float* IFb = (const float*)(P.ws + WS_IF);
    const float* cw = P.in[4];
    bf16* DC = (bf16*)((unsigned char*)P.out + OUT_DC); float* DN = (float*)(P.ws + WS_DN); float* SC = (float*)(P.ws + WS_SC);
    LAS bf16* KWT = (LAS bf16*)lds; LAS bf16* VT = (LAS bf16*)(lds + 18432); LAS float* sw = (LAS float*)(lds + 36864);
    const int r = lane & 15, g = lane >> 4;
    for (int item = blockIdx.x; item < 2048; item += gridDim.x) {
        const int bh = item >> 8, c = item & 255, b = bh >> 2, h = bh & 3;
        if (wave == 0) {
            const size_t row = (size_t)b * SEQ + c * 64 + lane;
            const float lf = logsigmoid(IFb[row * 8 + 4 + h]), ip = IFb[row * 8 + h];
            const float bc = scan_add(lf, lane), gg = __shfl(bc, 63), ds = gg - bc + ip, ml = wave_max(ds);
            sw[lane] = __expf(ds - ml);
            if (lane == 0) { SC[item] = ml; SC[2048 + item] = gg; }
        }
        __syncthreads();
        { const int ch = tid & 127, sq = tid >> 7, s0 = sq * 16; float o[16];
          conv16(QKM, cw, b, c * 64 + s0, 512 + h * 128 + ch, o);
#pragma unroll
          for (int i = 0; i < 16; i += 2) *(LAS unsigned*)(KWT + ch * 72 + s0 + i) = pk2(o[i] * 0.08838834764831845f * sw[s0 + i], o[i + 1] * 0.08838834764831845f * sw[s0 + i + 1]);
          const bf16* vsrc = VM + ((size_t)b * SEQ + c * 64 + s0) * 512 + h * 128 + ch;
#pragma unroll
          for (int i = 0; i < 16; i += 2) *(LAS unsigned*)(VT + ch * 72 + s0 + i) = (unsigned)vsrc[(size_t)i * 512] | ((unsigned)vsrc[(size_t)(i + 1) * 512] << 16);
        }
        __syncthreads();
        {
          const bf16x8 vb0 = *(const LAS bf16x8*)(VT + (16 * wave + r) * 72 + 8 * g), vb1 = *(const LAS bf16x8*)(VT + (16 * wave + r) * 72 + 32 + 8 * g);
          bf16* dst = DC + (size_t)item * 16384 + (size_t)(16 * wave + r) * 128 + 4 * g;
#pragma unroll
          for (int eb = 0; eb < 8; ++eb) {
              const bf16x8 ka0 = *(const LAS bf16x8*)(KWT + (16 * eb + r) * 72 + 8 * g), ka1 = *(const LAS bf16x8*)(KWT + (16 * eb + r) * 72 + 32 + 8 * g);
              f32x4 acc = {0.f, 0.f, 0.f, 0.f};
              acc = MFMA16(ka0, vb0, acc); acc = MFMA16(ka1, vb1, acc);
              uint2 o; o.x = pk2(acc[0], acc[1]); o.y = pk2(acc[2], acc[3]); *(uint2*)(dst + 16 * eb) = o;
          }
        }
        if (tid < 128) { float a = 0.f;
#pragma unroll
            for (int cc = 0; cc < 8; ++cc) { float f[8]; unpk8(*(const LAS v4u*)(KWT + tid * 72 + 8 * cc), f);
#pragma unroll
                for (int k = 0; k < 8; ++k) a += f[k]; }
            DN[(size_t)item * 128 + tid] = a; }
        __syncthreads();
    }
}

__device__ __forceinline__ void p3_mlstm_scan(const Params& P, int tid) {
    const unsigned* __restrict__ DC = (const unsigned*)((unsigned char*)P.out + OUT_DC); unsigned* __restrict__ CS = (unsigned*)((unsigned char*)P.out + OUT_CS);
    const float* __restrict__ DN = (const float*)(P.ws + WS_DN); float* __restrict__ NS = (float*)(P.ws + WS_NS); float* SC = (float*)(P.ws + WS_SC);
    for (int gid = blockIdx.x * 512 + tid; gid < 8 * 8192; gid += gridDim.x * 512) {
        const int bh = gid >> 13, idx = gid & 8191;
        float C0 = 0.f, C1 = 0.f, m = 0.f;
        for (int j0 = 0; j0 < 256; j0 += 8) {
            unsigned d[8]; float ml[8], gg[8];
#pragma unroll
            for (int u = 0; u < 8; ++u) { const int item = bh * 256 + j0 + u; d[u] = DC[(size_t)item * 8192 + idx]; ml[u] = SC[item]; gg[u] = SC[2048 + item]; }
#pragma unroll
            for (int u = 0; u < 8; ++u) { const int item = bh * 256 + j0 + u;
                CS[(size_t)item * 8192 + idx] = pk2(C0, C1);
                if (idx == 0) SC[4096 + item] = m;
                const float mn = fmaxf(gg[u] + m, ml[u]), a = __expf(gg[u] + m - mn), bb = __expf(ml[u] - mn);
                C0 = a * C0 + bb * bf_lo(d[u]); C1 = a * C1 + bb * bf_hi(d[u]); m = mn; }
        }
    }
    for (int gid = blockIdx.x * 512 + tid; gid < 8 * 128; gid += gridDim.x * 512) {
        const int bh = gid >> 7, idx = gid & 127; float n = 0.f, m = 0.f;
        for (int j = 0; j < 256; ++j) { const int item = bh * 256 + j; NS[(size_t)item * 128 + idx] = n;
            const float ml = SC[item], gg = SC[2048 + item], mn = fmaxf(gg + m, ml), a = __expf(gg + m - mn), bb = __expf(ml - mn);
            n = a * n + bb * DN[(size_t)item * 128 + idx]; m = mn; }
    }
}

__device__ __forceinline__ void p4_mlstm_out(const Params& P, LAS unsigned char* lds, int tid, int lane, int wave) {
    const bf16* QKM = (const bf16*)(P.ws + WS_QKM); const bf16* VM = (const bf16*)(P.ws + WS_VM); const bf16* OM = (const bf16*)(P.ws + WS_OM); const float* IFb = (const float*)(P.ws + WS_IF);
    const float* cw = P.in[4]; const float* mnorm = P.in[6];
    const bf16* CS = (const bf16*)((unsigned char*)P.out + OUT_CS); const float* NS = (const float*)(P.ws + WS_NS); const float* SC = (const float*)(P.ws + WS_SC);
    bf16* YM = (bf16*)(P.ws + WS_YM);
    LAS bf16* Qs = (LAS bf16*)lds; LAS bf16* Ks = (LAS bf16*)(lds + 17408); LAS bf16* VT = (LAS bf16*)(lds + 34816); LAS bf16* PT = (LAS bf16*)(lds + 53248);
    LAS float* sm = (LAS float*)(lds + 62464);
    const int r = lane & 15, g = lane >> 4;
    for (int item = blockIdx.x; item < 2048; item += gridDim.x) {
        const int bh = item >> 8, c = item & 255, b = bh >> 2, h = bh & 3;
        if (wave == 0) {
            const size_t row = (size_t)b * SEQ + c * 64 + lane;
            const float lf = logsigmoid(IFb[row * 8 + 4 + h]), ip = IFb[row * 8 + h];
            const float bc = scan_add(lf, lane), a = ip - bc, pm = scan_max(a, lane), ms = SC[4096 + item], M = fmaxf(ms, pm);
            sm[lane] = a; sm[64 + lane] = M; sm[128 + lane] = __expf(ms - M); sm[192 + lane] = __expf(-bc - M);
        } else if (wave < 3) sm[320 + tid - 64] = NS[(size_t)item * 128 + tid - 64];
        { const int ch = tid & 127, sq = tid >> 7, s0 = sq * 16; float o[16];
          conv16(QKM, cw, b, c * 64 + s0, h * 128 + ch, o);
#pragma unroll
          for (int i = 0; i < 16; ++i) Qs[(s0 + i) * 136 + ch] = (bf16)f2bf(o[i]);
          conv16(QKM, cw, b, c * 64 + s0, 512 + h * 128 + ch, o);
#pragma unroll
          for (int i = 0; i < 16; ++i) Ks[(s0 + i) * 136 + ch] = (bf16)f2bf(o[i] * 0.08838834764831845f);
          const bf16* vsrc = VM + ((size_t)b * SEQ + c * 64 + s0) * 512 + h * 128 + ch;
#pragma unroll
          for (int i = 0; i < 16; i += 2) *(LAS unsigned*)(VT + ch * 72 + s0 + i) = (unsigned)vsrc[(size_t)i * 512] | ((unsigned)vsrc[(size_t)(i + 1) * 512] << 16);
        }
        __syncthreads();
        {
          const int sb = wave >> 1;
          bf16x8 ka[4];
#pragma unroll
          for (int ks = 0; ks < 4; ++ks) ka[ks] = *(const LAS bf16x8*)(Ks + (16 * sb + r) * 136 + 32 * ks + 8 * g);
#pragma unroll
          for (int tt = 0; tt < 2; ++tt) { const int tb = 2 * (wave & 1) + tt, t = 16 * tb + r;
              f32x4 acc = {0.f, 0.f, 0.f, 0.f};
#pragma unroll
              for (int ks = 0; ks < 4; ++ks) { const bf16x8 qb = *(const LAS bf16x8*)(Qs + t * 136 + 32 * ks + 8 * g); acc = MFMA16(ka[ks], qb, acc); }
              const float Mt = sm[64 + t]; float p[4];
#pragma unroll
              for (int k = 0; k < 4; ++k) { const int s = 16 * sb + 4 * g + k; p[k] = (s <= t) ? acc[k] * __expf(sm[s] - Mt) : 0.f; }
              v2u o; o.x = pk2(p[0], p[1]); o.y = pk2(p[2], p[3]); *(LAS v2u*)(PT + t * 72 + 16 * sb + 4 * g) = o; }
        }
        __syncthreads();
        if (tid < 64) { const int t = tid; float sp = 0.f, qn = 0.f;
#pragma unroll
            for (int cc = 0; cc < 8; ++cc) { float f[8]; unpk8(*(const LAS v4u*)(PT + t * 72 + 8 * cc), f);
#pragma unroll
                for (int k = 0; k < 8; ++k) sp += f[k]; }
#pragma unroll
            for (int cc = 0; cc < 16; ++cc) { float f[8]; unpk8(*(const LAS v4u*)(Qs + t * 136 + 8 * cc), f);
#pragma unroll
                for (int k = 0; k < 8; ++k) qn += f[k] * sm[320 + 8 * cc + k]; }
            sm[256 + t] = fmaxf(fabsf(sm[128 + t] * qn + sp), sm[192 + t]); }
        f32x4 ai[4], ac[4];
#pragma unroll
        for (int tb = 0; tb < 4; ++tb) { ai[tb] = (f32x4){0.f, 0.f, 0.f, 0.f}; ac[tb] = (f32x4){0.f, 0.f, 0.f, 0.f}; }
        {
          const bf16x8 va0 = *(const LAS bf16x8*)(VT + (16 * wave + r) * 72 + 8 * g), va1 = *(const LAS bf16x8*)(VT + (16 * wave + r) * 72 + 32 + 8 * g);
          bf16x8 ca[4];
          const bf16* crow = CS + (size_t)item * 16384 + (size_t)(16 * wave + r) * 128 + 8 * g;
#pragma unroll
          for (int ks = 0; ks < 4; ++ks) ca[ks] = *(const bf16x8*)(crow + 32 * ks);
#pragma unroll
          for (int tb = 0; tb < 4; ++tb) { const int t = 16 * tb + r;
              const bf16x8 pb0 = *(const LAS bf16x8*)(PT + t * 72 + 8 * g), pb1 = *(const LAS bf16x8*)(PT + t * 72 + 32 + 8 * g);
              ai[tb] = MFMA16(va0, pb0, ai[tb]); ai[tb] = MFMA16(va1, pb1, ai[tb]);
#pragma unroll
              for (int ks = 0; ks < 4; ++ks) { const bf16x8 qb = *(const LAS bf16x8*)(Qs + t * 136 + 32 * ks + 8 * g); ac[tb] = MFMA16(ca[ks], qb, ac[tb]); } }
        }
        __syncthreads();
        float ssq[4];
#pragma unroll
        for (int tb = 0; tb < 4; ++tb) { const int t = 16 * tb + r; const float wi = sm[128 + t], inv = 1.0f / sm[256 + t]; float s2 = 0.f;
#pragma unroll
            for (int k = 0; k < 4; ++k) { ai[tb][k] = (wi * ac[tb][k] + ai[tb][k]) * inv; s2 += ai[tb][k] * ai[tb][k]; }
            s2 += __shfl_xor(s2, 16); s2 += __shfl_xor(s2, 32); ssq[tb] = s2;
            if (g == 0) sm[448 + wave * 64 + t] = s2; }
        __syncthreads();
#pragma unroll
        for (int tb = 0; tb < 4; ++tb) { const int t = 16 * tb + r; float tot = 0.f;
#pragma unroll
            for (int w = 0; w < 8; ++w) tot += sm[448 + w * 64 + t];
            const float rs = rsqrtf(tot * (1.f / 128.f) + EPS);
            const size_t row = (size_t)b * SEQ + c * 64 + t; const int col = h * 128 + 16 * wave + 4 * g;
            const uint2 omw = *(const uint2*)(OM + row * 512 + col); const f32x4 gn = *(const f32x4*)(mnorm + col);
            uint2 o; o.x = pk2(ai[tb][0] * rs * gn[0] * bf_lo(omw.x), ai[tb][1] * rs * gn[1] * bf_hi(omw.x)); o.y = pk2(ai[tb][2] * rs * gn[2] * bf_lo(omw.y), ai[tb][3] * rs * gn[3] * bf_hi(omw.y));
            *(uint2*)(YM + row * 512 + col) = o; }
        __syncthreads();
    }
}

__device__ __forceinline__ int f2ord(float f) { const int b = __float_as_int(f); return b ^ ((b >> 31) & 0x7fffffff); }
__device__ __forceinline__ float ord2f(int o) { return __int_as_float(o ^ ((o >> 31) & 0x7fffffff)); }
#define CE_DESC(a, i, j) { const int _h = max(a[i], a[j]), _l = min(a[i], a[j]); a[i] = _h; a[j] = _l; }
__device__ __forceinline__ void sort16_desc(int (&a)[16]) {
#pragma unroll
    for (int k = 2; k <= 16; k <<= 1) {
#pragma unroll
        for (int j = k >> 1; j > 0; j >>= 1) {
#pragma unroll
            for (int i = 0; i < 16; ++i) { const int l = i ^ j; if (l > i) { if ((i & k) == 0) CE_DESC(a, i, l) else CE_DESC(a, l, i) } }
        }
    }
}
__device__ __forceinline__ void merge16_desc(int (&a)[16], const int (&b)[16]) {
#pragma unroll
    for (int i = 0; i < 16; ++i) a[i] = max(a[i], b[15 - i]);
#pragma unroll
    for (int j = 8; j > 0; j >>= 1) {
#pragma unroll
        for (int i = 0; i < 16; ++i) { const int l = i ^ j; if (l > i) CE_DESC(a, i, l) }
    }
}
__device__ __forceinline__ void xmerge16(int (&a)[16], int mask) {
    int b[16];
#pragma unroll
    for (int i = 0; i < 16; ++i) b[i] = __shfl_xor(a[i], mask);
    merge16_desc(a, b);
}
__device__ __forceinline__ void p10_topk(const Params& P, LAS unsigned char* lds, int tid, int lane, int wave) {
    const bf16* Q2 = (const bf16*)(P.ws + WS_Q2); const bf16* K1B = (const bf16*)(P.ws + WS_K1B); const bf16* K2B = (const bf16*)(P.ws + WS_K2B);
    int* IDX = (int*)(P.ws + WS_IDX); float* GATE = (float*)(P.ws + WS_GATE);
    LAS bf16* Kl = (LAS bf16*)lds;
    LAS int* Tb = (LAS int*)(lds + 69632 + wave * 2048);
    const int r = lane & 15, g = lane >> 4;
    const int h = blockIdx.x & 7, wgx = blockIdx.x >> 3, nwg = gridDim.x >> 3;
    __syncthreads();
    for (int i = tid; i < 4096; i += 512) { const int half = i >> 11, rem = i & 2047, n = rem >> 4, c = rem & 15;
        *(LAS v4u*)(Kl + half * 17408 + n * 136 + c * 8) = *(const v4u*)((half ? K2B : K1B) + (size_t)h * 16384 + n * 128 + c * 8); }
    __syncthreads();
    for (int tile = wgx * NW + wave; tile < NTOK / 16; tile += nwg * NW) {
        const size_t row = (size_t)tile * 16 + r;
        int R[2][16];
#pragma unroll
        for (int half = 0; half < 2; ++half) {
            bf16x8 qb[4];
#pragma unroll
            for (int ks = 0; ks < 4; ++ks) qb[ks] = *(const bf16x8*)(Q2 + row * 2048 + h * 256 + half * 128 + 32 * ks + 8 * g);
            int X[16], Y[16];
#pragma unroll
            for (int nb = 0; nb < 8; ++nb) {
                f32x4 acc = {0.f, 0.f, 0.f, 0.f};
#pragma unroll
                for (int ks = 0; ks < 4; ++ks) acc = MFMA16(*(const LAS bf16x8*)(Kl + half * 17408 + (16 * nb + r) * 136 + 32 * ks + 8 * g), qb[ks], acc);
#pragma unroll
                for (int k = 0; k < 4; ++k) { const int key = (f2ord(acc[k]) & ~0x7f) | (16 * nb + 4 * g + k); if (nb < 4) X[4 * nb + k] = key; else Y[4 * (nb - 4) + k] = key; }
            }
            sort16_desc(X); sort16_desc(Y); merge16_desc(X, Y);
            xmerge16(X, 16); xmerge16(X, 32);
#pragma unroll
            for (int i = 0; i < 16; ++i) R[half][i] = X[i];
        }
        if (g == 0) {
#pragma unroll
            for (int i = 0; i < 16; ++i) { Tb[r * 32 + i] = R[0][i] & 0x7f; Tb[r * 32 + 16 + i] = R[1][i] & 0x7f; }
        }
        float F1[16], F2[16];
#pragma unroll
        for (int i = 0; i < 16; ++i) { F1[i] = ord2f(R[0][i] & ~0x7f); F2[i] = ord2f(R[1][i] & ~0x7f); }
        int C[16];
#pragma unroll
        for (int sl = 0; sl < 16; ++sl) {
            const int a1 = sl < 8 ? 1 : (sl < 13 ? 2 : -1), b1 = sl < 8 ? sl : sl - 8;
            const int a2 = sl < 4 ? 3 : (sl < 7 ? 4 : (sl < 9 ? 5 : (sl < 11 ? 6 : (sl < 13 ? 7 : -1)))), b2 = sl < 4 ? sl : (sl < 7 ? sl - 4 : (sl < 9 ? sl - 7 : (sl < 11 ? sl - 9 : sl - 11)));
            const int a3 = sl < 8 ? 8 + sl : -1;
            const int k0 = (f2ord(F1[0] + F2[sl]) & ~0xff) | (0 << 4) | sl;
            const int k1 = a1 >= 0 ? ((f2ord(F1[a1 < 0 ? 0 : a1] + F2[b1 & 15]) & ~0xff) | (a1 << 4) | (b1 & 15)) : (int)0x80000000;
            const int k2 = a2 >= 0 ? ((f2ord(F1[a2 < 0 ? 0 : a2] + F2[b2 & 15]) & ~0xff) | (a2 << 4) | (b2 & 15)) : (int)0x80000000;
            const int k3 = a3 >= 0 ? ((f2ord(F1[a3 < 0 ? 0 : a3] + F2[0]) & ~0xff) | (a3 << 4)) : (int)0x80000000;
            C[sl] = g == 0 ? k0 : (g == 1 ? k1 : (g == 2 ? k2 : k3));
        }
        sort16_desc(C); xmerge16(C, 16); xmerge16(C, 32);
        float e[16], sum = 0.f; const float mx = ord2f(C[0] & ~0xff);
#pragma unroll
        for (int i = 0; i < 16; ++i) { e[i] = __expf(ord2f(C[i] & ~0xff) - mx); sum += e[i]; }
        const float inv = 1.0f / sum;
        int oi[4]; float og[4];
#pragma unroll
        for (int kk = 0; kk < 4; ++kk) {
            const int key = g == 0 ? C[kk] : (g == 1 ? C[4 + kk] : (g == 2 ? C[8 + kk] : C[12 + kk]));
            const float ev = g == 0 ? e[kk] : (g == 1 ? e[4 + kk] : (g == 2 ? e[8 + kk] : e[12 + kk]));
            const int a = (key >> 4) & 15, bq = key & 15;
            oi[kk] = Tb[r * 32 + a] * 128 + Tb[r * 32 + 16 + bq]; og[kk] = ev * inv;
        }
#pragma unroll
        for (int kk = 0; kk < 4; ++kk) { const int pos = (4 * (g & 1) + kk) * 16 + 2 * h + (g >> 1); IDX[row * 128 + pos] = oi[kk]; GATE[row * 128 + pos] = og[kk]; }
    }
}

typedef _Float16 f16x2 __attribute__((ext_vector_type(2)));
__device__ __forceinline__ f16x2 bfpair_to_h2(unsigned w) { return __builtin_bit_cast(f16x2, __builtin_amdgcn_cvt_pkrtz(bf_lo(w), bf_hi(w))); }
__device__ __forceinline__ f16x2 fp8lo_to_h2(unsigned w) { return __builtin_bit_cast(f16x2, __builtin_amdgcn_cvt_scalef32_pk_f16_fp8((int)w, 1.0f, false)); }
__device__ __forceinline__ f16x2 fp8hi_to_h2(unsigned w) { return __builtin_bit_cast(f16x2, __builtin_amdgcn_cvt_scalef32_pk_f16_fp8((int)w, 1.0f, true)); }
__device__ __forceinline__ void p11a_udot(const Params& P, int lane, int wave) {
    const bf16* HN = (const bf16*)(P.ws + WS_HN); const unsigned char* U8 = P.ws + WS_U8; const int* IDX = (const int*)(P.ws + WS_IDX); float* PART = (float*)(P.ws + WS_PART);
    const int x = blockIdx.x & 7, wgx = blockIdx.x >> 3, nwg = gridDim.x >> 3, rg = lane >> 3, ch = lane & 7;
    for (int t = wgx * NW + wave; t < NTOK; t += nwg * NW) {
        int e[16];
#pragma unroll
        for (int q = 0; q < 4; ++q) { const int4 v = *(const int4*)(IDX + (size_t)t * 128 + rg * 16 + 4 * q); e[4 * q] = v.x; e[4 * q + 1] = v.y; e[4 * q + 2] = v.z; e[4 * q + 3] = v.w; }
        const v4u h0 = *(const v4u*)(HN + (size_t)t * 1024 + 128 * x + 16 * ch), h1 = *(const v4u*)(HN + (size_t)t * 1024 + 128 * x + 16 * ch + 8);
        v4u ud[16];
#pragma unroll
        for (int gq = 0; gq < 16; ++gq) ud[gq] = *(const v4u*)(U8 + (size_t)e[gq] * 1024 + 128 * x + 16 * ch);
        f16x2 hh[8]; hh[0] = bfpair_to_h2(h0.x); hh[1] = bfpair_to_h2(h0.y); hh[2] = bfpair_to_h2(h0.z); hh[3] = bfpair_to_h2(h0.w); hh[4] = bfpair_to_h2(h1.x); hh[5] = bfpair_to_h2(h1.y); hh[6] = bfpair_to_h2(h1.z); hh[7] = bfpair_to_h2(h1.w);
        float z[16];
#pragma unroll
        for (int gq = 0; gq < 16; ++gq) { float d = 0.f; const unsigned w4[4] = {ud[gq].x, ud[gq].y, ud[gq].z, ud[gq].w};
#pragma unroll
            for (int q = 0; q < 4; ++q) { d = __builtin_amdgcn_fdot2(fp8lo_to_h2(w4[q]), hh[2 * q], d, false); d = __builtin_amdgcn_fdot2(fp8hi_to_h2(w4[q]), hh[2 * q + 1], d, false); }
            z[gq] = d; }
        float z8[8], z4[4], z2[2];
        { const bool b = ch & 4;
#pragma unroll
          for (int i = 0; i < 8; ++i) { const float keep = b ? z[8 + i] : z[i], send = b ? z[i] : z[8 + i]; z8[i] = keep + __shfl_xor(send, 4); } }
        { const bool b = ch & 2;
#pragma unroll
          for (int i = 0; i < 4; ++i) { const float keep = b ? z8[4 + i] : z8[i], send = b ? z8[i] : z8[4 + i]; z4[i] = keep + __shfl_xor(send, 2); } }
        { const bool b = ch & 1;
#pragma unroll
          for (int i = 0; i < 2; ++i) { const float keep = b ? z4[2 + i] : z4[i], send = b ? z4[i] : z4[2 + i]; z2[i] = keep + __shfl_xor(send, 1); } }
        *(float2*)(PART + ((size_t)t * 8 + x) * 128 + rg * 16 + 2 * ch) = make_float2(z2[0], z2[1]);
    }
}
__device__ __forceinline__ void p11b_weights(const Params& P, int tid) {
    const float* PART = (const float*)(P.ws + WS_PART); float* GW = (float*)(P.ws + WS_GATE);
    for (size_t i = (size_t)blockIdx.x * 512 + tid; i < (size_t)NTOK * 128; i += (size_t)gridDim.x * 512) {
        const size_t t = i >> 7, pos = i & 127; float zs = 0.f;
#pragma unroll
        for (int x = 0; x < 8; ++x) zs += PART[(t * 8 + x) * 128 + pos];
        const float zv = zs * (1.0f / SCALE_U);
        GW[i] = GW[i] * 0.5f * zv * (1.0f + erff(zv * 0.70710678118654752f));
    }
}
__device__ __forceinline__ void p11c_vacc(const Params& P, int lane, int wave) {
    const unsigned char* V8 = P.ws + WS_V8; const int* IDX = (const int*)(P.ws + WS_IDX); const float* GW = (const float*)(P.ws + WS_GATE);
    float* X = P.out; float* SSQ = (float*)(P.ws + WS_SSQ); bf16* XG = (bf16*)(P.ws + WS_HN2); const float* gple = P.in[16];
    const int x = blockIdx.x & 7, wgx = blockIdx.x >> 3, nwg = gridDim.x >> 3, rg = lane >> 3, ch = lane & 7;
    const float2 gp = *(const float2*)(gple + 128 * x + 16 * ch + 2 * rg);
    for (int t = wgx * NW + wave; t < NTOK; t += nwg * NW) {
        int e[16]; float w[16];
#pragma unroll
        for (int q = 0; q < 4; ++q) { const int4 v = *(const int4*)(IDX + (size_t)t * 128 + rg * 16 + 4 * q); e[4 * q] = v.x; e[4 * q + 1] = v.y; e[4 * q + 2] = v.z; e[4 * q + 3] = v.w;
            const float4 wv = *(const float4*)(GW + (size_t)t * 128 + rg * 16 + 4 * q); w[4 * q] = wv.x; w[4 * q + 1] = wv.y; w[4 * q + 2] = wv.z; w[4 * q + 3] = wv.w; }
        v4u vd[16];
#pragma unroll
        for (int gq = 0; gq < 16; ++gq) vd[gq] = *(const v4u*)(V8 + (size_t)e[gq] * 1024 + 128 * x + 16 * ch);
        const float2 xo = *(const float2*)(X + (size_t)t * 1024 + 128 * x + 16 * ch + 2 * rg);
        f16x2 acc[8];
#pragma unroll
        for (int i = 0; i < 8; ++i) acc[i] = (f16x2){(_Float16)0.f, (_Float16)0.f};
#pragma unroll
        for (int gq = 0; gq < 16; ++gq) { const f16x2 ww = __builtin_bit_cast(f16x2, __builtin_amdgcn_cvt_pkrtz(w[gq], w[gq])); const unsigned w4[4] = {vd[gq].x, vd[gq].y, vd[gq].z, vd[gq].w};
#pragma unroll
            for (int q = 0; q < 4; ++q) { acc[2 * q] = __builtin_elementwise_fma(fp8lo_to_h2(w4[q]), ww, acc[2 * q]); acc[2 * q + 1] = __builtin_elementwise_fma(fp8hi_to_h2(w4[q]), ww, acc[2 * q + 1]); } }
        f16x2 a4[4], a2[2], a1;
        { const bool b = rg & 4;
#pragma unroll
          for (int i = 0; i < 4; ++i) { const f16x2 keep = b ? acc[4 + i] : acc[i], send = b ? acc[i] : acc[4 + i]; a4[i] = keep + __builtin_bit_cast(f16x2, __shfl_xor(__builtin_bit_cast(int, send), 32)); } }
        { const bool b = rg & 2;
#pragma unroll
          for (int i = 0; i < 2; ++i) { const f16x2 keep = b ? a4[2 + i] : a4[i], send = b ? a4[i] : a4[2 + i]; a2[i] = keep + __builtin_bit_cast(f16x2, __shfl_xor(__builtin_bit_cast(int, send), 16)); } }
        { const bool b = rg & 1; const f16x2 keep = b ? a2[1] : a2[0], send = b ? a2[0] : a2[1]; a1 = keep + __builtin_bit_cast(f16x2, __shfl_xor(__builtin_bit_cast(int, send), 8)); }
        const float x0 = xo.x + (float)a1[0] * (1.0f / SCALE_V), x1 = xo.y + (float)a1[1] * (1.0f / SCALE_V);
        *(float2*)(X + (size_t)t * 1024 + 128 * x + 16 * ch + 2 * rg) = make_float2(x0, x1);
        *(unsigned*)(XG + (size_t)t * 1024 + 128 * x + 16 * ch + 2 * rg) = pk2(x0 * gp.x, x1 * gp.y);
        const float ss = wave_sum(x0 * x0 + x1 * x1);
        if (lane == 0) atomicAdd(SSQ + t, ss);
    }
}

__global__ void __launch_bounds__(512, 2) mk_fwd(Params P) {
    extern __shared__ __attribute__((aligned(16))) unsigned char lds_raw[];
    cg::grid_group grid = cg::this_grid();
    LAS unsigned char* lds = (LAS unsigned char*)lds_raw;
    const int tid = threadIdx.x, lane = tid & 63, wave = __builtin_amdgcn_readfirstlane(tid >> 6);
    const int lo = P.ph_lo, hi = P.ph_hi, G = gridDim.x, bx = blockIdx.x;
    unsigned char* ws = P.ws;
    const int gw = bx * NW + wave, NGW = G * NW;
#ifndef PH_MASK
#define PH_MASK 0xffff
#endif
#define IN(k) (((PH_MASK >> (k)) & 1) && lo <= (k) && (k) < hi)
#define SYNC_AFTER(k) do { if (IN(k) && IN((k) + 1)) grid.sync(); } while (0)
    typedef pg8::bf16_t pb;
    if (IN(0)) p0_prologue(P, lds, tid, lane, wave);
    SYNC_AFTER(0);
    if (IN(1)) {
        pg8::Gemm g{(const pb*)(ws + WS_XN), (const pb*)(ws + WS_W1T), NTOK, 5632, 1024}; pg8::StaticOrder S; S.init(NTOK, 5632, G, bx);
        pg8::EpiProj E{(pb*)(ws + WS_QKVA), (pb*)(ws + WS_QKM), (pb*)(ws + WS_VM), (pb*)(ws + WS_OM), (pb*)(ws + WS_G), C2};
        pg8::gemm_phase<pg8::EpiProj, pg8::StaticOrder, true, true>(lds, g, S, E);
    }
    SYNC_AFTER(1);
    if (IN(2)) { p2_attention(P, lds, lane, wave); __syncthreads(); p2_mlstm_local(P, lds, tid, lane, wave); }
    SYNC_AFTER(2);
    if (IN(3)) p3_mlstm_scan(P, tid);
    SYNC_AFTER(3);
    if (IN(4)) p4_mlstm_out(P, lds, tid, lane, wave);
    SYNC_AFTER(4);
    if (IN(5)) {
        pg8::Gemm g{(const pb*)(ws + WS_YA), (const pb*)(ws + WS_WAT), NTOK, 1024, 512}; pg8::StaticOrder S; S.init(NTOK, 1024, G, bx);
        pg8::EpiGated<false> E{(pb*)(ws + WS_TMP), nullptr, (const pb*)(ws + WS_G), 0};
        pg8::gemm_phase<pg8::EpiGated<false>, pg8::StaticOrder, true, true>(lds, g, S, E);
    }
    if (IN(5) && IN(6)) { asm volatile("s_waitcnt vmcnt(0)" ::: "memory"); __syncthreads(); }
    if (IN(6)) {
        pg8::Gemm g{(const pb*)(ws + WS_YM), (const pb*)(ws + WS_WMT), NTOK, 1024, 512}; pg8::StaticOrder S; S.init(NTOK, 1024, G, bx);
        pg8::EpiGated<true> E{(pb*)(ws + WS_MERGED), (const pb*)(ws + WS_TMP), (const pb*)(ws + WS_G), 1024};
        pg8::gemm_phase<pg8::EpiGated<true>, pg8::StaticOrder, true, true>(lds, g, S, E);
    }
    SYNC_AFTER(6);
    if (IN(7)) {
        pg8::Gemm g{(const pb*)(ws + WS_MERGED), (const pb*)(ws + WS_WOT), NTOK, 1024, 1024}; pg8::StaticOrder S; S.init(NTOK, 1024, G, bx);
        pg8::EpiResidual E{P.in[0], P.out};
        pg8::gemm_phase<pg8::EpiResidual, pg8::StaticOrder, true, true>(lds, g, S, E);
    }
    SYNC_AFTER(7);
    if (IN(8)) {
        for (int m = gw; m < NTOK; m += NGW) rms_row_to_bf16(P.out + (size_t)m * 1024, P.in[10], (bf16*)(ws + WS_HN) + (size_t)m * 1024, lane);
        cvt_f32_bf16(P.in[1], (bf16*)(ws + WS_PB), (size_t)NTOK * 256 / 4, (size_t)bx * 512 + tid, (size_t)G * 512);
        for (int i = bx * 512 + tid; i < NTOK; i += G * 512) ((float*)(ws + WS_SSQ))[i] = 0.f;
    }
    SYNC_AFTER(8);
    if (IN(9)) {
        pg8::Gemm g{(const pb*)(ws + WS_HN), (const pb*)(ws + WS_WQT), NTOK, 2048, 1024}; pg8::StaticOrder S; S.init(NTOK, 2048, G, bx);
        pg8::EpiStore E{(pb*)(ws + WS_Q2), 2048};
        pg8::gemm_phase<pg8::EpiStore, pg8::StaticOrder, true, true>(lds, g, S, E);
    }
    SYNC_AFTER(9);
    if (IN(10)) p10_topk(P, lds, tid, lane, wave);
    SYNC_AFTER(10);
    if (IN(11)) { p11a_udot(P, lane, wave); grid.sync(); p11b_weights(P, tid); grid.sync(); p11c_vacc(P, lane, wave); }
    SYNC_AFTER(11);
    if (IN(12)) {
        pg8::Gemm g{(const pb*)(ws + WS_PB), (const pb*)(ws + WS_WPT), NTOK, 1024, 256}; pg8::StaticOrder S; S.init(NTOK, 1024, G, bx);
        pg8::EpiStore E{(pb*)(ws + WS_E), 1024};
        pg8::gemm_phase<pg8::EpiStore, pg8::StaticOrder, true, true>(lds, g, S, E);
    }
    if (IN(12) && IN(13)) { asm volatile("s_waitcnt vmcnt(0)" ::: "memory"); __syncthreads(); }
    if (IN(13)) {
        pg8::Gemm g{(const pb*)(ws + WS_HN2), (const pb*)(ws + WS_WGT), NTOK, 1024, 1024}; pg8::StaticOrder S; S.init(NTOK, 1024, G, bx);
        pg8::EpiPle E{P.out, (const pb*)(ws + WS_E), (const float*)(ws + WS_SSQ)};
        pg8::gemm_phase<pg8::EpiPle, pg8::StaticOrder, true, true>(lds, g, S, E);
    }
    SYNC_AFTER(13);
    if (IN(14)) {
        const float* gf = P.in[19];
        for (int m = gw; m < NTOK; m += NGW) {
            float* xr = P.out + (size_t)m * 1024; f32x4 v[4]; float s = 0.f;
#pragma unroll
            for (int j = 0; j < 4; ++j) { v[j] = ((const f32x4*)xr)[lane + 64 * j]; s += (v[j][0] * v[j][0] + v[j][1] * v[j][1]) + (v[j][2] * v[j][2] + v[j][3] * v[j][3]); }
            const float rstd = rsqrtf(wave_sum(s) * (1.f / 1024.f) + EPS);
#pragma unroll
            for (int j = 0; j < 4; ++j) { const f32x4 g = ((const f32x4*)gf)[lane + 64 * j]; ((f32x4*)xr)[lane + 64 * j] = v[j] * rstd * g; }
        }
    }
}

extern "C" void kernel_launch(void* const* d_in, const int* in_sizes, int n_in, void* d_out, int out_size, void* d_ws, size_t ws_size, hipStream_t stream) {
    static int grid_blocks = 0;
    if (!grid_blocks) {
        int dev = 0, cus = 0, per_cu = 0;
        (void)hipGetDevice(&dev);
        (void)hipDeviceGetAttribute(&cus, hipDeviceAttributeMultiprocessorCount, dev);
        (void)hipFuncSetAttribute((const void*)mk_fwd, hipFuncAttributeMaxDynamicSharedMemorySize, LDS_BYTES);
        (void)hipOccupancyMaxActiveBlocksPerMultiprocessor(&per_cu, mk_fwd, 512, LDS_BYTES);
        if (per_cu > 1) per_cu = 1;
        grid_blocks = cus * per_cu;
    }
    if (n_in < 20 || ws_size < WS_NEED || grid_blocks <= 0) { fprintf(stderr, "kernel_launch: bad setup (n_in %d ws %zu grid %d)\n", n_in, ws_size, grid_blocks); return; }
    Params p{};
    for (int i = 0; i < 20; ++i) p.in[i] = (const float*)d_in[i];
    p.out = (float*)d_out; p.ws = (unsigned char*)d_ws; p.ph_lo = 0; p.ph_hi = 15;
    void* args[] = {&p};
    hipError_t e = hipLaunchCooperativeKernel((void*)mk_fwd, dim3(grid_blocks), dim3(512), args, LDS_BYTES, stream);
    if (e != hipSuccess) fprintf(stderr, "cooperative launch failed: %s (grid %d)\n", hipGetErrorString(e), grid_blocks);
}
```

```cpp
#include <hip/hip_runtime.h>
#include <hip/hip_cooperative_groups.h>
#include <cstdio>
#include <cstdint>
namespace cg = cooperative_groups;
namespace pg8 {
#define PG8_LAS __attribute__((address_space(3)))
typedef unsigned short bf16_t;
typedef short bf16x8 __attribute__((ext_vector_type(8)));
typedef float f32x4 __attribute__((ext_vector_type(4)));
typedef unsigned u32x4 __attribute__((ext_vector_type(4)));
constexpr int BM = 256, BK = 64, HALF = 128, HTB = HALF * BK * 2  , STAGE_BYTES = 8 * HTB, NXCD = 8, WGM = 8;

__host__ __device__ __forceinline__ int lds_byte(int r, int c) { const int st = (r >> 4) * 2 + (c >> 5), rr = r & 15, cc = c & 31, ob = rr * 64 + cc * 2; return st * 1024 + (ob ^ (((ob >> 9) & 1) << 5)); }
__host__ __device__ __forceinline__ void stage_rc(int b, int& R, int& C) { const int st = b / 1024, sb = b % 1024, swz = sb ^ (((sb >> 9) & 1) << 5); R = (st >> 1) * 16 + swz / 64; C = (st & 1) * 32 + (swz % 64) / 2; }
__host__ __device__ __forceinline__ int perm32(int rho) { const int n = rho >> 4, i = rho & 15; return 8 * (i >> 2) + 4 * n + (i & 3); }

struct Unit { int pm, pn; };
struct Gemm { const bf16_t* A; const bf16_t* Bt; int M, N, K; };

struct StaticOrder {
    int nM, nN, nwg, G, c;
    __host__ __device__ void init(int M, int N, int G_, int c_) { nM = M / BM; nN = N / BM; nwg = nM * nN; G = G_; c = c_; }
    __host__ __device__ bool next(int i, Unit& u) const {
        const long L = (long)i * G + c; if (L >= nwg) return false;
        int wgid = (int)L; { const int q = nwg / NXCD, r = nwg % NXCD, xcd = wgid % NXCD, off = wgid / NXCD; wgid = (xcd < r ? xcd * (q + 1) : r * (q + 1) + (xcd - r) * q) + off; }
        const int nig = WGM * nN, gid = wgid / nig, fm = gid * WGM, gsz = (nM - fm) < WGM ? (nM - fm) : WGM;
        u.pm = fm + ((wgid % nig) % gsz); u.pn = (wgid % nig) / gsz; return true;
    }
    __device__ __forceinline__ void a_ready(const Unit&) const {}
    __device__ __forceinline__ void done(const Unit&) const {}
};

__device__ __forceinline__ unsigned cvt_pk_bf16(float lo, float hi) { unsigned r; asm volatile("v_cvt_pk_bf16_f32 %0, %1, %2" : "=v"(r) : "v"(lo), "v"(hi)); return r; }
typedef float f32x2 __attribute__((ext_vector_type(2)));

__device__ __forceinline__ float sigm(float x) { return 1.0f / (1.0f + __expf(-x)); }
__device__ __forceinline__ float bf_lo(unsigned w) { return __uint_as_float(w << 16); }
__device__ __forceinline__ float bf_hi(unsigned w) { return __uint_as_float(w & 0xffff0000u); }
__device__ __forceinline__ u32x4 pack8(const f32x4& v0, const f32x4& v1) { u32x4 w; w.x = cvt_pk_bf16(v0[0], v0[1]); w.y = cvt_pk_bf16(v0[2], v0[3]); w.z = cvt_pk_bf16(v1[0], v1[1]); w.w = cvt_pk_bf16(v1[2], v1[3]); return w; }
__device__ __forceinline__ void unpack8(const u32x4& w, f32x4& v0, f32x4& v1) { v0[0] = bf_lo(w.x); v0[1] = bf_hi(w.x); v0[2] = bf_lo(w.y); v0[3] = bf_hi(w.y); v1[0] = bf_lo(w.z); v1[1] = bf_hi(w.z); v1[2] = bf_lo(w.w); v1[3] = bf_hi(w.w); }

#define PG8_EPI_WALK(...) \
    _Pragma("unroll") for (int ai = 0; ai < 2; ++ai) _Pragma("unroll") for (int m = 0; m < 4; ++m) { const int row = u.pm * BM + wr * 64 + fr + ai * HALF + m * 16; \
        _Pragma("unroll") for (int bj = 0; bj < 2; ++bj) { const int ct = bj * HALF + wc * 32 + 8 * fq; f32x4 v0 = acc[ai][bj][m][0], v1 = acc[ai][bj][m][1]; __VA_ARGS__ } }

struct EpiProj {
    static constexpr bool PERM = true, AFTER_DRAIN = false;
    bf16_t *qkva, *qkm, *vm, *om, *g; float c2;
    __device__ __forceinline__ void operator()(const f32x4 (&acc)[2][2][4][2], const Unit& u, int wr, int wc, int fr, int fq) const {
        const int pn = u.pn; bf16_t* base; int ldc, colt, mode = 0; float sc = 1.f;
        if (pn < 6) { base = qkva; ldc = 1536; colt = pn * 256; if (pn < 2) sc = c2; }
        else if (pn < 10) { base = qkm; ldc = 1024; colt = (pn - 6) * 256; }
        else if (pn < 12) { base = vm; ldc = 512; colt = (pn - 10) * 256; }
        else if (pn < 14) { base = om; ldc = 512; colt = (pn - 12) * 256; mode = 1; }
        else { base = g; ldc = 2048; colt = (pn - 14) * 256; mode = 1; }
        PG8_EPI_WALK({
            if (mode == 1) { _Pragma("unroll") for (int i = 0; i < 4; ++i) { v0[i] = sigm(v0[i]); v1[i] = sigm(v1[i]); } }
            else { v0 = v0 * sc; v1 = v1 * sc; }
            *(u32x4*)(base + (size_t)row * ldc + colt + ct) = pack8(v0, v1);
        })
    }
};
struct EpiStore {
    static constexpr bool PERM = true, AFTER_DRAIN = false;
    bf16_t* O; int ldc;
    __device__ __forceinline__ void operator()(const f32x4 (&acc)[2][2][4][2], const Unit& u, int wr, int wc, int fr, int fq) const {
        PG8_EPI_WALK({ *(u32x4*)(O + (size_t)row * ldc + u.pn * BM + ct) = pack8(v0, v1); })
    }
};
template <bool ADD> struct EpiGated {
    static constexpr bool PERM = true, AFTER_DRAIN = false;
    bf16_t* O; const bf16_t* prev; const bf16_t* gate; int gcol0;
    __device__ __forceinline__ void operator()(const f32x4 (&acc)[2][2][4][2], const Unit& u, int wr, int wc, int fr, int fq) const {
        PG8_EPI_WALK({
            const int col = u.pn * BM + ct; f32x4 g0, g1; unpack8(*(const u32x4*)(gate + (size_t)row * 2048 + gcol0 + col), g0, g1);
            v0 = v0 * g0; v1 = v1 * g1;
            if (ADD) { f32x4 p0, p1; unpack8(*(const u32x4*)(prev + (size_t)row * 1024 + col), p0, p1); v0 = v0 + p0; v1 = v1 + p1; }
            *(u32x4*)(O + (size_t)row * 1024 + col) = pack8(v0, v1);
        })
    }
};
struct EpiResidual {
    static constexpr bool PERM = true, AFTER_DRAIN = false;
    const float* res; float* out; bf16_t* xa; const float* gain; float* ssq;
    __device__ __forceinline__ void operator()(const f32x4 (&acc)[2][2][4][2], const Unit& u, int wr, int wc, int fr, int fq) const {
#pragma unroll
        for (int ai = 0; ai < 2; ++ai)
#pragma unroll
            for (int m = 0; m < 4; ++m) { const int row = u.pm * BM + wr * 64 + fr + ai * HALF + m * 16; float s = 0.f;
#pragma unroll
                for (int bj = 0; bj < 2; ++bj) { const int ct = bj * HALF + wc * 32 + 8 * fq; f32x4 v0 = acc[ai][bj][m][0], v1 = acc[ai][bj][m][1];
                    const size_t o = (size_t)row * 1024 + u.pn * BM + ct; const f32x4 r0 = *(const f32x4*)(res + o), r1 = *(const f32x4*)(res + o + 4);
                    v0 = v0 + r0; v1 = v1 + r1; *(f32x4*)(out + o) = v0; *(f32x4*)(out + o + 4) = v1;
                    s += (v0[0] * v0[0] + v0[1] * v0[1]) + (v0[2] * v0[2] + v0[3] * v0[3]) + (v1[0] * v1[0] + v1[1] * v1[1]) + (v1[2] * v1[2] + v1[3] * v1[3]);
                    const f32x4 g0 = *(const f32x4*)(gain + u.pn * BM + ct), g1 = *(const f32x4*)(gain + u.pn * BM + ct + 4);
                    *(u32x4*)(xa + o) = pack8(v0 * g0, v1 * g1); }
                s += __shfl_xor(s, 16); s += __shfl_xor(s, 32);
                if (fq == 0) atomicAdd(ssq + row, s);
                asm volatile("" ::: "memory"); }
    }
};
struct EpiStoreScaled {
    static constexpr bool PERM = true, AFTER_DRAIN = false;
    bf16_t* O; int ldc; const float* ssq;
    __device__ __forceinline__ void operator()(const f32x4 (&acc)[2][2][4][2], const Unit& u, int wr, int wc, int fr, int fq) const {
        PG8_EPI_WALK({ const float rstd = rsqrtf(ssq[row] * (1.0f / 1024.0f) + 1e-6f); *(u32x4*)(O + (size_t)row * ldc + u.pn * BM + ct) = pack8(v0 * rstd, v1 * rstd); })
    }
};
struct EpiPle {
    static constexpr bool PERM = true, AFTER_DRAIN = false;
    float* xio; const bf16_t* e; const float* ssq;
    __device__ __forceinline__ void operator()(const f32x4 (&acc)[2][2][4][2], const Unit& u, int wr, int wc, int fr, int fq) const {
        PG8_EPI_WALK({
            const float rstd = rsqrtf(ssq[row] * (1.0f / 1024.0f) + 1e-6f); v0 = v0 * rstd; v1 = v1 * rstd;
            const size_t o = (size_t)row * 1024 + u.pn * BM + ct; f32x4 e0, e1; unpack8(*(const u32x4*)(e + o), e0, e1);
            const f32x4 r0 = *(const f32x4*)(xio + o), r1 = *(const f32x4*)(xio + o + 4);
            _Pragma("unroll") for (int i = 0; i < 4; ++i) { v0[i] = r0[i] + sigm(v0[i]) * e0[i]; v1[i] = r1[i] + sigm(v1[i]) * e1[i]; }
            *(f32x4*)(xio + o) = v0; *(f32x4*)(xio + o + 4) = v1;
        })
    }
};

template <class Epi, class Sched, bool ALIGN_EPI = false, bool SP2 = false>
__device__ __forceinline__ void gemm_phase(PG8_LAS unsigned char* lds, const Gemm g, const Sched& S, const Epi& E) {
    int tid_ = threadIdx.x; asm volatile("" : "+v"(tid_));
    const int tid = tid_, wid = __builtin_amdgcn_readfirstlane(tid >> 6), lane = tid & 63, wr = wid >> 2, wc = wid & 3, fr = lane & 15, fq = lane >> 4;
    int K_ = g.K; asm volatile("" : "+s"(K_));
    const int K = K_, nt = K / BK;
    unsigned voffA[2], voffB[2];
#pragma unroll
    for (int i = 0; i < 2; ++i) { int R, C; stage_rc(tid * 16 + i * 8192, R, C); const int Rb = Epi::PERM ? ((R & ~31) + perm32(R & 31)) : R;
        voffA[i] = (unsigned)(R * K + C) * 2u; voffB[i] = (unsigned)(Rb * K + C) * 2u; }
    const size_t kstep = (size_t)(BK * 2);
    const size_t hstep = (size_t)HALF * K * 2;
    const size_t tstep = 2 * hstep;
    const unsigned ldsw = (unsigned)wid * 1024u;
    const int aoff = lds_byte(wr * 64 + fr, fq * 8), boff = lds_byte(wc * 32 + fr, fq * 8);
#define PG8_SA(b, h) (((b) * 2 + (h)) * HTB)
#define PG8_SB(b, h) ((4 + (b) * 2 + (h)) * HTB)
#define PG8_STAGE(bufoff, gbase, voff) do { _Pragma("unroll") for (int _i = 0; _i < 2; ++_i) \
        __builtin_amdgcn_global_load_lds((const unsigned*)((const char*)(gbase) + (voff)[_i]), (PG8_LAS unsigned*)(lds + (bufoff) + ldsw + _i * 8192), 16, 0, 0); } while (0)
#define PG8_LDA(dst, b, h) do { _Pragma("unroll") for (int m = 0; m < 4; ++m) _Pragma("unroll") for (int k = 0; k < 2; ++k) dst[m][k] = *(const PG8_LAS bf16x8*)(lds + PG8_SA(b, h) + aoff + m * 2048 + k * 1024); } while (0)
#define PG8_LDB(dst, b, h) do { _Pragma("unroll") for (int n = 0; n < 2; ++n) _Pragma("unroll") for (int k = 0; k < 2; ++k) dst[n][k] = *(const PG8_LAS bf16x8*)(lds + PG8_SB(b, h) + boff + n * 2048 + k * 1024); } while (0)
#define PG8_MMA(ai, bj, At, Bt) do { __builtin_amdgcn_s_setprio(1); _Pragma("unroll") for (int m = 0; m < 4; ++m) _Pragma("unroll") for (int n = 0; n < 2; ++n) _Pragma("unroll") for (int k = 0; k < 2; ++k) \
        acc[ai][bj][m][n] = __builtin_amdgcn_mfma_f32_16x16x32_bf16(Bt[n][k], At[m][k], acc[ai][bj][m][n], 0, 0, 0); __builtin_amdgcn_s_setprio(0); } while (0)
#define PG8_WAIT_V(n) asm volatile("s_waitcnt vmcnt(" #n ")" ::: "memory")
#define PG8_WAIT_L(n) asm volatile("s_waitcnt lgkmcnt(" #n ")" ::: "memory")
#define PG8_BAR __builtin_amdgcn_s_barrier()
#define PG8_SCHED __builtin_amdgcn_sched_barrier(0)
    Unit cur, nxt; int ui = 0;
    if (!S.next(0, cur)) return;
    f32x4 acc[2][2][4][2];
#pragma unroll
    for (int a = 0; a < 2; ++a)
#pragma unroll
        for (int b = 0; b < 2; ++b)
#pragma unroll
            for (int m = 0; m < 4; ++m)
#pragma unroll
                for (int n = 0; n < 2; ++n) acc[a][b][m][n] = (f32x4){0.f, 0.f, 0.f, 0.f};
    bf16x8 At[4][2], B0[2][2], B1[2][2];
    const char* cA = (const char*)g.A + (size_t)cur.pm * tstep; const char* cB = (const char*)g.Bt + (size_t)cur.pn * tstep;
    S.a_ready(cur);
    if constexpr (SP2) {
        PG8_STAGE(PG8_SB(0, 0), cB, voffB); PG8_STAGE(PG8_SB(0, 1), cB + hstep, voffB); PG8_STAGE(PG8_SA(0, 0), cA, voffA); PG8_STAGE(PG8_SA(0, 1), cA + hstep, voffA);
        if (wr == 1) PG8_BAR;
        PG8_WAIT_V(2); PG8_BAR;
        PG8_STAGE(PG8_SB(1, 0), cB + kstep, voffB); PG8_STAGE(PG8_SA(1, 0), cA + kstep, voffA); PG8_STAGE(PG8_SB(1, 1), cB + hstep + kstep, voffB);
        PG8_WAIT_V(6); PG8_BAR;
    } else {
        PG8_STAGE(PG8_SB(0, 0), cB, voffB); PG8_STAGE(PG8_SA(0, 0), cA, voffA); PG8_STAGE(PG8_SB(0, 1), cB + hstep, voffB); PG8_STAGE(PG8_SA(0, 1), cA + hstep, voffA);
        if (wr == 1) PG8_BAR;
        PG8_WAIT_V(4); PG8_BAR;
        PG8_STAGE(PG8_SB(1, 0), cB + kstep, voffB); PG8_STAGE(PG8_SA(1, 0), cA + kstep, voffA); PG8_STAGE(PG8_SB(1, 1), cB + hstep + kstep, voffB);
        PG8_WAIT_V(6); PG8_BAR;
    }
    for (;;) {
        const bool has_next = S.next(ui + 1, nxt);
        const char* nA = has_next ? (const char*)g.A + (size_t)nxt.pm * tstep : cA; const char* nB = has_next ? (const char*)g.Bt + (size_t)nxt.pn * tstep : cB;
        for (int t = 0; t < nt; t += 2) {
            const bool last = (t == nt - 2);
            const char* a1 = cA + (size_t)(t + 1) * kstep;
            const char* a2 = last ? nA : cA + (size_t)(t + 2) * kstep; const char* b2 = last ? nB : cB + (size_t)(t + 2) * kstep;
            const char* a3 = a2 + kstep; const char* b3 = b2 + kstep;
            if (last && has_next) S.a_ready(nxt);
            if constexpr (SP2) {
            PG8_LDB(B0, 0, 0); PG8_LDB(B1, 0, 1); PG8_SCHED; PG8_LDA(At, 0, 0); PG8_STAGE(PG8_SA(1, 1), a1 + hstep, voffA);
            PG8_WAIT_V(8); PG8_WAIT_L(0); PG8_BAR; PG8_MMA(0, 0, At, B0); PG8_MMA(0, 1, At, B1); PG8_BAR; PG8_SCHED;
            PG8_LDA(At, 0, 1); PG8_STAGE(PG8_SB(0, 0), b2, voffB); PG8_STAGE(PG8_SB(0, 1), b2 + hstep, voffB); PG8_STAGE(PG8_SA(0, 0), a2, voffA);
            PG8_WAIT_V(8); PG8_WAIT_L(0); PG8_BAR; PG8_MMA(1, 0, At, B0); PG8_MMA(1, 1, At, B1); PG8_BAR; PG8_SCHED;
            PG8_LDB(B0, 1, 0); PG8_LDB(B1, 1, 1); PG8_SCHED; PG8_LDA(At, 1, 0); PG8_STAGE(PG8_SA(0, 1), a2 + hstep, voffA);
            PG8_WAIT_V(8); PG8_WAIT_L(0); PG8_BAR; PG8_MMA(0, 0, At, B0); PG8_MMA(0, 1, At, B1); PG8_BAR; PG8_SCHED;
            PG8_LDA(At, 1, 1); PG8_STAGE(PG8_SB(1, 0), b3, voffB); PG8_STAGE(PG8_SB(1, 1), b3 + hstep, voffB); PG8_STAGE(PG8_SA(1, 0), a3, voffA);
            PG8_WAIT_V(8); PG8_WAIT_L(0); PG8_BAR; PG8_MMA(1, 0, At, B0); PG8_MMA(1, 1, At, B1); PG8_BAR; PG8_SCHED;
            } else {
            PG8_LDB(B0, 0, 0); PG8_SCHED; PG8_LDA(At, 0, 0); PG8_STAGE(PG8_SA(1, 1), a1 + hstep, voffA);
            PG8_WAIT_L(8); PG8_BAR; PG8_WAIT_L(0); PG8_MMA(0, 0, At, B0); PG8_BAR; PG8_SCHED;
            PG8_LDB(B1, 0, 1); PG8_STAGE(PG8_SB(0, 0), b2, voffB);
            PG8_BAR; PG8_WAIT_L(0); PG8_MMA(0, 1, At, B1); PG8_BAR;
            PG8_LDA(At, 0, 1); PG8_STAGE(PG8_SA(0, 0), a2, voffA);
            PG8_BAR; PG8_WAIT_L(0); PG8_MMA(1, 0, At, B0); PG8_BAR; PG8_SCHED;
            PG8_STAGE(PG8_SB(0, 1), b2 + hstep, voffB);
            PG8_WAIT_V(6); PG8_BAR; PG8_MMA(1, 1, At, B1); PG8_BAR;
            PG8_LDB(B0, 1, 0); PG8_SCHED; PG8_LDA(At, 1, 0); PG8_STAGE(PG8_SA(0, 1), a2 + hstep, voffA);
            PG8_WAIT_L(8); PG8_BAR; PG8_WAIT_L(0); PG8_MMA(0, 0, At, B0); PG8_BAR; PG8_SCHED;
            PG8_LDB(B1, 1, 1); PG8_STAGE(PG8_SB(1, 0), b3, voffB);
            PG8_BAR; PG8_WAIT_L(0); PG8_MMA(0, 1, At, B1); PG8_BAR;
            PG8_LDA(At, 1, 1); PG8_STAGE(PG8_SA(1, 0), a3, voffA);
            PG8_BAR; PG8_WAIT_L(0); PG8_MMA(1, 0, At, B0); PG8_BAR; PG8_SCHED;
            PG8_STAGE(PG8_SB(1, 1), b3 + hstep, voffB);
            PG8_WAIT_V(6); PG8_BAR; PG8_MMA(1, 1, At, B1); PG8_BAR;
            }
        }
        if constexpr (ALIGN_EPI) { if (wr == 0) PG8_BAR; }
        if constexpr (!Epi::AFTER_DRAIN) { E(acc, cur, wr, wc, fr, fq); S.done(cur); }
        if (!has_next) break;
#pragma unroll
        for (int a = 0; a < 2; ++a)
#pragma unroll
            for (int b = 0; b < 2; ++b)
#pragma unroll
                for (int m = 0; m < 4; ++m)
#pragma unroll
                    for (int n = 0; n < 2; ++n) acc[a][b][m][n] = (f32x4){0.f, 0.f, 0.f, 0.f};
        cur = nxt; cA = nA; cB = nB; ++ui;
        if constexpr (ALIGN_EPI) { if (wr == 1) PG8_BAR; }
    }
    PG8_WAIT_V(0);
    if constexpr (!ALIGN_EPI) { if (wr == 0) PG8_BAR; }
    PG8_BAR;
    if constexpr (Epi::AFTER_DRAIN) { E.fused(acc, cur, wr, wc, fr, fq, lds, wid, lane); S.done(cur); }
#undef PG8_SA
#undef PG8_SB
#undef PG8_STAGE
#undef PG8_LDA
#undef PG8_LDB
#undef PG8_MMA
#undef PG8_WAIT_V
#undef PG8_WAIT_L
#undef PG8_BAR
#undef PG8_SCHED
}
}

#define GAS __attribute__((address_space(1)))
#define LAS __attribute__((address_space(3)))
typedef unsigned short bf16;
typedef unsigned v4u __attribute__((ext_vector_type(4)));
typedef unsigned v2u __attribute__((ext_vector_type(2)));
typedef float f32x4 __attribute__((ext_vector_type(4)));
using pg8::bf_lo; using pg8::bf_hi; using pg8::sigm;

constexpr int NTOK = 32768, SEQ = 16384, DM = 1024, NW = 8;
constexpr float EPS = 1e-6f;
constexpr float C2 = 0.125f * 1.4426950408889634f;
constexpr size_t MiB = 1u << 20;
constexpr size_t WS_W1T = 1 * MiB, WS_WAT = 12 * MiB, WS_WMT = 13 * MiB, WS_WOT = 14 * MiB, WS_WQT = 16 * MiB, WS_WGT = 20 * MiB, WS_WPT = 22 * MiB;
constexpr size_t WS_K1B = 22 * MiB + 512 * 1024, WS_K2B = 22 * MiB + 768 * 1024, WS_IF = 23 * MiB, WS_UB = 24 * MiB, WS_VB = 56 * MiB;
constexpr size_t WS_XN = 88 * MiB, WS_YA = 88 * MiB, WS_YM = 120 * MiB, WS_HN = 88 * MiB;
constexpr size_t WS_QKVA = 152 * MiB, WS_QKM = 248 * MiB, WS_VM = 312 * MiB, WS_OM = 344 * MiB, WS_G = 376 * MiB;
constexpr size_t WS_DN = 504 * MiB, WS_NS = 505 * MiB, WS_SC = 506 * MiB;
constexpr size_t WS_MERGED = 152 * MiB, WS_TMP = 216 * MiB, WS_Q2 = 376 * MiB, WS_IDX = 152 * MiB, WS_GATE = 168 * MiB, WS_HN2 = 184 * MiB, WS_PB = 56 * MiB, WS_E = 264 * MiB;
constexpr size_t WS_NEED = 507 * MiB;
constexpr size_t WS_U8 = 24 * MiB, WS_V8 = 40 * MiB, WS_PART = 376 * MiB, WS_SSQ = 506 * MiB + 512 * 1024;
constexpr float SCALE_U = 256.f, SCALE_V = 16.f;
constexpr size_t WS_SSQ1 = 506 * MiB + 768 * 1024, WS_BAR = 0, BAR_BYTES = 16384;
constexpr size_t OUT_DC = 0, OUT_CS = 64 * MiB;
constexpr int LDS_BYTES = 147456;

__device__ __forceinline__ unsigned f2bf(float f) { unsigned u = __float_as_uint(f); return (u + 0x7fffu + ((u >> 16) & 1u)) >> 16; }
__device__ __forceinline__ unsigned pk2(float lo, float hi) { return f2bf(lo) | (f2bf(hi) << 16); }
__device__ __forceinline__ float bf2f(bf16 b) { return __uint_as_float((unsigned)b << 16); }
__device__ __forceinline__ float wave_sum(float v) {
#pragma unroll
    for (int o = 1; o < 64; o <<= 1) v += __shfl_xor(v, o);
    return v;
}
__device__ __forceinline__ void unpk8(const v4u w, float* f) { f[0] = bf_lo(w.x); f[1] = bf_hi(w.x); f[2] = bf_lo(w.y); f[3] = bf_hi(w.y); f[4] = bf_lo(w.z); f[5] = bf_hi(w.z); f[6] = bf_lo(w.w); f[7] = bf_hi(w.w); }
__device__ __forceinline__ v4u pk8(const float* f) { v4u w; w.x = pk2(f[0], f[1]); w.y = pk2(f[2], f[3]); w.z = pk2(f[4], f[5]); w.w = pk2(f[6], f[7]); return w; }
typedef __bf16 bf16x2_t __attribute__((ext_vector_type(2)));
__device__ __forceinline__ float dot2bf(unsigned a, unsigned b, float c) { return __builtin_amdgcn_fdot2_f32_bf16(__builtin_bit_cast(bf16x2_t, a), __builtin_bit_cast(bf16x2_t, b), c, false); }
__device__ __forceinline__ float logsigmoid(float x) { return fminf(x, 0.f) - log1pf(__expf(-fabsf(x))); }
__device__ __forceinline__ float silu(float x) { return x / (1.0f + __expf(-x)); }

#define XB_TMO      128
#define XB_XCNT(j)  (256  + 64 * (j))
#define XB_XSUB(j)  (1280 + 64 * (j))
#define XB_XGEN(j)  (2304 + 64 * (j))
#define XB_TOP      3328
#define XB_TOPGEN   3392
#define XCD_BAR_WORDS 3456
#define XB_SPIN_CAP (1u << 18)

__device__ __forceinline__ unsigned xb_ld(unsigned* p)              { return __hip_atomic_load(p, __ATOMIC_RELAXED, __HIP_MEMORY_SCOPE_AGENT); }
__device__ __forceinline__ unsigned xb_add(unsigned* p, unsigned v) { return __hip_atomic_fetch_add(p, v, __ATOMIC_RELAXED, __HIP_MEMORY_SCOPE_AGENT); }
__device__ __forceinline__ unsigned xb_xcc_id() { return (unsigned)__builtin_amdgcn_s_getreg((3 << 11) | 20) & 0xFu; }
#define XB_SPIN(cond, bar) do { unsigned _sp = 0; while (cond) { __builtin_amdgcn_s_sleep(1); \
    if ((++_sp & 255u) == 0u) { if (xb_ld(&(bar)[XB_TMO])) break; if (_sp > XB_SPIN_CAP) { atomicAdd(&(bar)[XB_TMO], 1u); break; } } } } while (0)

struct XcdBarrier {
    unsigned* bar; unsigned x;
    volatile LAS unsigned* st;
};

__device__ __forceinline__ XcdBarrier xcd_barrier_post(unsigned* bar, volatile LAS unsigned* st) {
    XcdBarrier b; b.bar = bar; b.x = xb_xcc_id(); b.st = st;
    if (threadIdx.x == 0) (void)xb_add(&bar[XB_XCNT(b.x)], 1u);
    return b;
}
__device__ __forceinline__ void xcd_barrier_complete(unsigned* bar, unsigned x, unsigned& nloc, unsigned& nx) {
    const unsigned G = gridDim.x * gridDim.y * gridDim.z;
    unsigned sum, cnt, mine, sp = 0u;
    for (;;) {
        sum = 0u; cnt = 0u; mine = 0u;
#pragma unroll
        for (unsigned j = 0; j < 16; ++j) { const unsigned c = xb_ld(&bar[XB_XCNT(j)]); sum += c; cnt += (c > 0u) ? 1u : 0u; mine = (j == x) ? c : mine; }
        if (sum == G) break;
        __builtin_amdgcn_s_sleep(1);
        if ((++sp & 255u) == 0u) { if (xb_ld(&bar[XB_TMO])) break; if (sp > XB_SPIN_CAP) { atomicAdd(&bar[XB_TMO], 1u); break; } }
    }
    nloc = mine > 0u ? mine : 1u; nx = cnt > 0u ? cnt : 1u;
}

__device__ __forceinline__ void xcd_barrier(const XcdBarrier& b) {
    asm volatile("s_waitcnt vmcnt(0)" ::: "memory");
    __syncthreads();
    if (threadIdx.x == 0) {
        unsigned* bar = b.bar;
        __builtin_amdgcn_s_waitcnt(0);
        unsigned nloc = b.st[0], nx = b.st[1];
        if (nloc == 0u) { xcd_barrier_complete(bar, b.x, nloc, nx); b.st[0] = nloc; b.st[1] = nx; }
        const unsigned old = xb_add(&bar[XB_XSUB(b.x)], 1u);
        const unsigned gen = old / nloc;
        if (old + 1u == (gen + 1u) * nloc) {
            __builtin_amdgcn_fence(__ATOMIC_RELEASE, "agent");
            asm volatile("s_waitcnt vmcnt(0)" ::: "memory");
            const unsigned og = xb_add(&bar[XB_TOP], 1u);
            const unsigned tg = og / nx;
            if (og + 1u == (tg + 1u) * nx) xb_add(&bar[XB_TOPGEN], 1u);
            else XB_SPIN(xb_ld(&bar[XB_TOPGEN]) == tg, bar);
            __builtin_amdgcn_fence(__ATOMIC_ACQUIRE, "agent");
            xb_add(&bar[XB_XGEN(b.x)], 1u);
            asm volatile("s_waitcnt vmcnt(0)" ::: "memory");
        } else {
            XB_SPIN(xb_ld(&bar[XB_XGEN(b.x)]) == gen, bar);
            __builtin_amdgcn_fence(__ATOMIC_ACQUIRE, "agent");
            asm volatile("s_waitcnt vmcnt(0)" ::: "memory");
        }
    }
    __syncthreads();
}


struct Params { const float* in[20]; float* out; unsigned char* ws; int ph_lo, ph_hi; };

__device__ __forceinline__ void transpose_item(const float* W, int ldw, int col0, int K, bf16* WT, int row0, LAS float* scr, int item, int nblk, int lane) {
    const int kb = item / nblk, nb = item % nblk, k0 = 64 * kb, n0 = 32 * nb;
#pragma unroll 8
    for (int i = 0; i < 32; ++i) { const int kk = 2 * i + (lane >> 5); scr[kk * 33 + (lane & 31)] = W[(size_t)(k0 + kk) * ldw + col0 + n0 + (lane & 31)]; }
    asm volatile("s_waitcnt lgkmcnt(0)" ::: "memory");
    const int c = lane & 7;
#pragma unroll
    for (int j = 0; j < 4; ++j) { const int n = (lane >> 3) + 8 * j; const LAS float* s = scr + (8 * c) * 33 + n;
        v4u o; o.x = pk2(s[0 * 33], s[1 * 33]); o.y = pk2(s[2 * 33], s[3 * 33]); o.z = pk2(s[4 * 33], s[5 * 33]); o.w = pk2(s[6 * 33], s[7 * 33]);
        *(v4u*)(WT + (size_t)(row0 + n0 + n) * K + k0 + 8 * c) = o; }
    asm volatile("s_waitcnt lgkmcnt(0)" ::: "memory");
}
__device__ __forceinline__ void cvt_f32_bf16(const float* src, bf16* dst, size_t n4, size_t gtid, size_t gsz) {
    for (size_t i = gtid; i < n4; i += gsz) { const f32x4 v = ((const f32x4*)src)[i]; uint2 o; o.x = pk2(v[0], v[1]); o.y = pk2(v[2], v[3]); ((uint2*)dst)[i] = o; }
}
__device__ __forceinline__ void cvt_f32_fp8(const float* src, unsigned* dst, size_t n4, float sc, size_t gtid, size_t gsz) {
    for (size_t i = gtid; i < n4; i += gsz) { const f32x4 v = ((const f32x4*)src)[i]; int w = __builtin_amdgcn_cvt_pk_fp8_f32(v[0] * sc, v[1] * sc, 0, false); w = __builtin_amdgcn_cvt_pk_fp8_f32(v[2] * sc, v[3] * sc, w, true); dst[i] = (unsigned)w; }
}
__device__ __forceinline__ void rms_row_to_bf16(const float* xrow, const float* gain, bf16* orow, int lane) {
    f32x4 v[4]; float s = 0.f;
#pragma unroll
    for (int j = 0; j < 4; ++j) { v[j] = ((const f32x4*)xrow)[lane + 64 * j]; s += (v[j][0] * v[j][0] + v[j][1] * v[j][1]) + (v[j][2] * v[j][2] + v[j][3] * v[j][3]); }
    const float rstd = rsqrtf(wave_sum(s) * (1.f / 1024.f) + EPS);
#pragma unroll
    for (int j = 0; j < 4; ++j) { const f32x4 g = ((const f32x4*)gain)[lane + 64 * j]; uint2 o; o.x = pk2(v[j][0] * rstd * g[0], v[j][1] * rstd * g[1]); o.y = pk2(v[j][2] * rstd * g[2], v[j][3] * rstd * g[3]); ((uint2*)orow)[lane + 64 * j] = o; }
}
__device__ __forceinline__ void p0_prologue(const Params& P, LAS unsigned char* lds, int tid, int lane, int wave) {
    unsigned char* ws = P.ws;
    const int gw = blockIdx.x * NW + wave, NGW = gridDim.x * NW;
    LAS float* scr = (LAS float*)(lds + wave * 8448);
    LAS float* wif = (LAS float*)(lds + 69632);
    const float* w_in = P.in[3];
    for (int i = tid; i < 8192; i += 512) wif[i] = w_in[(size_t)(i >> 3) * 5640 + 3584 + (i & 7)];
    __syncthreads();
    constexpr int I1A = 16 * 112, I1B = 16 * 64, IUP = 8 * 32, IOUT = 16 * 32, IQ = 16 * 64, IPL = 4 * 32;
    constexpr int NITEMS = I1A + I1B + 2 * IUP + IOUT + IQ + IOUT + IPL;
    for (int it = gw; it < NITEMS; it += NGW) {
        int r = it;
        if (r < I1A) { transpose_item(w_in, 5640, 0, 1024, (bf16*)(ws + WS_W1T), 0, scr, r, 112, lane); continue; } r -= I1A;
        if (r < I1B) { transpose_item(w_in, 5640, 3592, 1024, (bf16*)(ws + WS_W1T), 3584, scr, r, 64, lane); continue; } r -= I1B;
        if (r < IUP) { transpose_item(P.in[7], 1024, 0, 512, (bf16*)(ws + WS_WAT), 0, scr, r, 32, lane); continue; } r -= IUP;
        if (r < IUP) { transpose_item(P.in[8], 1024, 0, 512, (bf16*)(ws + WS_WMT), 0, scr, r, 32, lane); continue; } r -= IUP;
        if (r < IOUT) { transpose_item(P.in[9], 1024, 0, 1024, (bf16*)(ws + WS_WOT), 0, scr, r, 32, lane); continue; } r -= IOUT;
        if (r < IQ) { transpose_item(P.in[11], 2048, 0, 1024, (bf16*)(ws + WS_WQT), 0, scr, r, 64, lane); continue; } r -= IQ;
        if (r < IOUT) { transpose_item(P.in[17], 1024, 0, 1024, (bf16*)(ws + WS_WGT), 0, scr, r, 32, lane); continue; } r -= IOUT;
        transpose_item(P.in[18], 1024, 0, 256, (bf16*)(ws + WS_WPT), 0, scr, r, 32, lane);
    }
    const size_t gtid = (size_t)blockIdx.x * 512 + tid, gsz = (size_t)gridDim.x * 512;
    cvt_f32_bf16(P.in[12], (bf16*)(ws + WS_K1B), 8 * 128 * 128 / 4, gtid, gsz);
    cvt_f32_bf16(P.in[13], (bf16*)(ws + WS_K2B), 8 * 128 * 128 / 4, gtid, gsz);
    cvt_f32_fp8(P.in[14], (unsigned*)(ws + WS_U8), (size_t)16384 * 1024 / 4, SCALE_U, gtid, gsz);
    cvt_f32_fp8(P.in[15], (unsigned*)(ws + WS_V8), (size_t)16384 * 1024 / 4, SCALE_V, gtid, gsz);
    cvt_f32_bf16(P.in[1], (bf16*)(ws + WS_PB), (size_t)NTOK * 256 / 4, gtid, gsz);
    for (size_t i = gtid; i < (size_t)NTOK; i += gsz) { ((float*)(ws + WS_SSQ))[i] = 0.f; ((float*)(ws + WS_SSQ1))[i] = 0.f; }
    const float* x = P.in[0]; const float* gmix = P.in[2]; const float* gbias = P.in[5];
    bf16* XN = (bf16*)(ws + WS_XN); float* IFb = (float*)(ws + WS_IF);
    for (int m = gw; m < NTOK; m += NGW) {
        const float* xrow = x + (size_t)m * 1024;
        f32x4 v[4]; float s = 0.f;
#pragma unroll
        for (int j = 0; j < 4; ++j) { v[j] = ((const f32x4*)xrow)[lane + 64 * j]; s += (v[j][0] * v[j][0] + v[j][1] * v[j][1]) + (v[j][2] * v[j][2] + v[j][3] * v[j][3]); }
        const float rstd = rsqrtf(wave_sum(s) * (1.f / 1024.f) + EPS);
        float a8[8] = {0.f, 0.f, 0.f, 0.f, 0.f, 0.f, 0.f, 0.f};
#pragma unroll
        for (int j = 0; j < 4; ++j) {
            const f32x4 g = ((const f32x4*)gmix)[lane + 64 * j];
#pragma unroll
            for (int i = 0; i < 4; ++i) { v[j][i] = v[j][i] * rstd * g[i]; const int d = 4 * (lane + 64 * j) + i; const f32x4 wa = *(const LAS f32x4*)(wif + d * 8), wb = *(const LAS f32x4*)(wif + d * 8 + 4);
                a8[0] += v[j][i] * wa[0]; a8[1] += v[j][i] * wa[1]; a8[2] += v[j][i] * wa[2]; a8[3] += v[j][i] * wa[3]; a8[4] += v[j][i] * wb[0]; a8[5] += v[j][i] * wb[1]; a8[6] += v[j][i] * wb[2]; a8[7] += v[j][i] * wb[3]; }
            uint2 o; o.x = pk2(v[j][0], v[j][1]); o.y = pk2(v[j][2], v[j][3]); ((uint2*)(XN + (size_t)m * 1024))[lane + 64 * j] = o;
        }
#pragma unroll
        for (int c = 0; c < 8; ++c) a8[c] = wave_sum(a8[c]);
        if (lane == 0) {
#pragma unroll
            for (int c = 0; c < 8; ++c) IFb[(size_t)m * 8 + c] = a8[c] + gbias[c];
        }
    }
}

typedef short bf16x8 __attribute__((ext_vector_type(8)));
typedef short v4i16 __attribute__((ext_vector_type(4)));
#define MFMA16(a, b, c) __builtin_amdgcn_mfma_f32_16x16x32_bf16((a), (b), (c), 0, 0, 0)
__device__ __forceinline__ void attn_pair_params(int pp, int& d, int& n0, int& sh) {
    if (pp < 5) { d = 16; sh = 4; n0 = -144 + 32 * pp; } else if (pp < 11) { d = 4; sh = 2; n0 = -128 + 32 * (pp - 5); } else { d = 1; sh = 0; n0 = -128 + 32 * (pp - 11); }
}
__device__ __forceinline__ void p2_attention(const Params& P, LAS unsigned char* lds, int lane, int wave) {
    const bf16* QKVA = (const bf16*)(P.ws + WS_QKVA); bf16* YA = (bf16*)(P.ws + WS_YA);
    LAS unsigned char* vbuf = lds + wave * 10240;
    const int r = lane & 15, g = lane >> 4, kk = lane & 31, half = lane >> 5;
    const int trq = (lane >> 2) & 3, trp = lane & 3;
    const int tr_off = (4 * g + trq) * 160 + trp * 8;
    for (int wi = blockIdx.x; wi < 1024; wi += gridDim.x) {
        const int bh = wi >> 6, tb = wi & 63, b = bh >> 3, h = bh & 7;
        const bf16* base = QKVA + (size_t)b * SEQ * 1536 + h * 64;
#pragma unroll 1
        for (int uu = 0; uu < 2; ++uu) {
            const int t0 = tb * 256 + wave * 2 + uu, tq = t0 + 16 * r;
            const bf16x8 qb0 = *(const bf16x8*)(base + (size_t)tq * 1536 + 8 * g), qb1 = *(const bf16x8*)(base + (size_t)tq * 1536 + 32 + 8 * g);
            f32x4 o[4];
#pragma unroll
            for (int i = 0; i < 4; ++i) o[i] = (f32x4){0.f, 0.f, 0.f, 0.f};
            float m = -1e30f, l = 0.f;
            bf16x8 kc[2][2], kn[2][2]; v4u vn[4];
            { int d, n0, sh; attn_pair_params(0, d, n0, sh);
#pragma unroll
              for (int blk = 0; blk < 2; ++blk) { int tok = t0 + d * (n0 + 16 * blk + r); tok = min(max(tok, 0), SEQ - 1); const bf16* kp = base + 512 + (size_t)tok * 1536 + 8 * g; kc[blk][0] = *(const bf16x8*)kp; kc[blk][1] = *(const bf16x8*)(kp + 32); }
              int tokv = t0 + d * (n0 + kk); tokv = min(max(tokv, 0), SEQ - 1); const bf16* vp = base + 1024 + (size_t)tokv * 1536 + 32 * half;
#pragma unroll
              for (int c = 0; c < 4; ++c) vn[c] = *(const v4u*)(vp + 8 * c);
#pragma unroll
              for (int c = 0; c < 4; ++c) *(LAS v4u*)(vbuf + kk * 160 + half * 64 + c * 16) = vn[c];
            }
#pragma unroll 1
            for (int pp = 0; pp < 23; ++pp) {
                int d, n0, sh; attn_pair_params(pp, d, n0, sh);
                { int dn, nn, shn; attn_pair_params(pp < 22 ? pp + 1 : pp, dn, nn, shn);
#pragma unroll
                  for (int blk = 0; blk < 2; ++blk) { int tok = t0 + dn * (nn + 16 * blk + r); tok = min(max(tok, 0), SEQ - 1); const bf16* kp = base + 512 + (size_t)tok * 1536 + 8 * g; kn[blk][0] = *(const bf16x8*)kp; kn[blk][1] = *(const bf16x8*)(kp + 32); }
                  int tokv = t0 + dn * (nn + kk); tokv = min(max(tokv, 0), SEQ - 1); const bf16* vp = base + 1024 + (size_t)tokv * 1536 + 32 * half;
#pragma unroll
                  for (int c = 0; c < 4; ++c) vn[c] = *(const v4u*)(vp + 8 * c);
                }
                const int hi = r << (4 - sh), lo = max(hi - 128, -(t0 >> sh));
                f32x4 s0 = {0.f, 0.f, 0.f, 0.f}, s1 = {0.f, 0.f, 0.f, 0.f};
                s0 = MFMA16(kc[0][0], qb0, s0); s0 = MFMA16(kc[0][1], qb1, s0);
                s1 = MFMA16(kc[1][0], qb0, s1); s1 = MFMA16(kc[1][1], qb1, s1);
                bool v0[4], v1[4]; float mx = -1e30f;
#pragma unroll
                for (int k = 0; k < 4; ++k) { const int na = n0 + 4 * g + k, nb = na + 16; v0[k] = (na >= lo) && (na <= hi); v1[k] = (nb >= lo) && (nb <= hi);
                    mx = fmaxf(mx, v0[k] ? s0[k] : -1e30f); mx = fmaxf(mx, v1[k] ? s1[k] : -1e30f); }
                mx = fmaxf(mx, __shfl_xor(mx, 16)); mx = fmaxf(mx, __shfl_xor(mx, 32));
                const float mn = fmaxf(m, mx), alpha = __builtin_amdgcn_exp2f(m - mn); m = mn;
                float p0[4], p1[4], ps = 0.f;
#pragma unroll
                for (int k = 0; k < 4; ++k) { p0[k] = v0[k] ? __builtin_amdgcn_exp2f(s0[k] - mn) : 0.f; p1[k] = v1[k] ? __builtin_amdgcn_exp2f(s1[k] - mn) : 0.f; ps += p0[k] + p1[k]; }
                l = l * alpha + ps;
#pragma unroll
                for (int i = 0; i < 4; ++i) o[i] = o[i] * alpha;
                bf16x8 pb; { v4u w; w.x = pk2(p0[0], p0[1]); w.y = pk2(p0[2], p0[3]); w.z = pk2(p1[0], p1[1]); w.w = pk2(p1[2], p1[3]); pb = __builtin_bit_cast(bf16x8, w); }
                LAS unsigned char* vb = vbuf + (pp & 1) * 5120 + tr_off;
#pragma unroll
                for (int db = 0; db < 4; ++db) {
                    const v4i16 a0 = __builtin_amdgcn_ds_read_tr16_b64_v4i16((LAS v4i16*)(vb + db * 32)), a1 = __builtin_amdgcn_ds_read_tr16_b64_v4i16((LAS v4i16*)(vb + 16 * 160 + db * 32));
                    bf16x8 va; va[0] = a0[0]; va[1] = a0[1]; va[2] = a0[2]; va[3] = a0[3]; va[4] = a1[0]; va[5] = a1[1]; va[6] = a1[2]; va[7] = a1[3];
                    o[db] = MFMA16(va, pb, o[db]);
                }
                LAS unsigned char* vw = vbuf + ((pp + 1) & 1) * 5120 + kk * 160 + half * 64;
#pragma unroll
                for (int c = 0; c < 4; ++c) *(LAS v4u*)(vw + c * 16) = vn[c];
#pragma unroll
                for (int blk = 0; blk < 2; ++blk) { kc[blk][0] = kn[blk][0]; kc[blk][1] = kn[blk][1]; }
            }
            l += __shfl_xor(l, 16); l += __shfl_xor(l, 32);
            const float inv = 1.0f / l;
            bf16* yo = YA + ((size_t)b * SEQ + tq) * 512 + h * 64 + 4 * g;
#pragma unroll
            for (int db = 0; db < 4; ++db) { uint2 w; w.x = pk2(o[db][0] * inv, o[db][1] * inv); w.y = pk2(o[db][2] * inv, o[db][3] * inv); *(uint2*)(yo + 16 * db) = w; }
        }
    }
}

__device__ __forceinline__ float conv_silu(const bf16* QKM, const float* cw, int b, int t, int ch) {
    float a = 0.f;
#pragma unroll
    for (int j = 0; j < 4; ++j) { const int tt = t - 3 + j; if (tt >= 0) a += cw[j * 1024 + ch] * bf2f(QKM[((size_t)b * SEQ + tt) * 1024 + ch]); }
    return silu(a);
}

__device__ __forceinline__ float scan_add(float v, int lane) {
#pragma unroll
    for (int o = 1; o < 64; o <<= 1) { const float u = __shfl_up(v, o); if (lane >= o) v += u; }
    return v;
}
__device__ __forceinline__ float scan_max(float v, int lane) {
#pragma unroll
    for (int o = 1; o < 64; o <<= 1) { const float u = __shfl_up(v, o); if (lane >= o) v = fmaxf(v, u); }
    return v;
}
__device__ __forceinline__ float wave_max(float v) {
#pragma unroll
    for (int o = 1; o < 64; o <<= 1) v = fmaxf(v, __shfl_xor(v, o));
    return v;
}
__device__ __forceinline__ void conv16(const bf16* QKM, const float* cw, int b, int t0, int chan, float* out) {
    const bf16* src = QKM + (size_t)b * SEQ * 1024 + chan;
    const float w0 = cw[chan], w1 = cw[1024 + chan], w2 = cw[2048 + chan], w3 = cw[3072 + chan];
    float x0 = t0 >= 3 ? bf2f(src[(size_t)(t0 - 3) * 1024]) : 0.f, x1 = t0 >= 2 ? bf2f(src[(size_t)(t0 - 2) * 1024]) : 0.f, x2 = t0 >= 1 ? bf2f(src[(size_t)(t0 - 1) * 1024]) : 0.f;
#pragma unroll
    for (int i = 0; i < 16; ++i) { const float x3 = bf2f(src[(size_t)(t0 + i) * 1024]); out[i] = silu(w0 * x0 + w1 * x1 + w2 * x2 + w3 * x3); x0 = x1; x1 = x2; x2 = x3; }
}

__device__ __forceinline__ void p2_mlstm_local(const Params& P, LAS unsigned char* lds, int tid, int lane, int wave) {
    const bf16* QKM = (const bf16*)(P.ws + WS_QKM); const bf16* VM = (const bf16*)(P.ws + WS_VM); const float* IFb = (const float*)(P.ws + WS_IF);
    const float* cw = P.in[4];
    bf16* DC = (bf16*)((unsigned char*)P.out + OUT_DC); float* DN = (float*)(P.ws + WS_DN); float* SC = (float*)(P.ws + WS_SC);
    LAS bf16* KWT = (LAS bf16*)lds; LAS bf16* VT = (LAS bf16*)(lds + 18432); LAS float* sw = (LAS float*)(lds + 36864);
    const int r = lane & 15, g = lane >> 4;
    for (int item = blockIdx.x; item < 2048; item += gridDim.x) {
        const int bh = item >> 8, c = item & 255, b = bh >> 2, h = bh & 3;
        if (wave == 0) {
            const size_t row = (size_t)b * SEQ + c * 64 + lane;
            const float lf = logsigmoid(IFb[row * 8 + 4 + h]), ip = IFb[row * 8 + h];
            const float bc = scan_add(lf, lane), gg = __shfl(bc, 63), ds = gg - bc + ip, ml = wave_max(ds);
            sw[lane] = __expf(ds - ml);
            if (lane == 0) { SC[item] = ml; SC[2048 + item] = gg; }
        }
        __syncthreads();
        { const int ch = tid & 127, sq = tid >> 7, s0 = sq * 16; float o[16];
          conv16(QKM, cw, b, c * 64 + s0, 512 + h * 128 + ch, o);
#pragma unroll
          for (int i = 0; i < 16; i += 2) *(LAS unsigned*)(KWT + ch * 72 + s0 + i) = pk2(o[i] * 0.08838834764831845f * sw[s0 + i], o[i + 1] * 0.08838834764831845f * sw[s0 + i + 1]);
          const bf16* vsrc = VM + ((size_t)b * SEQ + c * 64 + s0) * 512 + h * 128 + ch;
#pragma unroll
          for (int i = 0; i < 16; i += 2) *(LAS unsigned*)(VT + ch * 72 + s0 + i) = (unsigned)vsrc[(size_t)i * 512] | ((unsigned)vsrc[(size_t)(i + 1) * 512] << 16);
        }
        __syncthreads();
        {
          const bf16x8 vb0 = *(const LAS bf16x8*)(VT + (16 * wave + r) * 72 + 8 * g), vb1 = *(const LAS bf16x8*)(VT + (16 * wave + r) * 72 + 32 + 8 * g);
          bf16* dst = DC + (size_t)item * 16384 + (size_t)(16 * wave + r) * 128 + 4 * g;
#pragma unroll
          for (int eb = 0; eb < 8; ++eb) {
              const bf16x8 ka0 = *(const LAS bf16x8*)(KWT + (16 * eb + r) * 72 + 8 * g), ka1 = *(const LAS bf16x8*)(KWT + (16 * eb + r) * 72 + 32 + 8 * g);
              f32x4 acc = {0.f, 0.f, 0.f, 0.f};
              acc = MFMA16(ka0, vb0, acc); acc = MFMA16(ka1, vb1, acc);
              uint2 o; o.x = pk2(acc[0], acc[1]); o.y = pk2(acc[2], acc[3]); *(uint2*)(dst + 16 * eb) = o;
          }
        }
        if (tid < 128) { float a = 0.f;
#pragma unroll
            for (int cc = 0; cc < 8; ++cc) { float f[8]; unpk8(*(const LAS v4u*)(KWT + tid * 72 + 8 * cc), f);
#pragma unroll
                for (int k = 0; k < 8; ++k) a += f[k]; }
            DN[(size_t)item * 128 + tid] = a; }
        __syncthreads();
    }
}

__device__ __forceinline__ void p3_mlstm_scan(const Params& P, int tid) {
    const unsigned* __restrict__ DC = (const unsigned*)((unsigned char*)P.out + OUT_DC); unsigned* __restrict__ CS = (unsigned*)((unsigned char*)P.out + OUT_CS);
    const float* __restrict__ DN = (const float*)(P.ws + WS_DN); float* __restrict__ NS = (float*)(P.ws + WS_NS); float* SC = (float*)(P.ws + WS_SC);
    for (int gid = blockIdx.x * 512 + tid; gid < 8 * 8192; gid += gridDim.x * 512) {
        const int bh = gid >> 13, idx = gid & 8191;
        float C0 = 0.f, C1 = 0.f, m = 0.f;
        for (int j0 = 0; j0 < 256; j0 += 8) {
            unsigned d[8]; float ml[8], gg[8];
#pragma unroll
            for (int u = 0; u < 8; ++u) { const int item = bh * 256 + j0 + u; d[u] = DC[(size_t)item * 8192 + idx]; ml[u] = SC[item]; gg[u] = SC[2048 + item]; }
#pragma unroll
            for (int u = 0; u < 8; ++u) { const int item = bh * 256 + j0 + u;
                CS[(size_t)item * 8192 + idx] = pk2(C0, C1);
                if (idx == 0) SC[4096 + item] = m;
                const float mn = fmaxf(gg[u] + m, ml[u]), a = __expf(gg[u] + m - mn), bb = __expf(ml[u] - mn);
                C0 = a * C0 + bb * bf_lo(d[u]); C1 = a * C1 + bb * bf_hi(d[u]); m = mn; }
        }
    }
    for (int gid = blockIdx.x * 512 + tid; gid < 8 * 128; gid += gridDim.x * 512) {
        const int bh = gid >> 7, idx = gid & 127; float n = 0.f, m = 0.f;
        for (int j = 0; j < 256; ++j) { const int item = bh * 256 + j; NS[(size_t)item * 128 + idx] = n;
            const float ml = SC[item], gg = SC[2048 + item], mn = fmaxf(gg + m, ml), a = __expf(gg + m - mn), bb = __expf(ml - mn);
            n = a * n + bb * DN[(size_t)item * 128 + idx]; m = mn; }
    }
}

__device__ __forceinline__ void p4_mlstm_out(const Params& P, LAS unsigned char* lds, int tid, int lane, int wave) {
    const bf16* QKM = (const bf16*)(P.ws + WS_QKM); const bf16* VM = (const bf16*)(P.ws + WS_VM); const bf16* OM = (const bf16*)(P.ws + WS_OM); const float* IFb = (const float*)(P.ws + WS_IF);
    const float* cw = P.in[4]; const float* mnorm = P.in[6];
    const bf16* CS = (const bf16*)((unsigned char*)P.out + OUT_CS); const float* NS = (const float*)(P.ws + WS_NS); const float* SC = (const float*)(P.ws + WS_SC);
    bf16* YM = (bf16*)(P.ws + WS_YM);
    LAS bf16* Qs = (LAS bf16*)lds; LAS bf16* Ks = (LAS bf16*)(lds + 17408); LAS bf16* VT = (LAS bf16*)(lds + 34816); LAS bf16* PT = (LAS bf16*)(lds + 53248);
    LAS float* sm = (LAS float*)(lds + 62464);
    const int r = lane & 15, g = lane >> 4;
    for (int item = blockIdx.x; item < 2048; item += gridDim.x) {
        const int bh = item >> 8, c = item & 255, b = bh >> 2, h = bh & 3;
        if (wave == 0) {
            const size_t row = (size_t)b * SEQ + c * 64 + lane;
            const float lf = logsigmoid(IFb[row * 8 + 4 + h]), ip = IFb[row * 8 + h];
            const float bc = scan_add(lf, lane), a = ip - bc, pm = scan_max(a, lane), ms = SC[4096 + item], M = fmaxf(ms, pm);
            sm[lane] = a; sm[64 + lane] = M; sm[128 + lane] = __expf(ms - M); sm[192 + lane] = __expf(-bc - M);
        } else if (wave < 3) sm[320 + tid - 64] = NS[(size_t)item * 128 + tid - 64];
        { const int ch = tid & 127, sq = tid >> 7, s0 = sq * 16; float o[16];
          conv16(QKM, cw, b, c * 64 + s0, h * 128 + ch, o);
#pragma unroll
          for (int i = 0; i < 16; ++i) Qs[(s0 + i) * 136 + ch] = (bf16)f2bf(o[i]);
          conv16(QKM, cw, b, c * 64 + s0, 512 + h * 128 + ch, o);
#pragma unroll
          for (int i = 0; i < 16; ++i) Ks[(s0 + i) * 136 + ch] = (bf16)f2bf(o[i] * 0.08838834764831845f);
          const bf16* vsrc = VM + ((size_t)b * SEQ + c * 64 + s0) * 512 + h * 128 + ch;
#pragma unroll
          for (int i = 0; i < 16; i += 2) *(LAS unsigned*)(VT + ch * 72 + s0 + i) = (unsigned)vsrc[(size_t)i * 512] | ((unsigned)vsrc[(size_t)(i + 1) * 512] << 16);
        }
        __syncthreads();
        {
          const int sb = wave >> 1;
          bf16x8 ka[4];
#pragma unroll
          for (int ks = 0; ks < 4; ++ks) ka[ks] = *(const LAS bf16x8*)(Ks + (16 * sb + r) * 136 + 32 * ks + 8 * g);
#pragma unroll
          for (int tt = 0; tt < 2; ++tt) { const int tb = 2 * (wave & 1) + tt, t = 16 * tb + r;
              f32x4 acc = {0.f, 0.f, 0.f, 0.f};
#pragma unroll
              for (int ks = 0; ks < 4; ++ks) { const bf16x8 qb = *(const LAS bf16x8*)(Qs + t * 136 + 32 * ks + 8 * g); acc = MFMA16(ka[ks], qb, acc); }
              const float Mt = sm[64 + t]; float p[4];
#pragma unroll
              for (int k = 0; k < 4; ++k) { const int s = 16 * sb + 4 * g + k; p[k] = (s <= t) ? acc[k] * __expf(sm[s] - Mt) : 0.f; }
              v2u o; o.x = pk2(p[0], p[1]); o.y = pk2(p[2], p[3]); *(LAS v2u*)(PT + t * 72 + 16 * sb + 4 * g) = o; }
        }
        __syncthreads();
        if (tid < 64) { const int t = tid; float sp = 0.f, qn = 0.f;
#pragma unroll
            for (int cc = 0; cc < 8; ++cc) { float f[8]; unpk8(*(const LAS v4u*)(PT + t * 72 + 8 * cc), f);
#pragma unroll
                for (int k = 0; k < 8; ++k) sp += f[k]; }
#pragma unroll
            for (int cc = 0; cc < 16; ++cc) { float f[8]; unpk8(*(const LAS v4u*)(Qs + t * 136 + 8 * cc), f);
#pragma unroll
                for (int k = 0; k < 8; ++k) qn += f[k] * sm[320 + 8 * cc + k]; }
            sm[256 + t] = fmaxf(fabsf(sm[128 + t] * qn + sp), sm[192 + t]); }
        f32x4 ai[4], ac[4];
#pragma unroll
        for (int tb = 0; tb < 4; ++tb) { ai[tb] = (f32x4){0.f, 0.f, 0.f, 0.f}; ac[tb] = (f32x4){0.f, 0.f, 0.f, 0.f}; }
        {
          const bf16x8 va0 = *(const LAS bf16x8*)(VT + (16 * wave + r) * 72 + 8 * g), va1 = *(const LAS bf16x8*)(VT + (16 * wave + r) * 72 + 32 + 8 * g);
          bf16x8 ca[4];
          const bf16* crow = CS + (size_t)item * 16384 + (size_t)(16 * wave + r) * 128 + 8 * g;
#pragma unroll
          for (int ks = 0; ks < 4; ++ks) ca[ks] = *(const bf16x8*)(crow + 32 * ks);
#pragma unroll
          for (int tb = 0; tb < 4; ++tb) { const int t = 16 * tb + r;
              const bf16x8 pb0 = *(const LAS bf16x8*)(PT + t * 72 + 8 * g), pb1 = *(const LAS bf16x8*)(PT + t * 72 + 32 + 8 * g);
              ai[tb] = MFMA16(va0, pb0, ai[tb]); ai[tb] = MFMA16(va1, pb1, ai[tb]);
#pragma unroll
              for (int ks = 0; ks < 4; ++ks) { const bf16x8 qb = *(const LAS bf16x8*)(Qs + t * 136 + 32 * ks + 8 * g); ac[tb] = MFMA16(ca[ks], qb, ac[tb]); } }
        }
        __syncthreads();
        float ssq[4];
#pragma unroll
        for (int tb = 0; tb < 4; ++tb) { const int t = 16 * tb + r; const float wi = sm[128 + t], inv = 1.0f / sm[256 + t]; float s2 = 0.f;
#pragma unroll
            for (int k = 0; k < 4; ++k) { ai[tb][k] = (wi * ac[tb][k] + ai[tb][k]) * inv; s2 += ai[tb][k] * ai[tb][k]; }
            s2 += __shfl_xor(s2, 16); s2 += __shfl_xor(s2, 32); ssq[tb] = s2;
            if (g == 0) sm[448 + wave * 64 + t] = s2; }
        __syncthreads();
#pragma unroll
        for (int tb = 0; tb < 4; ++tb) { const int t = 16 * tb + r; float tot = 0.f;
#pragma unroll
            for (int w = 0; w < 8; ++w) tot += sm[448 + w * 64 + t];
            const float rs = rsqrtf(tot * (1.f / 128.f) + EPS);
            const size_t row = (size_t)b * SEQ + c * 64 + t; const int col = h * 128 + 16 * wave + 4 * g;
            const uint2 omw = *(const uint2*)(OM + row * 512 + col); const f32x4 gn = *(const f32x4*)(mnorm + col);
            uint2 o; o.x = pk2(ai[tb][0] * rs * gn[0] * bf_lo(omw.x), ai[tb][1] * rs * gn[1] * bf_hi(omw.x)); o.y = pk2(ai[tb][2] * rs * gn[2] * bf_lo(omw.y), ai[tb][3] * rs * gn[3] * bf_hi(omw.y));
            *(uint2*)(YM + row * 512 + col) = o; }
        __syncthreads();
    }
}

__device__ __forceinline__ int f2ord(float f) { const int b = __float_as_int(f); return b ^ ((b >> 31) & 0x7fffffff); }
__device__ __forceinline__ float ord2f(int o) { return __int_as_float(o ^ ((o >> 31) & 0x7fffffff)); }
#define CE_DESC(a, i, j) { const int _h = max(a[i], a[j]), _l = min(a[i], a[j]); a[i] = _h; a[j] = _l; }
__device__ __forceinline__ void sort16_desc(int (&a)[16]) {
#pragma unroll
    for (int k = 2; k <= 16; k <<= 1) {
#pragma unroll
        for (int j = k >> 1; j > 0; j >>= 1) {
#pragma unroll
            for (int i = 0; i < 16; ++i) { const int l = i ^ j; if (l > i) { if ((i & k) == 0) CE_DESC(a, i, l) else CE_DESC(a, l, i) } }
        }
    }
}
__device__ __forceinline__ void merge16_desc(int (&a)[16], const int (&b)[16]) {
#pragma unroll
    for (int i = 0; i < 16; ++i) a[i] = max(a[i], b[15 - i]);
#pragma unroll
    for (int j = 8; j > 0; j >>= 1) {
#pragma unroll
        for (int i = 0; i < 16; ++i) { const int l = i ^ j; if (l > i) CE_DESC(a, i, l) }
    }
}
__device__ __forceinline__ void xmerge16(int (&a)[16], int mask) {
    int b[16];
#pragma unroll
    for (int i = 0; i < 16; ++i) b[i] = __shfl_xor(a[i], mask);
    merge16_desc(a, b);
}
__device__ __forceinline__ void p10_topk(const Params& P, LAS unsigned char* lds, int tid, int lane, int wave) {
    const bf16* Q2 = (const bf16*)(P.ws + WS_Q2); const bf16* K1B = (const bf16*)(P.ws + WS_K1B); const bf16* K2B = (const bf16*)(P.ws + WS_K2B);
    int* IDX = (int*)(P.ws + WS_IDX); float* GATE = (float*)(P.ws + WS_GATE);
    LAS bf16* Kl = (LAS bf16*)lds;
    LAS int* Tb = (LAS int*)(lds + 69632 + wave * 2048);
    const int r = lane & 15, g = lane >> 4;
    const int h = blockIdx.x & 7, wgx = blockIdx.x >> 3, nwg = gridDim.x >> 3;
    __syncthreads();
    for (int i = tid; i < 4096; i += 512) { const int half = i >> 11, rem = i & 2047, n = rem >> 4, c = rem & 15;
        *(LAS v4u*)(Kl + half * 17408 + n * 136 + c * 8) = *(const v4u*)((half ? K2B : K1B) + (size_t)h * 16384 + n * 128 + c * 8); }
    __syncthreads();
    for (int tile = wgx * NW + wave; tile < NTOK / 16; tile += nwg * NW) {
        const size_t row = (size_t)tile * 16 + r;
        int R[2][16];
#pragma unroll
        for (int half = 0; half < 2; ++half) {
            bf16x8 qb[4];
#pragma unroll
            for (int ks = 0; ks < 4; ++ks) qb[ks] = *(const bf16x8*)(Q2 + row * 2048 + h * 256 + half * 128 + 32 * ks + 8 * g);
            int X[16], Y[16];
#pragma unroll
            for (int nb = 0; nb < 8; ++nb) {
                f32x4 acc = {0.f, 0.f, 0.f, 0.f};
#pragma unroll
                for (int ks = 0; ks < 4; ++ks) acc = MFMA16(*(const LAS bf16x8*)(Kl + half * 17408 + (16 * nb + r) * 136 + 32 * ks + 8 * g), qb[ks], acc);
#pragma unroll
                for (int k = 0; k < 4; ++k) { const int key = (f2ord(acc[k]) & ~0x7f) | (16 * nb + 4 * g + k); if (nb < 4) X[4 * nb + k] = key; else Y[4 * (nb - 4) + k] = key; }
            }
            sort16_desc(X); sort16_desc(Y); merge16_desc(X, Y);
            xmerge16(X, 16); xmerge16(X, 32);
#pragma unroll
            for (int i = 0; i < 16; ++i) R[half][i] = X[i];
        }
        if (g == 0) {
#pragma unroll
            for (int i = 0; i < 16; ++i) { Tb[r * 32 + i] = R[0][i] & 0x7f; Tb[r * 32 + 16 + i] = R[1][i] & 0x7f; }
        }
        float F1[16], F2[16];
#pragma unroll
        for (int i = 0; i < 16; ++i) { F1[i] = ord2f(R[0][i] & ~0x7f); F2[i] = ord2f(R[1][i] & ~0x7f); }
        int C[16];
#pragma unroll
        for (int sl = 0; sl < 16; ++sl) {
            const int a1 = sl < 8 ? 1 : (sl < 13 ? 2 : -1), b1 = sl < 8 ? sl : sl - 8;
            const int a2 = sl < 4 ? 3 : (sl < 7 ? 4 : (sl < 9 ? 5 : (sl < 11 ? 6 : (sl < 13 ? 7 : -1)))), b2 = sl < 4 ? sl : (sl < 7 ? sl - 4 : (sl < 9 ? sl - 7 : (sl < 11 ? sl - 9 : sl - 11)));
            const int a3 = sl < 8 ? 8 + sl : -1;
            const int k0 = (f2ord(F1[0] + F2[sl]) & ~0xff) | (0 << 4) | sl;
            const int k1 = a1 >= 0 ? ((f2ord(F1[a1 < 0 ? 0 : a1] + F2[b1 & 15]) & ~0xff) | (a1 << 4) | (b1 & 15)) : (int)0x80000000;
            const int k2 = a2 >= 0 ? ((f2ord(F1[a2 < 0 ? 0 : a2] + F2[b2 & 15]) & ~0xff) | (a2 << 4) | (b2 & 15)) : (int)0x80000000;
            const int k3 = a3 >= 0 ? ((f2ord(F1[a3 < 0 ? 0 : a3] + F2[0]) & ~0xff) | (a3 << 4)) : (int)0x80000000;
            C[sl] = g == 0 ? k0 : (g == 1 ? k1 : (g == 2 ? k2 : k3));
        }
        sort16_desc(C); xmerge16(C, 16); xmerge16(C, 32);
        float e[16], sum = 0.f; const float mx = ord2f(C[0] & ~0xff);
#pragma unroll
        for (int i = 0; i < 16; ++i) { e[i] = __expf(ord2f(C[i] & ~0xff) - mx); sum += e[i]; }
        const float inv = 1.0f / sum;
        int oi[4]; float og[4];
#pragma unroll
        for (int kk = 0; kk < 4; ++kk) {
            const int key = g == 0 ? C[kk] : (g == 1 ? C[4 + kk] : (g == 2 ? C[8 + kk] : C[12 + kk]));
            const float ev = g == 0 ? e[kk] : (g == 1 ? e[4 + kk] : (g == 2 ? e[8 + kk] : e[12 + kk]));
            const int a = (key >> 4) & 15, bq = key & 15;
            oi[kk] = Tb[r * 32 + a] * 128 + Tb[r * 32 + 16 + bq]; og[kk] = ev * inv;
        }
#pragma unroll
        for (int kk = 0; kk < 4; ++kk) { const int pos = (4 * (g & 1) + kk) * 16 + 2 * h + (g >> 1); IDX[row * 128 + pos] = oi[kk]; GATE[row * 128 + pos] = og[kk]; }
    }
}

typedef _Float16 f16x2 __attribute__((ext_vector_type(2)));
__device__ __forceinline__ f16x2 bfpair_to_h2(unsigned w) { return __builtin_bit_cast(f16x2, __builtin_amdgcn_cvt_pkrtz(bf_lo(w), bf_hi(w))); }
__device__ __forceinline__ f16x2 fp8lo_to_h2(unsigned w) { return __builtin_bit_cast(f16x2, __builtin_amdgcn_cvt_scalef32_pk_f16_fp8((int)w, 1.0f, false)); }
__device__ __forceinline__ f16x2 fp8hi_to_h2(unsigned w) { return __builtin_bit_cast(f16x2, __builtin_amdgcn_cvt_scalef32_pk_f16_fp8((int)w, 1.0f, true)); }
__device__ __forceinline__ void p11a_udot(const Params& P, int lane, int wave) {
    const bf16* HN = (const bf16*)(P.ws + WS_HN); const unsigned char* U8 = P.ws + WS_U8; const int* IDX = (const int*)(P.ws + WS_IDX); float* PART = (float*)(P.ws + WS_PART);
    const int x = blockIdx.x & 7, wgx = blockIdx.x >> 3, nwg = gridDim.x >> 3, rg = lane >> 3, ch = lane & 7;
    for (int t = wgx * NW + wave; t < NTOK; t += nwg * NW) {
        int e[16];
#pragma unroll
        for (int q = 0; q < 4; ++q) { const int4 v = *(const int4*)(IDX + (size_t)t * 128 + rg * 16 + 4 * q); e[4 * q] = v.x; e[4 * q + 1] = v.y; e[4 * q + 2] = v.z; e[4 * q + 3] = v.w; }
        const v4u h0 = *(const v4u*)(HN + (size_t)t * 1024 + 128 * x + 16 * ch), h1 = *(const v4u*)(HN + (size_t)t * 1024 + 128 * x + 16 * ch + 8);
        v4u ud[16];
#pragma unroll
        for (int gq = 0; gq < 16; ++gq) ud[gq] = *(const v4u*)(U8 + (size_t)e[gq] * 1024 + 128 * x + 16 * ch);
        f16x2 hh[8]; hh[0] = bfpair_to_h2(h0.x); hh[1] = bfpair_to_h2(h0.y); hh[2] = bfpair_to_h2(h0.z); hh[3] = bfpair_to_h2(h0.w); hh[4] = bfpair_to_h2(h1.x); hh[5] = bfpair_to_h2(h1.y); hh[6] = bfpair_to_h2(h1.z); hh[7] = bfpair_to_h2(h1.w);
        float z[16];
#pragma unroll
        for (int gq = 0; gq < 16; ++gq) { float d = 0.f; const unsigned w4[4] = {ud[gq].x, ud[gq].y, ud[gq].z, ud[gq].w};
#pragma unroll
            for (int q = 0; q < 4; ++q) { d = __builtin_amdgcn_fdot2(fp8lo_to_h2(w4[q]), hh[2 * q], d, false); d = __builtin_amdgcn_fdot2(fp8hi_to_h2(w4[q]), hh[2 * q + 1], d, false); }
            z[gq] = d; }
        float z8[8], z4[4], z2[2];
        { const bool b = ch & 4;
#pragma unroll
          for (int i = 0; i < 8; ++i) { const float keep = b ? z[8 + i] : z[i], send = b ? z[i] : z[8 + i]; z8[i] = keep + __shfl_xor(send, 4); } }
        { const bool b = ch & 2;
#pragma unroll
          for (int i = 0; i < 4; ++i) { const float keep = b ? z8[4 + i] : z8[i], send = b ? z8[i] : z8[4 + i]; z4[i] = keep + __shfl_xor(send, 2); } }
        { const bool b = ch & 1;
#pragma unroll
          for (int i = 0; i < 2; ++i) { const float keep = b ? z4[2 + i] : z4[i], send = b ? z4[i] : z4[2 + i]; z2[i] = keep + __shfl_xor(send, 1); } }
        *(float2*)(PART + ((size_t)t * 8 + x) * 128 + rg * 16 + 2 * ch) = make_float2(z2[0], z2[1]);
    }
}
__device__ __forceinline__ void p11b_weights(const Params& P, int tid) {
    const float* PART = (const float*)(P.ws + WS_PART); float* GW = (float*)(P.ws + WS_GATE); const float* SSQ1 = (const float*)(P.ws + WS_SSQ1);
    for (size_t i = (size_t)blockIdx.x * 512 + tid; i < (size_t)NTOK * 128; i += (size_t)gridDim.x * 512) {
        const size_t t = i >> 7, pos = i & 127; float zs = 0.f;
#pragma unroll
        for (int x = 0; x < 8; ++x) zs += PART[(t * 8 + x) * 128 + pos];
        const float zv = zs * (1.0f / SCALE_U) * rsqrtf(SSQ1[t] * (1.0f / 1024.0f) + EPS);
        GW[i] = GW[i] * 0.5f * zv * (1.0f + erff(zv * 0.70710678118654752f));
    }
}
__device__ __forceinline__ void p11c_vacc(const Params& P, int lane, int wave) {
    const unsigned char* V8 = P.ws + WS_V8; const int* IDX = (const int*)(P.ws + WS_IDX); const float* GW = (const float*)(P.ws + WS_GATE);
    float* X = P.out; float* SSQ = (float*)(P.ws + WS_SSQ); bf16* XG = (bf16*)(P.ws + WS_HN2); const float* gple = P.in[16];
    const int x = blockIdx.x & 7, wgx = blockIdx.x >> 3, nwg = gridDim.x >> 3, rg = lane >> 3, ch = lane & 7;
    const float2 gp = *(const float2*)(gple + 128 * x + 16 * ch + 2 * rg);
    for (int t = wgx * NW + wave; t < NTOK; t += nwg * NW) {
        int e[16]; float w[16];
#pragma unroll
        for (int q = 0; q < 4; ++q) { const int4 v = *(const int4*)(IDX + (size_t)t * 128 + rg * 16 + 4 * q); e[4 * q] = v.x; e[4 * q + 1] = v.y; e[4 * q + 2] = v.z; e[4 * q + 3] = v.w;
            const float4 wv = *(const float4*)(GW + (size_t)t * 128 + rg * 16 + 4 * q); w[4 * q] = wv.x; w[4 * q + 1] = wv.y; w[4 * q + 2] = wv.z; w[4 * q + 3] = wv.w; }
        v4u vd[16];
#pragma unroll
        for (int gq = 0; gq < 16; ++gq) vd[gq] = *(const v4u*)(V8 + (size_t)e[gq] * 1024 + 128 * x + 16 * ch);
        const float2 xo = *(const float2*)(X + (size_t)t * 1024 + 128 * x + 16 * ch + 2 * rg);
        f16x2 acc[8];
#pragma unroll
        for (int i = 0; i < 8; ++i) acc[i] = (f16x2){(_Float16)0.f, (_Float16)0.f};
#pragma unroll
        for (int gq = 0; gq < 16; ++gq) { const f16x2 ww = __builtin_bit_cast(f16x2, __builtin_amdgcn_cvt_pkrtz(w[gq], w[gq])); const unsigned w4[4] = {vd[gq].x, vd[gq].y, vd[gq].z, vd[gq].w};
#pragma unroll
            for (int q = 0; q < 4; ++q) { acc[2 * q] = __builtin_elementwise_fma(fp8lo_to_h2(w4[q]), ww, acc[2 * q]); acc[2 * q + 1] = __builtin_elementwise_fma(fp8hi_to_h2(w4[q]), ww, acc[2 * q + 1]); } }
        f16x2 a4[4], a2[2], a1;
        { const bool b = rg & 4;
#pragma unroll
          for (int i = 0; i < 4; ++i) { const f16x2 keep = b ? acc[4 + i] : acc[i], send = b ? acc[i] : acc[4 + i]; a4[i] = keep + __builtin_bit_cast(f16x2, __shfl_xor(__builtin_bit_cast(int, send), 32)); } }
        { const bool b = rg & 2;
#pragma unroll
          for (int i = 0; i < 2; ++i) { const f16x2 keep = b ? a4[2 + i] : a4[i], send = b ? a4[i] : a4[2 + i]; a2[i] = keep + __builtin_bit_cast(f16x2, __shfl_xor(__builtin_bit_cast(int, send), 16)); } }
        { const bool b = rg & 1; const f16x2 keep = b ? a2[1] : a2[0], send = b ? a2[0] : a2[1]; a1 = keep + __builtin_bit_cast(f16x2, __shfl_xor(__builtin_bit_cast(int, send), 8)); }
        const float x0 = xo.x + (float)a1[0] * (1.0f / SCALE_V), x1 = xo.y + (float)a1[1] * (1.0f / SCALE_V);
        *(float2*)(X + (size_t)t * 1024 + 128 * x + 16 * ch + 2 * rg) = make_float2(x0, x1);
        *(unsigned*)(XG + (size_t)t * 1024 + 128 * x + 16 * ch + 2 * rg) = pk2(x0 * gp.x, x1 * gp.y);
        const float ss = wave_sum(x0 * x0 + x1 * x1);
        if (lane == 0) atomicAdd(SSQ + t, ss);
    }
}

__global__ void __launch_bounds__(512, 2) mk_fwd(Params P) {
    extern __shared__ __attribute__((aligned(16))) unsigned char lds_raw[];
    cg::grid_group grid = cg::this_grid();
    LAS unsigned char* lds = (LAS unsigned char*)lds_raw;
    const int tid = threadIdx.x, lane = tid & 63, wave = __builtin_amdgcn_readfirstlane(tid >> 6);
    const int lo = P.ph_lo, hi = P.ph_hi, G = gridDim.x, bx = blockIdx.x;
    unsigned char* ws = P.ws;
    const int gw = bx * NW + wave, NGW = G * NW;
#ifndef PH_MASK
#define PH_MASK 0xffff
#endif
#define IN(k) (((PH_MASK >> (k)) & 1) && lo <= (k) && (k) < hi)
    volatile LAS unsigned* xst = (volatile LAS unsigned*)(lds + LDS_BYTES - 16);
    if (tid < 4) xst[tid] = 0u;
    __syncthreads();
    const XcdBarrier bar = xcd_barrier_post((unsigned*)(ws + WS_BAR), xst);
#ifdef USE_CG
#define GRID_BAR() grid.sync()
#else
#define GRID_BAR() xcd_barrier(bar)
#endif
#define SYNC_AFTER(k) do { if (IN(k) && IN((k) + 1)) { if ((k) == 0) grid.sync(); else GRID_BAR(); } } while (0)
    typedef pg8::bf16_t pb;
    if (IN(0)) p0_prologue(P, lds, tid, lane, wave);
    SYNC_AFTER(0);
    if (IN(1)) {
        pg8::Gemm g{(const pb*)(ws + WS_XN), (const pb*)(ws + WS_W1T), NTOK, 5632, 1024}; pg8::StaticOrder S; S.init(NTOK, 5632, G, bx);
        pg8::EpiProj E{(pb*)(ws + WS_QKVA), (pb*)(ws + WS_QKM), (pb*)(ws + WS_VM), (pb*)(ws + WS_OM), (pb*)(ws + WS_G), C2};
        pg8::gemm_phase<pg8::EpiProj, pg8::StaticOrder, true, true>(lds, g, S, E);
    }
    SYNC_AFTER(1);
    if (IN(2)) { p2_attention(P, lds, lane, wave); __syncthreads(); p2_mlstm_local(P, lds, tid, lane, wave); }
    SYNC_AFTER(2);
    if (IN(3)) p3_mlstm_scan(P, tid);
    SYNC_AFTER(3);
    if (IN(4)) p4_mlstm_out(P, lds, tid, lane, wave);
    SYNC_AFTER(4);
    if (IN(5)) {
        pg8::Gemm g{(const pb*)(ws + WS_YA), (const pb*)(ws + WS_WAT), NTOK, 1024, 512}; pg8::StaticOrder S; S.init(NTOK, 1024, G, bx);
        pg8::EpiGated<false> E{(pb*)(ws + WS_TMP), nullptr, (const pb*)(ws + WS_G), 0};
        pg8::gemm_phase<pg8::EpiGated<false>, pg8::StaticOrder, true, true>(lds, g, S, E);
    }
    if (IN(5) && IN(6)) { asm volatile("s_waitcnt vmcnt(0)" ::: "memory"); __syncthreads(); }
    if (IN(6)) {
        pg8::Gemm g{(const pb*)(ws + WS_YM), (const pb*)(ws + WS_WMT), NTOK, 1024, 512}; pg8::StaticOrder S; S.init(NTOK, 1024, G, bx);
        pg8::EpiGated<true> E{(pb*)(ws + WS_MERGED), (const pb*)(ws + WS_TMP), (const pb*)(ws + WS_G), 1024};
        pg8::gemm_phase<pg8::EpiGated<true>, pg8::StaticOrder, true, true>(lds, g, S, E);
    }
    SYNC_AFTER(6);
    if (IN(7)) {
        pg8::Gemm g{(const pb*)(ws + WS_MERGED), (const pb*)(ws + WS_WOT), NTOK, 1024, 1024}; pg8::StaticOrder S; S.init(NTOK, 1024, G, bx);
        pg8::EpiResidual E{P.in[0], P.out, (pb*)(ws + WS_HN), P.in[10], (float*)(ws + WS_SSQ1)};
        pg8::gemm_phase<pg8::EpiResidual, pg8::StaticOrder, true, true>(lds, g, S, E);
    }
    if (IN(7) && IN(9)) GRID_BAR();
    if (IN(9)) {
        pg8::Gemm g{(const pb*)(ws + WS_HN), (const pb*)(ws + WS_WQT), NTOK, 2048, 1024}; pg8::StaticOrder S; S.init(NTOK, 2048, G, bx);
        pg8::EpiStoreScaled E{(pb*)(ws + WS_Q2), 2048, (const float*)(ws + WS_SSQ1)};
        pg8::gemm_phase<pg8::EpiStoreScaled, pg8::StaticOrder, true, true>(lds, g, S, E);
    }
    SYNC_AFTER(9);
    if (IN(10)) p10_topk(P, lds, tid, lane, wave);
    SYNC_AFTER(10);
    if (IN(11)) { p11a_udot(P, lane, wave); GRID_BAR(); p11b_weights(P, tid); GRID_BAR(); p11c_vacc(P, lane, wave); }
    SYNC_AFTER(11);
    if (IN(12)) {
        pg8::Gemm g{(const pb*)(ws + WS_PB), (const pb*)(ws + WS_WPT), NTOK, 1024, 256}; pg8::StaticOrder S; S.init(NTOK, 1024, G, bx);
        pg8::EpiStore E{(pb*)(ws + WS_E), 1024};
        pg8::gemm_phase<pg8::EpiStore, pg8::StaticOrder, true, true>(lds, g, S, E);
    }
    if (IN(12) && IN(13)) { asm volatile("s_waitcnt vmcnt(0)" ::: "memory"); __syncthreads(); }
    if (IN(13)) {
        pg8::Gemm g{(const pb*)(ws + WS_HN2), (const pb*)(ws + WS_WGT), NTOK, 1024, 1024}; pg8::StaticOrder S; S.init(NTOK, 1024, G, bx);
        pg8::EpiPle E{P.out, (const pb*)(ws + WS_E), (const float*)(ws + WS_SSQ)};
        pg8::gemm_phase<pg8::EpiPle, pg8::StaticOrder, true, true>(lds, g, S, E);
    }
    SYNC_AFTER(13);
    if (IN(14)) {
        const float* gf = P.in[19];
        for (int m = gw; m < NTOK; m += NGW) {
            float* xr = P.out + (size_t)m * 1024; f32x4 v[4]; float s = 0.f;
#pragma unroll
            for (int j = 0; j < 4; ++j) { v[j] = ((const f32x4*)xr)[lane + 64 * j]; s += (v[j][0] * v[j][0] + v[j][1] * v[j][1]) + (v[j][2] * v[j][2] + v[j][3] * v[j][3]); }
            const float rstd = rsqrtf(wave_sum(s) * (1.f / 1024.f) + EPS);
#pragma unroll
            for (int j = 0; j < 4; ++j) { const f32x4 g = ((const f32x4*)gf)[lane + 64 * j]; ((f32x4*)xr)[lane + 64 * j] = v[j] * rstd * g; }
        }
    }
}

extern "C" void kernel_launch(void* const* d_in, const int* in_sizes, int n_in, void* d_out, int out_size, void* d_ws, size_t ws_size, hipStream_t stream) {
    static int grid_blocks = 0;
    if (!grid_blocks) {
        int dev = 0, cus = 0, per_cu = 0;
        (void)hipGetDevice(&dev);
        (void)hipDeviceGetAttribute(&cus, hipDeviceAttributeMultiprocessorCount, dev);
        (void)hipFuncSetAttribute((const void*)mk_fwd, hipFuncAttributeMaxDynamicSharedMemorySize, LDS_BYTES);
        (void)hipOccupancyMaxActiveBlocksPerMultiprocessor(&per_cu, mk_fwd, 512, LDS_BYTES);
        if (per_cu > 1) per_cu = 1;
        grid_blocks = cus * per_cu;
    }
    if (n_in < 20 || ws_size < WS_NEED || grid_blocks <= 0) { fprintf(stderr, "kernel_launch: bad setup (n_in %d ws %zu grid %d)\n", n_in, ws_size, grid_blocks); return; }
    Params p{};
    for (int i = 0; i < 20; ++i) p.in[i] = (const float*)d_in[i];
    p.out = (float*)d_out; p.ws = (unsigned char*)d_ws; p.ph_lo = 0; p.ph_hi = 15;
    (void)hipMemsetAsync((unsigned char*)d_ws + WS_BAR, 0, BAR_BYTES, stream);
    void* args[] = {&p};
    hipError_t e = hipLaunchCooperativeKernel((void*)mk_fwd, dim3(grid_blocks), dim3(512), args, LDS_BYTES, stream);
    if (e != hipSuccess) fprintf(stderr, "cooperative launch failed: %s (grid %d)\n", hipGetErrorString(e), grid_blocks);
}
```

```cpp
#include <hip/hip_runtime.h>
#include <hip/hip_cooperative_groups.h>
#include <cstdio>
#include <cstdint>
namespace cg = cooperative_groups;
namespace pg8 {
#define PG8_LAS __attribute__((address_space(3)))
typedef unsigned short bf16_t;
typedef short bf16x8 __attribute__((ext_vector_type(8)));
typedef float f32x4 __attribute__((ext_vector_type(4)));
typedef unsigned u32x4 __attribute__((ext_vector_type(4)));
constexpr int BM = 256, BK = 64, HALF = 128, HTB = HALF * BK * 2  , STAGE_BYTES = 8 * HTB, NXCD = 8, WGM = 8;

__host__ __device__ __forceinline__ int lds_byte(int r, int c) { const int st = (r >> 4) * 2 + (c >> 5), rr = r & 15, cc = c & 31, ob = rr * 64 + cc * 2; return st * 1024 + (ob ^ (((ob >> 9) & 1) << 5)); }
__host__ __device__ __forceinline__ void stage_rc(int b, int& R, int& C) { const int st = b / 1024, sb = b % 1024, swz = sb ^ (((sb >> 9) & 1) << 5); R = (st >> 1) * 16 + swz / 64; C = (st & 1) * 32 + (swz % 64) / 2; }
__host__ __device__ __forceinline__ int perm32(int rho) { const int n = rho >> 4, i = rho & 15; return 8 * (i >> 2) + 4 * n + (i & 3); }

struct Unit { int pm, pn; };
struct Gemm { const bf16_t* A; const bf16_t* Bt; int M, N, K; };

struct StaticOrder {
    int nM, nN, nwg, G, c;
    __host__ __device__ void init(int M, int N, int G_, int c_) { nM = M / BM; nN = N / BM; nwg = nM * nN; G = G_; c = c_; }
    __host__ __device__ bool next(int i, Unit& u) const {
        const long L = (long)i * G + c; if (L >= nwg) return false;
        int wgid = (int)L; { const int q = nwg / NXCD, r = nwg % NXCD, xcd = wgid % NXCD, off = wgid / NXCD; wgid = (xcd < r ? xcd * (q + 1) : r * (q + 1) + (xcd - r) * q) + off; }
        const int nig = WGM * nN, gid = wgid / nig, fm = gid * WGM, gsz = (nM - fm) < WGM ? (nM - fm) : WGM;
        u.pm = fm + ((wgid % nig) % gsz); u.pn = (wgid % nig) / gsz; return true;
    }
    __device__ __forceinline__ void a_ready(const Unit&) const {}
    __device__ __forceinline__ void done(const Unit&) const {}
};

__device__ __forceinline__ unsigned cvt_pk_bf16(float lo, float hi) { unsigned r; asm volatile("v_cvt_pk_bf16_f32 %0, %1, %2" : "=v"(r) : "v"(lo), "v"(hi)); return r; }
typedef float f32x2 __attribute__((ext_vector_type(2)));

__device__ __forceinline__ float sigm(float x) { return 1.0f / (1.0f + __expf(-x)); }
__device__ __forceinline__ float bf_lo(unsigned w) { return __uint_as_float(w << 16); }
__device__ __forceinline__ float bf_hi(unsigned w) { return __uint_as_float(w & 0xffff0000u); }
__device__ __forceinline__ u32x4 pack8(const f32x4& v0, const f32x4& v1) { u32x4 w; w.x = cvt_pk_bf16(v0[0], v0[1]); w.y = cvt_pk_bf16(v0[2], v0[3]); w.z = cvt_pk_bf16(v1[0], v1[1]); w.w = cvt_pk_bf16(v1[2], v1[3]); return w; }
__device__ __forceinline__ void unpack8(const u32x4& w, f32x4& v0, f32x4& v1) { v0[0] = bf_lo(w.x); v0[1] = bf_hi(w.x); v0[2] = bf_lo(w.y); v0[3] = bf_hi(w.y); v1[0] = bf_lo(w.z); v1[1] = bf_hi(w.z); v1[2] = bf_lo(w.w); v1[3] = bf_hi(w.w); }

#define PG8_EPI_WALK(...) \
    _Pragma("unroll") for (int ai = 0; ai < 2; ++ai) _Pragma("unroll") for (int m = 0; m < 4; ++m) { const int row = u.pm * BM + wr * 64 + fr + ai * HALF + m * 16; \
        _Pragma("unroll") for (int bj = 0; bj < 2; ++bj) { const int ct = wc * 64 + bj * 32 + 8 * fq; f32x4 v0 = acc[ai][bj][m][0], v1 = acc[ai][bj][m][1]; __VA_ARGS__ } }

__device__ __forceinline__ u32x4 xor8_16B(u32x4 v) { u32x4 r; r.x = (unsigned)__shfl_xor((int)v.x, 8); r.y = (unsigned)__shfl_xor((int)v.y, 8); r.z = (unsigned)__shfl_xor((int)v.z, 8); r.w = (unsigned)__shfl_xor((int)v.w, 8); return r; }
__device__ __forceinline__ u32x4 bperm_16B(int src_byte, u32x4 v) { u32x4 r; r.x = (unsigned)__builtin_amdgcn_ds_bpermute(src_byte, (int)v.x); r.y = (unsigned)__builtin_amdgcn_ds_bpermute(src_byte, (int)v.y); r.z = (unsigned)__builtin_amdgcn_ds_bpermute(src_byte, (int)v.z); r.w = (unsigned)__builtin_amdgcn_ds_bpermute(src_byte, (int)v.w); return r; }
__device__ __forceinline__ void store_rows_bf16(bf16_t* O, size_t ldc, int r0, int c0, int fr, int fq, u32x4 w0, u32x4 w1) {
    const bool h = fr & 8; const u32x4 recv = xor8_16B(h ? w0 : w1);
    const u32x4 d1 = h ? recv : w0, d2 = h ? w1 : recv;
    const int lane = fr + 16 * fq, src = ((lane >> 3) + 8 * ((lane >> 2) & 1) + 16 * (lane & 3)) * 4;
    const u32x4 e1 = bperm_16B(src, d1), e2 = bperm_16B(src, d2);
    bf16_t* p = O + (size_t)(r0 + (lane >> 3)) * ldc + c0 + 8 * (lane & 7);
    *(u32x4*)p = e1; *(u32x4*)(p + 8 * ldc) = e2;
}
struct EpiProj {
    static constexpr bool PERM = true, AFTER_DRAIN = false;
    bf16_t *qkva, *qkm, *vm, *om, *g; float c2;
    __device__ __forceinline__ void operator()(const f32x4 (&acc)[2][2][4][2], const Unit& u, int wr, int wc, int fr, int fq) const {
        const int pn = u.pn; bf16_t* base; int ldc, colt, mode = 0; float sc = 1.f;
        if (pn < 6) { base = qkva; ldc = 1536; colt = pn * 256; if (pn < 2) sc = c2; }
        else if (pn < 10) { base = qkm; ldc = 1024; colt = (pn - 6) * 256; }
        else if (pn < 12) { base = vm; ldc = 512; colt = (pn - 10) * 256; }
        else if (pn < 14) { base = om; ldc = 512; colt = (pn - 12) * 256; mode = 1; }
        else { base = g; ldc = 2048; colt = (pn - 14) * 256; mode = 1; }
#pragma unroll
        for (int ai = 0; ai < 2; ++ai)
#pragma unroll
            for (int m = 0; m < 4; ++m) { u32x4 w[2];
#pragma unroll
                for (int bj = 0; bj < 2; ++bj) { f32x4 v0 = acc[ai][bj][m][0], v1 = acc[ai][bj][m][1];
                    if (mode == 1) { _Pragma("unroll") for (int i = 0; i < 4; ++i) { v0[i] = sigm(v0[i]); v1[i] = sigm(v1[i]); } }
                    else { v0 = v0 * sc; v1 = v1 * sc; }
                    w[bj] = pack8(v0, v1); }
                store_rows_bf16(base, (size_t)ldc, u.pm * BM + wr * 64 + ai * HALF + m * 16, colt + wc * 64, fr, fq, w[0], w[1]); }
    }
};
struct EpiStore {
    static constexpr bool PERM = true, AFTER_DRAIN = false;
    bf16_t* O; int ldc;
    __device__ __forceinline__ void operator()(const f32x4 (&acc)[2][2][4][2], const Unit& u, int wr, int wc, int fr, int fq) const {
#pragma unroll
        for (int ai = 0; ai < 2; ++ai)
#pragma unroll
            for (int m = 0; m < 4; ++m) store_rows_bf16(O, (size_t)ldc, u.pm * BM + wr * 64 + ai * HALF + m * 16, u.pn * BM + wc * 64, fr, fq, pack8(acc[ai][0][m][0], acc[ai][0][m][1]), pack8(acc[ai][1][m][0], acc[ai][1][m][1]));
    }
};
template <bool ADD> struct EpiGated {
    static constexpr bool PERM = true, AFTER_DRAIN = false;
    bf16_t* O; const bf16_t* prev; const bf16_t* gate; int gcol0;
    __device__ __forceinline__ void operator()(const f32x4 (&acc)[2][2][4][2], const Unit& u, int wr, int wc, int fr, int fq) const {
#pragma unroll
        for (int ai = 0; ai < 2; ++ai)
#pragma unroll
            for (int m = 0; m < 4; ++m) { const int row = u.pm * BM + wr * 64 + fr + ai * HALF + m * 16; u32x4 w[2];
#pragma unroll
                for (int bj = 0; bj < 2; ++bj) { const int col = u.pn * BM + wc * 64 + bj * 32 + 8 * fq; f32x4 v0 = acc[ai][bj][m][0], v1 = acc[ai][bj][m][1];
                    f32x4 g0, g1; unpack8(*(const u32x4*)(gate + (size_t)row * 2048 + gcol0 + col), g0, g1);
                    v0 = v0 * g0; v1 = v1 * g1;
                    if (ADD) { f32x4 p0, p1; unpack8(*(const u32x4*)(prev + (size_t)row * 1024 + col), p0, p1); v0 = v0 + p0; v1 = v1 + p1; }
                    w[bj] = pack8(v0, v1); }
                store_rows_bf16(O, 1024, u.pm * BM + wr * 64 + ai * HALF + m * 16, u.pn * BM + wc * 64, fr, fq, w[0], w[1]); }
    }
};
struct EpiResidual {
    static constexpr bool PERM = true, AFTER_DRAIN = false;
    const float* res; float* out; bf16_t* xa; const float* gain; float* ssq;
    __device__ __forceinline__ void operator()(const f32x4 (&acc)[2][2][4][2], const Unit& u, int wr, int wc, int fr, int fq) const {
#pragma unroll
        for (int ai = 0; ai < 2; ++ai)
#pragma unroll
            for (int m = 0; m < 4; ++m) { const int row = u.pm * BM + wr * 64 + fr + ai * HALF + m * 16; float s = 0.f; u32x4 wx[2];
#pragma unroll
                for (int bj = 0; bj < 2; ++bj) { const int ct = wc * 64 + bj * 32 + 8 * fq; f32x4 v0 = acc[ai][bj][m][0], v1 = acc[ai][bj][m][1];
                    const size_t o = (size_t)row * 1024 + u.pn * BM + ct; const f32x4 r0 = *(const f32x4*)(res + o), r1 = *(const f32x4*)(res + o + 4);
                    v0 = v0 + r0; v1 = v1 + r1; *(f32x4*)(out + o) = v0; *(f32x4*)(out + o + 4) = v1;
                    s += (v0[0] * v0[0] + v0[1] * v0[1]) + (v0[2] * v0[2] + v0[3] * v0[3]) + (v1[0] * v1[0] + v1[1] * v1[1]) + (v1[2] * v1[2] + v1[3] * v1[3]);
                    const f32x4 g0 = *(const f32x4*)(gain + u.pn * BM + ct), g1 = *(const f32x4*)(gain + u.pn * BM + ct + 4);
                    wx[bj] = pack8(v0 * g0, v1 * g1); }
                store_rows_bf16(xa, 1024, u.pm * BM + wr * 64 + ai * HALF + m * 16, u.pn * BM + wc * 64, fr, fq, wx[0], wx[1]);
                s += __shfl_xor(s, 16); s += __shfl_xor(s, 32);
                if (fq == 0) atomicAdd(ssq + row, s);
                asm volatile("" ::: "memory"); }
    }
};
struct EpiPle {
    static constexpr bool PERM = true, AFTER_DRAIN = false;
    float* xio; const bf16_t* e; const float* ssq;
    __device__ __forceinline__ void operator()(const f32x4 (&acc)[2][2][4][2], const Unit& u, int wr, int wc, int fr, int fq) const {
        const int row0 = u.pm * BM + wr * 64 + fr;
        float sq_next = ssq[row0];
#pragma unroll
        for (int ai = 0; ai < 2; ++ai)
#pragma unroll
            for (int m = 0; m < 4; ++m) { const int row = row0 + ai * HALF + m * 16; const float sq = sq_next;
                if (!(ai == 1 && m == 3)) sq_next = ssq[row0 + (m == 3 ? HALF : ai * HALF + (m + 1) * 16)];
                const float rstd = rsqrtf(sq * (1.0f / 1024.0f) + 1e-6f);
#pragma unroll
                for (int bj = 0; bj < 2; ++bj) { const int ct = wc * 64 + bj * 32 + 8 * fq; f32x4 v0 = acc[ai][bj][m][0] * rstd, v1 = acc[ai][bj][m][1] * rstd;
                    const size_t o = (size_t)row * 1024 + u.pn * BM + ct; f32x4 e0, e1; unpack8(*(const u32x4*)(e + o), e0, e1);
                    const f32x4 r0 = *(const f32x4*)(xio + o), r1 = *(const f32x4*)(xio + o + 4);
#pragma unroll
                    for (int i = 0; i < 4; ++i) { v0[i] = r0[i] + sigm(v0[i]) * e0[i]; v1[i] = r1[i] + sigm(v1[i]) * e1[i]; }
                    *(f32x4*)(xio + o) = v0; *(f32x4*)(xio + o + 4) = v1; } }
    }
};

template <class Epi, class Sched, bool ALIGN_EPI = false, bool SP2 = false>
__device__ __forceinline__ void gemm_phase(PG8_LAS unsigned char* lds, const Gemm g, const Sched& S, const Epi& E) {
    int tid_ = threadIdx.x; asm volatile("" : "+v"(tid_));
    const int tid = tid_, wid = __builtin_amdgcn_readfirstlane(tid >> 6), lane = tid & 63, wr = wid >> 2, wc = wid & 3, fr = lane & 15, fq = lane >> 4;
    int K_ = g.K; asm volatile("" : "+s"(K_));
    const int K = K_, nt = K / BK;
    unsigned voffA[2], voffB[2];
#pragma unroll
    for (int i = 0; i < 2; ++i) { int R, C; stage_rc(tid * 16 + i * 8192, R, C); const int Rb = Epi::PERM ? (2 * (R & ~31) + perm32(R & 31)) : R;
        voffA[i] = (unsigned)(R * K + C) * 2u; voffB[i] = (unsigned)(Rb * K + C) * 2u; }
    const size_t kstep = (size_t)(BK * 2);
    const size_t hstep = (size_t)HALF * K * 2;
    const size_t hstepB = Epi::PERM ? (size_t)32 * K * 2 : hstep;
    const size_t tstep = 2 * hstep;
    const unsigned ldsw = (unsigned)wid * 1024u;
    const int aoff = lds_byte(wr * 64 + fr, fq * 8), boff = lds_byte(wc * 32 + fr, fq * 8);
#define PG8_SA(b, h) (((b) * 2 + (h)) * HTB)
#define PG8_SB(b, h) ((4 + (b) * 2 + (h)) * HTB)
#define PG8_STAGE(bufoff, gbase, voff) do { _Pragma("unroll") for (int _i = 0; _i < 2; ++_i) \
        __builtin_amdgcn_global_load_lds((const unsigned*)((const char*)(gbase) + (voff)[_i]), (PG8_LAS unsigned*)(lds + (bufoff) + ldsw + _i * 8192), 16, 0, 0); } while (0)
#define PG8_LDA(dst, b, h) do { _Pragma("unroll") for (int m = 0; m < 4; ++m) _Pragma("unroll") for (int k = 0; k < 2; ++k) dst[m][k] = *(const PG8_LAS bf16x8*)(lds + PG8_SA(b, h) + aoff + m * 2048 + k * 1024); } while (0)
#define PG8_LDB(dst, b, h) do { _Pragma("unroll") for (int n = 0; n < 2; ++n) _Pragma("unroll") for (int k = 0; k < 2; ++k) dst[n][k] = *(const PG8_LAS bf16x8*)(lds + PG8_SB(b, h) + boff + n * 2048 + k * 1024); } while (0)
#define PG8_MMA(ai, bj, At, Bt) do { __builtin_amdgcn_s_setprio(1); _Pragma("unroll") for (int m = 0; m < 4; ++m) _Pragma("unroll") for (int n = 0; n < 2; ++n) _Pragma("unroll") for (int k = 0; k < 2; ++k) \
        acc[ai][bj][m][n] = __builtin_amdgcn_mfma_f32_16x16x32_bf16(Bt[n][k], At[m][k], acc[ai][bj][m][n], 0, 0, 0); __builtin_amdgcn_s_setprio(0); } while (0)
#define PG8_WAIT_V(n) asm volatile("s_waitcnt vmcnt(" #n ")" ::: "memory")
#define PG8_WAIT_L(n) asm volatile("s_waitcnt lgkmcnt(" #n ")" ::: "memory")
#define PG8_BAR __builtin_amdgcn_s_barrier()
#define PG8_SCHED __builtin_amdgcn_sched_barrier(0)
    Unit cur, nxt; int ui = 0;
    if (!S.next(0, cur)) return;
    f32x4 acc[2][2][4][2];
#pragma unroll
    for (int a = 0; a < 2; ++a)
#pragma unroll
        for (int b = 0; b < 2; ++b)
#pragma unroll
            for (int m = 0; m < 4; ++m)
#pragma unroll
                for (int n = 0; n < 2; ++n) acc[a][b][m][n] = (f32x4){0.f, 0.f, 0.f, 0.f};
    bf16x8 At[4][2], B0[2][2], B1[2][2];
    const char* cA = (const char*)g.A + (size_t)cur.pm * tstep; const char* cB = (const char*)g.Bt + (size_t)cur.pn * tstep;
    S.a_ready(cur);
    if constexpr (SP2) {
        PG8_STAGE(PG8_SB(0, 0), cB, voffB); PG8_STAGE(PG8_SB(0, 1), cB + hstepB, voffB); PG8_STAGE(PG8_SA(0, 0), cA, voffA); PG8_STAGE(PG8_SA(0, 1), cA + hstep, voffA);
        if (wr == 1) PG8_BAR;
        PG8_WAIT_V(2); PG8_BAR;
        PG8_STAGE(PG8_SB(1, 0), cB + kstep, voffB); PG8_STAGE(PG8_SA(1, 0), cA + kstep, voffA); PG8_STAGE(PG8_SB(1, 1), cB + hstepB + kstep, voffB);
        PG8_WAIT_V(6); PG8_BAR;
    } else {
        PG8_STAGE(PG8_SB(0, 0), cB, voffB); PG8_STAGE(PG8_SA(0, 0), cA, voffA); PG8_STAGE(PG8_SB(0, 1), cB + hstepB, voffB); PG8_STAGE(PG8_SA(0, 1), cA + hstep, voffA);
        if (wr == 1) PG8_BAR;
        PG8_WAIT_V(4); PG8_BAR;
        PG8_STAGE(PG8_SB(1, 0), cB + kstep, voffB); PG8_STAGE(PG8_SA(1, 0), cA + kstep, voffA); PG8_STAGE(PG8_SB(1, 1), cB + hstepB + kstep, voffB);
        PG8_WAIT_V(6); PG8_BAR;
    }
    for (;;) {
        const bool has_next = S.next(ui + 1, nxt);
        const char* nA = has_next ? (const char*)g.A + (size_t)nxt.pm * tstep : cA; const char* nB = has_next ? (const char*)g.Bt + (size_t)nxt.pn * tstep : cB;
        for (int t = 0; t < nt; t += 2) {
            const bool last = (t == nt - 2);
            const char* a1 = cA + (size_t)(t + 1) * kstep;
            const char* a2 = last ? nA : cA + (size_t)(t + 2) * kstep; const char* b2 = last ? nB : cB + (size_t)(t + 2) * kstep;
            const char* a3 = a2 + kstep; const char* b3 = b2 + kstep;
            if (last && has_next) S.a_ready(nxt);
            if constexpr (SP2) {
            PG8_LDB(B0, 0, 0); PG8_LDB(B1, 0, 1); PG8_SCHED; PG8_LDA(At, 0, 0); PG8_STAGE(PG8_SA(1, 1), a1 + hstep, voffA);
            PG8_WAIT_V(8); PG8_WAIT_L(0); PG8_BAR; PG8_MMA(0, 0, At, B0); PG8_MMA(0, 1, At, B1); PG8_BAR; PG8_SCHED;
            PG8_LDA(At, 0, 1); PG8_STAGE(PG8_SB(0, 0), b2, voffB); PG8_STAGE(PG8_SB(0, 1), b2 + hstepB, voffB); PG8_STAGE(PG8_SA(0, 0), a2, voffA);
            PG8_WAIT_V(8); PG8_WAIT_L(0); PG8_BAR; PG8_MMA(1, 0, At, B0); PG8_MMA(1, 1, At, B1); PG8_BAR; PG8_SCHED;
            PG8_LDB(B0, 1, 0); PG8_LDB(B1, 1, 1); PG8_SCHED; PG8_LDA(At, 1, 0); PG8_STAGE(PG8_SA(0, 1), a2 + hstep, voffA);
            PG8_WAIT_V(8); PG8_WAIT_L(0); PG8_BAR; PG8_MMA(0, 0, At, B0); PG8_MMA(0, 1, At, B1); PG8_BAR; PG8_SCHED;
            PG8_LDA(At, 1, 1); PG8_STAGE(PG8_SB(1, 0), b3, voffB); PG8_STAGE(PG8_SB(1, 1), b3 + hstepB, voffB); PG8_STAGE(PG8_SA(1, 0), a3, voffA);
            PG8_WAIT_V(8); PG8_WAIT_L(0); PG8_BAR; PG8_MMA(1, 0, At, B0); PG8_MMA(1, 1, At, B1); PG8_BAR; PG8_SCHED;
            } else {
            PG8_LDB(B0, 0, 0); PG8_SCHED; PG8_LDA(At, 0, 0); PG8_STAGE(PG8_SA(1, 1), a1 + hstep, voffA);
            PG8_WAIT_L(8); PG8_BAR; PG8_WAIT_L(0); PG8_MMA(0, 0, At, B0); PG8_BAR; PG8_SCHED;
            PG8_LDB(B1, 0, 1); PG8_STAGE(PG8_SB(0, 0), b2, voffB);
            PG8_BAR; PG8_WAIT_L(0); PG8_MMA(0, 1, At, B1); PG8_BAR;
            PG8_LDA(At, 0, 1); PG8_STAGE(PG8_SA(0, 0), a2, voffA);
            PG8_BAR; PG8_WAIT_L(0); PG8_MMA(1, 0, At, B0); PG8_BAR; PG8_SCHED;
            PG8_STAGE(PG8_SB(0, 1), b2 + hstepB, voffB);
            PG8_WAIT_V(6); PG8_BAR; PG8_MMA(1, 1, At, B1); PG8_BAR;
            PG8_LDB(B0, 1, 0); PG8_SCHED; PG8_LDA(At, 1, 0); PG8_STAGE(PG8_SA(0, 1), a2 + hstep, voffA);
            PG8_WAIT_L(8); PG8_BAR; PG8_WAIT_L(0); PG8_MMA(0, 0, At, B0); PG8_BAR; PG8_SCHED;
            PG8_LDB(B1, 1, 1); PG8_STAGE(PG8_SB(1, 0), b3, voffB);
            PG8_BAR; PG8_WAIT_L(0); PG8_MMA(0, 1, At, B1); PG8_BAR;
            PG8_LDA(At, 1, 1); PG8_STAGE(PG8_SA(1, 0), a3, voffA);
            PG8_BAR; PG8_WAIT_L(0); PG8_MMA(1, 0, At, B0); PG8_BAR; PG8_SCHED;
            PG8_STAGE(PG8_SB(1, 1), b3 + hstepB, voffB);
            PG8_WAIT_V(6); PG8_BAR; PG8_MMA(1, 1, At, B1); PG8_BAR;
            }
        }
        if constexpr (ALIGN_EPI) { if (wr == 0) PG8_BAR; }
        if constexpr (!Epi::AFTER_DRAIN) { E(acc, cur, wr, wc, fr, fq); S.done(cur); }
        if (!has_next) break;
#pragma unroll
        for (int a = 0; a < 2; ++a)
#pragma unroll
            for (int b = 0; b < 2; ++b)
#pragma unroll
                for (int m = 0; m < 4; ++m)
#pragma unroll
                    for (int n = 0; n < 2; ++n) acc[a][b][m][n] = (f32x4){0.f, 0.f, 0.f, 0.f};
        cur = nxt; cA = nA; cB = nB; ++ui;
        if constexpr (ALIGN_EPI) { if (wr == 1) PG8_BAR; }
    }
    PG8_WAIT_V(0);
    if constexpr (!ALIGN_EPI) { if (wr == 0) PG8_BAR; }
    PG8_BAR;
    if constexpr (Epi::AFTER_DRAIN) { E.fused(acc, cur, wr, wc, fr, fq, lds, wid, lane); S.done(cur); }
#undef PG8_SA
#undef PG8_SB
#undef PG8_STAGE
#undef PG8_LDA
#undef PG8_LDB
#undef PG8_MMA
#undef PG8_WAIT_V
#undef PG8_WAIT_L
#undef PG8_BAR
#undef PG8_SCHED
}
}

#define GAS __attribute__((address_space(1)))
#define LAS __attribute__((address_space(3)))
typedef unsigned short bf16;
typedef unsigned v4u __attribute__((ext_vector_type(4)));
typedef unsigned v2u __attribute__((ext_vector_type(2)));
typedef float f32x4 __attribute__((ext_vector_type(4)));
using pg8::bf_lo; using pg8::bf_hi; using pg8::sigm;

constexpr int NTOK = 32768, SEQ = 16384, DM = 1024, NW = 8;
constexpr float EPS = 1e-6f;
constexpr float C2 = 0.125f * 1.4426950408889634f;
constexpr size_t MiB = 1u << 20;
constexpr size_t WS_W1T = 1 * MiB, WS_WAT = 12 * MiB, WS_WMT = 13 * MiB, WS_WOT = 14 * MiB, WS_WQT = 16 * MiB, WS_WGT = 20 * MiB, WS_WPT = 22 * MiB;
constexpr size_t WS_K1B = 22 * MiB + 512 * 1024, WS_K2B = 22 * MiB + 768 * 1024, WS_IF = 23 * MiB, WS_UB = 24 * MiB, WS_VB = 56 * MiB;
constexpr size_t WS_XN = 88 * MiB, WS_YA = 88 * MiB, WS_YM = 120 * MiB, WS_HN = 88 * MiB;
constexpr size_t WS_QKVA = 152 * MiB, WS_QKM = 248 * MiB, WS_VM = 312 * MiB, WS_OM = 344 * MiB, WS_G = 376 * MiB;
constexpr size_t WS_DN = 504 * MiB, WS_NS = 505 * MiB, WS_SC = 506 * MiB;
constexpr size_t WS_MERGED = 152 * MiB, WS_TMP = 216 * MiB, WS_Q2 = 376 * MiB, WS_IDX = 152 * MiB, WS_GATE = 168 * MiB, WS_HN2 = 184 * MiB, WS_PB = 56 * MiB, WS_E = 264 * MiB;
constexpr size_t WS_NEED = 507 * MiB;
constexpr size_t WS_U8 = 24 * MiB, WS_V8 = 40 * MiB, WS_PART = 376 * MiB, WS_SSQ = 506 * MiB + 512 * 1024;
constexpr float SCALE_U = 256.f, SCALE_V = 16.f;
constexpr size_t WS_SSQ1 = 506 * MiB + 768 * 1024, WS_BAR = 0, BAR_BYTES = 32768;
constexpr size_t OUT_DC = 0, OUT_CS = 64 * MiB;
constexpr int LDS_BYTES = 147456;

__device__ __forceinline__ unsigned f2bf(float f) { unsigned u = __float_as_uint(f); return (u + 0x7fffu + ((u >> 16) & 1u)) >> 16; }
__device__ __forceinline__ unsigned pk2(float lo, float hi) { return f2bf(lo) | (f2bf(hi) << 16); }
__device__ __forceinline__ float bf2f(bf16 b) { return __uint_as_float((unsigned)b << 16); }
__device__ __forceinline__ float wave_sum(float v) {
#pragma unroll
    for (int o = 1; o < 64; o <<= 1) v += __shfl_xor(v, o);
    return v;
}
__device__ __forceinline__ void unpk8(const v4u w, float* f) { f[0] = bf_lo(w.x); f[1] = bf_hi(w.x); f[2] = bf_lo(w.y); f[3] = bf_hi(w.y); f[4] = bf_lo(w.z); f[5] = bf_hi(w.z); f[6] = bf_lo(w.w); f[7] = bf_hi(w.w); }
__device__ __forceinline__ v4u pk8(const float* f) { v4u w; w.x = pk2(f[0], f[1]); w.y = pk2(f[2], f[3]); w.z = pk2(f[4], f[5]); w.w = pk2(f[6], f[7]); return w; }
typedef __bf16 bf16x2_t __attribute__((ext_vector_type(2)));
__device__ __forceinline__ float dot2bf(unsigned a, unsigned b, float c) { return __builtin_amdgcn_fdot2_f32_bf16(__builtin_bit_cast(bf16x2_t, a), __builtin_bit_cast(bf16x2_t, b), c, false); }
__device__ __forceinline__ float logsigmoid(float x) { return fminf(x, 0.f) - log1pf(__expf(-fabsf(x))); }
__device__ __forceinline__ float silu(float x) { return x / (1.0f + __expf(-x)); }

#define XB_TMO      128
#define XB_XCNT(j)  (256  + 64 * (j))
#define XB_XSUB(j)  (1280 + 64 * (j))
#define XB_XGEN(j)  (2304 + 64 * (j))
#define XB_TOP      3328
#define XB_TOPGEN   3392
#define XCD_BAR_WORDS 3456
#define XB_SPIN_CAP (1u << 18)

__device__ __forceinline__ unsigned xb_ld(unsigned* p)              { return __hip_atomic_load(p, __ATOMIC_RELAXED, __HIP_MEMORY_SCOPE_AGENT); }
__device__ __forceinline__ unsigned xb_add(unsigned* p, unsigned v) { return __hip_atomic_fetch_add(p, v, __ATOMIC_RELAXED, __HIP_MEMORY_SCOPE_AGENT); }
__device__ __forceinline__ unsigned xb_xcc_id() { return (unsigned)__builtin_amdgcn_s_getreg((3 << 11) | 20) & 0xFu; }
#define XB_SPIN(cond, bar) do { unsigned _sp = 0; while (cond) { __builtin_amdgcn_s_sleep(1); \
    if ((++_sp & 255u) == 0u) { if (xb_ld(&(bar)[XB_TMO])) break; if (_sp > XB_SPIN_CAP) { atomicAdd(&(bar)[XB_TMO], 1u); break; } } } } while (0)

struct XcdBarrier {
    unsigned* bar; unsigned x;
    volatile LAS unsigned* st;
};

__device__ __forceinline__ XcdBarrier xcd_barrier_post(unsigned* bar, volatile LAS unsigned* st) {
    XcdBarrier b; b.bar = bar; b.x = xb_xcc_id(); b.st = st;
    if (threadIdx.x == 0) (void)xb_add(&bar[XB_XCNT(b.x)], 1u);
    return b;
}
__device__ __forceinline__ void xcd_barrier_complete(unsigned* bar, unsigned x, unsigned& nloc, unsigned& nx) {
    const unsigned G = gridDim.x * gridDim.y * gridDim.z;
    unsigned sum, cnt, mine, sp = 0u;
    for (;;) {
        sum = 0u; cnt = 0u; mine = 0u;
#pragma unroll
        for (unsigned j = 0; j < 16; ++j) { const unsigned c = xb_ld(&bar[XB_XCNT(j)]); sum += c; cnt += (c > 0u) ? 1u : 0u; mine = (j == x) ? c : mine; }
        if (sum == G) break;
        __builtin_amdgcn_s_sleep(1);
        if ((++sp & 255u) == 0u) { if (xb_ld(&bar[XB_TMO])) break; if (sp > XB_SPIN_CAP) { atomicAdd(&bar[XB_TMO], 1u); break; } }
    }
    nloc = mine > 0u ? mine : 1u; nx = cnt > 0u ? cnt : 1u;
}

__device__ __forceinline__ void xcd_barrier(const XcdBarrier& b) {
    asm volatile("s_waitcnt vmcnt(0)" ::: "memory");
    __syncthreads();
    if (threadIdx.x == 0) {
        unsigned* bar = b.bar;
        __builtin_amdgcn_s_waitcnt(0);
        unsigned nloc = b.st[0], nx = b.st[1];
        if (nloc == 0u) { xcd_barrier_complete(bar, b.x, nloc, nx); b.st[0] = nloc; b.st[1] = nx; }
        const unsigned old = xb_add(&bar[XB_XSUB(b.x)], 1u);
        const unsigned gen = old / nloc;
        if (old + 1u == (gen + 1u) * nloc) {
            __builtin_amdgcn_fence(__ATOMIC_RELEASE, "agent");
            asm volatile("s_waitcnt vmcnt(0)" ::: "memory");
            const unsigned og = xb_add(&bar[XB_TOP], 1u);
            const unsigned tg = og / nx;
            if (og + 1u == (tg + 1u) * nx) xb_add(&bar[XB_TOPGEN], 1u);
            else XB_SPIN(xb_ld(&bar[XB_TOPGEN]) == tg, bar);
            __builtin_amdgcn_fence(__ATOMIC_ACQUIRE, "agent");
            xb_add(&bar[XB_XGEN(b.x)], 1u);
            asm volatile("s_waitcnt vmcnt(0)" ::: "memory");
        } else {
            XB_SPIN(xb_ld(&bar[XB_XGEN(b.x)]) == gen, bar);
            __builtin_amdgcn_fence(__ATOMIC_ACQUIRE, "agent");
            asm volatile("s_waitcnt vmcnt(0)" ::: "memory");
        }
    }
    __syncthreads();
}


struct Params { const float* in[20]; float* out; unsigned char* ws; int ph_lo, ph_hi; };

__device__ __forceinline__ void transpose_item(const float* W, int ldw, int col0, int K, bf16* WT, int row0, LAS float* scr, int item, int nblk, int lane) {
    const int kb = item / nblk, nb = item % nblk, k0 = 64 * kb, n0 = 32 * nb;
#pragma unroll 8
    for (int i = 0; i < 32; ++i) { const int kk = 2 * i + (lane >> 5); scr[kk * 33 + (lane & 31)] = W[(size_t)(k0 + kk) * ldw + col0 + n0 + (lane & 31)]; }
    asm volatile("s_waitcnt lgkmcnt(0)" ::: "memory");
    const int c = lane & 7;
#pragma unroll
    for (int j = 0; j < 4; ++j) { const int n = (lane >> 3) + 8 * j; const LAS float* s = scr + (8 * c) * 33 + n;
        v4u o; o.x = pk2(s[0 * 33], s[1 * 33]); o.y = pk2(s[2 * 33], s[3 * 33]); o.z = pk2(s[4 * 33], s[5 * 33]); o.w = pk2(s[6 * 33], s[7 * 33]);
        *(v4u*)(WT + (size_t)(row0 + n0 + n) * K + k0 + 8 * c) = o; }
    asm volatile("s_waitcnt lgkmcnt(0)" ::: "memory");
}
__device__ __forceinline__ void cvt_f32_bf16(const float* src, bf16* dst, size_t n4, size_t gtid, size_t gsz) {
    for (size_t i = gtid; i < n4; i += gsz) { const f32x4 v = ((const f32x4*)src)[i]; uint2 o; o.x = pk2(v[0], v[1]); o.y = pk2(v[2], v[3]); ((uint2*)dst)[i] = o; }
}
__device__ __forceinline__ void cvt_f32_fp8(const float* src, unsigned* dst, size_t n4, float sc, size_t gtid, size_t gsz) {
    for (size_t i = gtid; i < n4; i += gsz) { const f32x4 v = ((const f32x4*)src)[i]; int w = __builtin_amdgcn_cvt_pk_fp8_f32(v[0] * sc, v[1] * sc, 0, false); w = __builtin_amdgcn_cvt_pk_fp8_f32(v[2] * sc, v[3] * sc, w, true); dst[i] = (unsigned)w; }
}
__device__ __forceinline__ void rms_row_to_bf16(const float* xrow, const float* gain, bf16* orow, int lane) {
    f32x4 v[4]; float s = 0.f;
#pragma unroll
    for (int j = 0; j < 4; ++j) { v[j] = ((const f32x4*)xrow)[lane + 64 * j]; s += (v[j][0] * v[j][0] + v[j][1] * v[j][1]) + (v[j][2] * v[j][2] + v[j][3] * v[j][3]); }
    const float rstd = rsqrtf(wave_sum(s) * (1.f / 1024.f) + EPS);
#pragma unroll
    for (int j = 0; j < 4; ++j) { const f32x4 g = ((const f32x4*)gain)[lane + 64 * j]; uint2 o; o.x = pk2(v[j][0] * rstd * g[0], v[j][1] * rstd * g[1]); o.y = pk2(v[j][2] * rstd * g[2], v[j][3] * rstd * g[3]); ((uint2*)orow)[lane + 64 * j] = o; }
}
__device__ __forceinline__ void p0_prologue(const Params& P, LAS unsigned char* lds, int tid, int lane, int wave) {
    unsigned char* ws = P.ws;
    const int gw = blockIdx.x * NW + wave, NGW = gridDim.x * NW;
    LAS float* scr = (LAS float*)(lds + wave * 8448);
    LAS float* wif = (LAS float*)(lds + 69632);
    const float* w_in = P.in[3];
    for (int i = tid; i < 8192; i += 512) wif[i] = w_in[(size_t)(i >> 3) * 5640 + 3584 + (i & 7)];
    __syncthreads();
    constexpr int I1A = 16 * 112, I1B = 16 * 64, IUP = 8 * 32, IOUT = 16 * 32, IQ = 16 * 64, IPL = 4 * 32;
    constexpr int NITEMS = I1A + I1B + 2 * IUP + IOUT + IQ + IOUT + IPL;
    for (int it = gw; it < NITEMS; it += NGW) {
        int r = it;
        if (r < I1A) { transpose_item(w_in, 5640, 0, 1024, (bf16*)(ws + WS_W1T), 0, scr, r, 112, lane); continue; } r -= I1A;
        if (r < I1B) { transpose_item(w_in, 5640, 3592, 1024, (bf16*)(ws + WS_W1T), 3584, scr, r, 64, lane); continue; } r -= I1B;
        if (r < IUP) { transpose_item(P.in[7], 1024, 0, 512, (bf16*)(ws + WS_WAT), 0, scr, r, 32, lane); continue; } r -= IUP;
        if (r < IUP) { transpose_item(P.in[8], 1024, 0, 512, (bf16*)(ws + WS_WMT), 0, scr, r, 32, lane); continue; } r -= IUP;
        if (r < IOUT) { transpose_item(P.in[9], 1024, 0, 1024, (bf16*)(ws + WS_WOT), 0, scr, r, 32, lane); continue; } r -= IOUT;
        if (r < IQ) { transpose_item(P.in[11], 2048, 0, 1024, (bf16*)(ws + WS_WQT), 0, scr, r, 64, lane); continue; } r -= IQ;
        if (r < IOUT) { transpose_item(P.in[17], 1024, 0, 1024, (bf16*)(ws + WS_WGT), 0, scr, r, 32, lane); continue; } r -= IOUT;
        transpose_item(P.in[18], 1024, 0, 256, (bf16*)(ws + WS_WPT), 0, scr, r, 32, lane);
    }
    const size_t gtid = (size_t)blockIdx.x * 512 + tid, gsz = (size_t)gridDim.x * 512;
    cvt_f32_bf16(P.in[12], (bf16*)(ws + WS_K1B), 8 * 128 * 128 / 4, gtid, gsz);
    cvt_f32_bf16(P.in[13], (bf16*)(ws + WS_K2B), 8 * 128 * 128 / 4, gtid, gsz);
    cvt_f32_fp8(P.in[14], (unsigned*)(ws + WS_U8), (size_t)16384 * 1024 / 4, SCALE_U, gtid, gsz);
    cvt_f32_fp8(P.in[15], (unsigned*)(ws + WS_V8), (size_t)16384 * 1024 / 4, SCALE_V, gtid, gsz);
    cvt_f32_bf16(P.in[1], (bf16*)(ws + WS_PB), (size_t)NTOK * 256 / 4, gtid, gsz);
    for (size_t i = gtid; i < (size_t)NTOK; i += gsz) { ((float*)(ws + WS_SSQ))[i] = 0.f; ((float*)(ws + WS_SSQ1))[i] = 0.f; }
    const float* x = P.in[0]; const float* gmix = P.in[2]; const float* gbias = P.in[5];
    bf16* XN = (bf16*)(ws + WS_XN); float* IFb = (float*)(ws + WS_IF);
    for (int m = gw; m < NTOK; m += NGW) {
        const float* xrow = x + (size_t)m * 1024;
        f32x4 v[4]; float s = 0.f;
#pragma unroll
        for (int j = 0; j < 4; ++j) { v[j] = ((const f32x4*)xrow)[lane + 64 * j]; s += (v[j][0] * v[j][0] + v[j][1] * v[j][1]) + (v[j][2] * v[j][2] + v[j][3] * v[j][3]); }
        const float rstd = rsqrtf(wave_sum(s) * (1.f / 1024.f) + EPS);
        float a8[8] = {0.f, 0.f, 0.f, 0.f, 0.f, 0.f, 0.f, 0.f};
#pragma unroll
        for (int j = 0; j < 4; ++j) {
            const f32x4 g = ((const f32x4*)gmix)[lane + 64 * j];
#pragma unroll
            for (int i = 0; i < 4; ++i) { v[j][i] = v[j][i] * rstd * g[i]; const int d = 4 * (lane + 64 * j) + i; const f32x4 wa = *(const LAS f32x4*)(wif + d * 8), wb = *(const LAS f32x4*)(wif + d * 8 + 4);
                a8[0] += v[j][i] * wa[0]; a8[1] += v[j][i] * wa[1]; a8[2] += v[j][i] * wa[2]; a8[3] += v[j][i] * wa[3]; a8[4] += v[j][i] * wb[0]; a8[5] += v[j][i] * wb[1]; a8[6] += v[j][i] * wb[2]; a8[7] += v[j][i] * wb[3]; }
            uint2 o; o.x = pk2(v[j][0], v[j][1]); o.y = pk2(v[j][2], v[j][3]); ((uint2*)(XN + (size_t)m * 1024))[lane + 64 * j] = o;
        }
#pragma unroll
        for (int c = 0; c < 8; ++c) a8[c] = wave_sum(a8[c]);
        if (lane == 0) {
#pragma unroll
            for (int c = 0; c < 8; ++c) IFb[(size_t)m * 8 + c] = a8[c] + gbias[c];
        }
    }
}

typedef short bf16x8 __attribute__((ext_vector_type(8)));
typedef short v4i16 __attribute__((ext_vector_type(4)));
#define MFMA16(a, b, c) __builtin_amdgcn_mfma_f32_16x16x32_bf16((a), (b), (c), 0, 0, 0)
__device__ __forceinline__ void attn_pair_params(int pp, int& d, int& n0, int& sh) {
    if (pp < 5) { d = 16; sh = 4; n0 = -144 + 32 * pp; } else if (pp < 11) { d = 4; sh = 2; n0 = -128 + 32 * (pp - 5); } else { d = 1; sh = 0; n0 = -128 + 32 * (pp - 11); }
}
#define ATT_LOAD(SET, PPX) do { int d_, n_, sh_; attn_pair_params((PPX) < 23 ? (PPX) : 22, d_, n_, sh_); \
    _Pragma("unroll") for (int c = 0; c < 4; ++c) { int tok = t0 + d_ * (n_ + 8 * c + lrow); tok = min(max(tok, 0), SEQ - 1); const bf16* rp = base + 512 + (size_t)tok * 1536 + 8 * lch; \
        kr[SET][c] = *(const v4u*)rp; vr[SET][c] = *(const v4u*)(rp + 512); } } while (0)
__device__ __forceinline__ void p2_attention(const Params& P, LAS unsigned char* lds, int lane, int wave, int vb) {
    const bf16* QKVA = (const bf16*)(P.ws + WS_QKVA); bf16* YA = (bf16*)(P.ws + WS_YA);
    LAS unsigned char* kbuf = lds + wave * 9728;
    LAS unsigned char* vbuf = kbuf + 4608;
    const int r = lane & 15, g = lane >> 4, lrow = lane >> 3, lch = lane & 7;
    const int trq = (lane >> 2) & 3, trp = lane & 3;
    const int tr_off = (4 * g + trq) * 160 + trp * 8;
    for (int wi = vb; wi < 1024; wi += gridDim.x) {
        const int bh = wi >> 6, tb = wi & 63, b = bh >> 3, h = bh & 7;
        const bf16* base = QKVA + (size_t)b * SEQ * 1536 + h * 64;
#pragma unroll 1
        for (int uu = 0; uu < 2; ++uu) {
            const int t0 = tb * 256 + wave * 2 + uu, tq = t0 + 16 * r;
            const bf16x8 qb0 = *(const bf16x8*)(base + (size_t)tq * 1536 + 8 * g), qb1 = *(const bf16x8*)(base + (size_t)tq * 1536 + 32 + 8 * g);
            f32x4 o[4];
#pragma unroll
            for (int i = 0; i < 4; ++i) o[i] = (f32x4){0.f, 0.f, 0.f, 0.f};
            float m = -1e30f, l = 0.f;
            v4u kr[4][4], vr[4][4];
            ATT_LOAD(0, 0); ATT_LOAD(1, 1); ATT_LOAD(2, 2); ATT_LOAD(3, 3);
#pragma unroll 1
            for (int pp0 = 0; pp0 < 24; pp0 += 4) {
#pragma unroll
                for (int u = 0; u < 4; ++u) {
                    const int pp = pp0 + u; const bool active = pp < 23;
                    int d, n0, sh; attn_pair_params(active ? pp : 22, d, n0, sh);
                    const int hi = r << (4 - sh), lo = max(hi - 128, -(t0 >> sh));
#pragma unroll
                    for (int c = 0; c < 4; ++c) { *(LAS v4u*)(kbuf + (8 * c + lrow) * 144 + lch * 16) = kr[u][c]; *(LAS v4u*)(vbuf + (8 * c + lrow) * 160 + lch * 16) = vr[u][c]; }
                    ATT_LOAD(u, pp + 4);
                    f32x4 s0 = {0.f, 0.f, 0.f, 0.f}, s1 = {0.f, 0.f, 0.f, 0.f};
                    { const bf16x8 k00 = *(const LAS bf16x8*)(kbuf + r * 144 + g * 16), k01 = *(const LAS bf16x8*)(kbuf + r * 144 + 64 + g * 16);
                      const bf16x8 k10 = *(const LAS bf16x8*)(kbuf + (16 + r) * 144 + g * 16), k11 = *(const LAS bf16x8*)(kbuf + (16 + r) * 144 + 64 + g * 16);
                      s0 = MFMA16(k00, qb0, s0); s0 = MFMA16(k01, qb1, s0); s1 = MFMA16(k10, qb0, s1); s1 = MFMA16(k11, qb1, s1); }
                    bool v0[4], v1[4]; float mx = -1e30f;
#pragma unroll
                    for (int k = 0; k < 4; ++k) { const int na = n0 + 4 * g + k, nb = na + 16; v0[k] = active && (na >= lo) && (na <= hi); v1[k] = active && (nb >= lo) && (nb <= hi);
                        mx = fmaxf(mx, v0[k] ? s0[k] : -1e30f); mx = fmaxf(mx, v1[k] ? s1[k] : -1e30f); }
                    mx = fmaxf(mx, __shfl_xor(mx, 16)); mx = fmaxf(mx, __shfl_xor(mx, 32));
                    const float mn = fmaxf(m, mx), alpha = __builtin_amdgcn_exp2f(m - mn); m = mn;
                    float p0[4], p1[4], ps = 0.f;
#pragma unroll
                    for (int k = 0; k < 4; ++k) { p0[k] = v0[k] ? __builtin_amdgcn_exp2f(s0[k] - mn) : 0.f; p1[k] = v1[k] ? __builtin_amdgcn_exp2f(s1[k] - mn) : 0.f; ps += p0[k] + p1[k]; }
                    l = l * alpha + ps;
#pragma unroll
                    for (int i = 0; i < 4; ++i) o[i] = o[i] * alpha;
                    bf16x8 pb; { v4u w; w.x = pk2(p0[0], p0[1]); w.y = pk2(p0[2], p0[3]); w.z = pk2(p1[0], p1[1]); w.w = pk2(p1[2], p1[3]); pb = __builtin_bit_cast(bf16x8, w); }
                    LAS unsigned char* vrd = vbuf + tr_off;
#pragma unroll
                    for (int db = 0; db < 4; ++db) {
                        const v4i16 a0 = __builtin_amdgcn_ds_read_tr16_b64_v4i16((LAS v4i16*)(vrd + db * 32)), a1 = __builtin_amdgcn_ds_read_tr16_b64_v4i16((LAS v4i16*)(vrd + 16 * 160 + db * 32));
                        bf16x8 va; va[0] = a0[0]; va[1] = a0[1]; va[2] = a0[2]; va[3] = a0[3]; va[4] = a1[0]; va[5] = a1[1]; va[6] = a1[2]; va[7] = a1[3];
                        o[db] = MFMA16(va, pb, o[db]);
                    }
                }
            }
            l += __shfl_xor(l, 16); l += __shfl_xor(l, 32);
            const float inv = 1.0f / l;
            bf16* yo = YA + ((size_t)b * SEQ + tq) * 512 + h * 64 + 4 * g;
#pragma unroll
            for (int db = 0; db < 4; ++db) { uint2 w; w.x = pk2(o[db][0] * inv, o[db][1] * inv); w.y = pk2(o[db][2] * inv, o[db][3] * inv); *(uint2*)(yo + 16 * db) = w; }
        }
    }
}

__device__ __forceinline__ float conv_silu(const bf16* QKM, const float* cw, int b, int t, int ch) {
    float a = 0.f;
#pragma unroll
    for (int j = 0; j < 4; ++j) { const int tt = t - 3 + j; if (tt >= 0) a += cw[j * 1024 + ch] * bf2f(QKM[((size_t)b * SEQ + tt) * 1024 + ch]); }
    return silu(a);
}

__device__ __forceinline__ float scan_add(float v, int lane) {
#pragma unroll
    for (int o = 1; o < 64; o <<= 1) { const float u = __shfl_up(v, o); if (lane >= o) v += u; }
    return v;
}
__device__ __forceinline__ float scan_max(float v, int lane) {
#pragma unroll
    for (int o = 1; o < 64; o <<= 1) { const float u = __shfl_up(v, o); if (lane >= o) v = fmaxf(v, u); }
    return v;
}
__device__ __forceinline__ float wave_max(float v) {
#pragma unroll
    for (int o = 1; o < 64; o <<= 1) v = fmaxf(v, __shfl_xor(v, o));
    return v;
}
__device__ __forceinline__ void conv16(const bf16* QKM, const float* cw, int b, int t0, int chan, float* out) {
    const bf16* src = QKM + (size_t)b * SEQ * 1024 + chan;
    const float w0 = cw[chan], w1 = cw[1024 + chan], w2 = cw[2048 + chan], w3 = cw[3072 + chan];
    float x0 = t0 >= 3 ? bf2f(src[(size_t)(t0 - 3) * 1024]) : 0.f, x1 = t0 >= 2 ? bf2f(src[(size_t)(t0 - 2) * 1024]) : 0.f, x2 = t0 >= 1 ? bf2f(src[(size_t)(t0 - 1) * 1024]) : 0.f;
#pragma unroll
    for (int i = 0; i < 16; ++i) { const float x3 = bf2f(src[(size_t)(t0 + i) * 1024]); out[i] = silu(w0 * x0 + w1 * x1 + w2 * x2 + w3 * x3); x0 = x1; x1 = x2; x2 = x3; }
}

__device__ __forceinline__ void p2_mlstm_local(const Params& P, LAS unsigned char* lds, int tid, int lane, int wave, int vb) {
    const bf16* QKM = (const bf16*)(P.ws + WS_QKM); const bf16* VM = (const bf16*)(P.ws + WS_VM); const float* IFb = (const float*)(P.ws + WS_IF);
    const float* cw = P.in[4];
    bf16* DC = (bf16*)((unsigned char*)P.out + OUT_DC); float* DN = (float*)(P.ws + WS_DN); float* SC = (float*)(P.ws + WS_SC);
    LAS bf16* KWT = (LAS bf16*)lds; LAS bf16* VT = (LAS bf16*)(lds + 18432); LAS float* sw = (LAS float*)(lds + 36864);
    const int r = lane & 15, g = lane >> 4;
    for (int item = vb; item < 2048; item += gridDim.x) {
        const int bh = item >> 8, c = item & 255, b = bh >> 2, h = bh & 3;
        if (wave == 0) {
            const size_t row = (size_t)b * SEQ + c * 64 + lane;
            const float lf = logsigmoid(IFb[row * 8 + 4 + h]), ip = IFb[row * 8 + h];
            const float bc = scan_add(lf, lane), gg = __shfl(bc, 63), ds = gg - bc + ip, ml = wave_max(ds);
            sw[lane] = __expf(ds - ml);
            if (lane == 0) { SC[item] = ml; SC[2048 + item] = gg; }
        }
        __syncthreads();
        { const int ch = tid & 127, sq = tid >> 7, s0 = sq * 16; float o[16];
          conv16(QKM, cw, b, c * 64 + s0, 512 + h * 128 + ch, o);
#pragma unroll
          for (int i = 0; i < 16; i += 2) *(LAS unsigned*)(KWT + ch * 72 + s0 + i) = pk2(o[i] * 0.08838834764831845f * sw[s0 + i], o[i + 1] * 0.08838834764831845f * sw[s0 + i + 1]);
          const bf16* vsrc = VM + ((size_t)b * SEQ + c * 64 + s0) * 512 + h * 128 + ch;
#pragma unroll
          for (int i = 0; i < 16; i += 2) *(LAS unsigned*)(VT + ch * 72 + s0 + i) = (unsigned)vsrc[(size_t)i * 512] | ((unsigned)vsrc[(size_t)(i + 1) * 512] << 16);
        }
        __syncthreads();
        {
          const bf16x8 vb0 = *(const LAS bf16x8*)(VT + (16 * wave + r) * 72 + 8 * g), vb1 = *(const LAS bf16x8*)(VT + (16 * wave + r) * 72 + 32 + 8 * g);
          bf16* dst = DC + (size_t)item * 16384 + (size_t)(16 * wave + r) * 128 + 4 * g;
#pragma unroll
          for (int eb = 0; eb < 8; ++eb) {
              const bf16x8 ka0 = *(const LAS bf16x8*)(KWT + (16 * eb + r) * 72 + 8 * g), ka1 = *(const LAS bf16x8*)(KWT + (16 * eb + r) * 72 + 32 + 8 * g);
              f32x4 acc = {0.f, 0.f, 0.f, 0.f};
              acc = MFMA16(ka0, vb0, acc); acc = MFMA16(ka1, vb1, acc);
              uint2 o; o.x = pk2(acc[0], acc[1]); o.y = pk2(acc[2], acc[3]); *(uint2*)(dst + 16 * eb) = o;
          }
        }
        if (tid < 128) { float a = 0.f;
#pragma unroll
            for (int cc = 0; cc < 8; ++cc) { float f[8]; unpk8(*(const LAS v4u*)(KWT + tid * 72 + 8 * cc), f);
#pragma unroll
                for (int k = 0; k < 8; ++k) a += f[k]; }
            DN[(size_t)item * 128 + tid] = a; }
        __syncthreads();
    }
}

__device__ __forceinline__ void p3_mlstm_scan(const Params& P, int tid, int vb) {
    const unsigned* __restrict__ DC = (const unsigned*)((unsigned char*)P.out + OUT_DC); unsigned* __restrict__ CS = (unsigned*)((unsigned char*)P.out + OUT_CS);
    const float* __restrict__ DN = (const float*)(P.ws + WS_DN); float* __restrict__ NS = (float*)(P.ws + WS_NS); float* SC = (float*)(P.ws + WS_SC);
    for (int gid = vb * 512 + tid; gid < 8 * 8192; gid += gridDim.x * 512) {
        const int bh = gid >> 13, idx = gid & 8191; const bool hasn = idx < 64;
        float C0 = 0.f, C1 = 0.f, n0 = 0.f, n1 = 0.f, m = 0.f;
        for (int j0 = 0; j0 < 256; j0 += 8) {
            unsigned d[8]; float ml[8], gg[8]; float2 dn[8];
#pragma unroll
            for (int u = 0; u < 8; ++u) { const int item = bh * 256 + j0 + u; d[u] = DC[(size_t)item * 8192 + idx]; ml[u] = SC[item]; gg[u] = SC[2048 + item];
                dn[u] = hasn ? *(const float2*)(DN + (size_t)item * 128 + 2 * idx) : make_float2(0.f, 0.f); }
#pragma unroll
            for (int u = 0; u < 8; ++u) { const int item = bh * 256 + j0 + u;
                CS[(size_t)item * 8192 + idx] = pk2(C0, C1);
                if (hasn) *(float2*)(NS + (size_t)item * 128 + 2 * idx) = make_float2(n0, n1);
                if (idx == 0) SC[4096 + item] = m;
                const float mn = fmaxf(gg[u] + m, ml[u]), a = __expf(gg[u] + m - mn), bb = __expf(ml[u] - mn);
                C0 = a * C0 + bb * bf_lo(d[u]); C1 = a * C1 + bb * bf_hi(d[u]); n0 = a * n0 + bb * dn[u].x; n1 = a * n1 + bb * dn[u].y; m = mn; }
        }
    }
}

__device__ __forceinline__ void p4_mlstm_out(const Params& P, LAS unsigned char* lds, int tid, int lane, int wave, int vb) {
    const bf16* QKM = (const bf16*)(P.ws + WS_QKM); const bf16* VM = (const bf16*)(P.ws + WS_VM); const bf16* OM = (const bf16*)(P.ws + WS_OM); const float* IFb = (const float*)(P.ws + WS_IF);
    const float* cw = P.in[4]; const float* mnorm = P.in[6];
    const bf16* CS = (const bf16*)((unsigned char*)P.out + OUT_CS); const float* NS = (const float*)(P.ws + WS_NS); const float* SC = (const float*)(P.ws + WS_SC);
    bf16* YM = (bf16*)(P.ws + WS_YM);
    LAS bf16* Qs = (LAS bf16*)lds; LAS bf16* Ks = (LAS bf16*)(lds + 17408); LAS bf16* VT = (LAS bf16*)(lds + 34816); LAS bf16* PT = (LAS bf16*)(lds + 53248);
    LAS float* sm = (LAS float*)(lds + 62464);
    const int r = lane & 15, g = lane >> 4;
    for (int item = vb; item < 2048; item += gridDim.x) {
        const int bh = item >> 8, c = item & 255, b = bh >> 2, h = bh & 3;
        if (wave == 0) {
            const size_t row = (size_t)b * SEQ + c * 64 + lane;
            const float lf = logsigmoid(IFb[row * 8 + 4 + h]), ip = IFb[row * 8 + h];
            const float bc = scan_add(lf, lane), a = ip - bc, pm = scan_max(a, lane), ms = SC[4096 + item], M = fmaxf(ms, pm);
            sm[lane] = a; sm[64 + lane] = M; sm[128 + lane] = __expf(ms - M); sm[192 + lane] = __expf(-bc - M);
        } else if (wave < 3) sm[320 + tid - 64] = NS[(size_t)item * 128 + tid - 64];
        { const int ch = tid & 127, sq = tid >> 7, s0 = sq * 16; float o[16];
          conv16(QKM, cw, b, c * 64 + s0, h * 128 + ch, o);
#pragma unroll
          for (int i = 0; i < 16; ++i) Qs[(s0 + i) * 136 + ch] = (bf16)f2bf(o[i]);
          conv16(QKM, cw, b, c * 64 + s0, 512 + h * 128 + ch, o);
#pragma unroll
          for (int i = 0; i < 16; ++i) Ks[(s0 + i) * 136 + ch] = (bf16)f2bf(o[i] * 0.08838834764831845f);
          const bf16* vsrc = VM + ((size_t)b * SEQ + c * 64 + s0) * 512 + h * 128 + ch;
#pragma unroll
          for (int i = 0; i < 16; i += 2) *(LAS unsigned*)(VT + ch * 72 + s0 + i) = (unsigned)vsrc[(size_t)i * 512] | ((unsigned)vsrc[(size_t)(i + 1) * 512] << 16);
        }
        __syncthreads();
        {
          const int sb = wave >> 1;
          bf16x8 ka[4];
#pragma unroll
          for (int ks = 0; ks < 4; ++ks) ka[ks] = *(const LAS bf16x8*)(Ks + (16 * sb + r) * 136 + 32 * ks + 8 * g);
#pragma unroll
          for (int tt = 0; tt < 2; ++tt) { const int tb = 2 * (wave & 1) + tt, t = 16 * tb + r;
              f32x4 acc = {0.f, 0.f, 0.f, 0.f};
#pragma unroll
              for (int ks = 0; ks < 4; ++ks) { const bf16x8 qb = *(const LAS bf16x8*)(Qs + t * 136 + 32 * ks + 8 * g); acc = MFMA16(ka[ks], qb, acc); }
              const float Mt = sm[64 + t]; float p[4];
#pragma unroll
              for (int k = 0; k < 4; ++k) { const int s = 16 * sb + 4 * g + k; p[k] = (s <= t) ? acc[k] * __expf(sm[s] - Mt) : 0.f; }
              v2u o; o.x = pk2(p[0], p[1]); o.y = pk2(p[2], p[3]); *(LAS v2u*)(PT + t * 72 + 16 * sb + 4 * g) = o; }
        }
        __syncthreads();
        if (tid < 64) { const int t = tid; float sp = 0.f, qn = 0.f;
#pragma unroll
            for (int cc = 0; cc < 8; ++cc) { float f[8]; unpk8(*(const LAS v4u*)(PT + t * 72 + 8 * cc), f);
#pragma unroll
                for (int k = 0; k < 8; ++k) sp += f[k]; }
#pragma unroll
            for (int cc = 0; cc < 16; ++cc) { float f[8]; unpk8(*(const LAS v4u*)(Qs + t * 136 + 8 * cc), f);
#pragma unroll
                for (int k = 0; k < 8; ++k) qn += f[k] * sm[320 + 8 * cc + k]; }
            sm[256 + t] = fmaxf(fabsf(sm[128 + t] * qn + sp), sm[192 + t]); }
        f32x4 ai[4], ac[4];
#pragma unroll
        for (int tb = 0; tb < 4; ++tb) { ai[tb] = (f32x4){0.f, 0.f, 0.f, 0.f}; ac[tb] = (f32x4){0.f, 0.f, 0.f, 0.f}; }
        {
          const bf16x8 va0 = *(const LAS bf16x8*)(VT + (16 * wave + r) * 72 + 8 * g), va1 = *(const LAS bf16x8*)(VT + (16 * wave + r) * 72 + 32 + 8 * g);
          bf16x8 ca[4];
          const bf16* crow = CS + (size_t)item * 16384 + (size_t)(16 * wave + r) * 128 + 8 * g;
#pragma unroll
          for (int ks = 0; ks < 4; ++ks) ca[ks] = *(const bf16x8*)(crow + 32 * ks);
#pragma unroll
          for (int tb = 0; tb < 4; ++tb) { const int t = 16 * tb + r;
              const bf16x8 pb0 = *(const LAS bf16x8*)(PT + t * 72 + 8 * g), pb1 = *(const LAS bf16x8*)(PT + t * 72 + 32 + 8 * g);
              ai[tb] = MFMA16(va0, pb0, ai[tb]); ai[tb] = MFMA16(va1, pb1, ai[tb]);
#pragma unroll
              for (int ks = 0; ks < 4; ++ks) { const bf16x8 qb = *(const LAS bf16x8*)(Qs + t * 136 + 32 * ks + 8 * g); ac[tb] = MFMA16(ca[ks], qb, ac[tb]); } }
        }
        __syncthreads();
        float ssq[4];
#pragma unroll
        for (int tb = 0; tb < 4; ++tb) { const int t = 16 * tb + r; const float wi = sm[128 + t], inv = 1.0f / sm[256 + t]; float s2 = 0.f;
#pragma unroll
            for (int k = 0; k < 4; ++k) { ai[tb][k] = (wi * ac[tb][k] + ai[tb][k]) * inv; s2 += ai[tb][k] * ai[tb][k]; }
            s2 += __shfl_xor(s2, 16); s2 += __shfl_xor(s2, 32); ssq[tb] = s2;
            if (g == 0) sm[448 + wave * 64 + t] = s2; }
        __syncthreads();
#pragma unroll
        for (int tb = 0; tb < 4; ++tb) { const int t = 16 * tb + r; float tot = 0.f;
#pragma unroll
            for (int w = 0; w < 8; ++w) tot += sm[448 + w * 64 + t];
            const float rs = rsqrtf(tot * (1.f / 128.f) + EPS);
            const size_t row = (size_t)b * SEQ + c * 64 + t; const int col = h * 128 + 16 * wave + 4 * g;
            const uint2 omw = *(const uint2*)(OM + row * 512 + col); const f32x4 gn = *(const f32x4*)(mnorm + col);
            uint2 o; o.x = pk2(ai[tb][0] * rs * gn[0] * bf_lo(omw.x), ai[tb][1] * rs * gn[1] * bf_hi(omw.x)); o.y = pk2(ai[tb][2] * rs * gn[2] * bf_lo(omw.y), ai[tb][3] * rs * gn[3] * bf_hi(omw.y));
            *(uint2*)(YM + row * 512 + col) = o; }
        __syncthreads();
    }
}

__device__ __forceinline__ int f2ord(float f) { const int b = __float_as_int(f); return b ^ ((b >> 31) & 0x7fffffff); }
__device__ __forceinline__ float ord2f(int o) { return __int_as_float(o ^ ((o >> 31) & 0x7fffffff)); }
#define CE_DESC(a, i, j) { const int _h = max(a[i], a[j]), _l = min(a[i], a[j]); a[i] = _h; a[j] = _l; }
__device__ __forceinline__ void sort16_desc(int (&a)[16]) {
#pragma unroll
    for (int k = 2; k <= 16; k <<= 1) {
#pragma unroll
        for (int j = k >> 1; j > 0; j >>= 1) {
#pragma unroll
            for (int i = 0; i < 16; ++i) { const int l = i ^ j; if (l > i) { if ((i & k) == 0) CE_DESC(a, i, l) else CE_DESC(a, l, i) } }
        }
    }
}
__device__ __forceinline__ void merge16_desc(int (&a)[16], const int (&b)[16]) {
#pragma unroll
    for (int i = 0; i < 16; ++i) a[i] = max(a[i], b[15 - i]);
#pragma unroll
    for (int j = 8; j > 0; j >>= 1) {
#pragma unroll
        for (int i = 0; i < 16; ++i) { const int l = i ^ j; if (l > i) CE_DESC(a, i, l) }
    }
}
__device__ __forceinline__ void xmerge16(int (&a)[16], int mask) {
    int b[16];
#pragma unroll
    for (int i = 0; i < 16; ++i) b[i] = __shfl_xor(a[i], mask);
    merge16_desc(a, b);
}
__device__ __forceinline__ void p10_topk(const Params& P, LAS unsigned char* lds, int tid, int lane, int wave, int vb) {
    const bf16* Q2 = (const bf16*)(P.ws + WS_Q2); const bf16* K1B = (const bf16*)(P.ws + WS_K1B); const bf16* K2B = (const bf16*)(P.ws + WS_K2B);
    int* IDX = (int*)(P.ws + WS_IDX); float* GATE = (float*)(P.ws + WS_GATE); const float* SSQ1 = (const float*)(P.ws + WS_SSQ1);
    LAS bf16* Kl = (LAS bf16*)lds;
    LAS int* Tb = (LAS int*)(lds + 69632 + wave * 2048);
    const int r = lane & 15, g = lane >> 4;
    const int h = vb & 7, wgx = vb >> 3, nwg = gridDim.x >> 3;
    __syncthreads();
    for (int i = tid; i < 4096; i += 512) { const int half = i >> 11, rem = i & 2047, n = rem >> 4, c = rem & 15;
        *(LAS v4u*)(Kl + half * 17408 + n * 136 + c * 8) = *(const v4u*)((half ? K2B : K1B) + (size_t)h * 16384 + n * 128 + c * 8); }
    __syncthreads();
    for (int tile = wgx * NW + wave; tile < NTOK / 16; tile += nwg * NW) {
        const size_t row = (size_t)tile * 16 + r;
        int R[2][16];
#pragma unroll
        for (int half = 0; half < 2; ++half) {
            bf16x8 qb[4];
#pragma unroll
            for (int ks = 0; ks < 4; ++ks) qb[ks] = *(const bf16x8*)(Q2 + row * 2048 + h * 256 + half * 128 + 32 * ks + 8 * g);
            int X[16], Y[16];
#pragma unroll
            for (int nb = 0; nb < 8; ++nb) {
                f32x4 acc = {0.f, 0.f, 0.f, 0.f};
#pragma unroll
                for (int ks = 0; ks < 4; ++ks) acc = MFMA16(*(const LAS bf16x8*)(Kl + half * 17408 + (16 * nb + r) * 136 + 32 * ks + 8 * g), qb[ks], acc);
#pragma unroll
                for (int k = 0; k < 4; ++k) { const int key = (f2ord(acc[k]) & ~0x7f) | (16 * nb + 4 * g + k); if (nb < 4) X[4 * nb + k] = key; else Y[4 * (nb - 4) + k] = key; }
            }
            sort16_desc(X); sort16_desc(Y); merge16_desc(X, Y);
            xmerge16(X, 16); xmerge16(X, 32);
#pragma unroll
            for (int i = 0; i < 16; ++i) R[half][i] = X[i];
        }
        if (g == 0) {
#pragma unroll
            for (int i = 0; i < 16; ++i) { Tb[r * 32 + i] = R[0][i] & 0x7f; Tb[r * 32 + 16 + i] = R[1][i] & 0x7f; }
        }
        float F1[16], F2[16];
#pragma unroll
        for (int i = 0; i < 16; ++i) { F1[i] = ord2f(R[0][i] & ~0x7f); F2[i] = ord2f(R[1][i] & ~0x7f); }
        int C[16];
#pragma unroll
        for (int sl = 0; sl < 16; ++sl) {
            const int a1 = sl < 8 ? 1 : (sl < 13 ? 2 : -1), b1 = sl < 8 ? sl : sl - 8;
            const int a2 = sl < 4 ? 3 : (sl < 7 ? 4 : (sl < 9 ? 5 : (sl < 11 ? 6 : (sl < 13 ? 7 : -1)))), b2 = sl < 4 ? sl : (sl < 7 ? sl - 4 : (sl < 9 ? sl - 7 : (sl < 11 ? sl - 9 : sl - 11)));
            const int a3 = sl < 8 ? 8 + sl : -1;
            const int k0 = (f2ord(F1[0] + F2[sl]) & ~0xff) | (0 << 4) | sl;
            const int k1 = a1 >= 0 ? ((f2ord(F1[a1 < 0 ? 0 : a1] + F2[b1 & 15]) & ~0xff) | (a1 << 4) | (b1 & 15)) : (int)0x80000000;
            const int k2 = a2 >= 0 ? ((f2ord(F1[a2 < 0 ? 0 : a2] + F2[b2 & 15]) & ~0xff) | (a2 << 4) | (b2 & 15)) : (int)0x80000000;
            const int k3 = a3 >= 0 ? ((f2ord(F1[a3 < 0 ? 0 : a3] + F2[0]) & ~0xff) | (a3 << 4)) : (int)0x80000000;
            C[sl] = g == 0 ? k0 : (g == 1 ? k1 : (g == 2 ? k2 : k3));
        }
        sort16_desc(C); xmerge16(C, 16); xmerge16(C, 32);
        const float rstd1 = rsqrtf(SSQ1[row] * (1.0f / 1024.0f) + EPS);
        float e[16], sum = 0.f; const float mx = ord2f(C[0] & ~0xff);
#pragma unroll
        for (int i = 0; i < 16; ++i) { e[i] = __expf((ord2f(C[i] & ~0xff) - mx) * rstd1); sum += e[i]; }
        const float inv = 1.0f / sum;
        int oi[4]; float og[4];
#pragma unroll
        for (int kk = 0; kk < 4; ++kk) {
            const int key = g == 0 ? C[kk] : (g == 1 ? C[4 + kk] : (g == 2 ? C[8 + kk] : C[12 + kk]));
            const float ev = g == 0 ? e[kk] : (g == 1 ? e[4 + kk] : (g == 2 ? e[8 + kk] : e[12 + kk]));
            const int a = (key >> 4) & 15, bq = key & 15;
            oi[kk] = Tb[r * 32 + a] * 128 + Tb[r * 32 + 16 + bq]; og[kk] = ev * inv;
        }
#pragma unroll
        for (int kk = 0; kk < 4; ++kk) { const int pos = (4 * (g & 1) + kk) * 16 + 2 * h + (g >> 1); IDX[row * 128 + pos] = oi[kk]; GATE[row * 128 + pos] = og[kk]; }
    }
}

typedef _Float16 f16x2 __attribute__((ext_vector_type(2)));
__device__ __forceinline__ f16x2 bfpair_to_h2(unsigned w) { return __builtin_bit_cast(f16x2, __builtin_amdgcn_cvt_pkrtz(bf_lo(w), bf_hi(w))); }
__device__ __forceinline__ f16x2 fp8lo_to_h2(unsigned w) { return __builtin_bit_cast(f16x2, __builtin_amdgcn_cvt_scalef32_pk_f16_fp8((int)w, 1.0f, false)); }
__device__ __forceinline__ f16x2 fp8hi_to_h2(unsigned w) { return __builtin_bit_cast(f16x2, __builtin_amdgcn_cvt_scalef32_pk_f16_fp8((int)w, 1.0f, true)); }
__device__ __forceinline__ void p11a_udot(const Params& P, int lane, int wave, int vb) {
    const bf16* HN = (const bf16*)(P.ws + WS_HN); const unsigned char* U8 = P.ws + WS_U8; const int* IDX = (const int*)(P.ws + WS_IDX); float* PART = (float*)(P.ws + WS_PART);
    const int x = vb & 7, wgx = vb >> 3, nwg = gridDim.x >> 3, rg = lane >> 3, ch = lane & 7;
    for (int t = wgx * NW + wave; t < NTOK; t += nwg * NW) {
        int e[16];
#pragma unroll
        for (int q = 0; q < 4; ++q) { const int4 v = *(const int4*)(IDX + (size_t)t * 128 + rg * 16 + 4 * q); e[4 * q] = v.x; e[4 * q + 1] = v.y; e[4 * q + 2] = v.z; e[4 * q + 3] = v.w; }
        const v4u h0 = *(const v4u*)(HN + (size_t)t * 1024 + 128 * x + 16 * ch), h1 = *(const v4u*)(HN + (size_t)t * 1024 + 128 * x + 16 * ch + 8);
        v4u ud[16];
#pragma unroll
        for (int gq = 0; gq < 16; ++gq) ud[gq] = *(const v4u*)(U8 + (size_t)e[gq] * 1024 + 128 * x + 16 * ch);
        f16x2 hh[8]; hh[0] = bfpair_to_h2(h0.x); hh[1] = bfpair_to_h2(h0.y); hh[2] = bfpair_to_h2(h0.z); hh[3] = bfpair_to_h2(h0.w); hh[4] = bfpair_to_h2(h1.x); hh[5] = bfpair_to_h2(h1.y); hh[6] = bfpair_to_h2(h1.z); hh[7] = bfpair_to_h2(h1.w);
        float z[16];
#pragma unroll
        for (int gq = 0; gq < 16; ++gq) { float d = 0.f; const unsigned w4[4] = {ud[gq].x, ud[gq].y, ud[gq].z, ud[gq].w};
#pragma unroll
            for (int q = 0; q < 4; ++q) { d = __builtin_amdgcn_fdot2(fp8lo_to_h2(w4[q]), hh[2 * q], d, false); d = __builtin_amdgcn_fdot2(fp8hi_to_h2(w4[q]), hh[2 * q + 1], d, false); }
            z[gq] = d; }
        float z8[8], z4[4], z2[2];
        { const bool b = ch & 4;
#pragma unroll
          for (int i = 0; i < 8; ++i) { const float keep = b ? z[8 + i] : z[i], send = b ? z[i] : z[8 + i]; z8[i] = keep + __shfl_xor(send, 4); } }
        { const bool b = ch & 2;
#pragma unroll
          for (int i = 0; i < 4; ++i) { const float keep = b ? z8[4 + i] : z8[i], send = b ? z8[i] : z8[4 + i]; z4[i] = keep + __shfl_xor(send, 2); } }
        { const bool b = ch & 1;
#pragma unroll
          for (int i = 0; i < 2; ++i) { const float keep = b ? z4[2 + i] : z4[i], send = b ? z4[i] : z4[2 + i]; z2[i] = keep + __shfl_xor(send, 1); } }
        *(float2*)(PART + ((size_t)t * 8 + x) * 128 + rg * 16 + 2 * ch) = make_float2(z2[0], z2[1]);
    }
}
__device__ __forceinline__ void p11b_weights(const Params& P, int tid, int vb) {
    const float* PART = (const float*)(P.ws + WS_PART); float* GW = (float*)(P.ws + WS_GATE); const float* SSQ1 = (const float*)(P.ws + WS_SSQ1);
    for (size_t i = (size_t)vb * 512 + tid; i < (size_t)NTOK * 128; i += (size_t)gridDim.x * 512) {
        const size_t t = i >> 7, pos = i & 127; float zs = 0.f;
#pragma unroll
        for (int x = 0; x < 8; ++x) zs += PART[(t * 8 + x) * 128 + pos];
        const float zv = zs * (1.0f / SCALE_U) * rsqrtf(SSQ1[t] * (1.0f / 1024.0f) + EPS);
        GW[i] = GW[i] * 0.5f * zv * (1.0f + erff(zv * 0.70710678118654752f));
    }
}
__device__ __forceinline__ void p11c_vacc(const Params& P, int lane, int wave, int vb) {
    const unsigned char* V8 = P.ws + WS_V8; const int* IDX = (const int*)(P.ws + WS_IDX); const float* GW = (const float*)(P.ws + WS_GATE);
    float* X = P.out; float* SSQ = (float*)(P.ws + WS_SSQ); bf16* XG = (bf16*)(P.ws + WS_HN2); const float* gple = P.in[16];
    const int x = vb & 7, wgx = vb >> 3, nwg = gridDim.x >> 3, rg = lane >> 3, ch = lane & 7;
    const float2 gp = *(const float2*)(gple + 128 * x + 16 * ch + 2 * rg);
    for (int t = wgx * NW + wave; t < NTOK; t += nwg * NW) {
        int e[16]; float w[16];
#pragma unroll
        for (int q = 0; q < 4; ++q) { const int4 v = *(const int4*)(IDX + (size_t)t * 128 + rg * 16 + 4 * q); e[4 * q] = v.x; e[4 * q + 1] = v.y; e[4 * q + 2] = v.z; e[4 * q + 3] = v.w;
            const float4 wv = *(const float4*)(GW + (size_t)t * 128 + rg * 16 + 4 * q); w[4 * q] = wv.x; w[4 * q + 1] = wv.y; w[4 * q + 2] = wv.z; w[4 * q + 3] = wv.w; }
        v4u vd[16];
#pragma unroll
        for (int gq = 0; gq < 16; ++gq) vd[gq] = *(const v4u*)(V8 + (size_t)e[gq] * 1024 + 128 * x + 16 * ch);
        const float2 xo = *(const float2*)(X + (size_t)t * 1024 + 128 * x + 16 * ch + 2 * rg);
        f16x2 acc[8];
#pragma unroll
        for (int i = 0; i < 8; ++i) acc[i] = (f16x2){(_Float16)0.f, (_Float16)0.f};
#pragma unroll
        for (int gq = 0; gq < 16; ++gq) { const f16x2 ww = __builtin_bit_cast(f16x2, __builtin_amdgcn_cvt_pkrtz(w[gq], w[gq])); const unsigned w4[4] = {vd[gq].x, vd[gq].y, vd[gq].z, vd[gq].w};
#pragma unroll
            for (int q = 0; q < 4; ++q) { acc[2 * q] = __builtin_elementwise_fma(fp8lo_to_h2(w4[q]), ww, acc[2 * q]); acc[2 * q + 1] = __builtin_elementwise_fma(fp8hi_to_h2(w4[q]), ww, acc[2 * q + 1]); } }
        f16x2 a4[4], a2[2], a1;
        { const bool b = rg & 4;
#pragma unroll
          for (int i = 0; i < 4; ++i) { const f16x2 keep = b ? acc[4 + i] : acc[i], send = b ? acc[i] : acc[4 + i]; a4[i] = keep + __builtin_bit_cast(f16x2, __shfl_xor(__builtin_bit_cast(int, send), 32)); } }
        { const bool b = rg & 2;
#pragma unroll
          for (int i = 0; i < 2; ++i) { const f16x2 keep = b ? a4[2 + i] : a4[i], send = b ? a4[i] : a4[2 + i]; a2[i] = keep + __builtin_bit_cast(f16x2, __shfl_xor(__builtin_bit_cast(int, send), 16)); } }
        { const bool b = rg & 1; const f16x2 keep = b ? a2[1] : a2[0], send = b ? a2[0] : a2[1]; a1 = keep + __builtin_bit_cast(f16x2, __shfl_xor(__builtin_bit_cast(int, send), 8)); }
        const float x0 = xo.x + (float)a1[0] * (1.0f / SCALE_V), x1 = xo.y + (float)a1[1] * (1.0f / SCALE_V);
        *(float2*)(X + (size_t)t * 1024 + 128 * x + 16 * ch + 2 * rg) = make_float2(x0, x1);
        *(unsigned*)(XG + (size_t)t * 1024 + 128 * x + 16 * ch + 2 * rg) = pk2(x0 * gp.x, x1 * gp.y);
        const float ss = wave_sum(x0 * x0 + x1 * x1);
        if (lane == 0) atomicAdd(SSQ + t, ss);
    }
}

__global__ void __launch_bounds__(512, 2) mk_fwd(Params P) {
    extern __shared__ __attribute__((aligned(16))) unsigned char lds_raw[];
    cg::grid_group grid = cg::this_grid();
    LAS unsigned char* lds = (LAS unsigned char*)lds_raw;
    const int tid = threadIdx.x, lane = tid & 63, wave = __builtin_amdgcn_readfirstlane(tid >> 6);
    const int lo = P.ph_lo, hi = P.ph_hi, G = gridDim.x, bx = blockIdx.x;
    unsigned char* ws = P.ws;
    const int gw = bx * NW + wave, NGW = G * NW;
#ifndef PH_MASK
#define PH_MASK 0xffff
#endif
#define IN(k) (((PH_MASK >> (k)) & 1) && lo <= (k) && (k) < hi)
    volatile LAS unsigned* xst = (volatile LAS unsigned*)(lds + LDS_BYTES - 16);
    if (tid < 4) xst[tid] = 0u;
    __syncthreads();
    const XcdBarrier bar = xcd_barrier_post((unsigned*)(ws + WS_BAR), xst);
    unsigned* vctl = (unsigned*)(ws + WS_BAR) + 4096;
    if (tid == 0) { const unsigned xcc = xb_xcc_id() & 7u; xst[2] = xcc; xst[3] = xb_add(&vctl[16 * xcc], 1u); }
#ifdef USE_CG
#define GRID_BAR() grid.sync()
#else
#define GRID_BAR() xcd_barrier(bar)
#endif
#define SYNC_AFTER(k) do { if (IN(k) && IN((k) + 1)) { if ((k) == 0) grid.sync(); else GRID_BAR(); } } while (0)
    typedef pg8::bf16_t pb;
    if (IN(0)) p0_prologue(P, lds, tid, lane, wave);
    SYNC_AFTER(0);
    if (tid == 0) {
        const unsigned xcc = xst[2], sl = xst[3], cap = (unsigned)G >> 3; unsigned v;
        if (sl < cap) v = sl * 8u + xcc;
        else { unsigned o = xb_add(&vctl[160], 1u); v = 0u;
            for (unsigned x = 0; x < 8u; ++x) { const unsigned c = min(xb_ld(&vctl[16 * x]), cap), fr = cap - c; if (o < fr) { v = (c + o) * 8u + x; break; } o -= fr; } }
        xst[2] = v;
    }
    __syncthreads();
    const int vb = (int)xst[2];
    if (IN(1)) {
        pg8::Gemm g{(const pb*)(ws + WS_XN), (const pb*)(ws + WS_W1T), NTOK, 5632, 1024}; pg8::StaticOrder S; S.init(NTOK, 5632, G, vb);
        pg8::EpiProj E{(pb*)(ws + WS_QKVA), (pb*)(ws + WS_QKM), (pb*)(ws + WS_VM), (pb*)(ws + WS_OM), (pb*)(ws + WS_G), C2};
        pg8::gemm_phase<pg8::EpiProj, pg8::StaticOrder, true, true>(lds, g, S, E);
    }
    SYNC_AFTER(1);
    if (IN(2)) { p2_attention(P, lds, lane, wave, vb); __syncthreads(); p2_mlstm_local(P, lds, tid, lane, wave, vb); }
    SYNC_AFTER(2);
    if (IN(3)) p3_mlstm_scan(P, tid, vb);
    SYNC_AFTER(3);
    if (IN(4)) p4_mlstm_out(P, lds, tid, lane, wave, vb);
    SYNC_AFTER(4);
    if (IN(5)) {
        pg8::Gemm g{(const pb*)(ws + WS_YA), (const pb*)(ws + WS_WAT), NTOK, 1024, 512}; pg8::StaticOrder S; S.init(NTOK, 1024, G, vb);
        pg8::EpiGated<false> E{(pb*)(ws + WS_TMP), nullptr, (const pb*)(ws + WS_G), 0};
        pg8::gemm_phase<pg8::EpiGated<false>, pg8::StaticOrder, true, true>(lds, g, S, E);
    }
    if (IN(5) && IN(6)) { asm volatile("s_waitcnt vmcnt(0)" ::: "memory"); __syncthreads(); }
    if (IN(6)) {
        pg8::Gemm g{(const pb*)(ws + WS_YM), (const pb*)(ws + WS_WMT), NTOK, 1024, 512}; pg8::StaticOrder S; S.init(NTOK, 1024, G, vb);
        pg8::EpiGated<true> E{(pb*)(ws + WS_MERGED), (const pb*)(ws + WS_TMP), (const pb*)(ws + WS_G), 1024};
        pg8::gemm_phase<pg8::EpiGated<true>, pg8::StaticOrder, true, true>(lds, g, S, E);
    }
    SYNC_AFTER(6);
    if (IN(7)) {
        pg8::Gemm g{(const pb*)(ws + WS_MERGED), (const pb*)(ws + WS_WOT), NTOK, 1024, 1024}; pg8::StaticOrder S; S.init(NTOK, 1024, G, vb);
        pg8::EpiResidual E{P.in[0], P.out, (pb*)(ws + WS_HN), P.in[10], (float*)(ws + WS_SSQ1)};
        pg8::gemm_phase<pg8::EpiResidual, pg8::StaticOrder, true, true>(lds, g, S, E);
    }
    if (IN(7) && IN(9)) GRID_BAR();
    if (IN(9)) {
        pg8::Gemm g{(const pb*)(ws + WS_HN), (const pb*)(ws + WS_WQT), NTOK, 2048, 1024}; pg8::StaticOrder S; S.init(NTOK, 2048, G, vb);
        pg8::EpiStore E{(pb*)(ws + WS_Q2), 2048};
        pg8::gemm_phase<pg8::EpiStore, pg8::StaticOrder, true, true>(lds, g, S, E);
    }
    SYNC_AFTER(9);
    if (IN(10)) p10_topk(P, lds, tid, lane, wave, vb);
    SYNC_AFTER(10);
    if (IN(11)) { p11a_udot(P, lane, wave, vb); GRID_BAR(); p11b_weights(P, tid, vb); GRID_BAR(); p11c_vacc(P, lane, wave, vb); }
    SYNC_AFTER(11);
    if (IN(12)) {
        pg8::Gemm g{(const pb*)(ws + WS_PB), (const pb*)(ws + WS_WPT), NTOK, 1024, 256}; pg8::StaticOrder S; S.init(NTOK, 1024, G, vb);
        pg8::EpiStore E{(pb*)(ws + WS_E), 1024};
        pg8::gemm_phase<pg8::EpiStore, pg8::StaticOrder, true, true>(lds, g, S, E);
    }
    if (IN(12) && IN(13)) { asm volatile("s_waitcnt vmcnt(0)" ::: "memory"); __syncthreads(); }
    if (IN(13)) {
        pg8::Gemm g{(const pb*)(ws + WS_HN2), (const pb*)(ws + WS_WGT), NTOK, 1024, 1024}; pg8::StaticOrder S; S.init(NTOK, 1024, G, vb);
        pg8::EpiPle E{P.out, (const pb*)(ws + WS_E), (const float*)(ws + WS_SSQ)};
        pg8::gemm_phase<pg8::EpiPle, pg8::StaticOrder, true, true>(lds, g, S, E);
    }
    SYNC_AFTER(13);
    if (IN(14)) {
        const float* gf = P.in[19];
        for (int m = gw; m < NTOK; m += NGW) {
            float* xr = P.out + (size_t)m * 1024; f32x4 v[4]; float s = 0.f;
#pragma unroll
            for (int j = 0; j < 4; ++j) { v[j] = ((const f32x4*)xr)[lane + 64 * j]; s += (v[j][0] * v[j][0] + v[j][1] * v[j][1]) + (v[j][2] * v[j][2] + v[j][3] * v[j][3]); }
            const float rstd = rsqrtf(wave_sum(s) * (1.f / 1024.f) + EPS);
#pragma unroll
            for (int j = 0; j < 4; ++j) { const f32x4 g = ((const f32x4*)gf)[lane + 64 * j]; ((f32x4*)xr)[lane + 64 * j] = v[j] * rstd * g; }
        }
    }
}

extern "C" void kernel_launch(void* const* d_in, const int* in_sizes, int n_in, void* d_out, int out_size, void* d_ws, size_t ws_size, hipStream_t stream) {
    static int grid_blocks = 0;
    if (!grid_blocks) {
        int dev = 0, cus = 0, per_cu = 0;
        (void)hipGetDevice(&dev);
        (void)hipDeviceGetAttribute(&cus, hipDeviceAttributeMultiprocessorCount, dev);
        (void)hipFuncSetAttribute((const void*)mk_fwd, hipFuncAttributeMaxDynamicSharedMemorySize, LDS_BYTES);
        (void)hipOccupancyMaxActiveBlocksPerMultiprocessor(&per_cu, mk_fwd, 512, LDS_BYTES);
        if (per_cu > 1) per_cu = 1;
        grid_blocks = cus * per_cu;
    }
    if (n_in < 20 || ws_size < WS_NEED || grid_blocks <= 0) { fprintf(stderr, "kernel_launch: bad setup (n_in %d ws %zu grid %d)\n", n_in, ws_size, grid_blocks); return; }
    Params p{};
    for (int i = 0; i < 20; ++i) p.in[i] = (const float*)d_in[i];
    p.out = (float*)d_out; p.ws = (unsigned char*)d_ws; p.ph_lo = 0; p.ph_hi = 15;
    (void)hipMemsetAsync((unsigned char*)d_ws + WS_BAR, 0, BAR_BYTES, stream);
    void* args[] = {&p};
    hipError_t e = hipLaunchCooperativeKernel((void*)mk_fwd, dim3(grid_blocks), dim3(512), args, LDS_BYTES, stream);
    if (e != hipSuccess) fprintf(stderr, "cooperative launch failed: %s (grid %d)\n", hipGetErrorString(e), grid_blocks);
}
```

```cpp
#include <hip/hip_runtime.h>
#include <hip/hip_cooperative_groups.h>
#include <cstdio>
#include <cstdint>
namespace cg = cooperative_groups;
namespace pg8 {
#define PG8_LAS __attribute__((address_space(3)))
typedef unsigned short bf16_t;
typedef short bf16x8 __attribute__((ext_vector_type(8)));
typedef float f32x4 __attribute__((ext_vector_type(4)));
typedef unsigned u32x4 __attribute__((ext_vector_type(4)));
constexpr int BM = 256, BK = 64, HALF = 128, HTB = HALF * BK * 2  , STAGE_BYTES = 8 * HTB, NXCD = 8, WGM = 8;

__host__ __device__ __forceinline__ int lds_byte(int r, int c) { const int st = (r >> 4) * 2 + (c >> 5), rr = r & 15, cc = c & 31, ob = rr * 64 + cc * 2; return st * 1024 + (ob ^ (((ob >> 9) & 1) << 5)); }
__host__ __device__ __forceinline__ void stage_rc(int b, int& R, int& C) { const int st = b / 1024, sb = b % 1024, swz = sb ^ (((sb >> 9) & 1) << 5); R = (st >> 1) * 16 + swz / 64; C = (st & 1) * 32 + (swz % 64) / 2; }
__host__ __device__ __forceinline__ int perm32(int rho) { const int n = rho >> 4, i = rho & 15; return 8 * (i >> 2) + 4 * n + (i & 3); }

struct Unit { int pm, pn; };
struct Gemm { const bf16_t* A; const bf16_t* Bt; int M, N, K; };

struct StaticOrder {
    int nM, nN, nwg, G, c;
    __host__ __device__ void init(int M, int N, int G_, int c_) { nM = M / BM; nN = N / BM; nwg = nM * nN; G = G_; c = c_; }
    __host__ __device__ bool next(int i, Unit& u) const {
        const long L = (long)i * G + c; if (L >= nwg) return false;
        int wgid = (int)L; { const int q = nwg / NXCD, r = nwg % NXCD, xcd = wgid % NXCD, off = wgid / NXCD; wgid = (xcd < r ? xcd * (q + 1) : r * (q + 1) + (xcd - r) * q) + off; }
        const int nig = WGM * nN, gid = wgid / nig, fm = gid * WGM, gsz = (nM - fm) < WGM ? (nM - fm) : WGM;
        u.pm = fm + ((wgid % nig) % gsz); u.pn = (wgid % nig) / gsz; return true;
    }
    __device__ __forceinline__ void a_ready(const Unit&) const {}
    __device__ __forceinline__ void done(const Unit&) const {}
};

__device__ __forceinline__ unsigned cvt_pk_bf16(float lo, float hi) { unsigned r; asm volatile("v_cvt_pk_bf16_f32 %0, %1, %2" : "=v"(r) : "v"(lo), "v"(hi)); return r; }
typedef float f32x2 __attribute__((ext_vector_type(2)));

__device__ __forceinline__ float sigm(float x) { return 1.0f / (1.0f + __expf(-x)); }
__device__ __forceinline__ float bf_lo(unsigned w) { return __uint_as_float(w << 16); }
__device__ __forceinline__ float bf_hi(unsigned w) { return __uint_as_float(w & 0xffff0000u); }
__device__ __forceinline__ u32x4 pack8(const f32x4& v0, const f32x4& v1) { u32x4 w; w.x = cvt_pk_bf16(v0[0], v0[1]); w.y = cvt_pk_bf16(v0[2], v0[3]); w.z = cvt_pk_bf16(v1[0], v1[1]); w.w = cvt_pk_bf16(v1[2], v1[3]); return w; }
__device__ __forceinline__ void unpack8(const u32x4& w, f32x4& v0, f32x4& v1) { v0[0] = bf_lo(w.x); v0[1] = bf_hi(w.x); v0[2] = bf_lo(w.y); v0[3] = bf_hi(w.y); v1[0] = bf_lo(w.z); v1[1] = bf_hi(w.z); v1[2] = bf_lo(w.w); v1[3] = bf_hi(w.w); }

#define PG8_EPI_WALK(...) \
    _Pragma("unroll") for (int ai = 0; ai < 2; ++ai) _Pragma("unroll") for (int m = 0; m < 4; ++m) { const int row = u.pm * BM + wr * 64 + fr + ai * HALF + m * 16; \
        _Pragma("unroll") for (int bj = 0; bj < 2; ++bj) { const int ct = wc * 64 + bj * 32 + 8 * fq; f32x4 v0 = acc[ai][bj][m][0], v1 = acc[ai][bj][m][1]; __VA_ARGS__ } }

__device__ __forceinline__ u32x4 xor8_16B(u32x4 v) { u32x4 r; r.x = (unsigned)__shfl_xor((int)v.x, 8); r.y = (unsigned)__shfl_xor((int)v.y, 8); r.z = (unsigned)__shfl_xor((int)v.z, 8); r.w = (unsigned)__shfl_xor((int)v.w, 8); return r; }
__device__ __forceinline__ u32x4 bperm_16B(int src_byte, u32x4 v) { u32x4 r; r.x = (unsigned)__builtin_amdgcn_ds_bpermute(src_byte, (int)v.x); r.y = (unsigned)__builtin_amdgcn_ds_bpermute(src_byte, (int)v.y); r.z = (unsigned)__builtin_amdgcn_ds_bpermute(src_byte, (int)v.z); r.w = (unsigned)__builtin_amdgcn_ds_bpermute(src_byte, (int)v.w); return r; }
__device__ __forceinline__ void store_rows_bf16(bf16_t* O, size_t ldc, int r0, int c0, int fr, int fq, u32x4 w0, u32x4 w1) {
    const bool h = fr & 8; const u32x4 recv = xor8_16B(h ? w0 : w1);
    const u32x4 d1 = h ? recv : w0, d2 = h ? w1 : recv;
    const int lane = fr + 16 * fq, src = ((lane >> 3) + 8 * ((lane >> 2) & 1) + 16 * (lane & 3)) * 4;
    const u32x4 e1 = bperm_16B(src, d1), e2 = bperm_16B(src, d2);
    bf16_t* p = O + (size_t)(r0 + (lane >> 3)) * ldc + c0 + 8 * (lane & 7);
    *(u32x4*)p = e1; *(u32x4*)(p + 8 * ldc) = e2;
}
struct EpiProj {
    static constexpr bool PERM = true, AFTER_DRAIN = false;
    bf16_t *qkva, *qkm, *vm, *om, *g; float c2;
    __device__ __forceinline__ void operator()(const f32x4 (&acc)[2][2][4][2], const Unit& u, int wr, int wc, int fr, int fq) const {
        const int pn = u.pn; bf16_t* base; int ldc, colt, mode = 0; float sc = 1.f;
        if (pn < 6) { base = qkva; ldc = 1536; colt = pn * 256; if (pn < 2) sc = c2; }
        else if (pn < 10) { base = qkm; ldc = 1024; colt = (pn - 6) * 256; }
        else if (pn < 12) { base = vm; ldc = 512; colt = (pn - 10) * 256; }
        else if (pn < 14) { base = om; ldc = 512; colt = (pn - 12) * 256; mode = 1; }
        else { base = g; ldc = 2048; colt = (pn - 14) * 256; mode = 1; }
#pragma unroll
        for (int ai = 0; ai < 2; ++ai)
#pragma unroll
            for (int m = 0; m < 4; ++m) { u32x4 w[2];
#pragma unroll
                for (int bj = 0; bj < 2; ++bj) { f32x4 v0 = acc[ai][bj][m][0], v1 = acc[ai][bj][m][1];
                    if (mode == 1) { _Pragma("unroll") for (int i = 0; i < 4; ++i) { v0[i] = sigm(v0[i]); v1[i] = sigm(v1[i]); } }
                    else { v0 = v0 * sc; v1 = v1 * sc; }
                    w[bj] = pack8(v0, v1); }
                store_rows_bf16(base, (size_t)ldc, u.pm * BM + wr * 64 + ai * HALF + m * 16, colt + wc * 64, fr, fq, w[0], w[1]); }
    }
};
struct EpiStore {
    static constexpr bool PERM = true, AFTER_DRAIN = false;
    bf16_t* O; int ldc;
    __device__ __forceinline__ void operator()(const f32x4 (&acc)[2][2][4][2], const Unit& u, int wr, int wc, int fr, int fq) const {
#pragma unroll
        for (int ai = 0; ai < 2; ++ai)
#pragma unroll
            for (int m = 0; m < 4; ++m) store_rows_bf16(O, (size_t)ldc, u.pm * BM + wr * 64 + ai * HALF + m * 16, u.pn * BM + wc * 64, fr, fq, pack8(acc[ai][0][m][0], acc[ai][0][m][1]), pack8(acc[ai][1][m][0], acc[ai][1][m][1]));
    }
};
template <bool ADD> struct EpiGated {
    static constexpr bool PERM = true, AFTER_DRAIN = false;
    bf16_t* O; const bf16_t* prev; const bf16_t* gate; int gcol0;
    __device__ __forceinline__ void operator()(const f32x4 (&acc)[2][2][4][2], const Unit& u, int wr, int wc, int fr, int fq) const {
#pragma unroll
        for (int ai = 0; ai < 2; ++ai)
#pragma unroll
            for (int m = 0; m < 4; ++m) { const int row = u.pm * BM + wr * 64 + fr + ai * HALF + m * 16; u32x4 w[2];
#pragma unroll
                for (int bj = 0; bj < 2; ++bj) { const int col = u.pn * BM + wc * 64 + bj * 32 + 8 * fq; f32x4 v0 = acc[ai][bj][m][0], v1 = acc[ai][bj][m][1];
                    f32x4 g0, g1; unpack8(*(const u32x4*)(gate + (size_t)row * 2048 + gcol0 + col), g0, g1);
                    v0 = v0 * g0; v1 = v1 * g1;
                    if (ADD) { f32x4 p0, p1; unpack8(*(const u32x4*)(prev + (size_t)row * 1024 + col), p0, p1); v0 = v0 + p0; v1 = v1 + p1; }
                    w[bj] = pack8(v0, v1); }
                store_rows_bf16(O, 1024, u.pm * BM + wr * 64 + ai * HALF + m * 16, u.pn * BM + wc * 64, fr, fq, w[0], w[1]); }
    }
};
struct EpiResidual {
    static constexpr bool PERM = true, AFTER_DRAIN = false;
    const float* res; float* out; bf16_t* xa; const float* gain; float* ssq;
    __device__ __forceinline__ void operator()(const f32x4 (&acc)[2][2][4][2], const Unit& u, int wr, int wc, int fr, int fq) const {
#pragma unroll
        for (int ai = 0; ai < 2; ++ai)
#pragma unroll
            for (int m = 0; m < 4; ++m) { const int row = u.pm * BM + wr * 64 + fr + ai * HALF + m * 16; float s = 0.f; u32x4 wx[2];
#pragma unroll
                for (int bj = 0; bj < 2; ++bj) { const int ct = wc * 64 + bj * 32 + 8 * fq; f32x4 v0 = acc[ai][bj][m][0], v1 = acc[ai][bj][m][1];
                    const size_t o = (size_t)row * 1024 + u.pn * BM + ct; const f32x4 r0 = *(const f32x4*)(res + o), r1 = *(const f32x4*)(res + o + 4);
                    v0 = v0 + r0; v1 = v1 + r1; *(f32x4*)(out + o) = v0; *(f32x4*)(out + o + 4) = v1;
                    s += (v0[0] * v0[0] + v0[1] * v0[1]) + (v0[2] * v0[2] + v0[3] * v0[3]) + (v1[0] * v1[0] + v1[1] * v1[1]) + (v1[2] * v1[2] + v1[3] * v1[3]);
                    const f32x4 g0 = *(const f32x4*)(gain + u.pn * BM + ct), g1 = *(const f32x4*)(gain + u.pn * BM + ct + 4);
                    wx[bj] = pack8(v0 * g0, v1 * g1); }
                store_rows_bf16(xa, 1024, u.pm * BM + wr * 64 + ai * HALF + m * 16, u.pn * BM + wc * 64, fr, fq, wx[0], wx[1]);
                s += __shfl_xor(s, 16); s += __shfl_xor(s, 32);
                if (fq == 0) atomicAdd(ssq + row, s);
                asm volatile("" ::: "memory"); }
    }
};
struct EpiPle {
    static constexpr bool PERM = true, AFTER_DRAIN = false;
    float* xio; const bf16_t* e; const float* ssq;
    __device__ __forceinline__ void operator()(const f32x4 (&acc)[2][2][4][2], const Unit& u, int wr, int wc, int fr, int fq) const {
        const int row0 = u.pm * BM + wr * 64 + fr;
        float sq_next = ssq[row0];
#pragma unroll
        for (int ai = 0; ai < 2; ++ai)
#pragma unroll
            for (int m = 0; m < 4; ++m) { const int row = row0 + ai * HALF + m * 16; const float sq = sq_next;
                if (!(ai == 1 && m == 3)) sq_next = ssq[row0 + (m == 3 ? HALF : ai * HALF + (m + 1) * 16)];
                const float rstd = rsqrtf(sq * (1.0f / 1024.0f) + 1e-6f);
#pragma unroll
                for (int bj = 0; bj < 2; ++bj) { const int ct = wc * 64 + bj * 32 + 8 * fq; f32x4 v0 = acc[ai][bj][m][0] * rstd, v1 = acc[ai][bj][m][1] * rstd;
                    const size_t o = (size_t)row * 1024 + u.pn * BM + ct; f32x4 e0, e1; unpack8(*(const u32x4*)(e + o), e0, e1);
                    const f32x4 r0 = *(const f32x4*)(xio + o), r1 = *(const f32x4*)(xio + o + 4);
#pragma unroll
                    for (int i = 0; i < 4; ++i) { v0[i] = r0[i] + sigm(v0[i]) * e0[i]; v1[i] = r1[i] + sigm(v1[i]) * e1[i]; }
                    *(f32x4*)(xio + o) = v0; *(f32x4*)(xio + o + 4) = v1; } }
    }
};

template <class Epi, class Sched, bool ALIGN_EPI = false, bool SP2 = false>
__device__ __forceinline__ void gemm_phase(PG8_LAS unsigned char* lds, const Gemm g, const Sched& S, const Epi& E) {
    int tid_ = threadIdx.x; asm volatile("" : "+v"(tid_));
    const int tid = tid_, wid = __builtin_amdgcn_readfirstlane(tid >> 6), lane = tid & 63, wr = wid >> 2, wc = wid & 3, fr = lane & 15, fq = lane >> 4;
    int K_ = g.K; asm volatile("" : "+s"(K_));
    const int K = K_, nt = K / BK;
    unsigned voffA[2], voffB[2];
#pragma unroll
    for (int i = 0; i < 2; ++i) { int R, C; stage_rc(tid * 16 + i * 8192, R, C); const int Rb = Epi::PERM ? (2 * (R & ~31) + perm32(R & 31)) : R;
        voffA[i] = (unsigned)(R * K + C) * 2u; voffB[i] = (unsigned)(Rb * K + C) * 2u; }
    const size_t kstep = (size_t)(BK * 2);
    const size_t hstep = (size_t)HALF * K * 2;
    const size_t hstepB = Epi::PERM ? (size_t)32 * K * 2 : hstep;
    const size_t tstep = 2 * hstep;
    const unsigned ldsw = (unsigned)wid * 1024u;
    const int aoff = lds_byte(wr * 64 + fr, fq * 8), boff = lds_byte(wc * 32 + fr, fq * 8);
#define PG8_SA(b, h) (((b) * 2 + (h)) * HTB)
#define PG8_SB(b, h) ((4 + (b) * 2 + (h)) * HTB)
#define PG8_STAGE(bufoff, gbase, voff) do { _Pragma("unroll") for (int _i = 0; _i < 2; ++_i) \
        __builtin_amdgcn_global_load_lds((const unsigned*)((const char*)(gbase) + (voff)[_i]), (PG8_LAS unsigned*)(lds + (bufoff) + ldsw + _i * 8192), 16, 0, 0); } while (0)
#define PG8_LDA(dst, b, h) do { _Pragma("unroll") for (int m = 0; m < 4; ++m) _Pragma("unroll") for (int k = 0; k < 2; ++k) dst[m][k] = *(const PG8_LAS bf16x8*)(lds + PG8_SA(b, h) + aoff + m * 2048 + k * 1024); } while (0)
#define PG8_LDB(dst, b, h) do { _Pragma("unroll") for (int n = 0; n < 2; ++n) _Pragma("unroll") for (int k = 0; k < 2; ++k) dst[n][k] = *(const PG8_LAS bf16x8*)(lds + PG8_SB(b, h) + boff + n * 2048 + k * 1024); } while (0)
#define PG8_MMA(ai, bj, At, Bt) do { __builtin_amdgcn_s_setprio(1); _Pragma("unroll") for (int m = 0; m < 4; ++m) _Pragma("unroll") for (int n = 0; n < 2; ++n) _Pragma("unroll") for (int k = 0; k < 2; ++k) \
        acc[ai][bj][m][n] = __builtin_amdgcn_mfma_f32_16x16x32_bf16(Bt[n][k], At[m][k], acc[ai][bj][m][n], 0, 0, 0); __builtin_amdgcn_s_setprio(0); } while (0)
#define PG8_WAIT_V(n) asm volatile("s_waitcnt vmcnt(" #n ")" ::: "memory")
#define PG8_WAIT_L(n) asm volatile("s_waitcnt lgkmcnt(" #n ")" ::: "memory")
#define PG8_BAR __builtin_amdgcn_s_barrier()
#define PG8_SCHED __builtin_amdgcn_sched_barrier(0)
    Unit cur, nxt; int ui = 0;
    if (!S.next(0, cur)) return;
    f32x4 acc[2][2][4][2];
#pragma unroll
    for (int a = 0; a < 2; ++a)
#pragma unroll
        for (int b = 0; b < 2; ++b)
#pragma unroll
            for (int m = 0; m < 4; ++m)
#pragma unroll
                for (int n = 0; n < 2; ++n) acc[a][b][m][n] = (f32x4){0.f, 0.f, 0.f, 0.f};
    bf16x8 At[4][2], B0[2][2], B1[2][2];
    const char* cA = (const char*)g.A + (size_t)cur.pm * tstep; const char* cB = (const char*)g.Bt + (size_t)cur.pn * tstep;
    S.a_ready(cur);
    if constexpr (SP2) {
        PG8_STAGE(PG8_SB(0, 0), cB, voffB); PG8_STAGE(PG8_SB(0, 1), cB + hstepB, voffB); PG8_STAGE(PG8_SA(0, 0), cA, voffA); PG8_STAGE(PG8_SA(0, 1), cA + hstep, voffA);
        if (wr == 1) PG8_BAR;
        PG8_WAIT_V(2); PG8_BAR;
        PG8_STAGE(PG8_SB(1, 0), cB + kstep, voffB); PG8_STAGE(PG8_SA(1, 0), cA + kstep, voffA); PG8_STAGE(PG8_SB(1, 1), cB + hstepB + kstep, voffB);
        PG8_WAIT_V(6); PG8_BAR;
    } else {
        PG8_STAGE(PG8_SB(0, 0), cB, voffB); PG8_STAGE(PG8_SA(0, 0), cA, voffA); PG8_STAGE(PG8_SB(0, 1), cB + hstepB, voffB); PG8_STAGE(PG8_SA(0, 1), cA + hstep, voffA);
        if (wr == 1) PG8_BAR;
        PG8_WAIT_V(4); PG8_BAR;
        PG8_STAGE(PG8_SB(1, 0), cB + kstep, voffB); PG8_STAGE(PG8_SA(1, 0), cA + kstep, voffA); PG8_STAGE(PG8_SB(1, 1), cB + hstepB + kstep, voffB);
        PG8_WAIT_V(6); PG8_BAR;
    }
    for (;;) {
        const bool has_next = S.next(ui + 1, nxt);
        const char* nA = has_next ? (const char*)g.A + (size_t)nxt.pm * tstep : cA; const char* nB = has_next ? (const char*)g.Bt + (size_t)nxt.pn * tstep : cB;
        for (int t = 0; t < nt; t += 2) {
            const bool last = (t == nt - 2);
            const char* a1 = cA + (size_t)(t + 1) * kstep;
            const char* a2 = last ? nA : cA + (size_t)(t + 2) * kstep; const char* b2 = last ? nB : cB + (size_t)(t + 2) * kstep;
            const char* a3 = a2 + kstep; const char* b3 = b2 + kstep;
            if (last && has_next) S.a_ready(nxt);
            if constexpr (SP2) {
            PG8_LDB(B0, 0, 0); PG8_LDB(B1, 0, 1); PG8_SCHED; PG8_LDA(At, 0, 0); PG8_STAGE(PG8_SA(1, 1), a1 + hstep, voffA);
            PG8_WAIT_V(8); PG8_WAIT_L(0); PG8_BAR; PG8_MMA(0, 0, At, B0); PG8_MMA(0, 1, At, B1); PG8_BAR; PG8_SCHED;
            PG8_LDA(At, 0, 1); PG8_STAGE(PG8_SB(0, 0), b2, voffB); PG8_STAGE(PG8_SB(0, 1), b2 + hstepB, voffB); PG8_STAGE(PG8_SA(0, 0), a2, voffA);
            PG8_WAIT_V(8); PG8_WAIT_L(0); PG8_BAR; PG8_MMA(1, 0, At, B0); PG8_MMA(1, 1, At, B1); PG8_BAR; PG8_SCHED;
            PG8_LDB(B0, 1, 0); PG8_LDB(B1, 1, 1); PG8_SCHED; PG8_LDA(At, 1, 0); PG8_STAGE(PG8_SA(0, 1), a2 + hstep, voffA);
            PG8_WAIT_V(8); PG8_WAIT_L(0); PG8_BAR; PG8_MMA(0, 0, At, B0); PG8_MMA(0, 1, At, B1); PG8_BAR; PG8_SCHED;
            PG8_LDA(At, 1, 1); PG8_STAGE(PG8_SB(1, 0), b3, voffB); PG8_STAGE(PG8_SB(1, 1), b3 + hstepB, voffB); PG8_STAGE(PG8_SA(1, 0), a3, voffA);
            PG8_WAIT_V(8); PG8_WAIT_L(0); PG8_BAR; PG8_MMA(1, 0, At, B0); PG8_MMA(1, 1, At, B1); PG8_BAR; PG8_SCHED;
            } else {
            PG8_LDB(B0, 0, 0); PG8_SCHED; PG8_LDA(At, 0, 0); PG8_STAGE(PG8_SA(1, 1), a1 + hstep, voffA);
            PG8_WAIT_L(8); PG8_BAR; PG8_WAIT_L(0); PG8_MMA(0, 0, At, B0); PG8_BAR; PG8_SCHED;
            PG8_LDB(B1, 0, 1); PG8_STAGE(PG8_SB(0, 0), b2, voffB);
            PG8_BAR; PG8_WAIT_L(0); PG8_MMA(0, 1, At, B1); PG8_BAR;
            PG8_LDA(At, 0, 1); PG8_STAGE(PG8_SA(0, 0), a2, voffA);
            PG8_BAR; PG8_WAIT_L(0); PG8_MMA(1, 0, At, B0); PG8_BAR; PG8_SCHED;
            PG8_STAGE(PG8_SB(0, 1), b2 + hstepB, voffB);
            PG8_WAIT_V(6); PG8_BAR; PG8_MMA(1, 1, At, B1); PG8_BAR;
            PG8_LDB(B0, 1, 0); PG8_SCHED; PG8_LDA(At, 1, 0); PG8_STAGE(PG8_SA(0, 1), a2 + hstep, voffA);
            PG8_WAIT_L(8); PG8_BAR; PG8_WAIT_L(0); PG8_MMA(0, 0, At, B0); PG8_BAR; PG8_SCHED;
            PG8_LDB(B1, 1, 1); PG8_STAGE(PG8_SB(1, 0), b3, voffB);
            PG8_BAR; PG8_WAIT_L(0); PG8_MMA(0, 1, At, B1); PG8_BAR;
            PG8_LDA(At, 1, 1); PG8_STAGE(PG8_SA(1, 0), a3, voffA);
            PG8_BAR; PG8_WAIT_L(0); PG8_MMA(1, 0, At, B0); PG8_BAR; PG8_SCHED;
            PG8_STAGE(PG8_SB(1, 1), b3 + hstepB, voffB);
            PG8_WAIT_V(6); PG8_BAR; PG8_MMA(1, 1, At, B1); PG8_BAR;
            }
        }
        if constexpr (ALIGN_EPI) { if (wr == 0) PG8_BAR; }
        if constexpr (!Epi::AFTER_DRAIN) { E(acc, cur, wr, wc, fr, fq); S.done(cur); }
        if (!has_next) break;
#pragma unroll
        for (int a = 0; a < 2; ++a)
#pragma unroll
            for (int b = 0; b < 2; ++b)
#pragma unroll
                for (int m = 0; m < 4; ++m)
#pragma unroll
                    for (int n = 0; n < 2; ++n) acc[a][b][m][n] = (f32x4){0.f, 0.f, 0.f, 0.f};
        cur = nxt; cA = nA; cB = nB; ++ui;
        if constexpr (ALIGN_EPI) { if (wr == 1) PG8_BAR; }
    }
    PG8_WAIT_V(0);
    if constexpr (!ALIGN_EPI) { if (wr == 0) PG8_BAR; }
    PG8_BAR;
    if constexpr (Epi::AFTER_DRAIN) { E.fused(acc, cur, wr, wc, fr, fq, lds, wid, lane); S.done(cur); }
#undef PG8_SA
#undef PG8_SB
#undef PG8_STAGE
#undef PG8_LDA
#undef PG8_LDB
#undef PG8_MMA
#undef PG8_WAIT_V
#undef PG8_WAIT_L
#undef PG8_BAR
#undef PG8_SCHED
}
}

#define GAS __attribute__((address_space(1)))
#define LAS __attribute__((address_space(3)))
typedef unsigned short bf16;
typedef unsigned v4u __attribute__((ext_vector_type(4)));
typedef unsigned v2u __attribute__((ext_vector_type(2)));
typedef float f32x4 __attribute__((ext_vector_type(4)));
using pg8::bf_lo; using pg8::bf_hi; using pg8::sigm;

constexpr int NTOK = 32768, SEQ = 16384, DM = 1024, NW = 8;
constexpr float EPS = 1e-6f;
constexpr float C2 = 0.125f * 1.4426950408889634f;
constexpr size_t MiB = 1u << 20;
constexpr size_t WS_W1T = 1 * MiB, WS_WAT = 12 * MiB, WS_WMT = 13 * MiB, WS_WOT = 14 * MiB, WS_WQT = 16 * MiB, WS_WGT = 20 * MiB, WS_WPT = 22 * MiB;
constexpr size_t WS_K1B = 22 * MiB + 512 * 1024, WS_K2B = 22 * MiB + 768 * 1024, WS_IF = 23 * MiB, WS_UB = 24 * MiB, WS_VB = 56 * MiB;
constexpr size_t WS_XN = 88 * MiB, WS_YA = 88 * MiB, WS_YM = 120 * MiB, WS_HN = 88 * MiB;
constexpr size_t WS_QKVA = 152 * MiB, WS_QKM = 248 * MiB, WS_VM = 312 * MiB, WS_OM = 344 * MiB, WS_G = 376 * MiB;
constexpr size_t WS_DN = 504 * MiB, WS_NS = 505 * MiB, WS_SC = 506 * MiB;
constexpr size_t WS_MERGED = 152 * MiB, WS_TMP = 216 * MiB, WS_Q2 = 376 * MiB, WS_IDX = 152 * MiB, WS_GATE = 168 * MiB, WS_HN2 = 184 * MiB, WS_PB = 56 * MiB, WS_E = 264 * MiB;
constexpr size_t WS_NEED = 507 * MiB;
constexpr size_t WS_U8 = 24 * MiB, WS_V8 = 40 * MiB, WS_PART = 376 * MiB, WS_SSQ = 506 * MiB + 512 * 1024;
constexpr size_t WS_U4 = 24 * MiB, WS_V4 = 32 * MiB, WS_SU = 40 * MiB, WS_SV = 40 * MiB + 65536;
constexpr size_t WS_SSQ1 = 506 * MiB + 768 * 1024, WS_BAR = 0, BAR_BYTES = 32768;
constexpr size_t OUT_DC = 0, OUT_CS = 64 * MiB;
constexpr int LDS_BYTES = 147456;

__device__ __forceinline__ unsigned f2bf(float f) { unsigned u = __float_as_uint(f); return (u + 0x7fffu + ((u >> 16) & 1u)) >> 16; }
__device__ __forceinline__ unsigned pk2(float lo, float hi) { return f2bf(lo) | (f2bf(hi) << 16); }
__device__ __forceinline__ float bf2f(bf16 b) { return __uint_as_float((unsigned)b << 16); }
__device__ __forceinline__ float wave_sum(float v) {
#pragma unroll
    for (int o = 1; o < 64; o <<= 1) v += __shfl_xor(v, o);
    return v;
}
__device__ __forceinline__ float wave_max(float v) {
#pragma unroll
    for (int o = 1; o < 64; o <<= 1) v = fmaxf(v, __shfl_xor(v, o));
    return v;
}
__device__ __forceinline__ void unpk8(const v4u w, float* f) { f[0] = bf_lo(w.x); f[1] = bf_hi(w.x); f[2] = bf_lo(w.y); f[3] = bf_hi(w.y); f[4] = bf_lo(w.z); f[5] = bf_hi(w.z); f[6] = bf_lo(w.w); f[7] = bf_hi(w.w); }
__device__ __forceinline__ v4u pk8(const float* f) { v4u w; w.x = pk2(f[0], f[1]); w.y = pk2(f[2], f[3]); w.z = pk2(f[4], f[5]); w.w = pk2(f[6], f[7]); return w; }
typedef __bf16 bf16x2_t __attribute__((ext_vector_type(2)));
__device__ __forceinline__ float dot2bf(unsigned a, unsigned b, float c) { return __builtin_amdgcn_fdot2_f32_bf16(__builtin_bit_cast(bf16x2_t, a), __builtin_bit_cast(bf16x2_t, b), c, false); }
__device__ __forceinline__ float logsigmoid(float x) { return fminf(x, 0.f) - log1pf(__expf(-fabsf(x))); }
__device__ __forceinline__ float silu(float x) { return x / (1.0f + __expf(-x)); }

#define XB_TMO      128
#define XB_XCNT(j)  (256  + 64 * (j))
#define XB_XSUB(j)  (1280 + 64 * (j))
#define XB_XGEN(j)  (2304 + 64 * (j))
#define XB_TOP      3328
#define XB_TOPGEN   3392
#define XCD_BAR_WORDS 3456
#define XB_SPIN_CAP (1u << 18)

__device__ __forceinline__ unsigned xb_ld(unsigned* p)              { return __hip_atomic_load(p, __ATOMIC_RELAXED, __HIP_MEMORY_SCOPE_AGENT); }
__device__ __forceinline__ unsigned xb_add(unsigned* p, unsigned v) { return __hip_atomic_fetch_add(p, v, __ATOMIC_RELAXED, __HIP_MEMORY_SCOPE_AGENT); }
__device__ __forceinline__ unsigned xb_xcc_id() { return (unsigned)__builtin_amdgcn_s_getreg((3 << 11) | 20) & 0xFu; }
#define XB_SPIN(cond, bar) do { unsigned _sp = 0; while (cond) { __builtin_amdgcn_s_sleep(1); \
    if ((++_sp & 255u) == 0u) { if (xb_ld(&(bar)[XB_TMO])) break; if (_sp > XB_SPIN_CAP) { atomicAdd(&(bar)[XB_TMO], 1u); break; } } } } while (0)

struct XcdBarrier {
    unsigned* bar; unsigned x;
    volatile LAS unsigned* st;
};

__device__ __forceinline__ XcdBarrier xcd_barrier_post(unsigned* bar, volatile LAS unsigned* st) {
    XcdBarrier b; b.bar = bar; b.x = xb_xcc_id(); b.st = st;
    if (threadIdx.x == 0) (void)xb_add(&bar[XB_XCNT(b.x)], 1u);
    return b;
}
__device__ __forceinline__ void xcd_barrier_complete(unsigned* bar, unsigned x, unsigned& nloc, unsigned& nx) {
    const unsigned G = gridDim.x * gridDim.y * gridDim.z;
    unsigned sum, cnt, mine, sp = 0u;
    for (;;) {
        sum = 0u; cnt = 0u; mine = 0u;
#pragma unroll
        for (unsigned j = 0; j < 16; ++j) { const unsigned c = xb_ld(&bar[XB_XCNT(j)]); sum += c; cnt += (c > 0u) ? 1u : 0u; mine = (j == x) ? c : mine; }
        if (sum == G) break;
        __builtin_amdgcn_s_sleep(1);
        if ((++sp & 255u) == 0u) { if (xb_ld(&bar[XB_TMO])) break; if (sp > XB_SPIN_CAP) { atomicAdd(&bar[XB_TMO], 1u); break; } }
    }
    nloc = mine > 0u ? mine : 1u; nx = cnt > 0u ? cnt : 1u;
}

__device__ __forceinline__ void xcd_barrier(const XcdBarrier& b) {
    asm volatile("s_waitcnt vmcnt(0)" ::: "memory");
    __syncthreads();
    if (threadIdx.x == 0) {
        unsigned* bar = b.bar;
        __builtin_amdgcn_s_waitcnt(0);
        unsigned nloc = b.st[0], nx = b.st[1];
        if (nloc == 0u) { xcd_barrier_complete(bar, b.x, nloc, nx); b.st[0] = nloc; b.st[1] = nx; }
        const unsigned old = xb_add(&bar[XB_XSUB(b.x)], 1u);
        const unsigned gen = old / nloc;
        if (old + 1u == (gen + 1u) * nloc) {
            __builtin_amdgcn_fence(__ATOMIC_RELEASE, "agent");
            asm volatile("s_waitcnt vmcnt(0)" ::: "memory");
            const unsigned og = xb_add(&bar[XB_TOP], 1u);
            const unsigned tg = og / nx;
            if (og + 1u == (tg + 1u) * nx) xb_add(&bar[XB_TOPGEN], 1u);
            else XB_SPIN(xb_ld(&bar[XB_TOPGEN]) == tg, bar);
            __builtin_amdgcn_fence(__ATOMIC_ACQUIRE, "agent");
            xb_add(&bar[XB_XGEN(b.x)], 1u);
            asm volatile("s_waitcnt vmcnt(0)" ::: "memory");
        } else {
            XB_SPIN(xb_ld(&bar[XB_XGEN(b.x)]) == gen, bar);
            __builtin_amdgcn_fence(__ATOMIC_ACQUIRE, "agent");
            asm volatile("s_waitcnt vmcnt(0)" ::: "memory");
        }
    }
    __syncthreads();
}


struct Params { const float* in[20]; float* out; unsigned char* ws; int ph_lo, ph_hi; };

__device__ __forceinline__ void transpose_item(const float* W, int ldw, int col0, int K, bf16* WT, int row0, LAS float* scr, int item, int nblk, int lane) {
    const int kb = item / nblk, nb = item % nblk, k0 = 64 * kb, n0 = 32 * nb;
#pragma unroll 8
    for (int i = 0; i < 32; ++i) { const int kk = 2 * i + (lane >> 5); scr[kk * 33 + (lane & 31)] = W[(size_t)(k0 + kk) * ldw + col0 + n0 + (lane & 31)]; }
    asm volatile("s_waitcnt lgkmcnt(0)" ::: "memory");
    const int c = lane & 7;
#pragma unroll
    for (int j = 0; j < 4; ++j) { const int n = (lane >> 3) + 8 * j; const LAS float* s = scr + (8 * c) * 33 + n;
        v4u o; o.x = pk2(s[0 * 33], s[1 * 33]); o.y = pk2(s[2 * 33], s[3 * 33]); o.z = pk2(s[4 * 33], s[5 * 33]); o.w = pk2(s[6 * 33], s[7 * 33]);
        *(v4u*)(WT + (size_t)(row0 + n0 + n) * K + k0 + 8 * c) = o; }
    asm volatile("s_waitcnt lgkmcnt(0)" ::: "memory");
}
__device__ __forceinline__ void cvt_f32_bf16(const float* src, bf16* dst, size_t n4, size_t gtid, size_t gsz) {
    for (size_t i = gtid; i < n4; i += gsz) { const f32x4 v = ((const f32x4*)src)[i]; uint2 o; o.x = pk2(v[0], v[1]); o.y = pk2(v[2], v[3]); ((uint2*)dst)[i] = o; }
}
__device__ __forceinline__ void cvt_f32_fp8(const float* src, unsigned* dst, size_t n4, float sc, size_t gtid, size_t gsz) {
    for (size_t i = gtid; i < n4; i += gsz) { const f32x4 v = ((const f32x4*)src)[i]; int w = __builtin_amdgcn_cvt_pk_fp8_f32(v[0] * sc, v[1] * sc, 0, false); w = __builtin_amdgcn_cvt_pk_fp8_f32(v[2] * sc, v[3] * sc, w, true); dst[i] = (unsigned)w; }
}
__device__ __forceinline__ void rms_row_to_bf16(const float* xrow, const float* gain, bf16* orow, int lane) {
    f32x4 v[4]; float s = 0.f;
#pragma unroll
    for (int j = 0; j < 4; ++j) { v[j] = ((const f32x4*)xrow)[lane + 64 * j]; s += (v[j][0] * v[j][0] + v[j][1] * v[j][1]) + (v[j][2] * v[j][2] + v[j][3] * v[j][3]); }
    const float rstd = rsqrtf(wave_sum(s) * (1.f / 1024.f) + EPS);
#pragma unroll
    for (int j = 0; j < 4; ++j) { const f32x4 g = ((const f32x4*)gain)[lane + 64 * j]; uint2 o; o.x = pk2(v[j][0] * rstd * g[0], v[j][1] * rstd * g[1]); o.y = pk2(v[j][2] * rstd * g[2], v[j][3] * rstd * g[3]); ((uint2*)orow)[lane + 64 * j] = o; }
}
__device__ __forceinline__ void p0_prologue(const Params& P, LAS unsigned char* lds, int tid, int lane, int wave) {
    unsigned char* ws = P.ws;
    const int gw = blockIdx.x * NW + wave, NGW = gridDim.x * NW;
    LAS float* scr = (LAS float*)(lds + wave * 8448);
    LAS float* wif = (LAS float*)(lds + 69632);
    const float* w_in = P.in[3];
    for (int i = tid; i < 8192; i += 512) wif[i] = w_in[(size_t)(i >> 3) * 5640 + 3584 + (i & 7)];
    __syncthreads();
    constexpr int I1A = 16 * 112, I1B = 16 * 64, IUP = 8 * 32, IOUT = 16 * 32, IQ = 16 * 64, IPL = 4 * 32;
    constexpr int NITEMS = I1A + I1B + 2 * IUP + IOUT + IQ + IOUT + IPL;
    for (int it = gw; it < NITEMS; it += NGW) {
        int r = it;
        if (r < I1A) { transpose_item(w_in, 5640, 0, 1024, (bf16*)(ws + WS_W1T), 0, scr, r, 112, lane); continue; } r -= I1A;
        if (r < I1B) { transpose_item(w_in, 5640, 3592, 1024, (bf16*)(ws + WS_W1T), 3584, scr, r, 64, lane); continue; } r -= I1B;
        if (r < IUP) { transpose_item(P.in[7], 1024, 0, 512, (bf16*)(ws + WS_WAT), 0, scr, r, 32, lane); continue; } r -= IUP;
        if (r < IUP) { transpose_item(P.in[8], 1024, 0, 512, (bf16*)(ws + WS_WMT), 0, scr, r, 32, lane); continue; } r -= IUP;
        if (r < IOUT) { transpose_item(P.in[9], 1024, 0, 1024, (bf16*)(ws + WS_WOT), 0, scr, r, 32, lane); continue; } r -= IOUT;
        if (r < IQ) { transpose_item(P.in[11], 2048, 0, 1024, (bf16*)(ws + WS_WQT), 0, scr, r, 64, lane); continue; } r -= IQ;
        if (r < IOUT) { transpose_item(P.in[17], 1024, 0, 1024, (bf16*)(ws + WS_WGT), 0, scr, r, 32, lane); continue; } r -= IOUT;
        transpose_item(P.in[18], 1024, 0, 256, (bf16*)(ws + WS_WPT), 0, scr, r, 32, lane);
    }
    const size_t gtid = (size_t)blockIdx.x * 512 + tid, gsz = (size_t)gridDim.x * 512;
    cvt_f32_bf16(P.in[12], (bf16*)(ws + WS_K1B), 8 * 128 * 128 / 4, gtid, gsz);
    cvt_f32_bf16(P.in[13], (bf16*)(ws + WS_K2B), 8 * 128 * 128 / 4, gtid, gsz);
    for (int rw = gw; rw < 2 * 16384; rw += NGW) {
        const int tb_ = rw >> 14, e = rw & 16383; const float* src = P.in[14 + tb_] + (size_t)e * 1024;
        f32x4 v[4]; v[0] = ((const f32x4*)src)[2 * lane]; v[1] = ((const f32x4*)src)[2 * lane + 1]; v[2] = ((const f32x4*)src)[128 + 2 * lane]; v[3] = ((const f32x4*)src)[128 + 2 * lane + 1];
        float mx = 0.f;
#pragma unroll
        for (int j = 0; j < 4; ++j)
#pragma unroll
            for (int i = 0; i < 4; ++i) mx = fmaxf(mx, fabsf(v[j][i]));
        mx = wave_max(mx);
        const float sc = mx > 0.f ? mx * (1.0f / 6.0f) : 1.0f, inv = 1.0f / sc;
        unsigned w0 = 0u, w1 = 0u;
        w0 = __builtin_amdgcn_cvt_scalef32_pk_fp4_f32(w0, v[0][0] * inv, v[0][1] * inv, 1.0f, 0); w0 = __builtin_amdgcn_cvt_scalef32_pk_fp4_f32(w0, v[0][2] * inv, v[0][3] * inv, 1.0f, 1);
        w0 = __builtin_amdgcn_cvt_scalef32_pk_fp4_f32(w0, v[1][0] * inv, v[1][1] * inv, 1.0f, 2); w0 = __builtin_amdgcn_cvt_scalef32_pk_fp4_f32(w0, v[1][2] * inv, v[1][3] * inv, 1.0f, 3);
        w1 = __builtin_amdgcn_cvt_scalef32_pk_fp4_f32(w1, v[2][0] * inv, v[2][1] * inv, 1.0f, 0); w1 = __builtin_amdgcn_cvt_scalef32_pk_fp4_f32(w1, v[2][2] * inv, v[2][3] * inv, 1.0f, 1);
        w1 = __builtin_amdgcn_cvt_scalef32_pk_fp4_f32(w1, v[3][0] * inv, v[3][1] * inv, 1.0f, 2); w1 = __builtin_amdgcn_cvt_scalef32_pk_fp4_f32(w1, v[3][2] * inv, v[3][3] * inv, 1.0f, 3);
        unsigned* dst = (unsigned*)(ws + (tb_ ? WS_V4 : WS_U4)) + (size_t)e * 128;
        dst[lane] = w0; dst[64 + lane] = w1;
        if (lane == 0) ((float*)(ws + (tb_ ? WS_SV : WS_SU)))[e] = sc;
    }
    cvt_f32_bf16(P.in[1], (bf16*)(ws + WS_PB), (size_t)NTOK * 256 / 4, gtid, gsz);
    for (size_t i = gtid; i < (size_t)NTOK; i += gsz) { ((float*)(ws + WS_SSQ))[i] = 0.f; ((float*)(ws + WS_SSQ1))[i] = 0.f; }
    const float* x = P.in[0]; const float* gmix = P.in[2]; const float* gbias = P.in[5];
    bf16* XN = (bf16*)(ws + WS_XN); float* IFb = (float*)(ws + WS_IF);
    for (int m = gw; m < NTOK; m += NGW) {
        const float* xrow = x + (size_t)m * 1024;
        f32x4 v[4]; float s = 0.f;
#pragma unroll
        for (int j = 0; j < 4; ++j) { v[j] = ((const f32x4*)xrow)[lane + 64 * j]; s += (v[j][0] * v[j][0] + v[j][1] * v[j][1]) + (v[j][2] * v[j][2] + v[j][3] * v[j][3]); }
        const float rstd = rsqrtf(wave_sum(s) * (1.f / 1024.f) + EPS);
        float a8[8] = {0.f, 0.f, 0.f, 0.f, 0.f, 0.f, 0.f, 0.f};
#pragma unroll
        for (int j = 0; j < 4; ++j) {
            const f32x4 g = ((const f32x4*)gmix)[lane + 64 * j];
#pragma unroll
            for (int i = 0; i < 4; ++i) { v[j][i] = v[j][i] * rstd * g[i]; const int d = 4 * (lane + 64 * j) + i; const f32x4 wa = *(const LAS f32x4*)(wif + d * 8), wb = *(const LAS f32x4*)(wif + d * 8 + 4);
                a8[0] += v[j][i] * wa[0]; a8[1] += v[j][i] * wa[1]; a8[2] += v[j][i] * wa[2]; a8[3] += v[j][i] * wa[3]; a8[4] += v[j][i] * wb[0]; a8[5] += v[j][i] * wb[1]; a8[6] += v[j][i] * wb[2]; a8[7] += v[j][i] * wb[3]; }
            uint2 o; o.x = pk2(v[j][0], v[j][1]); o.y = pk2(v[j][2], v[j][3]); ((uint2*)(XN + (size_t)m * 1024))[lane + 64 * j] = o;
        }
#pragma unroll
        for (int c = 0; c < 8; ++c) a8[c] = wave_sum(a8[c]);
        if (lane == 0) {
#pragma unroll
            for (int c = 0; c < 8; ++c) IFb[(size_t)m * 8 + c] = a8[c] + gbias[c];
        }
    }
}

typedef short bf16x8 __attribute__((ext_vector_type(8)));
typedef short v4i16 __attribute__((ext_vector_type(4)));
#define MFMA16(a, b, c) __builtin_amdgcn_mfma_f32_16x16x32_bf16((a), (b), (c), 0, 0, 0)
__device__ __forceinline__ void attn_pair_params(int pp, int& d, int& n0, int& sh) {
    if (pp < 5) { d = 16; sh = 4; n0 = -144 + 32 * pp; } else if (pp < 11) { d = 4; sh = 2; n0 = -128 + 32 * (pp - 5); } else { d = 1; sh = 0; n0 = -128 + 32 * (pp - 11); }
}
#define ATT_LOAD(SET, PPX) do { int d_, n_, sh_; attn_pair_params((PPX) < 23 ? (PPX) : 22, d_, n_, sh_); \
    _Pragma("unroll") for (int c = 0; c < 4; ++c) { int tok = t0 + d_ * (n_ + 8 * c + lrow); tok = min(max(tok, 0), SEQ - 1); const bf16* rp = base + 512 + (size_t)tok * 1536 + 8 * lch; \
        kr[SET][c] = *(const v4u*)rp; vr[SET][c] = *(const v4u*)(rp + 512); } } while (0)
__device__ __forceinline__ void p2_attention(const Params& P, LAS unsigned char* lds, int lane, int wave, int vb) {
    const bf16* QKVA = (const bf16*)(P.ws + WS_QKVA); bf16* YA = (bf16*)(P.ws + WS_YA);
    LAS unsigned char* kbuf = lds + wave * 9728;
    LAS unsigned char* vbuf = kbuf + 4608;
    const int r = lane & 15, g = lane >> 4, lrow = lane >> 3, lch = lane & 7;
    const int trq = (lane >> 2) & 3, trp = lane & 3;
    const int tr_off = (4 * g + trq) * 160 + trp * 8;
    for (int wi = vb; wi < 1024; wi += gridDim.x) {
        const int bh = wi >> 6, tb = wi & 63, b = bh >> 3, h = bh & 7;
        const bf16* base = QKVA + (size_t)b * SEQ * 1536 + h * 64;
#pragma unroll 1
        for (int uu = 0; uu < 2; ++uu) {
            const int t0 = tb * 256 + wave * 2 + uu, tq = t0 + 16 * r;
            const bf16x8 qb0 = *(const bf16x8*)(base + (size_t)tq * 1536 + 8 * g), qb1 = *(const bf16x8*)(base + (size_t)tq * 1536 + 32 + 8 * g);
            f32x4 o[4];
#pragma unroll
            for (int i = 0; i < 4; ++i) o[i] = (f32x4){0.f, 0.f, 0.f, 0.f};
            float m = -1e30f, l = 0.f;
            v4u kr[4][4], vr[4][4];
            ATT_LOAD(0, 0); ATT_LOAD(1, 1); ATT_LOAD(2, 2); ATT_LOAD(3, 3);
#pragma unroll 1
            for (int pp0 = 0; pp0 < 24; pp0 += 4) {
#pragma unroll
                for (int u = 0; u < 4; ++u) {
                    const int pp = pp0 + u; const bool active = pp < 23;
                    int d, n0, sh; attn_pair_params(active ? pp : 22, d, n0, sh);
                    const int hi = r << (4 - sh), lo = max(hi - 128, -(t0 >> sh));
#pragma unroll
                    for (int c = 0; c < 4; ++c) { *(LAS v4u*)(kbuf + (8 * c + lrow) * 144 + lch * 16) = kr[u][c]; *(LAS v4u*)(vbuf + (8 * c + lrow) * 160 + lch * 16) = vr[u][c]; }
                    ATT_LOAD(u, pp + 4);
                    f32x4 s0 = {0.f, 0.f, 0.f, 0.f}, s1 = {0.f, 0.f, 0.f, 0.f};
                    { const bf16x8 k00 = *(const LAS bf16x8*)(kbuf + r * 144 + g * 16), k01 = *(const LAS bf16x8*)(kbuf + r * 144 + 64 + g * 16);
                      const bf16x8 k10 = *(const LAS bf16x8*)(kbuf + (16 + r) * 144 + g * 16), k11 = *(const LAS bf16x8*)(kbuf + (16 + r) * 144 + 64 + g * 16);
                      s0 = MFMA16(k00, qb0, s0); s0 = MFMA16(k01, qb1, s0); s1 = MFMA16(k10, qb0, s1); s1 = MFMA16(k11, qb1, s1); }
                    bool v0[4], v1[4]; float mx = -1e30f;
#pragma unroll
                    for (int k = 0; k < 4; ++k) { const int na = n0 + 4 * g + k, nb = na + 16; v0[k] = active && (na >= lo) && (na <= hi); v1[k] = active && (nb >= lo) && (nb <= hi);
                        mx = fmaxf(mx, v0[k] ? s0[k] : -1e30f); mx = fmaxf(mx, v1[k] ? s1[k] : -1e30f); }
                    mx = fmaxf(mx, __shfl_xor(mx, 16)); mx = fmaxf(mx, __shfl_xor(mx, 32));
                    const float mn = fmaxf(m, mx), alpha = __builtin_amdgcn_exp2f(m - mn); m = mn;
                    float p0[4], p1[4], ps = 0.f;
#pragma unroll
                    for (int k = 0; k < 4; ++k) { p0[k] = v0[k] ? __builtin_amdgcn_exp2f(s0[k] - mn) : 0.f; p1[k] = v1[k] ? __builtin_amdgcn_exp2f(s1[k] - mn) : 0.f; ps += p0[k] + p1[k]; }
                    l = l * alpha + ps;
#pragma unroll
                    for (int i = 0; i < 4; ++i) o[i] = o[i] * alpha;
                    bf16x8 pb; { v4u w; w.x = pk2(p0[0], p0[1]); w.y = pk2(p0[2], p0[3]); w.z = pk2(p1[0], p1[1]); w.w = pk2(p1[2], p1[3]); pb = __builtin_bit_cast(bf16x8, w); }
                    LAS unsigned char* vrd = vbuf + tr_off;
#pragma unroll
                    for (int db = 0; db < 4; ++db) {
                        const v4i16 a0 = __builtin_amdgcn_ds_read_tr16_b64_v4i16((LAS v4i16*)(vrd + db * 32)), a1 = __builtin_amdgcn_ds_read_tr16_b64_v4i16((LAS v4i16*)(vrd + 16 * 160 + db * 32));
                        bf16x8 va; va[0] = a0[0]; va[1] = a0[1]; va[2] = a0[2]; va[3] = a0[3]; va[4] = a1[0]; va[5] = a1[1]; va[6] = a1[2]; va[7] = a1[3];
                        o[db] = MFMA16(va, pb, o[db]);
                    }
                }
            }
            l += __shfl_xor(l, 16); l += __shfl_xor(l, 32);
            const float inv = 1.0f / l;
            bf16* yo = YA + ((size_t)b * SEQ + tq) * 512 + h * 64 + 4 * g;
#pragma unroll
            for (int db = 0; db < 4; ++db) { uint2 w; w.x = pk2(o[db][0] * inv, o[db][1] * inv); w.y = pk2(o[db][2] * inv, o[db][3] * inv); *(uint2*)(yo + 16 * db) = w; }
        }
    }
}

__device__ __forceinline__ float conv_silu(const bf16* QKM, const float* cw, int b, int t, int ch) {
    float a = 0.f;
#pragma unroll
    for (int j = 0; j < 4; ++j) { const int tt = t - 3 + j; if (tt >= 0) a += cw[j * 1024 + ch] * bf2f(QKM[((size_t)b * SEQ + tt) * 1024 + ch]); }
    return silu(a);
}

__device__ __forceinline__ float scan_add(float v, int lane) {
#pragma unroll
    for (int o = 1; o < 64; o <<= 1) { const float u = __shfl_up(v, o); if (lane >= o) v += u; }
    return v;
}
__device__ __forceinline__ float scan_max(float v, int lane) {
#pragma unroll
    for (int o = 1; o < 64; o <<= 1) { const float u = __shfl_up(v, o); if (lane >= o) v = fmaxf(v, u); }
    return v;
}
__device__ __forceinline__ void conv16(const bf16* QKM, const float* cw, int b, int t0, int chan, float* out) {
    const bf16* src = QKM + (size_t)b * SEQ * 1024 + chan;
    const float w0 = cw[chan], w1 = cw[1024 + chan], w2 = cw[2048 + chan], w3 = cw[3072 + chan];
    float x0 = t0 >= 3 ? bf2f(src[(size_t)(t0 - 3) * 1024]) : 0.f, x1 = t0 >= 2 ? bf2f(src[(size_t)(t0 - 2) * 1024]) : 0.f, x2 = t0 >= 1 ? bf2f(src[(size_t)(t0 - 1) * 1024]) : 0.f;
#pragma unroll
    for (int i = 0; i < 16; ++i) { const float x3 = bf2f(src[(size_t)(t0 + i) * 1024]); out[i] = silu(w0 * x0 + w1 * x1 + w2 * x2 + w3 * x3); x0 = x1; x1 = x2; x2 = x3; }
}

__device__ __forceinline__ void p2_mlstm_local(const Params& P, LAS unsigned char* lds, int tid, int lane, int wave, int vb) {
    const bf16* QKM = (const bf16*)(P.ws + WS_QKM); const bf16* VM = (const bf16*)(P.ws + WS_VM); const float* IFb = (const float*)(P.ws + WS_IF);
    const float* cw = P.in[4];
    bf16* DC = (bf16*)((unsigned char*)P.out + OUT_DC); float* DN = (float*)(P.ws + WS_DN); float* SC = (float*)(P.ws + WS_SC);
    LAS bf16* KWT = (LAS bf16*)lds; LAS bf16* VT = (LAS bf16*)(lds + 18432); LAS float* sw = (LAS float*)(lds + 36864);
    const int r = lane & 15, g = lane >> 4;
    for (int item = vb; item < 2048; item += gridDim.x) {
        const int bh = item >> 8, c = item & 255, b = bh >> 2, h = bh & 3;
        if (wave == 0) {
            const size_t row = (size_t)b * SEQ + c * 64 + lane;
            const float lf = logsigmoid(IFb[row * 8 + 4 + h]), ip = IFb[row * 8 + h];
            const float bc = scan_add(lf, lane), gg = __shfl(bc, 63), ds = gg - bc + ip, ml = wave_max(ds);
            sw[lane] = __expf(ds - ml);
            if (lane == 0) { SC[item] = ml; SC[2048 + item] = gg; }
        }
        __syncthreads();
        { const int ch = tid & 127, sq = tid >> 7, s0 = sq * 16; float o[16];
          conv16(QKM, cw, b, c * 64 + s0, 512 + h * 128 + ch, o);
#pragma unroll
          for (int i = 0; i < 16; i += 2) *(LAS unsigned*)(KWT + ch * 72 + s0 + i) = pk2(o[i] * 0.08838834764831845f * sw[s0 + i], o[i + 1] * 0.08838834764831845f * sw[s0 + i + 1]);
          const bf16* vsrc = VM + ((size_t)b * SEQ + c * 64 + s0) * 512 + h * 128 + ch;
#pragma unroll
          for (int i = 0; i < 16; i += 2) *(LAS unsigned*)(VT + ch * 72 + s0 + i) = (unsigned)vsrc[(size_t)i * 512] | ((unsigned)vsrc[(size_t)(i + 1) * 512] << 16);
        }
        __syncthreads();
        {
          const bf16x8 vb0 = *(const LAS bf16x8*)(VT + (16 * wave + r) * 72 + 8 * g), vb1 = *(const LAS bf16x8*)(VT + (16 * wave + r) * 72 + 32 + 8 * g);
          bf16* dst = DC + (size_t)item * 16384 + (size_t)(16 * wave + r) * 128 + 4 * g;
#pragma unroll
          for (int eb = 0; eb < 8; ++eb) {
              const bf16x8 ka0 = *(const LAS bf16x8*)(KWT + (16 * eb + r) * 72 + 8 * g), ka1 = *(const LAS bf16x8*)(KWT + (16 * eb + r) * 72 + 32 + 8 * g);
              f32x4 acc = {0.f, 0.f, 0.f, 0.f};
              acc = MFMA16(ka0, vb0, acc); acc = MFMA16(ka1, vb1, acc);
              uint2 o; o.x = pk2(acc[0], acc[1]); o.y = pk2(acc[2], acc[3]); *(uint2*)(dst + 16 * eb) = o;
          }
        }
        if (tid < 128) { float a = 0.f;
#pragma unroll
            for (int cc = 0; cc < 8; ++cc) { float f[8]; unpk8(*(const LAS v4u*)(KWT + tid * 72 + 8 * cc), f);
#pragma unroll
                for (int k = 0; k < 8; ++k) a += f[k]; }
            DN[(size_t)item * 128 + tid] = a; }
        __syncthreads();
    }
}

__device__ __forceinline__ void p3_mlstm_scan(const Params& P, int tid, int vb) {
    const unsigned* __restrict__ DC = (const unsigned*)((unsigned char*)P.out + OUT_DC); unsigned* __restrict__ CS = (unsigned*)((unsigned char*)P.out + OUT_CS);
    const float* __restrict__ DN = (const float*)(P.ws + WS_DN); float* __restrict__ NS = (float*)(P.ws + WS_NS); float* SC = (float*)(P.ws + WS_SC);
    for (int gid = vb * 512 + tid; gid < 8 * 8192; gid += gridDim.x * 512) {
        const int bh = gid >> 13, idx = gid & 8191; const bool hasn = idx < 64;
        float C0 = 0.f, C1 = 0.f, n0 = 0.f, n1 = 0.f, m = 0.f;
        for (int j0 = 0; j0 < 256; j0 += 8) {
            unsigned d[8]; float ml[8], gg[8]; float2 dn[8];
#pragma unroll
            for (int u = 0; u < 8; ++u) { const int item = bh * 256 + j0 + u; d[u] = DC[(size_t)item * 8192 + idx]; ml[u] = SC[item]; gg[u] = SC[2048 + item];
                dn[u] = hasn ? *(const float2*)(DN + (size_t)item * 128 + 2 * idx) : make_float2(0.f, 0.f); }
#pragma unroll
            for (int u = 0; u < 8; ++u) { const int item = bh * 256 + j0 + u;
                CS[(size_t)item * 8192 + idx] = pk2(C0, C1);
                if (hasn) *(float2*)(NS + (size_t)item * 128 + 2 * idx) = make_float2(n0, n1);
                if (idx == 0) SC[4096 + item] = m;
                const float mn = fmaxf(gg[u] + m, ml[u]), a = __expf(gg[u] + m - mn), bb = __expf(ml[u] - mn);
                C0 = a * C0 + bb * bf_lo(d[u]); C1 = a * C1 + bb * bf_hi(d[u]); n0 = a * n0 + bb * dn[u].x; n1 = a * n1 + bb * dn[u].y; m = mn; }
        }
    }
}

struct P4Pref { v4u raw[7]; v4u cs[4]; uint2 om[4]; f32x4 gn; float ifa, ifb, nsv; };
__device__ __forceinline__ void p4_prefetch_raw(P4Pref& pf, const Params& P, int item, int tid, int lane) {
    const bf16* QKM = (const bf16*)(P.ws + WS_QKM); const bf16* VM = (const bf16*)(P.ws + WS_VM); const float* IFb = (const float*)(P.ws + WS_IF); const float* NS = (const float*)(P.ws + WS_NS);
    const int bh = item >> 8, c = item & 255, b = bh >> 2, h = bh & 3;
#pragma unroll
    for (int i = 0; i < 7; ++i) { const int v = tid + 512 * i; const int rr = v / 48, rem = v - rr * 48, seg = rem >> 4, c16 = rem & 15; const int t = c * 64 + rr - 3;
        v4u val = {0u, 0u, 0u, 0u};
        if (v < 3216 && t >= 0) val = (seg < 2) ? *(const v4u*)(QKM + ((size_t)b * SEQ + t) * 1024 + seg * 512 + h * 128 + 8 * c16) : *(const v4u*)(VM + ((size_t)b * SEQ + t) * 512 + h * 128 + 8 * c16);
        pf.raw[i] = val; }
    const size_t row = (size_t)b * SEQ + c * 64 + lane;
    pf.ifa = IFb[row * 8 + 4 + h]; pf.ifb = IFb[row * 8 + h];
    pf.nsv = NS[(size_t)item * 128 + (tid & 127)];
}
__device__ __forceinline__ void p4_prefetch_cs(P4Pref& pf, const Params& P, int item, int lane, int wave) {
    const bf16* CS = (const bf16*)((unsigned char*)P.out + OUT_CS);
    const bf16* crow = CS + (size_t)item * 16384 + (size_t)(16 * wave + (lane & 15)) * 128 + 8 * (lane >> 4);
#pragma unroll
    for (int ks = 0; ks < 4; ++ks) pf.cs[ks] = *(const v4u*)(crow + 32 * ks);
}
__device__ __forceinline__ void p4_prefetch_om(P4Pref& pf, const Params& P, int item, int lane, int wave) {
    const bf16* OM = (const bf16*)(P.ws + WS_OM);
    const int bh = item >> 8, c = item & 255, b = bh >> 2, h = bh & 3, r = lane & 15, g = lane >> 4;
#pragma unroll
    for (int tb = 0; tb < 4; ++tb) pf.om[tb] = *(const uint2*)(OM + ((size_t)b * SEQ + c * 64 + 16 * tb + r) * 512 + h * 128 + 16 * wave + 4 * g);
    pf.gn = *(const f32x4*)(P.in[6] + h * 128 + 16 * wave + 4 * g);
}
__device__ __forceinline__ void p4_mlstm_out(const Params& P, LAS unsigned char* lds, int tid, int lane, int wave, int vb) {
    const float* cw = P.in[4]; const float* SC = (const float*)(P.ws + WS_SC); bf16* YM = (bf16*)(P.ws + WS_YM);
    LAS float* CW = (LAS float*)lds;
    LAS unsigned char* RAW = lds + 16384;
    LAS bf16* Qs = (LAS bf16*)(lds + 68912); LAS bf16* Ks = (LAS bf16*)(lds + 86320); LAS bf16* VT = (LAS bf16*)(lds + 103728); LAS bf16* PT = (LAS bf16*)(lds + 122160);
    LAS float* sm = (LAS float*)(lds + 131376);
    LAS bf16* NSB = (LAS bf16*)(lds + 135728);
    const int r = lane & 15, g = lane >> 4;
    for (int i = tid; i < 1024; i += 512) ((LAS f32x4*)CW)[i] = ((const f32x4*)cw)[i];
    P4Pref pf;
    if (vb < 2048) { p4_prefetch_raw(pf, P, vb, tid, lane); p4_prefetch_cs(pf, P, vb, lane, wave); p4_prefetch_om(pf, P, vb, lane, wave); }
    for (int item = vb; item < 2048; item += gridDim.x) {
        const int bh = item >> 8, c = item & 255, b = bh >> 2, h = bh & 3;
#pragma unroll
        for (int i = 0; i < 7; ++i) { const int v = tid + 512 * i; if (v < 3216) { const int rr = v / 48, rem = v - rr * 48; *(LAS v4u*)(RAW + rr * 784 + rem * 16) = pf.raw[i]; } }
        if (tid < 128) NSB[tid] = (bf16)f2bf(pf.nsv);
        if (wave == 0) {
            const float lf = logsigmoid(pf.ifa), ip = pf.ifb;
            const float bc = scan_add(lf, lane), a = ip - bc, pm = scan_max(a, lane), ms = SC[4096 + item], M = fmaxf(ms, pm);
            sm[lane] = a; sm[64 + lane] = M; sm[128 + lane] = __expf(ms - M); sm[192 + lane] = __expf(-bc - M);
        }
        __syncthreads();
        { const int g4 = tid & 31, s0 = (tid >> 5) * 4;
#pragma unroll
          for (int tile = 0; tile < 2; ++tile) {
              float x[7][4];
#pragma unroll
              for (int j = 0; j < 7; ++j) { const v2u rv = *(const LAS v2u*)(RAW + (s0 + j) * 784 + tile * 256 + g4 * 8); x[j][0] = bf_lo(rv.x); x[j][1] = bf_hi(rv.x); x[j][2] = bf_lo(rv.y); x[j][3] = bf_hi(rv.y); }
              f32x4 w[4];
#pragma unroll
              for (int tp = 0; tp < 4; ++tp) w[tp] = *(const LAS f32x4*)(CW + tp * 1024 + tile * 512 + h * 128 + 4 * g4);
              const float sc = tile ? 0.08838834764831845f : 1.0f; LAS bf16* dst = tile ? Ks : Qs;
#pragma unroll
              for (int j = 0; j < 4; ++j) { float y[4];
#pragma unroll
                  for (int i = 0; i < 4; ++i) y[i] = silu(w[0][i] * x[j][i] + w[1][i] * x[j + 1][i] + w[2][i] * x[j + 2][i] + w[3][i] * x[j + 3][i]) * sc;
                  v2u o; o.x = pk2(y[0], y[1]); o.y = pk2(y[2], y[3]); *(LAS v2u*)(dst + (s0 + j) * 136 + 4 * g4) = o; }
          }
          const int ch = tid & 127, sv = (tid >> 7) * 16;
#pragma unroll
          for (int i = 0; i < 16; i += 2) { const unsigned lo = *(const LAS bf16*)(RAW + (3 + sv + i) * 784 + 512 + ch * 2), hi = *(const LAS bf16*)(RAW + (4 + sv + i) * 784 + 512 + ch * 2);
              *(LAS unsigned*)(VT + ch * 72 + sv + i) = lo | (hi << 16); }
        }
        asm volatile("" ::: "memory");
        if (item + (int)gridDim.x < 2048) p4_prefetch_raw(pf, P, item + gridDim.x, tid, lane);
        __syncthreads();
        { const int sb = wave >> 1;
          bf16x8 ka[4];
#pragma unroll
          for (int ks = 0; ks < 4; ++ks) ka[ks] = *(const LAS bf16x8*)(Ks + (16 * sb + r) * 136 + 32 * ks + 8 * g);
#pragma unroll
          for (int tt = 0; tt < 2; ++tt) { const int tb = 2 * (wave & 1) + tt, t = 16 * tb + r;
              f32x4 acc = {0.f, 0.f, 0.f, 0.f};
#pragma unroll
              for (int ks = 0; ks < 4; ++ks) { const bf16x8 qb = *(const LAS bf16x8*)(Qs + t * 136 + 32 * ks + 8 * g); acc = MFMA16(ka[ks], qb, acc); }
              const float Mt = sm[64 + t]; float p[4], ps = 0.f;
#pragma unroll
              for (int k = 0; k < 4; ++k) { const int s = 16 * sb + 4 * g + k; p[k] = (s <= t) ? acc[k] * __expf(sm[s] - Mt) : 0.f; ps += p[k]; }
              v2u o; o.x = pk2(p[0], p[1]); o.y = pk2(p[2], p[3]); *(LAS v2u*)(PT + t * 72 + 16 * sb + 4 * g) = o;
              ps += __shfl_xor(ps, 16); ps += __shfl_xor(ps, 32);
              if (g == 0) sm[320 + sb * 64 + t] = ps; }
        }
        __syncthreads();
        f32x4 ai[4], ac[4], an[4];
#pragma unroll
        for (int tb = 0; tb < 4; ++tb) { ai[tb] = (f32x4){0.f, 0.f, 0.f, 0.f}; ac[tb] = (f32x4){0.f, 0.f, 0.f, 0.f}; an[tb] = (f32x4){0.f, 0.f, 0.f, 0.f}; }
        { const bf16x8 va0 = *(const LAS bf16x8*)(VT + (16 * wave + r) * 72 + 8 * g), va1 = *(const LAS bf16x8*)(VT + (16 * wave + r) * 72 + 32 + 8 * g);
          const bf16x8 ca0 = __builtin_bit_cast(bf16x8, pf.cs[0]), ca1 = __builtin_bit_cast(bf16x8, pf.cs[1]), ca2 = __builtin_bit_cast(bf16x8, pf.cs[2]), ca3 = __builtin_bit_cast(bf16x8, pf.cs[3]);
          const bf16x8 zero8 = {0, 0, 0, 0, 0, 0, 0, 0};
#pragma unroll
          for (int tb = 0; tb < 4; ++tb) { const int t = 16 * tb + r;
              const bf16x8 pb0 = *(const LAS bf16x8*)(PT + t * 72 + 8 * g), pb1 = *(const LAS bf16x8*)(PT + t * 72 + 32 + 8 * g);
              ai[tb] = MFMA16(va0, pb0, ai[tb]); ai[tb] = MFMA16(va1, pb1, ai[tb]);
              const bf16x8 q0 = *(const LAS bf16x8*)(Qs + t * 136 + 8 * g), q1 = *(const LAS bf16x8*)(Qs + t * 136 + 32 + 8 * g), q2 = *(const LAS bf16x8*)(Qs + t * 136 + 64 + 8 * g), q3 = *(const LAS bf16x8*)(Qs + t * 136 + 96 + 8 * g);
              ac[tb] = MFMA16(ca0, q0, ac[tb]); ac[tb] = MFMA16(ca1, q1, ac[tb]); ac[tb] = MFMA16(ca2, q2, ac[tb]); ac[tb] = MFMA16(ca3, q3, ac[tb]);
              if (wave == 0) {
                  const bf16x8 n0 = r == 0 ? *(const LAS bf16x8*)(NSB + 8 * g) : zero8, n1 = r == 0 ? *(const LAS bf16x8*)(NSB + 32 + 8 * g) : zero8, n2 = r == 0 ? *(const LAS bf16x8*)(NSB + 64 + 8 * g) : zero8, n3 = r == 0 ? *(const LAS bf16x8*)(NSB + 96 + 8 * g) : zero8;
                  an[tb] = MFMA16(n0, q0, an[tb]); an[tb] = MFMA16(n1, q1, an[tb]); an[tb] = MFMA16(n2, q2, an[tb]); an[tb] = MFMA16(n3, q3, an[tb]);
                  if (g == 0) { const float den = sm[128 + t] * an[tb][0] + (sm[320 + t] + sm[384 + t]) + (sm[448 + t] + sm[512 + t]); sm[256 + t] = fmaxf(fabsf(den), sm[192 + t]); } } }
        }
        asm volatile("" ::: "memory");
        if (item + (int)gridDim.x < 2048) p4_prefetch_cs(pf, P, item + gridDim.x, lane, wave);
#pragma unroll
        for (int tb = 0; tb < 4; ++tb) { const int t = 16 * tb + r; const float wi = sm[128 + t]; float s2 = 0.f;
#pragma unroll
            for (int k = 0; k < 4; ++k) { ai[tb][k] = wi * ac[tb][k] + ai[tb][k]; s2 += ai[tb][k] * ai[tb][k]; }
            s2 += __shfl_xor(s2, 16); s2 += __shfl_xor(s2, 32);
            if (g == 0) sm[576 + wave * 64 + t] = s2; }
        __syncthreads();
        {
#pragma unroll
          for (int tb = 0; tb < 4; ++tb) { const int t = 16 * tb + r; float tot = 0.f;
#pragma unroll
              for (int w = 0; w < 8; ++w) tot += sm[576 + w * 64 + t];
              const float inv = 1.0f / sm[256 + t], rs = inv * rsqrtf(tot * inv * inv * (1.f / 128.f) + EPS);
              const size_t row = (size_t)b * SEQ + c * 64 + t; const int col = h * 128 + 16 * wave + 4 * g;
              uint2 o; o.x = pk2(ai[tb][0] * rs * pf.gn[0] * bf_lo(pf.om[tb].x), ai[tb][1] * rs * pf.gn[1] * bf_hi(pf.om[tb].x)); o.y = pk2(ai[tb][2] * rs * pf.gn[2] * bf_lo(pf.om[tb].y), ai[tb][3] * rs * pf.gn[3] * bf_hi(pf.om[tb].y));
              *(uint2*)(YM + row * 512 + col) = o; }
        }
        asm volatile("" ::: "memory");
        if (item + (int)gridDim.x < 2048) p4_prefetch_om(pf, P, item + gridDim.x, lane, wave);
        __syncthreads();
    }
}

__device__ __forceinline__ int f2ord(float f) { const int b = __float_as_int(f); return b ^ ((b >> 31) & 0x7fffffff); }
__device__ __forceinline__ float ord2f(int o) { return __int_as_float(o ^ ((o >> 31) & 0x7fffffff)); }
#define CE_DESC(a, i, j) { const int _h = max(a[i], a[j]), _l = min(a[i], a[j]); a[i] = _h; a[j] = _l; }
__device__ __forceinline__ void sort16_desc(int (&a)[16]) {
#pragma unroll
    for (int k = 2; k <= 16; k <<= 1) {
#pragma unroll
        for (int j = k >> 1; j > 0; j >>= 1) {
#pragma unroll
            for (int i = 0; i < 16; ++i) { const int l = i ^ j; if (l > i) { if ((i & k) == 0) CE_DESC(a, i, l) else CE_DESC(a, l, i) } }
        }
    }
}
__device__ __forceinline__ void merge16_desc(int (&a)[16], const int (&b)[16]) {
#pragma unroll
    for (int i = 0; i < 16; ++i) a[i] = max(a[i], b[15 - i]);
#pragma unroll
    for (int j = 8; j > 0; j >>= 1) {
#pragma unroll
        for (int i = 0; i < 16; ++i) { const int l = i ^ j; if (l > i) CE_DESC(a, i, l) }
    }
}
__device__ __forceinline__ void xmerge16(int (&a)[16], int mask) {
    int b[16];
#pragma unroll
    for (int i = 0; i < 16; ++i) b[i] = __shfl_xor(a[i], mask);
    merge16_desc(a, b);
}
__device__ __forceinline__ void p10_topk(const Params& P, LAS unsigned char* lds, int tid, int lane, int wave, int vb) {
    const bf16* Q2 = (const bf16*)(P.ws + WS_Q2); const bf16* K1B = (const bf16*)(P.ws + WS_K1B); const bf16* K2B = (const bf16*)(P.ws + WS_K2B);
    int* IDX = (int*)(P.ws + WS_IDX); float* GATE = (float*)(P.ws + WS_GATE); const float* SSQ1 = (const float*)(P.ws + WS_SSQ1);
    LAS bf16* Kl = (LAS bf16*)lds;
    LAS int* Tb = (LAS int*)(lds + 69632 + wave * 2048);
    const int r = lane & 15, g = lane >> 4;
    const int h = vb & 7, wgx = vb >> 3, nwg = gridDim.x >> 3;
    __syncthreads();
    for (int i = tid; i < 4096; i += 512) { const int half = i >> 11, rem = i & 2047, n = rem >> 4, c = rem & 15;
        *(LAS v4u*)(Kl + half * 17408 + n * 136 + c * 8) = *(const v4u*)((half ? K2B : K1B) + (size_t)h * 16384 + n * 128 + c * 8); }
    __syncthreads();
    for (int tile = wgx * NW + wave; tile < NTOK / 16; tile += nwg * NW) {
        const size_t row = (size_t)tile * 16 + r;
        int R[2][16];
#pragma unroll
        for (int half = 0; half < 2; ++half) {
            bf16x8 qb[4];
#pragma unroll
            for (int ks = 0; ks < 4; ++ks) qb[ks] = *(const bf16x8*)(Q2 + row * 2048 + h * 256 + half * 128 + 32 * ks + 8 * g);
            int X[16], Y[16];
#pragma unroll
            for (int nb = 0; nb < 8; ++nb) {
                f32x4 acc = {0.f, 0.f, 0.f, 0.f};
#pragma unroll
                for (int ks = 0; ks < 4; ++ks) acc = MFMA16(*(const LAS bf16x8*)(Kl + half * 17408 + (16 * nb + r) * 136 + 32 * ks + 8 * g), qb[ks], acc);
#pragma unroll
                for (int k = 0; k < 4; ++k) { const int key = (f2ord(acc[k]) & ~0x7f) | (16 * nb + 4 * g + k); if (nb < 4) X[4 * nb + k] = key; else Y[4 * (nb - 4) + k] = key; }
            }
            sort16_desc(X); sort16_desc(Y); merge16_desc(X, Y);
            xmerge16(X, 16); xmerge16(X, 32);
#pragma unroll
            for (int i = 0; i < 16; ++i) R[half][i] = X[i];
        }
        if (g == 0) {
#pragma unroll
            for (int i = 0; i < 16; ++i) { Tb[r * 32 + i] = R[0][i] & 0x7f; Tb[r * 32 + 16 + i] = R[1][i] & 0x7f; }
        }
        float F1[16], F2[16];
#pragma unroll
        for (int i = 0; i < 16; ++i) { F1[i] = ord2f(R[0][i] & ~0x7f); F2[i] = ord2f(R[1][i] & ~0x7f); }
        int C[16];
#pragma unroll
        for (int sl = 0; sl < 16; ++sl) {
            const int a1 = sl < 8 ? 1 : (sl < 13 ? 2 : -1), b1 = sl < 8 ? sl : sl - 8;
            const int a2 = sl < 4 ? 3 : (sl < 7 ? 4 : (sl < 9 ? 5 : (sl < 11 ? 6 : (sl < 13 ? 7 : -1)))), b2 = sl < 4 ? sl : (sl < 7 ? sl - 4 : (sl < 9 ? sl - 7 : (sl < 11 ? sl - 9 : sl - 11)));
            const int a3 = sl < 8 ? 8 + sl : -1;
            const int k0 = (f2ord(F1[0] + F2[sl]) & ~0xff) | (0 << 4) | sl;
            const int k1 = a1 >= 0 ? ((f2ord(F1[a1 < 0 ? 0 : a1] + F2[b1 & 15]) & ~0xff) | (a1 << 4) | (b1 & 15)) : (int)0x80000000;
            const int k2 = a2 >= 0 ? ((f2ord(F1[a2 < 0 ? 0 : a2] + F2[b2 & 15]) & ~0xff) | (a2 << 4) | (b2 & 15)) : (int)0x80000000;
            const int k3 = a3 >= 0 ? ((f2ord(F1[a3 < 0 ? 0 : a3] + F2[0]) & ~0xff) | (a3 << 4)) : (int)0x80000000;
            C[sl] = g == 0 ? k0 : (g == 1 ? k1 : (g == 2 ? k2 : k3));
        }
        sort16_desc(C); xmerge16(C, 16); xmerge16(C, 32);
        const float rstd1 = rsqrtf(SSQ1[row] * (1.0f / 1024.0f) + EPS);
        float e[16], sum = 0.f; const float mx = ord2f(C[0] & ~0xff);
#pragma unroll
        for (int i = 0; i < 16; ++i) { e[i] = __expf((ord2f(C[i] & ~0xff) - mx) * rstd1); sum += e[i]; }
        const float inv = 1.0f / sum;
        int oi[4]; float og[4];
#pragma unroll
        for (int kk = 0; kk < 4; ++kk) {
            const int key = g == 0 ? C[kk] : (g == 1 ? C[4 + kk] : (g == 2 ? C[8 + kk] : C[12 + kk]));
            const float ev = g == 0 ? e[kk] : (g == 1 ? e[4 + kk] : (g == 2 ? e[8 + kk] : e[12 + kk]));
            const int a = (key >> 4) & 15, bq = key & 15;
            oi[kk] = Tb[r * 32 + a] * 128 + Tb[r * 32 + 16 + bq]; og[kk] = ev * inv;
        }
#pragma unroll
        for (int kk = 0; kk < 4; ++kk) { const int pos = (4 * (g & 1) + kk) * 16 + 2 * h + (g >> 1); IDX[row * 128 + pos] = oi[kk]; GATE[row * 128 + pos] = og[kk]; }
    }
}

typedef _Float16 f16x2 __attribute__((ext_vector_type(2)));
__device__ __forceinline__ f16x2 bfpair_to_h2(unsigned w) { return __builtin_bit_cast(f16x2, __builtin_amdgcn_cvt_pkrtz(bf_lo(w), bf_hi(w))); }
template <int B> __device__ __forceinline__ f16x2 fp4_to_h2(unsigned w) { return __builtin_bit_cast(f16x2, __builtin_amdgcn_cvt_scalef32_pk_f16_fp4(w, 1.0f, B)); }
__device__ __forceinline__ void p11a_udot(const Params& P, int lane, int wave, int vb) {
    const bf16* HN = (const bf16*)(P.ws + WS_HN); const unsigned char* U4 = P.ws + WS_U4; const int* IDX = (const int*)(P.ws + WS_IDX); float* PART = (float*)(P.ws + WS_PART);
    const int x = vb & 3, wgx = vb >> 2, nwg = gridDim.x >> 2, rg = lane >> 3, ch = lane & 7;
    for (int t = wgx * NW + wave; t < NTOK; t += nwg * NW) {
        int e[16];
#pragma unroll
        for (int q = 0; q < 4; ++q) { const int4 v = *(const int4*)(IDX + (size_t)t * 128 + rg * 16 + 4 * q); e[4 * q] = v.x; e[4 * q + 1] = v.y; e[4 * q + 2] = v.z; e[4 * q + 3] = v.w; }
        v4u hq[4];
#pragma unroll
        for (int q = 0; q < 4; ++q) hq[q] = *(const v4u*)(HN + (size_t)t * 1024 + 256 * x + 32 * ch + 8 * q);
        v4u ud[16];
#pragma unroll
        for (int gq = 0; gq < 16; ++gq) ud[gq] = *(const v4u*)(U4 + (size_t)e[gq] * 512 + 128 * x + 16 * ch);
        f16x2 hh[16];
#pragma unroll
        for (int q = 0; q < 4; ++q) { hh[4 * q] = bfpair_to_h2(hq[q].x); hh[4 * q + 1] = bfpair_to_h2(hq[q].y); hh[4 * q + 2] = bfpair_to_h2(hq[q].z); hh[4 * q + 3] = bfpair_to_h2(hq[q].w); }
        float z[16];
#pragma unroll
        for (int gq = 0; gq < 16; ++gq) { float d = 0.f; const unsigned w4[4] = {ud[gq].x, ud[gq].y, ud[gq].z, ud[gq].w};
#pragma unroll
            for (int q = 0; q < 4; ++q) { d = __builtin_amdgcn_fdot2(fp4_to_h2<0>(w4[q]), hh[4 * q], d, false); d = __builtin_amdgcn_fdot2(fp4_to_h2<1>(w4[q]), hh[4 * q + 1], d, false);
                d = __builtin_amdgcn_fdot2(fp4_to_h2<2>(w4[q]), hh[4 * q + 2], d, false); d = __builtin_amdgcn_fdot2(fp4_to_h2<3>(w4[q]), hh[4 * q + 3], d, false); }
            z[gq] = d; }
        float z8[8], z4[4], z2[2];
        { const bool b = ch & 4;
#pragma unroll
          for (int i = 0; i < 8; ++i) { const float keep = b ? z[8 + i] : z[i], send = b ? z[i] : z[8 + i]; z8[i] = keep + __shfl_xor(send, 4); } }
        { const bool b = ch & 2;
#pragma unroll
          for (int i = 0; i < 4; ++i) { const float keep = b ? z8[4 + i] : z8[i], send = b ? z8[i] : z8[4 + i]; z4[i] = keep + __shfl_xor(send, 2); } }
        { const bool b = ch & 1;
#pragma unroll
          for (int i = 0; i < 2; ++i) { const float keep = b ? z4[2 + i] : z4[i], send = b ? z4[i] : z4[2 + i]; z2[i] = keep + __shfl_xor(send, 1); } }
        *(float2*)(PART + ((size_t)t * 4 + x) * 128 + rg * 16 + 2 * ch) = make_float2(z2[0], z2[1]);
    }
}
__device__ __forceinline__ void p11b_weights(const Params& P, int tid, int vb) {
    const float* PART = (const float*)(P.ws + WS_PART); float* GW = (float*)(P.ws + WS_GATE); const float* SSQ1 = (const float*)(P.ws + WS_SSQ1);
    const int* IDX = (const int*)(P.ws + WS_IDX); const float* SU = (const float*)(P.ws + WS_SU); const float* SV = (const float*)(P.ws + WS_SV);
    for (size_t i = (size_t)vb * 512 + tid; i < (size_t)NTOK * 128; i += (size_t)gridDim.x * 512) {
        const size_t t = i >> 7, pos = i & 127; float zs = 0.f;
#pragma unroll
        for (int x = 0; x < 4; ++x) zs += PART[(t * 4 + x) * 128 + pos];
        const int e = IDX[i];
        const float zv = zs * SU[e] * rsqrtf(SSQ1[t] * (1.0f / 1024.0f) + EPS);
        GW[i] = GW[i] * 0.5f * zv * (1.0f + erff(zv * 0.70710678118654752f)) * SV[e];
    }
}
__device__ __forceinline__ void p11c_vacc(const Params& P, int lane, int wave, int vb) {
    const unsigned char* V4 = P.ws + WS_V4; const int* IDX = (const int*)(P.ws + WS_IDX); const float* GW = (const float*)(P.ws + WS_GATE);
    float* X = P.out; float* SSQ = (float*)(P.ws + WS_SSQ); bf16* XG = (bf16*)(P.ws + WS_HN2); const float* gple = P.in[16];
    const int x = vb & 3, wgx = vb >> 2, nwg = gridDim.x >> 2, rg = lane >> 3, ch = lane & 7;
    const f32x4 gp = *(const f32x4*)(gple + 256 * x + 32 * ch + 4 * rg);
    for (int t = wgx * NW + wave; t < NTOK; t += nwg * NW) {
        int e[16]; float w[16];
#pragma unroll
        for (int q = 0; q < 4; ++q) { const int4 v = *(const int4*)(IDX + (size_t)t * 128 + rg * 16 + 4 * q); e[4 * q] = v.x; e[4 * q + 1] = v.y; e[4 * q + 2] = v.z; e[4 * q + 3] = v.w;
            const float4 wv = *(const float4*)(GW + (size_t)t * 128 + rg * 16 + 4 * q); w[4 * q] = wv.x; w[4 * q + 1] = wv.y; w[4 * q + 2] = wv.z; w[4 * q + 3] = wv.w; }
        v4u vd[16];
#pragma unroll
        for (int gq = 0; gq < 16; ++gq) vd[gq] = *(const v4u*)(V4 + (size_t)e[gq] * 512 + 128 * x + 16 * ch);
        float* xp = X + (size_t)t * 1024 + 256 * x + 32 * ch + 4 * rg;
        const f32x4 xo = *(const f32x4*)xp;
        f16x2 acc[16];
#pragma unroll
        for (int i = 0; i < 16; ++i) acc[i] = (f16x2){(_Float16)0.f, (_Float16)0.f};
#pragma unroll
        for (int gq = 0; gq < 16; ++gq) { const f16x2 ww = __builtin_bit_cast(f16x2, __builtin_amdgcn_cvt_pkrtz(w[gq], w[gq])); const unsigned w4[4] = {vd[gq].x, vd[gq].y, vd[gq].z, vd[gq].w};
#pragma unroll
            for (int q = 0; q < 4; ++q) { acc[4 * q] = __builtin_elementwise_fma(fp4_to_h2<0>(w4[q]), ww, acc[4 * q]); acc[4 * q + 1] = __builtin_elementwise_fma(fp4_to_h2<1>(w4[q]), ww, acc[4 * q + 1]);
                acc[4 * q + 2] = __builtin_elementwise_fma(fp4_to_h2<2>(w4[q]), ww, acc[4 * q + 2]); acc[4 * q + 3] = __builtin_elementwise_fma(fp4_to_h2<3>(w4[q]), ww, acc[4 * q + 3]); } }
        f16x2 a8[8], a4[4], a2[2];
        { const bool b = rg & 4;
#pragma unroll
          for (int i = 0; i < 8; ++i) { const f16x2 keep = b ? acc[8 + i] : acc[i], send = b ? acc[i] : acc[8 + i]; a8[i] = keep + __builtin_bit_cast(f16x2, __shfl_xor(__builtin_bit_cast(int, send), 32)); } }
        { const bool b = rg & 2;
#pragma unroll
          for (int i = 0; i < 4; ++i) { const f16x2 keep = b ? a8[4 + i] : a8[i], send = b ? a8[i] : a8[4 + i]; a4[i] = keep + __builtin_bit_cast(f16x2, __shfl_xor(__builtin_bit_cast(int, send), 16)); } }
        { const bool b = rg & 1;
#pragma unroll
          for (int i = 0; i < 2; ++i) { const f16x2 keep = b ? a4[2 + i] : a4[i], send = b ? a4[i] : a4[2 + i]; a2[i] = keep + __builtin_bit_cast(f16x2, __shfl_xor(__builtin_bit_cast(int, send), 8)); } }
        f32x4 xn; xn[0] = xo[0] + (float)a2[0][0]; xn[1] = xo[1] + (float)a2[0][1]; xn[2] = xo[2] + (float)a2[1][0]; xn[3] = xo[3] + (float)a2[1][1];
        *(f32x4*)xp = xn;
        uint2 xg; xg.x = pk2(xn[0] * gp[0], xn[1] * gp[1]); xg.y = pk2(xn[2] * gp[2], xn[3] * gp[3]);
        *(uint2*)(XG + (size_t)t * 1024 + 256 * x + 32 * ch + 4 * rg) = xg;
        const float ss = wave_sum((xn[0] * xn[0] + xn[1] * xn[1]) + (xn[2] * xn[2] + xn[3] * xn[3]));
        if (lane == 0) atomicAdd(SSQ + t, ss);
    }
}

__global__ void __launch_bounds__(512, 2) mk_fwd(Params P) {
    extern __shared__ __attribute__((aligned(16))) unsigned char lds_raw[];
    cg::grid_group grid = cg::this_grid();
    LAS unsigned char* lds = (LAS unsigned char*)lds_raw;
    const int tid = threadIdx.x, lane = tid & 63, wave = __builtin_amdgcn_readfirstlane(tid >> 6);
    const int lo = P.ph_lo, hi = P.ph_hi, G = gridDim.x, bx = blockIdx.x;
    unsigned char* ws = P.ws;
    const int gw = bx * NW + wave, NGW = G * NW;
#ifndef PH_MASK
#define PH_MASK 0xffff
#endif
#define IN(k) (((PH_MASK >> (k)) & 1) && lo <= (k) && (k) < hi)
    volatile LAS unsigned* xst = (volatile LAS unsigned*)(lds + LDS_BYTES - 16);
    if (tid < 4) xst[tid] = 0u;
    __syncthreads();
    const XcdBarrier bar = xcd_barrier_post((unsigned*)(ws + WS_BAR), xst);
    unsigned* vctl = (unsigned*)(ws + WS_BAR) + 4096;
    if (tid == 0) { const unsigned xcc = xb_xcc_id() & 7u; xst[2] = xcc; xst[3] = xb_add(&vctl[16 * xcc], 1u); }
#ifdef USE_CG
#define GRID_BAR() grid.sync()
#else
#define GRID_BAR() xcd_barrier(bar)
#endif
#define SYNC_AFTER(k) do { if (IN(k) && IN((k) + 1)) { if ((k) == 0) grid.sync(); else GRID_BAR(); } } while (0)
    typedef pg8::bf16_t pb;
    if (IN(0)) p0_prologue(P, lds, tid, lane, wave);
    SYNC_AFTER(0);
    if (tid == 0) {
        const unsigned xcc = xst[2], sl = xst[3], cap = (unsigned)G >> 3; unsigned v;
        if (sl < cap) v = sl * 8u + xcc;
        else { unsigned o = xb_add(&vctl[160], 1u); v = 0u;
            for (unsigned x = 0; x < 8u; ++x) { const unsigned c = min(xb_ld(&vctl[16 * x]), cap), fr = cap - c; if (o < fr) { v = (c + o) * 8u + x; break; } o -= fr; } }
        xst[2] = v;
    }
    __syncthreads();
    const int vb = (int)xst[2];
    if (IN(1)) {
        pg8::Gemm g{(const pb*)(ws + WS_XN), (const pb*)(ws + WS_W1T), NTOK, 5632, 1024}; pg8::StaticOrder S; S.init(NTOK, 5632, G, vb);
        pg8::EpiProj E{(pb*)(ws + WS_QKVA), (pb*)(ws + WS_QKM), (pb*)(ws + WS_VM), (pb*)(ws + WS_OM), (pb*)(ws + WS_G), C2};
        pg8::gemm_phase<pg8::EpiProj, pg8::StaticOrder, true, true>(lds, g, S, E);
    }
    SYNC_AFTER(1);
    if (IN(2)) { p2_attention(P, lds, lane, wave, vb); __syncthreads(); p2_mlstm_local(P, lds, tid, lane, wave, vb); }
    SYNC_AFTER(2);
    if (IN(3)) p3_mlstm_scan(P, tid, vb);
    SYNC_AFTER(3);
    if (IN(4)) p4_mlstm_out(P, lds, tid, lane, wave, vb);
    SYNC_AFTER(4);
    if (IN(5)) {
        pg8::Gemm g{(const pb*)(ws + WS_YA), (const pb*)(ws + WS_WAT), NTOK, 1024, 512}; pg8::StaticOrder S; S.init(NTOK, 1024, G, vb);
        pg8::EpiGated<false> E{(pb*)(ws + WS_TMP), nullptr, (const pb*)(ws + WS_G), 0};
        pg8::gemm_phase<pg8::EpiGated<false>, pg8::StaticOrder, true, true>(lds, g, S, E);
    }
    if (IN(5) && IN(6)) { asm volatile("s_waitcnt vmcnt(0)" ::: "memory"); __syncthreads(); }
    if (IN(6)) {
        pg8::Gemm g{(const pb*)(ws + WS_YM), (const pb*)(ws + WS_WMT), NTOK, 1024, 512}; pg8::StaticOrder S; S.init(NTOK, 1024, G, vb);
        pg8::EpiGated<true> E{(pb*)(ws + WS_MERGED), (const pb*)(ws + WS_TMP), (const pb*)(ws + WS_G), 1024};
        pg8::gemm_phase<pg8::EpiGated<true>, pg8::StaticOrder, true, true>(lds, g, S, E);
    }
    SYNC_AFTER(6);
    if (IN(7)) {
        pg8::Gemm g{(const pb*)(ws + WS_MERGED), (const pb*)(ws + WS_WOT), NTOK, 1024, 1024}; pg8::StaticOrder S; S.init(NTOK, 1024, G, vb);
        pg8::EpiResidual E{P.in[0], P.out, (pb*)(ws + WS_HN), P.in[10], (float*)(ws + WS_SSQ1)};
        pg8::gemm_phase<pg8::EpiResidual, pg8::StaticOrder, true, true>(lds, g, S, E);
    }
    if (IN(7) && IN(9)) GRID_BAR();
    if (IN(9)) {
        pg8::Gemm g{(const pb*)(ws + WS_HN), (const pb*)(ws + WS_WQT), NTOK, 2048, 1024}; pg8::StaticOrder S; S.init(NTOK, 2048, G, vb);
        pg8::EpiStore E{(pb*)(ws + WS_Q2), 2048};
        pg8::gemm_phase<pg8::EpiStore, pg8::StaticOrder, true, true>(lds, g, S, E);
    }
    SYNC_AFTER(9);
    if (IN(10)) p10_topk(P, lds, tid, lane, wave, vb);
    SYNC_AFTER(10);
    if (IN(11)) { p11a_udot(P, lane, wave, vb); GRID_BAR(); p11b_weights(P, tid, vb); GRID_BAR(); p11c_vacc(P, lane, wave, vb); }
    SYNC_AFTER(11);
    if (IN(12)) {
        pg8::Gemm g{(const pb*)(ws + WS_PB), (const pb*)(ws + WS_WPT), NTOK, 1024, 256}; pg8::StaticOrder S; S.init(NTOK, 1024, G, vb);
        pg8::EpiStore E{(pb*)(ws + WS_E), 1024};
        pg8::gemm_phase<pg8::EpiStore, pg8::StaticOrder, true, true>(lds, g, S, E);
    }
    if (IN(12) && IN(13)) { asm volatile("s_waitcnt vmcnt(0)" ::: "memory"); __syncthreads(); }
    if (IN(13)) {
        pg8::Gemm g{(const pb*)(ws + WS_HN2), (const pb*)(ws + WS_WGT), NTOK, 1024, 1024}; pg8::StaticOrder S; S.init(NTOK, 1024, G, vb);
        pg8::EpiPle E{P.out, (const pb*)(ws + WS_E), (const float*)(ws + WS_SSQ)};
        pg8::gemm_phase<pg8::EpiPle, pg8::StaticOrder, true, true>(lds, g, S, E);
    }
    SYNC_AFTER(13);
    if (IN(14)) {
        const float* gf = P.in[19];
        for (int m = gw; m < NTOK; m += NGW) {
            float* xr = P.out + (size_t)m * 1024; f32x4 v[4]; float s = 0.f;
#pragma unroll
            for (int j = 0; j < 4; ++j) { v[j] = ((const f32x4*)xr)[lane + 64 * j]; s += (v[j][0] * v[j][0] + v[j][1] * v[j][1]) + (v[j][2] * v[j][2] + v[j][3] * v[j][3]); }
            const float rstd = rsqrtf(wave_sum(s) * (1.f / 1024.f) + EPS);
#pragma unroll
            for (int j = 0; j < 4; ++j) { const f32x4 g = ((const f32x4*)gf)[lane + 64 * j]; ((f32x4*)xr)[lane + 64 * j] = v[j] * rstd * g; }
        }
    }
}

extern "C" void kernel_launch(void* const* d_in, const int* in_sizes, int n_in, void* d_out, int out_size, void* d_ws, size_t ws_size, hipStream_t stream) {
    static int grid_blocks = 0;
    if (!grid_blocks) {
        int dev = 0, cus = 0, per_cu = 0;
        (void)hipGetDevice(&dev);
        (void)hipDeviceGetAttribute(&cus, hipDeviceAttributeMultiprocessorCount, dev);
        (void)hipFuncSetAttribute((const void*)mk_fwd, hipFuncAttributeMaxDynamicSharedMemorySize, LDS_BYTES);
        (void)hipOccupancyMaxActiveBlocksPerMultiprocessor(&per_cu, mk_fwd, 512, LDS_BYTES);
        if (per_cu > 1) per_cu = 1;
        grid_blocks = cus * per_cu;
    }
    if (n_in < 20 || ws_size < WS_NEED || grid_blocks <= 0) { fprintf(stderr, "kernel_launch: bad setup (n_in %d ws %zu grid %d)\n", n_in, ws_size, grid_blocks); return; }
    Params p{};
    for (int i = 0; i < 20; ++i) p.in[i] = (const float*)d_in[i];
    p.out = (float*)d_out; p.ws = (unsigned char*)d_ws; p.ph_lo = 0; p.ph_hi = 15;
    (void)hipMemsetAsync((unsigned char*)d_ws + WS_BAR, 0, BAR_BYTES, stream);
    void* args[] = {&p};
    hipError_t e = hipLaunchCooperativeKernel((void*)mk_fwd, dim3(grid_blocks), dim3(512), args, LDS_BYTES, stream);
    if (e != hipSuccess) fprintf(stderr, "cooperative launch failed: %s (grid %d)\n", hipGetErrorString(e), grid_blocks);
}
```

```cpp
#include <hip/hip_runtime.h>
#include <hip/hip_cooperative_groups.h>
#include <cstdio>
#include <cstdint>
namespace cg = cooperative_groups;
namespace pg8 {
#define PG8_LAS __attribute__((address_space(3)))
typedef unsigned short bf16_t;
typedef short bf16x8 __attribute__((ext_vector_type(8)));
typedef float f32x4 __attribute__((ext_vector_type(4)));
typedef unsigned u32x4 __attribute__((ext_vector_type(4)));
constexpr int BM = 256, BK = 64, HALF = 128, HTB = HALF * BK * 2  , STAGE_BYTES = 8 * HTB, NXCD = 8, WGM = 8;

__host__ __device__ __forceinline__ int lds_byte(int r, int c) { const int st = (r >> 4) * 2 + (c >> 5), rr = r & 15, cc = c & 31, ob = rr * 64 + cc * 2; return st * 1024 + (ob ^ (((ob >> 9) & 1) << 5)); }
__host__ __device__ __forceinline__ void stage_rc(int b, int& R, int& C) { const int st = b / 1024, sb = b % 1024, swz = sb ^ (((sb >> 9) & 1) << 5); R = (st >> 1) * 16 + swz / 64; C = (st & 1) * 32 + (swz % 64) / 2; }
__host__ __device__ __forceinline__ int perm32(int rho) { const int n = rho >> 4, i = rho & 15; return 8 * (i >> 2) + 4 * n + (i & 3); }

struct Unit { int pm, pn; };
struct Gemm { const bf16_t* A; const bf16_t* Bt; int M, N, K; };

struct StaticOrder {
    int nM, nN, nwg, G, c;
    __host__ __device__ void init(int M, int N, int G_, int c_) { nM = M / BM; nN = N / BM; nwg = nM * nN; G = G_; c = c_; }
    __host__ __device__ bool next(int i, Unit& u) const {
        const long L = (long)i * G + c; if (L >= nwg) return false;
        int wgid = (int)L; { const int q = nwg / NXCD, r = nwg % NXCD, xcd = wgid % NXCD, off = wgid / NXCD; wgid = (xcd < r ? xcd * (q + 1) : r * (q + 1) + (xcd - r) * q) + off; }
        const int nig = WGM * nN, gid = wgid / nig, fm = gid * WGM, gsz = (nM - fm) < WGM ? (nM - fm) : WGM;
        u.pm = fm + ((wgid % nig) % gsz); u.pn = (wgid % nig) / gsz; return true;
    }
    __device__ __forceinline__ void a_ready(const Unit&) const {}
    __device__ __forceinline__ void done(const Unit&) const {}
};

__device__ __forceinline__ unsigned cvt_pk_bf16(float lo, float hi) { unsigned r; asm volatile("v_cvt_pk_bf16_f32 %0, %1, %2" : "=v"(r) : "v"(lo), "v"(hi)); return r; }
typedef float f32x2 __attribute__((ext_vector_type(2)));

__device__ __forceinline__ float sigm(float x) { return 1.0f / (1.0f + __expf(-x)); }
__device__ __forceinline__ float bf_lo(unsigned w) { return __uint_as_float(w << 16); }
__device__ __forceinline__ float bf_hi(unsigned w) { return __uint_as_float(w & 0xffff0000u); }
__device__ __forceinline__ u32x4 pack8(const f32x4& v0, const f32x4& v1) { u32x4 w; w.x = cvt_pk_bf16(v0[0], v0[1]); w.y = cvt_pk_bf16(v0[2], v0[3]); w.z = cvt_pk_bf16(v1[0], v1[1]); w.w = cvt_pk_bf16(v1[2], v1[3]); return w; }
__device__ __forceinline__ void unpack8(const u32x4& w, f32x4& v0, f32x4& v1) { v0[0] = bf_lo(w.x); v0[1] = bf_hi(w.x); v0[2] = bf_lo(w.y); v0[3] = bf_hi(w.y); v1[0] = bf_lo(w.z); v1[1] = bf_hi(w.z); v1[2] = bf_lo(w.w); v1[3] = bf_hi(w.w); }

#define PG8_EPI_WALK(...) \
    _Pragma("unroll") for (int ai = 0; ai < 2; ++ai) _Pragma("unroll") for (int m = 0; m < 4; ++m) { const int row = u.pm * BM + wr * 64 + fr + ai * HALF + m * 16; \
        _Pragma("unroll") for (int bj = 0; bj < 2; ++bj) { const int ct = wc * 64 + bj * 32 + 8 * fq; f32x4 v0 = acc[ai][bj][m][0], v1 = acc[ai][bj][m][1]; __VA_ARGS__ } }

__device__ __forceinline__ u32x4 xor8_16B(u32x4 v) { u32x4 r; r.x = (unsigned)__shfl_xor((int)v.x, 8); r.y = (unsigned)__shfl_xor((int)v.y, 8); r.z = (unsigned)__shfl_xor((int)v.z, 8); r.w = (unsigned)__shfl_xor((int)v.w, 8); return r; }
__device__ __forceinline__ u32x4 bperm_16B(int src_byte, u32x4 v) { u32x4 r; r.x = (unsigned)__builtin_amdgcn_ds_bpermute(src_byte, (int)v.x); r.y = (unsigned)__builtin_amdgcn_ds_bpermute(src_byte, (int)v.y); r.z = (unsigned)__builtin_amdgcn_ds_bpermute(src_byte, (int)v.z); r.w = (unsigned)__builtin_amdgcn_ds_bpermute(src_byte, (int)v.w); return r; }
__device__ __forceinline__ void store_rows_bf16(bf16_t* O, size_t ldc, int r0, int c0, int fr, int fq, u32x4 w0, u32x4 w1) {
    const bool h = fr & 8; const u32x4 recv = xor8_16B(h ? w0 : w1);
    const u32x4 d1 = h ? recv : w0, d2 = h ? w1 : recv;
    const int lane = fr + 16 * fq, src = ((lane >> 3) + 8 * ((lane >> 2) & 1) + 16 * (lane & 3)) * 4;
    const u32x4 e1 = bperm_16B(src, d1), e2 = bperm_16B(src, d2);
    bf16_t* p = O + (size_t)(r0 + (lane >> 3)) * ldc + c0 + 8 * (lane & 7);
    *(u32x4*)p = e1; *(u32x4*)(p + 8 * ldc) = e2;
}
struct EpiProj {
    static constexpr bool PERM = true, AFTER_DRAIN = false, MIDK = false;
    bf16_t *qkva, *qkm, *vm, *om, *g; float c2;
    __device__ __forceinline__ void operator()(const f32x4 (&acc)[2][2][4][2], const Unit& u, int wr, int wc, int fr, int fq) const {
        const int pn = u.pn; bf16_t* base; int ldc, colt, mode = 0; float sc = 1.f;
        if (pn < 6) { base = qkva; ldc = 1536; colt = pn * 256; if (pn < 2) sc = c2; }
        else if (pn < 10) { base = qkm; ldc = 1024; colt = (pn - 6) * 256; }
        else if (pn < 12) { base = vm; ldc = 512; colt = (pn - 10) * 256; }
        else if (pn < 14) { base = om; ldc = 512; colt = (pn - 12) * 256; mode = 1; }
        else { base = g; ldc = 2048; colt = (pn - 14) * 256; mode = 1; }
#pragma unroll
        for (int ai = 0; ai < 2; ++ai)
#pragma unroll
            for (int m = 0; m < 4; ++m) { u32x4 w[2];
#pragma unroll
                for (int bj = 0; bj < 2; ++bj) { f32x4 v0 = acc[ai][bj][m][0], v1 = acc[ai][bj][m][1];
                    if (mode == 1) { _Pragma("unroll") for (int i = 0; i < 4; ++i) { v0[i] = sigm(v0[i]); v1[i] = sigm(v1[i]); } }
                    else { v0 = v0 * sc; v1 = v1 * sc; }
                    w[bj] = pack8(v0, v1); }
                store_rows_bf16(base, (size_t)ldc, u.pm * BM + wr * 64 + ai * HALF + m * 16, colt + wc * 64, fr, fq, w[0], w[1]); }
    }
};
struct EpiStore {
    static constexpr bool PERM = true, AFTER_DRAIN = false, MIDK = false;
    bf16_t* O; int ldc;
    __device__ __forceinline__ void operator()(const f32x4 (&acc)[2][2][4][2], const Unit& u, int wr, int wc, int fr, int fq) const {
#pragma unroll
        for (int ai = 0; ai < 2; ++ai)
#pragma unroll
            for (int m = 0; m < 4; ++m) store_rows_bf16(O, (size_t)ldc, u.pm * BM + wr * 64 + ai * HALF + m * 16, u.pn * BM + wc * 64, fr, fq, pack8(acc[ai][0][m][0], acc[ai][0][m][1]), pack8(acc[ai][1][m][0], acc[ai][1][m][1]));
    }
};
template <bool ADD> struct EpiGated {
    static constexpr bool PERM = true, AFTER_DRAIN = false, MIDK = false;
    bf16_t* O; const bf16_t* prev; const bf16_t* gate; int gcol0;
    __device__ __forceinline__ void operator()(const f32x4 (&acc)[2][2][4][2], const Unit& u, int wr, int wc, int fr, int fq) const {
#pragma unroll
        for (int ai = 0; ai < 2; ++ai)
#pragma unroll
            for (int m = 0; m < 4; ++m) { const int row = u.pm * BM + wr * 64 + fr + ai * HALF + m * 16; u32x4 w[2];
#pragma unroll
                for (int bj = 0; bj < 2; ++bj) { const int col = u.pn * BM + wc * 64 + bj * 32 + 8 * fq; f32x4 v0 = acc[ai][bj][m][0], v1 = acc[ai][bj][m][1];
                    f32x4 g0, g1; unpack8(*(const u32x4*)(gate + (size_t)row * 2048 + gcol0 + col), g0, g1);
                    v0 = v0 * g0; v1 = v1 * g1;
                    if (ADD) { f32x4 p0, p1; unpack8(*(const u32x4*)(prev + (size_t)row * 1024 + col), p0, p1); v0 = v0 + p0; v1 = v1 + p1; }
                    w[bj] = pack8(v0, v1); }
                store_rows_bf16(O, 1024, u.pm * BM + wr * 64 + ai * HALF + m * 16, u.pn * BM + wc * 64, fr, fq, w[0], w[1]); }
    }
};
struct EpiMerged {
    static constexpr bool PERM = true, AFTER_DRAIN = false, MIDK = true;
    bf16_t* O; const bf16_t* gate;
    __device__ __forceinline__ void mid(f32x4 (&acc)[2][2][4][2], const Unit& u, int wr, int wc, int fr, int fq) const {
#pragma unroll
        for (int ai = 0; ai < 2; ++ai)
#pragma unroll
            for (int mp = 0; mp < 2; ++mp) {
                u32x4 ga[2][2], gm[2][2];
#pragma unroll
                for (int mm = 0; mm < 2; ++mm)
#pragma unroll
                    for (int bj = 0; bj < 2; ++bj) { const size_t o = (size_t)(u.pm * BM + wr * 64 + fr + ai * HALF + (2 * mp + mm) * 16) * 2048 + u.pn * BM + wc * 64 + bj * 32 + 8 * fq;
                        ga[mm][bj] = *(const u32x4*)(gate + o); gm[mm][bj] = *(const u32x4*)(gate + o + 1024); }
#pragma unroll
                for (int mm = 0; mm < 2; ++mm)
#pragma unroll
                    for (int bj = 0; bj < 2; ++bj) { f32x4 a0, a1, m0, m1; unpack8(ga[mm][bj], a0, a1); unpack8(gm[mm][bj], m0, m1);
#pragma unroll
                        for (int i = 0; i < 4; ++i) { acc[ai][bj][2 * mp + mm][0][i] *= a0[i] * __builtin_amdgcn_rcpf(m0[i]); acc[ai][bj][2 * mp + mm][1][i] *= a1[i] * __builtin_amdgcn_rcpf(m1[i]); } }
            }
    }
    __device__ __forceinline__ void operator()(const f32x4 (&acc)[2][2][4][2], const Unit& u, int wr, int wc, int fr, int fq) const {
#pragma unroll
        for (int ai = 0; ai < 2; ++ai)
#pragma unroll
            for (int mp = 0; mp < 2; ++mp) {
                u32x4 gm[2][2];
#pragma unroll
                for (int mm = 0; mm < 2; ++mm)
#pragma unroll
                    for (int bj = 0; bj < 2; ++bj) gm[mm][bj] = *(const u32x4*)(gate + (size_t)(u.pm * BM + wr * 64 + fr + ai * HALF + (2 * mp + mm) * 16) * 2048 + 1024 + u.pn * BM + wc * 64 + bj * 32 + 8 * fq);
#pragma unroll
                for (int mm = 0; mm < 2; ++mm) { const int m = 2 * mp + mm; u32x4 w[2];
#pragma unroll
                    for (int bj = 0; bj < 2; ++bj) { f32x4 m0, m1; unpack8(gm[mm][bj], m0, m1); w[bj] = pack8(acc[ai][bj][m][0] * m0, acc[ai][bj][m][1] * m1); }
                    store_rows_bf16(O, 1024, u.pm * BM + wr * 64 + ai * HALF + m * 16, u.pn * BM + wc * 64, fr, fq, w[0], w[1]); }
            }
    }
};
struct EpiResidual {
    static constexpr bool PERM = true, AFTER_DRAIN = false, MIDK = false;
    const float* res; float* out; bf16_t* xa; const float* gain; float* ssq;
    __device__ __forceinline__ void operator()(const f32x4 (&acc)[2][2][4][2], const Unit& u, int wr, int wc, int fr, int fq) const {
#pragma unroll
        for (int ai = 0; ai < 2; ++ai)
#pragma unroll
            for (int m = 0; m < 4; ++m) { const int row = u.pm * BM + wr * 64 + fr + ai * HALF + m * 16; float s = 0.f; u32x4 wx[2];
#pragma unroll
                for (int bj = 0; bj < 2; ++bj) { const int ct = wc * 64 + bj * 32 + 8 * fq; f32x4 v0 = acc[ai][bj][m][0], v1 = acc[ai][bj][m][1];
                    const size_t o = (size_t)row * 1024 + u.pn * BM + ct; const f32x4 r0 = *(const f32x4*)(res + o), r1 = *(const f32x4*)(res + o + 4);
                    v0 = v0 + r0; v1 = v1 + r1; *(f32x4*)(out + o) = v0; *(f32x4*)(out + o + 4) = v1;
                    s += (v0[0] * v0[0] + v0[1] * v0[1]) + (v0[2] * v0[2] + v0[3] * v0[3]) + (v1[0] * v1[0] + v1[1] * v1[1]) + (v1[2] * v1[2] + v1[3] * v1[3]);
                    const f32x4 g0 = *(const f32x4*)(gain + u.pn * BM + ct), g1 = *(const f32x4*)(gain + u.pn * BM + ct + 4);
                    wx[bj] = pack8(v0 * g0, v1 * g1); }
                store_rows_bf16(xa, 1024, u.pm * BM + wr * 64 + ai * HALF + m * 16, u.pn * BM + wc * 64, fr, fq, wx[0], wx[1]);
                s += __shfl_xor(s, 16); s += __shfl_xor(s, 32);
                if (fq == 0) atomicAdd(ssq + row, s);
                asm volatile("" ::: "memory"); }
    }
};
struct EpiPle {
    static constexpr bool PERM = true, AFTER_DRAIN = false, MIDK = false;
    float* xio; const bf16_t* e; const float* ssq;
    __device__ __forceinline__ void operator()(const f32x4 (&acc)[2][2][4][2], const Unit& u, int wr, int wc, int fr, int fq) const {
        const int row0 = u.pm * BM + wr * 64 + fr;
        float sq_next = ssq[row0];
#pragma unroll
        for (int ai = 0; ai < 2; ++ai)
#pragma unroll
            for (int m = 0; m < 4; ++m) { const int row = row0 + ai * HALF + m * 16; const float sq = sq_next;
                if (!(ai == 1 && m == 3)) sq_next = ssq[row0 + (m == 3 ? HALF : ai * HALF + (m + 1) * 16)];
                const float rstd = rsqrtf(sq * (1.0f / 1024.0f) + 1e-6f);
#pragma unroll
                for (int bj = 0; bj < 2; ++bj) { const int ct = wc * 64 + bj * 32 + 8 * fq; f32x4 v0 = acc[ai][bj][m][0] * rstd, v1 = acc[ai][bj][m][1] * rstd;
                    const size_t o = (size_t)row * 1024 + u.pn * BM + ct; f32x4 e0, e1; unpack8(*(const u32x4*)(e + o), e0, e1);
                    const f32x4 r0 = *(const f32x4*)(xio + o), r1 = *(const f32x4*)(xio + o + 4);
#pragma unroll
                    for (int i = 0; i < 4; ++i) { v0[i] = r0[i] + sigm(v0[i]) * e0[i]; v1[i] = r1[i] + sigm(v1[i]) * e1[i]; }
                    *(f32x4*)(xio + o) = v0; *(f32x4*)(xio + o + 4) = v1; } }
    }
};

template <class Epi, class Sched, bool ALIGN_EPI = false, bool SP2 = false>
__device__ __forceinline__ void gemm_phase(PG8_LAS unsigned char* lds, const Gemm g, const Sched& S, const Epi& E) {
    int tid_ = threadIdx.x; asm volatile("" : "+v"(tid_));
    const int tid = tid_, wid = __builtin_amdgcn_readfirstlane(tid >> 6), lane = tid & 63, wr = wid >> 2, wc = wid & 3, fr = lane & 15, fq = lane >> 4;
    int K_ = g.K; asm volatile("" : "+s"(K_));
    const int K = K_, nt = K / BK;
    unsigned voffA[2], voffB[2];
#pragma unroll
    for (int i = 0; i < 2; ++i) { int R, C; stage_rc(tid * 16 + i * 8192, R, C); const int Rb = Epi::PERM ? (2 * (R & ~31) + perm32(R & 31)) : R;
        voffA[i] = (unsigned)(R * K + C) * 2u; voffB[i] = (unsigned)(Rb * K + C) * 2u; }
    const size_t kstep = (size_t)(BK * 2);
    const size_t hstep = (size_t)HALF * K * 2;
    const size_t hstepB = Epi::PERM ? (size_t)32 * K * 2 : hstep;
    const size_t tstep = 2 * hstep;
    const unsigned ldsw = (unsigned)wid * 1024u;
    const int aoff = lds_byte(wr * 64 + fr, fq * 8), boff = lds_byte(wc * 32 + fr, fq * 8);
#define PG8_SA(b, h) (((b) * 2 + (h)) * HTB)
#define PG8_SB(b, h) ((4 + (b) * 2 + (h)) * HTB)
#define PG8_STAGE(bufoff, gbase, voff) do { _Pragma("unroll") for (int _i = 0; _i < 2; ++_i) \
        __builtin_amdgcn_global_load_lds((const unsigned*)((const char*)(gbase) + (voff)[_i]), (PG8_LAS unsigned*)(lds + (bufoff) + ldsw + _i * 8192), 16, 0, 0); } while (0)
#define PG8_LDA(dst, b, h) do { _Pragma("unroll") for (int m = 0; m < 4; ++m) _Pragma("unroll") for (int k = 0; k < 2; ++k) dst[m][k] = *(const PG8_LAS bf16x8*)(lds + PG8_SA(b, h) + aoff + m * 2048 + k * 1024); } while (0)
#define PG8_LDB(dst, b, h) do { _Pragma("unroll") for (int n = 0; n < 2; ++n) _Pragma("unroll") for (int k = 0; k < 2; ++k) dst[n][k] = *(const PG8_LAS bf16x8*)(lds + PG8_SB(b, h) + boff + n * 2048 + k * 1024); } while (0)
#define PG8_MMA(ai, bj, At, Bt) do { __builtin_amdgcn_s_setprio(1); _Pragma("unroll") for (int m = 0; m < 4; ++m) _Pragma("unroll") for (int n = 0; n < 2; ++n) _Pragma("unroll") for (int k = 0; k < 2; ++k) \
        acc[ai][bj][m][n] = __builtin_amdgcn_mfma_f32_16x16x32_bf16(Bt[n][k], At[m][k], acc[ai][bj][m][n], 0, 0, 0); __builtin_amdgcn_s_setprio(0); } while (0)
#define PG8_WAIT_V(n) asm volatile("s_waitcnt vmcnt(" #n ")" ::: "memory")
#define PG8_WAIT_L(n) asm volatile("s_waitcnt lgkmcnt(" #n ")" ::: "memory")
#define PG8_BAR __builtin_amdgcn_s_barrier()
#define PG8_SCHED __builtin_amdgcn_sched_barrier(0)
    Unit cur, nxt; int ui = 0;
    if (!S.next(0, cur)) return;
    f32x4 acc[2][2][4][2];
#pragma unroll
    for (int a = 0; a < 2; ++a)
#pragma unroll
        for (int b = 0; b < 2; ++b)
#pragma unroll
            for (int m = 0; m < 4; ++m)
#pragma unroll
                for (int n = 0; n < 2; ++n) acc[a][b][m][n] = (f32x4){0.f, 0.f, 0.f, 0.f};
    bf16x8 At[4][2], B0[2][2], B1[2][2];
    const char* cA = (const char*)g.A + (size_t)cur.pm * tstep; const char* cB = (const char*)g.Bt + (size_t)cur.pn * tstep;
    S.a_ready(cur);
    if constexpr (SP2) {
        PG8_STAGE(PG8_SB(0, 0), cB, voffB); PG8_STAGE(PG8_SB(0, 1), cB + hstepB, voffB); PG8_STAGE(PG8_SA(0, 0), cA, voffA); PG8_STAGE(PG8_SA(0, 1), cA + hstep, voffA);
        if (wr == 1) PG8_BAR;
        PG8_WAIT_V(2); PG8_BAR;
        PG8_STAGE(PG8_SB(1, 0), cB + kstep, voffB); PG8_STAGE(PG8_SA(1, 0), cA + kstep, voffA); PG8_STAGE(PG8_SB(1, 1), cB + hstepB + kstep, voffB);
        PG8_WAIT_V(6); PG8_BAR;
    } else {
        PG8_STAGE(PG8_SB(0, 0), cB, voffB); PG8_STAGE(PG8_SA(0, 0), cA, voffA); PG8_STAGE(PG8_SB(0, 1), cB + hstepB, voffB); PG8_STAGE(PG8_SA(0, 1), cA + hstep, voffA);
        if (wr == 1) PG8_BAR;
        PG8_WAIT_V(4); PG8_BAR;
        PG8_STAGE(PG8_SB(1, 0), cB + kstep, voffB); PG8_STAGE(PG8_SA(1, 0), cA + kstep, voffA); PG8_STAGE(PG8_SB(1, 1), cB + hstepB + kstep, voffB);
        PG8_WAIT_V(6); PG8_BAR;
    }
    for (;;) {
        const bool has_next = S.next(ui + 1, nxt);
        const char* nA = has_next ? (const char*)g.A + (size_t)nxt.pm * tstep : cA; const char* nB = has_next ? (const char*)g.Bt + (size_t)nxt.pn * tstep : cB;
        for (int t = 0; t < nt; t += 2) {
            if constexpr (Epi::MIDK) { if (t == (nt >> 1)) E.mid(acc, cur, wr, wc, fr, fq); }
            const bool last = (t == nt - 2);
            const char* a1 = cA + (size_t)(t + 1) * kstep;
            const char* a2 = last ? nA : cA + (size_t)(t + 2) * kstep; const char* b2 = last ? nB : cB + (size_t)(t + 2) * kstep;
            const char* a3 = a2 + kstep; const char* b3 = b2 + kstep;
            if (last && has_next) S.a_ready(nxt);
            if constexpr (SP2) {
            PG8_LDB(B0, 0, 0); PG8_LDB(B1, 0, 1); PG8_SCHED; PG8_LDA(At, 0, 0); PG8_STAGE(PG8_SA(1, 1), a1 + hstep, voffA);
            PG8_WAIT_V(8); PG8_WAIT_L(0); PG8_BAR; PG8_MMA(0, 0, At, B0); PG8_MMA(0, 1, At, B1); PG8_BAR; PG8_SCHED;
            PG8_LDA(At, 0, 1); PG8_STAGE(PG8_SB(0, 0), b2, voffB); PG8_STAGE(PG8_SB(0, 1), b2 + hstepB, voffB); PG8_STAGE(PG8_SA(0, 0), a2, voffA);
            PG8_WAIT_V(8); PG8_WAIT_L(0); PG8_BAR; PG8_MMA(1, 0, At, B0); PG8_MMA(1, 1, At, B1); PG8_BAR; PG8_SCHED;
            PG8_LDB(B0, 1, 0); PG8_LDB(B1, 1, 1); PG8_SCHED; PG8_LDA(At, 1, 0); PG8_STAGE(PG8_SA(0, 1), a2 + hstep, voffA);
            PG8_WAIT_V(8); PG8_WAIT_L(0); PG8_BAR; PG8_MMA(0, 0, At, B0); PG8_MMA(0, 1, At, B1); PG8_BAR; PG8_SCHED;
            PG8_LDA(At, 1, 1); PG8_STAGE(PG8_SB(1, 0), b3, voffB); PG8_STAGE(PG8_SB(1, 1), b3 + hstepB, voffB); PG8_STAGE(PG8_SA(1, 0), a3, voffA);
            PG8_WAIT_V(8); PG8_WAIT_L(0); PG8_BAR; PG8_MMA(1, 0, At, B0); PG8_MMA(1, 1, At, B1); PG8_BAR; PG8_SCHED;
            } else {
            PG8_LDB(B0, 0, 0); PG8_SCHED; PG8_LDA(At, 0, 0); PG8_STAGE(PG8_SA(1, 1), a1 + hstep, voffA);
            PG8_WAIT_L(8); PG8_BAR; PG8_WAIT_L(0); PG8_MMA(0, 0, At, B0); PG8_BAR; PG8_SCHED;
            PG8_LDB(B1, 0, 1); PG8_STAGE(PG8_SB(0, 0), b2, voffB);
            PG8_BAR; PG8_WAIT_L(0); PG8_MMA(0, 1, At, B1); PG8_BAR;
            PG8_LDA(At, 0, 1); PG8_STAGE(PG8_SA(0, 0), a2, voffA);
            PG8_BAR; PG8_WAIT_L(0); PG8_MMA(1, 0, At, B0); PG8_BAR; PG8_SCHED;
            PG8_STAGE(PG8_SB(0, 1), b2 + hstepB, voffB);
            PG8_WAIT_V(6); PG8_BAR; PG8_MMA(1, 1, At, B1); PG8_BAR;
            PG8_LDB(B0, 1, 0); PG8_SCHED; PG8_LDA(At, 1, 0); PG8_STAGE(PG8_SA(0, 1), a2 + hstep, voffA);
            PG8_WAIT_L(8); PG8_BAR; PG8_WAIT_L(0); PG8_MMA(0, 0, At, B0); PG8_BAR; PG8_SCHED;
            PG8_LDB(B1, 1, 1); PG8_STAGE(PG8_SB(1, 0), b3, voffB);
            PG8_BAR; PG8_WAIT_L(0); PG8_MMA(0, 1, At, B1); PG8_BAR;
            PG8_LDA(At, 1, 1); PG8_STAGE(PG8_SA(1, 0), a3, voffA);
            PG8_BAR; PG8_WAIT_L(0); PG8_MMA(1, 0, At, B0); PG8_BAR; PG8_SCHED;
            PG8_STAGE(PG8_SB(1, 1), b3 + hstepB, voffB);
            PG8_WAIT_V(6); PG8_BAR; PG8_MMA(1, 1, At, B1); PG8_BAR;
            }
        }
        if constexpr (ALIGN_EPI) { if (wr == 0) PG8_BAR; }
        if constexpr (!Epi::AFTER_DRAIN) { E(acc, cur, wr, wc, fr, fq); S.done(cur); }
        if (!has_next) break;
#pragma unroll
        for (int a = 0; a < 2; ++a)
#pragma unroll
            for (int b = 0; b < 2; ++b)
#pragma unroll
                for (int m = 0; m < 4; ++m)
#pragma unroll
                    for (int n = 0; n < 2; ++n) acc[a][b][m][n] = (f32x4){0.f, 0.f, 0.f, 0.f};
        cur = nxt; cA = nA; cB = nB; ++ui;
        if constexpr (ALIGN_EPI) { if (wr == 1) PG8_BAR; }
    }
    PG8_WAIT_V(0);
    if constexpr (!ALIGN_EPI) { if (wr == 0) PG8_BAR; }
    PG8_BAR;
    if constexpr (Epi::AFTER_DRAIN) { E.fused(acc, cur, wr, wc, fr, fq, lds, wid, lane); S.done(cur); }
#undef PG8_SA
#undef PG8_SB
#undef PG8_STAGE
#undef PG8_LDA
#undef PG8_LDB
#undef PG8_MMA
#undef PG8_WAIT_V
#undef PG8_WAIT_L
#undef PG8_BAR
#undef PG8_SCHED
}
}

#define GAS __attribute__((address_space(1)))
#define LAS __attribute__((address_space(3)))
typedef unsigned short bf16;
typedef unsigned v4u __attribute__((ext_vector_type(4)));
typedef unsigned v2u __attribute__((ext_vector_type(2)));
typedef float f32x4 __attribute__((ext_vector_type(4)));
using pg8::bf_lo; using pg8::bf_hi; using pg8::sigm;

constexpr int NTOK = 32768, SEQ = 16384, DM = 1024, NW = 8;
constexpr float EPS = 1e-6f;
constexpr float C2 = 0.125f * 1.4426950408889634f;
constexpr size_t MiB = 1u << 20;
constexpr size_t WS_W1T = 1 * MiB, WS_WAT = 12 * MiB, WS_WMT = 13 * MiB, WS_WOT = 14 * MiB, WS_WQT = 16 * MiB, WS_WGT = 20 * MiB, WS_WPT = 22 * MiB;
constexpr size_t WS_K1B = 22 * MiB + 512 * 1024, WS_K2B = 22 * MiB + 768 * 1024, WS_IF = 23 * MiB, WS_UB = 24 * MiB, WS_VB = 56 * MiB;
constexpr size_t WS_XN = 88 * MiB, WS_YA = 88 * MiB, WS_YM = 120 * MiB, WS_HN = 88 * MiB;
constexpr size_t WS_QKVA = 152 * MiB, WS_QKM = 248 * MiB, WS_VM = 312 * MiB, WS_OM = 344 * MiB, WS_G = 376 * MiB;
constexpr size_t WS_DN = 504 * MiB, WS_NS = 505 * MiB, WS_SC = 506 * MiB;
constexpr size_t WS_MERGED = 152 * MiB, WS_TMP = 216 * MiB, WS_Q2 = 376 * MiB, WS_IDX = 152 * MiB, WS_GATE = 168 * MiB, WS_HN2 = 184 * MiB, WS_PB = 56 * MiB, WS_E = 264 * MiB;
constexpr size_t WS_NEED = 507 * MiB;
constexpr size_t WS_U8 = 24 * MiB, WS_V8 = 40 * MiB, WS_PART = 376 * MiB, WS_SSQ = 506 * MiB + 512 * 1024;
constexpr size_t WS_U4 = 24 * MiB, WS_V4 = 32 * MiB, WS_SU = 40 * MiB, WS_SV = 40 * MiB + 65536;
constexpr size_t WS_SSQ1 = 506 * MiB + 768 * 1024, WS_BAR = 0, BAR_BYTES = 32768;
constexpr size_t OUT_DC = 0, OUT_CS = 64 * MiB;
constexpr int LDS_BYTES = 147456;

__device__ __forceinline__ unsigned f2bf(float f) { unsigned u = __float_as_uint(f); return (u + 0x7fffu + ((u >> 16) & 1u)) >> 16; }
__device__ __forceinline__ unsigned pk2(float lo, float hi) { return f2bf(lo) | (f2bf(hi) << 16); }
__device__ __forceinline__ float bf2f(bf16 b) { return __uint_as_float((unsigned)b << 16); }
__device__ __forceinline__ float wave_sum(float v) {
#pragma unroll
    for (int o = 1; o < 64; o <<= 1) v += __shfl_xor(v, o);
    return v;
}
__device__ __forceinline__ float wave_max(float v) {
#pragma unroll
    for (int o = 1; o < 64; o <<= 1) v = fmaxf(v, __shfl_xor(v, o));
    return v;
}
__device__ __forceinline__ void unpk8(const v4u w, float* f) { f[0] = bf_lo(w.x); f[1] = bf_hi(w.x); f[2] = bf_lo(w.y); f[3] = bf_hi(w.y); f[4] = bf_lo(w.z); f[5] = bf_hi(w.z); f[6] = bf_lo(w.w); f[7] = bf_hi(w.w); }
__device__ __forceinline__ v4u pk8(const float* f) { v4u w; w.x = pk2(f[0], f[1]); w.y = pk2(f[2], f[3]); w.z = pk2(f[4], f[5]); w.w = pk2(f[6], f[7]); return w; }
typedef __bf16 bf16x2_t __attribute__((ext_vector_type(2)));
__device__ __forceinline__ float dot2bf(unsigned a, unsigned b, float c) { return __builtin_amdgcn_fdot2_f32_bf16(__builtin_bit_cast(bf16x2_t, a), __builtin_bit_cast(bf16x2_t, b), c, false); }
__device__ __forceinline__ float logsigmoid(float x) { return fminf(x, 0.f) - log1pf(__expf(-fabsf(x))); }
__device__ __forceinline__ float silu(float x) { return x / (1.0f + __expf(-x)); }

#define XB_TMO      128
#define XB_XCNT(j)  (256  + 64 * (j))
#define XB_XSUB(j)  (1280 + 64 * (j))
#define XB_XGEN(j)  (2304 + 64 * (j))
#define XB_TOP      3328
#define XB_TOPGEN   3392
#define XCD_BAR_WORDS 3456
#define XB_SPIN_CAP (1u << 18)

__device__ __forceinline__ unsigned xb_ld(unsigned* p)              { return __hip_atomic_load(p, __ATOMIC_RELAXED, __HIP_MEMORY_SCOPE_AGENT); }
__device__ __forceinline__ unsigned xb_add(unsigned* p, unsigned v) { return __hip_atomic_fetch_add(p, v, __ATOMIC_RELAXED, __HIP_MEMORY_SCOPE_AGENT); }
__device__ __forceinline__ unsigned xb_xcc_id() { return (unsigned)__builtin_amdgcn_s_getreg((3 << 11) | 20) & 0xFu; }
#define XB_SPIN(cond, bar) do { unsigned _sp = 0; while (cond) { __builtin_amdgcn_s_sleep(1); \
    if ((++_sp & 255u) == 0u) { if (xb_ld(&(bar)[XB_TMO])) break; if (_sp > XB_SPIN_CAP) { atomicAdd(&(bar)[XB_TMO], 1u); break; } } } } while (0)

struct XcdBarrier {
    unsigned* bar; unsigned x;
    volatile LAS unsigned* st;
};

__device__ __forceinline__ XcdBarrier xcd_barrier_post(unsigned* bar, volatile LAS unsigned* st) {
    XcdBarrier b; b.bar = bar; b.x = xb_xcc_id(); b.st = st;
    if (threadIdx.x == 0) (void)xb_add(&bar[XB_XCNT(b.x)], 1u);
    return b;
}
__device__ __forceinline__ void xcd_barrier_complete(unsigned* bar, unsigned x, unsigned& nloc, unsigned& nx) {
    const unsigned G = gridDim.x * gridDim.y * gridDim.z;
    unsigned sum, cnt, mine, sp = 0u;
    for (;;) {
        sum = 0u; cnt = 0u; mine = 0u;
#pragma unroll
        for (unsigned j = 0; j < 16; ++j) { const unsigned c = xb_ld(&bar[XB_XCNT(j)]); sum += c; cnt += (c > 0u) ? 1u : 0u; mine = (j == x) ? c : mine; }
        if (sum == G) break;
        __builtin_amdgcn_s_sleep(1);
        if ((++sp & 255u) == 0u) { if (xb_ld(&bar[XB_TMO])) break; if (sp > XB_SPIN_CAP) { atomicAdd(&bar[XB_TMO], 1u); break; } }
    }
    nloc = mine > 0u ? mine : 1u; nx = cnt > 0u ? cnt : 1u;
}

__device__ __forceinline__ void xcd_barrier(const XcdBarrier& b) {
    asm volatile("s_waitcnt vmcnt(0)" ::: "memory");
    __syncthreads();
    if (threadIdx.x == 0) {
        unsigned* bar = b.bar;
        __builtin_amdgcn_s_waitcnt(0);
        unsigned nloc = b.st[0], nx = b.st[1];
        if (nloc == 0u) { xcd_barrier_complete(bar, b.x, nloc, nx); b.st[0] = nloc; b.st[1] = nx; }
        const unsigned old = xb_add(&bar[XB_XSUB(b.x)], 1u);
        const unsigned gen = old / nloc;
        if (old + 1u == (gen + 1u) * nloc) {
            __builtin_amdgcn_fence(__ATOMIC_RELEASE, "agent");
            asm volatile("s_waitcnt vmcnt(0)" ::: "memory");
            const unsigned og = xb_add(&bar[XB_TOP], 1u);
            const unsigned tg = og / nx;
            if (og + 1u == (tg + 1u) * nx) xb_add(&bar[XB_TOPGEN], 1u);
            else XB_SPIN(xb_ld(&bar[XB_TOPGEN]) == tg, bar);
            __builtin_amdgcn_fence(__ATOMIC_ACQUIRE, "agent");
            xb_add(&bar[XB_XGEN(b.x)], 1u);
            asm volatile("s_waitcnt vmcnt(0)" ::: "memory");
        } else {
            XB_SPIN(xb_ld(&bar[XB_XGEN(b.x)]) == gen, bar);
            __builtin_amdgcn_fence(__ATOMIC_ACQUIRE, "agent");
            asm volatile("s_waitcnt vmcnt(0)" ::: "memory");
        }
    }
    __syncthreads();
}


struct Params { const float* in[20]; float* out; unsigned char* ws; int ph_lo, ph_hi; };

__device__ __forceinline__ void transpose_item(const float* W, int ldw, int col0, int K, bf16* WT, int row0, LAS float* scr, int item, int nblk, int lane, int koff = 0) {
    const int kb = item / nblk, nb = item % nblk, k0 = 64 * kb, n0 = 32 * nb;
#pragma unroll 8
    for (int i = 0; i < 32; ++i) { const int kk = 2 * i + (lane >> 5); scr[kk * 33 + (lane & 31)] = W[(size_t)(k0 + kk) * ldw + col0 + n0 + (lane & 31)]; }
    asm volatile("s_waitcnt lgkmcnt(0)" ::: "memory");
    const int c = lane & 7;
#pragma unroll
    for (int j = 0; j < 4; ++j) { const int n = (lane >> 3) + 8 * j; const LAS float* s = scr + (8 * c) * 33 + n;
        v4u o; o.x = pk2(s[0 * 33], s[1 * 33]); o.y = pk2(s[2 * 33], s[3 * 33]); o.z = pk2(s[4 * 33], s[5 * 33]); o.w = pk2(s[6 * 33], s[7 * 33]);
        *(v4u*)(WT + (size_t)(row0 + n0 + n) * K + koff + k0 + 8 * c) = o; }
    asm volatile("s_waitcnt lgkmcnt(0)" ::: "memory");
}
__device__ __forceinline__ void cvt_f32_bf16(const float* src, bf16* dst, size_t n4, size_t gtid, size_t gsz) {
    for (size_t i = gtid; i < n4; i += gsz) { const f32x4 v = ((const f32x4*)src)[i]; uint2 o; o.x = pk2(v[0], v[1]); o.y = pk2(v[2], v[3]); ((uint2*)dst)[i] = o; }
}
__device__ __forceinline__ void cvt_f32_fp8(const float* src, unsigned* dst, size_t n4, float sc, size_t gtid, size_t gsz) {
    for (size_t i = gtid; i < n4; i += gsz) { const f32x4 v = ((const f32x4*)src)[i]; int w = __builtin_amdgcn_cvt_pk_fp8_f32(v[0] * sc, v[1] * sc, 0, false); w = __builtin_amdgcn_cvt_pk_fp8_f32(v[2] * sc, v[3] * sc, w, true); dst[i] = (unsigned)w; }
}
__device__ __forceinline__ void rms_row_to_bf16(const float* xrow, const float* gain, bf16* orow, int lane) {
    f32x4 v[4]; float s = 0.f;
#pragma unroll
    for (int j = 0; j < 4; ++j) { v[j] = ((const f32x4*)xrow)[lane + 64 * j]; s += (v[j][0] * v[j][0] + v[j][1] * v[j][1]) + (v[j][2] * v[j][2] + v[j][3] * v[j][3]); }
    const float rstd = rsqrtf(wave_sum(s) * (1.f / 1024.f) + EPS);
#pragma unroll
    for (int j = 0; j < 4; ++j) { const f32x4 g = ((const f32x4*)gain)[lane + 64 * j]; uint2 o; o.x = pk2(v[j][0] * rstd * g[0], v[j][1] * rstd * g[1]); o.y = pk2(v[j][2] * rstd * g[2], v[j][3] * rstd * g[3]); ((uint2*)orow)[lane + 64 * j] = o; }
}
__device__ __forceinline__ void p0_prologue(const Params& P, LAS unsigned char* lds, int tid, int lane, int wave) {
    unsigned char* ws = P.ws;
    const int gw = blockIdx.x * NW + wave, NGW = gridDim.x * NW;
    LAS float* scr = (LAS float*)(lds + wave * 8448);
    LAS float* wif = (LAS float*)(lds + 69632);
    const float* w_in = P.in[3];
    for (int i = tid; i < 8192; i += 512) wif[i] = w_in[(size_t)(i >> 3) * 5640 + 3584 + (i & 7)];
    __syncthreads();
    constexpr int I1A = 16 * 112, I1B = 16 * 64, IUP = 8 * 32, IOUT = 16 * 32, IQ = 16 * 64, IPL = 4 * 32;
    constexpr int NITEMS = I1A + I1B + 2 * IUP + IOUT + IQ + IOUT + IPL;
    for (int it = gw; it < NITEMS; it += NGW) {
        int r = it;
        if (r < I1A) { transpose_item(w_in, 5640, 0, 1024, (bf16*)(ws + WS_W1T), 0, scr, r, 112, lane); continue; } r -= I1A;
        if (r < I1B) { transpose_item(w_in, 5640, 3592, 1024, (bf16*)(ws + WS_W1T), 3584, scr, r, 64, lane); continue; } r -= I1B;
        if (r < IUP) { transpose_item(P.in[7], 1024, 0, 1024, (bf16*)(ws + WS_WAT), 0, scr, r, 32, lane, 0); continue; } r -= IUP;
        if (r < IUP) { transpose_item(P.in[8], 1024, 0, 1024, (bf16*)(ws + WS_WAT), 0, scr, r, 32, lane, 512); continue; } r -= IUP;
        if (r < IOUT) { transpose_item(P.in[9], 1024, 0, 1024, (bf16*)(ws + WS_WOT), 0, scr, r, 32, lane); continue; } r -= IOUT;
        if (r < IQ) { transpose_item(P.in[11], 2048, 0, 1024, (bf16*)(ws + WS_WQT), 0, scr, r, 64, lane); continue; } r -= IQ;
        if (r < IOUT) { transpose_item(P.in[17], 1024, 0, 1024, (bf16*)(ws + WS_WGT), 0, scr, r, 32, lane); continue; } r -= IOUT;
        transpose_item(P.in[18], 1024, 0, 256, (bf16*)(ws + WS_WPT), 0, scr, r, 32, lane);
    }
    const size_t gtid = (size_t)blockIdx.x * 512 + tid, gsz = (size_t)gridDim.x * 512;
    cvt_f32_bf16(P.in[12], (bf16*)(ws + WS_K1B), 8 * 128 * 128 / 4, gtid, gsz);
    cvt_f32_bf16(P.in[13], (bf16*)(ws + WS_K2B), 8 * 128 * 128 / 4, gtid, gsz);
    for (int rw = gw; rw < 2 * 16384; rw += NGW) {
        const int tb_ = rw >> 14, e = rw & 16383; const float* src = P.in[14 + tb_] + (size_t)e * 1024;
        f32x4 v[4]; v[0] = ((const f32x4*)src)[2 * lane]; v[1] = ((const f32x4*)src)[2 * lane + 1]; v[2] = ((const f32x4*)src)[128 + 2 * lane]; v[3] = ((const f32x4*)src)[128 + 2 * lane + 1];
        float mx = 0.f;
#pragma unroll
        for (int j = 0; j < 4; ++j)
#pragma unroll
            for (int i = 0; i < 4; ++i) mx = fmaxf(mx, fabsf(v[j][i]));
        mx = wave_max(mx);
        const float sc = mx > 0.f ? mx * (1.0f / 6.0f) : 1.0f, inv = 1.0f / sc;
        unsigned w0 = 0u, w1 = 0u;
        w0 = __builtin_amdgcn_cvt_scalef32_pk_fp4_f32(w0, v[0][0] * inv, v[0][1] * inv, 1.0f, 0); w0 = __builtin_amdgcn_cvt_scalef32_pk_fp4_f32(w0, v[0][2] * inv, v[0][3] * inv, 1.0f, 1);
        w0 = __builtin_amdgcn_cvt_scalef32_pk_fp4_f32(w0, v[1][0] * inv, v[1][1] * inv, 1.0f, 2); w0 = __builtin_amdgcn_cvt_scalef32_pk_fp4_f32(w0, v[1][2] * inv, v[1][3] * inv, 1.0f, 3);
        w1 = __builtin_amdgcn_cvt_scalef32_pk_fp4_f32(w1, v[2][0] * inv, v[2][1] * inv, 1.0f, 0); w1 = __builtin_amdgcn_cvt_scalef32_pk_fp4_f32(w1, v[2][2] * inv, v[2][3] * inv, 1.0f, 1);
        w1 = __builtin_amdgcn_cvt_scalef32_pk_fp4_f32(w1, v[3][0] * inv, v[3][1] * inv, 1.0f, 2); w1 = __builtin_amdgcn_cvt_scalef32_pk_fp4_f32(w1, v[3][2] * inv, v[3][3] * inv, 1.0f, 3);
        unsigned* dst = (unsigned*)(ws + (tb_ ? WS_V4 : WS_U4)) + (size_t)e * 128;
        dst[lane] = w0; dst[64 + lane] = w1;
        if (lane == 0) ((float*)(ws + (tb_ ? WS_SV : WS_SU)))[e] = sc;
    }
    cvt_f32_bf16(P.in[1], (bf16*)(ws + WS_PB), (size_t)NTOK * 256 / 4, gtid, gsz);
    for (size_t i = gtid; i < (size_t)NTOK; i += gsz) { ((float*)(ws + WS_SSQ))[i] = 0.f; ((float*)(ws + WS_SSQ1))[i] = 0.f; }
    const float* x = P.in[0]; const float* gmix = P.in[2]; const float* gbias = P.in[5];
    bf16* XN = (bf16*)(ws + WS_XN); float* IFb = (float*)(ws + WS_IF);
    for (int m = gw; m < NTOK; m += NGW) {
        const float* xrow = x + (size_t)m * 1024;
        f32x4 v[4];
#pragma unroll
        for (int j = 0; j < 4; ++j) v[j] = ((const f32x4*)xrow)[lane + 64 * j];
        float a16[16];
#pragma unroll
        for (int i = 0; i < 16; ++i) a16[i] = 0.f;
#pragma unroll
        for (int j = 0; j < 4; ++j) {
            const f32x4 g = ((const f32x4*)gmix)[lane + 64 * j];
#pragma unroll
            for (int i = 0; i < 4; ++i) { a16[0] += v[j][i] * v[j][i]; v[j][i] *= g[i]; const int d = 4 * (lane + 64 * j) + i; const f32x4 wa = *(const LAS f32x4*)(wif + d * 8), wb = *(const LAS f32x4*)(wif + d * 8 + 4);
                a16[1] += v[j][i] * wa[0]; a16[2] += v[j][i] * wa[1]; a16[3] += v[j][i] * wa[2]; a16[4] += v[j][i] * wa[3]; a16[5] += v[j][i] * wb[0]; a16[6] += v[j][i] * wb[1]; a16[7] += v[j][i] * wb[2]; a16[8] += v[j][i] * wb[3]; }
        }
        float r8[8], r4[4], r2[2], r1;
        { const bool b = lane & 32;
#pragma unroll
          for (int i = 0; i < 8; ++i) { const float keep = b ? a16[8 + i] : a16[i], send = b ? a16[i] : a16[8 + i]; r8[i] = keep + __shfl_xor(send, 32); } }
        { const bool b = lane & 16;
#pragma unroll
          for (int i = 0; i < 4; ++i) { const float keep = b ? r8[4 + i] : r8[i], send = b ? r8[i] : r8[4 + i]; r4[i] = keep + __shfl_xor(send, 16); } }
        { const bool b = lane & 8;
#pragma unroll
          for (int i = 0; i < 2; ++i) { const float keep = b ? r4[2 + i] : r4[i], send = b ? r4[i] : r4[2 + i]; r2[i] = keep + __shfl_xor(send, 8); } }
        { const bool b = lane & 4; const float keep = b ? r2[1] : r2[0], send = b ? r2[0] : r2[1]; r1 = keep + __shfl_xor(send, 4); }
        r1 += __shfl_xor(r1, 2); r1 += __shfl_xor(r1, 1);
        const float rstd = rsqrtf(__shfl(r1, 0) * (1.f / 1024.f) + EPS);
#pragma unroll
        for (int j = 0; j < 4; ++j) { uint2 o; o.x = pk2(v[j][0] * rstd, v[j][1] * rstd); o.y = pk2(v[j][2] * rstd, v[j][3] * rstd); ((uint2*)(XN + (size_t)m * 1024))[lane + 64 * j] = o; }
        const int which = ((lane >> 5) & 1) * 8 + ((lane >> 4) & 1) * 4 + ((lane >> 3) & 1) * 2 + ((lane >> 2) & 1);
        if ((lane & 3) == 0 && which >= 1 && which <= 8) IFb[(size_t)m * 8 + which - 1] = r1 * rstd + gbias[which - 1];
    }
}

typedef short bf16x8 __attribute__((ext_vector_type(8)));
typedef short v4i16 __attribute__((ext_vector_type(4)));
#define MFMA16(a, b, c) __builtin_amdgcn_mfma_f32_16x16x32_bf16((a), (b), (c), 0, 0, 0)
__device__ __forceinline__ void attn_pair_params(int pp, int& d, int& n0, int& sh) {
    if (pp < 5) { d = 16; sh = 4; n0 = -144 + 32 * pp; } else if (pp < 11) { d = 4; sh = 2; n0 = -128 + 32 * (pp - 5); } else { d = 1; sh = 0; n0 = -128 + 32 * (pp - 11); }
}
#define ATT_LOAD(SET, PPX) do { int d_, n_, sh_; attn_pair_params((PPX) < 23 ? (PPX) : 22, d_, n_, sh_); \
    _Pragma("unroll") for (int c = 0; c < 4; ++c) { int tok = t0 + d_ * (n_ + 8 * c + lrow); tok = min(max(tok, 0), SEQ - 1); const bf16* rp = base + 512 + (size_t)tok * 1536 + 8 * lch; \
        kr[SET][c] = *(const v4u*)rp; vr[SET][c] = *(const v4u*)(rp + 512); } } while (0)
__device__ __forceinline__ void p2_attention(const Params& P, LAS unsigned char* lds, int lane, int wave, int vb) {
    const bf16* QKVA = (const bf16*)(P.ws + WS_QKVA); bf16* YA = (bf16*)(P.ws + WS_YA);
    LAS unsigned char* kbuf = lds + wave * 9728;
    LAS unsigned char* vbuf = kbuf + 4608;
    const int r = lane & 15, g = lane >> 4, lrow = lane >> 3, lch = lane & 7;
    const int trq = (lane >> 2) & 3, trp = lane & 3;
    const int tr_off = (4 * g + trq) * 160 + trp * 8;
    for (int wi = vb; wi < 1024; wi += gridDim.x) {
        const int bh = wi >> 6, tb = wi & 63, b = bh >> 3, h = bh & 7;
        const bf16* base = QKVA + (size_t)b * SEQ * 1536 + h * 64;
#pragma unroll 1
        for (int uu = 0; uu < 2; ++uu) {
            const int t0 = tb * 256 + wave * 2 + uu, tq = t0 + 16 * r;
            const bf16x8 qb0 = *(const bf16x8*)(base + (size_t)tq * 1536 + 8 * g), qb1 = *(const bf16x8*)(base + (size_t)tq * 1536 + 32 + 8 * g);
            f32x4 o[4];
#pragma unroll
            for (int i = 0; i < 4; ++i) o[i] = (f32x4){0.f, 0.f, 0.f, 0.f};
            float m = -1e30f, l = 0.f;
            v4u kr[4][4], vr[4][4];
            ATT_LOAD(0, 0); ATT_LOAD(1, 1); ATT_LOAD(2, 2); ATT_LOAD(3, 3);
#pragma unroll 1
            for (int pp0 = 0; pp0 < 24; pp0 += 4) {
#pragma unroll
                for (int u = 0; u < 4; ++u) {
                    const int pp = pp0 + u;
                    int d, n0, sh; attn_pair_params(pp < 23 ? pp : 22, d, n0, sh);
                    if (pp >= 23) n0 = 1 << 20;
                    const int hi = r << (4 - sh), lo = max(hi - 128, -(t0 >> sh));
                    const int mbase = n0 + 4 * g - lo; const unsigned mspan = (unsigned)(hi - lo);
#pragma unroll
                    for (int c = 0; c < 4; ++c) { *(LAS v4u*)(kbuf + (8 * c + lrow) * 144 + lch * 16) = kr[u][c]; *(LAS v4u*)(vbuf + (8 * c + lrow) * 160 + lch * 16) = vr[u][c]; }
                    ATT_LOAD(u, pp + 4);
                    f32x4 s0 = {0.f, 0.f, 0.f, 0.f}, s1 = {0.f, 0.f, 0.f, 0.f};
                    { const bf16x8 k00 = *(const LAS bf16x8*)(kbuf + r * 144 + g * 16), k01 = *(const LAS bf16x8*)(kbuf + r * 144 + 64 + g * 16);
                      const bf16x8 k10 = *(const LAS bf16x8*)(kbuf + (16 + r) * 144 + g * 16), k11 = *(const LAS bf16x8*)(kbuf + (16 + r) * 144 + 64 + g * 16);
                      s0 = MFMA16(k00, qb0, s0); s0 = MFMA16(k01, qb1, s0); s1 = MFMA16(k10, qb0, s1); s1 = MFMA16(k11, qb1, s1); }
                    float mx = -INFINITY;
#pragma unroll
                    for (int k = 0; k < 4; ++k) { s0[k] = ((unsigned)(mbase + k) <= mspan) ? s0[k] : -INFINITY; s1[k] = ((unsigned)(mbase + 16 + k) <= mspan) ? s1[k] : -INFINITY; mx = fmaxf(mx, fmaxf(s0[k], s1[k])); }
                    mx = fmaxf(mx, __shfl_xor(mx, 16)); mx = fmaxf(mx, __shfl_xor(mx, 32));
                    if (__any(mx > m)) {
                        const float mn = fmaxf(m, mx), alpha = __builtin_amdgcn_exp2f(m - mn); m = mn; l *= alpha;
#pragma unroll
                        for (int i = 0; i < 4; ++i) o[i] = o[i] * alpha;
                    }
                    float p0[4], p1[4], ps = 0.f;
#pragma unroll
                    for (int k = 0; k < 4; ++k) { p0[k] = __builtin_amdgcn_exp2f(s0[k] - m); p1[k] = __builtin_amdgcn_exp2f(s1[k] - m); ps += p0[k] + p1[k]; }
                    l += ps;
                    bf16x8 pb; { v4u w; w.x = pg8::cvt_pk_bf16(p0[0], p0[1]); w.y = pg8::cvt_pk_bf16(p0[2], p0[3]); w.z = pg8::cvt_pk_bf16(p1[0], p1[1]); w.w = pg8::cvt_pk_bf16(p1[2], p1[3]); pb = __builtin_bit_cast(bf16x8, w); }
                    LAS unsigned char* vrd = vbuf + tr_off;
#pragma unroll
                    for (int db = 0; db < 4; ++db) {
                        const v4i16 a0 = __builtin_amdgcn_ds_read_tr16_b64_v4i16((LAS v4i16*)(vrd + db * 32)), a1 = __builtin_amdgcn_ds_read_tr16_b64_v4i16((LAS v4i16*)(vrd + 16 * 160 + db * 32));
                        const bf16x8 va = __builtin_shufflevector(a0, a1, 0, 1, 2, 3, 4, 5, 6, 7);
                        o[db] = MFMA16(va, pb, o[db]);
                    }
                }
            }
            l += __shfl_xor(l, 16); l += __shfl_xor(l, 32);
            const float inv = 1.0f / l;
            bf16* yo = YA + ((size_t)b * SEQ + tq) * 1024 + h * 64 + 4 * g;
#pragma unroll
            for (int db = 0; db < 4; ++db) { uint2 w; w.x = pk2(o[db][0] * inv, o[db][1] * inv); w.y = pk2(o[db][2] * inv, o[db][3] * inv); *(uint2*)(yo + 16 * db) = w; }
        }
    }
}

__device__ __forceinline__ float conv_silu(const bf16* QKM, const float* cw, int b, int t, int ch) {
    float a = 0.f;
#pragma unroll
    for (int j = 0; j < 4; ++j) { const int tt = t - 3 + j; if (tt >= 0) a += cw[j * 1024 + ch] * bf2f(QKM[((size_t)b * SEQ + tt) * 1024 + ch]); }
    return silu(a);
}

__device__ __forceinline__ float scan_add(float v, int lane) {
#pragma unroll
    for (int o = 1; o < 64; o <<= 1) { const float u = __shfl_up(v, o); if (lane >= o) v += u; }
    return v;
}
__device__ __forceinline__ float scan_max(float v, int lane) {
#pragma unroll
    for (int o = 1; o < 64; o <<= 1) { const float u = __shfl_up(v, o); if (lane >= o) v = fmaxf(v, u); }
    return v;
}
__device__ __forceinline__ void conv16(const bf16* QKM, const float* cw, int b, int t0, int chan, float* out) {
    const bf16* src = QKM + (size_t)b * SEQ * 1024 + chan;
    const float w0 = cw[chan], w1 = cw[1024 + chan], w2 = cw[2048 + chan], w3 = cw[3072 + chan];
    float x0 = t0 >= 3 ? bf2f(src[(size_t)(t0 - 3) * 1024]) : 0.f, x1 = t0 >= 2 ? bf2f(src[(size_t)(t0 - 2) * 1024]) : 0.f, x2 = t0 >= 1 ? bf2f(src[(size_t)(t0 - 1) * 1024]) : 0.f;
#pragma unroll
    for (int i = 0; i < 16; ++i) { const float x3 = bf2f(src[(size_t)(t0 + i) * 1024]); out[i] = silu(w0 * x0 + w1 * x1 + w2 * x2 + w3 * x3); x0 = x1; x1 = x2; x2 = x3; }
}

__device__ __forceinline__ void p2_mlstm_local(const Params& P, LAS unsigned char* lds, int tid, int lane, int wave, int vb) {
    const bf16* QKM = (const bf16*)(P.ws + WS_QKM); const bf16* VM = (const bf16*)(P.ws + WS_VM); const float* IFb = (const float*)(P.ws + WS_IF);
    const float* cw = P.in[4];
    bf16* DC = (bf16*)((unsigned char*)P.out + OUT_DC); float* DN = (float*)(P.ws + WS_DN); float* SC = (float*)(P.ws + WS_SC);
    LAS bf16* KWT = (LAS bf16*)lds; LAS bf16* VT = (LAS bf16*)(lds + 18432); LAS float* sw = (LAS float*)(lds + 36864);
    const int r = lane & 15, g = lane >> 4;
    for (int item = vb; item < 2048; item += gridDim.x) {
        const int bh = item >> 8, c = item & 255, b = bh >> 2, h = bh & 3;
        if (wave == 0) {
            const size_t row = (size_t)b * SEQ + c * 64 + lane;
            const float lf = logsigmoid(IFb[row * 8 + 4 + h]), ip = IFb[row * 8 + h];
            const float bc = scan_add(lf, lane), gg = __shfl(bc, 63), ds = gg - bc + ip, ml = wave_max(ds);
            sw[lane] = __expf(ds - ml);
            if (lane == 0) { SC[item] = ml; SC[2048 + item] = gg; }
        }
        __syncthreads();
        { const int ch = tid & 127, sq = tid >> 7, s0 = sq * 16; float o[16];
          conv16(QKM, cw, b, c * 64 + s0, 512 + h * 128 + ch, o);
#pragma unroll
          for (int i = 0; i < 16; i += 2) *(LAS unsigned*)(KWT + ch * 72 + s0 + i) = pk2(o[i] * 0.08838834764831845f * sw[s0 + i], o[i + 1] * 0.08838834764831845f * sw[s0 + i + 1]);
          const bf16* vsrc = VM + ((size_t)b * SEQ + c * 64 + s0) * 512 + h * 128 + ch;
#pragma unroll
          for (int i = 0; i < 16; i += 2) *(LAS unsigned*)(VT + ch * 72 + s0 + i) = (unsigned)vsrc[(size_t)i * 512] | ((unsigned)vsrc[(size_t)(i + 1) * 512] << 16);
        }
        __syncthreads();
        {
          const bf16x8 vb0 = *(const LAS bf16x8*)(VT + (16 * wave + r) * 72 + 8 * g), vb1 = *(const LAS bf16x8*)(VT + (16 * wave + r) * 72 + 32 + 8 * g);
          bf16* dst = DC + (size_t)item * 16384 + (size_t)(16 * wave + r) * 128 + 4 * g;
#pragma unroll
          for (int eb = 0; eb < 8; ++eb) {
              const bf16x8 ka0 = *(const LAS bf16x8*)(KWT + (16 * eb + r) * 72 + 8 * g), ka1 = *(const LAS bf16x8*)(KWT + (16 * eb + r) * 72 + 32 + 8 * g);
              f32x4 acc = {0.f, 0.f, 0.f, 0.f};
              acc = MFMA16(ka0, vb0, acc); acc = MFMA16(ka1, vb1, acc);
              uint2 o; o.x = pk2(acc[0], acc[1]); o.y = pk2(acc[2], acc[3]); *(uint2*)(dst + 16 * eb) = o;
          }
        }
        if (tid < 128) { float a = 0.f;
#pragma unroll
            for (int cc = 0; cc < 8; ++cc) { float f[8]; unpk8(*(const LAS v4u*)(KWT + tid * 72 + 8 * cc), f);
#pragma unroll
                for (int k = 0; k < 8; ++k) a += f[k]; }
            DN[(size_t)item * 128 + tid] = a; }
        __syncthreads();
    }
}

__device__ __forceinline__ void p3_mlstm_scan(const Params& P, int tid, int vb) {
    const unsigned* __restrict__ DC = (const unsigned*)((unsigned char*)P.out + OUT_DC); unsigned* __restrict__ CS = (unsigned*)((unsigned char*)P.out + OUT_CS);
    const float* __restrict__ DN = (const float*)(P.ws + WS_DN); float* __restrict__ NS = (float*)(P.ws + WS_NS); float* SC = (float*)(P.ws + WS_SC);
    for (int gid = vb * 512 + tid; gid < 8 * 8192; gid += gridDim.x * 512) {
        const int bh = gid >> 13, idx = gid & 8191; const bool hasn = idx < 64;
        float C0 = 0.f, C1 = 0.f, n0 = 0.f, n1 = 0.f, m = 0.f;
        for (int j0 = 0; j0 < 256; j0 += 8) {
            unsigned d[8]; float ml[8], gg[8]; float2 dn[8];
#pragma unroll
            for (int u = 0; u < 8; ++u) { const int item = bh * 256 + j0 + u; d[u] = DC[(size_t)item * 8192 + idx]; ml[u] = SC[item]; gg[u] = SC[2048 + item];
                dn[u] = hasn ? *(const float2*)(DN + (size_t)item * 128 + 2 * idx) : make_float2(0.f, 0.f); }
#pragma unroll
            for (int u = 0; u < 8; ++u) { const int item = bh * 256 + j0 + u;
                CS[(size_t)item * 8192 + idx] = pk2(C0, C1);
                if (hasn) *(float2*)(NS + (size_t)item * 128 + 2 * idx) = make_float2(n0, n1);
                if (idx == 0) SC[4096 + item] = m;
                const float mn = fmaxf(gg[u] + m, ml[u]), a = __expf(gg[u] + m - mn), bb = __expf(ml[u] - mn);
                C0 = a * C0 + bb * bf_lo(d[u]); C1 = a * C1 + bb * bf_hi(d[u]); n0 = a * n0 + bb * dn[u].x; n1 = a * n1 + bb * dn[u].y; m = mn; }
        }
    }
}

struct P4Pref { v4u raw[7]; v4u cs[4]; uint2 om[4]; f32x4 gn; float ifa, ifb, nsv; };
__device__ __forceinline__ void p4_prefetch_raw(P4Pref& pf, const Params& P, int item, int tid, int lane) {
    const bf16* QKM = (const bf16*)(P.ws + WS_QKM); const bf16* VM = (const bf16*)(P.ws + WS_VM); const float* IFb = (const float*)(P.ws + WS_IF); const float* NS = (const float*)(P.ws + WS_NS);
    const int bh = item >> 8, c = item & 255, b = bh >> 2, h = bh & 3;
#pragma unroll
    for (int i = 0; i < 7; ++i) { const int v = tid + 512 * i; const int rr = v / 48, rem = v - rr * 48, seg = rem >> 4, c16 = rem & 15; const int t = c * 64 + rr - 3;
        v4u val = {0u, 0u, 0u, 0u};
        if (v < 3216 && t >= 0) val = (seg < 2) ? *(const v4u*)(QKM + ((size_t)b * SEQ + t) * 1024 + seg * 512 + h * 128 + 8 * c16) : *(const v4u*)(VM + ((size_t)b * SEQ + t) * 512 + h * 128 + 8 * c16);
        pf.raw[i] = val; }
    const size_t row = (size_t)b * SEQ + c * 64 + lane;
    pf.ifa = IFb[row * 8 + 4 + h]; pf.ifb = IFb[row * 8 + h];
    pf.nsv = NS[(size_t)item * 128 + (tid & 127)];
}
__device__ __forceinline__ void p4_prefetch_cs(P4Pref& pf, const Params& P, int item, int lane, int wave) {
    const bf16* CS = (const bf16*)((unsigned char*)P.out + OUT_CS);
    const bf16* crow = CS + (size_t)item * 16384 + (size_t)(16 * wave + (lane & 15)) * 128 + 8 * (lane >> 4);
#pragma unroll
    for (int ks = 0; ks < 4; ++ks) pf.cs[ks] = *(const v4u*)(crow + 32 * ks);
}
__device__ __forceinline__ void p4_prefetch_om(P4Pref& pf, const Params& P, int item, int lane, int wave) {
    const bf16* OM = (const bf16*)(P.ws + WS_OM);
    const int bh = item >> 8, c = item & 255, b = bh >> 2, h = bh & 3, r = lane & 15, g = lane >> 4;
#pragma unroll
    for (int tb = 0; tb < 4; ++tb) pf.om[tb] = *(const uint2*)(OM + ((size_t)b * SEQ + c * 64 + 16 * tb + r) * 512 + h * 128 + 16 * wave + 4 * g);
    pf.gn = *(const f32x4*)(P.in[6] + h * 128 + 16 * wave + 4 * g);
}
__device__ __forceinline__ void p4_mlstm_out(const Params& P, LAS unsigned char* lds, int tid, int lane, int wave, int vb) {
    const float* cw = P.in[4]; const float* SC = (const float*)(P.ws + WS_SC); bf16* YM = (bf16*)(P.ws + WS_YA);
    LAS float* CW = (LAS float*)lds;
    LAS unsigned char* RAW = lds + 16384;
    LAS bf16* Qs = (LAS bf16*)(lds + 68912); LAS bf16* Ks = (LAS bf16*)(lds + 86320); LAS bf16* VT = (LAS bf16*)(lds + 103728); LAS bf16* PT = (LAS bf16*)(lds + 122160);
    LAS float* sm = (LAS float*)(lds + 131376);
    LAS bf16* NSB = (LAS bf16*)(lds + 135728);
    const int r = lane & 15, g = lane >> 4;
    for (int i = tid; i < 1024; i += 512) ((LAS f32x4*)CW)[i] = ((const f32x4*)cw)[i];
    P4Pref pf;
    if (vb < 2048) { p4_prefetch_raw(pf, P, vb, tid, lane); p4_prefetch_cs(pf, P, vb, lane, wave); p4_prefetch_om(pf, P, vb, lane, wave); }
    for (int item = vb; item < 2048; item += gridDim.x) {
        const int bh = item >> 8, c = item & 255, b = bh >> 2, h = bh & 3;
#pragma unroll
        for (int i = 0; i < 7; ++i) { const int v = tid + 512 * i; if (v < 3216) { const int rr = v / 48, rem = v - rr * 48; *(LAS v4u*)(RAW + rr * 784 + rem * 16) = pf.raw[i]; } }
        if (tid < 128) NSB[tid] = (bf16)f2bf(pf.nsv);
        if (wave == 0) {
            const float lf = logsigmoid(pf.ifa), ip = pf.ifb;
            const float bc = scan_add(lf, lane), a = ip - bc, pm = scan_max(a, lane), ms = SC[4096 + item], M = fmaxf(ms, pm);
            sm[lane] = a; sm[64 + lane] = M; sm[128 + lane] = __expf(ms - M); sm[192 + lane] = __expf(-bc - M);
        }
        __syncthreads();
        { const int g4 = tid & 31, s0 = (tid >> 5) * 4;
#pragma unroll
          for (int tile = 0; tile < 2; ++tile) {
              float x[7][4];
#pragma unroll
              for (int j = 0; j < 7; ++j) { const v2u rv = *(const LAS v2u*)(RAW + (s0 + j) * 784 + tile * 256 + g4 * 8); x[j][0] = bf_lo(rv.x); x[j][1] = bf_hi(rv.x); x[j][2] = bf_lo(rv.y); x[j][3] = bf_hi(rv.y); }
              f32x4 w[4];
#pragma unroll
              for (int tp = 0; tp < 4; ++tp) w[tp] = *(const LAS f32x4*)(CW + tp * 1024 + tile * 512 + h * 128 + 4 * g4);
              const float sc = tile ? 0.08838834764831845f : 1.0f; LAS bf16* dst = tile ? Ks : Qs;
#pragma unroll
              for (int j = 0; j < 4; ++j) { float y[4];
#pragma unroll
                  for (int i = 0; i < 4; ++i) y[i] = silu(w[0][i] * x[j][i] + w[1][i] * x[j + 1][i] + w[2][i] * x[j + 2][i] + w[3][i] * x[j + 3][i]) * sc;
                  v2u o; o.x = pk2(y[0], y[1]); o.y = pk2(y[2], y[3]); *(LAS v2u*)(dst + (s0 + j) * 136 + 4 * g4) = o; }
          }
          const int ch = tid & 127, sv = (tid >> 7) * 16;
#pragma unroll
          for (int i = 0; i < 16; i += 2) { const unsigned lo = *(const LAS bf16*)(RAW + (3 + sv + i) * 784 + 512 + ch * 2), hi = *(const LAS bf16*)(RAW + (4 + sv + i) * 784 + 512 + ch * 2);
              *(LAS unsigned*)(VT + ch * 72 + sv + i) = lo | (hi << 16); }
        }
        asm volatile("" ::: "memory");
        if (item + (int)gridDim.x < 2048) p4_prefetch_raw(pf, P, item + gridDim.x, tid, lane);
        __syncthreads();
        { const int sb = wave >> 1;
          bf16x8 ka[4];
#pragma unroll
          for (int ks = 0; ks < 4; ++ks) ka[ks] = *(const LAS bf16x8*)(Ks + (16 * sb + r) * 136 + 32 * ks + 8 * g);
#pragma unroll
          for (int tt = 0; tt < 2; ++tt) { const int tb = 2 * (wave & 1) + tt, t = 16 * tb + r;
              f32x4 acc = {0.f, 0.f, 0.f, 0.f};
#pragma unroll
              for (int ks = 0; ks < 4; ++ks) { const bf16x8 qb = *(const LAS bf16x8*)(Qs + t * 136 + 32 * ks + 8 * g); acc = MFMA16(ka[ks], qb, acc); }
              const float Mt = sm[64 + t]; float p[4], ps = 0.f;
#pragma unroll
              for (int k = 0; k < 4; ++k) { const int s = 16 * sb + 4 * g + k; p[k] = (s <= t) ? acc[k] * __expf(sm[s] - Mt) : 0.f; ps += p[k]; }
              v2u o; o.x = pk2(p[0], p[1]); o.y = pk2(p[2], p[3]); *(LAS v2u*)(PT + t * 72 + 16 * sb + 4 * g) = o;
              ps += __shfl_xor(ps, 16); ps += __shfl_xor(ps, 32);
              if (g == 0) sm[320 + sb * 64 + t] = ps; }
        }
        __syncthreads();
        f32x4 ai[4], ac[4], an[4];
#pragma unroll
        for (int tb = 0; tb < 4; ++tb) { ai[tb] = (f32x4){0.f, 0.f, 0.f, 0.f}; ac[tb] = (f32x4){0.f, 0.f, 0.f, 0.f}; an[tb] = (f32x4){0.f, 0.f, 0.f, 0.f}; }
        { const bf16x8 va0 = *(const LAS bf16x8*)(VT + (16 * wave + r) * 72 + 8 * g), va1 = *(const LAS bf16x8*)(VT + (16 * wave + r) * 72 + 32 + 8 * g);
          const bf16x8 ca0 = __builtin_bit_cast(bf16x8, pf.cs[0]), ca1 = __builtin_bit_cast(bf16x8, pf.cs[1]), ca2 = __builtin_bit_cast(bf16x8, pf.cs[2]), ca3 = __builtin_bit_cast(bf16x8, pf.cs[3]);
          const bf16x8 zero8 = {0, 0, 0, 0, 0, 0, 0, 0};
#pragma unroll
          for (int tb = 0; tb < 4; ++tb) { const int t = 16 * tb + r;
              const bf16x8 pb0 = *(const LAS bf16x8*)(PT + t * 72 + 8 * g), pb1 = *(const LAS bf16x8*)(PT + t * 72 + 32 + 8 * g);
              ai[tb] = MFMA16(va0, pb0, ai[tb]); ai[tb] = MFMA16(va1, pb1, ai[tb]);
              const bf16x8 q0 = *(const LAS bf16x8*)(Qs + t * 136 + 8 * g), q1 = *(const LAS bf16x8*)(Qs + t * 136 + 32 + 8 * g), q2 = *(const LAS bf16x8*)(Qs + t * 136 + 64 + 8 * g), q3 = *(const LAS bf16x8*)(Qs + t * 136 + 96 + 8 * g);
              ac[tb] = MFMA16(ca0, q0, ac[tb]); ac[tb] = MFMA16(ca1, q1, ac[tb]); ac[tb] = MFMA16(ca2, q2, ac[tb]); ac[tb] = MFMA16(ca3, q3, ac[tb]);
              if (wave == 0) {
                  const bf16x8 n0 = r == 0 ? *(const LAS bf16x8*)(NSB + 8 * g) : zero8, n1 = r == 0 ? *(const LAS bf16x8*)(NSB + 32 + 8 * g) : zero8, n2 = r == 0 ? *(const LAS bf16x8*)(NSB + 64 + 8 * g) : zero8, n3 = r == 0 ? *(const LAS bf16x8*)(NSB + 96 + 8 * g) : zero8;
                  an[tb] = MFMA16(n0, q0, an[tb]); an[tb] = MFMA16(n1, q1, an[tb]); an[tb] = MFMA16(n2, q2, an[tb]); an[tb] = MFMA16(n3, q3, an[tb]);
                  if (g == 0) { const float den = sm[128 + t] * an[tb][0] + (sm[320 + t] + sm[384 + t]) + (sm[448 + t] + sm[512 + t]); sm[256 + t] = fmaxf(fabsf(den), sm[192 + t]); } } }
        }
        asm volatile("" ::: "memory");
        if (item + (int)gridDim.x < 2048) p4_prefetch_cs(pf, P, item + gridDim.x, lane, wave);
#pragma unroll
        for (int tb = 0; tb < 4; ++tb) { const int t = 16 * tb + r; const float wi = sm[128 + t]; float s2 = 0.f;
#pragma unroll
            for (int k = 0; k < 4; ++k) { ai[tb][k] = wi * ac[tb][k] + ai[tb][k]; s2 += ai[tb][k] * ai[tb][k]; }
            s2 += __shfl_xor(s2, 16); s2 += __shfl_xor(s2, 32);
            if (g == 0) sm[576 + wave * 64 + t] = s2; }
        __syncthreads();
        {
#pragma unroll
          for (int tb = 0; tb < 4; ++tb) { const int t = 16 * tb + r; float tot = 0.f;
#pragma unroll
              for (int w = 0; w < 8; ++w) tot += sm[576 + w * 64 + t];
              const float inv = 1.0f / sm[256 + t], rs = inv * rsqrtf(tot * inv * inv * (1.f / 128.f) + EPS);
              const size_t row = (size_t)b * SEQ + c * 64 + t; const int col = h * 128 + 16 * wave + 4 * g;
              uint2 o; o.x = pk2(ai[tb][0] * rs * pf.gn[0] * bf_lo(pf.om[tb].x), ai[tb][1] * rs * pf.gn[1] * bf_hi(pf.om[tb].x)); o.y = pk2(ai[tb][2] * rs * pf.gn[2] * bf_lo(pf.om[tb].y), ai[tb][3] * rs * pf.gn[3] * bf_hi(pf.om[tb].y));
              *(uint2*)(YM + row * 1024 + 512 + col) = o; }
        }
        asm volatile("" ::: "memory");
        if (item + (int)gridDim.x < 2048) p4_prefetch_om(pf, P, item + gridDim.x, lane, wave);
        __syncthreads();
    }
}

__device__ __forceinline__ int f2ord(float f) { const int b = __float_as_int(f); return b ^ ((b >> 31) & 0x7fffffff); }
__device__ __forceinline__ float ord2f(int o) { return __int_as_float(o ^ ((o >> 31) & 0x7fffffff)); }
#define CE_DESC(a, i, j) { const int _h = max(a[i], a[j]), _l = min(a[i], a[j]); a[i] = _h; a[j] = _l; }
__device__ __forceinline__ void sort16_desc(int (&a)[16]) {
#pragma unroll
    for (int k = 2; k <= 16; k <<= 1) {
#pragma unroll
        for (int j = k >> 1; j > 0; j >>= 1) {
#pragma unroll
            for (int i = 0; i < 16; ++i) { const int l = i ^ j; if (l > i) { if ((i & k) == 0) CE_DESC(a, i, l) else CE_DESC(a, l, i) } }
        }
    }
}
__device__ __forceinline__ void merge16_desc(int (&a)[16], const int (&b)[16]) {
#pragma unroll
    for (int i = 0; i < 16; ++i) a[i] = max(a[i], b[15 - i]);
#pragma unroll
    for (int j = 8; j > 0; j >>= 1) {
#pragma unroll
        for (int i = 0; i < 16; ++i) { const int l = i ^ j; if (l > i) CE_DESC(a, i, l) }
    }
}
__device__ __forceinline__ void xmerge16(int (&a)[16], int mask) {
    int b[16];
#pragma unroll
    for (int i = 0; i < 16; ++i) b[i] = __shfl_xor(a[i], mask);
    merge16_desc(a, b);
}
__device__ __forceinline__ void p10_topk(const Params& P, LAS unsigned char* lds, int tid, int lane, int wave, int vb) {
    const bf16* Q2 = (const bf16*)(P.ws + WS_Q2); const bf16* K1B = (const bf16*)(P.ws + WS_K1B); const bf16* K2B = (const bf16*)(P.ws + WS_K2B);
    int* IDX = (int*)(P.ws + WS_IDX); float* GATE = (float*)(P.ws + WS_GATE); const float* SSQ1 = (const float*)(P.ws + WS_SSQ1);
    LAS bf16* Kl = (LAS bf16*)lds;
    LAS int* Tb = (LAS int*)(lds + 69632 + wave * 2048);
    const int r = lane & 15, g = lane >> 4;
    const int h = vb & 7, wgx = vb >> 3, nwg = gridDim.x >> 3;
    __syncthreads();
    for (int i = tid; i < 4096; i += 512) { const int half = i >> 11, rem = i & 2047, n = rem >> 4, c = rem & 15;
        *(LAS v4u*)(Kl + half * 17408 + n * 136 + c * 8) = *(const v4u*)((half ? K2B : K1B) + (size_t)h * 16384 + n * 128 + c * 8); }
    __syncthreads();
    for (int tile = wgx * NW + wave; tile < NTOK / 16; tile += nwg * NW) {
        const size_t row = (size_t)tile * 16 + r;
        int R[2][16];
#pragma unroll
        for (int half = 0; half < 2; ++half) {
            bf16x8 qb[4];
#pragma unroll
            for (int ks = 0; ks < 4; ++ks) qb[ks] = *(const bf16x8*)(Q2 + row * 2048 + h * 256 + half * 128 + 32 * ks + 8 * g);
            int X[16], Y[16];
#pragma unroll
            for (int nb = 0; nb < 8; ++nb) {
                f32x4 acc = {0.f, 0.f, 0.f, 0.f};
#pragma unroll
                for (int ks = 0; ks < 4; ++ks) acc = MFMA16(*(const LAS bf16x8*)(Kl + half * 17408 + (16 * nb + r) * 136 + 32 * ks + 8 * g), qb[ks], acc);
#pragma unroll
                for (int k = 0; k < 4; ++k) { const int key = (f2ord(acc[k]) & ~0x7f) | (16 * nb + 4 * g + k); if (nb < 4) X[4 * nb + k] = key; else Y[4 * (nb - 4) + k] = key; }
            }
            sort16_desc(X); sort16_desc(Y); merge16_desc(X, Y);
            xmerge16(X, 16); xmerge16(X, 32);
#pragma unroll
            for (int i = 0; i < 16; ++i) R[half][i] = X[i];
        }
        if (g == 0) {
#pragma unroll
            for (int i = 0; i < 16; ++i) { Tb[r * 32 + i] = R[0][i] & 0x7f; Tb[r * 32 + 16 + i] = R[1][i] & 0x7f; }
        }
        float F1[16], F2[16];
#pragma unroll
        for (int i = 0; i < 16; ++i) { F1[i] = ord2f(R[0][i] & ~0x7f); F2[i] = ord2f(R[1][i] & ~0x7f); }
        int C[16];
#pragma unroll
        for (int sl = 0; sl < 16; ++sl) {
            const int a1 = sl < 8 ? 1 : (sl < 13 ? 2 : -1), b1 = sl < 8 ? sl : sl - 8;
            const int a2 = sl < 4 ? 3 : (sl < 7 ? 4 : (sl < 9 ? 5 : (sl < 11 ? 6 : (sl < 13 ? 7 : -1)))), b2 = sl < 4 ? sl : (sl < 7 ? sl - 4 : (sl < 9 ? sl - 7 : (sl < 11 ? sl - 9 : sl - 11)));
            const int a3 = sl < 8 ? 8 + sl : -1;
            const int k0 = (f2ord(F1[0] + F2[sl]) & ~0xff) | (0 << 4) | sl;
            const int k1 = a1 >= 0 ? ((f2ord(F1[a1 < 0 ? 0 : a1] + F2[b1 & 15]) & ~0xff) | (a1 << 4) | (b1 & 15)) : (int)0x80000000;
            const int k2 = a2 >= 0 ? ((f2ord(F1[a2 < 0 ? 0 : a2] + F2[b2 & 15]) & ~0xff) | (a2 << 4) | (b2 & 15)) : (int)0x80000000;
            const int k3 = a3 >= 0 ? ((f2ord(F1[a3 < 0 ? 0 : a3] + F2[0]) & ~0xff) | (a3 << 4)) : (int)0x80000000;
            C[sl] = g == 0 ? k0 : (g == 1 ? k1 : (g == 2 ? k2 : k3));
        }
        sort16_desc(C); xmerge16(C, 16); xmerge16(C, 32);
        const float rstd1 = rsqrtf(SSQ1[row] * (1.0f / 1024.0f) + EPS);
        float e[16], sum = 0.f; const float mx = ord2f(C[0] & ~0xff);
#pragma unroll
        for (int i = 0; i < 16; ++i) { e[i] = __expf((ord2f(C[i] & ~0xff) - mx) * rstd1); sum += e[i]; }
        const float inv = 1.0f / sum;
        int oi[4]; float og[4];
#pragma unroll
        for (int kk = 0; kk < 4; ++kk) {
            const int key = g == 0 ? C[kk] : (g == 1 ? C[4 + kk] : (g == 2 ? C[8 + kk] : C[12 + kk]));
            const float ev = g == 0 ? e[kk] : (g == 1 ? e[4 + kk] : (g == 2 ? e[8 + kk] : e[12 + kk]));
            const int a = (key >> 4) & 15, bq = key & 15;
            oi[kk] = Tb[r * 32 + a] * 128 + Tb[r * 32 + 16 + bq]; og[kk] = ev * inv;
        }
#pragma unroll
        for (int kk = 0; kk < 4; ++kk) { const int pos = (4 * (g & 1) + kk) * 16 + 2 * h + (g >> 1); IDX[row * 128 + pos] = oi[kk]; GATE[row * 128 + pos] = og[kk]; }
    }
}

typedef _Float16 f16x2 __attribute__((ext_vector_type(2)));
__device__ __forceinline__ f16x2 bfpair_to_h2(unsigned w) { return __builtin_bit_cast(f16x2, __builtin_amdgcn_cvt_pkrtz(bf_lo(w), bf_hi(w))); }
template <int B> __device__ __forceinline__ f16x2 fp4_to_h2(unsigned w) { return __builtin_bit_cast(f16x2, __builtin_amdgcn_cvt_scalef32_pk_f16_fp4(w, 1.0f, B)); }
__device__ __forceinline__ void p11a_udot(const Params& P, int lane, int wave, int vb) {
    const bf16* HN = (const bf16*)(P.ws + WS_HN); const unsigned char* U4 = P.ws + WS_U4; const int* IDX = (const int*)(P.ws + WS_IDX); float* PART = (float*)(P.ws + WS_PART);
    const int x = vb & 3, wgx = vb >> 2, nwg = gridDim.x >> 2, rg = lane >> 3, ch = lane & 7;
    for (int t = wgx * NW + wave; t < NTOK; t += nwg * NW) {
        int e[16];
#pragma unroll
        for (int q = 0; q < 4; ++q) { const int4 v = *(const int4*)(IDX + (size_t)t * 128 + rg * 16 + 4 * q); e[4 * q] = v.x; e[4 * q + 1] = v.y; e[4 * q + 2] = v.z; e[4 * q + 3] = v.w; }
        v4u hq[4];
#pragma unroll
        for (int q = 0; q < 4; ++q) hq[q] = *(const v4u*)(HN + (size_t)t * 1024 + 256 * x + 32 * ch + 8 * q);
        v4u ud[16];
#pragma unroll
        for (int gq = 0; gq < 16; ++gq) ud[gq] = *(const v4u*)(U4 + (size_t)e[gq] * 512 + 128 * x + 16 * ch);
        f16x2 hh[16];
#pragma unroll
        for (int q = 0; q < 4; ++q) { hh[4 * q] = bfpair_to_h2(hq[q].x); hh[4 * q + 1] = bfpair_to_h2(hq[q].y); hh[4 * q + 2] = bfpair_to_h2(hq[q].z); hh[4 * q + 3] = bfpair_to_h2(hq[q].w); }
        float z[16];
#pragma unroll
        for (int gq = 0; gq < 16; ++gq) { float d = 0.f; const unsigned w4[4] = {ud[gq].x, ud[gq].y, ud[gq].z, ud[gq].w};
#pragma unroll
            for (int q = 0; q < 4; ++q) { d = __builtin_amdgcn_fdot2(fp4_to_h2<0>(w4[q]), hh[4 * q], d, false); d = __builtin_amdgcn_fdot2(fp4_to_h2<1>(w4[q]), hh[4 * q + 1], d, false);
                d = __builtin_amdgcn_fdot2(fp4_to_h2<2>(w4[q]), hh[4 * q + 2], d, false); d = __builtin_amdgcn_fdot2(fp4_to_h2<3>(w4[q]), hh[4 * q + 3], d, false); }
            z[gq] = d; }
        float z8[8], z4[4], z2[2];
        { const bool b = ch & 4;
#pragma unroll
          for (int i = 0; i < 8; ++i) { const float keep = b ? z[8 + i] : z[i], send = b ? z[i] : z[8 + i]; z8[i] = keep + __shfl_xor(send, 4); } }
        { const bool b = ch & 2;
#pragma unroll
          for (int i = 0; i < 4; ++i) { const float keep = b ? z8[4 + i] : z8[i], send = b ? z8[i] : z8[4 + i]; z4[i] = keep + __shfl_xor(send, 2); } }
        { const bool b = ch & 1;
#pragma unroll
          for (int i = 0; i < 2; ++i) { const float keep = b ? z4[2 + i] : z4[i], send = b ? z4[i] : z4[2 + i]; z2[i] = keep + __shfl_xor(send, 1); } }
        *(float2*)(PART + ((size_t)t * 4 + x) * 128 + rg * 16 + 2 * ch) = make_float2(z2[0], z2[1]);
    }
}
__device__ __forceinline__ void p11b_weights(const Params& P, int tid, int vb) {
    const float* PART = (const float*)(P.ws + WS_PART); float* GW = (float*)(P.ws + WS_GATE); const float* SSQ1 = (const float*)(P.ws + WS_SSQ1);
    const int* IDX = (const int*)(P.ws + WS_IDX); const float* SU = (const float*)(P.ws + WS_SU); const float* SV = (const float*)(P.ws + WS_SV);
    for (size_t i = (size_t)vb * 512 + tid; i < (size_t)NTOK * 128; i += (size_t)gridDim.x * 512) {
        const size_t t = i >> 7, pos = i & 127; float zs = 0.f;
#pragma unroll
        for (int x = 0; x < 4; ++x) zs += PART[(t * 4 + x) * 128 + pos];
        const int e = IDX[i];
        const float zv = zs * SU[e] * rsqrtf(SSQ1[t] * (1.0f / 1024.0f) + EPS);
        GW[i] = GW[i] * 0.5f * zv * (1.0f + erff(zv * 0.70710678118654752f)) * SV[e];
    }
}
__device__ __forceinline__ void p11c_vacc(const Params& P, int lane, int wave, int vb) {
    const unsigned char* V4 = P.ws + WS_V4; const int* IDX = (const int*)(P.ws + WS_IDX); const float* GW = (const float*)(P.ws + WS_GATE);
    float* X = P.out; float* SSQ = (float*)(P.ws + WS_SSQ); bf16* XG = (bf16*)(P.ws + WS_HN2); const float* gple = P.in[16];
    const int x = vb & 3, wgx = vb >> 2, nwg = gridDim.x >> 2, rg = lane >> 3, ch = lane & 7;
    const f32x4 gp = *(const f32x4*)(gple + 256 * x + 32 * ch + 4 * rg);
    for (int t = wgx * NW + wave; t < NTOK; t += nwg * NW) {
        int e[16]; float w[16];
#pragma unroll
        for (int q = 0; q < 4; ++q) { const int4 v = *(const int4*)(IDX + (size_t)t * 128 + rg * 16 + 4 * q); e[4 * q] = v.x; e[4 * q + 1] = v.y; e[4 * q + 2] = v.z; e[4 * q + 3] = v.w;
            const float4 wv = *(const float4*)(GW + (size_t)t * 128 + rg * 16 + 4 * q); w[4 * q] = wv.x; w[4 * q + 1] = wv.y; w[4 * q + 2] = wv.z; w[4 * q + 3] = wv.w; }
        v4u vd[16];
#pragma unroll
        for (int gq = 0; gq < 16; ++gq) vd[gq] = *(const v4u*)(V4 + (size_t)e[gq] * 512 + 128 * x + 16 * ch);
        float* xp = X + (size_t)t * 1024 + 256 * x + 32 * ch + 4 * rg;
        const f32x4 xo = *(const f32x4*)xp;
        f16x2 acc[16];
#pragma unroll
        for (int i = 0; i < 16; ++i) acc[i] = (f16x2){(_Float16)0.f, (_Float16)0.f};
#pragma unroll
        for (int gq = 0; gq < 16; ++gq) { const f16x2 ww = __builtin_bit_cast(f16x2, __builtin_amdgcn_cvt_pkrtz(w[gq], w[gq])); const unsigned w4[4] = {vd[gq].x, vd[gq].y, vd[gq].z, vd[gq].w};
#pragma unroll
            for (int q = 0; q < 4; ++q) { acc[4 * q] = __builtin_elementwise_fma(fp4_to_h2<0>(w4[q]), ww, acc[4 * q]); acc[4 * q + 1] = __builtin_elementwise_fma(fp4_to_h2<1>(w4[q]), ww, acc[4 * q + 1]);
                acc[4 * q + 2] = __builtin_elementwise_fma(fp4_to_h2<2>(w4[q]), ww, acc[4 * q + 2]); acc[4 * q + 3] = __builtin_elementwise_fma(fp4_to_h2<3>(w4[q]), ww, acc[4 * q + 3]); } }
        f16x2 a8[8], a4[4], a2[2];
        { const bool b = rg & 4;
#pragma unroll
          for (int i = 0; i < 8; ++i) { const f16x2 keep = b ? acc[8 + i] : acc[i], send = b ? acc[i] : acc[8 + i]; a8[i] = keep + __builtin_bit_cast(f16x2, __shfl_xor(__builtin_bit_cast(int, send), 32)); } }
        { const bool b = rg & 2;
#pragma unroll
          for (int i = 0; i < 4; ++i) { const f16x2 keep = b ? a8[4 + i] : a8[i], send = b ? a8[i] : a8[4 + i]; a4[i] = keep + __builtin_bit_cast(f16x2, __shfl_xor(__builtin_bit_cast(int, send), 16)); } }
        { const bool b = rg & 1;
#pragma unroll
          for (int i = 0; i < 2; ++i) { const f16x2 keep = b ? a4[2 + i] : a4[i], send = b ? a4[i] : a4[2 + i]; a2[i] = keep + __builtin_bit_cast(f16x2, __shfl_xor(__builtin_bit_cast(int, send), 8)); } }
        f32x4 xn; xn[0] = xo[0] + (float)a2[0][0]; xn[1] = xo[1] + (float)a2[0][1]; xn[2] = xo[2] + (float)a2[1][0]; xn[3] = xo[3] + (float)a2[1][1];
        *(f32x4*)xp = xn;
        uint2 xg; xg.x = pk2(xn[0] * gp[0], xn[1] * gp[1]); xg.y = pk2(xn[2] * gp[2], xn[3] * gp[3]);
        *(uint2*)(XG + (size_t)t * 1024 + 256 * x + 32 * ch + 4 * rg) = xg;
        const float ss = wave_sum((xn[0] * xn[0] + xn[1] * xn[1]) + (xn[2] * xn[2] + xn[3] * xn[3]));
        if (lane == 0) atomicAdd(SSQ + t, ss);
    }
}

__global__ void __launch_bounds__(512, 2) mk_fwd(Params P) {
    extern __shared__ __attribute__((aligned(16))) unsigned char lds_raw[];
    cg::grid_group grid = cg::this_grid();
    LAS unsigned char* lds = (LAS unsigned char*)lds_raw;
    const int tid = threadIdx.x, lane = tid & 63, wave = __builtin_amdgcn_readfirstlane(tid >> 6);
    const int lo = P.ph_lo, hi = P.ph_hi, G = gridDim.x, bx = blockIdx.x;
    unsigned char* ws = P.ws;
    const int gw = bx * NW + wave, NGW = G * NW;
#ifndef PH_MASK
#define PH_MASK 0xffff
#endif
#define IN(k) (((PH_MASK >> (k)) & 1) && lo <= (k) && (k) < hi)
    volatile LAS unsigned* xst = (volatile LAS unsigned*)(lds + LDS_BYTES - 16);
    if (tid < 4) xst[tid] = 0u;
    __syncthreads();
    const XcdBarrier bar = xcd_barrier_post((unsigned*)(ws + WS_BAR), xst);
    unsigned* vctl = (unsigned*)(ws + WS_BAR) + 4096;
    if (tid == 0) { const unsigned xcc = xb_xcc_id() & 7u; xst[2] = xcc; xst[3] = xb_add(&vctl[16 * xcc], 1u); }
#ifdef USE_CG
#define GRID_BAR() grid.sync()
#else
#define GRID_BAR() xcd_barrier(bar)
#endif
#define SYNC_AFTER(k) do { if (IN(k) && IN((k) + 1)) { if ((k) == 0) grid.sync(); else GRID_BAR(); } } while (0)
    typedef pg8::bf16_t pb;
    if (IN(0)) p0_prologue(P, lds, tid, lane, wave);
    SYNC_AFTER(0);
    if (tid == 0) {
        const unsigned xcc = xst[2], sl = xst[3], cap = (unsigned)G >> 3; unsigned v;
        if (sl < cap) v = sl * 8u + xcc;
        else { unsigned o = xb_add(&vctl[160], 1u); v = 0u;
            for (unsigned x = 0; x < 8u; ++x) { const unsigned c = min(xb_ld(&vctl[16 * x]), cap), fr = cap - c; if (o < fr) { v = (c + o) * 8u + x; break; } o -= fr; } }
        xst[2] = v;
    }
    __syncthreads();
    const int vb = (int)xst[2];
    if (IN(1)) {
        pg8::Gemm g{(const pb*)(ws + WS_XN), (const pb*)(ws + WS_W1T), NTOK, 5632, 1024}; pg8::StaticOrder S; S.init(NTOK, 5632, G, vb);
        pg8::EpiProj E{(pb*)(ws + WS_QKVA), (pb*)(ws + WS_QKM), (pb*)(ws + WS_VM), (pb*)(ws + WS_OM), (pb*)(ws + WS_G), C2};
        pg8::gemm_phase<pg8::EpiProj, pg8::StaticOrder, true, true>(lds, g, S, E);
    }
    SYNC_AFTER(1);
    if (IN(2)) { p2_attention(P, lds, lane, wave, vb); __syncthreads(); p2_mlstm_local(P, lds, tid, lane, wave, vb); }
    SYNC_AFTER(2);
    if (IN(3)) p3_mlstm_scan(P, tid, vb);
    SYNC_AFTER(3);
    if (IN(4)) p4_mlstm_out(P, lds, tid, lane, wave, vb);
    SYNC_AFTER(4);
    if (IN(5)) {
        pg8::Gemm g{(const pb*)(ws + WS_YA), (const pb*)(ws + WS_WAT), NTOK, 1024, 1024}; pg8::StaticOrder S; S.init(NTOK, 1024, G, vb);
        pg8::EpiMerged E{(pb*)(ws + WS_MERGED), (const pb*)(ws + WS_G)};
        pg8::gemm_phase<pg8::EpiMerged, pg8::StaticOrder, true, true>(lds, g, S, E);
    }
    if (IN(5) && IN(7)) GRID_BAR();
    if (IN(7)) {
        pg8::Gemm g{(const pb*)(ws + WS_MERGED), (const pb*)(ws + WS_WOT), NTOK, 1024, 1024}; pg8::StaticOrder S; S.init(NTOK, 1024, G, vb);
        pg8::EpiResidual E{P.in[0], P.out, (pb*)(ws + WS_HN), P.in[10], (float*)(ws + WS_SSQ1)};
        pg8::gemm_phase<pg8::EpiResidual, pg8::StaticOrder, true, true>(lds, g, S, E);
    }
    if (IN(7) && IN(9)) GRID_BAR();
    if (IN(9)) {
        pg8::Gemm g{(const pb*)(ws + WS_HN), (const pb*)(ws + WS_WQT), NTOK, 2048, 1024}; pg8::StaticOrder S; S.init(NTOK, 2048, G, vb);
        pg8::EpiStore E{(pb*)(ws + WS_Q2), 2048};
        pg8::gemm_phase<pg8::EpiStore, pg8::StaticOrder, true, true>(lds, g, S, E);
    }
    SYNC_AFTER(9);
    if (IN(10)) p10_topk(P, lds, tid, lane, wave, vb);
    SYNC_AFTER(10);
    if (IN(11)) { p11a_udot(P, lane, wave, vb); GRID_BAR(); p11b_weights(P, tid, vb); GRID_BAR(); p11c_vacc(P, lane, wave, vb); }
    SYNC_AFTER(11);
    if (IN(12)) {
        pg8::Gemm g{(const pb*)(ws + WS_PB), (const pb*)(ws + WS_WPT), NTOK, 1024, 256}; pg8::StaticOrder S; S.init(NTOK, 1024, G, vb);
        pg8::EpiStore E{(pb*)(ws + WS_E), 1024};
        pg8::gemm_phase<pg8::EpiStore, pg8::StaticOrder, true, true>(lds, g, S, E);
    }
    if (IN(12) && IN(13)) { asm volatile("s_waitcnt vmcnt(0)" ::: "memory"); __syncthreads(); }
    if (IN(13)) {
        pg8::Gemm g{(const pb*)(ws + WS_HN2), (const pb*)(ws + WS_WGT), NTOK, 1024, 1024}; pg8::StaticOrder S; S.init(NTOK, 1024, G, vb);
        pg8::EpiPle E{P.out, (const pb*)(ws + WS_E), (const float*)(ws + WS_SSQ)};
        pg8::gemm_phase<pg8::EpiPle, pg8::StaticOrder, true, true>(lds, g, S, E);
    }
    SYNC_AFTER(13);
    if (IN(14)) {
        const float* gf = P.in[19];
        for (int m = gw; m < NTOK; m += NGW) {
            float* xr = P.out + (size_t)m * 1024; f32x4 v[4]; float s = 0.f;
#pragma unroll
            for (int j = 0; j < 4; ++j) { v[j] = ((const f32x4*)xr)[lane + 64 * j]; s += (v[j][0] * v[j][0] + v[j][1] * v[j][1]) + (v[j][2] * v[j][2] + v[j][3] * v[j][3]); }
            const float rstd = rsqrtf(wave_sum(s) * (1.f / 1024.f) + EPS);
#pragma unroll
            for (int j = 0; j < 4; ++j) { const f32x4 g = ((const f32x4*)gf)[lane + 64 * j]; ((f32x4*)xr)[lane + 64 * j] = v[j] * rstd * g; }
        }
    }
}

extern "C" void kernel_launch(void* const* d_in, const int* in_sizes, int n_in, void* d_out, int out_size, void* d_ws, size_t ws_size, hipStream_t stream) {
    static int grid_blocks = 0;
    if (!grid_blocks) {
        int dev = 0, cus = 0, per_cu = 0;
        (void)hipGetDevice(&dev);
        (void)hipDeviceGetAttribute(&cus, hipDeviceAttributeMultiprocessorCount, dev);
        (void)hipFuncSetAttribute((const void*)mk_fwd, hipFuncAttributeMaxDynamicSharedMemorySize, LDS_BYTES);
        (void)hipOccupancyMaxActiveBlocksPerMultiprocessor(&per_cu, mk_fwd, 512, LDS_BYTES);
        if (per_cu > 1) per_cu = 1;
        grid_blocks = cus * per_cu;
    }
    if (n_in < 20 || ws_size < WS_NEED || grid_blocks <= 0) { fprintf(stderr, "kernel_launch: bad setup (n_in %d ws %zu grid %d)\n", n_in, ws_size, grid_blocks); return; }
    Params p{};
    for (int i = 0; i < 20; ++i) p.in[i] = (const float*)d_in[i];
    p.out = (float*)d_out; p.ws = (unsigned char*)d_ws; p.ph_lo = 0; p.ph_hi = 15;
    (void)hipMemsetAsync((unsigned char*)d_ws + WS_BAR, 0, BAR_BYTES, stream);
    void* args[] = {&p};
    hipError_t e = hipLaunchCooperativeKernel((void*)mk_fwd, dim3(grid_blocks), dim3(512), args, LDS_BYTES, stream);
    if (e != hipSuccess) fprintf(stderr, "cooperative launch failed: %s (grid %d)\n", hipGetErrorString(e), grid_blocks);
}
```

```cpp
#include <hip/hip_runtime.h>
#include <hip/hip_cooperative_groups.h>
#include <cstdio>
#include <cstdint>
namespace cg = cooperative_groups;
namespace pg8 {
#define PG8_LAS __attribute__((address_space(3)))
typedef unsigned short bf16_t;
typedef short bf16x8 __attribute__((ext_vector_type(8)));
typedef float f32x4 __attribute__((ext_vector_type(4)));
typedef unsigned u32x4 __attribute__((ext_vector_type(4)));
constexpr int BM = 256, BK = 64, HALF = 128, HTB = HALF * BK * 2  , STAGE_BYTES = 8 * HTB, NXCD = 8, WGM = 8;

__host__ __device__ __forceinline__ int lds_byte(int r, int c) { const int st = (r >> 4) * 2 + (c >> 5), rr = r & 15, cc = c & 31, ob = rr * 64 + cc * 2; return st * 1024 + (ob ^ (((ob >> 9) & 1) << 5)); }
__host__ __device__ __forceinline__ void stage_rc(int b, int& R, int& C) { const int st = b / 1024, sb = b % 1024, swz = sb ^ (((sb >> 9) & 1) << 5); R = (st >> 1) * 16 + swz / 64; C = (st & 1) * 32 + (swz % 64) / 2; }
__host__ __device__ __forceinline__ int perm32(int rho) { const int n = rho >> 4, i = rho & 15; return 8 * (i >> 2) + 4 * n + (i & 3); }

struct Unit { int pm, pn; };
struct Gemm { const bf16_t* A; const bf16_t* Bt; int M, N, K; };

struct StaticOrder {
    int nM, nN, nwg, G, c;
    __host__ __device__ void init(int M, int N, int G_, int c_) { nM = M / BM; nN = N / BM; nwg = nM * nN; G = G_; c = c_; }
    __host__ __device__ bool next(int i, Unit& u) const {
        const long L = (long)i * G + c; if (L >= nwg) return false;
        int wgid = (int)L; { const int q = nwg / NXCD, r = nwg % NXCD, xcd = wgid % NXCD, off = wgid / NXCD; wgid = (xcd < r ? xcd * (q + 1) : r * (q + 1) + (xcd - r) * q) + off; }
        const int nig = WGM * nN, gid = wgid / nig, fm = gid * WGM, gsz = (nM - fm) < WGM ? (nM - fm) : WGM;
        u.pm = fm + ((wgid % nig) % gsz); u.pn = (wgid % nig) / gsz; return true;
    }
    __device__ __forceinline__ void a_ready(const Unit&) const {}
    __device__ __forceinline__ void done(const Unit&) const {}
};

__device__ __forceinline__ unsigned cvt_pk_bf16(float lo, float hi) { unsigned r; asm volatile("v_cvt_pk_bf16_f32 %0, %1, %2" : "=v"(r) : "v"(lo), "v"(hi)); return r; }
typedef float f32x2 __attribute__((ext_vector_type(2)));

__device__ __forceinline__ float sigm(float x) { return 1.0f / (1.0f + __expf(-x)); }
__device__ __forceinline__ float bf_lo(unsigned w) { return __uint_as_float(w << 16); }
__device__ __forceinline__ float bf_hi(unsigned w) { return __uint_as_float(w & 0xffff0000u); }
__device__ __forceinline__ u32x4 pack8(const f32x4& v0, const f32x4& v1) { u32x4 w; w.x = cvt_pk_bf16(v0[0], v0[1]); w.y = cvt_pk_bf16(v0[2], v0[3]); w.z = cvt_pk_bf16(v1[0], v1[1]); w.w = cvt_pk_bf16(v1[2], v1[3]); return w; }
__device__ __forceinline__ void unpack8(const u32x4& w, f32x4& v0, f32x4& v1) { v0[0] = bf_lo(w.x); v0[1] = bf_hi(w.x); v0[2] = bf_lo(w.y); v0[3] = bf_hi(w.y); v1[0] = bf_lo(w.z); v1[1] = bf_hi(w.z); v1[2] = bf_lo(w.w); v1[3] = bf_hi(w.w); }

#define PG8_EPI_WALK(...) \
    _Pragma("unroll") for (int ai = 0; ai < 2; ++ai) _Pragma("unroll") for (int m = 0; m < 4; ++m) { const int row = u.pm * BM + wr * 64 + fr + ai * HALF + m * 16; \
        _Pragma("unroll") for (int bj = 0; bj < 2; ++bj) { const int ct = wc * 64 + bj * 32 + 8 * fq; f32x4 v0 = acc[ai][bj][m][0], v1 = acc[ai][bj][m][1]; __VA_ARGS__ } }

__device__ __forceinline__ u32x4 xor8_16B(u32x4 v) { u32x4 r; r.x = (unsigned)__shfl_xor((int)v.x, 8); r.y = (unsigned)__shfl_xor((int)v.y, 8); r.z = (unsigned)__shfl_xor((int)v.z, 8); r.w = (unsigned)__shfl_xor((int)v.w, 8); return r; }
__device__ __forceinline__ u32x4 bperm_16B(int src_byte, u32x4 v) { u32x4 r; r.x = (unsigned)__builtin_amdgcn_ds_bpermute(src_byte, (int)v.x); r.y = (unsigned)__builtin_amdgcn_ds_bpermute(src_byte, (int)v.y); r.z = (unsigned)__builtin_amdgcn_ds_bpermute(src_byte, (int)v.z); r.w = (unsigned)__builtin_amdgcn_ds_bpermute(src_byte, (int)v.w); return r; }
__device__ __forceinline__ void store_rows_bf16(bf16_t* O, size_t ldc, int r0, int c0, int fr, int fq, u32x4 w0, u32x4 w1) {
    const bool h = fr & 8; const u32x4 recv = xor8_16B(h ? w0 : w1);
    const u32x4 d1 = h ? recv : w0, d2 = h ? w1 : recv;
    const int lane = fr + 16 * fq, src = ((lane >> 3) + 8 * ((lane >> 2) & 1) + 16 * (lane & 3)) * 4;
    const u32x4 e1 = bperm_16B(src, d1), e2 = bperm_16B(src, d2);
    bf16_t* p = O + (size_t)(r0 + (lane >> 3)) * ldc + c0 + 8 * (lane & 7);
    *(u32x4*)p = e1; *(u32x4*)(p + 8 * ldc) = e2;
}
struct EpiProj {
    static constexpr bool PERM = true, AFTER_DRAIN = false, MIDK = false;
    bf16_t *qkva, *qkm, *vm, *om, *g; float c2;
    __device__ __forceinline__ void operator()(const f32x4 (&acc)[2][2][4][2], const Unit& u, int wr, int wc, int fr, int fq) const {
        const int pn = u.pn; bf16_t* base; int ldc, colt, mode = 0; float sc = 1.f;
        if (pn < 6) { base = qkva; ldc = 1536; colt = pn * 256; if (pn < 2) sc = c2; }
        else if (pn < 10) { base = qkm; ldc = 1024; colt = (pn - 6) * 256; }
        else if (pn < 12) { base = vm; ldc = 512; colt = (pn - 10) * 256; }
        else if (pn < 14) { base = om; ldc = 512; colt = (pn - 12) * 256; mode = 1; }
        else { base = g; ldc = 2048; colt = (pn - 14) * 256; mode = 1; }
#pragma unroll
        for (int ai = 0; ai < 2; ++ai)
#pragma unroll
            for (int m = 0; m < 4; ++m) { u32x4 w[2];
#pragma unroll
                for (int bj = 0; bj < 2; ++bj) { f32x4 v0 = acc[ai][bj][m][0], v1 = acc[ai][bj][m][1];
                    if (mode == 1) { _Pragma("unroll") for (int i = 0; i < 4; ++i) { v0[i] = sigm(v0[i]); v1[i] = sigm(v1[i]); } }
                    else { v0 = v0 * sc; v1 = v1 * sc; }
                    w[bj] = pack8(v0, v1); }
                store_rows_bf16(base, (size_t)ldc, u.pm * BM + wr * 64 + ai * HALF + m * 16, colt + wc * 64, fr, fq, w[0], w[1]); }
    }
};
struct EpiStore {
    static constexpr bool PERM = true, AFTER_DRAIN = false, MIDK = false;
    bf16_t* O; int ldc;
    __device__ __forceinline__ void operator()(const f32x4 (&acc)[2][2][4][2], const Unit& u, int wr, int wc, int fr, int fq) const {
#pragma unroll
        for (int ai = 0; ai < 2; ++ai)
#pragma unroll
            for (int m = 0; m < 4; ++m) store_rows_bf16(O, (size_t)ldc, u.pm * BM + wr * 64 + ai * HALF + m * 16, u.pn * BM + wc * 64, fr, fq, pack8(acc[ai][0][m][0], acc[ai][0][m][1]), pack8(acc[ai][1][m][0], acc[ai][1][m][1]));
    }
};
template <bool ADD> struct EpiGated {
    static constexpr bool PERM = true, AFTER_DRAIN = false, MIDK = false;
    bf16_t* O; const bf16_t* prev; const bf16_t* gate; int gcol0;
    __device__ __forceinline__ void operator()(const f32x4 (&acc)[2][2][4][2], const Unit& u, int wr, int wc, int fr, int fq) const {
#pragma unroll
        for (int ai = 0; ai < 2; ++ai)
#pragma unroll
            for (int m = 0; m < 4; ++m) { const int row = u.pm * BM + wr * 64 + fr + ai * HALF + m * 16; u32x4 w[2];
#pragma unroll
                for (int bj = 0; bj < 2; ++bj) { const int col = u.pn * BM + wc * 64 + bj * 32 + 8 * fq; f32x4 v0 = acc[ai][bj][m][0], v1 = acc[ai][bj][m][1];
                    f32x4 g0, g1; unpack8(*(const u32x4*)(gate + (size_t)row * 2048 + gcol0 + col), g0, g1);
                    v0 = v0 * g0; v1 = v1 * g1;
                    if (ADD) { f32x4 p0, p1; unpack8(*(const u32x4*)(prev + (size_t)row * 1024 + col), p0, p1); v0 = v0 + p0; v1 = v1 + p1; }
                    w[bj] = pack8(v0, v1); }
                store_rows_bf16(O, 1024, u.pm * BM + wr * 64 + ai * HALF + m * 16, u.pn * BM + wc * 64, fr, fq, w[0], w[1]); }
    }
};
struct EpiMerged {
    static constexpr bool PERM = true, AFTER_DRAIN = false, MIDK = true;
    bf16_t* O; const bf16_t* gate;
    __device__ __forceinline__ void mid(f32x4 (&acc)[2][2][4][2], const Unit& u, int wr, int wc, int fr, int fq) const {
#pragma unroll
        for (int ai = 0; ai < 2; ++ai)
#pragma unroll
            for (int mp = 0; mp < 2; ++mp) {
                u32x4 ga[2][2], gm[2][2];
#pragma unroll
                for (int mm = 0; mm < 2; ++mm)
#pragma unroll
                    for (int bj = 0; bj < 2; ++bj) { const size_t o = (size_t)(u.pm * BM + wr * 64 + fr + ai * HALF + (2 * mp + mm) * 16) * 2048 + u.pn * BM + wc * 64 + bj * 32 + 8 * fq;
                        ga[mm][bj] = *(const u32x4*)(gate + o); gm[mm][bj] = *(const u32x4*)(gate + o + 1024); }
#pragma unroll
                for (int mm = 0; mm < 2; ++mm)
#pragma unroll
                    for (int bj = 0; bj < 2; ++bj) { f32x4 a0, a1, m0, m1; unpack8(ga[mm][bj], a0, a1); unpack8(gm[mm][bj], m0, m1);
#pragma unroll
                        for (int i = 0; i < 4; ++i) { acc[ai][bj][2 * mp + mm][0][i] *= a0[i] * __builtin_amdgcn_rcpf(m0[i]); acc[ai][bj][2 * mp + mm][1][i] *= a1[i] * __builtin_amdgcn_rcpf(m1[i]); } }
            }
    }
    __device__ __forceinline__ void operator()(const f32x4 (&acc)[2][2][4][2], const Unit& u, int wr, int wc, int fr, int fq) const {
#pragma unroll
        for (int ai = 0; ai < 2; ++ai)
#pragma unroll
            for (int mp = 0; mp < 2; ++mp) {
                u32x4 gm[2][2];
#pragma unroll
                for (int mm = 0; mm < 2; ++mm)
#pragma unroll
                    for (int bj = 0; bj < 2; ++bj) gm[mm][bj] = *(const u32x4*)(gate + (size_t)(u.pm * BM + wr * 64 + fr + ai * HALF + (2 * mp + mm) * 16) * 2048 + 1024 + u.pn * BM + wc * 64 + bj * 32 + 8 * fq);
#pragma unroll
                for (int mm = 0; mm < 2; ++mm) { const int m = 2 * mp + mm; u32x4 w[2];
#pragma unroll
                    for (int bj = 0; bj < 2; ++bj) { f32x4 m0, m1; unpack8(gm[mm][bj], m0, m1); w[bj] = pack8(acc[ai][bj][m][0] * m0, acc[ai][bj][m][1] * m1); }
                    store_rows_bf16(O, 1024, u.pm * BM + wr * 64 + ai * HALF + m * 16, u.pn * BM + wc * 64, fr, fq, w[0], w[1]); }
            }
    }
};
struct EpiResidual {
    static constexpr bool PERM = true, AFTER_DRAIN = false, MIDK = false;
    const float* res; float* out; bf16_t* xa; const float* gain; float* ssq;
    __device__ __forceinline__ void operator()(const f32x4 (&acc)[2][2][4][2], const Unit& u, int wr, int wc, int fr, int fq) const {
#pragma unroll
        for (int ai = 0; ai < 2; ++ai)
#pragma unroll
            for (int m = 0; m < 4; ++m) { const int row = u.pm * BM + wr * 64 + fr + ai * HALF + m * 16; float s = 0.f; u32x4 wx[2];
#pragma unroll
                for (int bj = 0; bj < 2; ++bj) { const int ct = wc * 64 + bj * 32 + 8 * fq; f32x4 v0 = acc[ai][bj][m][0], v1 = acc[ai][bj][m][1];
                    const size_t o = (size_t)row * 1024 + u.pn * BM + ct; const f32x4 r0 = *(const f32x4*)(res + o), r1 = *(const f32x4*)(res + o + 4);
                    v0 = v0 + r0; v1 = v1 + r1; *(f32x4*)(out + o) = v0; *(f32x4*)(out + o + 4) = v1;
                    s += (v0[0] * v0[0] + v0[1] * v0[1]) + (v0[2] * v0[2] + v0[3] * v0[3]) + (v1[0] * v1[0] + v1[1] * v1[1]) + (v1[2] * v1[2] + v1[3] * v1[3]);
                    const f32x4 g0 = *(const f32x4*)(gain + u.pn * BM + ct), g1 = *(const f32x4*)(gain + u.pn * BM + ct + 4);
                    wx[bj] = pack8(v0 * g0, v1 * g1); }
                store_rows_bf16(xa, 1024, u.pm * BM + wr * 64 + ai * HALF + m * 16, u.pn * BM + wc * 64, fr, fq, wx[0], wx[1]);
                s += __shfl_xor(s, 16); s += __shfl_xor(s, 32);
                if (fq == 0) atomicAdd(ssq + row, s);
                asm volatile("" ::: "memory"); }
    }
};
struct EpiPle {
    static constexpr bool PERM = true, AFTER_DRAIN = false, MIDK = false;
    float* xio; const bf16_t* e; const float* ssq;
    __device__ __forceinline__ void operator()(const f32x4 (&acc)[2][2][4][2], const Unit& u, int wr, int wc, int fr, int fq) const {
        const int row0 = u.pm * BM + wr * 64 + fr;
        float sq_next = ssq[row0];
#pragma unroll
        for (int ai = 0; ai < 2; ++ai)
#pragma unroll
            for (int m = 0; m < 4; ++m) { const int row = row0 + ai * HALF + m * 16; const float sq = sq_next;
                if (!(ai == 1 && m == 3)) sq_next = ssq[row0 + (m == 3 ? HALF : ai * HALF + (m + 1) * 16)];
                const float rstd = rsqrtf(sq * (1.0f / 1024.0f) + 1e-6f);
#pragma unroll
                for (int bj = 0; bj < 2; ++bj) { const int ct = wc * 64 + bj * 32 + 8 * fq; f32x4 v0 = acc[ai][bj][m][0] * rstd, v1 = acc[ai][bj][m][1] * rstd;
                    const size_t o = (size_t)row * 1024 + u.pn * BM + ct; f32x4 e0, e1; unpack8(*(const u32x4*)(e + o), e0, e1);
                    const f32x4 r0 = *(const f32x4*)(xio + o), r1 = *(const f32x4*)(xio + o + 4);
#pragma unroll
                    for (int i = 0; i < 4; ++i) { v0[i] = r0[i] + sigm(v0[i]) * e0[i]; v1[i] = r1[i] + sigm(v1[i]) * e1[i]; }
                    *(f32x4*)(xio + o) = v0; *(f32x4*)(xio + o + 4) = v1; } }
    }
};

template <class Epi, class Sched, bool ALIGN_EPI = false, bool SP2 = false>
__device__ __forceinline__ void gemm_phase(PG8_LAS unsigned char* lds, const Gemm g, const Sched& S, const Epi& E) {
    int tid_ = threadIdx.x; asm volatile("" : "+v"(tid_));
    const int tid = tid_, wid = __builtin_amdgcn_readfirstlane(tid >> 6), lane = tid & 63, wr = wid >> 2, wc = wid & 3, fr = lane & 15, fq = lane >> 4;
    int K_ = g.K; asm volatile("" : "+s"(K_));
    const int K = K_, nt = K / BK;
    unsigned voffA[2], voffB[2];
#pragma unroll
    for (int i = 0; i < 2; ++i) { int R, C; stage_rc(tid * 16 + i * 8192, R, C); const int Rb = Epi::PERM ? (2 * (R & ~31) + perm32(R & 31)) : R;
        voffA[i] = (unsigned)(R * K + C) * 2u; voffB[i] = (unsigned)(Rb * K + C) * 2u; }
    const size_t kstep = (size_t)(BK * 2);
    const size_t hstep = (size_t)HALF * K * 2;
    const size_t hstepB = Epi::PERM ? (size_t)32 * K * 2 : hstep;
    const size_t tstep = 2 * hstep;
    const unsigned ldsw = (unsigned)wid * 1024u;
    const int aoff = lds_byte(wr * 64 + fr, fq * 8), boff = lds_byte(wc * 32 + fr, fq * 8);
#define PG8_SA(b, h) (((b) * 2 + (h)) * HTB)
#define PG8_SB(b, h) ((4 + (b) * 2 + (h)) * HTB)
#define PG8_STAGE(bufoff, gbase, voff) do { _Pragma("unroll") for (int _i = 0; _i < 2; ++_i) \
        __builtin_amdgcn_global_load_lds((const unsigned*)((const char*)(gbase) + (voff)[_i]), (PG8_LAS unsigned*)(lds + (bufoff) + ldsw + _i * 8192), 16, 0, 0); } while (0)
#define PG8_LDA(dst, b, h) do { _Pragma("unroll") for (int m = 0; m < 4; ++m) _Pragma("unroll") for (int k = 0; k < 2; ++k) dst[m][k] = *(const PG8_LAS bf16x8*)(lds + PG8_SA(b, h) + aoff + m * 2048 + k * 1024); } while (0)
#define PG8_LDB(dst, b, h) do { _Pragma("unroll") for (int n = 0; n < 2; ++n) _Pragma("unroll") for (int k = 0; k < 2; ++k) dst[n][k] = *(const PG8_LAS bf16x8*)(lds + PG8_SB(b, h) + boff + n * 2048 + k * 1024); } while (0)
#define PG8_MMA(ai, bj, At, Bt) do { __builtin_amdgcn_s_setprio(1); _Pragma("unroll") for (int m = 0; m < 4; ++m) _Pragma("unroll") for (int n = 0; n < 2; ++n) _Pragma("unroll") for (int k = 0; k < 2; ++k) \
        acc[ai][bj][m][n] = __builtin_amdgcn_mfma_f32_16x16x32_bf16(Bt[n][k], At[m][k], acc[ai][bj][m][n], 0, 0, 0); __builtin_amdgcn_s_setprio(0); } while (0)
#define PG8_WAIT_V(n) asm volatile("s_waitcnt vmcnt(" #n ")" ::: "memory")
#define PG8_WAIT_L(n) asm volatile("s_waitcnt lgkmcnt(" #n ")" ::: "memory")
#define PG8_BAR __builtin_amdgcn_s_barrier()
#define PG8_SCHED __builtin_amdgcn_sched_barrier(0)
    Unit cur, nxt; int ui = 0;
    if (!S.next(0, cur)) return;
    f32x4 acc[2][2][4][2];
#pragma unroll
    for (int a = 0; a < 2; ++a)
#pragma unroll
        for (int b = 0; b < 2; ++b)
#pragma unroll
            for (int m = 0; m < 4; ++m)
#pragma unroll
                for (int n = 0; n < 2; ++n) acc[a][b][m][n] = (f32x4){0.f, 0.f, 0.f, 0.f};
    bf16x8 At[4][2], B0[2][2], B1[2][2];
    const char* cA = (const char*)g.A + (size_t)cur.pm * tstep; const char* cB = (const char*)g.Bt + (size_t)cur.pn * tstep;
    S.a_ready(cur);
    if constexpr (SP2) {
        PG8_STAGE(PG8_SB(0, 0), cB, voffB); PG8_STAGE(PG8_SB(0, 1), cB + hstepB, voffB); PG8_STAGE(PG8_SA(0, 0), cA, voffA); PG8_STAGE(PG8_SA(0, 1), cA + hstep, voffA);
        if (wr == 1) PG8_BAR;
        PG8_WAIT_V(2); PG8_BAR;
        PG8_STAGE(PG8_SB(1, 0), cB + kstep, voffB); PG8_STAGE(PG8_SA(1, 0), cA + kstep, voffA); PG8_STAGE(PG8_SB(1, 1), cB + hstepB + kstep, voffB);
        PG8_WAIT_V(6); PG8_BAR;
    } else {
        PG8_STAGE(PG8_SB(0, 0), cB, voffB); PG8_STAGE(PG8_SA(0, 0), cA, voffA); PG8_STAGE(PG8_SB(0, 1), cB + hstepB, voffB); PG8_STAGE(PG8_SA(0, 1), cA + hstep, voffA);
        if (wr == 1) PG8_BAR;
        PG8_WAIT_V(4); PG8_BAR;
        PG8_STAGE(PG8_SB(1, 0), cB + kstep, voffB); PG8_STAGE(PG8_SA(1, 0), cA + kstep, voffA); PG8_STAGE(PG8_SB(1, 1), cB + hstepB + kstep, voffB);
        PG8_WAIT_V(6); PG8_BAR;
    }
    for (;;) {
        const bool has_next = S.next(ui + 1, nxt);
        const char* nA = has_next ? (const char*)g.A + (size_t)nxt.pm * tstep : cA; const char* nB = has_next ? (const char*)g.Bt + (size_t)nxt.pn * tstep : cB;
        for (int t = 0; t < nt; t += 2) {
            if constexpr (Epi::MIDK) { if (t == (nt >> 1)) E.mid(acc, cur, wr, wc, fr, fq); }
            const bool last = (t == nt - 2);
            const char* a1 = cA + (size_t)(t + 1) * kstep;
            const char* a2 = last ? nA : cA + (size_t)(t + 2) * kstep; const char* b2 = last ? nB : cB + (size_t)(t + 2) * kstep;
            const char* a3 = a2 + kstep; const char* b3 = b2 + kstep;
            if (last && has_next) S.a_ready(nxt);
            if constexpr (SP2) {
            PG8_LDB(B0, 0, 0); PG8_LDB(B1, 0, 1); PG8_SCHED; PG8_LDA(At, 0, 0); PG8_STAGE(PG8_SA(1, 1), a1 + hstep, voffA);
            PG8_WAIT_V(8); PG8_WAIT_L(0); PG8_BAR; PG8_MMA(0, 0, At, B0); PG8_MMA(0, 1, At, B1); PG8_BAR; PG8_SCHED;
            PG8_LDA(At, 0, 1); PG8_STAGE(PG8_SB(0, 0), b2, voffB); PG8_STAGE(PG8_SB(0, 1), b2 + hstepB, voffB); PG8_STAGE(PG8_SA(0, 0), a2, voffA);
            PG8_WAIT_V(8); PG8_WAIT_L(0); PG8_BAR; PG8_MMA(1, 0, At, B0); PG8_MMA(1, 1, At, B1); PG8_BAR; PG8_SCHED;
            PG8_LDB(B0, 1, 0); PG8_LDB(B1, 1, 1); PG8_SCHED; PG8_LDA(At, 1, 0); PG8_STAGE(PG8_SA(0, 1), a2 + hstep, voffA);
            PG8_WAIT_V(8); PG8_WAIT_L(0); PG8_BAR; PG8_MMA(0, 0, At, B0); PG8_MMA(0, 1, At, B1); PG8_BAR; PG8_SCHED;
            PG8_LDA(At, 1, 1); PG8_STAGE(PG8_SB(1, 0), b3, voffB); PG8_STAGE(PG8_SB(1, 1), b3 + hstepB, voffB); PG8_STAGE(PG8_SA(1, 0), a3, voffA);
            PG8_WAIT_V(8); PG8_WAIT_L(0); PG8_BAR; PG8_MMA(1, 0, At, B0); PG8_MMA(1, 1, At, B1); PG8_BAR; PG8_SCHED;
            } else {
            PG8_LDB(B0, 0, 0); PG8_SCHED; PG8_LDA(At, 0, 0); PG8_STAGE(PG8_SA(1, 1), a1 + hstep, voffA);
            PG8_WAIT_L(8); PG8_BAR; PG8_WAIT_L(0); PG8_MMA(0, 0, At, B0); PG8_BAR; PG8_SCHED;
            PG8_LDB(B1, 0, 1); PG8_STAGE(PG8_SB(0, 0), b2, voffB);
            PG8_BAR; PG8_WAIT_L(0); PG8_MMA(0, 1, At, B1); PG8_BAR;
            PG8_LDA(At, 0, 1); PG8_STAGE(PG8_SA(0, 0), a2, voffA);
            PG8_BAR; PG8_WAIT_L(0); PG8_MMA(1, 0, At, B0); PG8_BAR; PG8_SCHED;
            PG8_STAGE(PG8_SB(0, 1), b2 + hstepB, voffB);
            PG8_WAIT_V(6); PG8_BAR; PG8_MMA(1, 1, At, B1); PG8_BAR;
            PG8_LDB(B0, 1, 0); PG8_SCHED; PG8_LDA(At, 1, 0); PG8_STAGE(PG8_SA(0, 1), a2 + hstep, voffA);
            PG8_WAIT_L(8); PG8_BAR; PG8_WAIT_L(0); PG8_MMA(0, 0, At, B0); PG8_BAR; PG8_SCHED;
            PG8_LDB(B1, 1, 1); PG8_STAGE(PG8_SB(1, 0), b3, voffB);
            PG8_BAR; PG8_WAIT_L(0); PG8_MMA(0, 1, At, B1); PG8_BAR;
            PG8_LDA(At, 1, 1); PG8_STAGE(PG8_SA(1, 0), a3, voffA);
            PG8_BAR; PG8_WAIT_L(0); PG8_MMA(1, 0, At, B0); PG8_BAR; PG8_SCHED;
            PG8_STAGE(PG8_SB(1, 1), b3 + hstepB, voffB);
            PG8_WAIT_V(6); PG8_BAR; PG8_MMA(1, 1, At, B1); PG8_BAR;
            }
        }
        if constexpr (ALIGN_EPI) { if (wr == 0) PG8_BAR; }
        if constexpr (!Epi::AFTER_DRAIN) { E(acc, cur, wr, wc, fr, fq); S.done(cur); }
        if (!has_next) break;
#pragma unroll
        for (int a = 0; a < 2; ++a)
#pragma unroll
            for (int b = 0; b < 2; ++b)
#pragma unroll
                for (int m = 0; m < 4; ++m)
#pragma unroll
                    for (int n = 0; n < 2; ++n) acc[a][b][m][n] = (f32x4){0.f, 0.f, 0.f, 0.f};
        cur = nxt; cA = nA; cB = nB; ++ui;
        if constexpr (ALIGN_EPI) { if (wr == 1) PG8_BAR; }
    }
    PG8_WAIT_V(0);
    if constexpr (!ALIGN_EPI) { if (wr == 0) PG8_BAR; }
    PG8_BAR;
    if constexpr (Epi::AFTER_DRAIN) { E.fused(acc, cur, wr, wc, fr, fq, lds, wid, lane); S.done(cur); }
#undef PG8_SA
#undef PG8_SB
#undef PG8_STAGE
#undef PG8_LDA
#undef PG8_LDB
#undef PG8_MMA
#undef PG8_WAIT_V
#undef PG8_WAIT_L
#undef PG8_BAR
#undef PG8_SCHED
}
}

#define GAS __attribute__((address_space(1)))
#define LAS __attribute__((address_space(3)))
typedef unsigned short bf16;
typedef unsigned v4u __attribute__((ext_vector_type(4)));
typedef unsigned v2u __attribute__((ext_vector_type(2)));
typedef float f32x4 __attribute__((ext_vector_type(4)));
using pg8::bf_lo; using pg8::bf_hi; using pg8::sigm;

constexpr int NTOK = 32768, SEQ = 16384, DM = 1024, NW = 8;
constexpr float EPS = 1e-6f;
constexpr float C2 = 0.125f * 1.4426950408889634f;
constexpr size_t MiB = 1u << 20;
constexpr size_t WS_W1T = 1 * MiB, WS_WAT = 12 * MiB, WS_WMT = 13 * MiB, WS_WOT = 14 * MiB, WS_WQT = 16 * MiB, WS_WGT = 20 * MiB, WS_WPT = 22 * MiB;
constexpr size_t WS_K1B = 22 * MiB + 512 * 1024, WS_K2B = 22 * MiB + 768 * 1024, WS_IF = 23 * MiB, WS_UB = 24 * MiB, WS_VB = 56 * MiB;
constexpr size_t WS_XN = 88 * MiB, WS_YA = 88 * MiB, WS_YM = 120 * MiB, WS_HN = 88 * MiB;
constexpr size_t WS_QKVA = 152 * MiB, WS_QKM = 248 * MiB, WS_VM = 312 * MiB, WS_OM = 344 * MiB, WS_G = 376 * MiB;
constexpr size_t WS_DN = 504 * MiB, WS_NS = 505 * MiB, WS_SC = 506 * MiB;
constexpr size_t WS_MERGED = 152 * MiB, WS_TMP = 216 * MiB, WS_Q2 = 376 * MiB, WS_IDX = 152 * MiB, WS_GATE = 168 * MiB, WS_HN2 = 184 * MiB, WS_PB = 56 * MiB, WS_E = 264 * MiB;
constexpr size_t WS_NEED = 507 * MiB;
constexpr size_t WS_U8 = 24 * MiB, WS_V8 = 40 * MiB, WS_PART = 376 * MiB, WS_SSQ = 506 * MiB + 512 * 1024;
constexpr size_t WS_HQH = 280 * MiB, WS_HQL = 296 * MiB, WS_HS = 312 * MiB;
constexpr size_t WS_U4 = 24 * MiB, WS_V4 = 32 * MiB, WS_SU = 40 * MiB, WS_SV = 40 * MiB + 65536;
constexpr size_t WS_SSQ1 = 506 * MiB + 768 * 1024, WS_BAR = 0, BAR_BYTES = 32768;
constexpr size_t OUT_DC = 0, OUT_CS = 64 * MiB;
constexpr int LDS_BYTES = 151552;

__device__ __forceinline__ unsigned f2bf(float f) { unsigned u = __float_as_uint(f); return (u + 0x7fffu + ((u >> 16) & 1u)) >> 16; }
__device__ __forceinline__ unsigned pk2(float lo, float hi) { return f2bf(lo) | (f2bf(hi) << 16); }
__device__ __forceinline__ float bf2f(bf16 b) { return __uint_as_float((unsigned)b << 16); }
__device__ __forceinline__ float wave_sum(float v) {
#pragma unroll
    for (int o = 1; o < 64; o <<= 1) v += __shfl_xor(v, o);
    return v;
}
__device__ __forceinline__ float wave_max(float v) {
#pragma unroll
    for (int o = 1; o < 64; o <<= 1) v = fmaxf(v, __shfl_xor(v, o));
    return v;
}
__device__ __forceinline__ void unpk8(const v4u w, float* f) { f[0] = bf_lo(w.x); f[1] = bf_hi(w.x); f[2] = bf_lo(w.y); f[3] = bf_hi(w.y); f[4] = bf_lo(w.z); f[5] = bf_hi(w.z); f[6] = bf_lo(w.w); f[7] = bf_hi(w.w); }
__device__ __forceinline__ v4u pk8(const float* f) { v4u w; w.x = pk2(f[0], f[1]); w.y = pk2(f[2], f[3]); w.z = pk2(f[4], f[5]); w.w = pk2(f[6], f[7]); return w; }
typedef __bf16 bf16x2_t __attribute__((ext_vector_type(2)));
__device__ __forceinline__ float dot2bf(unsigned a, unsigned b, float c) { return __builtin_amdgcn_fdot2_f32_bf16(__builtin_bit_cast(bf16x2_t, a), __builtin_bit_cast(bf16x2_t, b), c, false); }
__device__ __forceinline__ float logsigmoid(float x) { return fminf(x, 0.f) - log1pf(__expf(-fabsf(x))); }
__device__ __forceinline__ float silu(float x) { return x / (1.0f + __expf(-x)); }

#define XB_TMO      128
#define XB_XCNT(j)  (256  + 64 * (j))
#define XB_XSUB(j)  (1280 + 64 * (j))
#define XB_XGEN(j)  (2304 + 64 * (j))
#define XB_TOP      3328
#define XB_TOPGEN   3392
#define XCD_BAR_WORDS 3456
#define XB_SPIN_CAP (1u << 18)

__device__ __forceinline__ unsigned xb_ld(unsigned* p)              { return __hip_atomic_load(p, __ATOMIC_RELAXED, __HIP_MEMORY_SCOPE_AGENT); }
__device__ __forceinline__ unsigned xb_add(unsigned* p, unsigned v) { return __hip_atomic_fetch_add(p, v, __ATOMIC_RELAXED, __HIP_MEMORY_SCOPE_AGENT); }
__device__ __forceinline__ unsigned xb_xcc_id() { return (unsigned)__builtin_amdgcn_s_getreg((3 << 11) | 20) & 0xFu; }
#define XB_SPIN(cond, bar) do { unsigned _sp = 0; while (cond) { __builtin_amdgcn_s_sleep(1); \
    if ((++_sp & 255u) == 0u) { if (xb_ld(&(bar)[XB_TMO])) break; if (_sp > XB_SPIN_CAP) { atomicAdd(&(bar)[XB_TMO], 1u); break; } } } } while (0)

struct XcdBarrier {
    unsigned* bar; unsigned x;
    volatile LAS unsigned* st;
};

__device__ __forceinline__ XcdBarrier xcd_barrier_post(unsigned* bar, volatile LAS unsigned* st) {
    XcdBarrier b; b.bar = bar; b.x = xb_xcc_id(); b.st = st;
    if (threadIdx.x == 0) (void)xb_add(&bar[XB_XCNT(b.x)], 1u);
    return b;
}
__device__ __forceinline__ void xcd_barrier_complete(unsigned* bar, unsigned x, unsigned& nloc, unsigned& nx) {
    const unsigned G = gridDim.x * gridDim.y * gridDim.z;
    unsigned sum, cnt, mine, sp = 0u;
    for (;;) {
        sum = 0u; cnt = 0u; mine = 0u;
#pragma unroll
        for (unsigned j = 0; j < 16; ++j) { const unsigned c = xb_ld(&bar[XB_XCNT(j)]); sum += c; cnt += (c > 0u) ? 1u : 0u; mine = (j == x) ? c : mine; }
        if (sum == G) break;
        __builtin_amdgcn_s_sleep(1);
        if ((++sp & 255u) == 0u) { if (xb_ld(&bar[XB_TMO])) break; if (sp > XB_SPIN_CAP) { atomicAdd(&bar[XB_TMO], 1u); break; } }
    }
    nloc = mine > 0u ? mine : 1u; nx = cnt > 0u ? cnt : 1u;
}

__device__ __forceinline__ void xcd_barrier(const XcdBarrier& b) {
    asm volatile("s_waitcnt vmcnt(0)" ::: "memory");
    __syncthreads();
    if (threadIdx.x == 0) {
        unsigned* bar = b.bar;
        __builtin_amdgcn_s_waitcnt(0);
        unsigned nloc = b.st[0], nx = b.st[1];
        if (nloc == 0u) { xcd_barrier_complete(bar, b.x, nloc, nx); b.st[0] = nloc; b.st[1] = nx; }
        const unsigned old = xb_add(&bar[XB_XSUB(b.x)], 1u);
        const unsigned gen = old / nloc;
        if (old + 1u == (gen + 1u) * nloc) {
            __builtin_amdgcn_fence(__ATOMIC_RELEASE, "agent");
            asm volatile("s_waitcnt vmcnt(0)" ::: "memory");
            const unsigned og = xb_add(&bar[XB_TOP], 1u);
            const unsigned tg = og / nx;
            if (og + 1u == (tg + 1u) * nx) xb_add(&bar[XB_TOPGEN], 1u);
            else XB_SPIN(xb_ld(&bar[XB_TOPGEN]) == tg, bar);
            __builtin_amdgcn_fence(__ATOMIC_ACQUIRE, "agent");
            xb_add(&bar[XB_XGEN(b.x)], 1u);
            asm volatile("s_waitcnt vmcnt(0)" ::: "memory");
        } else {
            XB_SPIN(xb_ld(&bar[XB_XGEN(b.x)]) == gen, bar);
            __builtin_amdgcn_fence(__ATOMIC_ACQUIRE, "agent");
            asm volatile("s_waitcnt vmcnt(0)" ::: "memory");
        }
    }
    __syncthreads();
}


struct Params { const float* in[20]; float* out; unsigned char* ws; int ph_lo, ph_hi; };

__device__ __forceinline__ void transpose_item(const float* W, int ldw, int col0, int K, bf16* WT, int row0, LAS float* scr, int item, int nblk, int lane, int koff = 0) {
    const int kb = item / nblk, nb = item % nblk, k0 = 64 * kb, n0 = 32 * nb;
#pragma unroll 8
    for (int i = 0; i < 32; ++i) { const int kk = 2 * i + (lane >> 5); scr[kk * 33 + (lane & 31)] = W[(size_t)(k0 + kk) * ldw + col0 + n0 + (lane & 31)]; }
    asm volatile("s_waitcnt lgkmcnt(0)" ::: "memory");
    const int c = lane & 7;
#pragma unroll
    for (int j = 0; j < 4; ++j) { const int n = (lane >> 3) + 8 * j; const LAS float* s = scr + (8 * c) * 33 + n;
        v4u o; o.x = pk2(s[0 * 33], s[1 * 33]); o.y = pk2(s[2 * 33], s[3 * 33]); o.z = pk2(s[4 * 33], s[5 * 33]); o.w = pk2(s[6 * 33], s[7 * 33]);
        *(v4u*)(WT + (size_t)(row0 + n0 + n) * K + koff + k0 + 8 * c) = o; }
    asm volatile("s_waitcnt lgkmcnt(0)" ::: "memory");
}
__device__ __forceinline__ void cvt_f32_bf16(const float* src, bf16* dst, size_t n4, size_t gtid, size_t gsz) {
    for (size_t i = gtid; i < n4; i += gsz) { const f32x4 v = ((const f32x4*)src)[i]; uint2 o; o.x = pk2(v[0], v[1]); o.y = pk2(v[2], v[3]); ((uint2*)dst)[i] = o; }
}
__device__ __forceinline__ void cvt_f32_fp8(const float* src, unsigned* dst, size_t n4, float sc, size_t gtid, size_t gsz) {
    for (size_t i = gtid; i < n4; i += gsz) { const f32x4 v = ((const f32x4*)src)[i]; int w = __builtin_amdgcn_cvt_pk_fp8_f32(v[0] * sc, v[1] * sc, 0, false); w = __builtin_amdgcn_cvt_pk_fp8_f32(v[2] * sc, v[3] * sc, w, true); dst[i] = (unsigned)w; }
}
__device__ __forceinline__ void rms_row_to_bf16(const float* xrow, const float* gain, bf16* orow, int lane) {
    f32x4 v[4]; float s = 0.f;
#pragma unroll
    for (int j = 0; j < 4; ++j) { v[j] = ((const f32x4*)xrow)[lane + 64 * j]; s += (v[j][0] * v[j][0] + v[j][1] * v[j][1]) + (v[j][2] * v[j][2] + v[j][3] * v[j][3]); }
    const float rstd = rsqrtf(wave_sum(s) * (1.f / 1024.f) + EPS);
#pragma unroll
    for (int j = 0; j < 4; ++j) { const f32x4 g = ((const f32x4*)gain)[lane + 64 * j]; uint2 o; o.x = pk2(v[j][0] * rstd * g[0], v[j][1] * rstd * g[1]); o.y = pk2(v[j][2] * rstd * g[2], v[j][3] * rstd * g[3]); ((uint2*)orow)[lane + 64 * j] = o; }
}
__device__ __forceinline__ void p0_prologue(const Params& P, LAS unsigned char* lds, int tid, int lane, int wave) {
    unsigned char* ws = P.ws;
    const int gw = blockIdx.x * NW + wave, NGW = gridDim.x * NW;
    LAS float* scr = (LAS float*)(lds + wave * 8448);
    LAS float* wif = (LAS float*)(lds + 69632);
    const float* w_in = P.in[3];
    for (int i = tid; i < 8192; i += 512) wif[i] = w_in[(size_t)(i >> 3) * 5640 + 3584 + (i & 7)];
    __syncthreads();
    constexpr int I1A = 16 * 112, I1B = 16 * 64, IUP = 8 * 32, IOUT = 16 * 32, IQ = 16 * 64, IPL = 4 * 32;
    constexpr int NITEMS = I1A + I1B + 2 * IUP + IOUT + IQ + IOUT + IPL;
    for (int it = gw; it < NITEMS; it += NGW) {
        int r = it;
        if (r < I1A) { transpose_item(w_in, 5640, 0, 1024, (bf16*)(ws + WS_W1T), 0, scr, r, 112, lane); continue; } r -= I1A;
        if (r < I1B) { transpose_item(w_in, 5640, 3592, 1024, (bf16*)(ws + WS_W1T), 3584, scr, r, 64, lane); continue; } r -= I1B;
        if (r < IUP) { transpose_item(P.in[7], 1024, 0, 1024, (bf16*)(ws + WS_WAT), 0, scr, r, 32, lane, 0); continue; } r -= IUP;
        if (r < IUP) { transpose_item(P.in[8], 1024, 0, 1024, (bf16*)(ws + WS_WAT), 0, scr, r, 32, lane, 512); continue; } r -= IUP;
        if (r < IOUT) { transpose_item(P.in[9], 1024, 0, 1024, (bf16*)(ws + WS_WOT), 0, scr, r, 32, lane); continue; } r -= IOUT;
        if (r < IQ) { transpose_item(P.in[11], 2048, 0, 1024, (bf16*)(ws + WS_WQT), 0, scr, r, 64, lane); continue; } r -= IQ;
        if (r < IOUT) { transpose_item(P.in[17], 1024, 0, 1024, (bf16*)(ws + WS_WGT), 0, scr, r, 32, lane); continue; } r -= IOUT;
        transpose_item(P.in[18], 1024, 0, 256, (bf16*)(ws + WS_WPT), 0, scr, r, 32, lane);
    }
    const size_t gtid = (size_t)blockIdx.x * 512 + tid, gsz = (size_t)gridDim.x * 512;
    cvt_f32_bf16(P.in[12], (bf16*)(ws + WS_K1B), 8 * 128 * 128 / 4, gtid, gsz);
    cvt_f32_bf16(P.in[13], (bf16*)(ws + WS_K2B), 8 * 128 * 128 / 4, gtid, gsz);
    for (int rw = gw; rw < 2 * 16384; rw += NGW) {
        const int tb_ = rw >> 14, e = rw & 16383; const float* src = P.in[14 + tb_] + (size_t)e * 1024;
        f32x4 v[4]; v[0] = ((const f32x4*)src)[2 * lane]; v[1] = ((const f32x4*)src)[2 * lane + 1]; v[2] = ((const f32x4*)src)[128 + 2 * lane]; v[3] = ((const f32x4*)src)[128 + 2 * lane + 1];
        float mx = 0.f, sq = 0.f;
#pragma unroll
        for (int j = 0; j < 4; ++j)
#pragma unroll
            for (int i = 0; i < 4; ++i) { mx = fmaxf(mx, fabsf(v[j][i])); sq += v[j][i] * v[j][i]; }
        mx = wave_max(mx);
        unsigned w0 = 0u, w1 = 0u; float sc;
        if (tb_) {
            sc = mx > 0.f ? mx * (1.0f / 6.0f) : 1.0f; const float inv = 1.0f / sc;
            w0 = __builtin_amdgcn_cvt_scalef32_pk_fp4_f32(w0, v[0][0] * inv, v[0][1] * inv, 1.0f, 0); w0 = __builtin_amdgcn_cvt_scalef32_pk_fp4_f32(w0, v[0][2] * inv, v[0][3] * inv, 1.0f, 1);
            w0 = __builtin_amdgcn_cvt_scalef32_pk_fp4_f32(w0, v[1][0] * inv, v[1][1] * inv, 1.0f, 2); w0 = __builtin_amdgcn_cvt_scalef32_pk_fp4_f32(w0, v[1][2] * inv, v[1][3] * inv, 1.0f, 3);
            w1 = __builtin_amdgcn_cvt_scalef32_pk_fp4_f32(w1, v[2][0] * inv, v[2][1] * inv, 1.0f, 0); w1 = __builtin_amdgcn_cvt_scalef32_pk_fp4_f32(w1, v[2][2] * inv, v[2][3] * inv, 1.0f, 1);
            w1 = __builtin_amdgcn_cvt_scalef32_pk_fp4_f32(w1, v[3][0] * inv, v[3][1] * inv, 1.0f, 2); w1 = __builtin_amdgcn_cvt_scalef32_pk_fp4_f32(w1, v[3][2] * inv, v[3][3] * inv, 1.0f, 3);
        } else {
            const float rms = sqrtf(wave_sum(sq) * (1.0f / 1024.0f)); const float clip = fminf(mx, 2.8f * rms);
            sc = clip > 0.f ? clip * (1.0f / 7.0f) : 1.0f; const float inv = 1.0f / sc;
#pragma unroll
            for (int i = 0; i < 4; ++i) { const int q0 = (int)fminf(fmaxf(rintf(v[0][i] * inv), -7.f), 7.f), q1 = (int)fminf(fmaxf(rintf(v[1][i] * inv), -7.f), 7.f), q2 = (int)fminf(fmaxf(rintf(v[2][i] * inv), -7.f), 7.f), q3 = (int)fminf(fmaxf(rintf(v[3][i] * inv), -7.f), 7.f);
                w0 |= ((unsigned)q0 & 15u) << (4 * i); w0 |= ((unsigned)q1 & 15u) << (16 + 4 * i); w1 |= ((unsigned)q2 & 15u) << (4 * i); w1 |= ((unsigned)q3 & 15u) << (16 + 4 * i); }
        }
        unsigned* dst = (unsigned*)(ws + (tb_ ? WS_V4 : WS_U4)) + (size_t)e * 128;
        dst[lane] = w0; dst[64 + lane] = w1;
        if (lane == 0) ((float*)(ws + (tb_ ? WS_SV : WS_SU)))[e] = sc;
    }
    cvt_f32_bf16(P.in[1], (bf16*)(ws + WS_PB), (size_t)NTOK * 256 / 4, gtid, gsz);
    for (size_t i = gtid; i < (size_t)NTOK; i += gsz) { ((float*)(ws + WS_SSQ))[i] = 0.f; ((float*)(ws + WS_SSQ1))[i] = 0.f; }
    const float* x = P.in[0]; const float* gmix = P.in[2]; const float* gbias = P.in[5];
    bf16* XN = (bf16*)(ws + WS_XN); float* IFb = (float*)(ws + WS_IF);
    for (int m = gw; m < NTOK; m += NGW) {
        const float* xrow = x + (size_t)m * 1024;
        f32x4 v[4];
#pragma unroll
        for (int j = 0; j < 4; ++j) v[j] = ((const f32x4*)xrow)[lane + 64 * j];
        float a16[16];
#pragma unroll
        for (int i = 0; i < 16; ++i) a16[i] = 0.f;
#pragma unroll
        for (int j = 0; j < 4; ++j) {
            const f32x4 g = ((const f32x4*)gmix)[lane + 64 * j];
#pragma unroll
            for (int i = 0; i < 4; ++i) { a16[0] += v[j][i] * v[j][i]; v[j][i] *= g[i]; const int d = 4 * (lane + 64 * j) + i; const f32x4 wa = *(const LAS f32x4*)(wif + d * 8), wb = *(const LAS f32x4*)(wif + d * 8 + 4);
                a16[1] += v[j][i] * wa[0]; a16[2] += v[j][i] * wa[1]; a16[3] += v[j][i] * wa[2]; a16[4] += v[j][i] * wa[3]; a16[5] += v[j][i] * wb[0]; a16[6] += v[j][i] * wb[1]; a16[7] += v[j][i] * wb[2]; a16[8] += v[j][i] * wb[3]; }
        }
        float r8[8], r4[4], r2[2], r1;
        { const bool b = lane & 32;
#pragma unroll
          for (int i = 0; i < 8; ++i) { const float keep = b ? a16[8 + i] : a16[i], send = b ? a16[i] : a16[8 + i]; r8[i] = keep + __shfl_xor(send, 32); } }
        { const bool b = lane & 16;
#pragma unroll
          for (int i = 0; i < 4; ++i) { const float keep = b ? r8[4 + i] : r8[i], send = b ? r8[i] : r8[4 + i]; r4[i] = keep + __shfl_xor(send, 16); } }
        { const bool b = lane & 8;
#pragma unroll
          for (int i = 0; i < 2; ++i) { const float keep = b ? r4[2 + i] : r4[i], send = b ? r4[i] : r4[2 + i]; r2[i] = keep + __shfl_xor(send, 8); } }
        { const bool b = lane & 4; const float keep = b ? r2[1] : r2[0], send = b ? r2[0] : r2[1]; r1 = keep + __shfl_xor(send, 4); }
        r1 += __shfl_xor(r1, 2); r1 += __shfl_xor(r1, 1);
        const float rstd = rsqrtf(__shfl(r1, 0) * (1.f / 1024.f) + EPS);
#pragma unroll
        for (int j = 0; j < 4; ++j) { uint2 o; o.x = pk2(v[j][0] * rstd, v[j][1] * rstd); o.y = pk2(v[j][2] * rstd, v[j][3] * rstd); ((uint2*)(XN + (size_t)m * 1024))[lane + 64 * j] = o; }
        const int which = ((lane >> 5) & 1) * 8 + ((lane >> 4) & 1) * 4 + ((lane >> 3) & 1) * 2 + ((lane >> 2) & 1);
        if ((lane & 3) == 0 && which >= 1 && which <= 8) IFb[(size_t)m * 8 + which - 1] = r1 * rstd + gbias[which - 1];
    }
}

typedef short bf16x8 __attribute__((ext_vector_type(8)));
typedef short v4i16 __attribute__((ext_vector_type(4)));
#define MFMA16(a, b, c) __builtin_amdgcn_mfma_f32_16x16x32_bf16((a), (b), (c), 0, 0, 0)
__device__ __forceinline__ void attn_pair_params(int pp, int& d, int& n0, int& sh) {
    if (pp < 5) { d = 16; sh = 4; n0 = -144 + 32 * pp; } else if (pp < 11) { d = 4; sh = 2; n0 = -128 + 32 * (pp - 5); } else { d = 1; sh = 0; n0 = -128 + 32 * (pp - 11); }
}
template <int MODE> __device__ __forceinline__ void attn_unit_params(int pp, int& d, int& n0, int& sh) {
    if (MODE == 0) { d = 1; sh = 0; n0 = -144 + 32 * pp; }
    else if (pp < 5) { d = 16; sh = 4; n0 = -144 + 32 * pp; } else { d = 4; sh = 2; n0 = -128 + 32 * (pp - 5); }
}
#define ATT_LOAD(SET, PPX) do { if ((PPX) < NP) { int d_, n_, sh_; attn_unit_params<MODE>((PPX), d_, n_, sh_); \
    _Pragma("unroll") for (int c = 0; c < 4; ++c) { int tok = t0 + d_ * (n_ + 8 * c + lrow); tok = min(max(tok, 0), SEQ - 1); const bf16* rp = base + 512 + (size_t)tok * 1536 + 8 * lch; \
        kr[SET][c] = *(const v4u*)rp; vr[SET][c] = *(const v4u*)(rp + 512); } } } while (0)
template <int MODE> __device__ __forceinline__ void attn_unit(const bf16* base, bf16* yrow0, int t0, int xidx, LAS float* partl, LAS unsigned char* kbuf, LAS unsigned char* vbuf, int lane) {
    constexpr int NP = MODE == 0 ? 5 : 11, NPAD = MODE == 0 ? 8 : 12;
    const int r = lane & 15, g = lane >> 4, lrow = lane >> 3, lch = lane & 7;
    const int trq = (lane >> 2) & 3, trp = lane & 3, tr_off = (4 * g + trq) * 160 + trp * 8;
    const int tq = MODE == 0 ? t0 + r : t0 + 16 * r;
    const bf16x8 qb0 = *(const bf16x8*)(base + (size_t)tq * 1536 + 8 * g), qb1 = *(const bf16x8*)(base + (size_t)tq * 1536 + 32 + 8 * g);
    f32x4 o[4]; float m, l;
    LAS float* xrow = partl + (MODE == 0 ? xidx + r : xidx + 16 * r) * 68;
    if (MODE == 0) {
#pragma unroll
        for (int i = 0; i < 4; ++i) o[i] = (f32x4){0.f, 0.f, 0.f, 0.f};
        m = -1e30f; l = 0.f;
    } else {
#pragma unroll
        for (int i = 0; i < 4; ++i) o[i] = *(const LAS f32x4*)(xrow + 16 * i + 4 * g);
        m = xrow[64]; l = g == 0 ? xrow[65] : 0.f;
    }
    v4u kr[4][4], vr[4][4];
    ATT_LOAD(0, 0); ATT_LOAD(1, 1); ATT_LOAD(2, 2); ATT_LOAD(3, 3);
#pragma unroll 1
    for (int pp0 = 0; pp0 < NPAD; pp0 += 4) {
#pragma unroll
        for (int u = 0; u < 4; ++u) {
            const int pp = pp0 + u;
            if (pp < NP) {
                int d, n0, sh; attn_unit_params<MODE>(pp, d, n0, sh);
                const int hi = MODE == 0 ? r : (r << (4 - sh)), lo = max(hi - 128, -(t0 >> sh));
                const int mbase = n0 + 4 * g - lo; const unsigned mspan = (unsigned)(hi - lo);
#pragma unroll
                for (int c = 0; c < 4; ++c) { *(LAS v4u*)(kbuf + (8 * c + lrow) * 144 + lch * 16) = kr[u][c]; *(LAS v4u*)(vbuf + (8 * c + lrow) * 160 + lch * 16) = vr[u][c]; }
                ATT_LOAD(u, pp + 4);
                f32x4 s0 = {0.f, 0.f, 0.f, 0.f}, s1 = {0.f, 0.f, 0.f, 0.f};
                { const bf16x8 k00 = *(const LAS bf16x8*)(kbuf + r * 144 + g * 16), k01 = *(const LAS bf16x8*)(kbuf + r * 144 + 64 + g * 16);
                  const bf16x8 k10 = *(const LAS bf16x8*)(kbuf + (16 + r) * 144 + g * 16), k11 = *(const LAS bf16x8*)(kbuf + (16 + r) * 144 + 64 + g * 16);
                  s0 = MFMA16(k00, qb0, s0); s0 = MFMA16(k01, qb1, s0); s1 = MFMA16(k10, qb0, s1); s1 = MFMA16(k11, qb1, s1); }
                float mx = -INFINITY;
#pragma unroll
                for (int k = 0; k < 4; ++k) { s0[k] = ((unsigned)(mbase + k) <= mspan) ? s0[k] : -INFINITY; s1[k] = ((unsigned)(mbase + 16 + k) <= mspan) ? s1[k] : -INFINITY; mx = fmaxf(mx, fmaxf(s0[k], s1[k])); }
                mx = fmaxf(mx, __shfl_xor(mx, 16)); mx = fmaxf(mx, __shfl_xor(mx, 32));
                if (__any(mx > m)) {
                    const float mn = fmaxf(m, mx), alpha = __builtin_amdgcn_exp2f(m - mn); m = mn; l *= alpha;
#pragma unroll
                    for (int i = 0; i < 4; ++i) o[i] = o[i] * alpha;
                }
                float p0[4], p1[4], ps = 0.f;
#pragma unroll
                for (int k = 0; k < 4; ++k) { p0[k] = __builtin_amdgcn_exp2f(s0[k] - m); p1[k] = __builtin_amdgcn_exp2f(s1[k] - m); ps += p0[k] + p1[k]; }
                l += ps;
                bf16x8 pb; { v4u w; w.x = pg8::cvt_pk_bf16(p0[0], p0[1]); w.y = pg8::cvt_pk_bf16(p0[2], p0[3]); w.z = pg8::cvt_pk_bf16(p1[0], p1[1]); w.w = pg8::cvt_pk_bf16(p1[2], p1[3]); pb = __builtin_bit_cast(bf16x8, w); }
                LAS unsigned char* vrd = vbuf + tr_off;
#pragma unroll
                for (int db = 0; db < 4; ++db) {
                    const v4i16 a0 = __builtin_amdgcn_ds_read_tr16_b64_v4i16((LAS v4i16*)(vrd + db * 32)), a1 = __builtin_amdgcn_ds_read_tr16_b64_v4i16((LAS v4i16*)(vrd + 16 * 160 + db * 32));
                    const bf16x8 va = __builtin_shufflevector(a0, a1, 0, 1, 2, 3, 4, 5, 6, 7);
                    o[db] = MFMA16(va, pb, o[db]);
                }
            }
        }
    }
    l += __shfl_xor(l, 16); l += __shfl_xor(l, 32);
    if (MODE == 0) {
#pragma unroll
        for (int i = 0; i < 4; ++i) *(LAS f32x4*)(xrow + 16 * i + 4 * g) = o[i];
        if (g == 0) { xrow[64] = m; xrow[65] = l; }
    } else {
        const float inv = 1.0f / l;
        bf16* yo = yrow0 + (size_t)tq * 1024 + 4 * g;
#pragma unroll
        for (int db = 0; db < 4; ++db) { uint2 w; w.x = pk2(o[db][0] * inv, o[db][1] * inv); w.y = pk2(o[db][2] * inv, o[db][3] * inv); *(uint2*)(yo + 16 * db) = w; }
    }
}
__device__ __forceinline__ void p2_attention(const Params& P, LAS unsigned char* lds, int lane, int wave, int vb) {
    const bf16* QKVA = (const bf16*)(P.ws + WS_QKVA); bf16* YA = (bf16*)(P.ws + WS_YA);
    LAS unsigned char* kbuf = lds + wave * 9728;
    LAS unsigned char* vbuf = kbuf + 4608;
    LAS float* partl = (LAS float*)(lds + 8 * 9728);
    for (int wi = vb; wi < 1024; wi += gridDim.x) {
        const int bh = wi >> 6, tb = wi & 63, b = bh >> 3, h = bh & 7;
        const bf16* base = QKVA + (size_t)b * SEQ * 1536 + h * 64;
        bf16* yrow0 = YA + (size_t)b * SEQ * 1024 + h * 64;
#pragma unroll 1
        for (int uu = 0; uu < 2; ++uu) { const int cu = wave * 2 + uu; attn_unit<0>(base, yrow0, tb * 256 + 16 * cu, 16 * cu, partl, kbuf, vbuf, lane); }
        __syncthreads();
#pragma unroll 1
        for (int uu = 0; uu < 2; ++uu) { const int rr = wave * 2 + uu; attn_unit<1>(base, yrow0, tb * 256 + rr, rr, partl, kbuf, vbuf, lane); }
        __syncthreads();
    }
}

__device__ __forceinline__ float conv_silu(const bf16* QKM, const float* cw, int b, int t, int ch) {
    float a = 0.f;
#pragma unroll
    for (int j = 0; j < 4; ++j) { const int tt = t - 3 + j; if (tt >= 0) a += cw[j * 1024 + ch] * bf2f(QKM[((size_t)b * SEQ + tt) * 1024 + ch]); }
    return silu(a);
}

__device__ __forceinline__ float scan_add(float v, int lane) {
#pragma unroll
    for (int o = 1; o < 64; o <<= 1) { const float u = __shfl_up(v, o); if (lane >= o) v += u; }
    return v;
}
__device__ __forceinline__ float scan_max(float v, int lane) {
#pragma unroll
    for (int o = 1; o < 64; o <<= 1) { const float u = __shfl_up(v, o); if (lane >= o) v = fmaxf(v, u); }
    return v;
}
__device__ __forceinline__ void conv16(const bf16* QKM, const float* cw, int b, int t0, int chan, float* out) {
    const bf16* src = QKM + (size_t)b * SEQ * 1024 + chan;
    const float w0 = cw[chan], w1 = cw[1024 + chan], w2 = cw[2048 + chan], w3 = cw[3072 + chan];
    float x0 = t0 >= 3 ? bf2f(src[(size_t)(t0 - 3) * 1024]) : 0.f, x1 = t0 >= 2 ? bf2f(src[(size_t)(t0 - 2) * 1024]) : 0.f, x2 = t0 >= 1 ? bf2f(src[(size_t)(t0 - 1) * 1024]) : 0.f;
#pragma unroll
    for (int i = 0; i < 16; ++i) { const float x3 = bf2f(src[(size_t)(t0 + i) * 1024]); out[i] = silu(w0 * x0 + w1 * x1 + w2 * x2 + w3 * x3); x0 = x1; x1 = x2; x2 = x3; }
}

__device__ __forceinline__ void p2_mlstm_local(const Params& P, LAS unsigned char* lds, int tid, int lane, int wave, int vb) {
    const bf16* QKM = (const bf16*)(P.ws + WS_QKM); const bf16* VM = (const bf16*)(P.ws + WS_VM); const float* IFb = (const float*)(P.ws + WS_IF);
    const float* cw = P.in[4];
    bf16* DC = (bf16*)((unsigned char*)P.out + OUT_DC); float* DN = (float*)(P.ws + WS_DN); float* SC = (float*)(P.ws + WS_SC);
    LAS bf16* KWT = (LAS bf16*)lds; LAS bf16* VT = (LAS bf16*)(lds + 18432); LAS float* sw = (LAS float*)(lds + 36864);
    const int r = lane & 15, g = lane >> 4;
    for (int item = vb; item < 2048; item += gridDim.x) {
        const int bh = item >> 8, c = item & 255, b = bh >> 2, h = bh & 3;
        if (wave == 0) {
            const size_t row = (size_t)b * SEQ + c * 64 + lane;
            const float lf = logsigmoid(IFb[row * 8 + 4 + h]), ip = IFb[row * 8 + h];
            const float bc = scan_add(lf, lane), gg = __shfl(bc, 63), ds = gg - bc + ip, ml = wave_max(ds);
            sw[lane] = __expf(ds - ml);
            if (lane == 0) { SC[item] = ml; SC[2048 + item] = gg; }
        }
        __syncthreads();
        { const int ch = tid & 127, sq = tid >> 7, s0 = sq * 16; float o[16];
          conv16(QKM, cw, b, c * 64 + s0, 512 + h * 128 + ch, o);
#pragma unroll
          for (int i = 0; i < 16; i += 2) *(LAS unsigned*)(KWT + ch * 72 + s0 + i) = pk2(o[i] * 0.08838834764831845f * sw[s0 + i], o[i + 1] * 0.08838834764831845f * sw[s0 + i + 1]);
          const bf16* vsrc = VM + ((size_t)b * SEQ + c * 64 + s0) * 512 + h * 128 + ch;
#pragma unroll
          for (int i = 0; i < 16; i += 2) *(LAS unsigned*)(VT + ch * 72 + s0 + i) = (unsigned)vsrc[(size_t)i * 512] | ((unsigned)vsrc[(size_t)(i + 1) * 512] << 16);
        }
        __syncthreads();
        {
          const bf16x8 vb0 = *(const LAS bf16x8*)(VT + (16 * wave + r) * 72 + 8 * g), vb1 = *(const LAS bf16x8*)(VT + (16 * wave + r) * 72 + 32 + 8 * g);
          bf16* dst = DC + (size_t)item * 16384 + (size_t)(16 * wave + r) * 128 + 4 * g;
#pragma unroll
          for (int eb = 0; eb < 8; ++eb) {
              const bf16x8 ka0 = *(const LAS bf16x8*)(KWT + (16 * eb + r) * 72 + 8 * g), ka1 = *(const LAS bf16x8*)(KWT + (16 * eb + r) * 72 + 32 + 8 * g);
              f32x4 acc = {0.f, 0.f, 0.f, 0.f};
              acc = MFMA16(ka0, vb0, acc); acc = MFMA16(ka1, vb1, acc);
              uint2 o; o.x = pk2(acc[0], acc[1]); o.y = pk2(acc[2], acc[3]); *(uint2*)(dst + 16 * eb) = o;
          }
        }
        if (tid < 128) { float a = 0.f;
#pragma unroll
            for (int cc = 0; cc < 8; ++cc) { float f[8]; unpk8(*(const LAS v4u*)(KWT + tid * 72 + 8 * cc), f);
#pragma unroll
                for (int k = 0; k < 8; ++k) a += f[k]; }
            DN[(size_t)item * 128 + tid] = a; }
        __syncthreads();
    }
}

__device__ __forceinline__ void p3_mlstm_scan(const Params& P, int tid, int vb) {
    const unsigned* __restrict__ DC = (const unsigned*)((unsigned char*)P.out + OUT_DC); unsigned* __restrict__ CS = (unsigned*)((unsigned char*)P.out + OUT_CS);
    const float* __restrict__ DN = (const float*)(P.ws + WS_DN); float* __restrict__ NS = (float*)(P.ws + WS_NS); float* SC = (float*)(P.ws + WS_SC);
    for (int gid = vb * 512 + tid; gid < 8 * 8192; gid += gridDim.x * 512) {
        const int bh = gid >> 13, idx = gid & 8191; const bool hasn = idx < 64;
        float C0 = 0.f, C1 = 0.f, n0 = 0.f, n1 = 0.f, m = 0.f;
        for (int j0 = 0; j0 < 256; j0 += 8) {
            unsigned d[8]; float ml[8], gg[8]; float2 dn[8];
#pragma unroll
            for (int u = 0; u < 8; ++u) { const int item = bh * 256 + j0 + u; d[u] = DC[(size_t)item * 8192 + idx]; ml[u] = SC[item]; gg[u] = SC[2048 + item];
                dn[u] = hasn ? *(const float2*)(DN + (size_t)item * 128 + 2 * idx) : make_float2(0.f, 0.f); }
#pragma unroll
            for (int u = 0; u < 8; ++u) { const int item = bh * 256 + j0 + u;
                CS[(size_t)item * 8192 + idx] = pk2(C0, C1);
                if (hasn) *(float2*)(NS + (size_t)item * 128 + 2 * idx) = make_float2(n0, n1);
                if (idx == 0) SC[4096 + item] = m;
                const float mn = fmaxf(gg[u] + m, ml[u]), a = __expf(gg[u] + m - mn), bb = __expf(ml[u] - mn);
                C0 = a * C0 + bb * bf_lo(d[u]); C1 = a * C1 + bb * bf_hi(d[u]); n0 = a * n0 + bb * dn[u].x; n1 = a * n1 + bb * dn[u].y; m = mn; }
        }
    }
}

struct P4Pref { v4u raw[7]; v4u cs[4]; uint2 om[4]; f32x4 gn; float ifa, ifb, nsv; };
__device__ __forceinline__ void p4_prefetch_raw(P4Pref& pf, const Params& P, int item, int tid, int lane) {
    const bf16* QKM = (const bf16*)(P.ws + WS_QKM); const bf16* VM = (const bf16*)(P.ws + WS_VM); const float* IFb = (const float*)(P.ws + WS_IF); const float* NS = (const float*)(P.ws + WS_NS);
    const int bh = item >> 8, c = item & 255, b = bh >> 2, h = bh & 3;
#pragma unroll
    for (int i = 0; i < 7; ++i) { const int v = tid + 512 * i; const int rr = v / 48, rem = v - rr * 48, seg = rem >> 4, c16 = rem & 15; const int t = c * 64 + rr - 3;
        v4u val = {0u, 0u, 0u, 0u};
        if (v < 3216 && t >= 0) val = (seg < 2) ? *(const v4u*)(QKM + ((size_t)b * SEQ + t) * 1024 + seg * 512 + h * 128 + 8 * c16) : *(const v4u*)(VM + ((size_t)b * SEQ + t) * 512 + h * 128 + 8 * c16);
        pf.raw[i] = val; }
    const size_t row = (size_t)b * SEQ + c * 64 + lane;
    pf.ifa = IFb[row * 8 + 4 + h]; pf.ifb = IFb[row * 8 + h];
    pf.nsv = NS[(size_t)item * 128 + (tid & 127)];
}
__device__ __forceinline__ void p4_prefetch_cs(P4Pref& pf, const Params& P, int item, int lane, int wave) {
    const bf16* CS = (const bf16*)((unsigned char*)P.out + OUT_CS);
    const bf16* crow = CS + (size_t)item * 16384 + (size_t)(16 * wave + (lane & 15)) * 128 + 8 * (lane >> 4);
#pragma unroll
    for (int ks = 0; ks < 4; ++ks) pf.cs[ks] = *(const v4u*)(crow + 32 * ks);
}
__device__ __forceinline__ void p4_prefetch_om(P4Pref& pf, const Params& P, int item, int lane, int wave) {
    const bf16* OM = (const bf16*)(P.ws + WS_OM);
    const int bh = item >> 8, c = item & 255, b = bh >> 2, h = bh & 3, r = lane & 15, g = lane >> 4;
#pragma unroll
    for (int tb = 0; tb < 4; ++tb) pf.om[tb] = *(const uint2*)(OM + ((size_t)b * SEQ + c * 64 + 16 * tb + r) * 512 + h * 128 + 16 * wave + 4 * g);
    pf.gn = *(const f32x4*)(P.in[6] + h * 128 + 16 * wave + 4 * g);
}
__device__ __forceinline__ void p4_mlstm_out(const Params& P, LAS unsigned char* lds, int tid, int lane, int wave, int vb) {
    const float* cw = P.in[4]; const float* SC = (const float*)(P.ws + WS_SC); bf16* YM = (bf16*)(P.ws + WS_YA);
    LAS float* CW = (LAS float*)lds;
    LAS unsigned char* RAW = lds + 16384;
    LAS bf16* Qs = (LAS bf16*)(lds + 68912); LAS bf16* Ks = (LAS bf16*)(lds + 86320); LAS bf16* VT = (LAS bf16*)(lds + 103728); LAS bf16* PT = (LAS bf16*)(lds + 122160);
    LAS float* sm = (LAS float*)(lds + 131376);
    LAS bf16* NSB = (LAS bf16*)(lds + 135728);
    const int r = lane & 15, g = lane >> 4;
    for (int i = tid; i < 1024; i += 512) ((LAS f32x4*)CW)[i] = ((const f32x4*)cw)[i];
    P4Pref pf;
    if (vb < 2048) { p4_prefetch_raw(pf, P, vb, tid, lane); p4_prefetch_cs(pf, P, vb, lane, wave); p4_prefetch_om(pf, P, vb, lane, wave); }
    for (int item = vb; item < 2048; item += gridDim.x) {
        const int bh = item >> 8, c = item & 255, b = bh >> 2, h = bh & 3;
#pragma unroll
        for (int i = 0; i < 7; ++i) { const int v = tid + 512 * i; if (v < 3216) { const int rr = v / 48, rem = v - rr * 48; *(LAS v4u*)(RAW + rr * 784 + rem * 16) = pf.raw[i]; } }
        if (tid < 128) NSB[tid] = (bf16)f2bf(pf.nsv);
        if (wave == 0) {
            const float lf = logsigmoid(pf.ifa), ip = pf.ifb;
            const float bc = scan_add(lf, lane), a = ip - bc, pm = scan_max(a, lane), ms = SC[4096 + item], M = fmaxf(ms, pm);
            sm[lane] = a; sm[64 + lane] = M; sm[128 + lane] = __expf(ms - M); sm[192 + lane] = __expf(-bc - M);
        }
        __syncthreads();
        { const int g4 = tid & 31, s0 = (tid >> 5) * 4;
#pragma unroll
          for (int tile = 0; tile < 2; ++tile) {
              float x[7][4];
#pragma unroll
              for (int j = 0; j < 7; ++j) { const v2u rv = *(const LAS v2u*)(RAW + (s0 + j) * 784 + tile * 256 + g4 * 8); x[j][0] = bf_lo(rv.x); x[j][1] = bf_hi(rv.x); x[j][2] = bf_lo(rv.y); x[j][3] = bf_hi(rv.y); }
              f32x4 w[4];
#pragma unroll
              for (int tp = 0; tp < 4; ++tp) w[tp] = *(const LAS f32x4*)(CW + tp * 1024 + tile * 512 + h * 128 + 4 * g4);
              const float sc = tile ? 0.08838834764831845f : 1.0f; LAS bf16* dst = tile ? Ks : Qs;
#pragma unroll
              for (int j = 0; j < 4; ++j) { float y[4];
#pragma unroll
                  for (int i = 0; i < 4; ++i) y[i] = silu(w[0][i] * x[j][i] + w[1][i] * x[j + 1][i] + w[2][i] * x[j + 2][i] + w[3][i] * x[j + 3][i]) * sc;
                  v2u o; o.x = pk2(y[0], y[1]); o.y = pk2(y[2], y[3]); *(LAS v2u*)(dst + (s0 + j) * 136 + 4 * g4) = o; }
          }
          const int ch = tid & 127, sv = (tid >> 7) * 16;
#pragma unroll
          for (int i = 0; i < 16; i += 2) { const unsigned lo = *(const LAS bf16*)(RAW + (3 + sv + i) * 784 + 512 + ch * 2), hi = *(const LAS bf16*)(RAW + (4 + sv + i) * 784 + 512 + ch * 2);
              *(LAS unsigned*)(VT + ch * 72 + sv + i) = lo | (hi << 16); }
        }
        asm volatile("" ::: "memory");
        if (item + (int)gridDim.x < 2048) p4_prefetch_raw(pf, P, item + gridDim.x, tid, lane);
        __syncthreads();
        { const int sb = wave >> 1;
          bf16x8 ka[4];
#pragma unroll
          for (int ks = 0; ks < 4; ++ks) ka[ks] = *(const LAS bf16x8*)(Ks + (16 * sb + r) * 136 + 32 * ks + 8 * g);
#pragma unroll
          for (int tt = 0; tt < 2; ++tt) { const int tb = 2 * (wave & 1) + tt, t = 16 * tb + r;
              f32x4 acc = {0.f, 0.f, 0.f, 0.f};
#pragma unroll
              for (int ks = 0; ks < 4; ++ks) { const bf16x8 qb = *(const LAS bf16x8*)(Qs + t * 136 + 32 * ks + 8 * g); acc = MFMA16(ka[ks], qb, acc); }
              const float Mt = sm[64 + t]; float p[4], ps = 0.f;
#pragma unroll
              for (int k = 0; k < 4; ++k) { const int s = 16 * sb + 4 * g + k; p[k] = (s <= t) ? acc[k] * __expf(sm[s] - Mt) : 0.f; ps += p[k]; }
              v2u o; o.x = pk2(p[0], p[1]); o.y = pk2(p[2], p[3]); *(LAS v2u*)(PT + t * 72 + 16 * sb + 4 * g) = o;
              ps += __shfl_xor(ps, 16); ps += __shfl_xor(ps, 32);
              if (g == 0) sm[320 + sb * 64 + t] = ps; }
        }
        __syncthreads();
        f32x4 ai[4], ac[4], an[4];
#pragma unroll
        for (int tb = 0; tb < 4; ++tb) { ai[tb] = (f32x4){0.f, 0.f, 0.f, 0.f}; ac[tb] = (f32x4){0.f, 0.f, 0.f, 0.f}; an[tb] = (f32x4){0.f, 0.f, 0.f, 0.f}; }
        { const bf16x8 va0 = *(const LAS bf16x8*)(VT + (16 * wave + r) * 72 + 8 * g), va1 = *(const LAS bf16x8*)(VT + (16 * wave + r) * 72 + 32 + 8 * g);
          const bf16x8 ca0 = __builtin_bit_cast(bf16x8, pf.cs[0]), ca1 = __builtin_bit_cast(bf16x8, pf.cs[1]), ca2 = __builtin_bit_cast(bf16x8, pf.cs[2]), ca3 = __builtin_bit_cast(bf16x8, pf.cs[3]);
          const bf16x8 zero8 = {0, 0, 0, 0, 0, 0, 0, 0};
#pragma unroll
          for (int tb = 0; tb < 4; ++tb) { const int t = 16 * tb + r;
              const bf16x8 pb0 = *(const LAS bf16x8*)(PT + t * 72 + 8 * g), pb1 = *(const LAS bf16x8*)(PT + t * 72 + 32 + 8 * g);
              ai[tb] = MFMA16(va0, pb0, ai[tb]); ai[tb] = MFMA16(va1, pb1, ai[tb]);
              const bf16x8 q0 = *(const LAS bf16x8*)(Qs + t * 136 + 8 * g), q1 = *(const LAS bf16x8*)(Qs + t * 136 + 32 + 8 * g), q2 = *(const LAS bf16x8*)(Qs + t * 136 + 64 + 8 * g), q3 = *(const LAS bf16x8*)(Qs + t * 136 + 96 + 8 * g);
              ac[tb] = MFMA16(ca0, q0, ac[tb]); ac[tb] = MFMA16(ca1, q1, ac[tb]); ac[tb] = MFMA16(ca2, q2, ac[tb]); ac[tb] = MFMA16(ca3, q3, ac[tb]);
              if (wave == 0) {
                  const bf16x8 n0 = r == 0 ? *(const LAS bf16x8*)(NSB + 8 * g) : zero8, n1 = r == 0 ? *(const LAS bf16x8*)(NSB + 32 + 8 * g) : zero8, n2 = r == 0 ? *(const LAS bf16x8*)(NSB + 64 + 8 * g) : zero8, n3 = r == 0 ? *(const LAS bf16x8*)(NSB + 96 + 8 * g) : zero8;
                  an[tb] = MFMA16(n0, q0, an[tb]); an[tb] = MFMA16(n1, q1, an[tb]); an[tb] = MFMA16(n2, q2, an[tb]); an[tb] = MFMA16(n3, q3, an[tb]);
                  if (g == 0) { const float den = sm[128 + t] * an[tb][0] + (sm[320 + t] + sm[384 + t]) + (sm[448 + t] + sm[512 + t]); sm[256 + t] = fmaxf(fabsf(den), sm[192 + t]); } } }
        }
        asm volatile("" ::: "memory");
        if (item + (int)gridDim.x < 2048) p4_prefetch_cs(pf, P, item + gridDim.x, lane, wave);
#pragma unroll
        for (int tb = 0; tb < 4; ++tb) { const int t = 16 * tb + r; const float wi = sm[128 + t]; float s2 = 0.f;
#pragma unroll
            for (int k = 0; k < 4; ++k) { ai[tb][k] = wi * ac[tb][k] + ai[tb][k]; s2 += ai[tb][k] * ai[tb][k]; }
            s2 += __shfl_xor(s2, 16); s2 += __shfl_xor(s2, 32);
            if (g == 0) sm[576 + wave * 64 + t] = s2; }
        __syncthreads();
        {
#pragma unroll
          for (int tb = 0; tb < 4; ++tb) { const int t = 16 * tb + r; float tot = 0.f;
#pragma unroll
              for (int w = 0; w < 8; ++w) tot += sm[576 + w * 64 + t];
              const float inv = 1.0f / sm[256 + t], rs = inv * rsqrtf(tot * inv * inv * (1.f / 128.f) + EPS);
              const size_t row = (size_t)b * SEQ + c * 64 + t; const int col = h * 128 + 16 * wave + 4 * g;
              uint2 o; o.x = pk2(ai[tb][0] * rs * pf.gn[0] * bf_lo(pf.om[tb].x), ai[tb][1] * rs * pf.gn[1] * bf_hi(pf.om[tb].x)); o.y = pk2(ai[tb][2] * rs * pf.gn[2] * bf_lo(pf.om[tb].y), ai[tb][3] * rs * pf.gn[3] * bf_hi(pf.om[tb].y));
              *(uint2*)(YM + row * 1024 + 512 + col) = o; }
        }
        asm volatile("" ::: "memory");
        if (item + (int)gridDim.x < 2048) p4_prefetch_om(pf, P, item + gridDim.x, lane, wave);
        __syncthreads();
    }
}

__device__ __forceinline__ int f2ord(float f) { const int b = __float_as_int(f); return b ^ ((b >> 31) & 0x7fffffff); }
__device__ __forceinline__ float ord2f(int o) { return __int_as_float(o ^ ((o >> 31) & 0x7fffffff)); }
#define CE_DESC(a, i, j) { const int _h = max(a[i], a[j]), _l = min(a[i], a[j]); a[i] = _h; a[j] = _l; }
__device__ __forceinline__ void sort16_desc(int (&a)[16]) {
#pragma unroll
    for (int k = 2; k <= 16; k <<= 1) {
#pragma unroll
        for (int j = k >> 1; j > 0; j >>= 1) {
#pragma unroll
            for (int i = 0; i < 16; ++i) { const int l = i ^ j; if (l > i) { if ((i & k) == 0) CE_DESC(a, i, l) else CE_DESC(a, l, i) } }
        }
    }
}
__device__ __forceinline__ void merge16_desc(int (&a)[16], const int (&b)[16]) {
#pragma unroll
    for (int i = 0; i < 16; ++i) a[i] = max(a[i], b[15 - i]);
#pragma unroll
    for (int j = 8; j > 0; j >>= 1) {
#pragma unroll
        for (int i = 0; i < 16; ++i) { const int l = i ^ j; if (l > i) CE_DESC(a, i, l) }
    }
}
__device__ __forceinline__ void xmerge16(int (&a)[16], int mask) {
    int b[16];
#pragma unroll
    for (int i = 0; i < 16; ++i) b[i] = __shfl_xor(a[i], mask);
    merge16_desc(a, b);
}
__device__ __forceinline__ void p10_quant_rows(const Params& P, int lane, int wave, int vb) {
    const bf16* HN = (const bf16*)(P.ws + WS_HN); unsigned* HQH = (unsigned*)(P.ws + WS_HQH); unsigned* HQL = (unsigned*)(P.ws + WS_HQL); float* HS = (float*)(P.ws + WS_HS);
    for (int t = vb * NW + wave; t < NTOK; t += gridDim.x * NW) {
        float y[16]; unpk8(((const v4u*)(HN + (size_t)t * 1024))[2 * lane], y); unpk8(((const v4u*)(HN + (size_t)t * 1024))[2 * lane + 1], y + 8);
        float cm = 0.f;
#pragma unroll
        for (int i = 0; i < 16; ++i) cm = fmaxf(cm, fabsf(y[i]));
        cm = fmaxf(cm, __shfl_xor(cm, 1));
        const float sc = cm > 0.f ? cm * (1.0f / 119.0f) : 1.0f, inv = 1.0f / sc; unsigned dh[2] = {0u, 0u}, dl[2] = {0u, 0u};
#pragma unroll
        for (int i = 0; i < 16; ++i) { const int h = (int)rintf(y[i] * inv), lo = ((h + 8) & 15) - 8;
            dl[i >> 3] |= ((unsigned)lo & 15u) << (4 * (i & 7)); dh[i >> 3] |= ((unsigned)((h - lo) >> 4) & 15u) << (4 * (i & 7)); }
        *(uint2*)(HQH + (size_t)t * 128 + 2 * lane) = make_uint2(dh[0], dh[1]); *(uint2*)(HQL + (size_t)t * 128 + 2 * lane) = make_uint2(dl[0], dl[1]);
        if ((lane & 1) == 0) HS[(size_t)t * 32 + (lane >> 1)] = sc;
    }
}
__device__ __forceinline__ void p10_topk(const Params& P, LAS unsigned char* lds, int tid, int lane, int wave, int vb) {
    const bf16* Q2 = (const bf16*)(P.ws + WS_Q2); const bf16* K1B = (const bf16*)(P.ws + WS_K1B); const bf16* K2B = (const bf16*)(P.ws + WS_K2B);
    int* IDX = (int*)(P.ws + WS_IDX); float* GATE = (float*)(P.ws + WS_GATE); const float* SSQ1 = (const float*)(P.ws + WS_SSQ1);
    LAS bf16* Kl = (LAS bf16*)lds;
    LAS int* Tb = (LAS int*)(lds + 69632 + wave * 2048);
    const int r = lane & 15, g = lane >> 4;
    const int h = vb & 7, wgx = vb >> 3, nwg = gridDim.x >> 3;
    __syncthreads();
    for (int i = tid; i < 4096; i += 512) { const int half = i >> 11, rem = i & 2047, n = rem >> 4, c = rem & 15;
        *(LAS v4u*)(Kl + half * 17408 + n * 136 + c * 8) = *(const v4u*)((half ? K2B : K1B) + (size_t)h * 16384 + n * 128 + c * 8); }
    __syncthreads();
    for (int tile = wgx * NW + wave; tile < NTOK / 16; tile += nwg * NW) {
        const size_t row = (size_t)tile * 16 + r;
        int R[2][16];
#pragma unroll
        for (int half = 0; half < 2; ++half) {
            bf16x8 qb[4];
#pragma unroll
            for (int ks = 0; ks < 4; ++ks) qb[ks] = *(const bf16x8*)(Q2 + row * 2048 + h * 256 + half * 128 + 32 * ks + 8 * g);
            int X[16], Y[16];
#pragma unroll
            for (int nb = 0; nb < 8; ++nb) {
                f32x4 acc = {0.f, 0.f, 0.f, 0.f};
#pragma unroll
                for (int ks = 0; ks < 4; ++ks) acc = MFMA16(*(const LAS bf16x8*)(Kl + half * 17408 + (16 * nb + r) * 136 + 32 * ks + 8 * g), qb[ks], acc);
#pragma unroll
                for (int k = 0; k < 4; ++k) { const int key = (f2ord(acc[k]) & ~0x7f) | (16 * nb + 4 * g + k); if (nb < 4) X[4 * nb + k] = key; else Y[4 * (nb - 4) + k] = key; }
            }
            sort16_desc(X); sort16_desc(Y); merge16_desc(X, Y);
            xmerge16(X, 16); xmerge16(X, 32);
#pragma unroll
            for (int i = 0; i < 16; ++i) R[half][i] = X[i];
        }
        if (g == 0) {
#pragma unroll
            for (int i = 0; i < 16; ++i) { Tb[r * 32 + i] = R[0][i] & 0x7f; Tb[r * 32 + 16 + i] = R[1][i] & 0x7f; }
        }
        float F1[16], F2[16];
#pragma unroll
        for (int i = 0; i < 16; ++i) { F1[i] = ord2f(R[0][i] & ~0x7f); F2[i] = ord2f(R[1][i] & ~0x7f); }
        int C[16];
#pragma unroll
        for (int sl = 0; sl < 16; ++sl) {
            const int a1 = sl < 8 ? 1 : (sl < 13 ? 2 : -1), b1 = sl < 8 ? sl : sl - 8;
            const int a2 = sl < 4 ? 3 : (sl < 7 ? 4 : (sl < 9 ? 5 : (sl < 11 ? 6 : (sl < 13 ? 7 : -1)))), b2 = sl < 4 ? sl : (sl < 7 ? sl - 4 : (sl < 9 ? sl - 7 : (sl < 11 ? sl - 9 : sl - 11)));
            const int a3 = sl < 8 ? 8 + sl : -1;
            const int k0 = (f2ord(F1[0] + F2[sl]) & ~0xff) | (0 << 4) | sl;
            const int k1 = a1 >= 0 ? ((f2ord(F1[a1 < 0 ? 0 : a1] + F2[b1 & 15]) & ~0xff) | (a1 << 4) | (b1 & 15)) : (int)0x80000000;
            const int k2 = a2 >= 0 ? ((f2ord(F1[a2 < 0 ? 0 : a2] + F2[b2 & 15]) & ~0xff) | (a2 << 4) | (b2 & 15)) : (int)0x80000000;
            const int k3 = a3 >= 0 ? ((f2ord(F1[a3 < 0 ? 0 : a3] + F2[0]) & ~0xff) | (a3 << 4)) : (int)0x80000000;
            C[sl] = g == 0 ? k0 : (g == 1 ? k1 : (g == 2 ? k2 : k3));
        }
        sort16_desc(C); xmerge16(C, 16); xmerge16(C, 32);
        const float rstd1 = rsqrtf(SSQ1[row] * (1.0f / 1024.0f) + EPS);
        float e[16], sum = 0.f; const float mx = ord2f(C[0] & ~0xff);
#pragma unroll
        for (int i = 0; i < 16; ++i) { e[i] = __expf((ord2f(C[i] & ~0xff) - mx) * rstd1); sum += e[i]; }
        const float inv = 1.0f / sum;
        int oi[4]; float og[4];
#pragma unroll
        for (int kk = 0; kk < 4; ++kk) {
            const int key = g == 0 ? C[kk] : (g == 1 ? C[4 + kk] : (g == 2 ? C[8 + kk] : C[12 + kk]));
            const float ev = g == 0 ? e[kk] : (g == 1 ? e[4 + kk] : (g == 2 ? e[8 + kk] : e[12 + kk]));
            const int a = (key >> 4) & 15, bq = key & 15;
            oi[kk] = Tb[r * 32 + a] * 128 + Tb[r * 32 + 16 + bq]; og[kk] = ev * inv;
        }
#pragma unroll
        for (int kk = 0; kk < 4; ++kk) { const int pos = (4 * (g & 1) + kk) * 16 + 2 * h + (g >> 1); IDX[row * 128 + pos] = oi[kk]; GATE[row * 128 + pos] = og[kk]; }
    }
}

typedef _Float16 f16x2 __attribute__((ext_vector_type(2)));
__device__ __forceinline__ f16x2 bfpair_to_h2(unsigned w) { return __builtin_bit_cast(f16x2, __builtin_amdgcn_cvt_pkrtz(bf_lo(w), bf_hi(w))); }
template <int B> __device__ __forceinline__ f16x2 fp4_to_h2(unsigned w) { return __builtin_bit_cast(f16x2, __builtin_amdgcn_cvt_scalef32_pk_f16_fp4(w, 1.0f, B)); }
__device__ __forceinline__ void p11a_reduce_store(const v4u (&ud)[16], const v4u hh, const v4u hl, const float hsc, float* PART, int t, int x, int rg, int ch) {
    float z[16];
#pragma unroll
    for (int gq = 0; gq < 16; ++gq) {
        int ah = __builtin_amdgcn_sdot8((int)ud[gq].x, (int)hh.x, 0, false), al = __builtin_amdgcn_sdot8((int)ud[gq].x, (int)hl.x, 0, false);
        ah = __builtin_amdgcn_sdot8((int)ud[gq].y, (int)hh.y, ah, false); al = __builtin_amdgcn_sdot8((int)ud[gq].y, (int)hl.y, al, false);
        ah = __builtin_amdgcn_sdot8((int)ud[gq].z, (int)hh.z, ah, false); al = __builtin_amdgcn_sdot8((int)ud[gq].z, (int)hl.z, al, false);
        ah = __builtin_amdgcn_sdot8((int)ud[gq].w, (int)hh.w, ah, false); al = __builtin_amdgcn_sdot8((int)ud[gq].w, (int)hl.w, al, false);
        z[gq] = (float)(16 * ah + al) * hsc; }
    float z8[8], z4[4], z2[2];
    { const bool b = ch & 4;
#pragma unroll
      for (int i = 0; i < 8; ++i) { const float keep = b ? z[8 + i] : z[i], send = b ? z[i] : z[8 + i]; z8[i] = keep + __shfl_xor(send, 4); } }
    { const bool b = ch & 2;
#pragma unroll
      for (int i = 0; i < 4; ++i) { const float keep = b ? z8[4 + i] : z8[i], send = b ? z8[i] : z8[4 + i]; z4[i] = keep + __shfl_xor(send, 2); } }
    { const bool b = ch & 1;
#pragma unroll
      for (int i = 0; i < 2; ++i) { const float keep = b ? z4[2 + i] : z4[i], send = b ? z4[i] : z4[2 + i]; z2[i] = keep + __shfl_xor(send, 1); } }
    *(float2*)(PART + ((size_t)t * 4 + x) * 128 + rg * 16 + 2 * ch) = make_float2(z2[0], z2[1]);
}
__device__ __forceinline__ void p11a_udot(const Params& P, int lane, int wave, int vb) {
    const unsigned* HQH = (const unsigned*)(P.ws + WS_HQH); const unsigned* HQL = (const unsigned*)(P.ws + WS_HQL); const float* HS = (const float*)(P.ws + WS_HS);
    const unsigned char* U4 = P.ws + WS_U4; const int* IDX = (const int*)(P.ws + WS_IDX); float* PART = (float*)(P.ws + WS_PART);
    const int x = vb & 3, wgx = vb >> 2, nwg = gridDim.x >> 2, rg = lane >> 3, ch = lane & 7;
    const int tstep = nwg * NW;
    for (int t = wgx * NW + wave; t < NTOK; t += 2 * tstep) {
        const int tB = t + tstep;
        int eA[16], eB[16];
#pragma unroll
        for (int q = 0; q < 4; ++q) { const int4 v = *(const int4*)(IDX + (size_t)t * 128 + rg * 16 + 4 * q); eA[4 * q] = v.x; eA[4 * q + 1] = v.y; eA[4 * q + 2] = v.z; eA[4 * q + 3] = v.w;
            const int4 w = *(const int4*)(IDX + (size_t)tB * 128 + rg * 16 + 4 * q); eB[4 * q] = w.x; eB[4 * q + 1] = w.y; eB[4 * q + 2] = w.z; eB[4 * q + 3] = w.w; }
        const v4u hhA = *(const v4u*)(HQH + (size_t)t * 128 + 32 * x + 4 * ch), hlA = *(const v4u*)(HQL + (size_t)t * 128 + 32 * x + 4 * ch);
        const v4u hhB = *(const v4u*)(HQH + (size_t)tB * 128 + 32 * x + 4 * ch), hlB = *(const v4u*)(HQL + (size_t)tB * 128 + 32 * x + 4 * ch);
        const float hsA = HS[(size_t)t * 32 + 8 * x + ch], hsB = HS[(size_t)tB * 32 + 8 * x + ch];
        v4u udA[16], udB[16];
#pragma unroll
        for (int gq = 0; gq < 16; ++gq) udA[gq] = *(const v4u*)(U4 + (size_t)eA[gq] * 512 + 128 * x + 16 * ch);
#pragma unroll
        for (int gq = 0; gq < 16; ++gq) udB[gq] = *(const v4u*)(U4 + (size_t)eB[gq] * 512 + 128 * x + 16 * ch);
        p11a_reduce_store(udA, hhA, hlA, hsA, PART, t, x, rg, ch);
        p11a_reduce_store(udB, hhB, hlB, hsB, PART, tB, x, rg, ch);
    }
}
__device__ __forceinline__ void p11b_weights(const Params& P, int tid, int vb) {
    const float* PART = (const float*)(P.ws + WS_PART); float* GW = (float*)(P.ws + WS_GATE); const float* SSQ1 = (const float*)(P.ws + WS_SSQ1);
    const int* IDX = (const int*)(P.ws + WS_IDX); const float* SU = (const float*)(P.ws + WS_SU); const float* SV = (const float*)(P.ws + WS_SV);
    for (size_t i = (size_t)vb * 512 + tid; i < (size_t)NTOK * 128; i += (size_t)gridDim.x * 512) {
        const size_t t = i >> 7, pos = i & 127; float zs = 0.f;
#pragma unroll
        for (int x = 0; x < 4; ++x) zs += PART[(t * 4 + x) * 128 + pos];
        const int e = IDX[i];
        const float zv = zs * SU[e] * rsqrtf(SSQ1[t] * (1.0f / 1024.0f) + EPS);
        GW[i] = GW[i] * 0.5f * zv * (1.0f + erff(zv * 0.70710678118654752f)) * SV[e];
    }
}
__device__ __forceinline__ void p11c_vacc(const Params& P, int lane, int wave, int vb) {
    const unsigned char* V4 = P.ws + WS_V4; const int* IDX = (const int*)(P.ws + WS_IDX); const float* GW = (const float*)(P.ws + WS_GATE);
    float* X = P.out; float* SSQ = (float*)(P.ws + WS_SSQ); bf16* XG = (bf16*)(P.ws + WS_HN2); const float* gple = P.in[16];
    const int x = vb & 3, wgx = vb >> 2, nwg = gridDim.x >> 2, rg = lane >> 3, ch = lane & 7;
    const f32x4 gp = *(const f32x4*)(gple + 256 * x + 32 * ch + 4 * rg);
    for (int t = wgx * NW + wave; t < NTOK; t += nwg * NW) {
        int e[16]; float w[16];
#pragma unroll
        for (int q = 0; q < 4; ++q) { const int4 v = *(const int4*)(IDX + (size_t)t * 128 + rg * 16 + 4 * q); e[4 * q] = v.x; e[4 * q + 1] = v.y; e[4 * q + 2] = v.z; e[4 * q + 3] = v.w;
            const float4 wv = *(const float4*)(GW + (size_t)t * 128 + rg * 16 + 4 * q); w[4 * q] = wv.x; w[4 * q + 1] = wv.y; w[4 * q + 2] = wv.z; w[4 * q + 3] = wv.w; }
        v4u vd[16];
#pragma unroll
        for (int gq = 0; gq < 16; ++gq) vd[gq] = *(const v4u*)(V4 + (size_t)e[gq] * 512 + 128 * x + 16 * ch);
        float* xp = X + (size_t)t * 1024 + 256 * x + 32 * ch + 4 * rg;
        const f32x4 xo = *(const f32x4*)xp;
        f16x2 acc[16];
#pragma unroll
        for (int i = 0; i < 16; ++i) acc[i] = (f16x2){(_Float16)0.f, (_Float16)0.f};
#pragma unroll
        for (int gq = 0; gq < 16; ++gq) { const f16x2 ww = __builtin_bit_cast(f16x2, __builtin_amdgcn_cvt_pkrtz(w[gq], w[gq])); const unsigned w4[4] = {vd[gq].x, vd[gq].y, vd[gq].z, vd[gq].w};
#pragma unroll
            for (int q = 0; q < 4; ++q) { acc[4 * q] = __builtin_elementwise_fma(fp4_to_h2<0>(w4[q]), ww, acc[4 * q]); acc[4 * q + 1] = __builtin_elementwise_fma(fp4_to_h2<1>(w4[q]), ww, acc[4 * q + 1]);
                acc[4 * q + 2] = __builtin_elementwise_fma(fp4_to_h2<2>(w4[q]), ww, acc[4 * q + 2]); acc[4 * q + 3] = __builtin_elementwise_fma(fp4_to_h2<3>(w4[q]), ww, acc[4 * q + 3]); } }
        f16x2 a8[8], a4[4], a2[2];
        { const bool b = rg & 4;
#pragma unroll
          for (int i = 0; i < 8; ++i) { const f16x2 keep = b ? acc[8 + i] : acc[i], send = b ? acc[i] : acc[8 + i]; a8[i] = keep + __builtin_bit_cast(f16x2, __shfl_xor(__builtin_bit_cast(int, send), 32)); } }
        { const bool b = rg & 2;
#pragma unroll
          for (int i = 0; i < 4; ++i) { const f16x2 keep = b ? a8[4 + i] : a8[i], send = b ? a8[i] : a8[4 + i]; a4[i] = keep + __builtin_bit_cast(f16x2, __shfl_xor(__builtin_bit_cast(int, send), 16)); } }
        { const bool b = rg & 1;
#pragma unroll
          for (int i = 0; i < 2; ++i) { const f16x2 keep = b ? a4[2 + i] : a4[i], send = b ? a4[i] : a4[2 + i]; a2[i] = keep + __builtin_bit_cast(f16x2, __shfl_xor(__builtin_bit_cast(int, send), 8)); } }
        f32x4 xn; xn[0] = xo[0] + (float)a2[0][0]; xn[1] = xo[1] + (float)a2[0][1]; xn[2] = xo[2] + (float)a2[1][0]; xn[3] = xo[3] + (float)a2[1][1];
        *(f32x4*)xp = xn;
        uint2 xg; xg.x = pk2(xn[0] * gp[0], xn[1] * gp[1]); xg.y = pk2(xn[2] * gp[2], xn[3] * gp[3]);
        *(uint2*)(XG + (size_t)t * 1024 + 256 * x + 32 * ch + 4 * rg) = xg;
        const float ss = wave_sum((xn[0] * xn[0] + xn[1] * xn[1]) + (xn[2] * xn[2] + xn[3] * xn[3]));
        if (lane == 0) atomicAdd(SSQ + t, ss);
    }
}

__global__ void __launch_bounds__(512, 2) mk_fwd(Params P) {
    extern __shared__ __attribute__((aligned(16))) unsigned char lds_raw[];
    cg::grid_group grid = cg::this_grid();
    LAS unsigned char* lds = (LAS unsigned char*)lds_raw;
    const int tid = threadIdx.x, lane = tid & 63, wave = __builtin_amdgcn_readfirstlane(tid >> 6);
    const int lo = P.ph_lo, hi = P.ph_hi, G = gridDim.x, bx = blockIdx.x;
    unsigned char* ws = P.ws;
    const int gw = bx * NW + wave, NGW = G * NW;
#ifndef PH_MASK
#define PH_MASK 0xffff
#endif
#define IN(k) (((PH_MASK >> (k)) & 1) && lo <= (k) && (k) < hi)
    volatile LAS unsigned* xst = (volatile LAS unsigned*)(lds + LDS_BYTES - 16);
    if (tid < 4) xst[tid] = 0u;
    __syncthreads();
    const XcdBarrier bar = xcd_barrier_post((unsigned*)(ws + WS_BAR), xst);
    unsigned* vctl = (unsigned*)(ws + WS_BAR) + 4096;
    if (tid == 0) { const unsigned xcc = xb_xcc_id() & 7u; xst[2] = xcc; xst[3] = xb_add(&vctl[16 * xcc], 1u); }
#ifdef USE_CG
#define GRID_BAR() grid.sync()
#else
#define GRID_BAR() xcd_barrier(bar)
#endif
#define SYNC_AFTER(k) do { if (IN(k) && IN((k) + 1)) { if ((k) == 0) grid.sync(); else GRID_BAR(); } } while (0)
    typedef pg8::bf16_t pb;
    if (IN(0)) p0_prologue(P, lds, tid, lane, wave);
    SYNC_AFTER(0);
    if (tid == 0) {
        const unsigned xcc = xst[2], sl = xst[3], cap = (unsigned)G >> 3; unsigned v;
        if (sl < cap) v = sl * 8u + xcc;
        else { unsigned o = xb_add(&vctl[160], 1u); v = 0u;
            for (unsigned x = 0; x < 8u; ++x) { const unsigned c = min(xb_ld(&vctl[16 * x]), cap), fr = cap - c; if (o < fr) { v = (c + o) * 8u + x; break; } o -= fr; } }
        xst[2] = v;
    }
    __syncthreads();
    const int vb = (int)xst[2];
    if (IN(1)) {
        pg8::Gemm g{(const pb*)(ws + WS_XN), (const pb*)(ws + WS_W1T), NTOK, 5632, 1024}; pg8::StaticOrder S; S.init(NTOK, 5632, G, vb);
        pg8::EpiProj E{(pb*)(ws + WS_QKVA), (pb*)(ws + WS_QKM), (pb*)(ws + WS_VM), (pb*)(ws + WS_OM), (pb*)(ws + WS_G), C2};
        pg8::gemm_phase<pg8::EpiProj, pg8::StaticOrder, true, true>(lds, g, S, E);
    }
    SYNC_AFTER(1);
    if (IN(2)) { p2_attention(P, lds, lane, wave, vb); __syncthreads(); p2_mlstm_local(P, lds, tid, lane, wave, vb); }
    SYNC_AFTER(2);
    if (IN(3)) p3_mlstm_scan(P, tid, vb);
    SYNC_AFTER(3);
    if (IN(4)) p4_mlstm_out(P, lds, tid, lane, wave, vb);
    SYNC_AFTER(4);
    if (IN(5)) {
        pg8::Gemm g{(const pb*)(ws + WS_YA), (const pb*)(ws + WS_WAT), NTOK, 1024, 1024}; pg8::StaticOrder S; S.init(NTOK, 1024, G, vb);
        pg8::EpiMerged E{(pb*)(ws + WS_MERGED), (const pb*)(ws + WS_G)};
        pg8::gemm_phase<pg8::EpiMerged, pg8::StaticOrder, true, true>(lds, g, S, E);
    }
    if (IN(5) && IN(7)) GRID_BAR();
    if (IN(7)) {
        pg8::Gemm g{(const pb*)(ws + WS_MERGED), (const pb*)(ws + WS_WOT), NTOK, 1024, 1024}; pg8::StaticOrder S; S.init(NTOK, 1024, G, vb);
        pg8::EpiResidual E{P.in[0], P.out, (pb*)(ws + WS_HN), P.in[10], (float*)(ws + WS_SSQ1)};
        pg8::gemm_phase<pg8::EpiResidual, pg8::StaticOrder, true, true>(lds, g, S, E);
    }
    if (IN(7) && IN(9)) GRID_BAR();
    if (IN(9)) {
        pg8::Gemm g{(const pb*)(ws + WS_HN), (const pb*)(ws + WS_WQT), NTOK, 2048, 1024}; pg8::StaticOrder S; S.init(NTOK, 2048, G, vb);
        pg8::EpiStore E{(pb*)(ws + WS_Q2), 2048};
        pg8::gemm_phase<pg8::EpiStore, pg8::StaticOrder, true, true>(lds, g, S, E);
    }
    SYNC_AFTER(9);
    if (IN(10)) { p10_quant_rows(P, lane, wave, vb); p10_topk(P, lds, tid, lane, wave, vb); }
    SYNC_AFTER(10);
    if (IN(11)) { p11a_udot(P, lane, wave, vb); GRID_BAR(); p11b_weights(P, tid, vb); GRID_BAR(); p11c_vacc(P, lane, wave, vb); }
    SYNC_AFTER(11);
    if (IN(12)) {
        pg8::Gemm g{(const pb*)(ws + WS_PB), (const pb*)(ws + WS_WPT), NTOK, 1024, 256}; pg8::StaticOrder S; S.init(NTOK, 1024, G, vb);
        pg8::EpiStore E{(pb*)(ws + WS_E), 1024};
        pg8::gemm_phase<pg8::EpiStore, pg8::StaticOrder, true, true>(lds, g, S, E);
    }
    if (IN(12) && IN(13)) { asm volatile("s_waitcnt vmcnt(0)" ::: "memory"); __syncthreads(); }
    if (IN(13)) {
        pg8::Gemm g{(const pb*)(ws + WS_HN2), (const pb*)(ws + WS_WGT), NTOK, 1024, 1024}; pg8::StaticOrder S; S.init(NTOK, 1024, G, vb);
        pg8::EpiPle E{P.out, (const pb*)(ws + WS_E), (const float*)(ws + WS_SSQ)};
        pg8::gemm_phase<pg8::EpiPle, pg8::StaticOrder, true, true>(lds, g, S, E);
    }
    SYNC_AFTER(13);
    if (IN(14)) {
        const float* gf = P.in[19];
        for (int m = gw; m < NTOK; m += NGW) {
            float* xr = P.out + (size_t)m * 1024; f32x4 v[4]; float s = 0.f;
#pragma unroll
            for (int j = 0; j < 4; ++j) { v[j] = ((const f32x4*)xr)[lane + 64 * j]; s += (v[j][0] * v[j][0] + v[j][1] * v[j][1]) + (v[j][2] * v[j][2] + v[j][3] * v[j][3]); }
            const float rstd = rsqrtf(wave_sum(s) * (1.f / 1024.f) + EPS);
#pragma unroll
            for (int j = 0; j < 4; ++j) { const f32x4 g = ((const f32x4*)gf)[lane + 64 * j]; ((f32x4*)xr)[lane + 64 * j] = v[j] * rstd * g; }
        }
    }
}

extern "C" void kernel_launch(void* const* d_in, const int* in_sizes, int n_in, void* d_out, int out_size, void* d_ws, size_t ws_size, hipStream_t stream) {
    static int grid_blocks = 0;
    if (!grid_blocks) {
        int dev = 0, cus = 0, per_cu = 0;
        (void)hipGetDevice(&dev);
        (void)hipDeviceGetAttribute(&cus, hipDeviceAttributeMultiprocessorCount, dev);
        (void)hipFuncSetAttribute((const void*)mk_fwd, hipFuncAttributeMaxDynamicSharedMemorySize, LDS_BYTES);
        (void)hipOccupancyMaxActiveBlocksPerMultiprocessor(&per_cu, mk_fwd, 512, LDS_BYTES);
        if (per_cu > 1) per_cu = 1;
        grid_blocks = cus * per_cu;
    }
    if (n_in < 20 || ws_size < WS_NEED || grid_blocks <= 0) { fprintf(stderr, "kernel_launch: bad setup (n_in %d ws %zu grid %d)\n", n_in, ws_size, grid_blocks); return; }
    Params p{};
    for (int i = 0; i < 20; ++i) p.in[i] = (const float*)d_in[i];
    p.out = (float*)d_out; p.ws = (unsigned char*)d_ws; p.ph_lo = 0; p.ph_hi = 15;
    (void)hipMemsetAsync((unsigned char*)d_ws + WS_BAR, 0, BAR_BYTES, stream);
    void* args[] = {&p};
    hipError_t e = hipLaunchCooperativeKernel((void*)mk_fwd, dim3(grid_blocks), dim3(512), args, LDS_BYTES, stream);
    if (e != hipSuccess) fprintf(stderr, "cooperative launch failed: %s (grid %d)\n", hipGetErrorString(e), grid_blocks);
}
```

```cpp
#include <hip/hip_runtime.h>
#include <hip/hip_cooperative_groups.h>
#include <cstdio>
#include <cstdint>
namespace cg = cooperative_groups;
namespace pg8 {
#define PG8_LAS __attribute__((address_space(3)))
typedef unsigned short bf16_t;
typedef short bf16x8 __attribute__((ext_vector_type(8)));
typedef float f32x4 __attribute__((ext_vector_type(4)));
typedef unsigned u32x4 __attribute__((ext_vector_type(4)));
constexpr int BM = 256, BK = 64, HALF = 128, HTB = HALF * BK * 2  , STAGE_BYTES = 8 * HTB, NXCD = 8, WGM = 8;

__host__ __device__ __forceinline__ int lds_byte(int r, int c) { const int st = (r >> 4) * 2 + (c >> 5), rr = r & 15, cc = c & 31, ob = rr * 64 + cc * 2; return st * 1024 + (ob ^ (((ob >> 9) & 1) << 5)); }
__host__ __device__ __forceinline__ void stage_rc(int b, int& R, int& C) { const int st = b / 1024, sb = b % 1024, swz = sb ^ (((sb >> 9) & 1) << 5); R = (st >> 1) * 16 + swz / 64; C = (st & 1) * 32 + (swz % 64) / 2; }
__host__ __device__ __forceinline__ int perm32(int rho) { const int n = rho >> 4, i = rho & 15; return 8 * (i >> 2) + 4 * n + (i & 3); }

struct Unit { int pm, pn; };
struct Gemm { const bf16_t* A; const bf16_t* Bt; int M, N, K; };

struct StaticOrder {
    int nM, nN, nwg, G, c;
    __host__ __device__ void init(int M, int N, int G_, int c_) { nM = M / BM; nN = N / BM; nwg = nM * nN; G = G_; c = c_; }
    __host__ __device__ bool next(int i, Unit& u) const {
        const long L = (long)i * G + c; if (L >= nwg) return false;
        int wgid = (int)L; { const int q = nwg / NXCD, r = nwg % NXCD, xcd = wgid % NXCD, off = wgid / NXCD; wgid = (xcd < r ? xcd * (q + 1) : r * (q + 1) + (xcd - r) * q) + off; }
        const int nig = WGM * nN, gid = wgid / nig, fm = gid * WGM, gsz = (nM - fm) < WGM ? (nM - fm) : WGM;
        u.pm = fm + ((wgid % nig) % gsz); u.pn = (wgid % nig) / gsz; return true;
    }
    __device__ __forceinline__ void a_ready(const Unit&) const {}
    __device__ __forceinline__ void done(const Unit&) const {}
};

__device__ __forceinline__ unsigned cvt_pk_bf16(float lo, float hi) { unsigned r; asm volatile("v_cvt_pk_bf16_f32 %0, %1, %2" : "=v"(r) : "v"(lo), "v"(hi)); return r; }
typedef float f32x2 __attribute__((ext_vector_type(2)));

__device__ __forceinline__ float sigm(float x) { return __builtin_amdgcn_rcpf(1.0f + __builtin_amdgcn_exp2f(-1.4426950408889634f * x)); }
__device__ __forceinline__ float bf_lo(unsigned w) { return __uint_as_float(w << 16); }
__device__ __forceinline__ float bf_hi(unsigned w) { return __uint_as_float(w & 0xffff0000u); }
__device__ __forceinline__ u32x4 pack8(const f32x4& v0, const f32x4& v1) { u32x4 w; w.x = cvt_pk_bf16(v0[0], v0[1]); w.y = cvt_pk_bf16(v0[2], v0[3]); w.z = cvt_pk_bf16(v1[0], v1[1]); w.w = cvt_pk_bf16(v1[2], v1[3]); return w; }
__device__ __forceinline__ void unpack8(const u32x4& w, f32x4& v0, f32x4& v1) { v0[0] = bf_lo(w.x); v0[1] = bf_hi(w.x); v0[2] = bf_lo(w.y); v0[3] = bf_hi(w.y); v1[0] = bf_lo(w.z); v1[1] = bf_hi(w.z); v1[2] = bf_lo(w.w); v1[3] = bf_hi(w.w); }

#define PG8_EPI_WALK(...) \
    _Pragma("unroll") for (int ai = 0; ai < 2; ++ai) _Pragma("unroll") for (int m = 0; m < 4; ++m) { const int row = u.pm * BM + wr * 64 + fr + ai * HALF + m * 16; \
        _Pragma("unroll") for (int bj = 0; bj < 2; ++bj) { const int ct = wc * 64 + bj * 32 + 8 * fq; f32x4 v0 = acc[ai][bj][m][0], v1 = acc[ai][bj][m][1]; __VA_ARGS__ } }

__device__ __forceinline__ u32x4 xor8_16B(u32x4 v) { u32x4 r; r.x = (unsigned)__shfl_xor((int)v.x, 8); r.y = (unsigned)__shfl_xor((int)v.y, 8); r.z = (unsigned)__shfl_xor((int)v.z, 8); r.w = (unsigned)__shfl_xor((int)v.w, 8); return r; }
__device__ __forceinline__ u32x4 bperm_16B(int src_byte, u32x4 v) { u32x4 r; r.x = (unsigned)__builtin_amdgcn_ds_bpermute(src_byte, (int)v.x); r.y = (unsigned)__builtin_amdgcn_ds_bpermute(src_byte, (int)v.y); r.z = (unsigned)__builtin_amdgcn_ds_bpermute(src_byte, (int)v.z); r.w = (unsigned)__builtin_amdgcn_ds_bpermute(src_byte, (int)v.w); return r; }
__device__ __forceinline__ void store_rows_bf16(bf16_t* O, size_t ldc, int r0, int c0, int fr, int fq, u32x4 w0, u32x4 w1) {
    const bool h = fr & 8; const u32x4 recv = xor8_16B(h ? w0 : w1);
    const u32x4 d1 = h ? recv : w0, d2 = h ? w1 : recv;
    const int lane = fr + 16 * fq, src = ((lane >> 3) + 8 * ((lane >> 2) & 1) + 16 * (lane & 3)) * 4;
    const u32x4 e1 = bperm_16B(src, d1), e2 = bperm_16B(src, d2);
    bf16_t* p = O + (size_t)(r0 + (lane >> 3)) * ldc + c0 + 8 * (lane & 7);
    *(u32x4*)p = e1; *(u32x4*)(p + 8 * ldc) = e2;
}
struct EpiProj {
    static constexpr bool PERM = true, AFTER_DRAIN = false, MIDK = false;
    bf16_t *qkva, *qkm, *vm, *om, *g; float c2;
    __device__ __forceinline__ void operator()(const f32x4 (&acc)[2][2][4][2], const Unit& u, int wr, int wc, int fr, int fq) const {
        const int pn = u.pn; bf16_t* base; int ldc, colt, mode = 0; float sc = 1.f;
        if (pn < 6) { base = qkva; ldc = 1536; colt = pn * 256; if (pn < 2) sc = c2; }
        else if (pn < 10) { base = qkm; ldc = 1024; colt = (pn - 6) * 256; }
        else if (pn < 12) { base = vm; ldc = 512; colt = (pn - 10) * 256; }
        else if (pn < 14) { base = om; ldc = 512; colt = (pn - 12) * 256; mode = 1; }
        else { base = g; ldc = 2048; colt = (pn - 14) * 256; mode = 1; }
#pragma unroll
        for (int ai = 0; ai < 2; ++ai)
#pragma unroll
            for (int m = 0; m < 4; ++m) { u32x4 w[2];
#pragma unroll
                for (int bj = 0; bj < 2; ++bj) { f32x4 v0 = acc[ai][bj][m][0], v1 = acc[ai][bj][m][1];
                    if (mode == 1) { _Pragma("unroll") for (int i = 0; i < 4; ++i) { v0[i] = sigm(v0[i]); v1[i] = sigm(v1[i]); } }
                    else { v0 = v0 * sc; v1 = v1 * sc; }
                    w[bj] = pack8(v0, v1); }
                store_rows_bf16(base, (size_t)ldc, u.pm * BM + wr * 64 + ai * HALF + m * 16, colt + wc * 64, fr, fq, w[0], w[1]); }
    }
};
struct EpiStore {
    static constexpr bool PERM = true, AFTER_DRAIN = false, MIDK = false;
    bf16_t* O; int ldc;
    __device__ __forceinline__ void operator()(const f32x4 (&acc)[2][2][4][2], const Unit& u, int wr, int wc, int fr, int fq) const {
#pragma unroll
        for (int ai = 0; ai < 2; ++ai)
#pragma unroll
            for (int m = 0; m < 4; ++m) store_rows_bf16(O, (size_t)ldc, u.pm * BM + wr * 64 + ai * HALF + m * 16, u.pn * BM + wc * 64, fr, fq, pack8(acc[ai][0][m][0], acc[ai][0][m][1]), pack8(acc[ai][1][m][0], acc[ai][1][m][1]));
    }
};
template <bool ADD> struct EpiGated {
    static constexpr bool PERM = true, AFTER_DRAIN = false, MIDK = false;
    bf16_t* O; const bf16_t* prev; const bf16_t* gate; int gcol0;
    __device__ __forceinline__ void operator()(const f32x4 (&acc)[2][2][4][2], const Unit& u, int wr, int wc, int fr, int fq) const {
#pragma unroll
        for (int ai = 0; ai < 2; ++ai)
#pragma unroll
            for (int m = 0; m < 4; ++m) { const int row = u.pm * BM + wr * 64 + fr + ai * HALF + m * 16; u32x4 w[2];
#pragma unroll
                for (int bj = 0; bj < 2; ++bj) { const int col = u.pn * BM + wc * 64 + bj * 32 + 8 * fq; f32x4 v0 = acc[ai][bj][m][0], v1 = acc[ai][bj][m][1];
                    f32x4 g0, g1; unpack8(*(const u32x4*)(gate + (size_t)row * 2048 + gcol0 + col), g0, g1);
                    v0 = v0 * g0; v1 = v1 * g1;
                    if (ADD) { f32x4 p0, p1; unpack8(*(const u32x4*)(prev + (size_t)row * 1024 + col), p0, p1); v0 = v0 + p0; v1 = v1 + p1; }
                    w[bj] = pack8(v0, v1); }
                store_rows_bf16(O, 1024, u.pm * BM + wr * 64 + ai * HALF + m * 16, u.pn * BM + wc * 64, fr, fq, w[0], w[1]); }
    }
};
struct EpiMerged {
    static constexpr bool PERM = true, AFTER_DRAIN = false, MIDK = true;
    bf16_t* O; const bf16_t* gate;
    __device__ __forceinline__ void mid(f32x4 (&acc)[2][2][4][2], const Unit& u, int wr, int wc, int fr, int fq) const {
#pragma unroll
        for (int ai = 0; ai < 2; ++ai)
#pragma unroll
            for (int mp = 0; mp < 2; ++mp) {
                u32x4 ga[2][2], gm[2][2];
#pragma unroll
                for (int mm = 0; mm < 2; ++mm)
#pragma unroll
                    for (int bj = 0; bj < 2; ++bj) { const size_t o = (size_t)(u.pm * BM + wr * 64 + fr + ai * HALF + (2 * mp + mm) * 16) * 2048 + u.pn * BM + wc * 64 + bj * 32 + 8 * fq;
                        ga[mm][bj] = *(const u32x4*)(gate + o); gm[mm][bj] = *(const u32x4*)(gate + o + 1024); }
#pragma unroll
                for (int mm = 0; mm < 2; ++mm)
#pragma unroll
                    for (int bj = 0; bj < 2; ++bj) { f32x4 a0, a1, m0, m1; unpack8(ga[mm][bj], a0, a1); unpack8(gm[mm][bj], m0, m1);
#pragma unroll
                        for (int i = 0; i < 4; ++i) { acc[ai][bj][2 * mp + mm][0][i] *= a0[i] * __builtin_amdgcn_rcpf(m0[i]); acc[ai][bj][2 * mp + mm][1][i] *= a1[i] * __builtin_amdgcn_rcpf(m1[i]); } }
            }
    }
    __device__ __forceinline__ void operator()(const f32x4 (&acc)[2][2][4][2], const Unit& u, int wr, int wc, int fr, int fq) const {
#pragma unroll
        for (int ai = 0; ai < 2; ++ai)
#pragma unroll
            for (int mp = 0; mp < 2; ++mp) {
                u32x4 gm[2][2];
#pragma unroll
                for (int mm = 0; mm < 2; ++mm)
#pragma unroll
                    for (int bj = 0; bj < 2; ++bj) gm[mm][bj] = *(const u32x4*)(gate + (size_t)(u.pm * BM + wr * 64 + fr + ai * HALF + (2 * mp + mm) * 16) * 2048 + 1024 + u.pn * BM + wc * 64 + bj * 32 + 8 * fq);
#pragma unroll
                for (int mm = 0; mm < 2; ++mm) { const int m = 2 * mp + mm; u32x4 w[2];
#pragma unroll
                    for (int bj = 0; bj < 2; ++bj) { f32x4 m0, m1; unpack8(gm[mm][bj], m0, m1); w[bj] = pack8(acc[ai][bj][m][0] * m0, acc[ai][bj][m][1] * m1); }
                    store_rows_bf16(O, 1024, u.pm * BM + wr * 64 + ai * HALF + m * 16, u.pn * BM + wc * 64, fr, fq, w[0], w[1]); }
            }
    }
};
struct EpiResidual {
    static constexpr bool PERM = true, AFTER_DRAIN = false, MIDK = false;
    const float* res; bf16_t* xb; float* ssq;
    __device__ __forceinline__ void operator()(const f32x4 (&acc)[2][2][4][2], const Unit& u, int wr, int wc, int fr, int fq) const {
#pragma unroll
        for (int ai = 0; ai < 2; ++ai)
#pragma unroll
            for (int m = 0; m < 4; ++m) { const int row = u.pm * BM + wr * 64 + fr + ai * HALF + m * 16; float s = 0.f; u32x4 wx[2];
#pragma unroll
                for (int bj = 0; bj < 2; ++bj) { const int ct = wc * 64 + bj * 32 + 8 * fq; f32x4 v0 = acc[ai][bj][m][0], v1 = acc[ai][bj][m][1];
                    const size_t o = (size_t)row * 1024 + u.pn * BM + ct; const f32x4 r0 = *(const f32x4*)(res + o), r1 = *(const f32x4*)(res + o + 4);
                    v0 = v0 + r0; v1 = v1 + r1;
                    s += (v0[0] * v0[0] + v0[1] * v0[1]) + (v0[2] * v0[2] + v0[3] * v0[3]) + (v1[0] * v1[0] + v1[1] * v1[1]) + (v1[2] * v1[2] + v1[3] * v1[3]);
                    wx[bj] = pack8(v0, v1); }
                store_rows_bf16(xb, 1024, u.pm * BM + wr * 64 + ai * HALF + m * 16, u.pn * BM + wc * 64, fr, fq, wx[0], wx[1]);
                s += __shfl_xor(s, 16); s += __shfl_xor(s, 32);
                if (fq == 0) atomicAdd(ssq + row, s);
                asm volatile("" ::: "memory"); }
    }
};
struct EpiPle {
    static constexpr bool PERM = true, AFTER_DRAIN = false, MIDK = false;
    const bf16_t* x2; bf16_t* x3; const bf16_t* e; const float* ssq;
    __device__ __forceinline__ void operator()(const f32x4 (&acc)[2][2][4][2], const Unit& u, int wr, int wc, int fr, int fq) const {
        const int row0 = u.pm * BM + wr * 64 + fr;
        float sq_next = ssq[row0];
#pragma unroll
        for (int ai = 0; ai < 2; ++ai)
#pragma unroll
            for (int m = 0; m < 4; ++m) { const int row = row0 + ai * HALF + m * 16; const float sq = sq_next; u32x4 wx[2];
                if (!(ai == 1 && m == 3)) sq_next = ssq[row0 + (m == 3 ? HALF : ai * HALF + (m + 1) * 16)];
                const float rstd = rsqrtf(sq * (1.0f / 1024.0f) + 1e-6f);
#pragma unroll
                for (int bj = 0; bj < 2; ++bj) { const int ct = wc * 64 + bj * 32 + 8 * fq; f32x4 v0 = acc[ai][bj][m][0] * rstd, v1 = acc[ai][bj][m][1] * rstd;
                    const size_t o = (size_t)row * 1024 + u.pn * BM + ct; f32x4 e0, e1, r0, r1; unpack8(*(const u32x4*)(e + o), e0, e1); unpack8(*(const u32x4*)(x2 + o), r0, r1);
#pragma unroll
                    for (int i = 0; i < 4; ++i) { v0[i] = r0[i] + sigm(v0[i]) * e0[i]; v1[i] = r1[i] + sigm(v1[i]) * e1[i]; }
                    wx[bj] = pack8(v0, v1); }
                store_rows_bf16(x3, 1024, u.pm * BM + wr * 64 + ai * HALF + m * 16, u.pn * BM + wc * 64, fr, fq, wx[0], wx[1]); }
    }
};

template <class Epi, class Sched, bool ALIGN_EPI = false, bool SP2 = false>
__device__ __forceinline__ void gemm_phase(PG8_LAS unsigned char* lds, const Gemm g, const Sched& S, const Epi& E) {
    int tid_ = threadIdx.x; asm volatile("" : "+v"(tid_));
    const int tid = tid_, wid = __builtin_amdgcn_readfirstlane(tid >> 6), lane = tid & 63, wr = wid >> 2, wc = wid & 3, fr = lane & 15, fq = lane >> 4;
    int K_ = g.K; asm volatile("" : "+s"(K_));
    const int K = K_, nt = K / BK;
    unsigned voffA[2], voffB[2];
#pragma unroll
    for (int i = 0; i < 2; ++i) { int R, C; stage_rc(tid * 16 + i * 8192, R, C); const int Rb = Epi::PERM ? (2 * (R & ~31) + perm32(R & 31)) : R;
        voffA[i] = (unsigned)(R * K + C) * 2u; voffB[i] = (unsigned)(Rb * K + C) * 2u; }
    const size_t kstep = (size_t)(BK * 2);
    const size_t hstep = (size_t)HALF * K * 2;
    const size_t hstepB = Epi::PERM ? (size_t)32 * K * 2 : hstep;
    const size_t tstep = 2 * hstep;
    const unsigned ldsw = (unsigned)wid * 1024u;
    const int aoff = lds_byte(wr * 64 + fr, fq * 8), boff = lds_byte(wc * 32 + fr, fq * 8);
#define PG8_SA(b, h) (((b) * 2 + (h)) * HTB)
#define PG8_SB(b, h) ((4 + (b) * 2 + (h)) * HTB)
#define PG8_STAGE(bufoff, gbase, voff) do { _Pragma("unroll") for (int _i = 0; _i < 2; ++_i) \
        __builtin_amdgcn_global_load_lds((const unsigned*)((const char*)(gbase) + (voff)[_i]), (PG8_LAS unsigned*)(lds + (bufoff) + ldsw + _i * 8192), 16, 0, 0); } while (0)
#define PG8_LDA(dst, b, h) do { _Pragma("unroll") for (int m = 0; m < 4; ++m) _Pragma("unroll") for (int k = 0; k < 2; ++k) dst[m][k] = *(const PG8_LAS bf16x8*)(lds + PG8_SA(b, h) + aoff + m * 2048 + k * 1024); } while (0)
#define PG8_LDB(dst, b, h) do { _Pragma("unroll") for (int n = 0; n < 2; ++n) _Pragma("unroll") for (int k = 0; k < 2; ++k) dst[n][k] = *(const PG8_LAS bf16x8*)(lds + PG8_SB(b, h) + boff + n * 2048 + k * 1024); } while (0)
#define PG8_MMA(ai, bj, At, Bt) do { __builtin_amdgcn_s_setprio(1); _Pragma("unroll") for (int m = 0; m < 4; ++m) _Pragma("unroll") for (int n = 0; n < 2; ++n) _Pragma("unroll") for (int k = 0; k < 2; ++k) \
        acc[ai][bj][m][n] = __builtin_amdgcn_mfma_f32_16x16x32_bf16(Bt[n][k], At[m][k], acc[ai][bj][m][n], 0, 0, 0); __builtin_amdgcn_s_setprio(0); } while (0)
#define PG8_WAIT_V(n) asm volatile("s_waitcnt vmcnt(" #n ")" ::: "memory")
#define PG8_WAIT_L(n) asm volatile("s_waitcnt lgkmcnt(" #n ")" ::: "memory")
#define PG8_BAR __builtin_amdgcn_s_barrier()
#define PG8_SCHED __builtin_amdgcn_sched_barrier(0)
    Unit cur, nxt; int ui = 0;
    if (!S.next(0, cur)) return;
    f32x4 acc[2][2][4][2];
#pragma unroll
    for (int a = 0; a < 2; ++a)
#pragma unroll
        for (int b = 0; b < 2; ++b)
#pragma unroll
            for (int m = 0; m < 4; ++m)
#pragma unroll
                for (int n = 0; n < 2; ++n) acc[a][b][m][n] = (f32x4){0.f, 0.f, 0.f, 0.f};
    bf16x8 At[4][2], B0[2][2], B1[2][2];
    const char* cA = (const char*)g.A + (size_t)cur.pm * tstep; const char* cB = (const char*)g.Bt + (size_t)cur.pn * tstep;
    S.a_ready(cur);
    if constexpr (SP2) {
        PG8_STAGE(PG8_SB(0, 0), cB, voffB); PG8_STAGE(PG8_SB(0, 1), cB + hstepB, voffB); PG8_STAGE(PG8_SA(0, 0), cA, voffA); PG8_STAGE(PG8_SA(0, 1), cA + hstep, voffA);
        if (wr == 1) PG8_BAR;
        PG8_WAIT_V(2); PG8_BAR;
        PG8_STAGE(PG8_SB(1, 0), cB + kstep, voffB); PG8_STAGE(PG8_SA(1, 0), cA + kstep, voffA); PG8_STAGE(PG8_SB(1, 1), cB + hstepB + kstep, voffB);
        PG8_WAIT_V(6); PG8_BAR;
    } else {
        PG8_STAGE(PG8_SB(0, 0), cB, voffB); PG8_STAGE(PG8_SA(0, 0), cA, voffA); PG8_STAGE(PG8_SB(0, 1), cB + hstepB, voffB); PG8_STAGE(PG8_SA(0, 1), cA + hstep, voffA);
        if (wr == 1) PG8_BAR;
        PG8_WAIT_V(4); PG8_BAR;
        PG8_STAGE(PG8_SB(1, 0), cB + kstep, voffB); PG8_STAGE(PG8_SA(1, 0), cA + kstep, voffA); PG8_STAGE(PG8_SB(1, 1), cB + hstepB + kstep, voffB);
        PG8_WAIT_V(6); PG8_BAR;
    }
    for (;;) {
        const bool has_next = S.next(ui + 1, nxt);
        const char* nA = has_next ? (const char*)g.A + (size_t)nxt.pm * tstep : cA; const char* nB = has_next ? (const char*)g.Bt + (size_t)nxt.pn * tstep : cB;
        for (int t = 0; t < nt; t += 2) {
            if constexpr (Epi::MIDK) { if (t == (nt >> 1)) E.mid(acc, cur, wr, wc, fr, fq); }
            const bool last = (t == nt - 2);
            const char* a1 = cA + (size_t)(t + 1) * kstep;
            const char* a2 = last ? nA : cA + (size_t)(t + 2) * kstep; const char* b2 = last ? nB : cB + (size_t)(t + 2) * kstep;
            const char* a3 = a2 + kstep; const char* b3 = b2 + kstep;
            if (last && has_next) S.a_ready(nxt);
            if constexpr (SP2) {
            PG8_LDB(B0, 0, 0); PG8_LDB(B1, 0, 1); PG8_SCHED; PG8_LDA(At, 0, 0); PG8_STAGE(PG8_SA(1, 1), a1 + hstep, voffA);
            PG8_WAIT_V(8); PG8_WAIT_L(0); PG8_BAR; PG8_MMA(0, 0, At, B0); PG8_MMA(0, 1, At, B1); PG8_BAR; PG8_SCHED;
            PG8_LDA(At, 0, 1); PG8_STAGE(PG8_SB(0, 0), b2, voffB); PG8_STAGE(PG8_SB(0, 1), b2 + hstepB, voffB); PG8_STAGE(PG8_SA(0, 0), a2, voffA);
            PG8_WAIT_V(8); PG8_WAIT_L(0); PG8_BAR; PG8_MMA(1, 0, At, B0); PG8_MMA(1, 1, At, B1); PG8_BAR; PG8_SCHED;
            PG8_LDB(B0, 1, 0); PG8_LDB(B1, 1, 1); PG8_SCHED; PG8_LDA(At, 1, 0); PG8_STAGE(PG8_SA(0, 1), a2 + hstep, voffA);
            PG8_WAIT_V(8); PG8_WAIT_L(0); PG8_BAR; PG8_MMA(0, 0, At, B0); PG8_MMA(0, 1, At, B1); PG8_BAR; PG8_SCHED;
            PG8_LDA(At, 1, 1); PG8_STAGE(PG8_SB(1, 0), b3, voffB); PG8_STAGE(PG8_SB(1, 1), b3 + hstepB, voffB); PG8_STAGE(PG8_SA(1, 0), a3, voffA);
            PG8_WAIT_V(8); PG8_WAIT_L(0); PG8_BAR; PG8_MMA(1, 0, At, B0); PG8_MMA(1, 1, At, B1); PG8_BAR; PG8_SCHED;
            } else {
            PG8_LDB(B0, 0, 0); PG8_SCHED; PG8_LDA(At, 0, 0); PG8_STAGE(PG8_SA(1, 1), a1 + hstep, voffA);
            PG8_WAIT_L(8); PG8_BAR; PG8_WAIT_L(0); PG8_MMA(0, 0, At, B0); PG8_BAR; PG8_SCHED;
            PG8_LDB(B1, 0, 1); PG8_STAGE(PG8_SB(0, 0), b2, voffB);
            PG8_BAR; PG8_WAIT_L(0); PG8_MMA(0, 1, At, B1); PG8_BAR;
            PG8_LDA(At, 0, 1); PG8_STAGE(PG8_SA(0, 0), a2, voffA);
            PG8_BAR; PG8_WAIT_L(0); PG8_MMA(1, 0, At, B0); PG8_BAR; PG8_SCHED;
            PG8_STAGE(PG8_SB(0, 1), b2 + hstepB, voffB);
            PG8_WAIT_V(6); PG8_BAR; PG8_MMA(1, 1, At, B1); PG8_BAR;
            PG8_LDB(B0, 1, 0); PG8_SCHED; PG8_LDA(At, 1, 0); PG8_STAGE(PG8_SA(0, 1), a2 + hstep, voffA);
            PG8_WAIT_L(8); PG8_BAR; PG8_WAIT_L(0); PG8_MMA(0, 0, At, B0); PG8_BAR; PG8_SCHED;
            PG8_LDB(B1, 1, 1); PG8_STAGE(PG8_SB(1, 0), b3, voffB);
            PG8_BAR; PG8_WAIT_L(0); PG8_MMA(0, 1, At, B1); PG8_BAR;
            PG8_LDA(At, 1, 1); PG8_STAGE(PG8_SA(1, 0), a3, voffA);
            PG8_BAR; PG8_WAIT_L(0); PG8_MMA(1, 0, At, B0); PG8_BAR; PG8_SCHED;
            PG8_STAGE(PG8_SB(1, 1), b3 + hstepB, voffB);
            PG8_WAIT_V(6); PG8_BAR; PG8_MMA(1, 1, At, B1); PG8_BAR;
            }
        }
        if constexpr (ALIGN_EPI) { if (wr == 0) PG8_BAR; }
        if constexpr (!Epi::AFTER_DRAIN) { E(acc, cur, wr, wc, fr, fq); S.done(cur); }
        if (!has_next) break;
#pragma unroll
        for (int a = 0; a < 2; ++a)
#pragma unroll
            for (int b = 0; b < 2; ++b)
#pragma unroll
                for (int m = 0; m < 4; ++m)
#pragma unroll
                    for (int n = 0; n < 2; ++n) acc[a][b][m][n] = (f32x4){0.f, 0.f, 0.f, 0.f};
        cur = nxt; cA = nA; cB = nB; ++ui;
        if constexpr (ALIGN_EPI) { if (wr == 1) PG8_BAR; }
    }
    PG8_WAIT_V(0);
    if constexpr (!ALIGN_EPI) { if (wr == 0) PG8_BAR; }
    PG8_BAR;
    if constexpr (Epi::AFTER_DRAIN) { E.fused(acc, cur, wr, wc, fr, fq, lds, wid, lane); S.done(cur); }
#undef PG8_SA
#undef PG8_SB
#undef PG8_STAGE
#undef PG8_LDA
#undef PG8_LDB
#undef PG8_MMA
#undef PG8_WAIT_V
#undef PG8_WAIT_L
#undef PG8_BAR
#undef PG8_SCHED
}
}

#define GAS __attribute__((address_space(1)))
#define LAS __attribute__((address_space(3)))
typedef unsigned short bf16;
typedef unsigned v4u __attribute__((ext_vector_type(4)));
typedef unsigned v2u __attribute__((ext_vector_type(2)));
typedef float f32x4 __attribute__((ext_vector_type(4)));
using pg8::bf_lo; using pg8::bf_hi; using pg8::sigm;

constexpr int NTOK = 32768, SEQ = 16384, DM = 1024, NW = 8;
constexpr float EPS = 1e-6f;
constexpr float C2 = 0.125f * 1.4426950408889634f;
constexpr size_t MiB = 1u << 20;
constexpr size_t WS_W1T = 1 * MiB, WS_WAT = 12 * MiB, WS_WMT = 13 * MiB, WS_WOT = 14 * MiB, WS_WQT = 16 * MiB, WS_WGT = 20 * MiB, WS_WPT = 22 * MiB;
constexpr size_t WS_K1B = 22 * MiB + 512 * 1024, WS_K2B = 22 * MiB + 768 * 1024, WS_IF = 23 * MiB, WS_UB = 24 * MiB, WS_VB = 56 * MiB;
constexpr size_t WS_XN = 88 * MiB, WS_YA = 88 * MiB, WS_YM = 120 * MiB, WS_HN = 88 * MiB;
constexpr size_t WS_QKVA = 152 * MiB, WS_QKM = 248 * MiB, WS_VM = 312 * MiB, WS_OM = 344 * MiB, WS_G = 376 * MiB;
constexpr size_t WS_DN = 504 * MiB, WS_NS = 505 * MiB, WS_SC = 506 * MiB;
constexpr size_t WS_MERGED = 152 * MiB, WS_TMP = 216 * MiB, WS_Q2 = 376 * MiB, WS_IDX = 152 * MiB, WS_GATE = 168 * MiB, WS_HN2 = 184 * MiB, WS_PB = 56 * MiB, WS_E = 264 * MiB;
constexpr size_t WS_NEED = 507 * MiB;
constexpr size_t WS_U8 = 24 * MiB, WS_V8 = 40 * MiB, WS_PART = 376 * MiB, WS_SSQ = 506 * MiB + 512 * 1024;
constexpr size_t WS_HQH = 280 * MiB, WS_HQL = 296 * MiB, WS_HS = 312 * MiB;
constexpr size_t WS_X3B = 376 * MiB;
constexpr size_t WS_U4 = 24 * MiB, WS_V4 = 32 * MiB, WS_SU = 40 * MiB, WS_SV = 40 * MiB + 65536;
constexpr size_t WS_SSQ1 = 506 * MiB + 768 * 1024, WS_BAR = 0, BAR_BYTES = 32768;
constexpr size_t OUT_DC = 0, OUT_CS = 64 * MiB;
constexpr int LDS_BYTES = 151552;

__device__ __forceinline__ unsigned f2bf(float f) { unsigned u = __float_as_uint(f); return (u + 0x7fffu + ((u >> 16) & 1u)) >> 16; }
__device__ __forceinline__ unsigned pk2(float lo, float hi) { return f2bf(lo) | (f2bf(hi) << 16); }
__device__ __forceinline__ float bf2f(bf16 b) { return __uint_as_float((unsigned)b << 16); }
__device__ __forceinline__ float wave_sum(float v) {
#pragma unroll
    for (int o = 1; o < 64; o <<= 1) v += __shfl_xor(v, o);
    return v;
}
__device__ __forceinline__ float wave_max(float v) {
#pragma unroll
    for (int o = 1; o < 64; o <<= 1) v = fmaxf(v, __shfl_xor(v, o));
    return v;
}
__device__ __forceinline__ void unpk8(const v4u w, float* f) { f[0] = bf_lo(w.x); f[1] = bf_hi(w.x); f[2] = bf_lo(w.y); f[3] = bf_hi(w.y); f[4] = bf_lo(w.z); f[5] = bf_hi(w.z); f[6] = bf_lo(w.w); f[7] = bf_hi(w.w); }
__device__ __forceinline__ v4u pk8(const float* f) { v4u w; w.x = pk2(f[0], f[1]); w.y = pk2(f[2], f[3]); w.z = pk2(f[4], f[5]); w.w = pk2(f[6], f[7]); return w; }
typedef __bf16 bf16x2_t __attribute__((ext_vector_type(2)));
__device__ __forceinline__ float dot2bf(unsigned a, unsigned b, float c) { return __builtin_amdgcn_fdot2_f32_bf16(__builtin_bit_cast(bf16x2_t, a), __builtin_bit_cast(bf16x2_t, b), c, false); }
__device__ __forceinline__ float logsigmoid(float x) { return fminf(x, 0.f) - log1pf(__expf(-fabsf(x))); }
__device__ __forceinline__ float silu(float x) { return x * __builtin_amdgcn_rcpf(1.0f + __builtin_amdgcn_exp2f(-1.4426950408889634f * x)); }

#define XB_TMO      128
#define XB_XCNT(j)  (256  + 64 * (j))
#define XB_XSUB(j)  (1280 + 64 * (j))
#define XB_XGEN(j)  (2304 + 64 * (j))
#define XB_TOP      3328
#define XB_TOPGEN   3392
#define XCD_BAR_WORDS 3456
#define XB_SPIN_CAP (1u << 18)

__device__ __forceinline__ unsigned xb_ld(unsigned* p)              { return __hip_atomic_load(p, __ATOMIC_RELAXED, __HIP_MEMORY_SCOPE_AGENT); }
__device__ __forceinline__ unsigned xb_add(unsigned* p, unsigned v) { return __hip_atomic_fetch_add(p, v, __ATOMIC_RELAXED, __HIP_MEMORY_SCOPE_AGENT); }
__device__ __forceinline__ unsigned xb_xcc_id() { return (unsigned)__builtin_amdgcn_s_getreg((3 << 11) | 20) & 0xFu; }
#define XB_SPIN(cond, bar) do { unsigned _sp = 0; while (cond) { __builtin_amdgcn_s_sleep(1); \
    if ((++_sp & 255u) == 0u) { if (xb_ld(&(bar)[XB_TMO])) break; if (_sp > XB_SPIN_CAP) { atomicAdd(&(bar)[XB_TMO], 1u); break; } } } } while (0)

struct XcdBarrier {
    unsigned* bar; unsigned x;
    volatile LAS unsigned* st;
};

__device__ __forceinline__ XcdBarrier xcd_barrier_post(unsigned* bar, volatile LAS unsigned* st) {
    XcdBarrier b; b.bar = bar; b.x = xb_xcc_id(); b.st = st;
    if (threadIdx.x == 0) (void)xb_add(&bar[XB_XCNT(b.x)], 1u);
    return b;
}
__device__ __forceinline__ void xcd_barrier_complete(unsigned* bar, unsigned x, unsigned& nloc, unsigned& nx) {
    const unsigned G = gridDim.x * gridDim.y * gridDim.z;
    unsigned sum, cnt, mine, sp = 0u;
    for (;;) {
        sum = 0u; cnt = 0u; mine = 0u;
#pragma unroll
        for (unsigned j = 0; j < 16; ++j) { const unsigned c = xb_ld(&bar[XB_XCNT(j)]); sum += c; cnt += (c > 0u) ? 1u : 0u; mine = (j == x) ? c : mine; }
        if (sum == G) break;
        __builtin_amdgcn_s_sleep(1);
        if ((++sp & 255u) == 0u) { if (xb_ld(&bar[XB_TMO])) break; if (sp > XB_SPIN_CAP) { atomicAdd(&bar[XB_TMO], 1u); break; } }
    }
    nloc = mine > 0u ? mine : 1u; nx = cnt > 0u ? cnt : 1u;
}

__device__ __forceinline__ void xcd_barrier(const XcdBarrier& b) {
    asm volatile("s_waitcnt vmcnt(0)" ::: "memory");
    __syncthreads();
    if (threadIdx.x == 0) {
        unsigned* bar = b.bar;
        __builtin_amdgcn_s_waitcnt(0);
        unsigned nloc = b.st[0], nx = b.st[1];
        if (nloc == 0u) { xcd_barrier_complete(bar, b.x, nloc, nx); b.st[0] = nloc; b.st[1] = nx; }
        const unsigned old = xb_add(&bar[XB_XSUB(b.x)], 1u);
        const unsigned gen = old / nloc;
        if (old + 1u == (gen + 1u) * nloc) {
            __builtin_amdgcn_fence(__ATOMIC_RELEASE, "agent");
            asm volatile("s_waitcnt vmcnt(0)" ::: "memory");
            const unsigned og = xb_add(&bar[XB_TOP], 1u);
            const unsigned tg = og / nx;
            if (og + 1u == (tg + 1u) * nx) xb_add(&bar[XB_TOPGEN], 1u);
            else XB_SPIN(xb_ld(&bar[XB_TOPGEN]) == tg, bar);
            __builtin_amdgcn_fence(__ATOMIC_ACQUIRE, "agent");
            xb_add(&bar[XB_XGEN(b.x)], 1u);
            asm volatile("s_waitcnt vmcnt(0)" ::: "memory");
        } else {
            XB_SPIN(xb_ld(&bar[XB_XGEN(b.x)]) == gen, bar);
            __builtin_amdgcn_fence(__ATOMIC_ACQUIRE, "agent");
            asm volatile("s_waitcnt vmcnt(0)" ::: "memory");
        }
    }
    __syncthreads();
}


struct Params { const float* in[20]; float* out; unsigned char* ws; int ph_lo, ph_hi; };

__device__ __forceinline__ void transpose_item(const float* W, int ldw, int col0, int K, bf16* WT, int row0, LAS float* scr, int item, int nblk, int lane, int koff = 0, const float* kgain = nullptr) {
    const int kb = item / nblk, nb = item % nblk, k0 = 64 * kb, n0 = 32 * nb;
#pragma unroll 8
    for (int i = 0; i < 32; ++i) { const int kk = 2 * i + (lane >> 5); const float gk = kgain ? kgain[k0 + kk] : 1.0f; scr[kk * 33 + (lane & 31)] = W[(size_t)(k0 + kk) * ldw + col0 + n0 + (lane & 31)] * gk; }
    asm volatile("s_waitcnt lgkmcnt(0)" ::: "memory");
    const int c = lane & 7;
#pragma unroll
    for (int j = 0; j < 4; ++j) { const int n = (lane >> 3) + 8 * j; const LAS float* s = scr + (8 * c) * 33 + n;
        v4u o; o.x = pk2(s[0 * 33], s[1 * 33]); o.y = pk2(s[2 * 33], s[3 * 33]); o.z = pk2(s[4 * 33], s[5 * 33]); o.w = pk2(s[6 * 33], s[7 * 33]);
        *(v4u*)(WT + (size_t)(row0 + n0 + n) * K + koff + k0 + 8 * c) = o; }
    asm volatile("s_waitcnt lgkmcnt(0)" ::: "memory");
}
__device__ __forceinline__ void cvt_f32_bf16(const float* src, bf16* dst, size_t n4, size_t gtid, size_t gsz) {
    for (size_t i = gtid; i < n4; i += gsz) { const f32x4 v = ((const f32x4*)src)[i]; uint2 o; o.x = pk2(v[0], v[1]); o.y = pk2(v[2], v[3]); ((uint2*)dst)[i] = o; }
}
__device__ __forceinline__ void cvt_f32_fp8(const float* src, unsigned* dst, size_t n4, float sc, size_t gtid, size_t gsz) {
    for (size_t i = gtid; i < n4; i += gsz) { const f32x4 v = ((const f32x4*)src)[i]; int w = __builtin_amdgcn_cvt_pk_fp8_f32(v[0] * sc, v[1] * sc, 0, false); w = __builtin_amdgcn_cvt_pk_fp8_f32(v[2] * sc, v[3] * sc, w, true); dst[i] = (unsigned)w; }
}
__device__ __forceinline__ void rms_row_to_bf16(const float* xrow, const float* gain, bf16* orow, int lane) {
    f32x4 v[4]; float s = 0.f;
#pragma unroll
    for (int j = 0; j < 4; ++j) { v[j] = ((const f32x4*)xrow)[lane + 64 * j]; s += (v[j][0] * v[j][0] + v[j][1] * v[j][1]) + (v[j][2] * v[j][2] + v[j][3] * v[j][3]); }
    const float rstd = rsqrtf(wave_sum(s) * (1.f / 1024.f) + EPS);
#pragma unroll
    for (int j = 0; j < 4; ++j) { const f32x4 g = ((const f32x4*)gain)[lane + 64 * j]; uint2 o; o.x = pk2(v[j][0] * rstd * g[0], v[j][1] * rstd * g[1]); o.y = pk2(v[j][2] * rstd * g[2], v[j][3] * rstd * g[3]); ((uint2*)orow)[lane + 64 * j] = o; }
}
__device__ __forceinline__ void p0_prologue(const Params& P, LAS unsigned char* lds, int tid, int lane, int wave) {
    unsigned char* ws = P.ws;
    const int gw = blockIdx.x * NW + wave, NGW = gridDim.x * NW;
    LAS float* scr = (LAS float*)(lds + wave * 8448);
    LAS float* wif = (LAS float*)(lds + 69632);
    const float* w_in = P.in[3];
    for (int i = tid; i < 8192; i += 512) wif[i] = w_in[(size_t)(i >> 3) * 5640 + 3584 + (i & 7)];
    __syncthreads();
    constexpr int I1A = 16 * 112, I1B = 16 * 64, IUP = 8 * 32, IOUT = 16 * 32, IQ = 16 * 64, IPL = 4 * 32;
    constexpr int NITEMS = I1A + I1B + 2 * IUP + IOUT + IQ + IOUT + IPL;
    for (int it = gw; it < NITEMS; it += NGW) {
        int r = it;
        if (r < I1A) { transpose_item(w_in, 5640, 0, 1024, (bf16*)(ws + WS_W1T), 0, scr, r, 112, lane); continue; } r -= I1A;
        if (r < I1B) { transpose_item(w_in, 5640, 3592, 1024, (bf16*)(ws + WS_W1T), 3584, scr, r, 64, lane); continue; } r -= I1B;
        if (r < IUP) { transpose_item(P.in[7], 1024, 0, 1024, (bf16*)(ws + WS_WAT), 0, scr, r, 32, lane, 0); continue; } r -= IUP;
        if (r < IUP) { transpose_item(P.in[8], 1024, 0, 1024, (bf16*)(ws + WS_WAT), 0, scr, r, 32, lane, 512); continue; } r -= IUP;
        if (r < IOUT) { transpose_item(P.in[9], 1024, 0, 1024, (bf16*)(ws + WS_WOT), 0, scr, r, 32, lane); continue; } r -= IOUT;
        if (r < IQ) { transpose_item(P.in[11], 2048, 0, 1024, (bf16*)(ws + WS_WQT), 0, scr, r, 64, lane, 0, P.in[10]); continue; } r -= IQ;
        if (r < IOUT) { transpose_item(P.in[17], 1024, 0, 1024, (bf16*)(ws + WS_WGT), 0, scr, r, 32, lane, 0, P.in[16]); continue; } r -= IOUT;
        transpose_item(P.in[18], 1024, 0, 256, (bf16*)(ws + WS_WPT), 0, scr, r, 32, lane);
    }
    const size_t gtid = (size_t)blockIdx.x * 512 + tid, gsz = (size_t)gridDim.x * 512;
    cvt_f32_bf16(P.in[12], (bf16*)(ws + WS_K1B), 8 * 128 * 128 / 4, gtid, gsz);
    cvt_f32_bf16(P.in[13], (bf16*)(ws + WS_K2B), 8 * 128 * 128 / 4, gtid, gsz);
    for (int rw = gw; rw < 2 * 16384; rw += NGW) {
        const int tb_ = rw >> 14, e = rw & 16383; const float* src = P.in[14 + tb_] + (size_t)e * 1024;
        f32x4 v[4]; v[0] = ((const f32x4*)src)[2 * lane]; v[1] = ((const f32x4*)src)[2 * lane + 1]; v[2] = ((const f32x4*)src)[128 + 2 * lane]; v[3] = ((const f32x4*)src)[128 + 2 * lane + 1];
        if (!tb_) { const float* gf = P.in[10]; v[0] = v[0] * ((const f32x4*)gf)[2 * lane]; v[1] = v[1] * ((const f32x4*)gf)[2 * lane + 1]; v[2] = v[2] * ((const f32x4*)gf)[128 + 2 * lane]; v[3] = v[3] * ((const f32x4*)gf)[128 + 2 * lane + 1]; }
        float mx = 0.f, sq = 0.f;
#pragma unroll
        for (int j = 0; j < 4; ++j)
#pragma unroll
            for (int i = 0; i < 4; ++i) { mx = fmaxf(mx, fabsf(v[j][i])); sq += v[j][i] * v[j][i]; }
        mx = wave_max(mx);
        unsigned w0 = 0u, w1 = 0u; float sc;
        if (tb_) {
            sc = mx > 0.f ? mx * (1.0f / 6.0f) : 1.0f; const float inv = 1.0f / sc;
            w0 = __builtin_amdgcn_cvt_scalef32_pk_fp4_f32(w0, v[0][0] * inv, v[0][1] * inv, 1.0f, 0); w0 = __builtin_amdgcn_cvt_scalef32_pk_fp4_f32(w0, v[0][2] * inv, v[0][3] * inv, 1.0f, 1);
            w0 = __builtin_amdgcn_cvt_scalef32_pk_fp4_f32(w0, v[1][0] * inv, v[1][1] * inv, 1.0f, 2); w0 = __builtin_amdgcn_cvt_scalef32_pk_fp4_f32(w0, v[1][2] * inv, v[1][3] * inv, 1.0f, 3);
            w1 = __builtin_amdgcn_cvt_scalef32_pk_fp4_f32(w1, v[2][0] * inv, v[2][1] * inv, 1.0f, 0); w1 = __builtin_amdgcn_cvt_scalef32_pk_fp4_f32(w1, v[2][2] * inv, v[2][3] * inv, 1.0f, 1);
            w1 = __builtin_amdgcn_cvt_scalef32_pk_fp4_f32(w1, v[3][0] * inv, v[3][1] * inv, 1.0f, 2); w1 = __builtin_amdgcn_cvt_scalef32_pk_fp4_f32(w1, v[3][2] * inv, v[3][3] * inv, 1.0f, 3);
        } else {
            const float rms = sqrtf(wave_sum(sq) * (1.0f / 1024.0f)); const float clip = fminf(mx, 2.8f * rms);
            sc = clip > 0.f ? clip * (1.0f / 7.0f) : 1.0f; const float inv = 1.0f / sc;
#pragma unroll
            for (int i = 0; i < 4; ++i) { const int q0 = (int)fminf(fmaxf(rintf(v[0][i] * inv), -7.f), 7.f), q1 = (int)fminf(fmaxf(rintf(v[1][i] * inv), -7.f), 7.f), q2 = (int)fminf(fmaxf(rintf(v[2][i] * inv), -7.f), 7.f), q3 = (int)fminf(fmaxf(rintf(v[3][i] * inv), -7.f), 7.f);
                w0 |= ((unsigned)q0 & 15u) << (4 * i); w0 |= ((unsigned)q1 & 15u) << (16 + 4 * i); w1 |= ((unsigned)q2 & 15u) << (4 * i); w1 |= ((unsigned)q3 & 15u) << (16 + 4 * i); }
        }
        unsigned* dst = (unsigned*)(ws + (tb_ ? WS_V4 : WS_U4)) + (size_t)e * 128;
        dst[lane] = w0; dst[64 + lane] = w1;
        if (lane == 0) ((float*)(ws + (tb_ ? WS_SV : WS_SU)))[e] = sc;
    }
    cvt_f32_bf16(P.in[1], (bf16*)(ws + WS_PB), (size_t)NTOK * 256 / 4, gtid, gsz);
    for (size_t i = gtid; i < (size_t)NTOK; i += gsz) { ((float*)(ws + WS_SSQ))[i] = 0.f; ((float*)(ws + WS_SSQ1))[i] = 0.f; }
    const float* x = P.in[0]; const float* gmix = P.in[2]; const float* gbias = P.in[5];
    bf16* XN = (bf16*)(ws + WS_XN); float* IFb = (float*)(ws + WS_IF);
    for (int m = gw; m < NTOK; m += NGW) {
        const float* xrow = x + (size_t)m * 1024;
        f32x4 v[4];
#pragma unroll
        for (int j = 0; j < 4; ++j) v[j] = ((const f32x4*)xrow)[lane + 64 * j];
        float a16[16];
#pragma unroll
        for (int i = 0; i < 16; ++i) a16[i] = 0.f;
#pragma unroll
        for (int j = 0; j < 4; ++j) {
            const f32x4 g = ((const f32x4*)gmix)[lane + 64 * j];
#pragma unroll
            for (int i = 0; i < 4; ++i) { a16[0] += v[j][i] * v[j][i]; v[j][i] *= g[i]; const int d = 4 * (lane + 64 * j) + i; const f32x4 wa = *(const LAS f32x4*)(wif + d * 8), wb = *(const LAS f32x4*)(wif + d * 8 + 4);
                a16[1] += v[j][i] * wa[0]; a16[2] += v[j][i] * wa[1]; a16[3] += v[j][i] * wa[2]; a16[4] += v[j][i] * wa[3]; a16[5] += v[j][i] * wb[0]; a16[6] += v[j][i] * wb[1]; a16[7] += v[j][i] * wb[2]; a16[8] += v[j][i] * wb[3]; }
        }
        float r8[8], r4[4], r2[2], r1;
        { const bool b = lane & 32;
#pragma unroll
          for (int i = 0; i < 8; ++i) { const float keep = b ? a16[8 + i] : a16[i], send = b ? a16[i] : a16[8 + i]; r8[i] = keep + __shfl_xor(send, 32); } }
        { const bool b = lane & 16;
#pragma unroll
          for (int i = 0; i < 4; ++i) { const float keep = b ? r8[4 + i] : r8[i], send = b ? r8[i] : r8[4 + i]; r4[i] = keep + __shfl_xor(send, 16); } }
        { const bool b = lane & 8;
#pragma unroll
          for (int i = 0; i < 2; ++i) { const float keep = b ? r4[2 + i] : r4[i], send = b ? r4[i] : r4[2 + i]; r2[i] = keep + __shfl_xor(send, 8); } }
        { const bool b = lane & 4; const float keep = b ? r2[1] : r2[0], send = b ? r2[0] : r2[1]; r1 = keep + __shfl_xor(send, 4); }
        r1 += __shfl_xor(r1, 2); r1 += __shfl_xor(r1, 1);
        const float rstd = rsqrtf(__shfl(r1, 0) * (1.f / 1024.f) + EPS);
#pragma unroll
        for (int j = 0; j < 4; ++j) { uint2 o; o.x = pk2(v[j][0] * rstd, v[j][1] * rstd); o.y = pk2(v[j][2] * rstd, v[j][3] * rstd); ((uint2*)(XN + (size_t)m * 1024))[lane + 64 * j] = o; }
        const int which = ((lane >> 5) & 1) * 8 + ((lane >> 4) & 1) * 4 + ((lane >> 3) & 1) * 2 + ((lane >> 2) & 1);
        if ((lane & 3) == 0 && which >= 1 && which <= 8) IFb[(size_t)m * 8 + which - 1] = r1 * rstd + gbias[which - 1];
    }
}

typedef short bf16x8 __attribute__((ext_vector_type(8)));
typedef short v4i16 __attribute__((ext_vector_type(4)));
#define MFMA16(a, b, c) __builtin_amdgcn_mfma_f32_16x16x32_bf16((a), (b), (c), 0, 0, 0)
__device__ __forceinline__ void attn_pair_params(int pp, int& d, int& n0, int& sh) {
    if (pp < 5) { d = 16; sh = 4; n0 = -144 + 32 * pp; } else if (pp < 11) { d = 4; sh = 2; n0 = -128 + 32 * (pp - 5); } else { d = 1; sh = 0; n0 = -128 + 32 * (pp - 11); }
}
template <int MODE> __device__ __forceinline__ void attn_unit_params(int pp, int& d, int& n0, int& sh) {
    if (MODE == 0) { d = 1; sh = 0; n0 = -144 + 32 * pp; }
    else if (pp < 5) { d = 16; sh = 4; n0 = -144 + 32 * pp; } else { d = 4; sh = 2; n0 = -128 + 32 * (pp - 5); }
}
#define ATT_LOAD(SET, PPX) do { if ((PPX) < NP) { int d_, n_, sh_; attn_unit_params<MODE>((PPX), d_, n_, sh_); \
    _Pragma("unroll") for (int c = 0; c < 4; ++c) { int tok = t0 + d_ * (n_ + 8 * c + lrow); tok = min(max(tok, 0), SEQ - 1); const bf16* rp = base + 512 + (size_t)tok * 1536 + 8 * lch; \
        kr[SET][c] = *(const v4u*)rp; vr[SET][c] = *(const v4u*)(rp + 512); } } } while (0)
template <int MODE> __device__ __forceinline__ void attn_unit(const bf16* base, bf16* yrow0, int t0, int xidx, LAS float* partl, LAS unsigned char* kbuf, LAS unsigned char* vbuf, int lane) {
    constexpr int NP = MODE == 0 ? 5 : 11, NPAD = MODE == 0 ? 8 : 12;
    const int r = lane & 15, g = lane >> 4, lrow = lane >> 3, lch = lane & 7;
    const int trq = (lane >> 2) & 3, trp = lane & 3, tr_off = (4 * g + trq) * 160 + trp * 8;
    const int tq = MODE == 0 ? t0 + r : t0 + 16 * r;
    const bf16x8 qb0 = *(const bf16x8*)(base + (size_t)tq * 1536 + 8 * g), qb1 = *(const bf16x8*)(base + (size_t)tq * 1536 + 32 + 8 * g);
    f32x4 o[4]; float m, l;
    LAS float* xrow = partl + (MODE == 0 ? xidx + r : xidx + 16 * r) * 68;
    if (MODE == 0) {
#pragma unroll
        for (int i = 0; i < 4; ++i) o[i] = (f32x4){0.f, 0.f, 0.f, 0.f};
        m = -1e30f; l = 0.f;
    } else {
#pragma unroll
        for (int i = 0; i < 4; ++i) o[i] = *(const LAS f32x4*)(xrow + 16 * i + 4 * g);
        m = xrow[64]; l = g == 0 ? xrow[65] : 0.f;
    }
    v4u kr[4][4], vr[4][4];
    ATT_LOAD(0, 0); ATT_LOAD(1, 1); ATT_LOAD(2, 2); ATT_LOAD(3, 3);
#pragma unroll 1
    for (int pp0 = 0; pp0 < NPAD; pp0 += 4) {
#pragma unroll
        for (int u = 0; u < 4; ++u) {
            const int pp = pp0 + u;
            if (pp < NP) {
                int d, n0, sh; attn_unit_params<MODE>(pp, d, n0, sh);
                const int hi = MODE == 0 ? r : (r << (4 - sh)), lo = max(hi - 128, -(t0 >> sh));
                const int mbase = n0 + 4 * g - lo; const unsigned mspan = (unsigned)(hi - lo);
#pragma unroll
                for (int c = 0; c < 4; ++c) { *(LAS v4u*)(kbuf + (8 * c + lrow) * 144 + lch * 16) = kr[u][c]; *(LAS v4u*)(vbuf + (8 * c + lrow) * 160 + lch * 16) = vr[u][c]; }
                ATT_LOAD(u, pp + 4);
                f32x4 s0 = {0.f, 0.f, 0.f, 0.f}, s1 = {0.f, 0.f, 0.f, 0.f};
                { const bf16x8 k00 = *(const LAS bf16x8*)(kbuf + r * 144 + g * 16), k01 = *(const LAS bf16x8*)(kbuf + r * 144 + 64 + g * 16);
                  const bf16x8 k10 = *(const LAS bf16x8*)(kbuf + (16 + r) * 144 + g * 16), k11 = *(const LAS bf16x8*)(kbuf + (16 + r) * 144 + 64 + g * 16);
                  s0 = MFMA16(k00, qb0, s0); s0 = MFMA16(k01, qb1, s0); s1 = MFMA16(k10, qb0, s1); s1 = MFMA16(k11, qb1, s1); }
                float mx = -INFINITY;
#pragma unroll
                for (int k = 0; k < 4; ++k) { s0[k] = ((unsigned)(mbase + k) <= mspan) ? s0[k] : -INFINITY; s1[k] = ((unsigned)(mbase + 16 + k) <= mspan) ? s1[k] : -INFINITY; mx = fmaxf(mx, fmaxf(s0[k], s1[k])); }
                mx = fmaxf(mx, __shfl_xor(mx, 16)); mx = fmaxf(mx, __shfl_xor(mx, 32));
                if (__any(mx > m)) {
                    const float mn = fmaxf(m, mx), alpha = __builtin_amdgcn_exp2f(m - mn); m = mn; l *= alpha;
#pragma unroll
                    for (int i = 0; i < 4; ++i) o[i] = o[i] * alpha;
                }
                float p0[4], p1[4], ps = 0.f;
#pragma unroll
                for (int k = 0; k < 4; ++k) { p0[k] = __builtin_amdgcn_exp2f(s0[k] - m); p1[k] = __builtin_amdgcn_exp2f(s1[k] - m); ps += p0[k] + p1[k]; }
                l += ps;
                bf16x8 pb; { v4u w; w.x = pg8::cvt_pk_bf16(p0[0], p0[1]); w.y = pg8::cvt_pk_bf16(p0[2], p0[3]); w.z = pg8::cvt_pk_bf16(p1[0], p1[1]); w.w = pg8::cvt_pk_bf16(p1[2], p1[3]); pb = __builtin_bit_cast(bf16x8, w); }
                LAS unsigned char* vrd = vbuf + tr_off;
#pragma unroll
                for (int db = 0; db < 4; ++db) {
                    const v4i16 a0 = __builtin_amdgcn_ds_read_tr16_b64_v4i16((LAS v4i16*)(vrd + db * 32)), a1 = __builtin_amdgcn_ds_read_tr16_b64_v4i16((LAS v4i16*)(vrd + 16 * 160 + db * 32));
                    const bf16x8 va = __builtin_shufflevector(a0, a1, 0, 1, 2, 3, 4, 5, 6, 7);
                    o[db] = MFMA16(va, pb, o[db]);
                }
            }
        }
    }
    l += __shfl_xor(l, 16); l += __shfl_xor(l, 32);
    if (MODE == 0) {
#pragma unroll
        for (int i = 0; i < 4; ++i) *(LAS f32x4*)(xrow + 16 * i + 4 * g) = o[i];
        if (g == 0) { xrow[64] = m; xrow[65] = l; }
    } else {
        const float inv = __builtin_amdgcn_rcpf(l);
        bf16* yo = yrow0 + (size_t)tq * 1024 + 4 * g;
#pragma unroll
        for (int db = 0; db < 4; ++db) { uint2 w; w.x = pk2(o[db][0] * inv, o[db][1] * inv); w.y = pk2(o[db][2] * inv, o[db][3] * inv); *(uint2*)(yo + 16 * db) = w; }
    }
}
__device__ __forceinline__ void p2_attention(const Params& P, LAS unsigned char* lds, int lane, int wave, int vb) {
    const bf16* QKVA = (const bf16*)(P.ws + WS_QKVA); bf16* YA = (bf16*)(P.ws + WS_YA);
    LAS unsigned char* kbuf = lds + wave * 9728;
    LAS unsigned char* vbuf = kbuf + 4608;
    LAS float* partl = (LAS float*)(lds + 8 * 9728);
    for (int wi = vb; wi < 1024; wi += gridDim.x) {
        const int bh = wi >> 6, tb = wi & 63, b = bh >> 3, h = bh & 7;
        const bf16* base = QKVA + (size_t)b * SEQ * 1536 + h * 64;
        bf16* yrow0 = YA + (size_t)b * SEQ * 1024 + h * 64;
#pragma unroll 1
        for (int uu = 0; uu < 2; ++uu) { const int cu = wave * 2 + uu; attn_unit<0>(base, yrow0, tb * 256 + 16 * cu, 16 * cu, partl, kbuf, vbuf, lane); }
        __syncthreads();
#pragma unroll 1
        for (int uu = 0; uu < 2; ++uu) { const int rr = wave * 2 + uu; attn_unit<1>(base, yrow0, tb * 256 + rr, rr, partl, kbuf, vbuf, lane); }
        __syncthreads();
    }
}

__device__ __forceinline__ float conv_silu(const bf16* QKM, const float* cw, int b, int t, int ch) {
    float a = 0.f;
#pragma unroll
    for (int j = 0; j < 4; ++j) { const int tt = t - 3 + j; if (tt >= 0) a += cw[j * 1024 + ch] * bf2f(QKM[((size_t)b * SEQ + tt) * 1024 + ch]); }
    return silu(a);
}

__device__ __forceinline__ float scan_add(float v, int lane) {
#pragma unroll
    for (int o = 1; o < 64; o <<= 1) { const float u = __shfl_up(v, o); if (lane >= o) v += u; }
    return v;
}
__device__ __forceinline__ float scan_max(float v, int lane) {
#pragma unroll
    for (int o = 1; o < 64; o <<= 1) { const float u = __shfl_up(v, o); if (lane >= o) v = fmaxf(v, u); }
    return v;
}
__device__ __forceinline__ void conv16(const bf16* QKM, const float* cw, int b, int t0, int chan, float* out) {
    const bf16* src = QKM + (size_t)b * SEQ * 1024 + chan;
    const float w0 = cw[chan], w1 = cw[1024 + chan], w2 = cw[2048 + chan], w3 = cw[3072 + chan];
    float x0 = t0 >= 3 ? bf2f(src[(size_t)(t0 - 3) * 1024]) : 0.f, x1 = t0 >= 2 ? bf2f(src[(size_t)(t0 - 2) * 1024]) : 0.f, x2 = t0 >= 1 ? bf2f(src[(size_t)(t0 - 1) * 1024]) : 0.f;
#pragma unroll
    for (int i = 0; i < 16; ++i) { const float x3 = bf2f(src[(size_t)(t0 + i) * 1024]); out[i] = silu(w0 * x0 + w1 * x1 + w2 * x2 + w3 * x3); x0 = x1; x1 = x2; x2 = x3; }
}

__device__ __forceinline__ void p2_mlstm_local(const Params& P, LAS unsigned char* lds, int tid, int lane, int wave, int vb) {
    const bf16* QKM = (const bf16*)(P.ws + WS_QKM); const bf16* VM = (const bf16*)(P.ws + WS_VM); const float* IFb = (const float*)(P.ws + WS_IF);
    const float* cw = P.in[4];
    bf16* DC = (bf16*)((unsigned char*)P.out + OUT_DC); float* DN = (float*)(P.ws + WS_DN); float* SC = (float*)(P.ws + WS_SC);
    LAS bf16* KWT = (LAS bf16*)lds; LAS bf16* VT = (LAS bf16*)(lds + 18432); LAS float* sw = (LAS float*)(lds + 36864);
    const int r = lane & 15, g = lane >> 4;
    for (int item = vb; item < 2048; item += gridDim.x) {
        const int bh = item >> 8, c = item & 255, b = bh >> 2, h = bh & 3;
        if (wave == 0) {
            const size_t row = (size_t)b * SEQ + c * 64 + lane;
            const float lf = logsigmoid(IFb[row * 8 + 4 + h]), ip = IFb[row * 8 + h];
            const float bc = scan_add(lf, lane), gg = __shfl(bc, 63), ds = gg - bc + ip, ml = wave_max(ds);
            sw[lane] = __expf(ds - ml);
            if (lane == 0) { SC[item] = ml; SC[2048 + item] = gg; }
        }
        __syncthreads();
        { const int ch = tid & 127, sq = tid >> 7, s0 = sq * 16; float o[16];
          conv16(QKM, cw, b, c * 64 + s0, 512 + h * 128 + ch, o);
#pragma unroll
          for (int i = 0; i < 16; i += 2) *(LAS unsigned*)(KWT + ch * 72 + s0 + i) = pk2(o[i] * 0.08838834764831845f * sw[s0 + i], o[i + 1] * 0.08838834764831845f * sw[s0 + i + 1]);
          const bf16* vsrc = VM + ((size_t)b * SEQ + c * 64 + s0) * 512 + h * 128 + ch;
#pragma unroll
          for (int i = 0; i < 16; i += 2) *(LAS unsigned*)(VT + ch * 72 + s0 + i) = (unsigned)vsrc[(size_t)i * 512] | ((unsigned)vsrc[(size_t)(i + 1) * 512] << 16);
        }
        __syncthreads();
        {
          const bf16x8 vb0 = *(const LAS bf16x8*)(VT + (16 * wave + r) * 72 + 8 * g), vb1 = *(const LAS bf16x8*)(VT + (16 * wave + r) * 72 + 32 + 8 * g);
          bf16* dst = DC + (size_t)item * 16384 + (size_t)(16 * wave + r) * 128 + 4 * g;
#pragma unroll
          for (int eb = 0; eb < 8; ++eb) {
              const bf16x8 ka0 = *(const LAS bf16x8*)(KWT + (16 * eb + r) * 72 + 8 * g), ka1 = *(const LAS bf16x8*)(KWT + (16 * eb + r) * 72 + 32 + 8 * g);
              f32x4 acc = {0.f, 0.f, 0.f, 0.f};
              acc = MFMA16(ka0, vb0, acc); acc = MFMA16(ka1, vb1, acc);
              uint2 o; o.x = pk2(acc[0], acc[1]); o.y = pk2(acc[2], acc[3]); *(uint2*)(dst + 16 * eb) = o;
          }
        }
        if (tid < 128) { float a = 0.f;
#pragma unroll
            for (int cc = 0; cc < 8; ++cc) { float f[8]; unpk8(*(const LAS v4u*)(KWT + tid * 72 + 8 * cc), f);
#pragma unroll
                for (int k = 0; k < 8; ++k) a += f[k]; }
            DN[(size_t)item * 128 + tid] = a; }
        __syncthreads();
    }
}

__device__ __forceinline__ void p3_mlstm_scan(const Params& P, int tid, int vb) {
    const unsigned* __restrict__ DC = (const unsigned*)((unsigned char*)P.out + OUT_DC); unsigned* __restrict__ CS = (unsigned*)((unsigned char*)P.out + OUT_CS);
    const float* __restrict__ DN = (const float*)(P.ws + WS_DN); float* __restrict__ NS = (float*)(P.ws + WS_NS); float* SC = (float*)(P.ws + WS_SC);
    for (int gid = vb * 512 + tid; gid < 8 * 8192; gid += gridDim.x * 512) {
        const int bh = gid >> 13, idx = gid & 8191; const bool hasn = idx < 64;
        float C0 = 0.f, C1 = 0.f, n0 = 0.f, n1 = 0.f, m = 0.f;
        for (int j0 = 0; j0 < 256; j0 += 8) {
            unsigned d[8]; float ml[8], gg[8]; float2 dn[8];
#pragma unroll
            for (int u = 0; u < 8; ++u) { const int item = bh * 256 + j0 + u; d[u] = DC[(size_t)item * 8192 + idx]; ml[u] = SC[item]; gg[u] = SC[2048 + item];
                dn[u] = hasn ? *(const float2*)(DN + (size_t)item * 128 + 2 * idx) : make_float2(0.f, 0.f); }
#pragma unroll
            for (int u = 0; u < 8; ++u) { const int item = bh * 256 + j0 + u;
                CS[(size_t)item * 8192 + idx] = pk2(C0, C1);
                if (hasn) *(float2*)(NS + (size_t)item * 128 + 2 * idx) = make_float2(n0, n1);
                if (idx == 0) SC[4096 + item] = m;
                const float mn = fmaxf(gg[u] + m, ml[u]), a = __expf(gg[u] + m - mn), bb = __expf(ml[u] - mn);
                C0 = a * C0 + bb * bf_lo(d[u]); C1 = a * C1 + bb * bf_hi(d[u]); n0 = a * n0 + bb * dn[u].x; n1 = a * n1 + bb * dn[u].y; m = mn; }
        }
    }
}

struct P4Pref { v4u raw[7]; v4u cs[4]; uint2 om[4]; f32x4 gn; float ifa, ifb, nsv; };
__device__ __forceinline__ void p4_prefetch_raw(P4Pref& pf, const Params& P, int item, int tid, int lane) {
    const bf16* QKM = (const bf16*)(P.ws + WS_QKM); const bf16* VM = (const bf16*)(P.ws + WS_VM); const float* IFb = (const float*)(P.ws + WS_IF); const float* NS = (const float*)(P.ws + WS_NS);
    const int bh = item >> 8, c = item & 255, b = bh >> 2, h = bh & 3;
#pragma unroll
    for (int i = 0; i < 7; ++i) { const int v = tid + 512 * i; const int rr = v / 48, rem = v - rr * 48, seg = rem >> 4, c16 = rem & 15; const int t = c * 64 + rr - 3;
        v4u val = {0u, 0u, 0u, 0u};
        if (v < 3216 && t >= 0) val = (seg < 2) ? *(const v4u*)(QKM + ((size_t)b * SEQ + t) * 1024 + seg * 512 + h * 128 + 8 * c16) : *(const v4u*)(VM + ((size_t)b * SEQ + t) * 512 + h * 128 + 8 * c16);
        pf.raw[i] = val; }
    const size_t row = (size_t)b * SEQ + c * 64 + lane;
    pf.ifa = IFb[row * 8 + 4 + h]; pf.ifb = IFb[row * 8 + h];
    pf.nsv = NS[(size_t)item * 128 + (tid & 127)];
}
__device__ __forceinline__ void p4_prefetch_cs(P4Pref& pf, const Params& P, int item, int lane, int wave) {
    const bf16* CS = (const bf16*)((unsigned char*)P.out + OUT_CS);
    const bf16* crow = CS + (size_t)item * 16384 + (size_t)(16 * wave + (lane & 15)) * 128 + 8 * (lane >> 4);
#pragma unroll
    for (int ks = 0; ks < 4; ++ks) pf.cs[ks] = *(const v4u*)(crow + 32 * ks);
}
__device__ __forceinline__ void p4_prefetch_om(P4Pref& pf, const Params& P, int item, int lane, int wave) {
    const bf16* OM = (const bf16*)(P.ws + WS_OM);
    const int bh = item >> 8, c = item & 255, b = bh >> 2, h = bh & 3, r = lane & 15, g = lane >> 4;
#pragma unroll
    for (int tb = 0; tb < 4; ++tb) pf.om[tb] = *(const uint2*)(OM + ((size_t)b * SEQ + c * 64 + 16 * tb + r) * 512 + h * 128 + 16 * wave + 4 * g);
    pf.gn = *(const f32x4*)(P.in[6] + h * 128 + 16 * wave + 4 * g);
}
__device__ __forceinline__ void p4_mlstm_out(const Params& P, LAS unsigned char* lds, int tid, int lane, int wave, int vb) {
    const float* cw = P.in[4]; const float* SC = (const float*)(P.ws + WS_SC); bf16* YM = (bf16*)(P.ws + WS_YA);
    LAS float* CW = (LAS float*)lds;
    LAS unsigned char* RAW = lds + 16384;
    LAS bf16* Qs = (LAS bf16*)(lds + 68912); LAS bf16* Ks = (LAS bf16*)(lds + 86320); LAS bf16* VT = (LAS bf16*)(lds + 103728); LAS bf16* PT = (LAS bf16*)(lds + 122160);
    LAS float* sm = (LAS float*)(lds + 131376);
    LAS bf16* NSB = (LAS bf16*)(lds + 135728);
    const int r = lane & 15, g = lane >> 4;
    for (int i = tid; i < 1024; i += 512) ((LAS f32x4*)CW)[i] = ((const f32x4*)cw)[i];
    P4Pref pf;
    if (vb < 2048) { p4_prefetch_raw(pf, P, vb, tid, lane); p4_prefetch_cs(pf, P, vb, lane, wave); p4_prefetch_om(pf, P, vb, lane, wave); }
    for (int item = vb; item < 2048; item += gridDim.x) {
        const int bh = item >> 8, c = item & 255, b = bh >> 2, h = bh & 3;
#pragma unroll
        for (int i = 0; i < 7; ++i) { const int v = tid + 512 * i; if (v < 3216) { const int rr = v / 48, rem = v - rr * 48; *(LAS v4u*)(RAW + rr * 784 + rem * 16) = pf.raw[i]; } }
        if (tid < 128) NSB[tid] = (bf16)f2bf(pf.nsv);
        if (wave == 0) {
            const float lf = logsigmoid(pf.ifa), ip = pf.ifb;
            const float bc = scan_add(lf, lane), a = ip - bc, pm = scan_max(a, lane), ms = SC[4096 + item], M = fmaxf(ms, pm);
            sm[lane] = a; sm[64 + lane] = M; sm[128 + lane] = __expf(ms - M); sm[192 + lane] = __expf(-bc - M);
        }
        __syncthreads();
        { const int g4 = tid & 31, s0 = (tid >> 5) * 4;
#pragma unroll
          for (int tile = 0; tile < 2; ++tile) {
              float x[7][4];
#pragma unroll
              for (int j = 0; j < 7; ++j) { const v2u rv = *(const LAS v2u*)(RAW + (s0 + j) * 784 + tile * 256 + g4 * 8); x[j][0] = bf_lo(rv.x); x[j][1] = bf_hi(rv.x); x[j][2] = bf_lo(rv.y); x[j][3] = bf_hi(rv.y); }
              f32x4 w[4];
#pragma unroll
              for (int tp = 0; tp < 4; ++tp) w[tp] = *(const LAS f32x4*)(CW + tp * 1024 + tile * 512 + h * 128 + 4 * g4);
              const float sc = tile ? 0.08838834764831845f : 1.0f; LAS bf16* dst = tile ? Ks : Qs;
#pragma unroll
              for (int j = 0; j < 4; ++j) { float y[4];
#pragma unroll
                  for (int i = 0; i < 4; ++i) y[i] = silu(w[0][i] * x[j][i] + w[1][i] * x[j + 1][i] + w[2][i] * x[j + 2][i] + w[3][i] * x[j + 3][i]) * sc;
                  v2u o; o.x = pk2(y[0], y[1]); o.y = pk2(y[2], y[3]); *(LAS v2u*)(dst + (s0 + j) * 136 + 4 * g4) = o; }
          }
          const int ch = tid & 127, sv = (tid >> 7) * 16;
#pragma unroll
          for (int i = 0; i < 16; i += 2) { const unsigned lo = *(const LAS bf16*)(RAW + (3 + sv + i) * 784 + 512 + ch * 2), hi = *(const LAS bf16*)(RAW + (4 + sv + i) * 784 + 512 + ch * 2);
              *(LAS unsigned*)(VT + ch * 72 + sv + i) = lo | (hi << 16); }
        }
        asm volatile("" ::: "memory");
        if (item + (int)gridDim.x < 2048) p4_prefetch_raw(pf, P, item + gridDim.x, tid, lane);
        __syncthreads();
        { const int sb = wave >> 1;
          bf16x8 ka[4];
#pragma unroll
          for (int ks = 0; ks < 4; ++ks) ka[ks] = *(const LAS bf16x8*)(Ks + (16 * sb + r) * 136 + 32 * ks + 8 * g);
#pragma unroll
          for (int tt = 0; tt < 2; ++tt) { const int tb = 2 * (wave & 1) + tt, t = 16 * tb + r;
              f32x4 acc = {0.f, 0.f, 0.f, 0.f};
#pragma unroll
              for (int ks = 0; ks < 4; ++ks) { const bf16x8 qb = *(const LAS bf16x8*)(Qs + t * 136 + 32 * ks + 8 * g); acc = MFMA16(ka[ks], qb, acc); }
              const float Mt = sm[64 + t]; float p[4], ps = 0.f;
#pragma unroll
              for (int k = 0; k < 4; ++k) { const int s = 16 * sb + 4 * g + k; p[k] = (s <= t) ? acc[k] * __expf(sm[s] - Mt) : 0.f; ps += p[k]; }
              v2u o; o.x = pk2(p[0], p[1]); o.y = pk2(p[2], p[3]); *(LAS v2u*)(PT + t * 72 + 16 * sb + 4 * g) = o;
              ps += __shfl_xor(ps, 16); ps += __shfl_xor(ps, 32);
              if (g == 0) sm[320 + sb * 64 + t] = ps; }
        }
        __syncthreads();
        f32x4 ai[4], ac[4], an[4];
#pragma unroll
        for (int tb = 0; tb < 4; ++tb) { ai[tb] = (f32x4){0.f, 0.f, 0.f, 0.f}; ac[tb] = (f32x4){0.f, 0.f, 0.f, 0.f}; an[tb] = (f32x4){0.f, 0.f, 0.f, 0.f}; }
        { const bf16x8 va0 = *(const LAS bf16x8*)(VT + (16 * wave + r) * 72 + 8 * g), va1 = *(const LAS bf16x8*)(VT + (16 * wave + r) * 72 + 32 + 8 * g);
          const bf16x8 ca0 = __builtin_bit_cast(bf16x8, pf.cs[0]), ca1 = __builtin_bit_cast(bf16x8, pf.cs[1]), ca2 = __builtin_bit_cast(bf16x8, pf.cs[2]), ca3 = __builtin_bit_cast(bf16x8, pf.cs[3]);
          const bf16x8 zero8 = {0, 0, 0, 0, 0, 0, 0, 0};
#pragma unroll
          for (int tb = 0; tb < 4; ++tb) { const int t = 16 * tb + r;
              const bf16x8 pb0 = *(const LAS bf16x8*)(PT + t * 72 + 8 * g), pb1 = *(const LAS bf16x8*)(PT + t * 72 + 32 + 8 * g);
              ai[tb] = MFMA16(va0, pb0, ai[tb]); ai[tb] = MFMA16(va1, pb1, ai[tb]);
              const bf16x8 q0 = *(const LAS bf16x8*)(Qs + t * 136 + 8 * g), q1 = *(const LAS bf16x8*)(Qs + t * 136 + 32 + 8 * g), q2 = *(const LAS bf16x8*)(Qs + t * 136 + 64 + 8 * g), q3 = *(const LAS bf16x8*)(Qs + t * 136 + 96 + 8 * g);
              ac[tb] = MFMA16(ca0, q0, ac[tb]); ac[tb] = MFMA16(ca1, q1, ac[tb]); ac[tb] = MFMA16(ca2, q2, ac[tb]); ac[tb] = MFMA16(ca3, q3, ac[tb]);
              if (wave == 0) {
                  const bf16x8 n0 = r == 0 ? *(const LAS bf16x8*)(NSB + 8 * g) : zero8, n1 = r == 0 ? *(const LAS bf16x8*)(NSB + 32 + 8 * g) : zero8, n2 = r == 0 ? *(const LAS bf16x8*)(NSB + 64 + 8 * g) : zero8, n3 = r == 0 ? *(const LAS bf16x8*)(NSB + 96 + 8 * g) : zero8;
                  an[tb] = MFMA16(n0, q0, an[tb]); an[tb] = MFMA16(n1, q1, an[tb]); an[tb] = MFMA16(n2, q2, an[tb]); an[tb] = MFMA16(n3, q3, an[tb]);
                  if (g == 0) { const float den = sm[128 + t] * an[tb][0] + (sm[320 + t] + sm[384 + t]) + (sm[448 + t] + sm[512 + t]); sm[256 + t] = fmaxf(fabsf(den), sm[192 + t]); } } }
        }
        asm volatile("" ::: "memory");
        if (item + (int)gridDim.x < 2048) p4_prefetch_cs(pf, P, item + gridDim.x, lane, wave);
#pragma unroll
        for (int tb = 0; tb < 4; ++tb) { const int t = 16 * tb + r; const float wi = sm[128 + t]; float s2 = 0.f;
#pragma unroll
            for (int k = 0; k < 4; ++k) { ai[tb][k] = wi * ac[tb][k] + ai[tb][k]; s2 += ai[tb][k] * ai[tb][k]; }
            s2 += __shfl_xor(s2, 16); s2 += __shfl_xor(s2, 32);
            if (g == 0) sm[576 + wave * 64 + t] = s2; }
        __syncthreads();
        {
#pragma unroll
          for (int tb = 0; tb < 4; ++tb) { const int t = 16 * tb + r; float tot = 0.f;
#pragma unroll
              for (int w = 0; w < 8; ++w) tot += sm[576 + w * 64 + t];
              const float inv = __builtin_amdgcn_rcpf(sm[256 + t]), rs = inv * rsqrtf(tot * inv * inv * (1.f / 128.f) + EPS);
              const size_t row = (size_t)b * SEQ + c * 64 + t; const int col = h * 128 + 16 * wave + 4 * g;
              uint2 o; o.x = pk2(ai[tb][0] * rs * pf.gn[0] * bf_lo(pf.om[tb].x), ai[tb][1] * rs * pf.gn[1] * bf_hi(pf.om[tb].x)); o.y = pk2(ai[tb][2] * rs * pf.gn[2] * bf_lo(pf.om[tb].y), ai[tb][3] * rs * pf.gn[3] * bf_hi(pf.om[tb].y));
              *(uint2*)(YM + row * 1024 + 512 + col) = o; }
        }
        asm volatile("" ::: "memory");
        if (item + (int)gridDim.x < 2048) p4_prefetch_om(pf, P, item + gridDim.x, lane, wave);
        __syncthreads();
    }
}

__device__ __forceinline__ int f2ord(float f) { const int b = __float_as_int(f); return b ^ ((b >> 31) & 0x7fffffff); }
__device__ __forceinline__ float ord2f(int o) { return __int_as_float(o ^ ((o >> 31) & 0x7fffffff)); }
#define CE_DESC(a, i, j) { const int _h = max(a[i], a[j]), _l = min(a[i], a[j]); a[i] = _h; a[j] = _l; }
__device__ __forceinline__ void sort16_desc(int (&a)[16]) {
#pragma unroll
    for (int k = 2; k <= 16; k <<= 1) {
#pragma unroll
        for (int j = k >> 1; j > 0; j >>= 1) {
#pragma unroll
            for (int i = 0; i < 16; ++i) { const int l = i ^ j; if (l > i) { if ((i & k) == 0) CE_DESC(a, i, l) else CE_DESC(a, l, i) } }
        }
    }
}
__device__ __forceinline__ void merge16_desc(int (&a)[16], const int (&b)[16]) {
#pragma unroll
    for (int i = 0; i < 16; ++i) a[i] = max(a[i], b[15 - i]);
#pragma unroll
    for (int j = 8; j > 0; j >>= 1) {
#pragma unroll
        for (int i = 0; i < 16; ++i) { const int l = i ^ j; if (l > i) CE_DESC(a, i, l) }
    }
}
__device__ __forceinline__ void xmerge16(int (&a)[16], int mask) {
    int b[16];
#pragma unroll
    for (int i = 0; i < 16; ++i) b[i] = __shfl_xor(a[i], mask);
    merge16_desc(a, b);
}
__device__ __forceinline__ void p10_quant_rows(const Params& P, int lane, int wave, int vb) {
    const bf16* HN = (const bf16*)(P.ws + WS_HN); unsigned* HQH = (unsigned*)(P.ws + WS_HQH); unsigned* HQL = (unsigned*)(P.ws + WS_HQL); float* HS = (float*)(P.ws + WS_HS);
    for (int t = vb * NW + wave; t < NTOK; t += gridDim.x * NW) {
        float y[16]; unpk8(((const v4u*)(HN + (size_t)t * 1024))[2 * lane], y); unpk8(((const v4u*)(HN + (size_t)t * 1024))[2 * lane + 1], y + 8);
        float cm = 0.f;
#pragma unroll
        for (int i = 0; i < 16; ++i) cm = fmaxf(cm, fabsf(y[i]));
        cm = fmaxf(cm, __shfl_xor(cm, 1));
        const float sc = cm > 0.f ? cm * (1.0f / 119.0f) : 1.0f, inv = 1.0f / sc; unsigned dh[2] = {0u, 0u}, dl[2] = {0u, 0u};
#pragma unroll
        for (int i = 0; i < 16; ++i) { const int h = (int)rintf(y[i] * inv), lo = ((h + 8) & 15) - 8;
            dl[i >> 3] |= ((unsigned)lo & 15u) << (4 * (i & 7)); dh[i >> 3] |= ((unsigned)((h - lo) >> 4) & 15u) << (4 * (i & 7)); }
        *(uint2*)(HQH + (size_t)t * 128 + 2 * lane) = make_uint2(dh[0], dh[1]); *(uint2*)(HQL + (size_t)t * 128 + 2 * lane) = make_uint2(dl[0], dl[1]);
        if ((lane & 1) == 0) HS[(size_t)t * 32 + (lane >> 1)] = sc;
    }
}
__device__ __forceinline__ void p10_topk(const Params& P, LAS unsigned char* lds, int tid, int lane, int wave, int vb) {
    const bf16* Q2 = (const bf16*)(P.ws + WS_Q2); const bf16* K1B = (const bf16*)(P.ws + WS_K1B); const bf16* K2B = (const bf16*)(P.ws + WS_K2B);
    int* IDX = (int*)(P.ws + WS_IDX); float* GATE = (float*)(P.ws + WS_GATE); const float* SSQ1 = (const float*)(P.ws + WS_SSQ1);
    LAS bf16* Kl = (LAS bf16*)lds;
    LAS int* Tb = (LAS int*)(lds + 69632 + wave * 2048);
    const int r = lane & 15, g = lane >> 4;
    const int h = vb & 7, wgx = vb >> 3, nwg = gridDim.x >> 3;
    __syncthreads();
    for (int i = tid; i < 4096; i += 512) { const int half = i >> 11, rem = i & 2047, n = rem >> 4, c = rem & 15;
        *(LAS v4u*)(Kl + half * 17408 + n * 136 + c * 8) = *(const v4u*)((half ? K2B : K1B) + (size_t)h * 16384 + n * 128 + c * 8); }
    __syncthreads();
    for (int tile = wgx * NW + wave; tile < NTOK / 16; tile += nwg * NW) {
        const size_t row = (size_t)tile * 16 + r;
        int R[2][16];
#pragma unroll
        for (int half = 0; half < 2; ++half) {
            bf16x8 qb[4];
#pragma unroll
            for (int ks = 0; ks < 4; ++ks) qb[ks] = *(const bf16x8*)(Q2 + row * 2048 + h * 256 + half * 128 + 32 * ks + 8 * g);
            int X[16], Y[16];
#pragma unroll
            for (int nb = 0; nb < 8; ++nb) {
                f32x4 acc = {0.f, 0.f, 0.f, 0.f};
#pragma unroll
                for (int ks = 0; ks < 4; ++ks) acc = MFMA16(*(const LAS bf16x8*)(Kl + half * 17408 + (16 * nb + r) * 136 + 32 * ks + 8 * g), qb[ks], acc);
#pragma unroll
                for (int k = 0; k < 4; ++k) { const int key = (f2ord(acc[k]) & ~0x7f) | (16 * nb + 4 * g + k); if (nb < 4) X[4 * nb + k] = key; else Y[4 * (nb - 4) + k] = key; }
            }
            sort16_desc(X); sort16_desc(Y); merge16_desc(X, Y);
            xmerge16(X, 16); xmerge16(X, 32);
#pragma unroll
            for (int i = 0; i < 16; ++i) R[half][i] = X[i];
        }
        if (g == 0) {
#pragma unroll
            for (int i = 0; i < 16; ++i) { Tb[r * 32 + i] = R[0][i] & 0x7f; Tb[r * 32 + 16 + i] = R[1][i] & 0x7f; }
        }
        float F1[16], F2[16];
#pragma unroll
        for (int i = 0; i < 16; ++i) { F1[i] = ord2f(R[0][i] & ~0x7f); F2[i] = ord2f(R[1][i] & ~0x7f); }
        int C[16];
#pragma unroll
        for (int sl = 0; sl < 16; ++sl) {
            const int a1 = sl < 8 ? 1 : (sl < 13 ? 2 : -1), b1 = sl < 8 ? sl : sl - 8;
            const int a2 = sl < 4 ? 3 : (sl < 7 ? 4 : (sl < 9 ? 5 : (sl < 11 ? 6 : (sl < 13 ? 7 : -1)))), b2 = sl < 4 ? sl : (sl < 7 ? sl - 4 : (sl < 9 ? sl - 7 : (sl < 11 ? sl - 9 : sl - 11)));
            const int a3 = sl < 8 ? 8 + sl : -1;
            const int k0 = (f2ord(F1[0] + F2[sl]) & ~0xff) | (0 << 4) | sl;
            const int k1 = a1 >= 0 ? ((f2ord(F1[a1 < 0 ? 0 : a1] + F2[b1 & 15]) & ~0xff) | (a1 << 4) | (b1 & 15)) : (int)0x80000000;
            const int k2 = a2 >= 0 ? ((f2ord(F1[a2 < 0 ? 0 : a2] + F2[b2 & 15]) & ~0xff) | (a2 << 4) | (b2 & 15)) : (int)0x80000000;
            const int k3 = a3 >= 0 ? ((f2ord(F1[a3 < 0 ? 0 : a3] + F2[0]) & ~0xff) | (a3 << 4)) : (int)0x80000000;
            C[sl] = g == 0 ? k0 : (g == 1 ? k1 : (g == 2 ? k2 : k3));
        }
        sort16_desc(C); xmerge16(C, 16); xmerge16(C, 32);
        const float rstd1 = rsqrtf(SSQ1[row] * (1.0f / 1024.0f) + EPS);
        float e[16], sum = 0.f; const float mx = ord2f(C[0] & ~0xff);
#pragma unroll
        for (int i = 0; i < 16; ++i) { e[i] = __expf((ord2f(C[i] & ~0xff) - mx) * rstd1); sum += e[i]; }
        const float inv = __builtin_amdgcn_rcpf(sum);
        int oi[4]; float og[4];
#pragma unroll
        for (int kk = 0; kk < 4; ++kk) {
            const int key = g == 0 ? C[kk] : (g == 1 ? C[4 + kk] : (g == 2 ? C[8 + kk] : C[12 + kk]));
            const float ev = g == 0 ? e[kk] : (g == 1 ? e[4 + kk] : (g == 2 ? e[8 + kk] : e[12 + kk]));
            const int a = (key >> 4) & 15, bq = key & 15;
            oi[kk] = Tb[r * 32 + a] * 128 + Tb[r * 32 + 16 + bq]; og[kk] = ev * inv;
        }
#pragma unroll
        for (int kk = 0; kk < 4; ++kk) { const int pos = (4 * (g & 1) + kk) * 16 + 2 * h + (g >> 1); IDX[row * 128 + pos] = oi[kk]; GATE[row * 128 + pos] = og[kk]; }
    }
}

typedef _Float16 f16x2 __attribute__((ext_vector_type(2)));
__device__ __forceinline__ f16x2 bfpair_to_h2(unsigned w) { return __builtin_bit_cast(f16x2, __builtin_amdgcn_cvt_pkrtz(bf_lo(w), bf_hi(w))); }
template <int B> __device__ __forceinline__ f16x2 fp4_to_h2(unsigned w) { return __builtin_bit_cast(f16x2, __builtin_amdgcn_cvt_scalef32_pk_f16_fp4(w, 1.0f, B)); }
__device__ __forceinline__ void p11a_reduce_store(const v4u (&ud)[16], const v4u hh, const v4u hl, const float hsc, float* PART, int t, int x, int rg, int ch) {
    float z[16];
#pragma unroll
    for (int gq = 0; gq < 16; ++gq) {
        int ah = __builtin_amdgcn_sdot8((int)ud[gq].x, (int)hh.x, 0, false), al = __builtin_amdgcn_sdot8((int)ud[gq].x, (int)hl.x, 0, false);
        ah = __builtin_amdgcn_sdot8((int)ud[gq].y, (int)hh.y, ah, false); al = __builtin_amdgcn_sdot8((int)ud[gq].y, (int)hl.y, al, false);
        ah = __builtin_amdgcn_sdot8((int)ud[gq].z, (int)hh.z, ah, false); al = __builtin_amdgcn_sdot8((int)ud[gq].z, (int)hl.z, al, false);
        ah = __builtin_amdgcn_sdot8((int)ud[gq].w, (int)hh.w, ah, false); al = __builtin_amdgcn_sdot8((int)ud[gq].w, (int)hl.w, al, false);
        z[gq] = (float)(16 * ah + al) * hsc; }
    float z8[8], z4[4], z2[2];
    { const bool b = ch & 4;
#pragma unroll
      for (int i = 0; i < 8; ++i) { const float keep = b ? z[8 + i] : z[i], send = b ? z[i] : z[8 + i]; z8[i] = keep + __shfl_xor(send, 4); } }
    { const bool b = ch & 2;
#pragma unroll
      for (int i = 0; i < 4; ++i) { const float keep = b ? z8[4 + i] : z8[i], send = b ? z8[i] : z8[4 + i]; z4[i] = keep + __shfl_xor(send, 2); } }
    { const bool b = ch & 1;
#pragma unroll
      for (int i = 0; i < 2; ++i) { const float keep = b ? z4[2 + i] : z4[i], send = b ? z4[i] : z4[2 + i]; z2[i] = keep + __shfl_xor(send, 1); } }
    *(float2*)(PART + ((size_t)t * 4 + x) * 128 + rg * 16 + 2 * ch) = make_float2(z2[0], z2[1]);
}
__device__ __forceinline__ void p11a_udot(const Params& P, int lane, int wave, int vb) {
    const unsigned* HQH = (const unsigned*)(P.ws + WS_HQH); const unsigned* HQL = (const unsigned*)(P.ws + WS_HQL); const float* HS = (const float*)(P.ws + WS_HS);
    const unsigned char* U4 = P.ws + WS_U4; const int* IDX = (const int*)(P.ws + WS_IDX); float* PART = (float*)(P.ws + WS_PART);
    const int x = vb & 3, wgx = vb >> 2, nwg = gridDim.x >> 2, rg = lane >> 3, ch = lane & 7;
    const int tstep = nwg * NW;
    for (int t = wgx * NW + wave; t < NTOK; t += 2 * tstep) {
        const int tB = t + tstep;
        int eA[16], eB[16];
#pragma unroll
        for (int q = 0; q < 4; ++q) { const int4 v = *(const int4*)(IDX + (size_t)t * 128 + rg * 16 + 4 * q); eA[4 * q] = v.x; eA[4 * q + 1] = v.y; eA[4 * q + 2] = v.z; eA[4 * q + 3] = v.w;
            const int4 w = *(const int4*)(IDX + (size_t)tB * 128 + rg * 16 + 4 * q); eB[4 * q] = w.x; eB[4 * q + 1] = w.y; eB[4 * q + 2] = w.z; eB[4 * q + 3] = w.w; }
        const v4u hhA = *(const v4u*)(HQH + (size_t)t * 128 + 32 * x + 4 * ch), hlA = *(const v4u*)(HQL + (size_t)t * 128 + 32 * x + 4 * ch);
        const v4u hhB = *(const v4u*)(HQH + (size_t)tB * 128 + 32 * x + 4 * ch), hlB = *(const v4u*)(HQL + (size_t)tB * 128 + 32 * x + 4 * ch);
        const float hsA = HS[(size_t)t * 32 + 8 * x + ch], hsB = HS[(size_t)tB * 32 + 8 * x + ch];
        v4u udA[16], udB[16];
#pragma unroll
        for (int gq = 0; gq < 16; ++gq) udA[gq] = *(const v4u*)(U4 + (size_t)eA[gq] * 512 + 128 * x + 16 * ch);
#pragma unroll
        for (int gq = 0; gq < 16; ++gq) udB[gq] = *(const v4u*)(U4 + (size_t)eB[gq] * 512 + 128 * x + 16 * ch);
        p11a_reduce_store(udA, hhA, hlA, hsA, PART, t, x, rg, ch);
        p11a_reduce_store(udB, hhB, hlB, hsB, PART, tB, x, rg, ch);
    }
}
__device__ __forceinline__ void p11b_weights(const Params& P, int tid, int vb) {
    const float* PART = (const float*)(P.ws + WS_PART); float* GW = (float*)(P.ws + WS_GATE); const float* SSQ1 = (const float*)(P.ws + WS_SSQ1);
    const int* IDX = (const int*)(P.ws + WS_IDX); const float* SU = (const float*)(P.ws + WS_SU); const float* SV = (const float*)(P.ws + WS_SV);
    for (size_t i = (size_t)vb * 512 + tid; i < (size_t)NTOK * 128; i += (size_t)gridDim.x * 512) {
        const size_t t = i >> 7, pos = i & 127; float zs = 0.f;
#pragma unroll
        for (int x = 0; x < 4; ++x) zs += PART[(t * 4 + x) * 128 + pos];
        const int e = IDX[i];
        const float zv = zs * SU[e] * rsqrtf(SSQ1[t] * (1.0f / 1024.0f) + EPS);
        GW[i] = GW[i] * 0.5f * zv * (1.0f + erff(zv * 0.70710678118654752f)) * SV[e];
    }
}
__device__ __forceinline__ void p11c_vacc(const Params& P, int lane, int wave, int vb) {
    const unsigned char* V4 = P.ws + WS_V4; const int* IDX = (const int*)(P.ws + WS_IDX); const float* GW = (const float*)(P.ws + WS_GATE);
    bf16* XB = (bf16*)(P.ws + WS_HN); float* SSQ = (float*)(P.ws + WS_SSQ);
    const int x = vb & 3, wgx = vb >> 2, nwg = gridDim.x >> 2, rg = lane >> 3, ch = lane & 7;
    for (int t = wgx * NW + wave; t < NTOK; t += nwg * NW) {
        int e[16]; float w[16];
#pragma unroll
        for (int q = 0; q < 4; ++q) { const int4 v = *(const int4*)(IDX + (size_t)t * 128 + rg * 16 + 4 * q); e[4 * q] = v.x; e[4 * q + 1] = v.y; e[4 * q + 2] = v.z; e[4 * q + 3] = v.w;
            const float4 wv = *(const float4*)(GW + (size_t)t * 128 + rg * 16 + 4 * q); w[4 * q] = wv.x; w[4 * q + 1] = wv.y; w[4 * q + 2] = wv.z; w[4 * q + 3] = wv.w; }
        v4u vd[16];
#pragma unroll
        for (int gq = 0; gq < 16; ++gq) vd[gq] = *(const v4u*)(V4 + (size_t)e[gq] * 512 + 128 * x + 16 * ch);
        bf16* xp = XB + (size_t)t * 1024 + 256 * x + 32 * ch + 4 * rg;
        const uint2 xo = *(const uint2*)xp;
        f16x2 acc[16];
#pragma unroll
        for (int i = 0; i < 16; ++i) acc[i] = (f16x2){(_Float16)0.f, (_Float16)0.f};
#pragma unroll
        for (int gq = 0; gq < 16; ++gq) { const f16x2 ww = __builtin_bit_cast(f16x2, __builtin_amdgcn_cvt_pkrtz(w[gq], w[gq])); const unsigned w4[4] = {vd[gq].x, vd[gq].y, vd[gq].z, vd[gq].w};
#pragma unroll
            for (int q = 0; q < 4; ++q) { acc[4 * q] = __builtin_elementwise_fma(fp4_to_h2<0>(w4[q]), ww, acc[4 * q]); acc[4 * q + 1] = __builtin_elementwise_fma(fp4_to_h2<1>(w4[q]), ww, acc[4 * q + 1]);
                acc[4 * q + 2] = __builtin_elementwise_fma(fp4_to_h2<2>(w4[q]), ww, acc[4 * q + 2]); acc[4 * q + 3] = __builtin_elementwise_fma(fp4_to_h2<3>(w4[q]), ww, acc[4 * q + 3]); } }
        f16x2 a8[8], a4[4], a2[2];
        { const bool b = rg & 4;
#pragma unroll
          for (int i = 0; i < 8; ++i) { const f16x2 keep = b ? acc[8 + i] : acc[i], send = b ? acc[i] : acc[8 + i]; a8[i] = keep + __builtin_bit_cast(f16x2, __shfl_xor(__builtin_bit_cast(int, send), 32)); } }
        { const bool b = rg & 2;
#pragma unroll
          for (int i = 0; i < 4; ++i) { const f16x2 keep = b ? a8[4 + i] : a8[i], send = b ? a8[i] : a8[4 + i]; a4[i] = keep + __builtin_bit_cast(f16x2, __shfl_xor(__builtin_bit_cast(int, send), 16)); } }
        { const bool b = rg & 1;
#pragma unroll
          for (int i = 0; i < 2; ++i) { const f16x2 keep = b ? a4[2 + i] : a4[i], send = b ? a4[i] : a4[2 + i]; a2[i] = keep + __builtin_bit_cast(f16x2, __shfl_xor(__builtin_bit_cast(int, send), 8)); } }
        f32x4 xn; xn[0] = bf_lo(xo.x) + (float)a2[0][0]; xn[1] = bf_hi(xo.x) + (float)a2[0][1]; xn[2] = bf_lo(xo.y) + (float)a2[1][0]; xn[3] = bf_hi(xo.y) + (float)a2[1][1];
        uint2 xg; xg.x = pk2(xn[0], xn[1]); xg.y = pk2(xn[2], xn[3]);
        *(uint2*)xp = xg;
        const float ss = wave_sum((xn[0] * xn[0] + xn[1] * xn[1]) + (xn[2] * xn[2] + xn[3] * xn[3]));
        if (lane == 0) atomicAdd(SSQ + t, ss);
    }
}

__global__ void __launch_bounds__(512, 2) mk_fwd(Params P) {
    extern __shared__ __attribute__((aligned(16))) unsigned char lds_raw[];
    cg::grid_group grid = cg::this_grid();
    LAS unsigned char* lds = (LAS unsigned char*)lds_raw;
    const int tid = threadIdx.x, lane = tid & 63, wave = __builtin_amdgcn_readfirstlane(tid >> 6);
    const int lo = P.ph_lo, hi = P.ph_hi, G = gridDim.x, bx = blockIdx.x;
    unsigned char* ws = P.ws;
    const int gw = bx * NW + wave, NGW = G * NW;
#ifndef PH_MASK
#define PH_MASK 0xffff
#endif
#define IN(k) (((PH_MASK >> (k)) & 1) && lo <= (k) && (k) < hi)
    volatile LAS unsigned* xst = (volatile LAS unsigned*)(lds + LDS_BYTES - 16);
    if (tid < 4) xst[tid] = 0u;
    __syncthreads();
    const XcdBarrier bar = xcd_barrier_post((unsigned*)(ws + WS_BAR), xst);
    unsigned* vctl = (unsigned*)(ws + WS_BAR) + 4096;
    if (tid == 0) { const unsigned xcc = xb_xcc_id() & 7u; xst[2] = xcc; xst[3] = xb_add(&vctl[16 * xcc], 1u); }
#ifdef USE_CG
#define GRID_BAR() grid.sync()
#else
#define GRID_BAR() xcd_barrier(bar)
#endif
#define SYNC_AFTER(k) do { if (IN(k) && IN((k) + 1)) { if ((k) == 0) grid.sync(); else GRID_BAR(); } } while (0)
    typedef pg8::bf16_t pb;
    if (IN(0)) p0_prologue(P, lds, tid, lane, wave);
    SYNC_AFTER(0);
    if (tid == 0) {
        const unsigned xcc = xst[2], sl = xst[3], cap = (unsigned)G >> 3; unsigned v;
        if (sl < cap) v = sl * 8u + xcc;
        else { unsigned o = xb_add(&vctl[160], 1u); v = 0u;
            for (unsigned x = 0; x < 8u; ++x) { const unsigned c = min(xb_ld(&vctl[16 * x]), cap), fr = cap - c; if (o < fr) { v = (c + o) * 8u + x; break; } o -= fr; } }
        xst[2] = v;
    }
    __syncthreads();
    const int vb = (int)xst[2];
    if (IN(1)) {
        pg8::Gemm g{(const pb*)(ws + WS_XN), (const pb*)(ws + WS_W1T), NTOK, 5632, 1024}; pg8::StaticOrder S; S.init(NTOK, 5632, G, vb);
        pg8::EpiProj E{(pb*)(ws + WS_QKVA), (pb*)(ws + WS_QKM), (pb*)(ws + WS_VM), (pb*)(ws + WS_OM), (pb*)(ws + WS_G), C2};
        pg8::gemm_phase<pg8::EpiProj, pg8::StaticOrder, true, true>(lds, g, S, E);
    }
    SYNC_AFTER(1);
    if (IN(2)) { p2_attention(P, lds, lane, wave, vb); __syncthreads(); p2_mlstm_local(P, lds, tid, lane, wave, vb); }
    SYNC_AFTER(2);
    if (IN(3)) p3_mlstm_scan(P, tid, vb);
    SYNC_AFTER(3);
    if (IN(4)) p4_mlstm_out(P, lds, tid, lane, wave, vb);
    SYNC_AFTER(4);
    if (IN(5)) {
        pg8::Gemm g{(const pb*)(ws + WS_YA), (const pb*)(ws + WS_WAT), NTOK, 1024, 1024}; pg8::StaticOrder S; S.init(NTOK, 1024, G, vb);
        pg8::EpiMerged E{(pb*)(ws + WS_MERGED), (const pb*)(ws + WS_G)};
        pg8::gemm_phase<pg8::EpiMerged, pg8::StaticOrder, true, true>(lds, g, S, E);
    }
    if (IN(5) && IN(7)) GRID_BAR();
    if (IN(7)) {
        pg8::Gemm g{(const pb*)(ws + WS_MERGED), (const pb*)(ws + WS_WOT), NTOK, 1024, 1024}; pg8::StaticOrder S; S.init(NTOK, 1024, G, vb);
        pg8::EpiResidual E{P.in[0], (pb*)(ws + WS_HN), (float*)(ws + WS_SSQ1)};
        pg8::gemm_phase<pg8::EpiResidual, pg8::StaticOrder, true, true>(lds, g, S, E);
    }
    if (IN(7) && IN(9)) GRID_BAR();
    if (IN(9)) {
        pg8::Gemm g{(const pb*)(ws + WS_HN), (const pb*)(ws + WS_WQT), NTOK, 2048, 1024}; pg8::StaticOrder S; S.init(NTOK, 2048, G, vb);
        pg8::EpiStore E{(pb*)(ws + WS_Q2), 2048};
        pg8::gemm_phase<pg8::EpiStore, pg8::StaticOrder, true, true>(lds, g, S, E);
    }
    SYNC_AFTER(9);
    if (IN(10)) { p10_quant_rows(P, lane, wave, vb); p10_topk(P, lds, tid, lane, wave, vb); }
    SYNC_AFTER(10);
    if (IN(11)) { p11a_udot(P, lane, wave, vb); GRID_BAR(); p11b_weights(P, tid, vb); GRID_BAR(); p11c_vacc(P, lane, wave, vb); }
    SYNC_AFTER(11);
    if (IN(12)) {
        pg8::Gemm g{(const pb*)(ws + WS_PB), (const pb*)(ws + WS_WPT), NTOK, 1024, 256}; pg8::StaticOrder S; S.init(NTOK, 1024, G, vb);
        pg8::EpiStore E{(pb*)(ws + WS_E), 1024};
        pg8::gemm_phase<pg8::EpiStore, pg8::StaticOrder, true, true>(lds, g, S, E);
    }
    if (IN(12) && IN(13)) { asm volatile("s_waitcnt vmcnt(0)" ::: "memory"); __syncthreads(); }
    if (IN(13)) {
        pg8::Gemm g{(const pb*)(ws + WS_HN), (const pb*)(ws + WS_WGT), NTOK, 1024, 1024}; pg8::StaticOrder S; S.init(NTOK, 1024, G, vb);
        pg8::EpiPle E{(const pb*)(ws + WS_HN), (pb*)(ws + WS_X3B), (const pb*)(ws + WS_E), (const float*)(ws + WS_SSQ)};
        pg8::gemm_phase<pg8::EpiPle, pg8::StaticOrder, true, true>(lds, g, S, E);
    }
    SYNC_AFTER(13);
    if (IN(14)) {
        const float* gf = P.in[19];
        for (int m = gw; m < NTOK; m += NGW) {
            const bf16* xr = (const bf16*)(ws + WS_X3B) + (size_t)m * 1024; float v[16]; float s = 0.f;
            unpk8(((const v4u*)xr)[2 * lane], v); unpk8(((const v4u*)xr)[2 * lane + 1], v + 8);
#pragma unroll
            for (int i = 0; i < 16; ++i) s += v[i] * v[i];
            const float rstd = rsqrtf(wave_sum(s) * (1.f / 1024.f) + EPS);
            float* orow = P.out + (size_t)m * 1024 + 16 * lane;
#pragma unroll
            for (int j = 0; j < 4; ++j) { const f32x4 g = ((const f32x4*)(gf + 16 * lane))[j]; f32x4 o; o[0] = v[4 * j] * rstd * g[0]; o[1] = v[4 * j + 1] * rstd * g[1]; o[2] = v[4 * j + 2] * rstd * g[2]; o[3] = v[4 * j + 3] * rstd * g[3]; ((f32x4*)orow)[j] = o; }
        }
    }
}

extern "C" void kernel_launch(void* const* d_in, const int* in_sizes, int n_in, void* d_out, int out_size, void* d_ws, size_t ws_size, hipStream_t stream) {
    static int grid_blocks = 0;
    if (!grid_blocks) {
        int dev = 0, cus = 0, per_cu = 0;
        (void)hipGetDevice(&dev);
        (void)hipDeviceGetAttribute(&cus, hipDeviceAttributeMultiprocessorCount, dev);
        (void)hipFuncSetAttribute((const void*)mk_fwd, hipFuncAttributeMaxDynamicSharedMemorySize, LDS_BYTES);
        (void)hipOccupancyMaxActiveBlocksPerMultiprocessor(&per_cu, mk_fwd, 512, LDS_BYTES);
        if (per_cu > 1) per_cu = 1;
        grid_blocks = cus * per_cu;
    }
    if (n_in < 20 || ws_size < WS_NEED || grid_blocks <= 0) { fprintf(stderr, "kernel_launch: bad setup (n_in %d ws %zu grid %d)\n", n_in, ws_size, grid_blocks); return; }
    Params p{};
    for (int i = 0; i < 20; ++i) p.in[i] = (const float*)d_in[i];
    p.out = (float*)d_out; p.ws = (unsigned char*)d_ws; p.ph_lo = 0; p.ph_hi = 15;
    (void)hipMemsetAsync((unsigned char*)d_ws + WS_BAR, 0, BAR_BYTES, stream);
    void* args[] = {&p};
    hipError_t e = hipLaunchCooperativeKernel((void*)mk_fwd, dim3(grid_blocks), dim3(512), args, LDS_BYTES, stream);
    if (e != hipSuccess) fprintf(stderr, "cooperative launch failed: %s (grid %d)\n", hipGetErrorString(e), grid_blocks);
}
```

```cpp
#include <hip/hip_runtime.h>
#include <hip/hip_cooperative_groups.h>
#include <cstdio>
#include <cstdint>
namespace cg = cooperative_groups;
namespace pg8 {
#define PG8_LAS __attribute__((address_space(3)))
typedef unsigned short bf16_t;
typedef short bf16x8 __attribute__((ext_vector_type(8)));
typedef float f32x4 __attribute__((ext_vector_type(4)));
typedef unsigned u32x4 __attribute__((ext_vector_type(4)));
constexpr int BM = 256, BK = 64, HALF = 128, HTB = HALF * BK * 2  , STAGE_BYTES = 8 * HTB, NXCD = 8, WGM = 8;

__host__ __device__ __forceinline__ int lds_byte(int r, int c) { const int st = (r >> 4) * 2 + (c >> 5), rr = r & 15, cc = c & 31, ob = rr * 64 + cc * 2; return st * 1024 + (ob ^ (((ob >> 9) & 1) << 5)); }
__host__ __device__ __forceinline__ void stage_rc(int b, int& R, int& C) { const int st = b / 1024, sb = b % 1024, swz = sb ^ (((sb >> 9) & 1) << 5); R = (st >> 1) * 16 + swz / 64; C = (st & 1) * 32 + (swz % 64) / 2; }
__host__ __device__ __forceinline__ int perm32(int rho) { const int n = rho >> 4, i = rho & 15; return 8 * (i >> 2) + 4 * n + (i & 3); }

struct Unit { int pm, pn; };
struct Gemm { const bf16_t* A; const bf16_t* Bt; int M, N, K; };

struct StaticOrder {
    int nM, nN, nwg, G, c;
    __host__ __device__ void init(int M, int N, int G_, int c_) { nM = M / BM; nN = N / BM; nwg = nM * nN; G = G_; c = c_; }
    __host__ __device__ bool next(int i, Unit& u) const {
        const long L = (long)i * G + c; if (L >= nwg) return false;
        int wgid = (int)L; { const int q = nwg / NXCD, r = nwg % NXCD, xcd = wgid % NXCD, off = wgid / NXCD; wgid = (xcd < r ? xcd * (q + 1) : r * (q + 1) + (xcd - r) * q) + off; }
        const int nig = WGM * nN, gid = wgid / nig, fm = gid * WGM, gsz = (nM - fm) < WGM ? (nM - fm) : WGM;
        u.pm = fm + ((wgid % nig) % gsz); u.pn = (wgid % nig) / gsz; return true;
    }
    __device__ __forceinline__ void a_ready(const Unit&) const {}
    __device__ __forceinline__ void done(const Unit&) const {}
};

__device__ __forceinline__ unsigned cvt_pk_bf16(float lo, float hi) { unsigned r; asm volatile("v_cvt_pk_bf16_f32 %0, %1, %2" : "=v"(r) : "v"(lo), "v"(hi)); return r; }
typedef float f32x2 __attribute__((ext_vector_type(2)));

__device__ __forceinline__ float sigm(float x) { return __builtin_amdgcn_rcpf(1.0f + __builtin_amdgcn_exp2f(-1.4426950408889634f * x)); }
__device__ __forceinline__ float bf_lo(unsigned w) { return __uint_as_float(w << 16); }
__device__ __forceinline__ float bf_hi(unsigned w) { return __uint_as_float(w & 0xffff0000u); }
__device__ __forceinline__ u32x4 pack8(const f32x4& v0, const f32x4& v1) { u32x4 w; w.x = cvt_pk_bf16(v0[0], v0[1]); w.y = cvt_pk_bf16(v0[2], v0[3]); w.z = cvt_pk_bf16(v1[0], v1[1]); w.w = cvt_pk_bf16(v1[2], v1[3]); return w; }
__device__ __forceinline__ void unpack8(const u32x4& w, f32x4& v0, f32x4& v1) { v0[0] = bf_lo(w.x); v0[1] = bf_hi(w.x); v0[2] = bf_lo(w.y); v0[3] = bf_hi(w.y); v1[0] = bf_lo(w.z); v1[1] = bf_hi(w.z); v1[2] = bf_lo(w.w); v1[3] = bf_hi(w.w); }

#define PG8_EPI_WALK(...) \
    _Pragma("unroll") for (int ai = 0; ai < 2; ++ai) _Pragma("unroll") for (int m = 0; m < 4; ++m) { const int row = u.pm * BM + wr * 64 + fr + ai * HALF + m * 16; \
        _Pragma("unroll") for (int bj = 0; bj < 2; ++bj) { const int ct = wc * 64 + bj * 32 + 8 * fq; f32x4 v0 = acc[ai][bj][m][0], v1 = acc[ai][bj][m][1]; __VA_ARGS__ } }

__device__ __forceinline__ u32x4 xor8_16B(u32x4 v) { u32x4 r; r.x = (unsigned)__shfl_xor((int)v.x, 8); r.y = (unsigned)__shfl_xor((int)v.y, 8); r.z = (unsigned)__shfl_xor((int)v.z, 8); r.w = (unsigned)__shfl_xor((int)v.w, 8); return r; }
__device__ __forceinline__ u32x4 bperm_16B(int src_byte, u32x4 v) { u32x4 r; r.x = (unsigned)__builtin_amdgcn_ds_bpermute(src_byte, (int)v.x); r.y = (unsigned)__builtin_amdgcn_ds_bpermute(src_byte, (int)v.y); r.z = (unsigned)__builtin_amdgcn_ds_bpermute(src_byte, (int)v.z); r.w = (unsigned)__builtin_amdgcn_ds_bpermute(src_byte, (int)v.w); return r; }
__device__ __forceinline__ void store_rows_bf16(bf16_t* O, size_t ldc, int r0, int c0, int fr, int fq, u32x4 w0, u32x4 w1) {
    const bool h = fr & 8; const u32x4 recv = xor8_16B(h ? w0 : w1);
    const u32x4 d1 = h ? recv : w0, d2 = h ? w1 : recv;
    const int lane = fr + 16 * fq, src = ((lane >> 3) + 8 * ((lane >> 2) & 1) + 16 * (lane & 3)) * 4;
    const u32x4 e1 = bperm_16B(src, d1), e2 = bperm_16B(src, d2);
    bf16_t* p = O + (size_t)(r0 + (lane >> 3)) * ldc + c0 + 8 * (lane & 7);
    *(u32x4*)p = e1; *(u32x4*)(p + 8 * ldc) = e2;
}
struct EpiProj {
    static constexpr bool PERM = true, AFTER_DRAIN = false, MIDK = false, FP8 = false; static constexpr int SCALE_B = 0x7f;
    bf16_t *qkva, *qkm, *vm, *om, *g; float c2;
    __device__ __forceinline__ void operator()(const f32x4 (&acc)[2][2][4][2], const Unit& u, int wr, int wc, int fr, int fq) const {
        const int pn = u.pn; bf16_t* base; int ldc, colt, mode = 0; float sc = 1.f;
        if (pn < 6) { base = qkva; ldc = 1536; colt = pn * 256; if (pn < 2) sc = c2; }
        else if (pn < 10) { base = qkm; ldc = 1024; colt = (pn - 6) * 256; }
        else if (pn < 12) { base = vm; ldc = 512; colt = (pn - 10) * 256; }
        else if (pn < 14) { base = om; ldc = 512; colt = (pn - 12) * 256; mode = 1; }
        else { base = g; ldc = 2048; colt = (pn - 14) * 256; mode = 1; }
#pragma unroll
        for (int ai = 0; ai < 2; ++ai)
#pragma unroll
            for (int m = 0; m < 4; ++m) { u32x4 w[2];
#pragma unroll
                for (int bj = 0; bj < 2; ++bj) { f32x4 v0 = acc[ai][bj][m][0], v1 = acc[ai][bj][m][1];
                    if (mode == 1) { _Pragma("unroll") for (int i = 0; i < 4; ++i) { v0[i] = sigm(v0[i]); v1[i] = sigm(v1[i]); } }
                    else { v0 = v0 * sc; v1 = v1 * sc; }
                    w[bj] = pack8(v0, v1); }
                store_rows_bf16(base, (size_t)ldc, u.pm * BM + wr * 64 + ai * HALF + m * 16, colt + wc * 64, fr, fq, w[0], w[1]); }
    }
};
struct EpiGateF8 {
    static constexpr bool PERM = true, AFTER_DRAIN = false, MIDK = false, FP8 = true; static constexpr int SCALE_B = 0x7b;
    bf16_t* g;
    __device__ __forceinline__ void operator()(const f32x4 (&acc)[2][2][4][2], const Unit& u, int wr, int wc, int fr, int fq) const {
#pragma unroll
        for (int ai = 0; ai < 2; ++ai)
#pragma unroll
            for (int m = 0; m < 4; ++m) { u32x4 w[2];
#pragma unroll
                for (int bj = 0; bj < 2; ++bj) { f32x4 v0 = acc[ai][bj][m][0], v1 = acc[ai][bj][m][1];
                    _Pragma("unroll") for (int i = 0; i < 4; ++i) { v0[i] = sigm(v0[i]); v1[i] = sigm(v1[i]); }
                    w[bj] = pack8(v0, v1); }
                store_rows_bf16(g, 2048, u.pm * BM + wr * 64 + ai * HALF + m * 16, u.pn * BM + wc * 64, fr, fq, w[0], w[1]); }
    }
};
struct EpiStore {
    static constexpr bool PERM = true, AFTER_DRAIN = false, MIDK = false, FP8 = false; static constexpr int SCALE_B = 0x7f;
    bf16_t* O; int ldc;
    __device__ __forceinline__ void operator()(const f32x4 (&acc)[2][2][4][2], const Unit& u, int wr, int wc, int fr, int fq) const {
#pragma unroll
        for (int ai = 0; ai < 2; ++ai)
#pragma unroll
            for (int m = 0; m < 4; ++m) store_rows_bf16(O, (size_t)ldc, u.pm * BM + wr * 64 + ai * HALF + m * 16, u.pn * BM + wc * 64, fr, fq, pack8(acc[ai][0][m][0], acc[ai][0][m][1]), pack8(acc[ai][1][m][0], acc[ai][1][m][1]));
    }
};
template <bool ADD> struct EpiGated {
    static constexpr bool PERM = true, AFTER_DRAIN = false, MIDK = false, FP8 = false; static constexpr int SCALE_B = 0x7f;
    bf16_t* O; const bf16_t* prev; const bf16_t* gate; int gcol0;
    __device__ __forceinline__ void operator()(const f32x4 (&acc)[2][2][4][2], const Unit& u, int wr, int wc, int fr, int fq) const {
#pragma unroll
        for (int ai = 0; ai < 2; ++ai)
#pragma unroll
            for (int m = 0; m < 4; ++m) { const int row = u.pm * BM + wr * 64 + fr + ai * HALF + m * 16; u32x4 w[2];
#pragma unroll
                for (int bj = 0; bj < 2; ++bj) { const int col = u.pn * BM + wc * 64 + bj * 32 + 8 * fq; f32x4 v0 = acc[ai][bj][m][0], v1 = acc[ai][bj][m][1];
                    f32x4 g0, g1; unpack8(*(const u32x4*)(gate + (size_t)row * 2048 + gcol0 + col), g0, g1);
                    v0 = v0 * g0; v1 = v1 * g1;
                    if (ADD) { f32x4 p0, p1; unpack8(*(const u32x4*)(prev + (size_t)row * 1024 + col), p0, p1); v0 = v0 + p0; v1 = v1 + p1; }
                    w[bj] = pack8(v0, v1); }
                store_rows_bf16(O, 1024, u.pm * BM + wr * 64 + ai * HALF + m * 16, u.pn * BM + wc * 64, fr, fq, w[0], w[1]); }
    }
};
struct EpiMerged {
    static constexpr bool PERM = true, AFTER_DRAIN = false, MIDK = true, FP8 = false; static constexpr int SCALE_B = 0x7f;
    bf16_t* O; const bf16_t* gate;
    __device__ __forceinline__ void mid(f32x4 (&acc)[2][2][4][2], const Unit& u, int wr, int wc, int fr, int fq) const {
#pragma unroll
        for (int ai = 0; ai < 2; ++ai)
#pragma unroll
            for (int mp = 0; mp < 2; ++mp) {
                u32x4 ga[2][2], gm[2][2];
#pragma unroll
                for (int mm = 0; mm < 2; ++mm)
#pragma unroll
                    for (int bj = 0; bj < 2; ++bj) { const size_t o = (size_t)(u.pm * BM + wr * 64 + fr + ai * HALF + (2 * mp + mm) * 16) * 2048 + u.pn * BM + wc * 64 + bj * 32 + 8 * fq;
                        ga[mm][bj] = *(const u32x4*)(gate + o); gm[mm][bj] = *(const u32x4*)(gate + o + 1024); }
#pragma unroll
                for (int mm = 0; mm < 2; ++mm)
#pragma unroll
                    for (int bj = 0; bj < 2; ++bj) { f32x4 a0, a1, m0, m1; unpack8(ga[mm][bj], a0, a1); unpack8(gm[mm][bj], m0, m1);
#pragma unroll
                        for (int i = 0; i < 4; ++i) { acc[ai][bj][2 * mp + mm][0][i] *= a0[i] * __builtin_amdgcn_rcpf(m0[i]); acc[ai][bj][2 * mp + mm][1][i] *= a1[i] * __builtin_amdgcn_rcpf(m1[i]); } }
            }
    }
    __device__ __forceinline__ void operator()(const f32x4 (&acc)[2][2][4][2], const Unit& u, int wr, int wc, int fr, int fq) const {
#pragma unroll
        for (int ai = 0; ai < 2; ++ai)
#pragma unroll
            for (int mp = 0; mp < 2; ++mp) {
                u32x4 gm[2][2];
#pragma unroll
                for (int mm = 0; mm < 2; ++mm)
#pragma unroll
                    for (int bj = 0; bj < 2; ++bj) gm[mm][bj] = *(const u32x4*)(gate + (size_t)(u.pm * BM + wr * 64 + fr + ai * HALF + (2 * mp + mm) * 16) * 2048 + 1024 + u.pn * BM + wc * 64 + bj * 32 + 8 * fq);
#pragma unroll
                for (int mm = 0; mm < 2; ++mm) { const int m = 2 * mp + mm; u32x4 w[2];
#pragma unroll
                    for (int bj = 0; bj < 2; ++bj) { f32x4 m0, m1; unpack8(gm[mm][bj], m0, m1); w[bj] = pack8(acc[ai][bj][m][0] * m0, acc[ai][bj][m][1] * m1); }
                    store_rows_bf16(O, 1024, u.pm * BM + wr * 64 + ai * HALF + m * 16, u.pn * BM + wc * 64, fr, fq, w[0], w[1]); }
            }
    }
};
struct EpiResidual {
    static constexpr bool PERM = true, AFTER_DRAIN = false, MIDK = false, FP8 = false; static constexpr int SCALE_B = 0x7f;
    const float* res; bf16_t* xb; float* ssq;
    __device__ __forceinline__ void operator()(const f32x4 (&acc)[2][2][4][2], const Unit& u, int wr, int wc, int fr, int fq) const {
#pragma unroll
        for (int ai = 0; ai < 2; ++ai)
#pragma unroll
            for (int m = 0; m < 4; ++m) { const int row = u.pm * BM + wr * 64 + fr + ai * HALF + m * 16; float s = 0.f; u32x4 wx[2];
#pragma unroll
                for (int bj = 0; bj < 2; ++bj) { const int ct = wc * 64 + bj * 32 + 8 * fq; f32x4 v0 = acc[ai][bj][m][0], v1 = acc[ai][bj][m][1];
                    const size_t o = (size_t)row * 1024 + u.pn * BM + ct; const f32x4 r0 = *(const f32x4*)(res + o), r1 = *(const f32x4*)(res + o + 4);
                    v0 = v0 + r0; v1 = v1 + r1;
                    s += (v0[0] * v0[0] + v0[1] * v0[1]) + (v0[2] * v0[2] + v0[3] * v0[3]) + (v1[0] * v1[0] + v1[1] * v1[1]) + (v1[2] * v1[2] + v1[3] * v1[3]);
                    wx[bj] = pack8(v0, v1); }
                store_rows_bf16(xb, 1024, u.pm * BM + wr * 64 + ai * HALF + m * 16, u.pn * BM + wc * 64, fr, fq, wx[0], wx[1]);
                s += __shfl_xor(s, 16); s += __shfl_xor(s, 32);
                if (fq == 0) atomicAdd(ssq + row, s);
                asm volatile("" ::: "memory"); }
    }
};
struct EpiPle {
    static constexpr bool PERM = true, AFTER_DRAIN = false, MIDK = false, FP8 = true; static constexpr int SCALE_B = 0x7b;
    const bf16_t* x2; bf16_t* x3; const bf16_t* e; const float* ssq;
    __device__ __forceinline__ void operator()(const f32x4 (&acc)[2][2][4][2], const Unit& u, int wr, int wc, int fr, int fq) const {
        const int row0 = u.pm * BM + wr * 64 + fr;
        float sq_next = ssq[row0];
#pragma unroll
        for (int ai = 0; ai < 2; ++ai)
#pragma unroll
            for (int m = 0; m < 4; ++m) { const int row = row0 + ai * HALF + m * 16; const float sq = sq_next; u32x4 wx[2];
                if (!(ai == 1 && m == 3)) sq_next = ssq[row0 + (m == 3 ? HALF : ai * HALF + (m + 1) * 16)];
                const float rstd = rsqrtf(sq * (1.0f / 1024.0f) + 1e-6f);
#pragma unroll
                for (int bj = 0; bj < 2; ++bj) { const int ct = wc * 64 + bj * 32 + 8 * fq; f32x4 v0 = acc[ai][bj][m][0] * rstd, v1 = acc[ai][bj][m][1] * rstd;
                    const size_t o = (size_t)row * 1024 + u.pn * BM + ct; f32x4 e0, e1, r0, r1; unpack8(*(const u32x4*)(e + o), e0, e1); unpack8(*(const u32x4*)(x2 + o), r0, r1);
#pragma unroll
                    for (int i = 0; i < 4; ++i) { v0[i] = r0[i] + sigm(v0[i]) * e0[i]; v1[i] = r1[i] + sigm(v1[i]) * e1[i]; }
                    wx[bj] = pack8(v0, v1); }
                store_rows_bf16(x3, 1024, u.pm * BM + wr * 64 + ai * HALF + m * 16, u.pn * BM + wc * 64, fr, fq, wx[0], wx[1]); }
    }
};

typedef int i32x8 __attribute__((ext_vector_type(8))); typedef int i32x4 __attribute__((ext_vector_type(4)));
__device__ __forceinline__ i32x8 cat8(bf16x8 a, bf16x8 b) { return __builtin_shufflevector(__builtin_bit_cast(i32x4, a), __builtin_bit_cast(i32x4, b), 0, 1, 2, 3, 4, 5, 6, 7); }
template <bool F8> struct Frag { bf16x8 v4[2]; i32x8 v8; __device__ __forceinline__ void set(bf16x8 a, bf16x8 b) { if constexpr (F8) v8 = cat8(a, b); else { v4[0] = a; v4[1] = b; } } };
template <class Epi, class Sched, bool ALIGN_EPI = false, bool SP2 = false>
__device__ __forceinline__ void gemm_phase(PG8_LAS unsigned char* lds, const Gemm g, const Sched& S, const Epi& E) {
    int tid_ = threadIdx.x; asm volatile("" : "+v"(tid_));
    const int tid = tid_, wid = __builtin_amdgcn_readfirstlane(tid >> 6), lane = tid & 63, wr = wid >> 2, wc = wid & 3, fr = lane & 15, fq = lane >> 4;
    int K_ = g.K; asm volatile("" : "+s"(K_));
    const int K = K_, nt = K / BK;
    unsigned voffA[2], voffB[2];
#pragma unroll
    for (int i = 0; i < 2; ++i) { int R, C; stage_rc(tid * 16 + i * 8192, R, C); const int Rb = Epi::PERM ? (2 * (R & ~31) + perm32(R & 31)) : R;
        voffA[i] = (unsigned)(R * K + C) * 2u; voffB[i] = (unsigned)(Rb * K + C) * 2u; }
    const size_t kstep = (size_t)(BK * 2);
    const size_t hstep = (size_t)HALF * K * 2;
    const size_t hstepB = Epi::PERM ? (size_t)32 * K * 2 : hstep;
    const size_t tstep = 2 * hstep;
    const unsigned ldsw = (unsigned)wid * 1024u;
    const int aoff = lds_byte(wr * 64 + fr, fq * 8), boff = lds_byte(wc * 32 + fr, fq * 8);
#define PG8_SA(b, h) (((b) * 2 + (h)) * HTB)
#define PG8_SB(b, h) ((4 + (b) * 2 + (h)) * HTB)
#define PG8_STAGE(bufoff, gbase, voff) do { _Pragma("unroll") for (int _i = 0; _i < 2; ++_i) \
        __builtin_amdgcn_global_load_lds((const unsigned*)((const char*)(gbase) + (voff)[_i]), (PG8_LAS unsigned*)(lds + (bufoff) + ldsw + _i * 8192), 16, 0, 0); } while (0)
#define PG8_LDA(dst, b, h) do { _Pragma("unroll") for (int m = 0; m < 4; ++m) { const bf16x8 f0_ = *(const PG8_LAS bf16x8*)(lds + PG8_SA(b, h) + aoff + m * 2048), f1_ = *(const PG8_LAS bf16x8*)(lds + PG8_SA(b, h) + aoff + m * 2048 + 1024); dst[m].set(f0_, f1_); } } while (0)
#define PG8_LDB(dst, b, h) do { _Pragma("unroll") for (int n = 0; n < 2; ++n) { const bf16x8 f0_ = *(const PG8_LAS bf16x8*)(lds + PG8_SB(b, h) + boff + n * 2048), f1_ = *(const PG8_LAS bf16x8*)(lds + PG8_SB(b, h) + boff + n * 2048 + 1024); dst[n].set(f0_, f1_); } } while (0)
#define PG8_MMA(ai, bj, At, Bt) do { __builtin_amdgcn_s_setprio(1); \
        if constexpr (Epi::FP8) { _Pragma("unroll") for (int m = 0; m < 4; ++m) _Pragma("unroll") for (int n = 0; n < 2; ++n) \
            asm volatile("v_mfma_scale_f32_16x16x128_f8f6f4 %0, %1, %2, %0, %3, %4 op_sel_hi:[0,0,0]" : "+v"(acc[ai][bj][m][n]) : "v"(Bt[n].v8), "v"(At[m].v8), "v"(sclB), "v"(sclA)); } \
        else { _Pragma("unroll") for (int m = 0; m < 4; ++m) _Pragma("unroll") for (int n = 0; n < 2; ++n) _Pragma("unroll") for (int k = 0; k < 2; ++k) \
            acc[ai][bj][m][n] = __builtin_amdgcn_mfma_f32_16x16x32_bf16(Bt[n].v4[k], At[m].v4[k], acc[ai][bj][m][n], 0, 0, 0); } \
        __builtin_amdgcn_s_setprio(0); } while (0)
#define PG8_WAIT_V(n) asm volatile("s_waitcnt vmcnt(" #n ")" ::: "memory")
#define PG8_WAIT_L(n) asm volatile("s_waitcnt lgkmcnt(" #n ")" ::: "memory")
#define PG8_BAR __builtin_amdgcn_s_barrier()
#define PG8_SCHED __builtin_amdgcn_sched_barrier(0)
    Unit cur, nxt; int ui = 0;
    if (!S.next(0, cur)) return;
    f32x4 acc[2][2][4][2];
#pragma unroll
    for (int a = 0; a < 2; ++a)
#pragma unroll
        for (int b = 0; b < 2; ++b)
#pragma unroll
            for (int m = 0; m < 4; ++m)
#pragma unroll
                for (int n = 0; n < 2; ++n) acc[a][b][m][n] = (f32x4){0.f, 0.f, 0.f, 0.f};
    Frag<Epi::FP8> At[4], B0[2], B1[2];
    const int sclB = Epi::SCALE_B, sclA = 0x7f;
    const char* cA = (const char*)g.A + (size_t)cur.pm * tstep; const char* cB = (const char*)g.Bt + (size_t)cur.pn * tstep;
    S.a_ready(cur);
    if constexpr (SP2) {
        PG8_STAGE(PG8_SB(0, 0), cB, voffB); PG8_STAGE(PG8_SB(0, 1), cB + hstepB, voffB); PG8_STAGE(PG8_SA(0, 0), cA, voffA); PG8_STAGE(PG8_SA(0, 1), cA + hstep, voffA);
        if (wr == 1) PG8_BAR;
        PG8_WAIT_V(2); PG8_BAR;
        PG8_STAGE(PG8_SB(1, 0), cB + kstep, voffB); PG8_STAGE(PG8_SA(1, 0), cA + kstep, voffA); PG8_STAGE(PG8_SB(1, 1), cB + hstepB + kstep, voffB);
        PG8_WAIT_V(6); PG8_BAR;
    } else {
        PG8_STAGE(PG8_SB(0, 0), cB, voffB); PG8_STAGE(PG8_SA(0, 0), cA, voffA); PG8_STAGE(PG8_SB(0, 1), cB + hstepB, voffB); PG8_STAGE(PG8_SA(0, 1), cA + hstep, voffA);
        if (wr == 1) PG8_BAR;
        PG8_WAIT_V(4); PG8_BAR;
        PG8_STAGE(PG8_SB(1, 0), cB + kstep, voffB); PG8_STAGE(PG8_SA(1, 0), cA + kstep, voffA); PG8_STAGE(PG8_SB(1, 1), cB + hstepB + kstep, voffB);
        PG8_WAIT_V(6); PG8_BAR;
    }
    for (;;) {
        const bool has_next = S.next(ui + 1, nxt);
        const char* nA = has_next ? (const char*)g.A + (size_t)nxt.pm * tstep : cA; const char* nB = has_next ? (const char*)g.Bt + (size_t)nxt.pn * tstep : cB;
        for (int t = 0; t < nt; t += 2) {
            if constexpr (Epi::MIDK) { if (t == (nt >> 1)) E.mid(acc, cur, wr, wc, fr, fq); }
            const bool last = (t == nt - 2);
            const char* a1 = cA + (size_t)(t + 1) * kstep;
            const char* a2 = last ? nA : cA + (size_t)(t + 2) * kstep; const char* b2 = last ? nB : cB + (size_t)(t + 2) * kstep;
            const char* a3 = a2 + kstep; const char* b3 = b2 + kstep;
            if (last && has_next) S.a_ready(nxt);
            if constexpr (SP2) {
            PG8_LDB(B0, 0, 0); PG8_LDB(B1, 0, 1); PG8_SCHED; PG8_LDA(At, 0, 0); PG8_STAGE(PG8_SA(1, 1), a1 + hstep, voffA);
            PG8_WAIT_V(8); PG8_WAIT_L(0); PG8_BAR; PG8_MMA(0, 0, At, B0); PG8_MMA(0, 1, At, B1); PG8_BAR; PG8_SCHED;
            PG8_LDA(At, 0, 1); PG8_STAGE(PG8_SB(0, 0), b2, voffB); PG8_STAGE(PG8_SB(0, 1), b2 + hstepB, voffB); PG8_STAGE(PG8_SA(0, 0), a2, voffA);
            PG8_WAIT_V(8); PG8_WAIT_L(0); PG8_BAR; PG8_MMA(1, 0, At, B0); PG8_MMA(1, 1, At, B1); PG8_BAR; PG8_SCHED;
            PG8_LDB(B0, 1, 0); PG8_LDB(B1, 1, 1); PG8_SCHED; PG8_LDA(At, 1, 0); PG8_STAGE(PG8_SA(0, 1), a2 + hstep, voffA);
            PG8_WAIT_V(8); PG8_WAIT_L(0); PG8_BAR; PG8_MMA(0, 0, At, B0); PG8_MMA(0, 1, At, B1); PG8_BAR; PG8_SCHED;
            PG8_LDA(At, 1, 1); PG8_STAGE(PG8_SB(1, 0), b3, voffB); PG8_STAGE(PG8_SB(1, 1), b3 + hstepB, voffB); PG8_STAGE(PG8_SA(1, 0), a3, voffA);
            PG8_WAIT_V(8); PG8_WAIT_L(0); PG8_BAR; PG8_MMA(1, 0, At, B0); PG8_MMA(1, 1, At, B1); PG8_BAR; PG8_SCHED;
            } else {
            PG8_LDB(B0, 0, 0); PG8_SCHED; PG8_LDA(At, 0, 0); PG8_STAGE(PG8_SA(1, 1), a1 + hstep, voffA);
            PG8_WAIT_L(8); PG8_BAR; PG8_WAIT_L(0); PG8_MMA(0, 0, At, B0); PG8_BAR; PG8_SCHED;
            PG8_LDB(B1, 0, 1); PG8_STAGE(PG8_SB(0, 0), b2, voffB);
            PG8_BAR; PG8_WAIT_L(0); PG8_MMA(0, 1, At, B1); PG8_BAR;
            PG8_LDA(At, 0, 1); PG8_STAGE(PG8_SA(0, 0), a2, voffA);
            PG8_BAR; PG8_WAIT_L(0); PG8_MMA(1, 0, At, B0); PG8_BAR; PG8_SCHED;
            PG8_STAGE(PG8_SB(0, 1), b2 + hstepB, voffB);
            PG8_WAIT_V(6); PG8_BAR; PG8_MMA(1, 1, At, B1); PG8_BAR;
            PG8_LDB(B0, 1, 0); PG8_SCHED; PG8_LDA(At, 1, 0); PG8_STAGE(PG8_SA(0, 1), a2 + hstep, voffA);
            PG8_WAIT_L(8); PG8_BAR; PG8_WAIT_L(0); PG8_MMA(0, 0, At, B0); PG8_BAR; PG8_SCHED;
            PG8_LDB(B1, 1, 1); PG8_STAGE(PG8_SB(1, 0), b3, voffB);
            PG8_BAR; PG8_WAIT_L(0); PG8_MMA(0, 1, At, B1); PG8_BAR;
            PG8_LDA(At, 1, 1); PG8_STAGE(PG8_SA(1, 0), a3, voffA);
            PG8_BAR; PG8_WAIT_L(0); PG8_MMA(1, 0, At, B0); PG8_BAR; PG8_SCHED;
            PG8_STAGE(PG8_SB(1, 1), b3 + hstepB, voffB);
            PG8_WAIT_V(6); PG8_BAR; PG8_MMA(1, 1, At, B1); PG8_BAR;
            }
        }
        if constexpr (ALIGN_EPI) { if (wr == 0) PG8_BAR; }
        if constexpr (!Epi::AFTER_DRAIN) { E(acc, cur, wr, wc, fr, fq); S.done(cur); }
        if (!has_next) break;
#pragma unroll
        for (int a = 0; a < 2; ++a)
#pragma unroll
            for (int b = 0; b < 2; ++b)
#pragma unroll
                for (int m = 0; m < 4; ++m)
#pragma unroll
                    for (int n = 0; n < 2; ++n) acc[a][b][m][n] = (f32x4){0.f, 0.f, 0.f, 0.f};
        cur = nxt; cA = nA; cB = nB; ++ui;
        if constexpr (ALIGN_EPI) { if (wr == 1) PG8_BAR; }
    }
    PG8_WAIT_V(0);
    if constexpr (!ALIGN_EPI) { if (wr == 0) PG8_BAR; }
    PG8_BAR;
    if constexpr (Epi::AFTER_DRAIN) { E.fused(acc, cur, wr, wc, fr, fq, lds, wid, lane); S.done(cur); }
#undef PG8_SA
#undef PG8_SB
#undef PG8_STAGE
#undef PG8_LDA
#undef PG8_LDB
#undef PG8_MMA
#undef PG8_WAIT_V
#undef PG8_WAIT_L
#undef PG8_BAR
#undef PG8_SCHED
}
}

#define GAS __attribute__((address_space(1)))
#define LAS __attribute__((address_space(3)))
typedef unsigned short bf16;
typedef unsigned v4u __attribute__((ext_vector_type(4)));
typedef unsigned v2u __attribute__((ext_vector_type(2)));
typedef float f32x4 __attribute__((ext_vector_type(4)));
using pg8::bf_lo; using pg8::bf_hi; using pg8::sigm;

constexpr int NTOK = 32768, SEQ = 16384, DM = 1024, NW = 8;
constexpr float EPS = 1e-6f;
constexpr float C2 = 0.125f * 1.4426950408889634f;
constexpr size_t MiB = 1u << 20;
constexpr size_t WS_W1T = 1 * MiB, WS_WAT = 12 * MiB, WS_WMT = 13 * MiB, WS_WOT = 14 * MiB, WS_WQT = 16 * MiB, WS_WGT = 20 * MiB, WS_WPT = 22 * MiB;
constexpr size_t WS_K1B = 22 * MiB + 512 * 1024, WS_K2B = 22 * MiB + 768 * 1024, WS_IF = 23 * MiB, WS_UB = 24 * MiB, WS_VB = 56 * MiB;
constexpr size_t WS_XN = 88 * MiB, WS_YA = 88 * MiB, WS_YM = 120 * MiB, WS_HN = 88 * MiB;
constexpr size_t WS_QKVA = 152 * MiB, WS_QKM = 248 * MiB, WS_VM = 312 * MiB, WS_OM = 344 * MiB, WS_G = 376 * MiB;
constexpr size_t WS_DN = 504 * MiB, WS_NS = 505 * MiB, WS_SC = 506 * MiB;
constexpr size_t WS_MERGED = 152 * MiB, WS_TMP = 216 * MiB, WS_Q2 = 376 * MiB, WS_IDX = 152 * MiB, WS_GATE = 168 * MiB, WS_HN2 = 184 * MiB, WS_PB = 56 * MiB, WS_E = 264 * MiB;
constexpr size_t WS_NEED = 507 * MiB;
constexpr size_t WS_U8 = 24 * MiB, WS_V8 = 40 * MiB, WS_PART = 376 * MiB, WS_SSQ = 506 * MiB + 512 * 1024;
constexpr size_t WS_HQH = 280 * MiB, WS_HQL = 296 * MiB, WS_HS = 312 * MiB;
constexpr size_t WS_W1G8 = 74 * MiB;
constexpr size_t WS_X2B8 = 184 * MiB, WS_WG8 = 72 * MiB;
constexpr size_t WS_X3B = 376 * MiB;
constexpr size_t WS_U4 = 24 * MiB, WS_V4 = 32 * MiB, WS_SU = 40 * MiB, WS_SV = 40 * MiB + 65536;
constexpr size_t WS_SSQ1 = 506 * MiB + 768 * 1024, WS_BAR = 0, BAR_BYTES = 32768;
constexpr size_t OUT_DC = 0, OUT_CS = 64 * MiB;
constexpr int LDS_BYTES = 151552;

__device__ __forceinline__ unsigned f2bf(float f) { unsigned u = __float_as_uint(f); return (u + 0x7fffu + ((u >> 16) & 1u)) >> 16; }
__device__ __forceinline__ unsigned pk2(float lo, float hi) { return f2bf(lo) | (f2bf(hi) << 16); }
__device__ __forceinline__ float bf2f(bf16 b) { return __uint_as_float((unsigned)b << 16); }
__device__ __forceinline__ float wave_sum(float v) {
#pragma unroll
    for (int o = 1; o < 64; o <<= 1) v += __shfl_xor(v, o);
    return v;
}
__device__ __forceinline__ float wave_max(float v) {
#pragma unroll
    for (int o = 1; o < 64; o <<= 1) v = fmaxf(v, __shfl_xor(v, o));
    return v;
}
__device__ __forceinline__ void unpk8(const v4u w, float* f) { f[0] = bf_lo(w.x); f[1] = bf_hi(w.x); f[2] = bf_lo(w.y); f[3] = bf_hi(w.y); f[4] = bf_lo(w.z); f[5] = bf_hi(w.z); f[6] = bf_lo(w.w); f[7] = bf_hi(w.w); }
__device__ __forceinline__ v4u pk8(const float* f) { v4u w; w.x = pk2(f[0], f[1]); w.y = pk2(f[2], f[3]); w.z = pk2(f[4], f[5]); w.w = pk2(f[6], f[7]); return w; }
typedef __bf16 bf16x2_t __attribute__((ext_vector_type(2)));
__device__ __forceinline__ float dot2bf(unsigned a, unsigned b, float c) { return __builtin_amdgcn_fdot2_f32_bf16(__builtin_bit_cast(bf16x2_t, a), __builtin_bit_cast(bf16x2_t, b), c, false); }
__device__ __forceinline__ float logsigmoid(float x) { return fminf(x, 0.f) - log1pf(__expf(-fabsf(x))); }
__device__ __forceinline__ float silu(float x) { return x * __builtin_amdgcn_rcpf(1.0f + __builtin_amdgcn_exp2f(-1.4426950408889634f * x)); }

#define XB_TMO      128
#define XB_XCNT(j)  (256  + 64 * (j))
#define XB_XSUB(j)  (1280 + 64 * (j))
#define XB_XGEN(j)  (2304 + 64 * (j))
#define XB_TOP      3328
#define XB_TOPGEN   3392
#define XCD_BAR_WORDS 3456
#define XB_SPIN_CAP (1u << 18)

__device__ __forceinline__ unsigned xb_ld(unsigned* p)              { return __hip_atomic_load(p, __ATOMIC_RELAXED, __HIP_MEMORY_SCOPE_AGENT); }
__device__ __forceinline__ unsigned xb_add(unsigned* p, unsigned v) { return __hip_atomic_fetch_add(p, v, __ATOMIC_RELAXED, __HIP_MEMORY_SCOPE_AGENT); }
__device__ __forceinline__ unsigned xb_xcc_id() { return (unsigned)__builtin_amdgcn_s_getreg((3 << 11) | 20) & 0xFu; }
#define XB_SPIN(cond, bar) do { unsigned _sp = 0; while (cond) { __builtin_amdgcn_s_sleep(1); \
    if ((++_sp & 255u) == 0u) { if (xb_ld(&(bar)[XB_TMO])) break; if (_sp > XB_SPIN_CAP) { atomicAdd(&(bar)[XB_TMO], 1u); break; } } } } while (0)

struct XcdBarrier {
    unsigned* bar; unsigned x;
    volatile LAS unsigned* st;
};

__device__ __forceinline__ XcdBarrier xcd_barrier_post(unsigned* bar, volatile LAS unsigned* st) {
    XcdBarrier b; b.bar = bar; b.x = xb_xcc_id(); b.st = st;
    if (threadIdx.x == 0) (void)xb_add(&bar[XB_XCNT(b.x)], 1u);
    return b;
}
__device__ __forceinline__ void xcd_barrier_complete(unsigned* bar, unsigned x, unsigned& nloc, unsigned& nx) {
    const unsigned G = gridDim.x * gridDim.y * gridDim.z;
    unsigned sum, cnt, mine, sp = 0u;
    for (;;) {
        sum = 0u; cnt = 0u; mine = 0u;
#pragma unroll
        for (unsigned j = 0; j < 16; ++j) { const unsigned c = xb_ld(&bar[XB_XCNT(j)]); sum += c; cnt += (c > 0u) ? 1u : 0u; mine = (j == x) ? c : mine; }
        if (sum == G) break;
        __builtin_amdgcn_s_sleep(1);
        if ((++sp & 255u) == 0u) { if (xb_ld(&bar[XB_TMO])) break; if (sp > XB_SPIN_CAP) { atomicAdd(&bar[XB_TMO], 1u); break; } }
    }
    nloc = mine > 0u ? mine : 1u; nx = cnt > 0u ? cnt : 1u;
}

__device__ __forceinline__ void xcd_barrier(const XcdBarrier& b) {
    asm volatile("s_waitcnt vmcnt(0)" ::: "memory");
    __syncthreads();
    if (threadIdx.x == 0) {
        unsigned* bar = b.bar;
        __builtin_amdgcn_s_waitcnt(0);
        unsigned nloc = b.st[0], nx = b.st[1];
        if (nloc == 0u) { xcd_barrier_complete(bar, b.x, nloc, nx); b.st[0] = nloc; b.st[1] = nx; }
        const unsigned old = xb_add(&bar[XB_XSUB(b.x)], 1u);
        const unsigned gen = old / nloc;
        if (old + 1u == (gen + 1u) * nloc) {
            __builtin_amdgcn_fence(__ATOMIC_RELEASE, "agent");
            asm volatile("s_waitcnt vmcnt(0)" ::: "memory");
            const unsigned og = xb_add(&bar[XB_TOP], 1u);
            const unsigned tg = og / nx;
            if (og + 1u == (tg + 1u) * nx) xb_add(&bar[XB_TOPGEN], 1u);
            else XB_SPIN(xb_ld(&bar[XB_TOPGEN]) == tg, bar);
            __builtin_amdgcn_fence(__ATOMIC_ACQUIRE, "agent");
            xb_add(&bar[XB_XGEN(b.x)], 1u);
            asm volatile("s_waitcnt vmcnt(0)" ::: "memory");
        } else {
            XB_SPIN(xb_ld(&bar[XB_XGEN(b.x)]) == gen, bar);
            __builtin_amdgcn_fence(__ATOMIC_ACQUIRE, "agent");
            asm volatile("s_waitcnt vmcnt(0)" ::: "memory");
        }
    }
    __syncthreads();
}


struct Params { const float* in[20]; float* out; unsigned char* ws; int ph_lo, ph_hi; };

__device__ __forceinline__ void transpose_item(const float* W, int ldw, int col0, int K, bf16* WT, int row0, LAS float* scr, int item, int nblk, int lane, int koff = 0, const float* kgain = nullptr, unsigned char* WT8 = nullptr, float sc8 = 1.0f) {
    const int kb = item / nblk, nb = item % nblk, k0 = 64 * kb, n0 = 32 * nb;
#pragma unroll 8
    for (int i = 0; i < 32; ++i) { const int kk = 2 * i + (lane >> 5); const float gk = kgain ? kgain[k0 + kk] : 1.0f; scr[kk * 33 + (lane & 31)] = W[(size_t)(k0 + kk) * ldw + col0 + n0 + (lane & 31)] * gk; }
    asm volatile("s_waitcnt lgkmcnt(0)" ::: "memory");
    const int c = lane & 7;
#pragma unroll
    for (int j = 0; j < 4; ++j) { const int n = (lane >> 3) + 8 * j; const LAS float* s = scr + (8 * c) * 33 + n;
        v4u o; o.x = pk2(s[0 * 33], s[1 * 33]); o.y = pk2(s[2 * 33], s[3 * 33]); o.z = pk2(s[4 * 33], s[5 * 33]); o.w = pk2(s[6 * 33], s[7 * 33]);
        *(v4u*)(WT + (size_t)(row0 + n0 + n) * K + koff + k0 + 8 * c) = o;
        if (WT8) { int p0 = __builtin_amdgcn_cvt_pk_fp8_f32(s[0 * 33] * sc8, s[1 * 33] * sc8, 0, false); p0 = __builtin_amdgcn_cvt_pk_fp8_f32(s[2 * 33] * sc8, s[3 * 33] * sc8, p0, true);
            int p1 = __builtin_amdgcn_cvt_pk_fp8_f32(s[4 * 33] * sc8, s[5 * 33] * sc8, 0, false); p1 = __builtin_amdgcn_cvt_pk_fp8_f32(s[6 * 33] * sc8, s[7 * 33] * sc8, p1, true);
            *(uint2*)(WT8 + (size_t)(row0 + n0 + n) * K + koff + k0 + 8 * c) = make_uint2((unsigned)p0, (unsigned)p1); } }
    asm volatile("s_waitcnt lgkmcnt(0)" ::: "memory");
}
__device__ __forceinline__ void cvt_f32_bf16(const float* src, bf16* dst, size_t n4, size_t gtid, size_t gsz) {
    for (size_t i = gtid; i < n4; i += gsz) { const f32x4 v = ((const f32x4*)src)[i]; uint2 o; o.x = pk2(v[0], v[1]); o.y = pk2(v[2], v[3]); ((uint2*)dst)[i] = o; }
}
__device__ __forceinline__ void cvt_f32_fp8(const float* src, unsigned* dst, size_t n4, float sc, size_t gtid, size_t gsz) {
    for (size_t i = gtid; i < n4; i += gsz) { const f32x4 v = ((const f32x4*)src)[i]; int w = __builtin_amdgcn_cvt_pk_fp8_f32(v[0] * sc, v[1] * sc, 0, false); w = __builtin_amdgcn_cvt_pk_fp8_f32(v[2] * sc, v[3] * sc, w, true); dst[i] = (unsigned)w; }
}
__device__ __forceinline__ void rms_row_to_bf16(const float* xrow, const float* gain, bf16* orow, int lane) {
    f32x4 v[4]; float s = 0.f;
#pragma unroll
    for (int j = 0; j < 4; ++j) { v[j] = ((const f32x4*)xrow)[lane + 64 * j]; s += (v[j][0] * v[j][0] + v[j][1] * v[j][1]) + (v[j][2] * v[j][2] + v[j][3] * v[j][3]); }
    const float rstd = rsqrtf(wave_sum(s) * (1.f / 1024.f) + EPS);
#pragma unroll
    for (int j = 0; j < 4; ++j) { const f32x4 g = ((const f32x4*)gain)[lane + 64 * j]; uint2 o; o.x = pk2(v[j][0] * rstd * g[0], v[j][1] * rstd * g[1]); o.y = pk2(v[j][2] * rstd * g[2], v[j][3] * rstd * g[3]); ((uint2*)orow)[lane + 64 * j] = o; }
}
__device__ __forceinline__ void p0_prologue(const Params& P, LAS unsigned char* lds, int tid, int lane, int wave) {
    unsigned char* ws = P.ws;
    const int gw = blockIdx.x * NW + wave, NGW = gridDim.x * NW;
    LAS float* scr = (LAS float*)(lds + wave * 8448);
    LAS float* wif = (LAS float*)(lds + 69632);
    const float* w_in = P.in[3];
    for (int i = tid; i < 8192; i += 512) wif[i] = w_in[(size_t)(i >> 3) * 5640 + 3584 + (i & 7)];
    __syncthreads();
    constexpr int I1A = 16 * 112, I1B = 16 * 64, IUP = 8 * 32, IOUT = 16 * 32, IQ = 16 * 64, IPL = 4 * 32;
    constexpr int NITEMS = I1A + I1B + 2 * IUP + IOUT + IQ + IOUT + IPL;
    for (int it = gw; it < NITEMS; it += NGW) {
        int r = it;
        if (r < I1A) { transpose_item(w_in, 5640, 0, 1024, (bf16*)(ws + WS_W1T), 0, scr, r, 112, lane); continue; } r -= I1A;
        if (r < I1B) { transpose_item(w_in, 5640, 3592, 1024, (bf16*)(ws + WS_W1T), 3584, scr, r, 64, lane, 0, nullptr, ws + WS_W1G8 - (size_t)3584 * 1024, 16.0f); continue; } r -= I1B;
        if (r < IUP) { transpose_item(P.in[7], 1024, 0, 1024, (bf16*)(ws + WS_WAT), 0, scr, r, 32, lane, 0); continue; } r -= IUP;
        if (r < IUP) { transpose_item(P.in[8], 1024, 0, 1024, (bf16*)(ws + WS_WAT), 0, scr, r, 32, lane, 512); continue; } r -= IUP;
        if (r < IOUT) { transpose_item(P.in[9], 1024, 0, 1024, (bf16*)(ws + WS_WOT), 0, scr, r, 32, lane); continue; } r -= IOUT;
        if (r < IQ) { transpose_item(P.in[11], 2048, 0, 1024, (bf16*)(ws + WS_WQT), 0, scr, r, 64, lane, 0, P.in[10]); continue; } r -= IQ;
        if (r < IOUT) { transpose_item(P.in[17], 1024, 0, 1024, (bf16*)(ws + WS_WGT), 0, scr, r, 32, lane, 0, P.in[16], ws + WS_WG8, 16.0f); continue; } r -= IOUT;
        transpose_item(P.in[18], 1024, 0, 256, (bf16*)(ws + WS_WPT), 0, scr, r, 32, lane);
    }
    const size_t gtid = (size_t)blockIdx.x * 512 + tid, gsz = (size_t)gridDim.x * 512;
    cvt_f32_bf16(P.in[12], (bf16*)(ws + WS_K1B), 8 * 128 * 128 / 4, gtid, gsz);
    cvt_f32_bf16(P.in[13], (bf16*)(ws + WS_K2B), 8 * 128 * 128 / 4, gtid, gsz);
    f32x4 egn[4]; { const float* gf = P.in[10]; egn[0] = ((const f32x4*)gf)[2 * lane]; egn[1] = ((const f32x4*)gf)[2 * lane + 1]; egn[2] = ((const f32x4*)gf)[128 + 2 * lane]; egn[3] = ((const f32x4*)gf)[128 + 2 * lane + 1]; }
    f32x4 vnx[4];
    if (gw < 2 * 16384) { const float* src = P.in[14 + (gw >> 14)] + (size_t)(gw & 16383) * 1024; vnx[0] = ((const f32x4*)src)[2 * lane]; vnx[1] = ((const f32x4*)src)[2 * lane + 1]; vnx[2] = ((const f32x4*)src)[128 + 2 * lane]; vnx[3] = ((const f32x4*)src)[128 + 2 * lane + 1]; }
    for (int rw = gw; rw < 2 * 16384; rw += NGW) {
        const int tb_ = rw >> 14, e = rw & 16383;
        f32x4 v[4]; v[0] = vnx[0]; v[1] = vnx[1]; v[2] = vnx[2]; v[3] = vnx[3];
        if (rw + NGW < 2 * 16384) { const int rn = rw + NGW; const float* src = P.in[14 + (rn >> 14)] + (size_t)(rn & 16383) * 1024; vnx[0] = ((const f32x4*)src)[2 * lane]; vnx[1] = ((const f32x4*)src)[2 * lane + 1]; vnx[2] = ((const f32x4*)src)[128 + 2 * lane]; vnx[3] = ((const f32x4*)src)[128 + 2 * lane + 1]; }
        if (!tb_) { v[0] = v[0] * egn[0]; v[1] = v[1] * egn[1]; v[2] = v[2] * egn[2]; v[3] = v[3] * egn[3]; }
        float mx = 0.f, sq = 0.f;
#pragma unroll
        for (int j = 0; j < 4; ++j)
#pragma unroll
            for (int i = 0; i < 4; ++i) { mx = fmaxf(mx, fabsf(v[j][i])); sq += v[j][i] * v[j][i]; }
        mx = wave_max(mx);
        unsigned w0 = 0u, w1 = 0u; float sc;
        if (tb_) {
            sc = mx > 0.f ? mx * (1.0f / 6.0f) : 1.0f; const float inv = 1.0f / sc;
            w0 = __builtin_amdgcn_cvt_scalef32_pk_fp4_f32(w0, v[0][0] * inv, v[0][1] * inv, 1.0f, 0); w0 = __builtin_amdgcn_cvt_scalef32_pk_fp4_f32(w0, v[0][2] * inv, v[0][3] * inv, 1.0f, 1);
            w0 = __builtin_amdgcn_cvt_scalef32_pk_fp4_f32(w0, v[1][0] * inv, v[1][1] * inv, 1.0f, 2); w0 = __builtin_amdgcn_cvt_scalef32_pk_fp4_f32(w0, v[1][2] * inv, v[1][3] * inv, 1.0f, 3);
            w1 = __builtin_amdgcn_cvt_scalef32_pk_fp4_f32(w1, v[2][0] * inv, v[2][1] * inv, 1.0f, 0); w1 = __builtin_amdgcn_cvt_scalef32_pk_fp4_f32(w1, v[2][2] * inv, v[2][3] * inv, 1.0f, 1);
            w1 = __builtin_amdgcn_cvt_scalef32_pk_fp4_f32(w1, v[3][0] * inv, v[3][1] * inv, 1.0f, 2); w1 = __builtin_amdgcn_cvt_scalef32_pk_fp4_f32(w1, v[3][2] * inv, v[3][3] * inv, 1.0f, 3);
        } else {
            const float rms = sqrtf(wave_sum(sq) * (1.0f / 1024.0f)); const float clip = fminf(mx, 2.8f * rms);
            sc = clip > 0.f ? clip * (1.0f / 7.0f) : 1.0f; const float inv = 1.0f / sc;
#pragma unroll
            for (int i = 0; i < 4; ++i) { const int q0 = (int)fminf(fmaxf(rintf(v[0][i] * inv), -7.f), 7.f), q1 = (int)fminf(fmaxf(rintf(v[1][i] * inv), -7.f), 7.f), q2 = (int)fminf(fmaxf(rintf(v[2][i] * inv), -7.f), 7.f), q3 = (int)fminf(fmaxf(rintf(v[3][i] * inv), -7.f), 7.f);
                w0 |= ((unsigned)q0 & 15u) << (4 * i); w0 |= ((unsigned)q1 & 15u) << (16 + 4 * i); w1 |= ((unsigned)q2 & 15u) << (4 * i); w1 |= ((unsigned)q3 & 15u) << (16 + 4 * i); }
        }
        unsigned* dst = (unsigned*)(ws + (tb_ ? WS_V4 : WS_U4)) + (size_t)e * 128;
        dst[lane] = w0; dst[64 + lane] = w1;
        if (lane == 0) ((float*)(ws + (tb_ ? WS_SV : WS_SU)))[e] = sc;
    }
    cvt_f32_bf16(P.in[1], (bf16*)(ws + WS_PB), (size_t)NTOK * 256 / 4, gtid, gsz);
    for (size_t i = gtid; i < (size_t)NTOK; i += gsz) { ((float*)(ws + WS_SSQ))[i] = 0.f; ((float*)(ws + WS_SSQ1))[i] = 0.f; }
    const float* x = P.in[0]; const float* gmix = P.in[2]; const float* gbias = P.in[5];
    bf16* XN = (bf16*)(ws + WS_XN); float* IFb = (float*)(ws + WS_IF);
    f32x4 xgn[4], xnx[4];
#pragma unroll
    for (int j = 0; j < 4; ++j) { xgn[j] = ((const f32x4*)gmix)[lane + 64 * j]; if (gw < NTOK) xnx[j] = ((const f32x4*)(x + (size_t)gw * 1024))[lane + 64 * j]; }
    for (int m = gw; m < NTOK; m += NGW) {
        f32x4 v[4];
#pragma unroll
        for (int j = 0; j < 4; ++j) v[j] = xnx[j];
        if (m + NGW < NTOK) {
#pragma unroll
            for (int j = 0; j < 4; ++j) xnx[j] = ((const f32x4*)(x + (size_t)(m + NGW) * 1024))[lane + 64 * j];
        }
        float a16[16];
#pragma unroll
        for (int i = 0; i < 16; ++i) a16[i] = 0.f;
#pragma unroll
        for (int j = 0; j < 4; ++j) {
            const f32x4 g = xgn[j];
#pragma unroll
            for (int i = 0; i < 4; ++i) { a16[0] += v[j][i] * v[j][i]; v[j][i] *= g[i]; const int d = 4 * (lane + 64 * j) + i; const f32x4 wa = *(const LAS f32x4*)(wif + d * 8), wb = *(const LAS f32x4*)(wif + d * 8 + 4);
                a16[1] += v[j][i] * wa[0]; a16[2] += v[j][i] * wa[1]; a16[3] += v[j][i] * wa[2]; a16[4] += v[j][i] * wa[3]; a16[5] += v[j][i] * wb[0]; a16[6] += v[j][i] * wb[1]; a16[7] += v[j][i] * wb[2]; a16[8] += v[j][i] * wb[3]; }
        }
        float r8[8], r4[4], r2[2], r1;
        { const bool b = lane & 32;
#pragma unroll
          for (int i = 0; i < 8; ++i) { const float keep = b ? a16[8 + i] : a16[i], send = b ? a16[i] : a16[8 + i]; r8[i] = keep + __shfl_xor(send, 32); } }
        { const bool b = lane & 16;
#pragma unroll
          for (int i = 0; i < 4; ++i) { const float keep = b ? r8[4 + i] : r8[i], send = b ? r8[i] : r8[4 + i]; r4[i] = keep + __shfl_xor(send, 16); } }
        { const bool b = lane & 8;
#pragma unroll
          for (int i = 0; i < 2; ++i) { const float keep = b ? r4[2 + i] : r4[i], send = b ? r4[i] : r4[2 + i]; r2[i] = keep + __shfl_xor(send, 8); } }
        { const bool b = lane & 4; const float keep = b ? r2[1] : r2[0], send = b ? r2[0] : r2[1]; r1 = keep + __shfl_xor(send, 4); }
        r1 += __shfl_xor(r1, 2); r1 += __shfl_xor(r1, 1);
        const float rstd = rsqrtf(__shfl(r1, 0) * (1.f / 1024.f) + EPS);
#pragma unroll
        for (int j = 0; j < 4; ++j) { uint2 o; o.x = pk2(v[j][0] * rstd, v[j][1] * rstd); o.y = pk2(v[j][2] * rstd, v[j][3] * rstd); ((uint2*)(XN + (size_t)m * 1024))[lane + 64 * j] = o;
            int p8 = __builtin_amdgcn_cvt_pk_fp8_f32(v[j][0] * rstd, v[j][1] * rstd, 0, false); p8 = __builtin_amdgcn_cvt_pk_fp8_f32(v[j][2] * rstd, v[j][3] * rstd, p8, true); ((int*)((unsigned char*)P.out + (size_t)m * 1024))[lane + 64 * j] = p8; }
        const int which = ((lane >> 5) & 1) * 8 + ((lane >> 4) & 1) * 4 + ((lane >> 3) & 1) * 2 + ((lane >> 2) & 1);
        if ((lane & 3) == 0 && which >= 1 && which <= 8) IFb[(size_t)m * 8 + which - 1] = r1 * rstd + gbias[which - 1];
    }
}

typedef short bf16x8 __attribute__((ext_vector_type(8)));
typedef short v4i16 __attribute__((ext_vector_type(4)));
#define MFMA16(a, b, c) __builtin_amdgcn_mfma_f32_16x16x32_bf16((a), (b), (c), 0, 0, 0)
__device__ __forceinline__ void attn_pair_params(int pp, int& d, int& n0, int& sh) {
    if (pp < 5) { d = 16; sh = 4; n0 = -144 + 32 * pp; } else if (pp < 11) { d = 4; sh = 2; n0 = -128 + 32 * (pp - 5); } else { d = 1; sh = 0; n0 = -128 + 32 * (pp - 11); }
}
template <int MODE> __device__ __forceinline__ void attn_unit_params(int pp, int& d, int& n0, int& sh) {
    if (MODE == 0) { d = 1; sh = 0; n0 = -144 + 32 * pp; }
    else if (pp < 5) { d = 16; sh = 4; n0 = -144 + 32 * pp; } else { d = 4; sh = 2; n0 = -128 + 32 * (pp - 5); }
}
#define ATT_LOAD(SET, PPX) do { if ((PPX) < NP) { int d_, n_, sh_; attn_unit_params<MODE>((PPX), d_, n_, sh_); \
    _Pragma("unroll") for (int c = 0; c < 4; ++c) { int tok = t0 + d_ * (n_ + 8 * c + lrow); tok = min(max(tok, 0), SEQ - 1); const bf16* rp = base + 512 + (size_t)tok * 1536 + 8 * lch; \
        kr[SET][c] = *(const v4u*)rp; vr[SET][c] = *(const v4u*)(rp + 512); } } } while (0)
template <int MODE> __device__ __forceinline__ void attn_unit(const bf16* base, bf16* yrow0, int t0, int xidx, LAS float* partl, LAS unsigned char* kbuf, LAS unsigned char* vbuf, int lane) {
    constexpr int NP = MODE == 0 ? 5 : 11, NPAD = MODE == 0 ? 8 : 12;
    const int r = lane & 15, g = lane >> 4, lrow = lane >> 3, lch = lane & 7;
    const int trq = (lane >> 2) & 3, trp = lane & 3, tr_off = (4 * g + trq) * 160 + trp * 8;
    const int tq = MODE == 0 ? t0 + r : t0 + 16 * r;
    const bf16x8 qb0 = *(const bf16x8*)(base + (size_t)tq * 1536 + 8 * g), qb1 = *(const bf16x8*)(base + (size_t)tq * 1536 + 32 + 8 * g);
    f32x4 o[4]; float m, l;
    LAS float* xrow = partl + (MODE == 0 ? xidx + r : xidx + 16 * r) * 68;
    if (MODE == 0) {
#pragma unroll
        for (int i = 0; i < 4; ++i) o[i] = (f32x4){0.f, 0.f, 0.f, 0.f};
        m = -1e30f; l = 0.f;
    } else {
#pragma unroll
        for (int i = 0; i < 4; ++i) o[i] = *(const LAS f32x4*)(xrow + 16 * i + 4 * g);
        m = xrow[64]; l = g == 0 ? xrow[65] : 0.f;
    }
    v4u kr[4][4], vr[4][4];
    ATT_LOAD(0, 0); ATT_LOAD(1, 1); ATT_LOAD(2, 2); ATT_LOAD(3, 3);
#pragma unroll 1
    for (int pp0 = 0; pp0 < NPAD; pp0 += 4) {
#pragma unroll
        for (int u = 0; u < 4; ++u) {
            const int pp = pp0 + u;
            if (pp < NP) {
                int d, n0, sh; attn_unit_params<MODE>(pp, d, n0, sh);
                const int hi = MODE == 0 ? r : (r << (4 - sh)), lo = max(hi - 128, -(t0 >> sh));
                const int mbase = n0 + 4 * g - lo; const unsigned mspan = (unsigned)(hi - lo);
#pragma unroll
                for (int c = 0; c < 4; ++c) { *(LAS v4u*)(kbuf + (8 * c + lrow) * 144 + lch * 16) = kr[u][c]; *(LAS v4u*)(vbuf + (8 * c + lrow) * 160 + lch * 16) = vr[u][c]; }
                ATT_LOAD(u, pp + 4);
                f32x4 s0 = {0.f, 0.f, 0.f, 0.f}, s1 = {0.f, 0.f, 0.f, 0.f};
                { const bf16x8 k00 = *(const LAS bf16x8*)(kbuf + r * 144 + g * 16), k01 = *(const LAS bf16x8*)(kbuf + r * 144 + 64 + g * 16);
                  const bf16x8 k10 = *(const LAS bf16x8*)(kbuf + (16 + r) * 144 + g * 16), k11 = *(const LAS bf16x8*)(kbuf + (16 + r) * 144 + 64 + g * 16);
                  s0 = MFMA16(k00, qb0, s0); s0 = MFMA16(k01, qb1, s0); s1 = MFMA16(k10, qb0, s1); s1 = MFMA16(k11, qb1, s1); }
                float mx = -INFINITY;
#pragma unroll
                for (int k = 0; k < 4; ++k) { s0[k] = ((unsigned)(mbase + k) <= mspan) ? s0[k] : -INFINITY; s1[k] = ((unsigned)(mbase + 16 + k) <= mspan) ? s1[k] : -INFINITY; mx = fmaxf(mx, fmaxf(s0[k], s1[k])); }
                mx = fmaxf(mx, __shfl_xor(mx, 16)); mx = fmaxf(mx, __shfl_xor(mx, 32));
                if (__any(mx > m)) {
                    const float mn = fmaxf(m, mx), alpha = __builtin_amdgcn_exp2f(m - mn); m = mn; l *= alpha;
#pragma unroll
                    for (int i = 0; i < 4; ++i) o[i] = o[i] * alpha;
                }
                float p0[4], p1[4], ps = 0.f;
#pragma unroll
                for (int k = 0; k < 4; ++k) { p0[k] = __builtin_amdgcn_exp2f(s0[k] - m); p1[k] = __builtin_amdgcn_exp2f(s1[k] - m); ps += p0[k] + p1[k]; }
                l += ps;
                bf16x8 pb; { v4u w; w.x = pg8::cvt_pk_bf16(p0[0], p0[1]); w.y = pg8::cvt_pk_bf16(p0[2], p0[3]); w.z = pg8::cvt_pk_bf16(p1[0], p1[1]); w.w = pg8::cvt_pk_bf16(p1[2], p1[3]); pb = __builtin_bit_cast(bf16x8, w); }
                LAS unsigned char* vrd = vbuf + tr_off;
#pragma unroll
                for (int db = 0; db < 4; ++db) {
                    const v4i16 a0 = __builtin_amdgcn_ds_read_tr16_b64_v4i16((LAS v4i16*)(vrd + db * 32)), a1 = __builtin_amdgcn_ds_read_tr16_b64_v4i16((LAS v4i16*)(vrd + 16 * 160 + db * 32));
                    const bf16x8 va = __builtin_shufflevector(a0, a1, 0, 1, 2, 3, 4, 5, 6, 7);
                    o[db] = MFMA16(va, pb, o[db]);
                }
            }
        }
    }
    l += __shfl_xor(l, 16); l += __shfl_xor(l, 32);
    if (MODE == 0) {
#pragma unroll
        for (int i = 0; i < 4; ++i) *(LAS f32x4*)(xrow + 16 * i + 4 * g) = o[i];
        if (g == 0) { xrow[64] = m; xrow[65] = l; }
    } else {
        const float inv = __builtin_amdgcn_rcpf(l);
        bf16* yo = yrow0 + (size_t)tq * 1024 + 4 * g;
#pragma unroll
        for (int db = 0; db < 4; ++db) { uint2 w; w.x = pk2(o[db][0] * inv, o[db][1] * inv); w.y = pk2(o[db][2] * inv, o[db][3] * inv); *(uint2*)(yo + 16 * db) = w; }
    }
}
__device__ __forceinline__ void p2_attention(const Params& P, LAS unsigned char* lds, int lane, int wave, int vb) {
    const bf16* QKVA = (const bf16*)(P.ws + WS_QKVA); bf16* YA = (bf16*)(P.ws + WS_YA);
    LAS unsigned char* kbuf = lds + wave * 9728;
    LAS unsigned char* vbuf = kbuf + 4608;
    LAS float* partl = (LAS float*)(lds + 8 * 9728);
    for (int wi = vb; wi < 1024; wi += gridDim.x) {
        const int bh = wi >> 6, tb = wi & 63, b = bh >> 3, h = bh & 7;
        const bf16* base = QKVA + (size_t)b * SEQ * 1536 + h * 64;
        bf16* yrow0 = YA + (size_t)b * SEQ * 1024 + h * 64;
#pragma unroll 1
        for (int uu = 0; uu < 2; ++uu) { const int cu = wave * 2 + uu; attn_unit<0>(base, yrow0, tb * 256 + 16 * cu, 16 * cu, partl, kbuf, vbuf, lane); }
        __syncthreads();
#pragma unroll 1
        for (int uu = 0; uu < 2; ++uu) { const int rr = wave * 2 + uu; attn_unit<1>(base, yrow0, tb * 256 + rr, rr, partl, kbuf, vbuf, lane); }
        __syncthreads();
    }
}

__device__ __forceinline__ float conv_silu(const bf16* QKM, const float* cw, int b, int t, int ch) {
    float a = 0.f;
#pragma unroll
    for (int j = 0; j < 4; ++j) { const int tt = t - 3 + j; if (tt >= 0) a += cw[j * 1024 + ch] * bf2f(QKM[((size_t)b * SEQ + tt) * 1024 + ch]); }
    return silu(a);
}

__device__ __forceinline__ float scan_add(float v, int lane) {
#pragma unroll
    for (int o = 1; o < 64; o <<= 1) { const float u = __shfl_up(v, o); if (lane >= o) v += u; }
    return v;
}
__device__ __forceinline__ float scan_max(float v, int lane) {
#pragma unroll
    for (int o = 1; o < 64; o <<= 1) { const float u = __shfl_up(v, o); if (lane >= o) v = fmaxf(v, u); }
    return v;
}
__device__ __forceinline__ void conv16(const bf16* QKM, const float* cw, int b, int t0, int chan, float* out) {
    const bf16* src = QKM + (size_t)b * SEQ * 1024 + chan;
    const float w0 = cw[chan], w1 = cw[1024 + chan], w2 = cw[2048 + chan], w3 = cw[3072 + chan];
    float x0 = t0 >= 3 ? bf2f(src[(size_t)(t0 - 3) * 1024]) : 0.f, x1 = t0 >= 2 ? bf2f(src[(size_t)(t0 - 2) * 1024]) : 0.f, x2 = t0 >= 1 ? bf2f(src[(size_t)(t0 - 1) * 1024]) : 0.f;
#pragma unroll
    for (int i = 0; i < 16; ++i) { const float x3 = bf2f(src[(size_t)(t0 + i) * 1024]); out[i] = silu(w0 * x0 + w1 * x1 + w2 * x2 + w3 * x3); x0 = x1; x1 = x2; x2 = x3; }
}

__device__ __forceinline__ void p2_mlstm_local(const Params& P, LAS unsigned char* lds, int tid, int lane, int wave, int vb) {
    const bf16* QKM = (const bf16*)(P.ws + WS_QKM); const bf16* VM = (const bf16*)(P.ws + WS_VM); const float* IFb = (const float*)(P.ws + WS_IF);
    const float* cw = P.in[4];
    bf16* DC = (bf16*)((unsigned char*)P.out + OUT_DC); float* DN = (float*)(P.ws + WS_DN); float* SC = (float*)(P.ws + WS_SC);
    LAS bf16* KWT = (LAS bf16*)lds; LAS bf16* VT = (LAS bf16*)(lds + 18432); LAS float* sw = (LAS float*)(lds + 36864);
    const int r = lane & 15, g = lane >> 4;
    for (int item = vb; item < 2048; item += gridDim.x) {
        const int bh = item >> 8, c = item & 255, b = bh >> 2, h = bh & 3;
        if (wave == 0) {
            const size_t row = (size_t)b * SEQ + c * 64 + lane;
            const float lf = logsigmoid(IFb[row * 8 + 4 + h]), ip = IFb[row * 8 + h];
            const float bc = scan_add(lf, lane), gg = __shfl(bc, 63), ds = gg - bc + ip, ml = wave_max(ds);
            sw[lane] = __expf(ds - ml);
            if (lane == 0) { SC[item] = ml; SC[2048 + item] = gg; }
        }
        __syncthreads();
        { const int ch = tid & 127, sq = tid >> 7, s0 = sq * 16; float o[16];
          conv16(QKM, cw, b, c * 64 + s0, 512 + h * 128 + ch, o);
#pragma unroll
          for (int i = 0; i < 16; i += 2) *(LAS unsigned*)(KWT + ch * 72 + s0 + i) = pk2(o[i] * 0.08838834764831845f * sw[s0 + i], o[i + 1] * 0.08838834764831845f * sw[s0 + i + 1]);
          const bf16* vsrc = VM + ((size_t)b * SEQ + c * 64 + s0) * 512 + h * 128 + ch;
#pragma unroll
          for (int i = 0; i < 16; i += 2) *(LAS unsigned*)(VT + ch * 72 + s0 + i) = (unsigned)vsrc[(size_t)i * 512] | ((unsigned)vsrc[(size_t)(i + 1) * 512] << 16);
        }
        __syncthreads();
        {
          const bf16x8 vb0 = *(const LAS bf16x8*)(VT + (16 * wave + r) * 72 + 8 * g), vb1 = *(const LAS bf16x8*)(VT + (16 * wave + r) * 72 + 32 + 8 * g);
          bf16* dst = DC + (size_t)item * 16384 + (size_t)(16 * wave + r) * 128 + 4 * g;
#pragma unroll
          for (int eb = 0; eb < 8; ++eb) {
              const bf16x8 ka0 = *(const LAS bf16x8*)(KWT + (16 * eb + r) * 72 + 8 * g), ka1 = *(const LAS bf16x8*)(KWT + (16 * eb + r) * 72 + 32 + 8 * g);
              f32x4 acc = {0.f, 0.f, 0.f, 0.f};
              acc = MFMA16(ka0, vb0, acc); acc = MFMA16(ka1, vb1, acc);
              uint2 o; o.x = pk2(acc[0], acc[1]); o.y = pk2(acc[2], acc[3]); *(uint2*)(dst + 16 * eb) = o;
          }
        }
        if (tid < 128) { float a = 0.f;
#pragma unroll
            for (int cc = 0; cc < 8; ++cc) { float f[8]; unpk8(*(const LAS v4u*)(KWT + tid * 72 + 8 * cc), f);
#pragma unroll
                for (int k = 0; k < 8; ++k) a += f[k]; }
            DN[(size_t)item * 128 + tid] = a; }
        __syncthreads();
    }
}

__device__ __forceinline__ void p3_mlstm_scan(const Params& P, int tid, int vb) {
    const unsigned* __restrict__ DC = (const unsigned*)((unsigned char*)P.out + OUT_DC); unsigned* __restrict__ CS = (unsigned*)((unsigned char*)P.out + OUT_CS);
    const float* __restrict__ DN = (const float*)(P.ws + WS_DN); float* __restrict__ NS = (float*)(P.ws + WS_NS); float* SC = (float*)(P.ws + WS_SC);
    for (int gid = vb * 512 + tid; gid < 8 * 8192; gid += gridDim.x * 512) {
        const int bh = gid >> 13, idx = gid & 8191; const bool hasn = idx < 64;
        float C0 = 0.f, C1 = 0.f, n0 = 0.f, n1 = 0.f, m = 0.f;
        for (int j0 = 0; j0 < 256; j0 += 16) {
            unsigned d[16]; float ml[16], gg[16]; float2 dn[16];
#pragma unroll
            for (int u = 0; u < 16; ++u) { const int item = bh * 256 + j0 + u; d[u] = DC[(size_t)item * 8192 + idx]; ml[u] = SC[item]; gg[u] = SC[2048 + item];
                dn[u] = hasn ? *(const float2*)(DN + (size_t)item * 128 + 2 * idx) : make_float2(0.f, 0.f); }
#pragma unroll
            for (int u = 0; u < 16; ++u) { const int item = bh * 256 + j0 + u;
                CS[(size_t)item * 8192 + idx] = pk2(C0, C1);
                if (hasn) *(float2*)(NS + (size_t)item * 128 + 2 * idx) = make_float2(n0, n1);
                if (idx == 0) SC[4096 + item] = m;
                const float mn = fmaxf(gg[u] + m, ml[u]), a = __expf(gg[u] + m - mn), bb = __expf(ml[u] - mn);
                C0 = a * C0 + bb * bf_lo(d[u]); C1 = a * C1 + bb * bf_hi(d[u]); n0 = a * n0 + bb * dn[u].x; n1 = a * n1 + bb * dn[u].y; m = mn; }
        }
    }
}

struct P4Pref { v4u raw[7]; v4u cs[4]; uint2 om[4]; f32x4 gn; float ifa, ifb, nsv; };
__device__ __forceinline__ void p4_prefetch_raw(P4Pref& pf, const Params& P, int item, int tid, int lane) {
    const bf16* QKM = (const bf16*)(P.ws + WS_QKM); const bf16* VM = (const bf16*)(P.ws + WS_VM); const float* IFb = (const float*)(P.ws + WS_IF); const float* NS = (const float*)(P.ws + WS_NS);
    const int bh = item >> 8, c = item & 255, b = bh >> 2, h = bh & 3;
#pragma unroll
    for (int i = 0; i < 7; ++i) { const int v = tid + 512 * i; const int rr = v / 48, rem = v - rr * 48, seg = rem >> 4, c16 = rem & 15; const int t = c * 64 + rr - 3;
        v4u val = {0u, 0u, 0u, 0u};
        if (v < 3216 && t >= 0) val = (seg < 2) ? *(const v4u*)(QKM + ((size_t)b * SEQ + t) * 1024 + seg * 512 + h * 128 + 8 * c16) : *(const v4u*)(VM + ((size_t)b * SEQ + t) * 512 + h * 128 + 8 * c16);
        pf.raw[i] = val; }
    const size_t row = (size_t)b * SEQ + c * 64 + lane;
    pf.ifa = IFb[row * 8 + 4 + h]; pf.ifb = IFb[row * 8 + h];
    pf.nsv = NS[(size_t)item * 128 + (tid & 127)];
}
__device__ __forceinline__ void p4_prefetch_cs(P4Pref& pf, const Params& P, int item, int lane, int wave) {
    const bf16* CS = (const bf16*)((unsigned char*)P.out + OUT_CS);
    const bf16* crow = CS + (size_t)item * 16384 + (size_t)(16 * wave + (lane & 15)) * 128 + 8 * (lane >> 4);
#pragma unroll
    for (int ks = 0; ks < 4; ++ks) pf.cs[ks] = *(const v4u*)(crow + 32 * ks);
}
__device__ __forceinline__ void p4_prefetch_om(P4Pref& pf, const Params& P, int item, int lane, int wave) {
    const bf16* OM = (const bf16*)(P.ws + WS_OM);
    const int bh = item >> 8, c = item & 255, b = bh >> 2, h = bh & 3, r = lane & 15, g = lane >> 4;
#pragma unroll
    for (int tb = 0; tb < 4; ++tb) pf.om[tb] = *(const uint2*)(OM + ((size_t)b * SEQ + c * 64 + 16 * tb + r) * 512 + h * 128 + 16 * wave + 4 * g);
    pf.gn = *(const f32x4*)(P.in[6] + h * 128 + 16 * wave + 4 * g);
}
__device__ __forceinline__ void p4_mlstm_out(const Params& P, LAS unsigned char* lds, int tid, int lane, int wave, int vb) {
    const float* cw = P.in[4]; const float* SC = (const float*)(P.ws + WS_SC); bf16* YM = (bf16*)(P.ws + WS_YA);
    LAS float* CW = (LAS float*)lds;
    LAS unsigned char* RAW = lds + 16384;
    LAS bf16* Qs = (LAS bf16*)(lds + 68912); LAS bf16* Ks = (LAS bf16*)(lds + 86320); LAS bf16* VT = (LAS bf16*)(lds + 103728); LAS bf16* PT = (LAS bf16*)(lds + 122160);
    LAS float* sm = (LAS float*)(lds + 131376);
    LAS bf16* NSB = (LAS bf16*)(lds + 135728);
    const int r = lane & 15, g = lane >> 4;
    for (int i = tid; i < 1024; i += 512) ((LAS f32x4*)CW)[i] = ((const f32x4*)cw)[i];
    P4Pref pf;
    if (vb < 2048) { p4_prefetch_raw(pf, P, vb, tid, lane); p4_prefetch_cs(pf, P, vb, lane, wave); p4_prefetch_om(pf, P, vb, lane, wave); }
    for (int item = vb; item < 2048; item += gridDim.x) {
        const int bh = item >> 8, c = item & 255, b = bh >> 2, h = bh & 3;
#pragma unroll
        for (int i = 0; i < 7; ++i) { const int v = tid + 512 * i; if (v < 3216) { const int rr = v / 48, rem = v - rr * 48; *(LAS v4u*)(RAW + rr * 784 + rem * 16) = pf.raw[i]; } }
        if (tid < 128) NSB[tid] = (bf16)f2bf(pf.nsv);
        if (wave == 0) {
            const float lf = logsigmoid(pf.ifa), ip = pf.ifb;
            const float bc = scan_add(lf, lane), a = ip - bc, pm = scan_max(a, lane), ms = SC[4096 + item], M = fmaxf(ms, pm);
            sm[lane] = a; sm[64 + lane] = M; sm[128 + lane] = __expf(ms - M); sm[192 + lane] = __expf(-bc - M);
        }
        __syncthreads();
        { const int g4 = tid & 31, s0 = (tid >> 5) * 4;
#pragma unroll
          for (int tile = 0; tile < 2; ++tile) {
              float x[7][4];
#pragma unroll
              for (int j = 0; j < 7; ++j) { const v2u rv = *(const LAS v2u*)(RAW + (s0 + j) * 784 + tile * 256 + g4 * 8); x[j][0] = bf_lo(rv.x); x[j][1] = bf_hi(rv.x); x[j][2] = bf_lo(rv.y); x[j][3] = bf_hi(rv.y); }
              f32x4 w[4];
#pragma unroll
              for (int tp = 0; tp < 4; ++tp) w[tp] = *(const LAS f32x4*)(CW + tp * 1024 + tile * 512 + h * 128 + 4 * g4);
              const float sc = tile ? 0.08838834764831845f : 1.0f; LAS bf16* dst = tile ? Ks : Qs;
#pragma unroll
              for (int j = 0; j < 4; ++j) { float y[4];
#pragma unroll
                  for (int i = 0; i < 4; ++i) y[i] = silu(w[0][i] * x[j][i] + w[1][i] * x[j + 1][i] + w[2][i] * x[j + 2][i] + w[3][i] * x[j + 3][i]) * sc;
                  v2u o; o.x = pk2(y[0], y[1]); o.y = pk2(y[2], y[3]); *(LAS v2u*)(dst + (s0 + j) * 136 + 4 * g4) = o; }
          }
          const int ch = tid & 127, sv = (tid >> 7) * 16;
#pragma unroll
          for (int i = 0; i < 16; i += 2) { const unsigned lo = *(const LAS bf16*)(RAW + (3 + sv + i) * 784 + 512 + ch * 2), hi = *(const LAS bf16*)(RAW + (4 + sv + i) * 784 + 512 + ch * 2);
              *(LAS unsigned*)(VT + ch * 72 + sv + i) = lo | (hi << 16); }
        }
        asm volatile("" ::: "memory");
        if (item + (int)gridDim.x < 2048) p4_prefetch_raw(pf, P, item + gridDim.x, tid, lane);
        __syncthreads();
        { const int sb = wave >> 1;
          bf16x8 ka[4];
#pragma unroll
          for (int ks = 0; ks < 4; ++ks) ka[ks] = *(const LAS bf16x8*)(Ks + (16 * sb + r) * 136 + 32 * ks + 8 * g);
#pragma unroll
          for (int tt = 0; tt < 2; ++tt) { const int tb = 2 * (wave & 1) + tt, t = 16 * tb + r;
              f32x4 acc = {0.f, 0.f, 0.f, 0.f};
#pragma unroll
              for (int ks = 0; ks < 4; ++ks) { const bf16x8 qb = *(const LAS bf16x8*)(Qs + t * 136 + 32 * ks + 8 * g); acc = MFMA16(ka[ks], qb, acc); }
              const float Mt = sm[64 + t]; float p[4], ps = 0.f;
#pragma unroll
              for (int k = 0; k < 4; ++k) { const int s = 16 * sb + 4 * g + k; p[k] = (s <= t) ? acc[k] * __expf(sm[s] - Mt) : 0.f; ps += p[k]; }
              v2u o; o.x = pk2(p[0], p[1]); o.y = pk2(p[2], p[3]); *(LAS v2u*)(PT + t * 72 + 16 * sb + 4 * g) = o;
              ps += __shfl_xor(ps, 16); ps += __shfl_xor(ps, 32);
              if (g == 0) sm[320 + sb * 64 + t] = ps; }
        }
        __syncthreads();
        f32x4 ai[4], ac[4], an[4];
#pragma unroll
        for (int tb = 0; tb < 4; ++tb) { ai[tb] = (f32x4){0.f, 0.f, 0.f, 0.f}; ac[tb] = (f32x4){0.f, 0.f, 0.f, 0.f}; an[tb] = (f32x4){0.f, 0.f, 0.f, 0.f}; }
        { const bf16x8 va0 = *(const LAS bf16x8*)(VT + (16 * wave + r) * 72 + 8 * g), va1 = *(const LAS bf16x8*)(VT + (16 * wave + r) * 72 + 32 + 8 * g);
          const bf16x8 ca0 = __builtin_bit_cast(bf16x8, pf.cs[0]), ca1 = __builtin_bit_cast(bf16x8, pf.cs[1]), ca2 = __builtin_bit_cast(bf16x8, pf.cs[2]), ca3 = __builtin_bit_cast(bf16x8, pf.cs[3]);
          const bf16x8 zero8 = {0, 0, 0, 0, 0, 0, 0, 0};
#pragma unroll
          for (int tb = 0; tb < 4; ++tb) { const int t = 16 * tb + r;
              const bf16x8 pb0 = *(const LAS bf16x8*)(PT + t * 72 + 8 * g), pb1 = *(const LAS bf16x8*)(PT + t * 72 + 32 + 8 * g);
              ai[tb] = MFMA16(va0, pb0, ai[tb]); ai[tb] = MFMA16(va1, pb1, ai[tb]);
              const bf16x8 q0 = *(const LAS bf16x8*)(Qs + t * 136 + 8 * g), q1 = *(const LAS bf16x8*)(Qs + t * 136 + 32 + 8 * g), q2 = *(const LAS bf16x8*)(Qs + t * 136 + 64 + 8 * g), q3 = *(const LAS bf16x8*)(Qs + t * 136 + 96 + 8 * g);
              ac[tb] = MFMA16(ca0, q0, ac[tb]); ac[tb] = MFMA16(ca1, q1, ac[tb]); ac[tb] = MFMA16(ca2, q2, ac[tb]); ac[tb] = MFMA16(ca3, q3, ac[tb]);
              if (wave == 0) {
                  const bf16x8 n0 = r == 0 ? *(const LAS bf16x8*)(NSB + 8 * g) : zero8, n1 = r == 0 ? *(const LAS bf16x8*)(NSB + 32 + 8 * g) : zero8, n2 = r == 0 ? *(const LAS bf16x8*)(NSB + 64 + 8 * g) : zero8, n3 = r == 0 ? *(const LAS bf16x8*)(NSB + 96 + 8 * g) : zero8;
                  an[tb] = MFMA16(n0, q0, an[tb]); an[tb] = MFMA16(n1, q1, an[tb]); an[tb] = MFMA16(n2, q2, an[tb]); an[tb] = MFMA16(n3, q3, an[tb]);
                  if (g == 0) { const float den = sm[128 + t] * an[tb][0] + (sm[320 + t] + sm[384 + t]) + (sm[448 + t] + sm[512 + t]); sm[256 + t] = fmaxf(fabsf(den), sm[192 + t]); } } }
        }
        asm volatile("" ::: "memory");
        if (item + (int)gridDim.x < 2048) p4_prefetch_cs(pf, P, item + gridDim.x, lane, wave);
#pragma unroll
        for (int tb = 0; tb < 4; ++tb) { const int t = 16 * tb + r; const float wi = sm[128 + t]; float s2 = 0.f;
#pragma unroll
            for (int k = 0; k < 4; ++k) { ai[tb][k] = wi * ac[tb][k] + ai[tb][k]; s2 += ai[tb][k] * ai[tb][k]; }
            s2 += __shfl_xor(s2, 16); s2 += __shfl_xor(s2, 32);
            if (g == 0) sm[576 + wave * 64 + t] = s2; }
        __syncthreads();
        {
#pragma unroll
          for (int tb = 0; tb < 4; ++tb) { const int t = 16 * tb + r; float tot = 0.f;
#pragma unroll
              for (int w = 0; w < 8; ++w) tot += sm[576 + w * 64 + t];
              const float inv = __builtin_amdgcn_rcpf(sm[256 + t]), rs = inv * rsqrtf(tot * inv * inv * (1.f / 128.f) + EPS);
              const size_t row = (size_t)b * SEQ + c * 64 + t; const int col = h * 128 + 16 * wave + 4 * g;
              uint2 o; o.x = pk2(ai[tb][0] * rs * pf.gn[0] * bf_lo(pf.om[tb].x), ai[tb][1] * rs * pf.gn[1] * bf_hi(pf.om[tb].x)); o.y = pk2(ai[tb][2] * rs * pf.gn[2] * bf_lo(pf.om[tb].y), ai[tb][3] * rs * pf.gn[3] * bf_hi(pf.om[tb].y));
              *(uint2*)(YM + row * 1024 + 512 + col) = o; }
        }
        asm volatile("" ::: "memory");
        if (item + (int)gridDim.x < 2048) p4_prefetch_om(pf, P, item + gridDim.x, lane, wave);
        __syncthreads();
    }
}

__device__ __forceinline__ int f2ord(float f) { const int b = __float_as_int(f); return b ^ ((b >> 31) & 0x7fffffff); }
__device__ __forceinline__ float ord2f(int o) { return __int_as_float(o ^ ((o >> 31) & 0x7fffffff)); }
#define CE_DESC(a, i, j) { const int _h = max(a[i], a[j]), _l = min(a[i], a[j]); a[i] = _h; a[j] = _l; }
__device__ __forceinline__ void sort16_desc(int (&a)[16]) {
#pragma unroll
    for (int k = 2; k <= 16; k <<= 1) {
#pragma unroll
        for (int j = k >> 1; j > 0; j >>= 1) {
#pragma unroll
            for (int i = 0; i < 16; ++i) { const int l = i ^ j; if (l > i) { if ((i & k) == 0) CE_DESC(a, i, l) else CE_DESC(a, l, i) } }
        }
    }
}
__device__ __forceinline__ void merge16_desc(int (&a)[16], const int (&b)[16]) {
#pragma unroll
    for (int i = 0; i < 16; ++i) a[i] = max(a[i], b[15 - i]);
#pragma unroll
    for (int j = 8; j > 0; j >>= 1) {
#pragma unroll
        for (int i = 0; i < 16; ++i) { const int l = i ^ j; if (l > i) CE_DESC(a, i, l) }
    }
}
__device__ __forceinline__ void xmerge16(int (&a)[16], int mask) {
    int b[16];
#pragma unroll
    for (int i = 0; i < 16; ++i) b[i] = __shfl_xor(a[i], mask);
    merge16_desc(a, b);
}
__device__ __forceinline__ void p10_quant_rows(const Params& P, int lane, int wave, int vb) {
    const bf16* HN = (const bf16*)(P.ws + WS_HN); unsigned* HQH = (unsigned*)(P.ws + WS_HQH); unsigned* HQL = (unsigned*)(P.ws + WS_HQL); float* HS = (float*)(P.ws + WS_HS);
    for (int t = vb * NW + wave; t < NTOK; t += gridDim.x * NW) {
        float y[16]; unpk8(((const v4u*)(HN + (size_t)t * 1024))[2 * lane], y); unpk8(((const v4u*)(HN + (size_t)t * 1024))[2 * lane + 1], y + 8);
        float cm = 0.f;
#pragma unroll
        for (int i = 0; i < 16; ++i) cm = fmaxf(cm, fabsf(y[i]));
        cm = fmaxf(cm, __shfl_xor(cm, 1));
        const float sc = cm > 0.f ? cm * (1.0f / 119.0f) : 1.0f, inv = 1.0f / sc; unsigned dh[2] = {0u, 0u}, dl[2] = {0u, 0u};
#pragma unroll
        for (int i = 0; i < 16; ++i) { const int h = (int)rintf(y[i] * inv), lo = ((h + 8) & 15) - 8;
            dl[i >> 3] |= ((unsigned)lo & 15u) << (4 * (i & 7)); dh[i >> 3] |= ((unsigned)((h - lo) >> 4) & 15u) << (4 * (i & 7)); }
        *(uint2*)(HQH + (size_t)t * 128 + 2 * lane) = make_uint2(dh[0], dh[1]); *(uint2*)(HQL + (size_t)t * 128 + 2 * lane) = make_uint2(dl[0], dl[1]);
        if ((lane & 1) == 0) HS[(size_t)t * 32 + (lane >> 1)] = sc;
    }
}
__device__ __forceinline__ void p10_topk(const Params& P, LAS unsigned char* lds, int tid, int lane, int wave, int vb) {
    const bf16* Q2 = (const bf16*)(P.ws + WS_Q2); const bf16* K1B = (const bf16*)(P.ws + WS_K1B); const bf16* K2B = (const bf16*)(P.ws + WS_K2B);
    int* IDX = (int*)(P.ws + WS_IDX); float* GATE = (float*)(P.ws + WS_GATE); const float* SSQ1 = (const float*)(P.ws + WS_SSQ1);
    LAS bf16* Kl = (LAS bf16*)lds;
    LAS int* Tb = (LAS int*)(lds + 69632 + wave * 2048);
    const int r = lane & 15, g = lane >> 4;
    const int h = vb & 7, wgx = vb >> 3, nwg = gridDim.x >> 3;
    __syncthreads();
    for (int i = tid; i < 4096; i += 512) { const int half = i >> 11, rem = i & 2047, n = rem >> 4, c = rem & 15;
        *(LAS v4u*)(Kl + half * 17408 + n * 136 + c * 8) = *(const v4u*)((half ? K2B : K1B) + (size_t)h * 16384 + n * 128 + c * 8); }
    __syncthreads();
    for (int tile = wgx * NW + wave; tile < NTOK / 16; tile += nwg * NW) {
        const size_t row = (size_t)tile * 16 + r;
        int R[2][16];
#pragma unroll
        for (int half = 0; half < 2; ++half) {
            bf16x8 qb[4];
#pragma unroll
            for (int ks = 0; ks < 4; ++ks) qb[ks] = *(const bf16x8*)(Q2 + row * 2048 + h * 256 + half * 128 + 32 * ks + 8 * g);
            int X[16], Y[16];
#pragma unroll
            for (int nb = 0; nb < 8; ++nb) {
                f32x4 acc = {0.f, 0.f, 0.f, 0.f};
#pragma unroll
                for (int ks = 0; ks < 4; ++ks) acc = MFMA16(*(const LAS bf16x8*)(Kl + half * 17408 + (16 * nb + r) * 136 + 32 * ks + 8 * g), qb[ks], acc);
#pragma unroll
                for (int k = 0; k < 4; ++k) { const int key = (f2ord(acc[k]) & ~0x7f) | (16 * nb + 4 * g + k); if (nb < 4) X[4 * nb + k] = key; else Y[4 * (nb - 4) + k] = key; }
            }
            sort16_desc(X); sort16_desc(Y); merge16_desc(X, Y);
            xmerge16(X, 16); xmerge16(X, 32);
#pragma unroll
            for (int i = 0; i < 16; ++i) R[half][i] = X[i];
        }
        if (g == 0) {
#pragma unroll
            for (int i = 0; i < 16; ++i) { Tb[r * 32 + i] = R[0][i] & 0x7f; Tb[r * 32 + 16 + i] = R[1][i] & 0x7f; }
        }
        float F1[16], F2[16];
#pragma unroll
        for (int i = 0; i < 16; ++i) { F1[i] = ord2f(R[0][i] & ~0x7f); F2[i] = ord2f(R[1][i] & ~0x7f); }
        int C[16];
#pragma unroll
        for (int sl = 0; sl < 16; ++sl) {
            const int a1 = sl < 8 ? 1 : (sl < 13 ? 2 : -1), b1 = sl < 8 ? sl : sl - 8;
            const int a2 = sl < 4 ? 3 : (sl < 7 ? 4 : (sl < 9 ? 5 : (sl < 11 ? 6 : (sl < 13 ? 7 : -1)))), b2 = sl < 4 ? sl : (sl < 7 ? sl - 4 : (sl < 9 ? sl - 7 : (sl < 11 ? sl - 9 : sl - 11)));
            const int a3 = sl < 8 ? 8 + sl : -1;
            const int k0 = (f2ord(F1[0] + F2[sl]) & ~0xff) | (0 << 4) | sl;
            const int k1 = a1 >= 0 ? ((f2ord(F1[a1 < 0 ? 0 : a1] + F2[b1 & 15]) & ~0xff) | (a1 << 4) | (b1 & 15)) : (int)0x80000000;
            const int k2 = a2 >= 0 ? ((f2ord(F1[a2 < 0 ? 0 : a2] + F2[b2 & 15]) & ~0xff) | (a2 << 4) | (b2 & 15)) : (int)0x80000000;
            const int k3 = a3 >= 0 ? ((f2ord(F1[a3 < 0 ? 0 : a3] + F2[0]) & ~0xff) | (a3 << 4)) : (int)0x80000000;
            C[sl] = g == 0 ? k0 : (g == 1 ? k1 : (g == 2 ? k2 : k3));
        }
        sort16_desc(C); xmerge16(C, 16); xmerge16(C, 32);
        const float rstd1 = rsqrtf(SSQ1[row] * (1.0f / 1024.0f) + EPS);
        float e[16], sum = 0.f; const float mx = ord2f(C[0] & ~0xff);
#pragma unroll
        for (int i = 0; i < 16; ++i) { e[i] = __expf((ord2f(C[i] & ~0xff) - mx) * rstd1); sum += e[i]; }
        const float inv = __builtin_amdgcn_rcpf(sum);
        int oi[4]; float og[4];
#pragma unroll
        for (int kk = 0; kk < 4; ++kk) {
            const int key = g == 0 ? C[kk] : (g == 1 ? C[4 + kk] : (g == 2 ? C[8 + kk] : C[12 + kk]));
            const float ev = g == 0 ? e[kk] : (g == 1 ? e[4 + kk] : (g == 2 ? e[8 + kk] : e[12 + kk]));
            const int a = (key >> 4) & 15, bq = key & 15;
            oi[kk] = Tb[r * 32 + a] * 128 + Tb[r * 32 + 16 + bq]; og[kk] = ev * inv;
        }
#pragma unroll
        for (int kk = 0; kk < 4; ++kk) { const int pos = (4 * (g & 1) + kk) * 16 + 2 * h + (g >> 1); IDX[row * 128 + pos] = oi[kk]; GATE[row * 128 + pos] = og[kk]; }
    }
}

typedef _Float16 f16x2 __attribute__((ext_vector_type(2)));
__device__ __forceinline__ f16x2 bfpair_to_h2(unsigned w) { return __builtin_bit_cast(f16x2, __builtin_amdgcn_cvt_pkrtz(bf_lo(w), bf_hi(w))); }
template <int B> __device__ __forceinline__ f16x2 fp4_to_h2(unsigned w) { return __builtin_bit_cast(f16x2, __builtin_amdgcn_cvt_scalef32_pk_f16_fp4(w, 1.0f, B)); }
__device__ __forceinline__ void p11a_reduce_store(const v4u (&ud)[16], const v4u hh, const v4u hl, const float hsc, float* PART, int t, int x, int rg, int ch) {
    float z[16];
#pragma unroll
    for (int gq = 0; gq < 16; ++gq) {
        int ah = __builtin_amdgcn_sdot8((int)ud[gq].x, (int)hh.x, 0, false), al = __builtin_amdgcn_sdot8((int)ud[gq].x, (int)hl.x, 0, false);
        ah = __builtin_amdgcn_sdot8((int)ud[gq].y, (int)hh.y, ah, false); al = __builtin_amdgcn_sdot8((int)ud[gq].y, (int)hl.y, al, false);
        ah = __builtin_amdgcn_sdot8((int)ud[gq].z, (int)hh.z, ah, false); al = __builtin_amdgcn_sdot8((int)ud[gq].z, (int)hl.z, al, false);
        ah = __builtin_amdgcn_sdot8((int)ud[gq].w, (int)hh.w, ah, false); al = __builtin_amdgcn_sdot8((int)ud[gq].w, (int)hl.w, al, false);
        z[gq] = (float)(16 * ah + al) * hsc; }
    float z8[8], z4[4], z2[2];
    { const bool b = ch & 4;
#pragma unroll
      for (int i = 0; i < 8; ++i) { const float keep = b ? z[8 + i] : z[i], send = b ? z[i] : z[8 + i]; z8[i] = keep + __shfl_xor(send, 4); } }
    { const bool b = ch & 2;
#pragma unroll
      for (int i = 0; i < 4; ++i) { const float keep = b ? z8[4 + i] : z8[i], send = b ? z8[i] : z8[4 + i]; z4[i] = keep + __shfl_xor(send, 2); } }
    { const bool b = ch & 1;
#pragma unroll
      for (int i = 0; i < 2; ++i) { const float keep = b ? z4[2 + i] : z4[i], send = b ? z4[i] : z4[2 + i]; z2[i] = keep + __shfl_xor(send, 1); } }
    *(float2*)(PART + ((size_t)t * 4 + x) * 128 + rg * 16 + 2 * ch) = make_float2(z2[0], z2[1]);
}
__device__ __forceinline__ void p11a_udot(const Params& P, int lane, int wave, int vb) {
    const unsigned* HQH = (const unsigned*)(P.ws + WS_HQH); const unsigned* HQL = (const unsigned*)(P.ws + WS_HQL); const float* HS = (const float*)(P.ws + WS_HS);
    const unsigned char* U4 = P.ws + WS_U4; const int* IDX = (const int*)(P.ws + WS_IDX); float* PART = (float*)(P.ws + WS_PART);
    const int x = vb & 3, wgx = vb >> 2, nwg = gridDim.x >> 2, rg = lane >> 3, ch = lane & 7;
    const int tstep = nwg * NW;
    for (int t = wgx * NW + wave; t < NTOK; t += 2 * tstep) {
        const int tB = t + tstep;
        int eA[16], eB[16];
#pragma unroll
        for (int q = 0; q < 4; ++q) { const int4 v = *(const int4*)(IDX + (size_t)t * 128 + rg * 16 + 4 * q); eA[4 * q] = v.x; eA[4 * q + 1] = v.y; eA[4 * q + 2] = v.z; eA[4 * q + 3] = v.w;
            const int4 w = *(const int4*)(IDX + (size_t)tB * 128 + rg * 16 + 4 * q); eB[4 * q] = w.x; eB[4 * q + 1] = w.y; eB[4 * q + 2] = w.z; eB[4 * q + 3] = w.w; }
        const v4u hhA = *(const v4u*)(HQH + (size_t)t * 128 + 32 * x + 4 * ch), hlA = *(const v4u*)(HQL + (size_t)t * 128 + 32 * x + 4 * ch);
        const v4u hhB = *(const v4u*)(HQH + (size_t)tB * 128 + 32 * x + 4 * ch), hlB = *(const v4u*)(HQL + (size_t)tB * 128 + 32 * x + 4 * ch);
        const float hsA = HS[(size_t)t * 32 + 8 * x + ch], hsB = HS[(size_t)tB * 32 + 8 * x + ch];
        v4u udA[16], udB[16];
#pragma unroll
        for (int gq = 0; gq < 16; ++gq) udA[gq] = *(const v4u*)(U4 + (size_t)eA[gq] * 512 + 128 * x + 16 * ch);
#pragma unroll
        for (int gq = 0; gq < 16; ++gq) udB[gq] = *(const v4u*)(U4 + (size_t)eB[gq] * 512 + 128 * x + 16 * ch);
        p11a_reduce_store(udA, hhA, hlA, hsA, PART, t, x, rg, ch);
        p11a_reduce_store(udB, hhB, hlB, hsB, PART, tB, x, rg, ch);
    }
}
__device__ __forceinline__ void p11b_weights(const Params& P, int tid, int vb) {
    const float* PART = (const float*)(P.ws + WS_PART); float* GW = (float*)(P.ws + WS_GATE); const float* SSQ1 = (const float*)(P.ws + WS_SSQ1);
    const int* IDX = (const int*)(P.ws + WS_IDX); const float* SU = (const float*)(P.ws + WS_SU); const float* SV = (const float*)(P.ws + WS_SV);
    for (size_t i = (size_t)vb * 512 + tid; i < (size_t)NTOK * 128; i += (size_t)gridDim.x * 512) {
        const size_t t = i >> 7, pos = i & 127; float zs = 0.f;
#pragma unroll
        for (int x = 0; x < 4; ++x) zs += PART[(t * 4 + x) * 128 + pos];
        const int e = IDX[i];
        const float zv = zs * SU[e] * rsqrtf(SSQ1[t] * (1.0f / 1024.0f) + EPS);
        GW[i] = GW[i] * 0.5f * zv * (1.0f + erff(zv * 0.70710678118654752f)) * SV[e];
    }
}
__device__ __forceinline__ void p11c_vacc(const Params& P, int lane, int wave, int vb) {
    const unsigned char* V4 = P.ws + WS_V4; const int* IDX = (const int*)(P.ws + WS_IDX); const float* GW = (const float*)(P.ws + WS_GATE);
    bf16* XB = (bf16*)(P.ws + WS_HN); float* SSQ = (float*)(P.ws + WS_SSQ);
    const int x = vb & 3, wgx = vb >> 2, nwg = gridDim.x >> 2, rg = lane >> 3, ch = lane & 7;
    for (int t = wgx * NW + wave; t < NTOK; t += nwg * NW) {
        int e[16]; float w[16];
#pragma unroll
        for (int q = 0; q < 4; ++q) { const int4 v = *(const int4*)(IDX + (size_t)t * 128 + rg * 16 + 4 * q); e[4 * q] = v.x; e[4 * q + 1] = v.y; e[4 * q + 2] = v.z; e[4 * q + 3] = v.w;
            const float4 wv = *(const float4*)(GW + (size_t)t * 128 + rg * 16 + 4 * q); w[4 * q] = wv.x; w[4 * q + 1] = wv.y; w[4 * q + 2] = wv.z; w[4 * q + 3] = wv.w; }
        v4u vd[16];
#pragma unroll
        for (int gq = 0; gq < 16; ++gq) vd[gq] = *(const v4u*)(V4 + (size_t)e[gq] * 512 + 128 * x + 16 * ch);
        bf16* xp = XB + (size_t)t * 1024 + 256 * x + 32 * ch + 4 * rg;
        const uint2 xo = *(const uint2*)xp;
        f16x2 acc[16];
#pragma unroll
        for (int i = 0; i < 16; ++i) acc[i] = (f16x2){(_Float16)0.f, (_Float16)0.f};
#pragma unroll
        for (int gq = 0; gq < 16; ++gq) { const f16x2 ww = __builtin_bit_cast(f16x2, __builtin_amdgcn_cvt_pkrtz(w[gq], w[gq])); const unsigned w4[4] = {vd[gq].x, vd[gq].y, vd[gq].z, vd[gq].w};
#pragma unroll
            for (int q = 0; q < 4; ++q) { acc[4 * q] = __builtin_elementwise_fma(fp4_to_h2<0>(w4[q]), ww, acc[4 * q]); acc[4 * q + 1] = __builtin_elementwise_fma(fp4_to_h2<1>(w4[q]), ww, acc[4 * q + 1]);
                acc[4 * q + 2] = __builtin_elementwise_fma(fp4_to_h2<2>(w4[q]), ww, acc[4 * q + 2]); acc[4 * q + 3] = __builtin_elementwise_fma(fp4_to_h2<3>(w4[q]), ww, acc[4 * q + 3]); } }
        f16x2 a8[8], a4[4], a2[2];
        { const bool b = rg & 4;
#pragma unroll
          for (int i = 0; i < 8; ++i) { const f16x2 keep = b ? acc[8 + i] : acc[i], send = b ? acc[i] : acc[8 + i]; a8[i] = keep + __builtin_bit_cast(f16x2, __shfl_xor(__builtin_bit_cast(int, send), 32)); } }
        { const bool b = rg & 2;
#pragma unroll
          for (int i = 0; i < 4; ++i) { const f16x2 keep = b ? a8[4 + i] : a8[i], send = b ? a8[i] : a8[4 + i]; a4[i] = keep + __builtin_bit_cast(f16x2, __shfl_xor(__builtin_bit_cast(int, send), 16)); } }
        { const bool b = rg & 1;
#pragma unroll
          for (int i = 0; i < 2; ++i) { const f16x2 keep = b ? a4[2 + i] : a4[i], send = b ? a4[i] : a4[2 + i]; a2[i] = keep + __builtin_bit_cast(f16x2, __shfl_xor(__builtin_bit_cast(int, send), 8)); } }
        f32x4 xn; xn[0] = bf_lo(xo.x) + (float)a2[0][0]; xn[1] = bf_hi(xo.x) + (float)a2[0][1]; xn[2] = bf_lo(xo.y) + (float)a2[1][0]; xn[3] = bf_hi(xo.y) + (float)a2[1][1];
        uint2 xg; xg.x = pk2(xn[0], xn[1]); xg.y = pk2(xn[2], xn[3]);
        *(uint2*)xp = xg;
        { int p8 = __builtin_amdgcn_cvt_pk_fp8_f32(xn[0], xn[1], 0, false); p8 = __builtin_amdgcn_cvt_pk_fp8_f32(xn[2], xn[3], p8, true); *(int*)(P.ws + WS_X2B8 + (size_t)t * 1024 + 256 * x + 32 * ch + 4 * rg) = p8; }
        const float ss = wave_sum((xn[0] * xn[0] + xn[1] * xn[1]) + (xn[2] * xn[2] + xn[3] * xn[3]));
        if (lane == 0) atomicAdd(SSQ + t, ss);
    }
}

__global__ void __launch_bounds__(512, 2) mk_fwd(Params P) {
    extern __shared__ __attribute__((aligned(16))) unsigned char lds_raw[];
    cg::grid_group grid = cg::this_grid();
    LAS unsigned char* lds = (LAS unsigned char*)lds_raw;
    const int tid = threadIdx.x, lane = tid & 63, wave = __builtin_amdgcn_readfirstlane(tid >> 6);
    const int lo = P.ph_lo, hi = P.ph_hi, G = gridDim.x, bx = blockIdx.x;
    unsigned char* ws = P.ws;
    const int gw = bx * NW + wave, NGW = G * NW;
#ifndef PH_MASK
#define PH_MASK 0xffff
#endif
#define IN(k) (((PH_MASK >> (k)) & 1) && lo <= (k) && (k) < hi)
    volatile LAS unsigned* xst = (volatile LAS unsigned*)(lds + LDS_BYTES - 16);
    if (tid < 4) xst[tid] = 0u;
    __syncthreads();
    const XcdBarrier bar = xcd_barrier_post((unsigned*)(ws + WS_BAR), xst);
    unsigned* vctl = (unsigned*)(ws + WS_BAR) + 4096;
    if (tid == 0) { const unsigned xcc = xb_xcc_id() & 7u; xst[2] = xcc; xst[3] = xb_add(&vctl[16 * xcc], 1u); }
#ifdef USE_CG
#define GRID_BAR() grid.sync()
#else
#define GRID_BAR() xcd_barrier(bar)
#endif
#define SYNC_AFTER(k) do { if (IN(k) && IN((k) + 1)) { if ((k) == 0) grid.sync(); else GRID_BAR(); } } while (0)
    typedef pg8::bf16_t pb;
    if (IN(0)) p0_prologue(P, lds, tid, lane, wave);
    SYNC_AFTER(0);
    if (tid == 0) {
        const unsigned xcc = xst[2], sl = xst[3], cap = (unsigned)G >> 3; unsigned v;
        if (sl < cap) v = sl * 8u + xcc;
        else { unsigned o = xb_add(&vctl[160], 1u); v = 0u;
            for (unsigned x = 0; x < 8u; ++x) { const unsigned c = min(xb_ld(&vctl[16 * x]), cap), fr = cap - c; if (o < fr) { v = (c + o) * 8u + x; break; } o -= fr; } }
        xst[2] = v;
    }
    __syncthreads();
    const int vb = (int)xst[2];
    if (IN(1)) {
        { pg8::Gemm g{(const pb*)(ws + WS_XN), (const pb*)(ws + WS_W1T), NTOK, 3584, 1024}; pg8::StaticOrder S; S.init(NTOK, 3584, G, vb);
          pg8::EpiProj E{(pb*)(ws + WS_QKVA), (pb*)(ws + WS_QKM), (pb*)(ws + WS_VM), (pb*)(ws + WS_OM), (pb*)(ws + WS_G), C2};
          pg8::gemm_phase<pg8::EpiProj, pg8::StaticOrder, true, true>(lds, g, S, E); }
        { pg8::Gemm g{(const pb*)P.out, (const pb*)(ws + WS_W1G8), NTOK, 2048, 512}; pg8::StaticOrder S; S.init(NTOK, 2048, G, vb);
          pg8::EpiGateF8 E{(pb*)(ws + WS_G)};
          pg8::gemm_phase<pg8::EpiGateF8, pg8::StaticOrder, true, true>(lds, g, S, E); }
    }
    SYNC_AFTER(1);
    if (IN(2)) { p2_attention(P, lds, lane, wave, vb); __syncthreads(); p2_mlstm_local(P, lds, tid, lane, wave, vb); }
    SYNC_AFTER(2);
    if (IN(3)) p3_mlstm_scan(P, tid, vb);
    SYNC_AFTER(3);
    if (IN(4)) p4_mlstm_out(P, lds, tid, lane, wave, vb);
    SYNC_AFTER(4);
    if (IN(5)) {
        pg8::Gemm g{(const pb*)(ws + WS_YA), (const pb*)(ws + WS_WAT), NTOK, 1024, 1024}; pg8::StaticOrder S; S.init(NTOK, 1024, G, vb);
        pg8::EpiMerged E{(pb*)(ws + WS_MERGED), (const pb*)(ws + WS_G)};
        pg8::gemm_phase<pg8::EpiMerged, pg8::StaticOrder, true, true>(lds, g, S, E);
    }
    if (IN(5) && IN(7)) GRID_BAR();
    if (IN(7)) {
        pg8::Gemm g{(const pb*)(ws + WS_MERGED), (const pb*)(ws + WS_WOT), NTOK, 1024, 1024}; pg8::StaticOrder S; S.init(NTOK, 1024, G, vb);
        pg8::EpiResidual E{P.in[0], (pb*)(ws + WS_HN), (float*)(ws + WS_SSQ1)};
        pg8::gemm_phase<pg8::EpiResidual, pg8::StaticOrder, true, true>(lds, g, S, E);
    }
    if (IN(7) && IN(9)) GRID_BAR();
    if (IN(9)) {
        pg8::Gemm g{(const pb*)(ws + WS_HN), (const pb*)(ws + WS_WQT), NTOK, 2048, 1024}; pg8::StaticOrder S; S.init(NTOK, 2048, G, vb);
        pg8::EpiStore E{(pb*)(ws + WS_Q2), 2048};
        pg8::gemm_phase<pg8::EpiStore, pg8::StaticOrder, true, true>(lds, g, S, E);
    }
    SYNC_AFTER(9);
    if (IN(10)) { p10_quant_rows(P, lane, wave, vb); p10_topk(P, lds, tid, lane, wave, vb); }
    SYNC_AFTER(10);
    if (IN(11)) { p11a_udot(P, lane, wave, vb); GRID_BAR(); p11b_weights(P, tid, vb); GRID_BAR(); p11c_vacc(P, lane, wave, vb); }
    SYNC_AFTER(11);
    if (IN(12)) {
        pg8::Gemm g{(const pb*)(ws + WS_PB), (const pb*)(ws + WS_WPT), NTOK, 1024, 256}; pg8::StaticOrder S; S.init(NTOK, 1024, G, vb);
        pg8::EpiStore E{(pb*)(ws + WS_E), 1024};
        pg8::gemm_phase<pg8::EpiStore, pg8::StaticOrder, true, true>(lds, g, S, E);
    }
    if (IN(12) && IN(13)) { asm volatile("s_waitcnt vmcnt(0)" ::: "memory"); __syncthreads(); }
    if (IN(13)) {
        pg8::Gemm g{(const pb*)(ws + WS_X2B8), (const pb*)(ws + WS_WG8), NTOK, 1024, 512}; pg8::StaticOrder S; S.init(NTOK, 1024, G, vb);
        pg8::EpiPle E{(const pb*)(ws + WS_HN), (pb*)(ws + WS_X3B), (const pb*)(ws + WS_E), (const float*)(ws + WS_SSQ)};
        pg8::gemm_phase<pg8::EpiPle, pg8::StaticOrder, true, true>(lds, g, S, E);
    }
    SYNC_AFTER(13);
    if (IN(14)) {
        const float* gf = P.in[19];
        for (int m = gw; m < NTOK; m += NGW) {
            const bf16* xr = (const bf16*)(ws + WS_X3B) + (size_t)m * 1024; float v[16]; float s = 0.f;
            unpk8(((const v4u*)xr)[2 * lane], v); unpk8(((const v4u*)xr)[2 * lane + 1], v + 8);
#pragma unroll
            for (int i = 0; i < 16; ++i) s += v[i] * v[i];
            const float rstd = rsqrtf(wave_sum(s) * (1.f / 1024.f) + EPS);
            float* orow = P.out + (size_t)m * 1024 + 16 * lane;
#pragma unroll
            for (int j = 0; j < 4; ++j) { const f32x4 g = ((const f32x4*)(gf + 16 * lane))[j]; f32x4 o; o[0] = v[4 * j] * rstd * g[0]; o[1] = v[4 * j + 1] * rstd * g[1]; o[2] = v[4 * j + 2] * rstd * g[2]; o[3] = v[4 * j + 3] * rstd * g[3]; ((f32x4*)orow)[j] = o; }
        }
    }
}

extern "C" void kernel_launch(void* const* d_in, const int* in_sizes, int n_in, void* d_out, int out_size, void* d_ws, size_t ws_size, hipStream_t stream) {
    static int grid_blocks = 0;
    if (!grid_blocks) {
        int dev = 0, cus = 0, per_cu = 0;
        (void)hipGetDevice(&dev);
        (void)hipDeviceGetAttribute(&cus, hipDeviceAttributeMultiprocessorCount, dev);
        (void)hipFuncSetAttribute((const void*)mk_fwd, hipFuncAttributeMaxDynamicSharedMemorySize, LDS_BYTES);
        (void)hipOccupancyMaxActiveBlocksPerMultiprocessor(&per_cu, mk_fwd, 512, LDS_BYTES);
        if (per_cu > 1) per_cu = 1;
        grid_blocks = cus * per_cu;
    }
    if (n_in < 20 || ws_size < WS_NEED || grid_blocks <= 0) { fprintf(stderr, "kernel_launch: bad setup (n_in %d ws %zu grid %d)\n", n_in, ws_size, grid_blocks); return; }
    Params p{};
    for (int i = 0; i < 20; ++i) p.in[i] = (const float*)d_in[i];
    p.out = (float*)d_out; p.ws = (unsigned char*)d_ws; p.ph_lo = 0; p.ph_hi = 15;
    (void)hipMemsetAsync((unsigned char*)d_ws + WS_BAR, 0, BAR_BYTES, stream);
    void* args[] = {&p};
    hipError_t e = hipLaunchCooperativeKernel((void*)mk_fwd, dim3(grid_blocks), dim3(512), args, LDS_BYTES, stream);
    if (e != hipSuccess) fprintf(stderr, "cooperative launch failed: %s (grid %d)\n", hipGetErrorString(e), grid_blocks);
}
```

```cpp
#include <hip/hip_runtime.h>
#include <hip/hip_cooperative_groups.h>
#include <cstdio>
#include <cstdint>
namespace cg = cooperative_groups;
namespace pg8 {
#define PG8_LAS __attribute__((address_space(3)))
typedef unsigned short bf16_t;
typedef short bf16x8 __attribute__((ext_vector_type(8)));
typedef float f32x4 __attribute__((ext_vector_type(4)));
typedef unsigned u32x4 __attribute__((ext_vector_type(4)));
constexpr int BM = 256, BK = 64, HALF = 128, HTB = HALF * BK * 2  , STAGE_BYTES = 8 * HTB, NXCD = 8, WGM = 8;

__host__ __device__ __forceinline__ int lds_byte(int r, int c) { const int st = (r >> 4) * 2 + (c >> 5), rr = r & 15, cc = c & 31, ob = rr * 64 + cc * 2; return st * 1024 + (ob ^ (((ob >> 9) & 1) << 5)); }
__host__ __device__ __forceinline__ void stage_rc(int b, int& R, int& C) { const int st = b / 1024, sb = b % 1024, swz = sb ^ (((sb >> 9) & 1) << 5); R = (st >> 1) * 16 + swz / 64; C = (st & 1) * 32 + (swz % 64) / 2; }
__host__ __device__ __forceinline__ int perm32(int rho) { const int n = rho >> 4, i = rho & 15; return 8 * (i >> 2) + 4 * n + (i & 3); }

struct Unit { int pm, pn; };
struct Gemm { const bf16_t* A; const bf16_t* Bt; int M, N, K; };

struct StaticOrder {
    int nM, nN, nwg, G, c;
    __host__ __device__ void init(int M, int N, int G_, int c_) { nM = M / BM; nN = N / BM; nwg = nM * nN; G = G_; c = c_; }
    __host__ __device__ bool next(int i, Unit& u) const {
        const long L = (long)i * G + c; if (L >= nwg) return false;
        int wgid = (int)L; { const int q = nwg / NXCD, r = nwg % NXCD, xcd = wgid % NXCD, off = wgid / NXCD; wgid = (xcd < r ? xcd * (q + 1) : r * (q + 1) + (xcd - r) * q) + off; }
        const int nig = WGM * nN, gid = wgid / nig, fm = gid * WGM, gsz = (nM - fm) < WGM ? (nM - fm) : WGM;
        u.pm = fm + ((wgid % nig) % gsz); u.pn = (wgid % nig) / gsz; return true;
    }
    __device__ __forceinline__ void a_ready(const Unit&) const {}
    __device__ __forceinline__ void done(const Unit&) const {}
};

__device__ __forceinline__ unsigned cvt_pk_bf16(float lo, float hi) { unsigned r; asm volatile("v_cvt_pk_bf16_f32 %0, %1, %2" : "=v"(r) : "v"(lo), "v"(hi)); return r; }
typedef float f32x2 __attribute__((ext_vector_type(2)));

__device__ __forceinline__ float sigm(float x) { return __builtin_amdgcn_rcpf(1.0f + __builtin_amdgcn_exp2f(-1.4426950408889634f * x)); }
__device__ __forceinline__ float bf_lo(unsigned w) { return __uint_as_float(w << 16); }
__device__ __forceinline__ float bf_hi(unsigned w) { return __uint_as_float(w & 0xffff0000u); }
__device__ __forceinline__ u32x4 pack8(const f32x4& v0, const f32x4& v1) { u32x4 w; w.x = cvt_pk_bf16(v0[0], v0[1]); w.y = cvt_pk_bf16(v0[2], v0[3]); w.z = cvt_pk_bf16(v1[0], v1[1]); w.w = cvt_pk_bf16(v1[2], v1[3]); return w; }
__device__ __forceinline__ void unpack8(const u32x4& w, f32x4& v0, f32x4& v1) { v0[0] = bf_lo(w.x); v0[1] = bf_hi(w.x); v0[2] = bf_lo(w.y); v0[3] = bf_hi(w.y); v1[0] = bf_lo(w.z); v1[1] = bf_hi(w.z); v1[2] = bf_lo(w.w); v1[3] = bf_hi(w.w); }

#define PG8_EPI_WALK(...) \
    _Pragma("unroll") for (int ai = 0; ai < 2; ++ai) _Pragma("unroll") for (int m = 0; m < 4; ++m) { const int row = u.pm * BM + wr * 64 + fr + ai * HALF + m * 16; \
        _Pragma("unroll") for (int bj = 0; bj < 2; ++bj) { const int ct = wc * 64 + bj * 32 + 8 * fq; f32x4 v0 = acc[ai][bj][m][0], v1 = acc[ai][bj][m][1]; __VA_ARGS__ } }

__device__ __forceinline__ u32x4 xor8_16B(u32x4 v) { u32x4 r; r.x = (unsigned)__shfl_xor((int)v.x, 8); r.y = (unsigned)__shfl_xor((int)v.y, 8); r.z = (unsigned)__shfl_xor((int)v.z, 8); r.w = (unsigned)__shfl_xor((int)v.w, 8); return r; }
__device__ __forceinline__ u32x4 bperm_16B(int src_byte, u32x4 v) { u32x4 r; r.x = (unsigned)__builtin_amdgcn_ds_bpermute(src_byte, (int)v.x); r.y = (unsigned)__builtin_amdgcn_ds_bpermute(src_byte, (int)v.y); r.z = (unsigned)__builtin_amdgcn_ds_bpermute(src_byte, (int)v.z); r.w = (unsigned)__builtin_amdgcn_ds_bpermute(src_byte, (int)v.w); return r; }
__device__ __forceinline__ void store_rows_bf16(bf16_t* O, size_t ldc, int r0, int c0, int fr, int fq, u32x4 w0, u32x4 w1) {
    const bool h = fr & 8; const u32x4 recv = xor8_16B(h ? w0 : w1);
    const u32x4 d1 = h ? recv : w0, d2 = h ? w1 : recv;
    const int lane = fr + 16 * fq, src = ((lane >> 3) + 8 * ((lane >> 2) & 1) + 16 * (lane & 3)) * 4;
    const u32x4 e1 = bperm_16B(src, d1), e2 = bperm_16B(src, d2);
    bf16_t* p = O + (size_t)(r0 + (lane >> 3)) * ldc + c0 + 8 * (lane & 7);
    *(u32x4*)p = e1; *(u32x4*)(p + 8 * ldc) = e2;
}
struct EpiProj {
    static constexpr bool PERM = true, AFTER_DRAIN = false, MIDK = false, FP8 = false; static constexpr int SCALE_B = 0x7f;
    bf16_t *qkva, *qkm, *vm, *om, *g; float c2;
    __device__ __forceinline__ void operator()(const f32x4 (&acc)[2][2][4][2], const Unit& u, int wr, int wc, int fr, int fq) const {
        const int pn = u.pn; bf16_t* base; int ldc, colt, mode = 0; float sc = 1.f;
        if (pn < 6) { base = qkva; ldc = 1536; colt = pn * 256; if (pn < 2) sc = c2; }
        else if (pn < 10) { base = qkm; ldc = 1024; colt = (pn - 6) * 256; }
        else if (pn < 12) { base = vm; ldc = 512; colt = (pn - 10) * 256; }
        else if (pn < 14) { base = om; ldc = 512; colt = (pn - 12) * 256; mode = 1; }
        else { base = g; ldc = 2048; colt = (pn - 14) * 256; mode = 1; }
#pragma unroll
        for (int ai = 0; ai < 2; ++ai)
#pragma unroll
            for (int m = 0; m < 4; ++m) { u32x4 w[2];
#pragma unroll
                for (int bj = 0; bj < 2; ++bj) { f32x4 v0 = acc[ai][bj][m][0], v1 = acc[ai][bj][m][1];
                    if (mode == 1) { _Pragma("unroll") for (int i = 0; i < 4; ++i) { v0[i] = sigm(v0[i]); v1[i] = sigm(v1[i]); } }
                    else { v0 = v0 * sc; v1 = v1 * sc; }
                    w[bj] = pack8(v0, v1); }
                store_rows_bf16(base, (size_t)ldc, u.pm * BM + wr * 64 + ai * HALF + m * 16, colt + wc * 64, fr, fq, w[0], w[1]); }
    }
};
struct EpiGateF8 {
    static constexpr bool PERM = true, AFTER_DRAIN = false, MIDK = false, FP8 = true; static constexpr int SCALE_B = 0x7b;
    bf16_t* g;
    __device__ __forceinline__ void operator()(const f32x4 (&acc)[2][2][4][2], const Unit& u, int wr, int wc, int fr, int fq) const {
#pragma unroll
        for (int ai = 0; ai < 2; ++ai)
#pragma unroll
            for (int m = 0; m < 4; ++m) { u32x4 w[2];
#pragma unroll
                for (int bj = 0; bj < 2; ++bj) { f32x4 v0 = acc[ai][bj][m][0], v1 = acc[ai][bj][m][1];
                    _Pragma("unroll") for (int i = 0; i < 4; ++i) { v0[i] = sigm(v0[i]); v1[i] = sigm(v1[i]); }
                    w[bj] = pack8(v0, v1); }
                store_rows_bf16(g, 2048, u.pm * BM + wr * 64 + ai * HALF + m * 16, u.pn * BM + wc * 64, fr, fq, w[0], w[1]); }
    }
};
struct EpiStore {
    static constexpr bool PERM = true, AFTER_DRAIN = false, MIDK = false, FP8 = false; static constexpr int SCALE_B = 0x7f;
    bf16_t* O; int ldc;
    __device__ __forceinline__ void operator()(const f32x4 (&acc)[2][2][4][2], const Unit& u, int wr, int wc, int fr, int fq) const {
#pragma unroll
        for (int ai = 0; ai < 2; ++ai)
#pragma unroll
            for (int m = 0; m < 4; ++m) store_rows_bf16(O, (size_t)ldc, u.pm * BM + wr * 64 + ai * HALF + m * 16, u.pn * BM + wc * 64, fr, fq, pack8(acc[ai][0][m][0], acc[ai][0][m][1]), pack8(acc[ai][1][m][0], acc[ai][1][m][1]));
    }
};
template <bool ADD> struct EpiGated {
    static constexpr bool PERM = true, AFTER_DRAIN = false, MIDK = false, FP8 = false; static constexpr int SCALE_B = 0x7f;
    bf16_t* O; const bf16_t* prev; const bf16_t* gate; int gcol0;
    __device__ __forceinline__ void operator()(const f32x4 (&acc)[2][2][4][2], const Unit& u, int wr, int wc, int fr, int fq) const {
#pragma unroll
        for (int ai = 0; ai < 2; ++ai)
#pragma unroll
            for (int m = 0; m < 4; ++m) { const int row = u.pm * BM + wr * 64 + fr + ai * HALF + m * 16; u32x4 w[2];
#pragma unroll
                for (int bj = 0; bj < 2; ++bj) { const int col = u.pn * BM + wc * 64 + bj * 32 + 8 * fq; f32x4 v0 = acc[ai][bj][m][0], v1 = acc[ai][bj][m][1];
                    f32x4 g0, g1; unpack8(*(const u32x4*)(gate + (size_t)row * 2048 + gcol0 + col), g0, g1);
                    v0 = v0 * g0; v1 = v1 * g1;
                    if (ADD) { f32x4 p0, p1; unpack8(*(const u32x4*)(prev + (size_t)row * 1024 + col), p0, p1); v0 = v0 + p0; v1 = v1 + p1; }
                    w[bj] = pack8(v0, v1); }
                store_rows_bf16(O, 1024, u.pm * BM + wr * 64 + ai * HALF + m * 16, u.pn * BM + wc * 64, fr, fq, w[0], w[1]); }
    }
};
struct EpiMerged {
    static constexpr bool PERM = true, AFTER_DRAIN = false, MIDK = true, FP8 = false; static constexpr int SCALE_B = 0x7f;
    bf16_t* O; const bf16_t* gate;
    __device__ __forceinline__ void mid(f32x4 (&acc)[2][2][4][2], const Unit& u, int wr, int wc, int fr, int fq) const {
#pragma unroll
        for (int ai = 0; ai < 2; ++ai)
#pragma unroll
            for (int mp = 0; mp < 2; ++mp) {
                u32x4 ga[2][2], gm[2][2];
#pragma unroll
                for (int mm = 0; mm < 2; ++mm)
#pragma unroll
                    for (int bj = 0; bj < 2; ++bj) { const size_t o = (size_t)(u.pm * BM + wr * 64 + fr + ai * HALF + (2 * mp + mm) * 16) * 2048 + u.pn * BM + wc * 64 + bj * 32 + 8 * fq;
                        ga[mm][bj] = *(const u32x4*)(gate + o); gm[mm][bj] = *(const u32x4*)(gate + o + 1024); }
#pragma unroll
                for (int mm = 0; mm < 2; ++mm)
#pragma unroll
                    for (int bj = 0; bj < 2; ++bj) { f32x4 a0, a1, m0, m1; unpack8(ga[mm][bj], a0, a1); unpack8(gm[mm][bj], m0, m1);
#pragma unroll
                        for (int i = 0; i < 4; ++i) { acc[ai][bj][2 * mp + mm][0][i] *= a0[i] * __builtin_amdgcn_rcpf(m0[i]); acc[ai][bj][2 * mp + mm][1][i] *= a1[i] * __builtin_amdgcn_rcpf(m1[i]); } }
            }
    }
    __device__ __forceinline__ void operator()(const f32x4 (&acc)[2][2][4][2], const Unit& u, int wr, int wc, int fr, int fq) const {
#pragma unroll
        for (int ai = 0; ai < 2; ++ai)
#pragma unroll
            for (int mp = 0; mp < 2; ++mp) {
                u32x4 gm[2][2];
#pragma unroll
                for (int mm = 0; mm < 2; ++mm)
#pragma unroll
                    for (int bj = 0; bj < 2; ++bj) gm[mm][bj] = *(const u32x4*)(gate + (size_t)(u.pm * BM + wr * 64 + fr + ai * HALF + (2 * mp + mm) * 16) * 2048 + 1024 + u.pn * BM + wc * 64 + bj * 32 + 8 * fq);
#pragma unroll
                for (int mm = 0; mm < 2; ++mm) { const int m = 2 * mp + mm; u32x4 w[2];
#pragma unroll
                    for (int bj = 0; bj < 2; ++bj) { f32x4 m0, m1; unpack8(gm[mm][bj], m0, m1); w[bj] = pack8(acc[ai][bj][m][0] * m0, acc[ai][bj][m][1] * m1); }
                    store_rows_bf16(O, 1024, u.pm * BM + wr * 64 + ai * HALF + m * 16, u.pn * BM + wc * 64, fr, fq, w[0], w[1]); }
            }
    }
};
struct EpiResidual {
    static constexpr bool PERM = true, AFTER_DRAIN = false, MIDK = false, FP8 = false; static constexpr int SCALE_B = 0x7f;
    const float* res; bf16_t* xb; float* ssq;
    __device__ __forceinline__ void operator()(const f32x4 (&acc)[2][2][4][2], const Unit& u, int wr, int wc, int fr, int fq) const {
#pragma unroll
        for (int ai = 0; ai < 2; ++ai)
#pragma unroll
            for (int m = 0; m < 4; ++m) { const int row = u.pm * BM + wr * 64 + fr + ai * HALF + m * 16; float s = 0.f; u32x4 wx[2];
#pragma unroll
                for (int bj = 0; bj < 2; ++bj) { const int ct = wc * 64 + bj * 32 + 8 * fq; f32x4 v0 = acc[ai][bj][m][0], v1 = acc[ai][bj][m][1];
                    const size_t o = (size_t)row * 1024 + u.pn * BM + ct; const f32x4 r0 = *(const f32x4*)(res + o), r1 = *(const f32x4*)(res + o + 4);
                    v0 = v0 + r0; v1 = v1 + r1;
                    s += (v0[0] * v0[0] + v0[1] * v0[1]) + (v0[2] * v0[2] + v0[3] * v0[3]) + (v1[0] * v1[0] + v1[1] * v1[1]) + (v1[2] * v1[2] + v1[3] * v1[3]);
                    wx[bj] = pack8(v0, v1); }
                store_rows_bf16(xb, 1024, u.pm * BM + wr * 64 + ai * HALF + m * 16, u.pn * BM + wc * 64, fr, fq, wx[0], wx[1]);
                s += __shfl_xor(s, 16); s += __shfl_xor(s, 32);
                if (fq == 0) atomicAdd(ssq + row, s);
                asm volatile("" ::: "memory"); }
    }
};
struct EpiPle {
    static constexpr bool PERM = true, AFTER_DRAIN = false, MIDK = false, FP8 = true; static constexpr int SCALE_B = 0x7b;
    const bf16_t* x2; bf16_t* x3; const bf16_t* e; const float* ssq;
    __device__ __forceinline__ void operator()(const f32x4 (&acc)[2][2][4][2], const Unit& u, int wr, int wc, int fr, int fq) const {
        const int row0 = u.pm * BM + wr * 64 + fr;
        float sq_next = ssq[row0];
#pragma unroll
        for (int ai = 0; ai < 2; ++ai)
#pragma unroll
            for (int m = 0; m < 4; ++m) { const int row = row0 + ai * HALF + m * 16; const float sq = sq_next; u32x4 wx[2];
                if (!(ai == 1 && m == 3)) sq_next = ssq[row0 + (m == 3 ? HALF : ai * HALF + (m + 1) * 16)];
                const float rstd = rsqrtf(sq * (1.0f / 1024.0f) + 1e-6f);
#pragma unroll
                for (int bj = 0; bj < 2; ++bj) { const int ct = wc * 64 + bj * 32 + 8 * fq; f32x4 v0 = acc[ai][bj][m][0] * rstd, v1 = acc[ai][bj][m][1] * rstd;
                    const size_t o = (size_t)row * 1024 + u.pn * BM + ct; f32x4 e0, e1, r0, r1; unpack8(*(const u32x4*)(e + o), e0, e1); unpack8(*(const u32x4*)(x2 + o), r0, r1);
#pragma unroll
                    for (int i = 0; i < 4; ++i) { v0[i] = r0[i] + sigm(v0[i]) * e0[i]; v1[i] = r1[i] + sigm(v1[i]) * e1[i]; }
                    wx[bj] = pack8(v0, v1); }
                store_rows_bf16(x3, 1024, u.pm * BM + wr * 64 + ai * HALF + m * 16, u.pn * BM + wc * 64, fr, fq, wx[0], wx[1]); }
    }
};

typedef int i32x8 __attribute__((ext_vector_type(8))); typedef int i32x4 __attribute__((ext_vector_type(4)));
__device__ __forceinline__ i32x8 cat8(bf16x8 a, bf16x8 b) { return __builtin_shufflevector(__builtin_bit_cast(i32x4, a), __builtin_bit_cast(i32x4, b), 0, 1, 2, 3, 4, 5, 6, 7); }
template <bool F8> struct Frag { bf16x8 v4[2]; i32x8 v8; __device__ __forceinline__ void set(bf16x8 a, bf16x8 b) { if constexpr (F8) v8 = cat8(a, b); else { v4[0] = a; v4[1] = b; } } };
template <class Epi, class Sched, bool ALIGN_EPI = false, bool SP2 = false>
__device__ __forceinline__ void gemm_phase(PG8_LAS unsigned char* lds, const Gemm g, const Sched& S, const Epi& E) {
    int tid_ = threadIdx.x; asm volatile("" : "+v"(tid_));
    const int tid = tid_, wid = __builtin_amdgcn_readfirstlane(tid >> 6), lane = tid & 63, wr = wid >> 2, wc = wid & 3, fr = lane & 15, fq = lane >> 4;
    int K_ = g.K; asm volatile("" : "+s"(K_));
    const int K = K_, nt = K / BK;
    unsigned voffA[2], voffB[2];
#pragma unroll
    for (int i = 0; i < 2; ++i) { int R, C; stage_rc(tid * 16 + i * 8192, R, C); const int Rb = Epi::PERM ? (2 * (R & ~31) + perm32(R & 31)) : R;
        voffA[i] = (unsigned)(R * K + C) * 2u; voffB[i] = (unsigned)(Rb * K + C) * 2u; }
    const size_t kstep = (size_t)(BK * 2);
    const size_t hstep = (size_t)HALF * K * 2;
    const size_t hstepB = Epi::PERM ? (size_t)32 * K * 2 : hstep;
    const size_t tstep = 2 * hstep;
    const unsigned ldsw = (unsigned)wid * 1024u;
    const int aoff = lds_byte(wr * 64 + fr, fq * 8), boff = lds_byte(wc * 32 + fr, fq * 8);
#define PG8_SA(b, h) (((b) * 2 + (h)) * HTB)
#define PG8_SB(b, h) ((4 + (b) * 2 + (h)) * HTB)
#define PG8_STAGE(bufoff, gbase, voff) do { _Pragma("unroll") for (int _i = 0; _i < 2; ++_i) \
        __builtin_amdgcn_global_load_lds((const unsigned*)((const char*)(gbase) + (voff)[_i]), (PG8_LAS unsigned*)(lds + (bufoff) + ldsw + _i * 8192), 16, 0, 0); } while (0)
#define PG8_LDA(dst, b, h) do { _Pragma("unroll") for (int m = 0; m < 4; ++m) { const bf16x8 f0_ = *(const PG8_LAS bf16x8*)(lds + PG8_SA(b, h) + aoff + m * 2048), f1_ = *(const PG8_LAS bf16x8*)(lds + PG8_SA(b, h) + aoff + m * 2048 + 1024); dst[m].set(f0_, f1_); } } while (0)
#define PG8_LDB(dst, b, h) do { _Pragma("unroll") for (int n = 0; n < 2; ++n) { const bf16x8 f0_ = *(const PG8_LAS bf16x8*)(lds + PG8_SB(b, h) + boff + n * 2048), f1_ = *(const PG8_LAS bf16x8*)(lds + PG8_SB(b, h) + boff + n * 2048 + 1024); dst[n].set(f0_, f1_); } } while (0)
#define PG8_MMA(ai, bj, At, Bt) do { __builtin_amdgcn_s_setprio(1); \
        if constexpr (Epi::FP8) { _Pragma("unroll") for (int m = 0; m < 4; ++m) _Pragma("unroll") for (int n = 0; n < 2; ++n) \
            asm volatile("v_mfma_scale_f32_16x16x128_f8f6f4 %0, %1, %2, %0, %3, %4 op_sel_hi:[0,0,0]" : "+v"(acc[ai][bj][m][n]) : "v"(Bt[n].v8), "v"(At[m].v8), "v"(sclB), "v"(sclA)); } \
        else { _Pragma("unroll") for (int m = 0; m < 4; ++m) _Pragma("unroll") for (int n = 0; n < 2; ++n) _Pragma("unroll") for (int k = 0; k < 2; ++k) \
            acc[ai][bj][m][n] = __builtin_amdgcn_mfma_f32_16x16x32_bf16(Bt[n].v4[k], At[m].v4[k], acc[ai][bj][m][n], 0, 0, 0); } \
        __builtin_amdgcn_s_setprio(0); } while (0)
#define PG8_WAIT_V(n) asm volatile("s_waitcnt vmcnt(" #n ")" ::: "memory")
#define PG8_WAIT_L(n) asm volatile("s_waitcnt lgkmcnt(" #n ")" ::: "memory")
#define PG8_BAR __builtin_amdgcn_s_barrier()
#define PG8_SCHED __builtin_amdgcn_sched_barrier(0)
    Unit cur, nxt; int ui = 0;
    if (!S.next(0, cur)) return;
    f32x4 acc[2][2][4][2];
#pragma unroll
    for (int a = 0; a < 2; ++a)
#pragma unroll
        for (int b = 0; b < 2; ++b)
#pragma unroll
            for (int m = 0; m < 4; ++m)
#pragma unroll
                for (int n = 0; n < 2; ++n) acc[a][b][m][n] = (f32x4){0.f, 0.f, 0.f, 0.f};
    Frag<Epi::FP8> At[4], B0[2], B1[2];
    const int sclB = Epi::SCALE_B, sclA = 0x7f;
    const char* cA = (const char*)g.A + (size_t)cur.pm * tstep; const char* cB = (const char*)g.Bt + (size_t)cur.pn * tstep;
    S.a_ready(cur);
    if constexpr (SP2) {
        PG8_STAGE(PG8_SB(0, 0), cB, voffB); PG8_STAGE(PG8_SB(0, 1), cB + hstepB, voffB); PG8_STAGE(PG8_SA(0, 0), cA, voffA); PG8_STAGE(PG8_SA(0, 1), cA + hstep, voffA);
        if (wr == 1) PG8_BAR;
        PG8_WAIT_V(2); PG8_BAR;
        PG8_STAGE(PG8_SB(1, 0), cB + kstep, voffB); PG8_STAGE(PG8_SA(1, 0), cA + kstep, voffA); PG8_STAGE(PG8_SB(1, 1), cB + hstepB + kstep, voffB);
        PG8_WAIT_V(6); PG8_BAR;
    } else {
        PG8_STAGE(PG8_SB(0, 0), cB, voffB); PG8_STAGE(PG8_SA(0, 0), cA, voffA); PG8_STAGE(PG8_SB(0, 1), cB + hstepB, voffB); PG8_STAGE(PG8_SA(0, 1), cA + hstep, voffA);
        if (wr == 1) PG8_BAR;
        PG8_WAIT_V(4); PG8_BAR;
        PG8_STAGE(PG8_SB(1, 0), cB + kstep, voffB); PG8_STAGE(PG8_SA(1, 0), cA + kstep, voffA); PG8_STAGE(PG8_SB(1, 1), cB + hstepB + kstep, voffB);
        PG8_WAIT_V(6); PG8_BAR;
    }
    for (;;) {
        const bool has_next = S.next(ui + 1, nxt);
        const char* nA = has_next ? (const char*)g.A + (size_t)nxt.pm * tstep : cA; const char* nB = has_next ? (const char*)g.Bt + (size_t)nxt.pn * tstep : cB;
        for (int t = 0; t < nt; t += 2) {
            if constexpr (Epi::MIDK) { if (t == (nt >> 1)) E.mid(acc, cur, wr, wc, fr, fq); }
            const bool last = (t == nt - 2);
            const char* a1 = cA + (size_t)(t + 1) * kstep;
            const char* a2 = last ? nA : cA + (size_t)(t + 2) * kstep; const char* b2 = last ? nB : cB + (size_t)(t + 2) * kstep;
            const char* a3 = a2 + kstep; const char* b3 = b2 + kstep;
            if (last && has_next) S.a_ready(nxt);
            if constexpr (SP2) {
            PG8_LDB(B0, 0, 0); PG8_LDB(B1, 0, 1); PG8_SCHED; PG8_LDA(At, 0, 0); PG8_STAGE(PG8_SA(1, 1), a1 + hstep, voffA);
            PG8_WAIT_V(8); PG8_WAIT_L(0); PG8_BAR; PG8_MMA(0, 0, At, B0); PG8_MMA(0, 1, At, B1); PG8_BAR; PG8_SCHED;
            PG8_LDA(At, 0, 1); PG8_STAGE(PG8_SB(0, 0), b2, voffB); PG8_STAGE(PG8_SB(0, 1), b2 + hstepB, voffB); PG8_STAGE(PG8_SA(0, 0), a2, voffA);
            PG8_WAIT_V(8); PG8_WAIT_L(0); PG8_BAR; PG8_MMA(1, 0, At, B0); PG8_MMA(1, 1, At, B1); PG8_BAR; PG8_SCHED;
            PG8_LDB(B0, 1, 0); PG8_LDB(B1, 1, 1); PG8_SCHED; PG8_LDA(At, 1, 0); PG8_STAGE(PG8_SA(0, 1), a2 + hstep, voffA);
            PG8_WAIT_V(8); PG8_WAIT_L(0); PG8_BAR; PG8_MMA(0, 0, At, B0); PG8_MMA(0, 1, At, B1); PG8_BAR; PG8_SCHED;
            PG8_LDA(At, 1, 1); PG8_STAGE(PG8_SB(1, 0), b3, voffB); PG8_STAGE(PG8_SB(1, 1), b3 + hstepB, voffB); PG8_STAGE(PG8_SA(1, 0), a3, voffA);
            PG8_WAIT_V(8); PG8_WAIT_L(0); PG8_BAR; PG8_MMA(1, 0, At, B0); PG8_MMA(1, 1, At, B1); PG8_BAR; PG8_SCHED;
            } else {
            PG8_LDB(B0, 0, 0); PG8_SCHED; PG8_LDA(At, 0, 0); PG8_STAGE(PG8_SA(1, 1), a1 + hstep, voffA);
            PG8_WAIT_L(8); PG8_BAR; PG8_WAIT_L(0); PG8_MMA(0, 0, At, B0); PG8_BAR; PG8_SCHED;
            PG8_LDB(B1, 0, 1); PG8_STAGE(PG8_SB(0, 0), b2, voffB);
            PG8_BAR; PG8_WAIT_L(0); PG8_MMA(0, 1, At, B1); PG8_BAR;
            PG8_LDA(At, 0, 1); PG8_STAGE(PG8_SA(0, 0), a2, voffA);
            PG8_BAR; PG8_WAIT_L(0); PG8_MMA(1, 0, At, B0); PG8_BAR; PG8_SCHED;
            PG8_STAGE(PG8_SB(0, 1), b2 + hstepB, voffB);
            PG8_WAIT_V(6); PG8_BAR; PG8_MMA(1, 1, At, B1); PG8_BAR;
            PG8_LDB(B0, 1, 0); PG8_SCHED; PG8_LDA(At, 1, 0); PG8_STAGE(PG8_SA(0, 1), a2 + hstep, voffA);
            PG8_WAIT_L(8); PG8_BAR; PG8_WAIT_L(0); PG8_MMA(0, 0, At, B0); PG8_BAR; PG8_SCHED;
            PG8_LDB(B1, 1, 1); PG8_STAGE(PG8_SB(1, 0), b3, voffB);
            PG8_BAR; PG8_WAIT_L(0); PG8_MMA(0, 1, At, B1); PG8_BAR;
            PG8_LDA(At, 1, 1); PG8_STAGE(PG8_SA(1, 0), a3, voffA);
            PG8_BAR; PG8_WAIT_L(0); PG8_MMA(1, 0, At, B0); PG8_BAR; PG8_SCHED;
            PG8_STAGE(PG8_SB(1, 1), b3 + hstepB, voffB);
            PG8_WAIT_V(6); PG8_BAR; PG8_MMA(1, 1, At, B1); PG8_BAR;
            }
        }
        if constexpr (ALIGN_EPI) { if (wr == 0) PG8_BAR; }
        if constexpr (!Epi::AFTER_DRAIN) { E(acc, cur, wr, wc, fr, fq); S.done(cur); }
        if (!has_next) break;
#pragma unroll
        for (int a = 0; a < 2; ++a)
#pragma unroll
            for (int b = 0; b < 2; ++b)
#pragma unroll
                for (int m = 0; m < 4; ++m)
#pragma unroll
                    for (int n = 0; n < 2; ++n) acc[a][b][m][n] = (f32x4){0.f, 0.f, 0.f, 0.f};
        cur = nxt; cA = nA; cB = nB; ++ui;
        if constexpr (ALIGN_EPI) { if (wr == 1) PG8_BAR; }
    }
    PG8_WAIT_V(0);
    if constexpr (!ALIGN_EPI) { if (wr == 0) PG8_BAR; }
    PG8_BAR;
    if constexpr (Epi::AFTER_DRAIN) { E.fused(acc, cur, wr, wc, fr, fq, lds, wid, lane); S.done(cur); }
#undef PG8_SA
#undef PG8_SB
#undef PG8_STAGE
#undef PG8_LDA
#undef PG8_LDB
#undef PG8_MMA
#undef PG8_WAIT_V
#undef PG8_WAIT_L
#undef PG8_BAR
#undef PG8_SCHED
}
}

#define GAS __attribute__((address_space(1)))
#define LAS __attribute__((address_space(3)))
typedef unsigned short bf16;
typedef unsigned v4u __attribute__((ext_vector_type(4)));
typedef unsigned v2u __attribute__((ext_vector_type(2)));
typedef float f32x4 __attribute__((ext_vector_type(4)));
using pg8::bf_lo; using pg8::bf_hi; using pg8::sigm;

constexpr int NTOK = 32768, SEQ = 16384, DM = 1024, NW = 8;
constexpr float EPS = 1e-6f;
constexpr float C2 = 0.125f * 1.4426950408889634f;
constexpr size_t MiB = 1u << 20;
constexpr size_t WS_W1T = 1 * MiB, WS_WAT = 12 * MiB, WS_WMT = 13 * MiB, WS_WOT = 14 * MiB, WS_WQT = 16 * MiB, WS_WGT = 20 * MiB, WS_WPT = 22 * MiB;
constexpr size_t WS_K1B = 22 * MiB + 512 * 1024, WS_K2B = 22 * MiB + 768 * 1024, WS_IF = 23 * MiB, WS_UB = 24 * MiB, WS_VB = 56 * MiB;
constexpr size_t WS_XN = 88 * MiB, WS_YA = 88 * MiB, WS_YM = 120 * MiB, WS_HN = 88 * MiB;
constexpr size_t WS_QKVA = 152 * MiB, WS_QKM = 248 * MiB, WS_VM = 312 * MiB, WS_OM = 344 * MiB, WS_G = 376 * MiB;
constexpr size_t WS_DN = 504 * MiB, WS_NS = 505 * MiB, WS_SC = 506 * MiB;
constexpr size_t WS_MERGED = 152 * MiB, WS_TMP = 216 * MiB, WS_Q2 = 376 * MiB, WS_IDX = 152 * MiB, WS_GATE = 168 * MiB, WS_HN2 = 184 * MiB, WS_PB = 56 * MiB, WS_E = 264 * MiB;
constexpr size_t WS_NEED = 507 * MiB;
constexpr size_t WS_U8 = 24 * MiB, WS_V8 = 40 * MiB, WS_PART = 376 * MiB, WS_SSQ = 506 * MiB + 512 * 1024;
constexpr size_t WS_HQH = 280 * MiB, WS_HQL = 296 * MiB, WS_HS = 312 * MiB;
constexpr size_t WS_W1G8 = 74 * MiB;
constexpr size_t WS_X2B8 = 184 * MiB, WS_WG8 = 72 * MiB;
constexpr size_t WS_X3B = 376 * MiB;
constexpr size_t WS_U4 = 24 * MiB, WS_V4 = 32 * MiB, WS_SU = 40 * MiB, WS_SV = 40 * MiB + 65536;
constexpr size_t WS_SSQ1 = 506 * MiB + 768 * 1024, WS_BAR = 0, BAR_BYTES = 32768;
constexpr size_t OUT_DC = 0, OUT_CS = 64 * MiB;
constexpr int LDS_BYTES = 151552;

__device__ __forceinline__ unsigned f2bf(float f) { unsigned u = __float_as_uint(f); return (u + 0x7fffu + ((u >> 16) & 1u)) >> 16; }
__device__ __forceinline__ unsigned pk2(float lo, float hi) { return f2bf(lo) | (f2bf(hi) << 16); }
__device__ __forceinline__ float bf2f(bf16 b) { return __uint_as_float((unsigned)b << 16); }
__device__ __forceinline__ float wave_sum(float v) {
#pragma unroll
    for (int o = 1; o < 64; o <<= 1) v += __shfl_xor(v, o);
    return v;
}
__device__ __forceinline__ float wave_max(float v) {
#pragma unroll
    for (int o = 1; o < 64; o <<= 1) v = fmaxf(v, __shfl_xor(v, o));
    return v;
}
__device__ __forceinline__ void unpk8(const v4u w, float* f) { f[0] = bf_lo(w.x); f[1] = bf_hi(w.x); f[2] = bf_lo(w.y); f[3] = bf_hi(w.y); f[4] = bf_lo(w.z); f[5] = bf_hi(w.z); f[6] = bf_lo(w.w); f[7] = bf_hi(w.w); }
__device__ __forceinline__ v4u pk8(const float* f) { v4u w; w.x = pk2(f[0], f[1]); w.y = pk2(f[2], f[3]); w.z = pk2(f[4], f[5]); w.w = pk2(f[6], f[7]); return w; }
typedef __bf16 bf16x2_t __attribute__((ext_vector_type(2)));
__device__ __forceinline__ float dot2bf(unsigned a, unsigned b, float c) { return __builtin_amdgcn_fdot2_f32_bf16(__builtin_bit_cast(bf16x2_t, a), __builtin_bit_cast(bf16x2_t, b), c, false); }
__device__ __forceinline__ float logsigmoid(float x) { return fminf(x, 0.f) - log1pf(__expf(-fabsf(x))); }
__device__ __forceinline__ float silu(float x) { return x * __builtin_amdgcn_rcpf(1.0f + __builtin_amdgcn_exp2f(-1.4426950408889634f * x)); }

#define XB_TMO      128
#define XB_XCNT(j)  (256  + 64 * (j))
#define XB_XSUB(j)  (1280 + 64 * (j))
#define XB_XGEN(j)  (2304 + 64 * (j))
#define XB_TOP      3328
#define XB_TOPGEN   3392
#define XCD_BAR_WORDS 3456
#define XB_SPIN_CAP (1u << 18)

__device__ __forceinline__ unsigned xb_ld(unsigned* p)              { return __hip_atomic_load(p, __ATOMIC_RELAXED, __HIP_MEMORY_SCOPE_AGENT); }
__device__ __forceinline__ unsigned xb_add(unsigned* p, unsigned v) { return __hip_atomic_fetch_add(p, v, __ATOMIC_RELAXED, __HIP_MEMORY_SCOPE_AGENT); }
__device__ __forceinline__ unsigned xb_xcc_id() { return (unsigned)__builtin_amdgcn_s_getreg((3 << 11) | 20) & 0xFu; }
#define XB_SPIN(cond, bar) do { unsigned _sp = 0; while (cond) { __builtin_amdgcn_s_sleep(1); \
    if ((++_sp & 255u) == 0u) { if (xb_ld(&(bar)[XB_TMO])) break; if (_sp > XB_SPIN_CAP) { atomicAdd(&(bar)[XB_TMO], 1u); break; } } } } while (0)

struct XcdBarrier {
    unsigned* bar; unsigned x;
    volatile LAS unsigned* st;
};

__device__ __forceinline__ XcdBarrier xcd_barrier_post(unsigned* bar, volatile LAS unsigned* st) {
    XcdBarrier b; b.bar = bar; b.x = xb_xcc_id(); b.st = st;
    if (threadIdx.x == 0) (void)xb_add(&bar[XB_XCNT(b.x)], 1u);
    return b;
}
__device__ __forceinline__ void xcd_barrier_complete(unsigned* bar, unsigned x, unsigned& nloc, unsigned& nx) {
    const unsigned G = gridDim.x * gridDim.y * gridDim.z;
    unsigned sum, cnt, mine, sp = 0u;
    for (;;) {
        sum = 0u; cnt = 0u; mine = 0u;
#pragma unroll
        for (unsigned j = 0; j < 16; ++j) { const unsigned c = xb_ld(&bar[XB_XCNT(j)]); sum += c; cnt += (c > 0u) ? 1u : 0u; mine = (j == x) ? c : mine; }
        if (sum == G) break;
        __builtin_amdgcn_s_sleep(1);
        if ((++sp & 255u) == 0u) { if (xb_ld(&bar[XB_TMO])) break; if (sp > XB_SPIN_CAP) { atomicAdd(&bar[XB_TMO], 1u); break; } }
    }
    nloc = mine > 0u ? mine : 1u; nx = cnt > 0u ? cnt : 1u;
}

__device__ __forceinline__ void xcd_barrier(const XcdBarrier& b) {
    asm volatile("s_waitcnt vmcnt(0)" ::: "memory");
    __syncthreads();
    if (threadIdx.x == 0) {
        unsigned* bar = b.bar;
        __builtin_amdgcn_s_waitcnt(0);
        unsigned nloc = b.st[0], nx = b.st[1];
        if (nloc == 0u) { xcd_barrier_complete(bar, b.x, nloc, nx); b.st[0] = nloc; b.st[1] = nx; }
        const unsigned old = xb_add(&bar[XB_XSUB(b.x)], 1u);
        const unsigned gen = old / nloc;
        if (old + 1u == (gen + 1u) * nloc) {
            __builtin_amdgcn_fence(__ATOMIC_RELEASE, "agent");
            asm volatile("s_waitcnt vmcnt(0)" ::: "memory");
            const unsigned og = xb_add(&bar[XB_TOP], 1u);
            const unsigned tg = og / nx;
            if (og + 1u == (tg + 1u) * nx) xb_add(&bar[XB_TOPGEN], 1u);
            else XB_SPIN(xb_ld(&bar[XB_TOPGEN]) == tg, bar);
            __builtin_amdgcn_fence(__ATOMIC_ACQUIRE, "agent");
            xb_add(&bar[XB_XGEN(b.x)], 1u);
            asm volatile("s_waitcnt vmcnt(0)" ::: "memory");
        } else {
            XB_SPIN(xb_ld(&bar[XB_XGEN(b.x)]) == gen, bar);
            __builtin_amdgcn_fence(__ATOMIC_ACQUIRE, "agent");
            asm volatile("s_waitcnt vmcnt(0)" ::: "memory");
        }
    }
    __syncthreads();
}


struct Params { const float* in[20]; float* out; unsigned char* ws; int ph_lo, ph_hi; };

__device__ __forceinline__ void transpose_item(const float* W, int ldw, int col0, int K, bf16* WT, int row0, LAS float* scr, int item, int nblk, int lane, int koff = 0, const float* kgain = nullptr, unsigned char* WT8 = nullptr, float sc8 = 1.0f) {
    const int kb = item / nblk, nb = item % nblk, k0 = 64 * kb, n0 = 32 * nb;
#pragma unroll 8
    for (int i = 0; i < 32; ++i) { const int kk = 2 * i + (lane >> 5); const float gk = kgain ? kgain[k0 + kk] : 1.0f; scr[kk * 33 + (lane & 31)] = W[(size_t)(k0 + kk) * ldw + col0 + n0 + (lane & 31)] * gk; }
    asm volatile("s_waitcnt lgkmcnt(0)" ::: "memory");
    const int c = lane & 7;
#pragma unroll
    for (int j = 0; j < 4; ++j) { const int n = (lane >> 3) + 8 * j; const LAS float* s = scr + (8 * c) * 33 + n;
        v4u o; o.x = pk2(s[0 * 33], s[1 * 33]); o.y = pk2(s[2 * 33], s[3 * 33]); o.z = pk2(s[4 * 33], s[5 * 33]); o.w = pk2(s[6 * 33], s[7 * 33]);
        *(v4u*)(WT + (size_t)(row0 + n0 + n) * K + koff + k0 + 8 * c) = o;
        if (WT8) { int p0 = __builtin_amdgcn_cvt_pk_fp8_f32(s[0 * 33] * sc8, s[1 * 33] * sc8, 0, false); p0 = __builtin_amdgcn_cvt_pk_fp8_f32(s[2 * 33] * sc8, s[3 * 33] * sc8, p0, true);
            int p1 = __builtin_amdgcn_cvt_pk_fp8_f32(s[4 * 33] * sc8, s[5 * 33] * sc8, 0, false); p1 = __builtin_amdgcn_cvt_pk_fp8_f32(s[6 * 33] * sc8, s[7 * 33] * sc8, p1, true);
            *(uint2*)(WT8 + (size_t)(row0 + n0 + n) * K + koff + k0 + 8 * c) = make_uint2((unsigned)p0, (unsigned)p1); } }
    asm volatile("s_waitcnt lgkmcnt(0)" ::: "memory");
}
__device__ __forceinline__ void cvt_f32_bf16(const float* src, bf16* dst, size_t n4, size_t gtid, size_t gsz) {
    for (size_t i = gtid; i < n4; i += gsz) { const f32x4 v = ((const f32x4*)src)[i]; uint2 o; o.x = pk2(v[0], v[1]); o.y = pk2(v[2], v[3]); ((uint2*)dst)[i] = o; }
}
__device__ __forceinline__ void cvt_f32_fp8(const float* src, unsigned* dst, size_t n4, float sc, size_t gtid, size_t gsz) {
    for (size_t i = gtid; i < n4; i += gsz) { const f32x4 v = ((const f32x4*)src)[i]; int w = __builtin_amdgcn_cvt_pk_fp8_f32(v[0] * sc, v[1] * sc, 0, false); w = __builtin_amdgcn_cvt_pk_fp8_f32(v[2] * sc, v[3] * sc, w, true); dst[i] = (unsigned)w; }
}
__device__ __forceinline__ void rms_row_to_bf16(const float* xrow, const float* gain, bf16* orow, int lane) {
    f32x4 v[4]; float s = 0.f;
#pragma unroll
    for (int j = 0; j < 4; ++j) { v[j] = ((const f32x4*)xrow)[lane + 64 * j]; s += (v[j][0] * v[j][0] + v[j][1] * v[j][1]) + (v[j][2] * v[j][2] + v[j][3] * v[j][3]); }
    const float rstd = rsqrtf(wave_sum(s) * (1.f / 1024.f) + EPS);
#pragma unroll
    for (int j = 0; j < 4; ++j) { const f32x4 g = ((const f32x4*)gain)[lane + 64 * j]; uint2 o; o.x = pk2(v[j][0] * rstd * g[0], v[j][1] * rstd * g[1]); o.y = pk2(v[j][2] * rstd * g[2], v[j][3] * rstd * g[3]); ((uint2*)orow)[lane + 64 * j] = o; }
}
__device__ __forceinline__ void p0_prologue(const Params& P, LAS unsigned char* lds, int tid, int lane, int wave) {
    unsigned char* ws = P.ws;
    const int gw = blockIdx.x * NW + wave, NGW = gridDim.x * NW;
    LAS float* scr = (LAS float*)(lds + wave * 8448);
    LAS float* wif = (LAS float*)(lds + 69632);
    const float* w_in = P.in[3];
    for (int i = tid; i < 8192; i += 512) wif[i] = w_in[(size_t)(i >> 3) * 5640 + 3584 + (i & 7)];
    __syncthreads();
    constexpr int I1A = 16 * 112, I1B = 16 * 64, IUP = 8 * 32, IOUT = 16 * 32, IQ = 16 * 64, IPL = 4 * 32;
    constexpr int NITEMS = I1A + I1B + 2 * IUP + IOUT + IQ + IOUT + IPL;
    for (int it = gw; it < NITEMS; it += NGW) {
        int r = it;
        if (r < I1A) { transpose_item(w_in, 5640, 0, 1024, (bf16*)(ws + WS_W1T), 0, scr, r, 112, lane); continue; } r -= I1A;
        if (r < I1B) { transpose_item(w_in, 5640, 3592, 1024, (bf16*)(ws + WS_W1T), 3584, scr, r, 64, lane, 0, nullptr, ws + WS_W1G8 - (size_t)3584 * 1024, 16.0f); continue; } r -= I1B;
        if (r < IUP) { transpose_item(P.in[7], 1024, 0, 1024, (bf16*)(ws + WS_WAT), 0, scr, r, 32, lane, 0); continue; } r -= IUP;
        if (r < IUP) { transpose_item(P.in[8], 1024, 0, 1024, (bf16*)(ws + WS_WAT), 0, scr, r, 32, lane, 512); continue; } r -= IUP;
        if (r < IOUT) { transpose_item(P.in[9], 1024, 0, 1024, (bf16*)(ws + WS_WOT), 0, scr, r, 32, lane); continue; } r -= IOUT;
        if (r < IQ) { transpose_item(P.in[11], 2048, 0, 1024, (bf16*)(ws + WS_WQT), 0, scr, r, 64, lane, 0, P.in[10]); continue; } r -= IQ;
        if (r < IOUT) { transpose_item(P.in[17], 1024, 0, 1024, (bf16*)(ws + WS_WGT), 0, scr, r, 32, lane, 0, P.in[16], ws + WS_WG8, 16.0f); continue; } r -= IOUT;
        transpose_item(P.in[18], 1024, 0, 256, (bf16*)(ws + WS_WPT), 0, scr, r, 32, lane);
    }
    const size_t gtid = (size_t)blockIdx.x * 512 + tid, gsz = (size_t)gridDim.x * 512;
    cvt_f32_bf16(P.in[12], (bf16*)(ws + WS_K1B), 8 * 128 * 128 / 4, gtid, gsz);
    cvt_f32_bf16(P.in[13], (bf16*)(ws + WS_K2B), 8 * 128 * 128 / 4, gtid, gsz);
    f32x4 egn[4]; { const float* gf = P.in[10]; egn[0] = ((const f32x4*)gf)[2 * lane]; egn[1] = ((const f32x4*)gf)[2 * lane + 1]; egn[2] = ((const f32x4*)gf)[128 + 2 * lane]; egn[3] = ((const f32x4*)gf)[128 + 2 * lane + 1]; }
    f32x4 vnx[4];
    if (gw < 2 * 16384) { const float* src = P.in[14 + (gw >> 14)] + (size_t)(gw & 16383) * 1024; vnx[0] = ((const f32x4*)src)[2 * lane]; vnx[1] = ((const f32x4*)src)[2 * lane + 1]; vnx[2] = ((const f32x4*)src)[128 + 2 * lane]; vnx[3] = ((const f32x4*)src)[128 + 2 * lane + 1]; }
    for (int rw = gw; rw < 2 * 16384; rw += NGW) {
        const int tb_ = rw >> 14, e = rw & 16383;
        f32x4 v[4]; v[0] = vnx[0]; v[1] = vnx[1]; v[2] = vnx[2]; v[3] = vnx[3];
        if (rw + NGW < 2 * 16384) { const int rn = rw + NGW; const float* src = P.in[14 + (rn >> 14)] + (size_t)(rn & 16383) * 1024; vnx[0] = ((const f32x4*)src)[2 * lane]; vnx[1] = ((const f32x4*)src)[2 * lane + 1]; vnx[2] = ((const f32x4*)src)[128 + 2 * lane]; vnx[3] = ((const f32x4*)src)[128 + 2 * lane + 1]; }
        if (!tb_) { v[0] = v[0] * egn[0]; v[1] = v[1] * egn[1]; v[2] = v[2] * egn[2]; v[3] = v[3] * egn[3]; }
        float mx = 0.f, sq = 0.f;
#pragma unroll
        for (int j = 0; j < 4; ++j)
#pragma unroll
            for (int i = 0; i < 4; ++i) { mx = fmaxf(mx, fabsf(v[j][i])); sq += v[j][i] * v[j][i]; }
        mx = wave_max(mx);
        unsigned w0 = 0u, w1 = 0u; float sc;
        if (tb_) {
            sc = mx > 0.f ? mx * (1.0f / 6.0f) : 1.0f; const float inv = 1.0f / sc;
            w0 = __builtin_amdgcn_cvt_scalef32_pk_fp4_f32(w0, v[0][0] * inv, v[0][1] * inv, 1.0f, 0); w0 = __builtin_amdgcn_cvt_scalef32_pk_fp4_f32(w0, v[0][2] * inv, v[0][3] * inv, 1.0f, 1);
            w0 = __builtin_amdgcn_cvt_scalef32_pk_fp4_f32(w0, v[1][0] * inv, v[1][1] * inv, 1.0f, 2); w0 = __builtin_amdgcn_cvt_scalef32_pk_fp4_f32(w0, v[1][2] * inv, v[1][3] * inv, 1.0f, 3);
            w1 = __builtin_amdgcn_cvt_scalef32_pk_fp4_f32(w1, v[2][0] * inv, v[2][1] * inv, 1.0f, 0); w1 = __builtin_amdgcn_cvt_scalef32_pk_fp4_f32(w1, v[2][2] * inv, v[2][3] * inv, 1.0f, 1);
            w1 = __builtin_amdgcn_cvt_scalef32_pk_fp4_f32(w1, v[3][0] * inv, v[3][1] * inv, 1.0f, 2); w1 = __builtin_amdgcn_cvt_scalef32_pk_fp4_f32(w1, v[3][2] * inv, v[3][3] * inv, 1.0f, 3);
        } else {
            const float rms = sqrtf(wave_sum(sq) * (1.0f / 1024.0f)); const float clip = fminf(mx, 2.8f * rms);
            sc = clip > 0.f ? clip * (1.0f / 7.0f) : 1.0f; const float inv = 1.0f / sc;
#pragma unroll
            for (int i = 0; i < 4; ++i) { const int q0 = (int)fminf(fmaxf(rintf(v[0][i] * inv), -7.f), 7.f), q1 = (int)fminf(fmaxf(rintf(v[1][i] * inv), -7.f), 7.f), q2 = (int)fminf(fmaxf(rintf(v[2][i] * inv), -7.f), 7.f), q3 = (int)fminf(fmaxf(rintf(v[3][i] * inv), -7.f), 7.f);
                w0 |= ((unsigned)q0 & 15u) << (4 * i); w0 |= ((unsigned)q1 & 15u) << (16 + 4 * i); w1 |= ((unsigned)q2 & 15u) << (4 * i); w1 |= ((unsigned)q3 & 15u) << (16 + 4 * i); }
        }
        unsigned* dst = (unsigned*)(ws + (tb_ ? WS_V4 : WS_U4)) + (size_t)e * 128;
        dst[lane] = w0; dst[64 + lane] = w1;
        if (lane == 0) ((float*)(ws + (tb_ ? WS_SV : WS_SU)))[e] = sc;
    }
    cvt_f32_bf16(P.in[1], (bf16*)(ws + WS_PB), (size_t)NTOK * 256 / 4, gtid, gsz);
    for (size_t i = gtid; i < (size_t)NTOK; i += gsz) { ((float*)(ws + WS_SSQ))[i] = 0.f; ((float*)(ws + WS_SSQ1))[i] = 0.f; }
    const float* x = P.in[0]; const float* gmix = P.in[2]; const float* gbias = P.in[5];
    bf16* XN = (bf16*)(ws + WS_XN); float* IFb = (float*)(ws + WS_IF);
    f32x4 xgn[4], xnx[4];
#pragma unroll
    for (int j = 0; j < 4; ++j) { xgn[j] = ((const f32x4*)gmix)[lane + 64 * j]; if (gw < NTOK) xnx[j] = ((const f32x4*)(x + (size_t)gw * 1024))[lane + 64 * j]; }
    for (int m = gw; m < NTOK; m += NGW) {
        f32x4 v[4];
#pragma unroll
        for (int j = 0; j < 4; ++j) v[j] = xnx[j];
        if (m + NGW < NTOK) {
#pragma unroll
            for (int j = 0; j < 4; ++j) xnx[j] = ((const f32x4*)(x + (size_t)(m + NGW) * 1024))[lane + 64 * j];
        }
        float a16[16];
#pragma unroll
        for (int i = 0; i < 16; ++i) a16[i] = 0.f;
#pragma unroll
        for (int j = 0; j < 4; ++j) {
            const f32x4 g = xgn[j];
#pragma unroll
            for (int i = 0; i < 4; ++i) { a16[0] += v[j][i] * v[j][i]; v[j][i] *= g[i]; const int d = 4 * (lane + 64 * j) + i; const f32x4 wa = *(const LAS f32x4*)(wif + d * 8), wb = *(const LAS f32x4*)(wif + d * 8 + 4);
                a16[1] += v[j][i] * wa[0]; a16[2] += v[j][i] * wa[1]; a16[3] += v[j][i] * wa[2]; a16[4] += v[j][i] * wa[3]; a16[5] += v[j][i] * wb[0]; a16[6] += v[j][i] * wb[1]; a16[7] += v[j][i] * wb[2]; a16[8] += v[j][i] * wb[3]; }
        }
        float r8[8], r4[4], r2[2], r1;
        { const bool b = lane & 32;
#pragma unroll
          for (int i = 0; i < 8; ++i) { const float keep = b ? a16[8 + i] : a16[i], send = b ? a16[i] : a16[8 + i]; r8[i] = keep + __shfl_xor(send, 32); } }
        { const bool b = lane & 16;
#pragma unroll
          for (int i = 0; i < 4; ++i) { const float keep = b ? r8[4 + i] : r8[i], send = b ? r8[i] : r8[4 + i]; r4[i] = keep + __shfl_xor(send, 16); } }
        { const bool b = lane & 8;
#pragma unroll
          for (int i = 0; i < 2; ++i) { const float keep = b ? r4[2 + i] : r4[i], send = b ? r4[i] : r4[2 + i]; r2[i] = keep + __shfl_xor(send, 8); } }
        { const bool b = lane & 4; const float keep = b ? r2[1] : r2[0], send = b ? r2[0] : r2[1]; r1 = keep + __shfl_xor(send, 4); }
        r1 += __shfl_xor(r1, 2); r1 += __shfl_xor(r1, 1);
        const float rstd = rsqrtf(__shfl(r1, 0) * (1.f / 1024.f) + EPS);
#pragma unroll
        for (int j = 0; j < 4; ++j) { uint2 o; o.x = pk2(v[j][0] * rstd, v[j][1] * rstd); o.y = pk2(v[j][2] * rstd, v[j][3] * rstd); ((uint2*)(XN + (size_t)m * 1024))[lane + 64 * j] = o;
            int p8 = __builtin_amdgcn_cvt_pk_fp8_f32(v[j][0] * rstd, v[j][1] * rstd, 0, false); p8 = __builtin_amdgcn_cvt_pk_fp8_f32(v[j][2] * rstd, v[j][3] * rstd, p8, true); ((int*)((unsigned char*)P.out + (size_t)m * 1024))[lane + 64 * j] = p8; }
        const int which = ((lane >> 5) & 1) * 8 + ((lane >> 4) & 1) * 4 + ((lane >> 3) & 1) * 2 + ((lane >> 2) & 1);
        if ((lane & 3) == 0 && which >= 1 && which <= 8) IFb[(size_t)m * 8 + which - 1] = r1 * rstd + gbias[which - 1];
    }
}

typedef short bf16x8 __attribute__((ext_vector_type(8)));
typedef short v4i16 __attribute__((ext_vector_type(4)));
#define MFMA16(a, b, c) __builtin_amdgcn_mfma_f32_16x16x32_bf16((a), (b), (c), 0, 0, 0)
__device__ __forceinline__ void attn_pair_params(int pp, int& d, int& n0, int& sh) {
    if (pp < 5) { d = 16; sh = 4; n0 = -144 + 32 * pp; } else if (pp < 11) { d = 4; sh = 2; n0 = -128 + 32 * (pp - 5); } else { d = 1; sh = 0; n0 = -128 + 32 * (pp - 11); }
}
template <int MODE> __device__ __forceinline__ void attn_unit_params(int pp, int& d, int& n0, int& sh) {
    if (MODE == 0) { d = 1; sh = 0; n0 = -144 + 32 * pp; }
    else if (pp < 5) { d = 16; sh = 4; n0 = -144 + 32 * pp; } else { d = 4; sh = 2; n0 = -128 + 32 * (pp - 5); }
}
#define ATT_LOAD(SET, PPX) do { if ((PPX) < NP) { int d_, n_, sh_; attn_unit_params<MODE>((PPX), d_, n_, sh_); \
    _Pragma("unroll") for (int c = 0; c < 4; ++c) { int tok = t0 + d_ * (n_ + 8 * c + lrow); tok = min(max(tok, 0), SEQ - 1); const bf16* rp = base + 512 + (size_t)tok * 1536 + 8 * lch; \
        kr[SET][c] = *(const v4u*)rp; vr[SET][c] = *(const v4u*)(rp + 512); } } } while (0)
template <int MODE> __device__ __forceinline__ void attn_unit(const bf16* base, bf16* yrow0, int t0, int xidx, LAS float* partl, LAS unsigned char* kbuf, LAS unsigned char* vbuf, int lane) {
    constexpr int NP = MODE == 0 ? 5 : 11, NPAD = MODE == 0 ? 8 : 12;
    const int r = lane & 15, g = lane >> 4, lrow = lane >> 3, lch = lane & 7;
    const int trq = (lane >> 2) & 3, trp = lane & 3, tr_off = (4 * g + trq) * 160 + trp * 8;
    const int tq = MODE == 0 ? t0 + r : t0 + 16 * r;
    const bf16x8 qb0 = *(const bf16x8*)(base + (size_t)tq * 1536 + 8 * g), qb1 = *(const bf16x8*)(base + (size_t)tq * 1536 + 32 + 8 * g);
    f32x4 o[4]; float m, l;
    LAS float* xrow = partl + (MODE == 0 ? xidx + r : xidx + 16 * r) * 68;
    if (MODE == 0) {
#pragma unroll
        for (int i = 0; i < 4; ++i) o[i] = (f32x4){0.f, 0.f, 0.f, 0.f};
        m = -1e30f; l = 0.f;
    } else {
#pragma unroll
        for (int i = 0; i < 4; ++i) o[i] = *(const LAS f32x4*)(xrow + 16 * i + 4 * g);
        m = xrow[64]; l = g == 0 ? xrow[65] : 0.f;
    }
    v4u kr[4][4], vr[4][4];
    ATT_LOAD(0, 0); ATT_LOAD(1, 1); ATT_LOAD(2, 2); ATT_LOAD(3, 3);
#pragma unroll 1
    for (int pp0 = 0; pp0 < NPAD; pp0 += 4) {
#pragma unroll
        for (int u = 0; u < 4; ++u) {
            const int pp = pp0 + u;
            if (pp < NP) {
                int d, n0, sh; attn_unit_params<MODE>(pp, d, n0, sh);
                const int hi = MODE == 0 ? r : (r << (4 - sh)), lo = max(hi - 128, -(t0 >> sh));
                const int mbase = n0 + 4 * g - lo; const unsigned mspan = (unsigned)(hi - lo);
#pragma unroll
                for (int c = 0; c < 4; ++c) { *(LAS v4u*)(kbuf + (8 * c + lrow) * 144 + lch * 16) = kr[u][c]; *(LAS v4u*)(vbuf + (8 * c + lrow) * 160 + lch * 16) = vr[u][c]; }
                ATT_LOAD(u, pp + 4);
                f32x4 s0 = {0.f, 0.f, 0.f, 0.f}, s1 = {0.f, 0.f, 0.f, 0.f};
                { const bf16x8 k00 = *(const LAS bf16x8*)(kbuf + r * 144 + g * 16), k01 = *(const LAS bf16x8*)(kbuf + r * 144 + 64 + g * 16);
                  const bf16x8 k10 = *(const LAS bf16x8*)(kbuf + (16 + r) * 144 + g * 16), k11 = *(const LAS bf16x8*)(kbuf + (16 + r) * 144 + 64 + g * 16);
                  s0 = MFMA16(k00, qb0, s0); s0 = MFMA16(k01, qb1, s0); s1 = MFMA16(k10, qb0, s1); s1 = MFMA16(k11, qb1, s1); }
                float mx = -INFINITY;
#pragma unroll
                for (int k = 0; k < 4; ++k) { s0[k] = ((unsigned)(mbase + k) <= mspan) ? s0[k] : -INFINITY; s1[k] = ((unsigned)(mbase + 16 + k) <= mspan) ? s1[k] : -INFINITY; mx = fmaxf(mx, fmaxf(s0[k], s1[k])); }
                mx = fmaxf(mx, __shfl_xor(mx, 16)); mx = fmaxf(mx, __shfl_xor(mx, 32));
                if (__any(mx > m)) {
                    const float mn = fmaxf(m, mx), alpha = __builtin_amdgcn_exp2f(m - mn); m = mn; l *= alpha;
#pragma unroll
                    for (int i = 0; i < 4; ++i) o[i] = o[i] * alpha;
                }
                float p0[4], p1[4], ps = 0.f;
#pragma unroll
                for (int k = 0; k < 4; ++k) { p0[k] = __builtin_amdgcn_exp2f(s0[k] - m); p1[k] = __builtin_amdgcn_exp2f(s1[k] - m); ps += p0[k] + p1[k]; }
                l += ps;
                bf16x8 pb; { v4u w; w.x = pg8::cvt_pk_bf16(p0[0], p0[1]); w.y = pg8::cvt_pk_bf16(p0[2], p0[3]); w.z = pg8::cvt_pk_bf16(p1[0], p1[1]); w.w = pg8::cvt_pk_bf16(p1[2], p1[3]); pb = __builtin_bit_cast(bf16x8, w); }
                LAS unsigned char* vrd = vbuf + tr_off;
#pragma unroll
                for (int db = 0; db < 4; ++db) {
                    const v4i16 a0 = __builtin_amdgcn_ds_read_tr16_b64_v4i16((LAS v4i16*)(vrd + db * 32)), a1 = __builtin_amdgcn_ds_read_tr16_b64_v4i16((LAS v4i16*)(vrd + 16 * 160 + db * 32));
                    const bf16x8 va = __builtin_shufflevector(a0, a1, 0, 1, 2, 3, 4, 5, 6, 7);
                    o[db] = MFMA16(va, pb, o[db]);
                }
            }
        }
    }
    l += __shfl_xor(l, 16); l += __shfl_xor(l, 32);
    if (MODE == 0) {
#pragma unroll
        for (int i = 0; i < 4; ++i) *(LAS f32x4*)(xrow + 16 * i + 4 * g) = o[i];
        if (g == 0) { xrow[64] = m; xrow[65] = l; }
    } else {
        const float inv = __builtin_amdgcn_rcpf(l);
        bf16* yo = yrow0 + (size_t)tq * 1024 + 4 * g;
#pragma unroll
        for (int db = 0; db < 4; ++db) { uint2 w; w.x = pk2(o[db][0] * inv, o[db][1] * inv); w.y = pk2(o[db][2] * inv, o[db][3] * inv); *(uint2*)(yo + 16 * db) = w; }
    }
}
__device__ __forceinline__ void p2_attention(const Params& P, LAS unsigned char* lds, int lane, int wave, int vb) {
    const bf16* QKVA = (const bf16*)(P.ws + WS_QKVA); bf16* YA = (bf16*)(P.ws + WS_YA);
    LAS unsigned char* kbuf = lds + wave * 9728;
    LAS unsigned char* vbuf = kbuf + 4608;
    LAS float* partl = (LAS float*)(lds + 8 * 9728);
    for (int wi = vb; wi < 1024; wi += gridDim.x) {
        const int bh = wi >> 6, tb = wi & 63, b = bh >> 3, h = bh & 7;
        const bf16* base = QKVA + (size_t)b * SEQ * 1536 + h * 64;
        bf16* yrow0 = YA + (size_t)b * SEQ * 1024 + h * 64;
#pragma unroll 1
        for (int uu = 0; uu < 2; ++uu) { const int cu = wave * 2 + uu; attn_unit<0>(base, yrow0, tb * 256 + 16 * cu, 16 * cu, partl, kbuf, vbuf, lane); }
        __syncthreads();
#pragma unroll 1
        for (int uu = 0; uu < 2; ++uu) { const int rr = wave * 2 + uu; attn_unit<1>(base, yrow0, tb * 256 + rr, rr, partl, kbuf, vbuf, lane); }
        __syncthreads();
    }
}

__device__ __forceinline__ float conv_silu(const bf16* QKM, const float* cw, int b, int t, int ch) {
    float a = 0.f;
#pragma unroll
    for (int j = 0; j < 4; ++j) { const int tt = t - 3 + j; if (tt >= 0) a += cw[j * 1024 + ch] * bf2f(QKM[((size_t)b * SEQ + tt) * 1024 + ch]); }
    return silu(a);
}

__device__ __forceinline__ float scan_add(float v, int lane) {
#pragma unroll
    for (int o = 1; o < 64; o <<= 1) { const float u = __shfl_up(v, o); if (lane >= o) v += u; }
    return v;
}
__device__ __forceinline__ float scan_max(float v, int lane) {
#pragma unroll
    for (int o = 1; o < 64; o <<= 1) { const float u = __shfl_up(v, o); if (lane >= o) v = fmaxf(v, u); }
    return v;
}
__device__ __forceinline__ void conv16(const bf16* QKM, const float* cw, int b, int t0, int chan, float* out) {
    const bf16* src = QKM + (size_t)b * SEQ * 1024 + chan;
    const float w0 = cw[chan], w1 = cw[1024 + chan], w2 = cw[2048 + chan], w3 = cw[3072 + chan];
    float x0 = t0 >= 3 ? bf2f(src[(size_t)(t0 - 3) * 1024]) : 0.f, x1 = t0 >= 2 ? bf2f(src[(size_t)(t0 - 2) * 1024]) : 0.f, x2 = t0 >= 1 ? bf2f(src[(size_t)(t0 - 1) * 1024]) : 0.f;
#pragma unroll
    for (int i = 0; i < 16; ++i) { const float x3 = bf2f(src[(size_t)(t0 + i) * 1024]); out[i] = silu(w0 * x0 + w1 * x1 + w2 * x2 + w3 * x3); x0 = x1; x1 = x2; x2 = x3; }
}

__device__ __forceinline__ void p2_mlstm_local(const Params& P, LAS unsigned char* lds, int tid, int lane, int wave, int vb) {
    const bf16* QKM = (const bf16*)(P.ws + WS_QKM); const bf16* VM = (const bf16*)(P.ws + WS_VM); const float* IFb = (const float*)(P.ws + WS_IF);
    const float* cw = P.in[4];
    bf16* DC = (bf16*)((unsigned char*)P.out + OUT_DC); float* DN = (float*)(P.ws + WS_DN); float* SC = (float*)(P.ws + WS_SC);
    LAS bf16* KWT = (LAS bf16*)lds; LAS bf16* VT = (LAS bf16*)(lds + 18432); LAS float* sw = (LAS float*)(lds + 36864);
    const int r = lane & 15, g = lane >> 4;
    for (int item = vb; item < 2048; item += gridDim.x) {
        const int bh = item >> 8, c = item & 255, b = bh >> 2, h = bh & 3;
        if (wave == 0) {
            const size_t row = (size_t)b * SEQ + c * 64 + lane;
            const float lf = logsigmoid(IFb[row * 8 + 4 + h]), ip = IFb[row * 8 + h];
            const float bc = scan_add(lf, lane), gg = __shfl(bc, 63), ds = gg - bc + ip, ml = wave_max(ds);
            sw[lane] = __expf(ds - ml);
            if (lane == 0) { SC[item] = ml; SC[2048 + item] = gg; }
        }
        __syncthreads();
        { const int ch = tid & 127, sq = tid >> 7, s0 = sq * 16; float o[16];
          conv16(QKM, cw, b, c * 64 + s0, 512 + h * 128 + ch, o);
#pragma unroll
          for (int i = 0; i < 16; i += 2) *(LAS unsigned*)(KWT + ch * 72 + s0 + i) = pk2(o[i] * 0.08838834764831845f * sw[s0 + i], o[i + 1] * 0.08838834764831845f * sw[s0 + i + 1]);
          const bf16* vsrc = VM + ((size_t)b * SEQ + c * 64 + s0) * 512 + h * 128 + ch;
#pragma unroll
          for (int i = 0; i < 16; i += 2) *(LAS unsigned*)(VT + ch * 72 + s0 + i) = (unsigned)vsrc[(size_t)i * 512] | ((unsigned)vsrc[(size_t)(i + 1) * 512] << 16);
        }
        __syncthreads();
        {
          const bf16x8 vb0 = *(const LAS bf16x8*)(VT + (16 * wave + r) * 72 + 8 * g), vb1 = *(const LAS bf16x8*)(VT + (16 * wave + r) * 72 + 32 + 8 * g);
          bf16* dst = DC + (size_t)item * 16384 + (size_t)(16 * wave + r) * 128 + 4 * g;
#pragma unroll
          for (int eb = 0; eb < 8; ++eb) {
              const bf16x8 ka0 = *(const LAS bf16x8*)(KWT + (16 * eb + r) * 72 + 8 * g), ka1 = *(const LAS bf16x8*)(KWT + (16 * eb + r) * 72 + 32 + 8 * g);
              f32x4 acc = {0.f, 0.f, 0.f, 0.f};
              acc = MFMA16(ka0, vb0, acc); acc = MFMA16(ka1, vb1, acc);
              uint2 o; o.x = pk2(acc[0], acc[1]); o.y = pk2(acc[2], acc[3]); *(uint2*)(dst + 16 * eb) = o;
          }
        }
        if (tid < 128) { float a = 0.f;
#pragma unroll
            for (int cc = 0; cc < 8; ++cc) { float f[8]; unpk8(*(const LAS v4u*)(KWT + tid * 72 + 8 * cc), f);
#pragma unroll
                for (int k = 0; k < 8; ++k) a += f[k]; }
            DN[(size_t)item * 128 + tid] = a; }
        __syncthreads();
    }
}

__device__ __forceinline__ void p3_mlstm_scan(const Params& P, int tid, int vb) {
    const unsigned* __restrict__ DC = (const unsigned*)((unsigned char*)P.out + OUT_DC); unsigned* __restrict__ CS = (unsigned*)((unsigned char*)P.out + OUT_CS);
    const float* __restrict__ DN = (const float*)(P.ws + WS_DN); float* __restrict__ NS = (float*)(P.ws + WS_NS); float* SC = (float*)(P.ws + WS_SC);
    for (int gid = vb * 512 + tid; gid < 8 * 8192; gid += gridDim.x * 512) {
        const int bh = gid >> 13, idx = gid & 8191; const bool hasn = idx < 64;
        float C0 = 0.f, C1 = 0.f, n0 = 0.f, n1 = 0.f, m = 0.f;
        for (int j0 = 0; j0 < 256; j0 += 16) {
            unsigned d[16]; float ml[16], gg[16]; float2 dn[16];
#pragma unroll
            for (int u = 0; u < 16; ++u) { const int item = bh * 256 + j0 + u; d[u] = DC[(size_t)item * 8192 + idx]; ml[u] = SC[item]; gg[u] = SC[2048 + item];
                dn[u] = hasn ? *(const float2*)(DN + (size_t)item * 128 + 2 * idx) : make_float2(0.f, 0.f); }
#pragma unroll
            for (int u = 0; u < 16; ++u) { const int item = bh * 256 + j0 + u;
                CS[(size_t)item * 8192 + idx] = pk2(C0, C1);
                if (hasn) *(float2*)(NS + (size_t)item * 128 + 2 * idx) = make_float2(n0, n1);
                if (idx == 0) SC[4096 + item] = m;
                const float mn = fmaxf(gg[u] + m, ml[u]), a = __expf(gg[u] + m - mn), bb = __expf(ml[u] - mn);
                C0 = a * C0 + bb * bf_lo(d[u]); C1 = a * C1 + bb * bf_hi(d[u]); n0 = a * n0 + bb * dn[u].x; n1 = a * n1 + bb * dn[u].y; m = mn; }
        }
    }
}

struct P4Pref { v4u raw[7]; v4u cs[4]; uint2 om[4]; f32x4 gn; float ifa, ifb, nsv; };
__device__ __forceinline__ void p4_prefetch_raw(P4Pref& pf, const Params& P, int item, int tid, int lane) {
    const bf16* QKM = (const bf16*)(P.ws + WS_QKM); const bf16* VM = (const bf16*)(P.ws + WS_VM); const float* IFb = (const float*)(P.ws + WS_IF); const float* NS = (const float*)(P.ws + WS_NS);
    const int bh = item >> 8, c = item & 255, b = bh >> 2, h = bh & 3;
#pragma unroll
    for (int i = 0; i < 7; ++i) { const int v = tid + 512 * i; const int rr = v / 48, rem = v - rr * 48, seg = rem >> 4, c16 = rem & 15; const int t = c * 64 + rr - 3;
        v4u val = {0u, 0u, 0u, 0u};
        if (v < 3216 && t >= 0) val = (seg < 2) ? *(const v4u*)(QKM + ((size_t)b * SEQ + t) * 1024 + seg * 512 + h * 128 + 8 * c16) : *(const v4u*)(VM + ((size_t)b * SEQ + t) * 512 + h * 128 + 8 * c16);
        pf.raw[i] = val; }
    const size_t row = (size_t)b * SEQ + c * 64 + lane;
    pf.ifa = IFb[row * 8 + 4 + h]; pf.ifb = IFb[row * 8 + h];
    pf.nsv = NS[(size_t)item * 128 + (tid & 127)];
}
__device__ __forceinline__ void p4_prefetch_cs(P4Pref& pf, const Params& P, int item, int lane, int wave) {
    const bf16* CS = (const bf16*)((unsigned char*)P.out + OUT_CS);
    const bf16* crow = CS + (size_t)item * 16384 + (size_t)(16 * wave + (lane & 15)) * 128 + 8 * (lane >> 4);
#pragma unroll
    for (int ks = 0; ks < 4; ++ks) pf.cs[ks] = *(const v4u*)(crow + 32 * ks);
}
__device__ __forceinline__ void p4_prefetch_om(P4Pref& pf, const Params& P, int item, int lane, int wave) {
    const bf16* OM = (const bf16*)(P.ws + WS_OM);
    const int bh = item >> 8, c = item & 255, b = bh >> 2, h = bh & 3, r = lane & 15, g = lane >> 4;
#pragma unroll
    for (int tb = 0; tb < 4; ++tb) pf.om[tb] = *(const uint2*)(OM + ((size_t)b * SEQ + c * 64 + 16 * tb + r) * 512 + h * 128 + 16 * wave + 4 * g);
    pf.gn = *(const f32x4*)(P.in[6] + h * 128 + 16 * wave + 4 * g);
}
__device__ __forceinline__ void p4_mlstm_out(const Params& P, LAS unsigned char* lds, int tid, int lane, int wave, int vb) {
    const float* cw = P.in[4]; const float* SC = (const float*)(P.ws + WS_SC); bf16* YM = (bf16*)(P.ws + WS_YA);
    LAS float* CW = (LAS float*)lds;
    LAS unsigned char* RAW = lds + 16384;
    LAS bf16* Qs = (LAS bf16*)(lds + 68912); LAS bf16* Ks = (LAS bf16*)(lds + 86320); LAS bf16* VT = (LAS bf16*)(lds + 103728); LAS bf16* PT = (LAS bf16*)(lds + 122160);
    LAS float* sm = (LAS float*)(lds + 131376);
    LAS bf16* NSB = (LAS bf16*)(lds + 135728);
    const int r = lane & 15, g = lane >> 4;
    for (int i = tid; i < 1024; i += 512) ((LAS f32x4*)CW)[i] = ((const f32x4*)cw)[i];
    P4Pref pf;
    if (vb < 2048) { p4_prefetch_raw(pf, P, vb, tid, lane); p4_prefetch_cs(pf, P, vb, lane, wave); p4_prefetch_om(pf, P, vb, lane, wave); }
    for (int item = vb; item < 2048; item += gridDim.x) {
        const int bh = item >> 8, c = item & 255, b = bh >> 2, h = bh & 3;
#pragma unroll
        for (int i = 0; i < 7; ++i) { const int v = tid + 512 * i; if (v < 3216) { const int rr = v / 48, rem = v - rr * 48; *(LAS v4u*)(RAW + rr * 784 + rem * 16) = pf.raw[i]; } }
        if (tid < 128) NSB[tid] = (bf16)f2bf(pf.nsv);
        if (wave == 0) {
            const float lf = logsigmoid(pf.ifa), ip = pf.ifb;
            const float bc = scan_add(lf, lane), a = ip - bc, pm = scan_max(a, lane), ms = SC[4096 + item], M = fmaxf(ms, pm);
            sm[lane] = a; sm[64 + lane] = M; sm[128 + lane] = __expf(ms - M); sm[192 + lane] = __expf(-bc - M);
        }
        __syncthreads();
        { const int g4 = tid & 31, s0 = (tid >> 5) * 4;
#pragma unroll
          for (int tile = 0; tile < 2; ++tile) {
              float x[7][4];
#pragma unroll
              for (int j = 0; j < 7; ++j) { const v2u rv = *(const LAS v2u*)(RAW + (s0 + j) * 784 + tile * 256 + g4 * 8); x[j][0] = bf_lo(rv.x); x[j][1] = bf_hi(rv.x); x[j][2] = bf_lo(rv.y); x[j][3] = bf_hi(rv.y); }
              f32x4 w[4];
#pragma unroll
              for (int tp = 0; tp < 4; ++tp) w[tp] = *(const LAS f32x4*)(CW + tp * 1024 + tile * 512 + h * 128 + 4 * g4);
              const float sc = tile ? 0.08838834764831845f : 1.0f; LAS bf16* dst = tile ? Ks : Qs;
#pragma unroll
              for (int j = 0; j < 4; ++j) { float y[4];
#pragma unroll
                  for (int i = 0; i < 4; ++i) y[i] = silu(w[0][i] * x[j][i] + w[1][i] * x[j + 1][i] + w[2][i] * x[j + 2][i] + w[3][i] * x[j + 3][i]) * sc;
                  v2u o; o.x = pk2(y[0], y[1]); o.y = pk2(y[2], y[3]); *(LAS v2u*)(dst + (s0 + j) * 136 + 4 * g4) = o; }
          }
          const int ch = tid & 127, sv = (tid >> 7) * 16;
#pragma unroll
          for (int i = 0; i < 16; i += 2) { const unsigned lo = *(const LAS bf16*)(RAW + (3 + sv + i) * 784 + 512 + ch * 2), hi = *(const LAS bf16*)(RAW + (4 + sv + i) * 784 + 512 + ch * 2);
              *(LAS unsigned*)(VT + ch * 72 + sv + i) = lo | (hi << 16); }
        }
        asm volatile("" ::: "memory");
        if (item + (int)gridDim.x < 2048) p4_prefetch_raw(pf, P, item + gridDim.x, tid, lane);
        __syncthreads();
        { const int sb = wave >> 1;
          bf16x8 ka[4];
#pragma unroll
          for (int ks = 0; ks < 4; ++ks) ka[ks] = *(const LAS bf16x8*)(Ks + (16 * sb + r) * 136 + 32 * ks + 8 * g);
#pragma unroll
          for (int tt = 0; tt < 2; ++tt) { const int tb = 2 * (wave & 1) + tt, t = 16 * tb + r;
              f32x4 acc = {0.f, 0.f, 0.f, 0.f};
#pragma unroll
              for (int ks = 0; ks < 4; ++ks) { const bf16x8 qb = *(const LAS bf16x8*)(Qs + t * 136 + 32 * ks + 8 * g); acc = MFMA16(ka[ks], qb, acc); }
              const float Mt = sm[64 + t]; float p[4], ps = 0.f;
#pragma unroll
              for (int k = 0; k < 4; ++k) { const int s = 16 * sb + 4 * g + k; p[k] = (s <= t) ? acc[k] * __expf(sm[s] - Mt) : 0.f; ps += p[k]; }
              v2u o; o.x = pk2(p[0], p[1]); o.y = pk2(p[2], p[3]); *(LAS v2u*)(PT + t * 72 + 16 * sb + 4 * g) = o;
              ps += __shfl_xor(ps, 16); ps += __shfl_xor(ps, 32);
              if (g == 0) sm[320 + sb * 64 + t] = ps; }
        }
        __syncthreads();
        f32x4 ai[4], ac[4], an[4];
#pragma unroll
        for (int tb = 0; tb < 4; ++tb) { ai[tb] = (f32x4){0.f, 0.f, 0.f, 0.f}; ac[tb] = (f32x4){0.f, 0.f, 0.f, 0.f}; an[tb] = (f32x4){0.f, 0.f, 0.f, 0.f}; }
        { const bf16x8 va0 = *(const LAS bf16x8*)(VT + (16 * wave + r) * 72 + 8 * g), va1 = *(const LAS bf16x8*)(VT + (16 * wave + r) * 72 + 32 + 8 * g);
          const bf16x8 ca0 = __builtin_bit_cast(bf16x8, pf.cs[0]), ca1 = __builtin_bit_cast(bf16x8, pf.cs[1]), ca2 = __builtin_bit_cast(bf16x8, pf.cs[2]), ca3 = __builtin_bit_cast(bf16x8, pf.cs[3]);
          const bf16x8 zero8 = {0, 0, 0, 0, 0, 0, 0, 0};
#pragma unroll
          for (int tb = 0; tb < 4; ++tb) { const int t = 16 * tb + r;
              const bf16x8 pb0 = *(const LAS bf16x8*)(PT + t * 72 + 8 * g), pb1 = *(const LAS bf16x8*)(PT + t * 72 + 32 + 8 * g);
              ai[tb] = MFMA16(va0, pb0, ai[tb]); ai[tb] = MFMA16(va1, pb1, ai[tb]);
              const bf16x8 q0 = *(const LAS bf16x8*)(Qs + t * 136 + 8 * g), q1 = *(const LAS bf16x8*)(Qs + t * 136 + 32 + 8 * g), q2 = *(const LAS bf16x8*)(Qs + t * 136 + 64 + 8 * g), q3 = *(const LAS bf16x8*)(Qs + t * 136 + 96 + 8 * g);
              ac[tb] = MFMA16(ca0, q0, ac[tb]); ac[tb] = MFMA16(ca1, q1, ac[tb]); ac[tb] = MFMA16(ca2, q2, ac[tb]); ac[tb] = MFMA16(ca3, q3, ac[tb]);
              if (wave == 0) {
                  const bf16x8 n0 = r == 0 ? *(const LAS bf16x8*)(NSB + 8 * g) : zero8, n1 = r == 0 ? *(const LAS bf16x8*)(NSB + 32 + 8 * g) : zero8, n2 = r == 0 ? *(const LAS bf16x8*)(NSB + 64 + 8 * g) : zero8, n3 = r == 0 ? *(const LAS bf16x8*)(NSB + 96 + 8 * g) : zero8;
                  an[tb] = MFMA16(n0, q0, an[tb]); an[tb] = MFMA16(n1, q1, an[tb]); an[tb] = MFMA16(n2, q2, an[tb]); an[tb] = MFMA16(n3, q3, an[tb]);
                  if (g == 0) { const float den = sm[128 + t] * an[tb][0] + (sm[320 + t] + sm[384 + t]) + (sm[448 + t] + sm[512 + t]); sm[256 + t] = fmaxf(fabsf(den), sm[192 + t]); } } }
        }
        asm volatile("" ::: "memory");
        if (item + (int)gridDim.x < 2048) p4_prefetch_cs(pf, P, item + gridDim.x, lane, wave);
#pragma unroll
        for (int tb = 0; tb < 4; ++tb) { const int t = 16 * tb + r; const float wi = sm[128 + t]; float s2 = 0.f;
#pragma unroll
            for (int k = 0; k < 4; ++k) { ai[tb][k] = wi * ac[tb][k] + ai[tb][k]; s2 += ai[tb][k] * ai[tb][k]; }
            s2 += __shfl_xor(s2, 16); s2 += __shfl_xor(s2, 32);
            if (g == 0) sm[576 + wave * 64 + t] = s2; }
        __syncthreads();
        {
#pragma unroll
          for (int tb = 0; tb < 4; ++tb) { const int t = 16 * tb + r; float tot = 0.f;
#pragma unroll
              for (int w = 0; w < 8; ++w) tot += sm[576 + w * 64 + t];
              const float inv = __builtin_amdgcn_rcpf(sm[256 + t]), rs = inv * rsqrtf(tot * inv * inv * (1.f / 128.f) + EPS);
              const size_t row = (size_t)b * SEQ + c * 64 + t; const int col = h * 128 + 16 * wave + 4 * g;
              uint2 o; o.x = pk2(ai[tb][0] * rs * pf.gn[0] * bf_lo(pf.om[tb].x), ai[tb][1] * rs * pf.gn[1] * bf_hi(pf.om[tb].x)); o.y = pk2(ai[tb][2] * rs * pf.gn[2] * bf_lo(pf.om[tb].y), ai[tb][3] * rs * pf.gn[3] * bf_hi(pf.om[tb].y));
              *(uint2*)(YM + row * 1024 + 512 + col) = o; }
        }
        asm volatile("" ::: "memory");
        if (item + (int)gridDim.x < 2048) p4_prefetch_om(pf, P, item + gridDim.x, lane, wave);
        __syncthreads();
    }
}

__device__ __forceinline__ int f2ord(float f) { const int b = __float_as_int(f); return b ^ ((b >> 31) & 0x7fffffff); }
__device__ __forceinline__ float ord2f(int o) { return __int_as_float(o ^ ((o >> 31) & 0x7fffffff)); }
#define CE_DESC(a, i, j) { const int _h = max(a[i], a[j]), _l = min(a[i], a[j]); a[i] = _h; a[j] = _l; }
__device__ __forceinline__ void sort16_desc(int (&a)[16]) {
#pragma unroll
    for (int k = 2; k <= 16; k <<= 1) {
#pragma unroll
        for (int j = k >> 1; j > 0; j >>= 1) {
#pragma unroll
            for (int i = 0; i < 16; ++i) { const int l = i ^ j; if (l > i) { if ((i & k) == 0) CE_DESC(a, i, l) else CE_DESC(a, l, i) } }
        }
    }
}
__device__ __forceinline__ void merge16_desc(int (&a)[16], const int (&b)[16]) {
#pragma unroll
    for (int i = 0; i < 16; ++i) a[i] = max(a[i], b[15 - i]);
#pragma unroll
    for (int j = 8; j > 0; j >>= 1) {
#pragma unroll
        for (int i = 0; i < 16; ++i) { const int l = i ^ j; if (l > i) CE_DESC(a, i, l) }
    }
}
__device__ __forceinline__ void xmerge16(int (&a)[16], int mask) {
    int b[16];
#pragma unroll
    for (int i = 0; i < 16; ++i) b[i] = __shfl_xor(a[i], mask);
    merge16_desc(a, b);
}
__device__ __forceinline__ void p10_quant_rows(const Params& P, int lane, int wave, int vb) {
    const bf16* HN = (const bf16*)(P.ws + WS_HN); unsigned* HQH = (unsigned*)(P.ws + WS_HQH); unsigned* HQL = (unsigned*)(P.ws + WS_HQL); float* HS = (float*)(P.ws + WS_HS);
    for (int t = vb * NW + wave; t < NTOK; t += gridDim.x * NW) {
        float y[16]; unpk8(((const v4u*)(HN + (size_t)t * 1024))[2 * lane], y); unpk8(((const v4u*)(HN + (size_t)t * 1024))[2 * lane + 1], y + 8);
        float cm = 0.f;
#pragma unroll
        for (int i = 0; i < 16; ++i) cm = fmaxf(cm, fabsf(y[i]));
        cm = fmaxf(cm, __shfl_xor(cm, 1));
        const float sc = cm > 0.f ? cm * (1.0f / 119.0f) : 1.0f, inv = 1.0f / sc; unsigned dh[2] = {0u, 0u}, dl[2] = {0u, 0u};
#pragma unroll
        for (int i = 0; i < 16; ++i) { const int h = (int)rintf(y[i] * inv), lo = ((h + 8) & 15) - 8;
            dl[i >> 3] |= ((unsigned)lo & 15u) << (4 * (i & 7)); dh[i >> 3] |= ((unsigned)((h - lo) >> 4) & 15u) << (4 * (i & 7)); }
        *(uint2*)(HQH + (size_t)t * 128 + 2 * lane) = make_uint2(dh[0], dh[1]); *(uint2*)(HQL + (size_t)t * 128 + 2 * lane) = make_uint2(dl[0], dl[1]);
        if ((lane & 1) == 0) HS[(size_t)t * 32 + (lane >> 1)] = sc;
    }
}
__device__ __forceinline__ void p10_topk(const Params& P, LAS unsigned char* lds, int tid, int lane, int wave, int vb) {
    const bf16* Q2 = (const bf16*)(P.ws + WS_Q2); const bf16* K1B = (const bf16*)(P.ws + WS_K1B); const bf16* K2B = (const bf16*)(P.ws + WS_K2B);
    int* IDX = (int*)(P.ws + WS_IDX); float* GATE = (float*)(P.ws + WS_GATE); const float* SSQ1 = (const float*)(P.ws + WS_SSQ1);
    LAS bf16* Kl = (LAS bf16*)lds;
    LAS int* Tb = (LAS int*)(lds + 69632 + wave * 2048);
    const int r = lane & 15, g = lane >> 4;
    const int h = vb & 7, wgx = vb >> 3, nwg = gridDim.x >> 3;
    __syncthreads();
    for (int i = tid; i < 4096; i += 512) { const int half = i >> 11, rem = i & 2047, n = rem >> 4, c = rem & 15;
        *(LAS v4u*)(Kl + half * 17408 + n * 136 + c * 8) = *(const v4u*)((half ? K2B : K1B) + (size_t)h * 16384 + n * 128 + c * 8); }
    __syncthreads();
    for (int tile = wgx * NW + wave; tile < NTOK / 16; tile += nwg * NW) {
        const size_t row = (size_t)tile * 16 + r;
        int R[2][16];
#pragma unroll
        for (int half = 0; half < 2; ++half) {
            bf16x8 qb[4];
#pragma unroll
            for (int ks = 0; ks < 4; ++ks) qb[ks] = *(const bf16x8*)(Q2 + row * 2048 + h * 256 + half * 128 + 32 * ks + 8 * g);
            int X[16], Y[16];
#pragma unroll
            for (int nb = 0; nb < 8; ++nb) {
                f32x4 acc = {0.f, 0.f, 0.f, 0.f};
#pragma unroll
                for (int ks = 0; ks < 4; ++ks) acc = MFMA16(*(const LAS bf16x8*)(Kl + half * 17408 + (16 * nb + r) * 136 + 32 * ks + 8 * g), qb[ks], acc);
#pragma unroll
                for (int k = 0; k < 4; ++k) { const int key = (f2ord(acc[k]) & ~0x7f) | (16 * nb + 4 * g + k); if (nb < 4) X[4 * nb + k] = key; else Y[4 * (nb - 4) + k] = key; }
            }
            sort16_desc(X); sort16_desc(Y); merge16_desc(X, Y);
            xmerge16(X, 16); xmerge16(X, 32);
#pragma unroll
            for (int i = 0; i < 16; ++i) R[half][i] = X[i];
        }
        if (g == 0) {
#pragma unroll
            for (int i = 0; i < 16; ++i) { Tb[r * 32 + i] = R[0][i] & 0x7f; Tb[r * 32 + 16 + i] = R[1][i] & 0x7f; }
        }
        float F1[16], F2[16];
#pragma unroll
        for (int i = 0; i < 16; ++i) { F1[i] = ord2f(R[0][i] & ~0x7f); F2[i] = ord2f(R[1][i] & ~0x7f); }
        int C[16];
#pragma unroll
        for (int sl = 0; sl < 16; ++sl) {
            const int a1 = sl < 8 ? 1 : (sl < 13 ? 2 : -1), b1 = sl < 8 ? sl : sl - 8;
            const int a2 = sl < 4 ? 3 : (sl < 7 ? 4 : (sl < 9 ? 5 : (sl < 11 ? 6 : (sl < 13 ? 7 : -1)))), b2 = sl < 4 ? sl : (sl < 7 ? sl - 4 : (sl < 9 ? sl - 7 : (sl < 11 ? sl - 9 : sl - 11)));
            const int a3 = sl < 8 ? 8 + sl : -1;
            const int k0 = (f2ord(F1[0] + F2[sl]) & ~0xff) | (0 << 4) | sl;
            const int k1 = a1 >= 0 ? ((f2ord(F1[a1 < 0 ? 0 : a1] + F2[b1 & 15]) & ~0xff) | (a1 << 4) | (b1 & 15)) : (int)0x80000000;
            const int k2 = a2 >= 0 ? ((f2ord(F1[a2 < 0 ? 0 : a2] + F2[b2 & 15]) & ~0xff) | (a2 << 4) | (b2 & 15)) : (int)0x80000000;
            const int k3 = a3 >= 0 ? ((f2ord(F1[a3 < 0 ? 0 : a3] + F2[0]) & ~0xff) | (a3 << 4)) : (int)0x80000000;
            C[sl] = g == 0 ? k0 : (g == 1 ? k1 : (g == 2 ? k2 : k3));
        }
        sort16_desc(C); xmerge16(C, 16); xmerge16(C, 32);
        const float rstd1 = rsqrtf(SSQ1[row] * (1.0f / 1024.0f) + EPS);
        float e[16], sum = 0.f; const float mx = ord2f(C[0] & ~0xff);
#pragma unroll
        for (int i = 0; i < 16; ++i) { e[i] = __expf((ord2f(C[i] & ~0xff) - mx) * rstd1); sum += e[i]; }
        const float inv = __builtin_amdgcn_rcpf(sum);
        int oi[4]; float og[4];
#pragma unroll
        for (int kk = 0; kk < 4; ++kk) {
            const int key = g == 0 ? C[kk] : (g == 1 ? C[4 + kk] : (g == 2 ? C[8 + kk] : C[12 + kk]));
            const float ev = g == 0 ? e[kk] : (g == 1 ? e[4 + kk] : (g == 2 ? e[8 + kk] : e[12 + kk]));
            const int a = (key >> 4) & 15, bq = key & 15;
            oi[kk] = Tb[r * 32 + a] * 128 + Tb[r * 32 + 16 + bq]; og[kk] = ev * inv;
        }
#pragma unroll
        for (int kk = 0; kk < 4; ++kk) { const int pos = (4 * (g & 1) + kk) * 16 + 2 * h + (g >> 1); IDX[row * 128 + pos] = oi[kk]; GATE[row * 128 + pos] = og[kk]; }
    }
}

typedef _Float16 f16x2 __attribute__((ext_vector_type(2)));
__device__ __forceinline__ f16x2 bfpair_to_h2(unsigned w) { return __builtin_bit_cast(f16x2, __builtin_amdgcn_cvt_pkrtz(bf_lo(w), bf_hi(w))); }
template <int B> __device__ __forceinline__ f16x2 fp4_to_h2(unsigned w) { return __builtin_bit_cast(f16x2, __builtin_amdgcn_cvt_scalef32_pk_f16_fp4(w, 1.0f, B)); }
__device__ __forceinline__ void p11a_reduce_store(const v4u (&ud)[16], const v4u hh, const v4u hl, const float hsc, float* PART, int t, int x, int rg, int ch) {
    float z[16];
#pragma unroll
    for (int gq = 0; gq < 16; ++gq) {
        int ah = __builtin_amdgcn_sdot8((int)ud[gq].x, (int)hh.x, 0, false), al = __builtin_amdgcn_sdot8((int)ud[gq].x, (int)hl.x, 0, false);
        ah = __builtin_amdgcn_sdot8((int)ud[gq].y, (int)hh.y, ah, false); al = __builtin_amdgcn_sdot8((int)ud[gq].y, (int)hl.y, al, false);
        ah = __builtin_amdgcn_sdot8((int)ud[gq].z, (int)hh.z, ah, false); al = __builtin_amdgcn_sdot8((int)ud[gq].z, (int)hl.z, al, false);
        ah = __builtin_amdgcn_sdot8((int)ud[gq].w, (int)hh.w, ah, false); al = __builtin_amdgcn_sdot8((int)ud[gq].w, (int)hl.w, al, false);
        z[gq] = (float)(16 * ah + al) * hsc; }
    float z8[8], z4[4], z2[2];
    { const bool b = ch & 4;
#pragma unroll
      for (int i = 0; i < 8; ++i) { const float keep = b ? z[8 + i] : z[i], send = b ? z[i] : z[8 + i]; z8[i] = keep + __shfl_xor(send, 4); } }
    { const bool b = ch & 2;
#pragma unroll
      for (int i = 0; i < 4; ++i) { const float keep = b ? z8[4 + i] : z8[i], send = b ? z8[i] : z8[4 + i]; z4[i] = keep + __shfl_xor(send, 2); } }
    { const bool b = ch & 1;
#pragma unroll
      for (int i = 0; i < 2; ++i) { const float keep = b ? z4[2 + i] : z4[i], send = b ? z4[i] : z4[2 + i]; z2[i] = keep + __shfl_xor(send, 1); } }
    *(float2*)(PART + ((size_t)t * 4 + x) * 128 + rg * 16 + 2 * ch) = make_float2(z2[0], z2[1]);
}
__device__ __forceinline__ void p11a_udot(const Params& P, int lane, int wave, int vb) {
    const unsigned* HQH = (const unsigned*)(P.ws + WS_HQH); const unsigned* HQL = (const unsigned*)(P.ws + WS_HQL); const float* HS = (const float*)(P.ws + WS_HS);
    const unsigned char* U4 = P.ws + WS_U4; const int* IDX = (const int*)(P.ws + WS_IDX); float* PART = (float*)(P.ws + WS_PART);
    const int x = vb & 3, wgx = vb >> 2, nwg = gridDim.x >> 2, rg = lane >> 3, ch = lane & 7;
    const int tstep = nwg * NW;
    for (int t = wgx * NW + wave; t < NTOK; t += 2 * tstep) {
        const int tB = t + tstep;
        int eA[16], eB[16];
#pragma unroll
        for (int q = 0; q < 4; ++q) { const int4 v = *(const int4*)(IDX + (size_t)t * 128 + rg * 16 + 4 * q); eA[4 * q] = v.x; eA[4 * q + 1] = v.y; eA[4 * q + 2] = v.z; eA[4 * q + 3] = v.w;
            const int4 w = *(const int4*)(IDX + (size_t)tB * 128 + rg * 16 + 4 * q); eB[4 * q] = w.x; eB[4 * q + 1] = w.y; eB[4 * q + 2] = w.z; eB[4 * q + 3] = w.w; }
        const v4u hhA = *(const v4u*)(HQH + (size_t)t * 128 + 32 * x + 4 * ch), hlA = *(const v4u*)(HQL + (size_t)t * 128 + 32 * x + 4 * ch);
        const v4u hhB = *(const v4u*)(HQH + (size_t)tB * 128 + 32 * x + 4 * ch), hlB = *(const v4u*)(HQL + (size_t)tB * 128 + 32 * x + 4 * ch);
        const float hsA = HS[(size_t)t * 32 + 8 * x + ch], hsB = HS[(size_t)tB * 32 + 8 * x + ch];
        v4u udA[16], udB[16];
#pragma unroll
        for (int gq = 0; gq < 16; ++gq) udA[gq] = *(const v4u*)(U4 + (size_t)eA[gq] * 512 + 128 * x + 16 * ch);
#pragma unroll
        for (int gq = 0; gq < 16; ++gq) udB[gq] = *(const v4u*)(U4 + (size_t)eB[gq] * 512 + 128 * x + 16 * ch);
        p11a_reduce_store(udA, hhA, hlA, hsA, PART, t, x, rg, ch);
        p11a_reduce_store(udB, hhB, hlB, hsB, PART, tB, x, rg, ch);
    }
}
__device__ __forceinline__ void p11b_weights(const Params& P, int tid, int vb) {
    const float* PART = (const float*)(P.ws + WS_PART); float* GW = (float*)(P.ws + WS_GATE); const float* SSQ1 = (const float*)(P.ws + WS_SSQ1);
    const int* IDX = (const int*)(P.ws + WS_IDX); const float* SU = (const float*)(P.ws + WS_SU); const float* SV = (const float*)(P.ws + WS_SV);
    for (size_t i = (size_t)vb * 512 + tid; i < (size_t)NTOK * 128; i += (size_t)gridDim.x * 512) {
        const size_t t = i >> 7, pos = i & 127; float zs = 0.f;
#pragma unroll
        for (int x = 0; x < 4; ++x) zs += PART[(t * 4 + x) * 128 + pos];
        const int e = IDX[i];
        const float zv = zs * SU[e] * rsqrtf(SSQ1[t] * (1.0f / 1024.0f) + EPS);
        GW[i] = GW[i] * 0.5f * zv * (1.0f + erff(zv * 0.70710678118654752f)) * SV[e];
    }
}
__device__ __forceinline__ void p11c_vacc(const Params& P, int lane, int wave, int vb) {
    const unsigned char* V4 = P.ws + WS_V4; const int* IDX = (const int*)(P.ws + WS_IDX); const float* GW = (const float*)(P.ws + WS_GATE);
    bf16* XB = (bf16*)(P.ws + WS_HN); float* SSQ = (float*)(P.ws + WS_SSQ);
    const int x = vb & 3, wgx = vb >> 2, nwg = gridDim.x >> 2, rg = lane >> 3, ch = lane & 7;
    for (int t = wgx * NW + wave; t < NTOK; t += nwg * NW) {
        int e[16]; float w[16];
#pragma unroll
        for (int q = 0; q < 4; ++q) { const int4 v = *(const int4*)(IDX + (size_t)t * 128 + rg * 16 + 4 * q); e[4 * q] = v.x; e[4 * q + 1] = v.y; e[4 * q + 2] = v.z; e[4 * q + 3] = v.w;
            const float4 wv = *(const float4*)(GW + (size_t)t * 128 + rg * 16 + 4 * q); w[4 * q] = wv.x; w[4 * q + 1] = wv.y; w[4 * q + 2] = wv.z; w[4 * q + 3] = wv.w; }
        v4u vd[16];
#pragma unroll
        for (int gq = 0; gq < 16; ++gq) vd[gq] = *(const v4u*)(V4 + (size_t)e[gq] * 512 + 128 * x + 16 * ch);
        bf16* xp = XB + (size_t)t * 1024 + 256 * x + 32 * ch + 4 * rg;
        const uint2 xo = *(const uint2*)xp;
        f16x2 acc[16];
#pragma unroll
        for (int i = 0; i < 16; ++i) acc[i] = (f16x2){(_Float16)0.f, (_Float16)0.f};
#pragma unroll
        for (int gq = 0; gq < 16; ++gq) { const f16x2 ww = __builtin_bit_cast(f16x2, __builtin_amdgcn_cvt_pkrtz(w[gq], w[gq])); const unsigned w4[4] = {vd[gq].x, vd[gq].y, vd[gq].z, vd[gq].w};
#pragma unroll
            for (int q = 0; q < 4; ++q) { acc[4 * q] = __builtin_elementwise_fma(fp4_to_h2<0>(w4[q]), ww, acc[4 * q]); acc[4 * q + 1] = __builtin_elementwise_fma(fp4_to_h2<1>(w4[q]), ww, acc[4 * q + 1]);
                acc[4 * q + 2] = __builtin_elementwise_fma(fp4_to_h2<2>(w4[q]), ww, acc[4 * q + 2]); acc[4 * q + 3] = __builtin_elementwise_fma(fp4_to_h2<3>(w4[q]), ww, acc[4 * q + 3]); } }
        f16x2 a8[8], a4[4], a2[2];
        { const bool b = rg & 4;
#pragma unroll
          for (int i = 0; i < 8; ++i) { const f16x2 keep = b ? acc[8 + i] : acc[i], send = b ? acc[i] : acc[8 + i]; a8[i] = keep + __builtin_bit_cast(f16x2, __shfl_xor(__builtin_bit_cast(int, send), 32)); } }
        { const bool b = rg & 2;
#pragma unroll
          for (int i = 0; i < 4; ++i) { const f16x2 keep = b ? a8[4 + i] : a8[i], send = b ? a8[i] : a8[4 + i]; a4[i] = keep + __builtin_bit_cast(f16x2, __shfl_xor(__builtin_bit_cast(int, send), 16)); } }
        { const bool b = rg & 1;
#pragma unroll
          for (int i = 0; i < 2; ++i) { const f16x2 keep = b ? a4[2 + i] : a4[i], send = b ? a4[i] : a4[2 + i]; a2[i] = keep + __builtin_bit_cast(f16x2, __shfl_xor(__builtin_bit_cast(int, send), 8)); } }
        f32x4 xn; xn[0] = bf_lo(xo.x) + (float)a2[0][0]; xn[1] = bf_hi(xo.x) + (float)a2[0][1]; xn[2] = bf_lo(xo.y) + (float)a2[1][0]; xn[3] = bf_hi(xo.y) + (float)a2[1][1];
        uint2 xg; xg.x = pk2(xn[0], xn[1]); xg.y = pk2(xn[2], xn[3]);
        *(uint2*)xp = xg;
        { int p8 = __builtin_amdgcn_cvt_pk_fp8_f32(xn[0], xn[1], 0, false); p8 = __builtin_amdgcn_cvt_pk_fp8_f32(xn[2], xn[3], p8, true); *(int*)(P.ws + WS_X2B8 + (size_t)t * 1024 + 256 * x + 32 * ch + 4 * rg) = p8; }
        const float ss = wave_sum((xn[0] * xn[0] + xn[1] * xn[1]) + (xn[2] * xn[2] + xn[3] * xn[3]));
        if (lane == 0) atomicAdd(SSQ + t, ss);
    }
}

__global__ void __launch_bounds__(512, 2) mk_fwd(Params P) {
    extern __shared__ __attribute__((aligned(16))) unsigned char lds_raw[];
    cg::grid_group grid = cg::this_grid();
    LAS unsigned char* lds = (LAS unsigned char*)lds_raw;
    const int tid = threadIdx.x, lane = tid & 63, wave = __builtin_amdgcn_readfirstlane(tid >> 6);
    const int lo = P.ph_lo, hi = P.ph_hi, G = gridDim.x, bx = blockIdx.x;
    unsigned char* ws = P.ws;
    const int gw = bx * NW + wave, NGW = G * NW;
#ifndef PH_MASK
#define PH_MASK 0xffff
#endif
#define IN(k) (((PH_MASK >> (k)) & 1) && lo <= (k) && (k) < hi)
    volatile LAS unsigned* xst = (volatile LAS unsigned*)(lds + LDS_BYTES - 16);
    if (tid < 4) xst[tid] = 0u;
    __syncthreads();
    const XcdBarrier bar = xcd_barrier_post((unsigned*)(ws + WS_BAR), xst);
    unsigned* vctl = (unsigned*)(ws + WS_BAR) + 4096;
    if (tid == 0) { const unsigned xcc = xb_xcc_id() & 7u; xst[2] = xcc; xst[3] = xb_add(&vctl[16 * xcc], 1u); }
#ifdef USE_CG
#define GRID_BAR() grid.sync()
#else
#define GRID_BAR() xcd_barrier(bar)
#endif
#define SYNC_AFTER(k) do { if (IN(k) && IN((k) + 1)) { GRID_BAR(); } } while (0)
    typedef pg8::bf16_t pb;
    if (IN(0)) p0_prologue(P, lds, tid, lane, wave);
    SYNC_AFTER(0);
    if (tid == 0) {
        const unsigned xcc = xst[2], sl = xst[3], cap = (unsigned)G >> 3; unsigned v;
        if (sl < cap) v = sl * 8u + xcc;
        else { unsigned o = xb_add(&vctl[160], 1u); v = 0u;
            for (unsigned x = 0; x < 8u; ++x) { const unsigned c = min(xb_ld(&vctl[16 * x]), cap), fr = cap - c; if (o < fr) { v = (c + o) * 8u + x; break; } o -= fr; } }
        xst[2] = v;
    }
    __syncthreads();
    const int vb = (int)xst[2];
    if (IN(1)) {
        { pg8::Gemm g{(const pb*)(ws + WS_XN), (const pb*)(ws + WS_W1T), NTOK, 3584, 1024}; pg8::StaticOrder S; S.init(NTOK, 3584, G, vb);
          pg8::EpiProj E{(pb*)(ws + WS_QKVA), (pb*)(ws + WS_QKM), (pb*)(ws + WS_VM), (pb*)(ws + WS_OM), (pb*)(ws + WS_G), C2};
          pg8::gemm_phase<pg8::EpiProj, pg8::StaticOrder, true, true>(lds, g, S, E); }
        { pg8::Gemm g{(const pb*)P.out, (const pb*)(ws + WS_W1G8), NTOK, 2048, 512}; pg8::StaticOrder S; S.init(NTOK, 2048, G, vb);
          pg8::EpiGateF8 E{(pb*)(ws + WS_G)};
          pg8::gemm_phase<pg8::EpiGateF8, pg8::StaticOrder, true, true>(lds, g, S, E); }
    }
    SYNC_AFTER(1);
    if (IN(2)) { p2_attention(P, lds, lane, wave, vb); __syncthreads(); p2_mlstm_local(P, lds, tid, lane, wave, vb); }
    SYNC_AFTER(2);
    if (IN(3)) p3_mlstm_scan(P, tid, vb);
    SYNC_AFTER(3);
    if (IN(4)) p4_mlstm_out(P, lds, tid, lane, wave, vb);
    SYNC_AFTER(4);
    if (IN(5)) {
        pg8::Gemm g{(const pb*)(ws + WS_YA), (const pb*)(ws + WS_WAT), NTOK, 1024, 1024}; pg8::StaticOrder S; S.init(NTOK, 1024, G, vb);
        pg8::EpiMerged E{(pb*)(ws + WS_MERGED), (const pb*)(ws + WS_G)};
        pg8::gemm_phase<pg8::EpiMerged, pg8::StaticOrder, true, true>(lds, g, S, E);
    }
    if (IN(5) && IN(7)) GRID_BAR();
    if (IN(7)) {
        pg8::Gemm g{(const pb*)(ws + WS_MERGED), (const pb*)(ws + WS_WOT), NTOK, 1024, 1024}; pg8::StaticOrder S; S.init(NTOK, 1024, G, vb);
        pg8::EpiResidual E{P.in[0], (pb*)(ws + WS_HN), (float*)(ws + WS_SSQ1)};
        pg8::gemm_phase<pg8::EpiResidual, pg8::StaticOrder, true, true>(lds, g, S, E);
    }
    if (IN(7) && IN(9)) GRID_BAR();
    if (IN(9)) {
        pg8::Gemm g{(const pb*)(ws + WS_HN), (const pb*)(ws + WS_WQT), NTOK, 2048, 1024}; pg8::StaticOrder S; S.init(NTOK, 2048, G, vb);
        pg8::EpiStore E{(pb*)(ws + WS_Q2), 2048};
        pg8::gemm_phase<pg8::EpiStore, pg8::StaticOrder, true, true>(lds, g, S, E);
    }
    SYNC_AFTER(9);
    if (IN(10)) { p10_quant_rows(P, lane, wave, vb); p10_topk(P, lds, tid, lane, wave, vb); }
    SYNC_AFTER(10);
    if (IN(11)) { p11a_udot(P, lane, wave, vb); GRID_BAR(); p11b_weights(P, tid, vb); GRID_BAR(); p11c_vacc(P, lane, wave, vb); }
    SYNC_AFTER(11);
    if (IN(12)) {
        pg8::Gemm g{(const pb*)(ws + WS_PB), (const pb*)(ws + WS_WPT), NTOK, 1024, 256}; pg8::StaticOrder S; S.init(NTOK, 1024, G, vb);
        pg8::EpiStore E{(pb*)(ws + WS_E), 1024};
        pg8::gemm_phase<pg8::EpiStore, pg8::StaticOrder, true, true>(lds, g, S, E);
    }
    if (IN(12) && IN(13)) { asm volatile("s_waitcnt vmcnt(0)" ::: "memory"); __syncthreads(); }
    if (IN(13)) {
        pg8::Gemm g{(const pb*)(ws + WS_X2B8), (const pb*)(ws + WS_WG8), NTOK, 1024, 512}; pg8::StaticOrder S; S.init(NTOK, 1024, G, vb);
        pg8::EpiPle E{(const pb*)(ws + WS_HN), (pb*)(ws + WS_X3B), (const pb*)(ws + WS_E), (const float*)(ws + WS_SSQ)};
        pg8::gemm_phase<pg8::EpiPle, pg8::StaticOrder, true, true>(lds, g, S, E);
    }
    SYNC_AFTER(13);
    if (IN(14)) {
        const float* gf = P.in[19];
        for (int m = gw; m < NTOK; m += NGW) {
            const bf16* xr = (const bf16*)(ws + WS_X3B) + (size_t)m * 1024; float v[16]; float s = 0.f;
            unpk8(((const v4u*)xr)[2 * lane], v); unpk8(((const v4u*)xr)[2 * lane + 1], v + 8);
#pragma unroll
            for (int i = 0; i < 16; ++i) s += v[i] * v[i];
            const float rstd = rsqrtf(wave_sum(s) * (1.f / 1024.f) + EPS);
            float* orow = P.out + (size_t)m * 1024 + 16 * lane;
#pragma unroll
            for (int j = 0; j < 4; ++j) { const f32x4 g = ((const f32x4*)(gf + 16 * lane))[j]; f32x4 o; o[0] = v[4 * j] * rstd * g[0]; o[1] = v[4 * j + 1] * rstd * g[1]; o[2] = v[4 * j + 2] * rstd * g[2]; o[3] = v[4 * j + 3] * rstd * g[3]; ((f32x4*)orow)[j] = o; }
        }
    }
}

extern "C" void kernel_launch(void* const* d_in, const int* in_sizes, int n_in, void* d_out, int out_size, void* d_ws, size_t ws_size, hipStream_t stream) {
    static int grid_blocks = 0;
    if (!grid_blocks) {
        int dev = 0, cus = 0, per_cu = 0;
        (void)hipGetDevice(&dev);
        (void)hipDeviceGetAttribute(&cus, hipDeviceAttributeMultiprocessorCount, dev);
        (void)hipFuncSetAttribute((const void*)mk_fwd, hipFuncAttributeMaxDynamicSharedMemorySize, LDS_BYTES);
        (void)hipOccupancyMaxActiveBlocksPerMultiprocessor(&per_cu, mk_fwd, 512, LDS_BYTES);
        if (per_cu > 1) per_cu = 1;
        grid_blocks = cus * per_cu;
    }
    if (n_in < 20 || ws_size < WS_NEED || grid_blocks <= 0) { fprintf(stderr, "kernel_launch: bad setup (n_in %d ws %zu grid %d)\n", n_in, ws_size, grid_blocks); return; }
    Params p{};
    for (int i = 0; i < 20; ++i) p.in[i] = (const float*)d_in[i];
    p.out = (float*)d_out; p.ws = (unsigned char*)d_ws; p.ph_lo = 0; p.ph_hi = 15;
    (void)hipMemsetAsync((unsigned char*)d_ws + WS_BAR, 0, BAR_BYTES, stream);
    void* args[] = {&p};
    hipError_t e = hipLaunchCooperativeKernel((void*)mk_fwd, dim3(grid_blocks), dim3(512), args, LDS_BYTES, stream);
    if (e != hipSuccess) fprintf(stderr, "cooperative launch failed: %s (grid %d)\n", hipGetErrorString(e), grid_blocks);
}
```

```cpp
#include <hip/hip_runtime.h>
#include <hip/hip_cooperative_groups.h>
#include <cstdio>
#include <cstdint>
namespace cg = cooperative_groups;
namespace pg8 {
#define PG8_LAS __attribute__((address_space(3)))
typedef unsigned short bf16_t;
typedef short bf16x8 __attribute__((ext_vector_type(8)));
typedef float f32x4 __attribute__((ext_vector_type(4)));
typedef unsigned u32x4 __attribute__((ext_vector_type(4)));
constexpr int BM = 256, BK = 64, HALF = 128, HTB = HALF * BK * 2  , STAGE_BYTES = 8 * HTB, NXCD = 8, WGM = 8;

__host__ __device__ __forceinline__ int lds_byte(int r, int c) { const int st = (r >> 4) * 2 + (c >> 5), rr = r & 15, cc = c & 31, ob = rr * 64 + cc * 2; return st * 1024 + (ob ^ (((ob >> 9) & 1) << 5)); }
__host__ __device__ __forceinline__ void stage_rc(int b, int& R, int& C) { const int st = b / 1024, sb = b % 1024, swz = sb ^ (((sb >> 9) & 1) << 5); R = (st >> 1) * 16 + swz / 64; C = (st & 1) * 32 + (swz % 64) / 2; }
__host__ __device__ __forceinline__ int perm32(int rho) { const int n = rho >> 4, i = rho & 15; return 8 * (i >> 2) + 4 * n + (i & 3); }

struct Unit { int pm, pn; };
struct Gemm { const bf16_t* A; const bf16_t* Bt; int M, N, K; };

struct StaticOrder {
    int nM, nN, nwg, G, c;
    __host__ __device__ void init(int M, int N, int G_, int c_) { nM = M / BM; nN = N / BM; nwg = nM * nN; G = G_; c = c_; }
    __host__ __device__ bool next(int i, Unit& u) const {
        const long L = (long)i * G + c; if (L >= nwg) return false;
        int wgid = (int)L; { const int q = nwg / NXCD, r = nwg % NXCD, xcd = wgid % NXCD, off = wgid / NXCD; wgid = (xcd < r ? xcd * (q + 1) : r * (q + 1) + (xcd - r) * q) + off; }
        const int nig = WGM * nN, gid = wgid / nig, fm = gid * WGM, gsz = (nM - fm) < WGM ? (nM - fm) : WGM;
        u.pm = fm + ((wgid % nig) % gsz); u.pn = (wgid % nig) / gsz; return true;
    }
    __device__ __forceinline__ void a_ready(const Unit&) const {}
    __device__ __forceinline__ void done(const Unit&) const {}
};

__device__ __forceinline__ unsigned cvt_pk_bf16(float lo, float hi) { unsigned r; asm volatile("v_cvt_pk_bf16_f32 %0, %1, %2" : "=v"(r) : "v"(lo), "v"(hi)); return r; }
typedef float f32x2 __attribute__((ext_vector_type(2)));

__device__ __forceinline__ float sigm(float x) { return __builtin_amdgcn_rcpf(1.0f + __builtin_amdgcn_exp2f(-1.4426950408889634f * x)); }
__device__ __forceinline__ float bf_lo(unsigned w) { return __uint_as_float(w << 16); }
__device__ __forceinline__ float bf_hi(unsigned w) { return __uint_as_float(w & 0xffff0000u); }
__device__ __forceinline__ u32x4 pack8(const f32x4& v0, const f32x4& v1) { u32x4 w; w.x = cvt_pk_bf16(v0[0], v0[1]); w.y = cvt_pk_bf16(v0[2], v0[3]); w.z = cvt_pk_bf16(v1[0], v1[1]); w.w = cvt_pk_bf16(v1[2], v1[3]); return w; }
__device__ __forceinline__ void unpack8(const u32x4& w, f32x4& v0, f32x4& v1) { v0[0] = bf_lo(w.x); v0[1] = bf_hi(w.x); v0[2] = bf_lo(w.y); v0[3] = bf_hi(w.y); v1[0] = bf_lo(w.z); v1[1] = bf_hi(w.z); v1[2] = bf_lo(w.w); v1[3] = bf_hi(w.w); }

#define PG8_EPI_WALK(...) \
    _Pragma("unroll") for (int ai = 0; ai < 2; ++ai) _Pragma("unroll") for (int m = 0; m < 4; ++m) { const int row = u.pm * BM + wr * 64 + fr + ai * HALF + m * 16; \
        _Pragma("unroll") for (int bj = 0; bj < 2; ++bj) { const int ct = wc * 64 + bj * 32 + 8 * fq; f32x4 v0 = acc[ai][bj][m][0], v1 = acc[ai][bj][m][1]; __VA_ARGS__ } }

__device__ __forceinline__ u32x4 xor8_16B(u32x4 v) { u32x4 r; r.x = (unsigned)__shfl_xor((int)v.x, 8); r.y = (unsigned)__shfl_xor((int)v.y, 8); r.z = (unsigned)__shfl_xor((int)v.z, 8); r.w = (unsigned)__shfl_xor((int)v.w, 8); return r; }
__device__ __forceinline__ u32x4 bperm_16B(int src_byte, u32x4 v) { u32x4 r; r.x = (unsigned)__builtin_amdgcn_ds_bpermute(src_byte, (int)v.x); r.y = (unsigned)__builtin_amdgcn_ds_bpermute(src_byte, (int)v.y); r.z = (unsigned)__builtin_amdgcn_ds_bpermute(src_byte, (int)v.z); r.w = (unsigned)__builtin_amdgcn_ds_bpermute(src_byte, (int)v.w); return r; }
__device__ __forceinline__ void store_rows_bf16(bf16_t* O, size_t ldc, int r0, int c0, int fr, int fq, u32x4 w0, u32x4 w1) {
    const bool h = fr & 8; const u32x4 recv = xor8_16B(h ? w0 : w1);
    const u32x4 d1 = h ? recv : w0, d2 = h ? w1 : recv;
    const int lane = fr + 16 * fq, src = ((lane >> 3) + 8 * ((lane >> 2) & 1) + 16 * (lane & 3)) * 4;
    const u32x4 e1 = bperm_16B(src, d1), e2 = bperm_16B(src, d2);
    bf16_t* p = O + (size_t)(r0 + (lane >> 3)) * ldc + c0 + 8 * (lane & 7);
    *(u32x4*)p = e1; *(u32x4*)(p + 8 * ldc) = e2;
}
struct EpiProj {
    static constexpr bool PERM = true, AFTER_DRAIN = false, MIDK = false, FP8 = false; static constexpr int SCALE_B = 0x7f;
    bf16_t *qkva, *qkm, *vm, *om, *g; float c2;
    __device__ __forceinline__ void operator()(const f32x4 (&acc)[2][2][4][2], const Unit& u, int wr, int wc, int fr, int fq) const {
        const int pn = u.pn; bf16_t* base; int ldc, colt, mode = 0; float sc = 1.f;
        if (pn < 6) { base = qkva; ldc = 1536; colt = pn * 256; if (pn < 2) sc = c2; }
        else if (pn < 10) { base = qkm; ldc = 1024; colt = (pn - 6) * 256; }
        else if (pn < 12) { base = vm; ldc = 512; colt = (pn - 10) * 256; }
        else if (pn < 14) { base = om; ldc = 512; colt = (pn - 12) * 256; mode = 1; }
        else { base = g; ldc = 2048; colt = (pn - 14) * 256; mode = 1; }
#pragma unroll
        for (int ai = 0; ai < 2; ++ai)
#pragma unroll
            for (int m = 0; m < 4; ++m) { u32x4 w[2];
#pragma unroll
                for (int bj = 0; bj < 2; ++bj) { f32x4 v0 = acc[ai][bj][m][0], v1 = acc[ai][bj][m][1];
                    if (mode == 1) { _Pragma("unroll") for (int i = 0; i < 4; ++i) { v0[i] = sigm(v0[i]); v1[i] = sigm(v1[i]); } }
                    else { v0 = v0 * sc; v1 = v1 * sc; }
                    w[bj] = pack8(v0, v1); }
                store_rows_bf16(base, (size_t)ldc, u.pm * BM + wr * 64 + ai * HALF + m * 16, colt + wc * 64, fr, fq, w[0], w[1]); }
    }
};
struct EpiGateF8 {
    static constexpr bool PERM = true, AFTER_DRAIN = false, MIDK = false, FP8 = true; static constexpr int SCALE_B = 0x7b;
    bf16_t* g;
    __device__ __forceinline__ void operator()(const f32x4 (&acc)[2][2][4][2], const Unit& u, int wr, int wc, int fr, int fq) const {
#pragma unroll
        for (int ai = 0; ai < 2; ++ai)
#pragma unroll
            for (int m = 0; m < 4; ++m) { u32x4 w[2];
#pragma unroll
                for (int bj = 0; bj < 2; ++bj) { f32x4 v0 = acc[ai][bj][m][0], v1 = acc[ai][bj][m][1];
                    _Pragma("unroll") for (int i = 0; i < 4; ++i) { v0[i] = sigm(v0[i]); v1[i] = sigm(v1[i]); }
                    w[bj] = pack8(v0, v1); }
                store_rows_bf16(g, 2048, u.pm * BM + wr * 64 + ai * HALF + m * 16, u.pn * BM + wc * 64, fr, fq, w[0], w[1]); }
    }
};
struct EpiStore {
    static constexpr bool PERM = true, AFTER_DRAIN = false, MIDK = false, FP8 = false; static constexpr int SCALE_B = 0x7f;
    bf16_t* O; int ldc;
    __device__ __forceinline__ void operator()(const f32x4 (&acc)[2][2][4][2], const Unit& u, int wr, int wc, int fr, int fq) const {
#pragma unroll
        for (int ai = 0; ai < 2; ++ai)
#pragma unroll
            for (int m = 0; m < 4; ++m) store_rows_bf16(O, (size_t)ldc, u.pm * BM + wr * 64 + ai * HALF + m * 16, u.pn * BM + wc * 64, fr, fq, pack8(acc[ai][0][m][0], acc[ai][0][m][1]), pack8(acc[ai][1][m][0], acc[ai][1][m][1]));
    }
};
template <bool ADD> struct EpiGated {
    static constexpr bool PERM = true, AFTER_DRAIN = false, MIDK = false, FP8 = false; static constexpr int SCALE_B = 0x7f;
    bf16_t* O; const bf16_t* prev; const bf16_t* gate; int gcol0;
    __device__ __forceinline__ void operator()(const f32x4 (&acc)[2][2][4][2], const Unit& u, int wr, int wc, int fr, int fq) const {
#pragma unroll
        for (int ai = 0; ai < 2; ++ai)
#pragma unroll
            for (int m = 0; m < 4; ++m) { const int row = u.pm * BM + wr * 64 + fr + ai * HALF + m * 16; u32x4 w[2];
#pragma unroll
                for (int bj = 0; bj < 2; ++bj) { const int col = u.pn * BM + wc * 64 + bj * 32 + 8 * fq; f32x4 v0 = acc[ai][bj][m][0], v1 = acc[ai][bj][m][1];
                    f32x4 g0, g1; unpack8(*(const u32x4*)(gate + (size_t)row * 2048 + gcol0 + col), g0, g1);
                    v0 = v0 * g0; v1 = v1 * g1;
                    if (ADD) { f32x4 p0, p1; unpack8(*(const u32x4*)(prev + (size_t)row * 1024 + col), p0, p1); v0 = v0 + p0; v1 = v1 + p1; }
                    w[bj] = pack8(v0, v1); }
                store_rows_bf16(O, 1024, u.pm * BM + wr * 64 + ai * HALF + m * 16, u.pn * BM + wc * 64, fr, fq, w[0], w[1]); }
    }
};
struct EpiMerged {
    static constexpr bool PERM = true, AFTER_DRAIN = false, MIDK = true, FP8 = false; static constexpr int SCALE_B = 0x7f;
    bf16_t* O; const bf16_t* gate;
    __device__ __forceinline__ void mid(f32x4 (&acc)[2][2][4][2], const Unit& u, int wr, int wc, int fr, int fq) const {
#pragma unroll
        for (int ai = 0; ai < 2; ++ai)
#pragma unroll
            for (int mp = 0; mp < 2; ++mp) {
                u32x4 ga[2][2], gm[2][2];
#pragma unroll
                for (int mm = 0; mm < 2; ++mm)
#pragma unroll
                    for (int bj = 0; bj < 2; ++bj) { const size_t o = (size_t)(u.pm * BM + wr * 64 + fr + ai * HALF + (2 * mp + mm) * 16) * 2048 + u.pn * BM + wc * 64 + bj * 32 + 8 * fq;
                        ga[mm][bj] = *(const u32x4*)(gate + o); gm[mm][bj] = *(const u32x4*)(gate + o + 1024); }
#pragma unroll
                for (int mm = 0; mm < 2; ++mm)
#pragma unroll
                    for (int bj = 0; bj < 2; ++bj) { f32x4 a0, a1, m0, m1; unpack8(ga[mm][bj], a0, a1); unpack8(gm[mm][bj], m0, m1);
#pragma unroll
                        for (int i = 0; i < 4; ++i) { acc[ai][bj][2 * mp + mm][0][i] *= a0[i] * __builtin_amdgcn_rcpf(m0[i]); acc[ai][bj][2 * mp + mm][1][i] *= a1[i] * __builtin_amdgcn_rcpf(m1[i]); } }
            }
    }
    __device__ __forceinline__ void operator()(const f32x4 (&acc)[2][2][4][2], const Unit& u, int wr, int wc, int fr, int fq) const {
#pragma unroll
        for (int ai = 0; ai < 2; ++ai)
#pragma unroll
            for (int mp = 0; mp < 2; ++mp) {
                u32x4 gm[2][2];
#pragma unroll
                for (int mm = 0; mm < 2; ++mm)
#pragma unroll
                    for (int bj = 0; bj < 2; ++bj) gm[mm][bj] = *(const u32x4*)(gate + (size_t)(u.pm * BM + wr * 64 + fr + ai * HALF + (2 * mp + mm) * 16) * 2048 + 1024 + u.pn * BM + wc * 64 + bj * 32 + 8 * fq);
#pragma unroll
                for (int mm = 0; mm < 2; ++mm) { const int m = 2 * mp + mm; u32x4 w[2];
#pragma unroll
                    for (int bj = 0; bj < 2; ++bj) { f32x4 m0, m1; unpack8(gm[mm][bj], m0, m1); w[bj] = pack8(acc[ai][bj][m][0] * m0, acc[ai][bj][m][1] * m1); }
                    store_rows_bf16(O, 1024, u.pm * BM + wr * 64 + ai * HALF + m * 16, u.pn * BM + wc * 64, fr, fq, w[0], w[1]); }
            }
    }
};
struct EpiResidual {
    static constexpr bool PERM = true, AFTER_DRAIN = false, MIDK = false, FP8 = false; static constexpr int SCALE_B = 0x7f;
    const float* res; bf16_t* xb; float* ssq;
    __device__ __forceinline__ void operator()(const f32x4 (&acc)[2][2][4][2], const Unit& u, int wr, int wc, int fr, int fq) const {
#pragma unroll
        for (int ai = 0; ai < 2; ++ai)
#pragma unroll
            for (int m = 0; m < 4; ++m) { const int row = u.pm * BM + wr * 64 + fr + ai * HALF + m * 16; float s = 0.f; u32x4 wx[2];
#pragma unroll
                for (int bj = 0; bj < 2; ++bj) { const int ct = wc * 64 + bj * 32 + 8 * fq; f32x4 v0 = acc[ai][bj][m][0], v1 = acc[ai][bj][m][1];
                    const size_t o = (size_t)row * 1024 + u.pn * BM + ct; const f32x4 r0 = *(const f32x4*)(res + o), r1 = *(const f32x4*)(res + o + 4);
                    v0 = v0 + r0; v1 = v1 + r1;
                    s += (v0[0] * v0[0] + v0[1] * v0[1]) + (v0[2] * v0[2] + v0[3] * v0[3]) + (v1[0] * v1[0] + v1[1] * v1[1]) + (v1[2] * v1[2] + v1[3] * v1[3]);
                    wx[bj] = pack8(v0, v1); }
                store_rows_bf16(xb, 1024, u.pm * BM + wr * 64 + ai * HALF + m * 16, u.pn * BM + wc * 64, fr, fq, wx[0], wx[1]);
                s += __shfl_xor(s, 16); s += __shfl_xor(s, 32);
                if (fq == 0) atomicAdd(ssq + row, s);
                asm volatile("" ::: "memory"); }
    }
};
struct EpiPle {
    static constexpr bool PERM = true, AFTER_DRAIN = false, MIDK = false, FP8 = true; static constexpr int SCALE_B = 0x7b;
    const bf16_t* x2; bf16_t* x3; const bf16_t* e; const float* ssq;
    __device__ __forceinline__ void operator()(const f32x4 (&acc)[2][2][4][2], const Unit& u, int wr, int wc, int fr, int fq) const {
        const int row0 = u.pm * BM + wr * 64 + fr;
        float sq_next = ssq[row0];
#pragma unroll
        for (int ai = 0; ai < 2; ++ai)
#pragma unroll
            for (int m = 0; m < 4; ++m) { const int row = row0 + ai * HALF + m * 16; const float sq = sq_next; u32x4 wx[2];
                if (!(ai == 1 && m == 3)) sq_next = ssq[row0 + (m == 3 ? HALF : ai * HALF + (m + 1) * 16)];
                const float rstd = rsqrtf(sq * (1.0f / 1024.0f) + 1e-6f);
#pragma unroll
                for (int bj = 0; bj < 2; ++bj) { const int ct = wc * 64 + bj * 32 + 8 * fq; f32x4 v0 = acc[ai][bj][m][0] * rstd, v1 = acc[ai][bj][m][1] * rstd;
                    const size_t o = (size_t)row * 1024 + u.pn * BM + ct; f32x4 e0, e1, r0, r1; unpack8(*(const u32x4*)(e + o), e0, e1); unpack8(*(const u32x4*)(x2 + o), r0, r1);
#pragma unroll
                    for (int i = 0; i < 4; ++i) { v0[i] = r0[i] + sigm(v0[i]) * e0[i]; v1[i] = r1[i] + sigm(v1[i]) * e1[i]; }
                    wx[bj] = pack8(v0, v1); }
                store_rows_bf16(x3, 1024, u.pm * BM + wr * 64 + ai * HALF + m * 16, u.pn * BM + wc * 64, fr, fq, wx[0], wx[1]); }
    }
};

typedef int i32x8 __attribute__((ext_vector_type(8))); typedef int i32x4 __attribute__((ext_vector_type(4)));
__device__ __forceinline__ i32x8 cat8(bf16x8 a, bf16x8 b) { return __builtin_shufflevector(__builtin_bit_cast(i32x4, a), __builtin_bit_cast(i32x4, b), 0, 1, 2, 3, 4, 5, 6, 7); }
template <bool F8> struct Frag { bf16x8 v4[2]; i32x8 v8; __device__ __forceinline__ void set(bf16x8 a, bf16x8 b) { if constexpr (F8) v8 = cat8(a, b); else { v4[0] = a; v4[1] = b; } } };
template <class Epi, class Sched, bool ALIGN_EPI = false, bool SP2 = false>
__device__ __forceinline__ void gemm_phase(PG8_LAS unsigned char* lds, const Gemm g, const Sched& S, const Epi& E) {
    int tid_ = threadIdx.x; asm volatile("" : "+v"(tid_));
    const int tid = tid_, wid = __builtin_amdgcn_readfirstlane(tid >> 6), lane = tid & 63, wr = wid >> 2, wc = wid & 3, fr = lane & 15, fq = lane >> 4;
    int K_ = g.K; asm volatile("" : "+s"(K_));
    const int K = K_, nt = K / BK;
    unsigned voffA[2], voffB[2];
#pragma unroll
    for (int i = 0; i < 2; ++i) { int R, C; stage_rc(tid * 16 + i * 8192, R, C); const int Rb = Epi::PERM ? (2 * (R & ~31) + perm32(R & 31)) : R;
        voffA[i] = (unsigned)(R * K + C) * 2u; voffB[i] = (unsigned)(Rb * K + C) * 2u; }
    const size_t kstep = (size_t)(BK * 2);
    const size_t hstep = (size_t)HALF * K * 2;
    const size_t hstepB = Epi::PERM ? (size_t)32 * K * 2 : hstep;
    const size_t tstep = 2 * hstep;
    const unsigned ldsw = (unsigned)wid * 1024u;
    const int aoff = lds_byte(wr * 64 + fr, fq * 8), boff = lds_byte(wc * 32 + fr, fq * 8);
#define PG8_SA(b, h) (((b) * 2 + (h)) * HTB)
#define PG8_SB(b, h) ((4 + (b) * 2 + (h)) * HTB)
#define PG8_STAGE(bufoff, gbase, voff) do { _Pragma("unroll") for (int _i = 0; _i < 2; ++_i) \
        __builtin_amdgcn_global_load_lds((const unsigned*)((const char*)(gbase) + (voff)[_i]), (PG8_LAS unsigned*)(lds + (bufoff) + ldsw + _i * 8192), 16, 0, 0); } while (0)
#define PG8_LDA(dst, b, h) do { _Pragma("unroll") for (int m = 0; m < 4; ++m) { const bf16x8 f0_ = *(const PG8_LAS bf16x8*)(lds + PG8_SA(b, h) + aoff + m * 2048), f1_ = *(const PG8_LAS bf16x8*)(lds + PG8_SA(b, h) + aoff + m * 2048 + 1024); dst[m].set(f0_, f1_); } } while (0)
#define PG8_LDB(dst, b, h) do { _Pragma("unroll") for (int n = 0; n < 2; ++n) { const bf16x8 f0_ = *(const PG8_LAS bf16x8*)(lds + PG8_SB(b, h) + boff + n * 2048), f1_ = *(const PG8_LAS bf16x8*)(lds + PG8_SB(b, h) + boff + n * 2048 + 1024); dst[n].set(f0_, f1_); } } while (0)
#define PG8_MMA(ai, bj, At, Bt) do { __builtin_amdgcn_s_setprio(1); \
        if constexpr (Epi::FP8) { _Pragma("unroll") for (int m = 0; m < 4; ++m) _Pragma("unroll") for (int n = 0; n < 2; ++n) \
            asm volatile("v_mfma_scale_f32_16x16x128_f8f6f4 %0, %1, %2, %0, %3, %4 op_sel_hi:[0,0,0]" : "+v"(acc[ai][bj][m][n]) : "v"(Bt[n].v8), "v"(At[m].v8), "v"(sclB), "v"(sclA)); } \
        else { _Pragma("unroll") for (int m = 0; m < 4; ++m) _Pragma("unroll") for (int n = 0; n < 2; ++n) _Pragma("unroll") for (int k = 0; k < 2; ++k) \
            acc[ai][bj][m][n] = __builtin_amdgcn_mfma_f32_16x16x32_bf16(Bt[n].v4[k], At[m].v4[k], acc[ai][bj][m][n], 0, 0, 0); } \
        __builtin_amdgcn_s_setprio(0); } while (0)
#define PG8_WAIT_V(n) asm volatile("s_waitcnt vmcnt(" #n ")" ::: "memory")
#define PG8_WAIT_L(n) asm volatile("s_waitcnt lgkmcnt(" #n ")" ::: "memory")
#define PG8_BAR __builtin_amdgcn_s_barrier()
#define PG8_SCHED __builtin_amdgcn_sched_barrier(0)
    Unit cur, nxt; int ui = 0;
    if (!S.next(0, cur)) return;
    f32x4 acc[2][2][4][2];
#pragma unroll
    for (int a = 0; a < 2; ++a)
#pragma unroll
        for (int b = 0; b < 2; ++b)
#pragma unroll
            for (int m = 0; m < 4; ++m)
#pragma unroll
                for (int n = 0; n < 2; ++n) acc[a][b][m][n] = (f32x4){0.f, 0.f, 0.f, 0.f};
    Frag<Epi::FP8> At[4], B0[2], B1[2];
    const int sclB = Epi::SCALE_B, sclA = 0x7f;
    const char* cA = (const char*)g.A + (size_t)cur.pm * tstep; const char* cB = (const char*)g.Bt + (size_t)cur.pn * tstep;
    S.a_ready(cur);
    if constexpr (SP2) {
        PG8_STAGE(PG8_SB(0, 0), cB, voffB); PG8_STAGE(PG8_SB(0, 1), cB + hstepB, voffB); PG8_STAGE(PG8_SA(0, 0), cA, voffA); PG8_STAGE(PG8_SA(0, 1), cA + hstep, voffA);
        if (wr == 1) PG8_BAR;
        PG8_WAIT_V(2); PG8_BAR;
        PG8_STAGE(PG8_SB(1, 0), cB + kstep, voffB); PG8_STAGE(PG8_SA(1, 0), cA + kstep, voffA); PG8_STAGE(PG8_SB(1, 1), cB + hstepB + kstep, voffB);
        PG8_WAIT_V(6); PG8_BAR;
    } else {
        PG8_STAGE(PG8_SB(0, 0), cB, voffB); PG8_STAGE(PG8_SA(0, 0), cA, voffA); PG8_STAGE(PG8_SB(0, 1), cB + hstepB, voffB); PG8_STAGE(PG8_SA(0, 1), cA + hstep, voffA);
        if (wr == 1) PG8_BAR;
        PG8_WAIT_V(4); PG8_BAR;
        PG8_STAGE(PG8_SB(1, 0), cB + kstep, voffB); PG8_STAGE(PG8_SA(1, 0), cA + kstep, voffA); PG8_STAGE(PG8_SB(1, 1), cB + hstepB + kstep, voffB);
        PG8_WAIT_V(6); PG8_BAR;
    }
    for (;;) {
        const bool has_next = S.next(ui + 1, nxt);
        const char* nA = has_next ? (const char*)g.A + (size_t)nxt.pm * tstep : cA; const char* nB = has_next ? (const char*)g.Bt + (size_t)nxt.pn * tstep : cB;
        for (int t = 0; t < nt; t += 2) {
            if constexpr (Epi::MIDK) { if (t == (nt >> 1)) E.mid(acc, cur, wr, wc, fr, fq); }
            const bool last = (t == nt - 2);
            const char* a1 = cA + (size_t)(t + 1) * kstep;
            const char* a2 = last ? nA : cA + (size_t)(t + 2) * kstep; const char* b2 = last ? nB : cB + (size_t)(t + 2) * kstep;
            const char* a3 = a2 + kstep; const char* b3 = b2 + kstep;
            if (last && has_next) S.a_ready(nxt);
            if constexpr (SP2) {
            PG8_LDB(B0, 0, 0); PG8_LDB(B1, 0, 1); PG8_SCHED; PG8_LDA(At, 0, 0); PG8_STAGE(PG8_SA(1, 1), a1 + hstep, voffA);
            PG8_WAIT_V(8); PG8_WAIT_L(0); PG8_BAR; PG8_MMA(0, 0, At, B0); PG8_MMA(0, 1, At, B1); PG8_BAR; PG8_SCHED;
            PG8_LDA(At, 0, 1); PG8_STAGE(PG8_SB(0, 0), b2, voffB); PG8_STAGE(PG8_SB(0, 1), b2 + hstepB, voffB); PG8_STAGE(PG8_SA(0, 0), a2, voffA);
            PG8_WAIT_V(8); PG8_WAIT_L(0); PG8_BAR; PG8_MMA(1, 0, At, B0); PG8_MMA(1, 1, At, B1); PG8_BAR; PG8_SCHED;
            PG8_LDB(B0, 1, 0); PG8_LDB(B1, 1, 1); PG8_SCHED; PG8_LDA(At, 1, 0); PG8_STAGE(PG8_SA(0, 1), a2 + hstep, voffA);
            PG8_WAIT_V(8); PG8_WAIT_L(0); PG8_BAR; PG8_MMA(0, 0, At, B0); PG8_MMA(0, 1, At, B1); PG8_BAR; PG8_SCHED;
            PG8_LDA(At, 1, 1); PG8_STAGE(PG8_SB(1, 0), b3, voffB); PG8_STAGE(PG8_SB(1, 1), b3 + hstepB, voffB); PG8_STAGE(PG8_SA(1, 0), a3, voffA);
            PG8_WAIT_V(8); PG8_WAIT_L(0); PG8_BAR; PG8_MMA(1, 0, At, B0); PG8_MMA(1, 1, At, B1); PG8_BAR; PG8_SCHED;
            } else {
            PG8_LDB(B0, 0, 0); PG8_SCHED; PG8_LDA(At, 0, 0); PG8_STAGE(PG8_SA(1, 1), a1 + hstep, voffA);
            PG8_WAIT_L(8); PG8_BAR; PG8_WAIT_L(0); PG8_MMA(0, 0, At, B0); PG8_BAR; PG8_SCHED;
            PG8_LDB(B1, 0, 1); PG8_STAGE(PG8_SB(0, 0), b2, voffB);
            PG8_BAR; PG8_WAIT_L(0); PG8_MMA(0, 1, At, B1); PG8_BAR;
            PG8_LDA(At, 0, 1); PG8_STAGE(PG8_SA(0, 0), a2, voffA);
            PG8_BAR; PG8_WAIT_L(0); PG8_MMA(1, 0, At, B0); PG8_BAR; PG8_SCHED;
            PG8_STAGE(PG8_SB(0, 1), b2 + hstepB, voffB);
            PG8_WAIT_V(6); PG8_BAR; PG8_MMA(1, 1, At, B1); PG8_BAR;
            PG8_LDB(B0, 1, 0); PG8_SCHED; PG8_LDA(At, 1, 0); PG8_STAGE(PG8_SA(0, 1), a2 + hstep, voffA);
            PG8_WAIT_L(8); PG8_BAR; PG8_WAIT_L(0); PG8_MMA(0, 0, At, B0); PG8_BAR; PG8_SCHED;
            PG8_LDB(B1, 1, 1); PG8_STAGE(PG8_SB(1, 0), b3, voffB);
            PG8_BAR; PG8_WAIT_L(0); PG8_MMA(0, 1, At, B1); PG8_BAR;
            PG8_LDA(At, 1, 1); PG8_STAGE(PG8_SA(1, 0), a3, voffA);
            PG8_BAR; PG8_WAIT_L(0); PG8_MMA(1, 0, At, B0); PG8_BAR; PG8_SCHED;
            PG8_STAGE(PG8_SB(1, 1), b3 + hstepB, voffB);
            PG8_WAIT_V(6); PG8_BAR; PG8_MMA(1, 1, At, B1); PG8_BAR;
            }
        }
        if constexpr (ALIGN_EPI) { if (wr == 0) PG8_BAR; }
        if constexpr (!Epi::AFTER_DRAIN) { E(acc, cur, wr, wc, fr, fq); S.done(cur); }
        if (!has_next) break;
#pragma unroll
        for (int a = 0; a < 2; ++a)
#pragma unroll
            for (int b = 0; b < 2; ++b)
#pragma unroll
                for (int m = 0; m < 4; ++m)
#pragma unroll
                    for (int n = 0; n < 2; ++n) acc[a][b][m][n] = (f32x4){0.f, 0.f, 0.f, 0.f};
        cur = nxt; cA = nA; cB = nB; ++ui;
        if constexpr (ALIGN_EPI) { if (wr == 1) PG8_BAR; }
    }
    PG8_WAIT_V(0);
    if constexpr (!ALIGN_EPI) { if (wr == 0) PG8_BAR; }
    PG8_BAR;
    if constexpr (Epi::AFTER_DRAIN) { E.fused(acc, cur, wr, wc, fr, fq, lds, wid, lane); S.done(cur); }
#undef PG8_SA
#undef PG8_SB
#undef PG8_STAGE
#undef PG8_LDA
#undef PG8_LDB
#undef PG8_MMA
#undef PG8_WAIT_V
#undef PG8_WAIT_L
#undef PG8_BAR
#undef PG8_SCHED
}
}

#define GAS __attribute__((address_space(1)))
#define LAS __attribute__((address_space(3)))
typedef unsigned short bf16;
typedef unsigned v4u __attribute__((ext_vector_type(4)));
typedef unsigned v2u __attribute__((ext_vector_type(2)));
typedef float f32x4 __attribute__((ext_vector_type(4)));
using pg8::bf_lo; using pg8::bf_hi; using pg8::sigm;

constexpr int NTOK = 32768, SEQ = 16384, DM = 1024, NW = 8;
constexpr float EPS = 1e-6f;
constexpr float C2 = 0.125f * 1.4426950408889634f;
constexpr size_t MiB = 1u << 20;
constexpr size_t WS_W1T = 1 * MiB, WS_WAT = 12 * MiB, WS_WMT = 13 * MiB, WS_WOT = 14 * MiB, WS_WQT = 16 * MiB, WS_WGT = 20 * MiB, WS_WPT = 22 * MiB;
constexpr size_t WS_K1B = 22 * MiB + 512 * 1024, WS_K2B = 22 * MiB + 768 * 1024, WS_IF = 23 * MiB, WS_UB = 24 * MiB, WS_VB = 56 * MiB;
constexpr size_t WS_XN = 88 * MiB, WS_YA = 88 * MiB, WS_YM = 120 * MiB, WS_HN = 88 * MiB;
constexpr size_t WS_QKVA = 152 * MiB, WS_QKM = 248 * MiB, WS_VM = 312 * MiB, WS_OM = 344 * MiB, WS_G = 376 * MiB;
constexpr size_t WS_DN = 504 * MiB, WS_NS = 505 * MiB, WS_SC = 506 * MiB;
constexpr size_t WS_MERGED = 152 * MiB, WS_TMP = 216 * MiB, WS_Q2 = 376 * MiB, WS_IDX = 152 * MiB, WS_GATE = 168 * MiB, WS_HN2 = 184 * MiB, WS_PB = 56 * MiB, WS_E = 264 * MiB;
constexpr size_t WS_NEED = 507 * MiB;
constexpr size_t WS_U8 = 24 * MiB, WS_V8 = 40 * MiB, WS_PART = 376 * MiB, WS_SSQ = 506 * MiB + 512 * 1024;
constexpr size_t WS_HQH = 280 * MiB, WS_HQL = 296 * MiB, WS_HS = 312 * MiB;
constexpr size_t WS_W1G8 = 74 * MiB;
constexpr size_t WS_X2B8 = 184 * MiB, WS_WG8 = 72 * MiB;
constexpr size_t WS_X3B = 376 * MiB;
constexpr size_t WS_U4 = 24 * MiB, WS_V4 = 32 * MiB, WS_SU = 40 * MiB, WS_SV = 40 * MiB + 65536;
constexpr size_t WS_SSQ1 = 506 * MiB + 768 * 1024, WS_BAR = 0, BAR_BYTES = 32768;
constexpr size_t OUT_DC = 0, OUT_CS = 64 * MiB;
constexpr int LDS_BYTES = 152576;

__device__ __forceinline__ unsigned f2bf(float f) { unsigned u = __float_as_uint(f); return (u + 0x7fffu + ((u >> 16) & 1u)) >> 16; }
__device__ __forceinline__ unsigned pk2(float lo, float hi) { return f2bf(lo) | (f2bf(hi) << 16); }
__device__ __forceinline__ float bf2f(bf16 b) { return __uint_as_float((unsigned)b << 16); }
__device__ __forceinline__ float wave_sum(float v) {
#pragma unroll
    for (int o = 1; o < 64; o <<= 1) v += __shfl_xor(v, o);
    return v;
}
__device__ __forceinline__ float wave_max(float v) {
#pragma unroll
    for (int o = 1; o < 64; o <<= 1) v = fmaxf(v, __shfl_xor(v, o));
    return v;
}
__device__ __forceinline__ void unpk8(const v4u w, float* f) { f[0] = bf_lo(w.x); f[1] = bf_hi(w.x); f[2] = bf_lo(w.y); f[3] = bf_hi(w.y); f[4] = bf_lo(w.z); f[5] = bf_hi(w.z); f[6] = bf_lo(w.w); f[7] = bf_hi(w.w); }
__device__ __forceinline__ v4u pk8(const float* f) { v4u w; w.x = pk2(f[0], f[1]); w.y = pk2(f[2], f[3]); w.z = pk2(f[4], f[5]); w.w = pk2(f[6], f[7]); return w; }
typedef __bf16 bf16x2_t __attribute__((ext_vector_type(2)));
__device__ __forceinline__ float dot2bf(unsigned a, unsigned b, float c) { return __builtin_amdgcn_fdot2_f32_bf16(__builtin_bit_cast(bf16x2_t, a), __builtin_bit_cast(bf16x2_t, b), c, false); }
__device__ __forceinline__ float logsigmoid(float x) { return fminf(x, 0.f) - log1pf(__expf(-fabsf(x))); }
__device__ __forceinline__ float silu(float x) { return x * __builtin_amdgcn_rcpf(1.0f + __builtin_amdgcn_exp2f(-1.4426950408889634f * x)); }

#define XB_TMO      128
#define XB_XCNT(j)  (256  + 64 * (j))
#define XB_XSUB(j)  (1280 + 64 * (j))
#define XB_XGEN(j)  (2304 + 64 * (j))
#define XB_TOP      3328
#define XB_TOPGEN   3392
#define XCD_BAR_WORDS 3456
#define XB_SPIN_CAP (1u << 18)

__device__ __forceinline__ unsigned xb_ld(unsigned* p)              { return __hip_atomic_load(p, __ATOMIC_RELAXED, __HIP_MEMORY_SCOPE_AGENT); }
__device__ __forceinline__ unsigned xb_add(unsigned* p, unsigned v) { return __hip_atomic_fetch_add(p, v, __ATOMIC_RELAXED, __HIP_MEMORY_SCOPE_AGENT); }
__device__ __forceinline__ unsigned xb_xcc_id() { return (unsigned)__builtin_amdgcn_s_getreg((3 << 11) | 20) & 0xFu; }
#define XB_SPIN(cond, bar) do { unsigned _sp = 0; while (cond) { __builtin_amdgcn_s_sleep(1); \
    if ((++_sp & 255u) == 0u) { if (xb_ld(&(bar)[XB_TMO])) break; if (_sp > XB_SPIN_CAP) { atomicAdd(&(bar)[XB_TMO], 1u); break; } } } } while (0)

struct XcdBarrier {
    unsigned* bar; unsigned x;
    volatile LAS unsigned* st;
};

__device__ __forceinline__ XcdBarrier xcd_barrier_post(unsigned* bar, volatile LAS unsigned* st) {
    XcdBarrier b; b.bar = bar; b.x = xb_xcc_id(); b.st = st;
    if (threadIdx.x == 0) (void)xb_add(&bar[XB_XCNT(b.x)], 1u);
    return b;
}
__device__ __forceinline__ void xcd_barrier_complete(unsigned* bar, unsigned x, unsigned& nloc, unsigned& nx) {
    const unsigned G = gridDim.x * gridDim.y * gridDim.z;
    unsigned sum, cnt, mine, sp = 0u;
    for (;;) {
        sum = 0u; cnt = 0u; mine = 0u;
#pragma unroll
        for (unsigned j = 0; j < 16; ++j) { const unsigned c = xb_ld(&bar[XB_XCNT(j)]); sum += c; cnt += (c > 0u) ? 1u : 0u; mine = (j == x) ? c : mine; }
        if (sum == G) break;
        __builtin_amdgcn_s_sleep(1);
        if ((++sp & 255u) == 0u) { if (xb_ld(&bar[XB_TMO])) break; if (sp > XB_SPIN_CAP) { atomicAdd(&bar[XB_TMO], 1u); break; } }
    }
    nloc = mine > 0u ? mine : 1u; nx = cnt > 0u ? cnt : 1u;
}

__device__ __forceinline__ void xcd_barrier(const XcdBarrier& b) {
    asm volatile("s_waitcnt vmcnt(0)" ::: "memory");
    __syncthreads();
    if (threadIdx.x == 0) {
        unsigned* bar = b.bar;
        __builtin_amdgcn_s_waitcnt(0);
        unsigned nloc = b.st[0], nx = b.st[1];
        if (nloc == 0u) { xcd_barrier_complete(bar, b.x, nloc, nx); b.st[0] = nloc; b.st[1] = nx; }
        const unsigned old = xb_add(&bar[XB_XSUB(b.x)], 1u);
        const unsigned gen = old / nloc;
        if (old + 1u == (gen + 1u) * nloc) {
            __builtin_amdgcn_fence(__ATOMIC_RELEASE, "agent");
            asm volatile("s_waitcnt vmcnt(0)" ::: "memory");
            const unsigned og = xb_add(&bar[XB_TOP], 1u);
            const unsigned tg = og / nx;
            if (og + 1u == (tg + 1u) * nx) xb_add(&bar[XB_TOPGEN], 1u);
            else XB_SPIN(xb_ld(&bar[XB_TOPGEN]) == tg, bar);
            __builtin_amdgcn_fence(__ATOMIC_ACQUIRE, "agent");
            xb_add(&bar[XB_XGEN(b.x)], 1u);
            asm volatile("s_waitcnt vmcnt(0)" ::: "memory");
        } else {
            XB_SPIN(xb_ld(&bar[XB_XGEN(b.x)]) == gen, bar);
            __builtin_amdgcn_fence(__ATOMIC_ACQUIRE, "agent");
            asm volatile("s_waitcnt vmcnt(0)" ::: "memory");
        }
    }
    __syncthreads();
}


struct Params { const float* in[20]; float* out; unsigned char* ws; int ph_lo, ph_hi; };

__device__ __forceinline__ void transpose_item(const float* W, int ldw, int col0, int K, bf16* WT, int row0, LAS float* scr, int item, int nblk, int lane, int koff = 0, const float* kgain = nullptr, unsigned char* WT8 = nullptr, float sc8 = 1.0f) {
    const int kb = item / nblk, nb = item % nblk, k0 = 64 * kb, n0 = 32 * nb;
#pragma unroll 8
    for (int i = 0; i < 32; ++i) { const int kk = 2 * i + (lane >> 5); const float gk = kgain ? kgain[k0 + kk] : 1.0f; scr[kk * 33 + (lane & 31)] = W[(size_t)(k0 + kk) * ldw + col0 + n0 + (lane & 31)] * gk; }
    asm volatile("s_waitcnt lgkmcnt(0)" ::: "memory");
    const int c = lane & 7;
#pragma unroll
    for (int j = 0; j < 4; ++j) { const int n = (lane >> 3) + 8 * j; const LAS float* s = scr + (8 * c) * 33 + n;
        v4u o; o.x = pk2(s[0 * 33], s[1 * 33]); o.y = pk2(s[2 * 33], s[3 * 33]); o.z = pk2(s[4 * 33], s[5 * 33]); o.w = pk2(s[6 * 33], s[7 * 33]);
        *(v4u*)(WT + (size_t)(row0 + n0 + n) * K + koff + k0 + 8 * c) = o;
        if (WT8) { int p0 = __builtin_amdgcn_cvt_pk_fp8_f32(s[0 * 33] * sc8, s[1 * 33] * sc8, 0, false); p0 = __builtin_amdgcn_cvt_pk_fp8_f32(s[2 * 33] * sc8, s[3 * 33] * sc8, p0, true);
            int p1 = __builtin_amdgcn_cvt_pk_fp8_f32(s[4 * 33] * sc8, s[5 * 33] * sc8, 0, false); p1 = __builtin_amdgcn_cvt_pk_fp8_f32(s[6 * 33] * sc8, s[7 * 33] * sc8, p1, true);
            *(uint2*)(WT8 + (size_t)(row0 + n0 + n) * K + koff + k0 + 8 * c) = make_uint2((unsigned)p0, (unsigned)p1); } }
    asm volatile("s_waitcnt lgkmcnt(0)" ::: "memory");
}
__device__ __forceinline__ void cvt_f32_bf16(const float* src, bf16* dst, size_t n4, size_t gtid, size_t gsz) {
    for (size_t i = gtid; i < n4; i += gsz) { const f32x4 v = ((const f32x4*)src)[i]; uint2 o; o.x = pk2(v[0], v[1]); o.y = pk2(v[2], v[3]); ((uint2*)dst)[i] = o; }
}
__device__ __forceinline__ void cvt_f32_fp8(const float* src, unsigned* dst, size_t n4, float sc, size_t gtid, size_t gsz) {
    for (size_t i = gtid; i < n4; i += gsz) { const f32x4 v = ((const f32x4*)src)[i]; int w = __builtin_amdgcn_cvt_pk_fp8_f32(v[0] * sc, v[1] * sc, 0, false); w = __builtin_amdgcn_cvt_pk_fp8_f32(v[2] * sc, v[3] * sc, w, true); dst[i] = (unsigned)w; }
}
__device__ __forceinline__ void rms_row_to_bf16(const float* xrow, const float* gain, bf16* orow, int lane) {
    f32x4 v[4]; float s = 0.f;
#pragma unroll
    for (int j = 0; j < 4; ++j) { v[j] = ((const f32x4*)xrow)[lane + 64 * j]; s += (v[j][0] * v[j][0] + v[j][1] * v[j][1]) + (v[j][2] * v[j][2] + v[j][3] * v[j][3]); }
    const float rstd = rsqrtf(wave_sum(s) * (1.f / 1024.f) + EPS);
#pragma unroll
    for (int j = 0; j < 4; ++j) { const f32x4 g = ((const f32x4*)gain)[lane + 64 * j]; uint2 o; o.x = pk2(v[j][0] * rstd * g[0], v[j][1] * rstd * g[1]); o.y = pk2(v[j][2] * rstd * g[2], v[j][3] * rstd * g[3]); ((uint2*)orow)[lane + 64 * j] = o; }
}
__device__ __forceinline__ void p0_prologue(const Params& P, LAS unsigned char* lds, int tid, int lane, int wave) {
    unsigned char* ws = P.ws;
    const int gw = blockIdx.x * NW + wave, NGW = gridDim.x * NW;
    LAS float* scr = (LAS float*)(lds + wave * 8448);
    LAS float* wif = (LAS float*)(lds + 69632);
    const float* w_in = P.in[3];
    for (int i = tid; i < 8192; i += 512) wif[i] = w_in[(size_t)(i >> 3) * 5640 + 3584 + (i & 7)];
    __syncthreads();
    constexpr int I1A = 16 * 112, I1B = 16 * 64, IUP = 8 * 32, IOUT = 16 * 32, IQ = 16 * 64, IPL = 4 * 32;
    constexpr int NITEMS = I1A + I1B + 2 * IUP + IOUT + IQ + IOUT + IPL;
    for (int it = gw; it < NITEMS; it += NGW) {
        int r = it;
        if (r < I1A) { transpose_item(w_in, 5640, 0, 1024, (bf16*)(ws + WS_W1T), 0, scr, r, 112, lane); continue; } r -= I1A;
        if (r < I1B) { transpose_item(w_in, 5640, 3592, 1024, (bf16*)(ws + WS_W1T), 3584, scr, r, 64, lane, 0, nullptr, ws + WS_W1G8 - (size_t)3584 * 1024, 16.0f); continue; } r -= I1B;
        if (r < IUP) { transpose_item(P.in[7], 1024, 0, 1024, (bf16*)(ws + WS_WAT), 0, scr, r, 32, lane, 0); continue; } r -= IUP;
        if (r < IUP) { transpose_item(P.in[8], 1024, 0, 1024, (bf16*)(ws + WS_WAT), 0, scr, r, 32, lane, 512); continue; } r -= IUP;
        if (r < IOUT) { transpose_item(P.in[9], 1024, 0, 1024, (bf16*)(ws + WS_WOT), 0, scr, r, 32, lane); continue; } r -= IOUT;
        if (r < IQ) { transpose_item(P.in[11], 2048, 0, 1024, (bf16*)(ws + WS_WQT), 0, scr, r, 64, lane, 0, P.in[10]); continue; } r -= IQ;
        if (r < IOUT) { transpose_item(P.in[17], 1024, 0, 1024, (bf16*)(ws + WS_WGT), 0, scr, r, 32, lane, 0, P.in[16], ws + WS_WG8, 16.0f); continue; } r -= IOUT;
        transpose_item(P.in[18], 1024, 0, 256, (bf16*)(ws + WS_WPT), 0, scr, r, 32, lane);
    }
    const size_t gtid = (size_t)blockIdx.x * 512 + tid, gsz = (size_t)gridDim.x * 512;
    cvt_f32_bf16(P.in[12], (bf16*)(ws + WS_K1B), 8 * 128 * 128 / 4, gtid, gsz);
    cvt_f32_bf16(P.in[13], (bf16*)(ws + WS_K2B), 8 * 128 * 128 / 4, gtid, gsz);
    f32x4 egn[4]; { const float* gf = P.in[10]; egn[0] = ((const f32x4*)gf)[2 * lane]; egn[1] = ((const f32x4*)gf)[2 * lane + 1]; egn[2] = ((const f32x4*)gf)[128 + 2 * lane]; egn[3] = ((const f32x4*)gf)[128 + 2 * lane + 1]; }
    f32x4 vnx[4];
    if (gw < 2 * 16384) { const float* src = P.in[14 + (gw >> 14)] + (size_t)(gw & 16383) * 1024; vnx[0] = ((const f32x4*)src)[2 * lane]; vnx[1] = ((const f32x4*)src)[2 * lane + 1]; vnx[2] = ((const f32x4*)src)[128 + 2 * lane]; vnx[3] = ((const f32x4*)src)[128 + 2 * lane + 1]; }
    for (int rw = gw; rw < 2 * 16384; rw += NGW) {
        const int tb_ = rw >> 14, e = rw & 16383;
        f32x4 v[4]; v[0] = vnx[0]; v[1] = vnx[1]; v[2] = vnx[2]; v[3] = vnx[3];
        if (rw + NGW < 2 * 16384) { const int rn = rw + NGW; const float* src = P.in[14 + (rn >> 14)] + (size_t)(rn & 16383) * 1024; vnx[0] = ((const f32x4*)src)[2 * lane]; vnx[1] = ((const f32x4*)src)[2 * lane + 1]; vnx[2] = ((const f32x4*)src)[128 + 2 * lane]; vnx[3] = ((const f32x4*)src)[128 + 2 * lane + 1]; }
        if (!tb_) { v[0] = v[0] * egn[0]; v[1] = v[1] * egn[1]; v[2] = v[2] * egn[2]; v[3] = v[3] * egn[3]; }
        float mx = 0.f, sq = 0.f;
#pragma unroll
        for (int j = 0; j < 4; ++j)
#pragma unroll
            for (int i = 0; i < 4; ++i) { mx = fmaxf(mx, fabsf(v[j][i])); sq += v[j][i] * v[j][i]; }
        mx = wave_max(mx);
        unsigned w0 = 0u, w1 = 0u; float sc;
        if (tb_) {
            sc = mx > 0.f ? mx * (1.0f / 6.0f) : 1.0f; const float inv = 1.0f / sc;
            w0 = __builtin_amdgcn_cvt_scalef32_pk_fp4_f32(w0, v[0][0] * inv, v[0][1] * inv, 1.0f, 0); w0 = __builtin_amdgcn_cvt_scalef32_pk_fp4_f32(w0, v[0][2] * inv, v[0][3] * inv, 1.0f, 1);
            w0 = __builtin_amdgcn_cvt_scalef32_pk_fp4_f32(w0, v[1][0] * inv, v[1][1] * inv, 1.0f, 2); w0 = __builtin_amdgcn_cvt_scalef32_pk_fp4_f32(w0, v[1][2] * inv, v[1][3] * inv, 1.0f, 3);
            w1 = __builtin_amdgcn_cvt_scalef32_pk_fp4_f32(w1, v[2][0] * inv, v[2][1] * inv, 1.0f, 0); w1 = __builtin_amdgcn_cvt_scalef32_pk_fp4_f32(w1, v[2][2] * inv, v[2][3] * inv, 1.0f, 1);
            w1 = __builtin_amdgcn_cvt_scalef32_pk_fp4_f32(w1, v[3][0] * inv, v[3][1] * inv, 1.0f, 2); w1 = __builtin_amdgcn_cvt_scalef32_pk_fp4_f32(w1, v[3][2] * inv, v[3][3] * inv, 1.0f, 3);
        } else {
            const float rms = sqrtf(wave_sum(sq) * (1.0f / 1024.0f)); const float clip = fminf(mx, 2.8f * rms);
            sc = clip > 0.f ? clip * (1.0f / 7.0f) : 1.0f; const float inv = 1.0f / sc;
#pragma unroll
            for (int i = 0; i < 4; ++i) { const int q0 = (int)fminf(fmaxf(rintf(v[0][i] * inv), -7.f), 7.f), q1 = (int)fminf(fmaxf(rintf(v[1][i] * inv), -7.f), 7.f), q2 = (int)fminf(fmaxf(rintf(v[2][i] * inv), -7.f), 7.f), q3 = (int)fminf(fmaxf(rintf(v[3][i] * inv), -7.f), 7.f);
                w0 |= ((unsigned)q0 & 15u) << (4 * i); w0 |= ((unsigned)q1 & 15u) << (16 + 4 * i); w1 |= ((unsigned)q2 & 15u) << (4 * i); w1 |= ((unsigned)q3 & 15u) << (16 + 4 * i); }
        }
        unsigned* dst = (unsigned*)(ws + (tb_ ? WS_V4 : WS_U4)) + (size_t)e * 128;
        dst[lane] = w0; dst[64 + lane] = w1;
        if (lane == 0) ((float*)(ws + (tb_ ? WS_SV : WS_SU)))[e] = sc;
    }
    cvt_f32_bf16(P.in[1], (bf16*)(ws + WS_PB), (size_t)NTOK * 256 / 4, gtid, gsz);
    for (size_t i = gtid; i < (size_t)NTOK; i += gsz) { ((float*)(ws + WS_SSQ))[i] = 0.f; ((float*)(ws + WS_SSQ1))[i] = 0.f; }
    const float* x = P.in[0]; const float* gmix = P.in[2]; const float* gbias = P.in[5];
    bf16* XN = (bf16*)(ws + WS_XN); float* IFb = (float*)(ws + WS_IF);
    f32x4 xgn[4], xnx[4];
#pragma unroll
    for (int j = 0; j < 4; ++j) { xgn[j] = ((const f32x4*)gmix)[lane + 64 * j]; if (gw < NTOK) xnx[j] = ((const f32x4*)(x + (size_t)gw * 1024))[lane + 64 * j]; }
    for (int m = gw; m < NTOK; m += NGW) {
        f32x4 v[4];
#pragma unroll
        for (int j = 0; j < 4; ++j) v[j] = xnx[j];
        if (m + NGW < NTOK) {
#pragma unroll
            for (int j = 0; j < 4; ++j) xnx[j] = ((const f32x4*)(x + (size_t)(m + NGW) * 1024))[lane + 64 * j];
        }
        float a16[16];
#pragma unroll
        for (int i = 0; i < 16; ++i) a16[i] = 0.f;
#pragma unroll
        for (int j = 0; j < 4; ++j) {
            const f32x4 g = xgn[j];
#pragma unroll
            for (int i = 0; i < 4; ++i) { a16[0] += v[j][i] * v[j][i]; v[j][i] *= g[i]; const int d = 4 * (lane + 64 * j) + i; const f32x4 wa = *(const LAS f32x4*)(wif + d * 8), wb = *(const LAS f32x4*)(wif + d * 8 + 4);
                a16[1] += v[j][i] * wa[0]; a16[2] += v[j][i] * wa[1]; a16[3] += v[j][i] * wa[2]; a16[4] += v[j][i] * wa[3]; a16[5] += v[j][i] * wb[0]; a16[6] += v[j][i] * wb[1]; a16[7] += v[j][i] * wb[2]; a16[8] += v[j][i] * wb[3]; }
        }
        float r8[8], r4[4], r2[2], r1;
        { const bool b = lane & 32;
#pragma unroll
          for (int i = 0; i < 8; ++i) { const float keep = b ? a16[8 + i] : a16[i], send = b ? a16[i] : a16[8 + i]; r8[i] = keep + __shfl_xor(send, 32); } }
        { const bool b = lane & 16;
#pragma unroll
          for (int i = 0; i < 4; ++i) { const float keep = b ? r8[4 + i] : r8[i], send = b ? r8[i] : r8[4 + i]; r4[i] = keep + __shfl_xor(send, 16); } }
        { const bool b = lane & 8;
#pragma unroll
          for (int i = 0; i < 2; ++i) { const float keep = b ? r4[2 + i] : r4[i], send = b ? r4[i] : r4[2 + i]; r2[i] = keep + __shfl_xor(send, 8); } }
        { const bool b = lane & 4; const float keep = b ? r2[1] : r2[0], send = b ? r2[0] : r2[1]; r1 = keep + __shfl_xor(send, 4); }
        r1 += __shfl_xor(r1, 2); r1 += __shfl_xor(r1, 1);
        const float rstd = rsqrtf(__shfl(r1, 0) * (1.f / 1024.f) + EPS);
#pragma unroll
        for (int j = 0; j < 4; ++j) { uint2 o; o.x = pk2(v[j][0] * rstd, v[j][1] * rstd); o.y = pk2(v[j][2] * rstd, v[j][3] * rstd); ((uint2*)(XN + (size_t)m * 1024))[lane + 64 * j] = o;
            int p8 = __builtin_amdgcn_cvt_pk_fp8_f32(v[j][0] * rstd, v[j][1] * rstd, 0, false); p8 = __builtin_amdgcn_cvt_pk_fp8_f32(v[j][2] * rstd, v[j][3] * rstd, p8, true); ((int*)((unsigned char*)P.out + (size_t)m * 1024))[lane + 64 * j] = p8; }
        const int which = ((lane >> 5) & 1) * 8 + ((lane >> 4) & 1) * 4 + ((lane >> 3) & 1) * 2 + ((lane >> 2) & 1);
        if ((lane & 3) == 0 && which >= 1 && which <= 8) IFb[(size_t)m * 8 + which - 1] = r1 * rstd + gbias[which - 1];
    }
}

typedef short bf16x8 __attribute__((ext_vector_type(8)));
typedef short v4i16 __attribute__((ext_vector_type(4)));
#define MFMA16(a, b, c) __builtin_amdgcn_mfma_f32_16x16x32_bf16((a), (b), (c), 0, 0, 0)
__device__ __forceinline__ void attn_pair_params(int pp, int& d, int& n0, int& sh) {
    if (pp < 5) { d = 16; sh = 4; n0 = -144 + 32 * pp; } else if (pp < 11) { d = 4; sh = 2; n0 = -128 + 32 * (pp - 5); } else { d = 1; sh = 0; n0 = -128 + 32 * (pp - 11); }
}
template <int MODE> __device__ __forceinline__ void attn_unit_params(int pp, int& d, int& n0, int& sh) {
    if (MODE == 0) { d = 1; sh = 0; n0 = -144 + 32 * pp; }
    else if (pp < 5) { d = 16; sh = 4; n0 = -144 + 32 * pp; } else { d = 4; sh = 2; n0 = -128 + 32 * (pp - 5); }
}
#define ATT_LOAD(SET, PPX) do { if ((PPX) < NP) { int d_, n_, sh_; attn_unit_params<MODE>((PPX), d_, n_, sh_); \
    _Pragma("unroll") for (int c = 0; c < 4; ++c) { int tok = t0 + d_ * (n_ + 8 * c + lrow); tok = min(max(tok, 0), SEQ - 1); const bf16* rp = base + 512 + (size_t)tok * 1536 + 8 * lch; \
        kr[SET][c] = *(const v4u*)rp; vr[SET][c] = *(const v4u*)(rp + 512); } } } while (0)
template <int MODE> __device__ __forceinline__ void attn_unit(const bf16* base, bf16* yrow0, int t0, int xidx, LAS float* partl, LAS unsigned char* kbuf, LAS unsigned char* vbuf, int lane) {
    constexpr int NP = MODE == 0 ? 5 : 11, NPAD = MODE == 0 ? 8 : 12;
    const int r = lane & 15, g = lane >> 4, lrow = lane >> 3, lch = lane & 7;
    const int trq = (lane >> 2) & 3, trp = lane & 3, tr_off = (4 * g + trq) * 160 + trp * 8;
    const int tq = MODE == 0 ? t0 + r : t0 + 16 * r;
    const bf16x8 qb0 = *(const bf16x8*)(base + (size_t)tq * 1536 + 8 * g), qb1 = *(const bf16x8*)(base + (size_t)tq * 1536 + 32 + 8 * g);
    f32x4 o[4]; float m, l;
    LAS float* xrow = partl + (MODE == 0 ? xidx + r : xidx + 16 * r) * 68;
    if (MODE == 0) {
#pragma unroll
        for (int i = 0; i < 4; ++i) o[i] = (f32x4){0.f, 0.f, 0.f, 0.f};
        m = -1e30f; l = 0.f;
    } else {
#pragma unroll
        for (int i = 0; i < 4; ++i) o[i] = *(const LAS f32x4*)(xrow + 16 * i + 4 * g);
        m = xrow[64]; l = g == 0 ? xrow[65] : 0.f;
    }
    v4u kr[4][4], vr[4][4];
    ATT_LOAD(0, 0); ATT_LOAD(1, 1); ATT_LOAD(2, 2); ATT_LOAD(3, 3);
#pragma unroll 1
    for (int pp0 = 0; pp0 < NPAD; pp0 += 4) {
#pragma unroll
        for (int u = 0; u < 4; ++u) {
            const int pp = pp0 + u;
            if (pp < NP) {
                int d, n0, sh; attn_unit_params<MODE>(pp, d, n0, sh);
                const int hi = MODE == 0 ? r : (r << (4 - sh)), lo = max(hi - 128, -(t0 >> sh));
                const int mbase = n0 + 4 * g - lo; const unsigned mspan = (unsigned)(hi - lo);
#pragma unroll
                for (int c = 0; c < 4; ++c) { *(LAS v4u*)(kbuf + (8 * c + lrow) * 144 + lch * 16) = kr[u][c]; *(LAS v4u*)(vbuf + (8 * c + lrow) * 160 + lch * 16) = vr[u][c]; }
                ATT_LOAD(u, pp + 4);
                f32x4 s0 = {0.f, 0.f, 0.f, 0.f}, s1 = {0.f, 0.f, 0.f, 0.f};
                { const bf16x8 k00 = *(const LAS bf16x8*)(kbuf + r * 144 + g * 16), k01 = *(const LAS bf16x8*)(kbuf + r * 144 + 64 + g * 16);
                  const bf16x8 k10 = *(const LAS bf16x8*)(kbuf + (16 + r) * 144 + g * 16), k11 = *(const LAS bf16x8*)(kbuf + (16 + r) * 144 + 64 + g * 16);
                  s0 = MFMA16(k00, qb0, s0); s0 = MFMA16(k01, qb1, s0); s1 = MFMA16(k10, qb0, s1); s1 = MFMA16(k11, qb1, s1); }
                float mx = -INFINITY;
#pragma unroll
                for (int k = 0; k < 4; ++k) { s0[k] = ((unsigned)(mbase + k) <= mspan) ? s0[k] : -INFINITY; s1[k] = ((unsigned)(mbase + 16 + k) <= mspan) ? s1[k] : -INFINITY; mx = fmaxf(mx, fmaxf(s0[k], s1[k])); }
                mx = fmaxf(mx, __shfl_xor(mx, 16)); mx = fmaxf(mx, __shfl_xor(mx, 32));
                if (__any(mx > m)) {
                    const float mn = fmaxf(m, mx), alpha = __builtin_amdgcn_exp2f(m - mn); m = mn; l *= alpha;
#pragma unroll
                    for (int i = 0; i < 4; ++i) o[i] = o[i] * alpha;
                }
                float p0[4], p1[4], ps = 0.f;
#pragma unroll
                for (int k = 0; k < 4; ++k) { p0[k] = __builtin_amdgcn_exp2f(s0[k] - m); p1[k] = __builtin_amdgcn_exp2f(s1[k] - m); ps += p0[k] + p1[k]; }
                l += ps;
                bf16x8 pb; { v4u w; w.x = pg8::cvt_pk_bf16(p0[0], p0[1]); w.y = pg8::cvt_pk_bf16(p0[2], p0[3]); w.z = pg8::cvt_pk_bf16(p1[0], p1[1]); w.w = pg8::cvt_pk_bf16(p1[2], p1[3]); pb = __builtin_bit_cast(bf16x8, w); }
                LAS unsigned char* vrd = vbuf + tr_off;
#pragma unroll
                for (int db = 0; db < 4; ++db) {
                    const v4i16 a0 = __builtin_amdgcn_ds_read_tr16_b64_v4i16((LAS v4i16*)(vrd + db * 32)), a1 = __builtin_amdgcn_ds_read_tr16_b64_v4i16((LAS v4i16*)(vrd + 16 * 160 + db * 32));
                    const bf16x8 va = __builtin_shufflevector(a0, a1, 0, 1, 2, 3, 4, 5, 6, 7);
                    o[db] = MFMA16(va, pb, o[db]);
                }
            }
        }
    }
    l += __shfl_xor(l, 16); l += __shfl_xor(l, 32);
    if (MODE == 0) {
#pragma unroll
        for (int i = 0; i < 4; ++i) *(LAS f32x4*)(xrow + 16 * i + 4 * g) = o[i];
        if (g == 0) { xrow[64] = m; xrow[65] = l; }
    } else {
        const float inv = __builtin_amdgcn_rcpf(l);
        bf16* yo = yrow0 + (size_t)tq * 1024 + 4 * g;
#pragma unroll
        for (int db = 0; db < 4; ++db) { uint2 w; w.x = pk2(o[db][0] * inv, o[db][1] * inv); w.y = pk2(o[db][2] * inv, o[db][3] * inv); *(uint2*)(yo + 16 * db) = w; }
    }
}
typedef float f32x16 __attribute__((ext_vector_type(16)));
#define MFMA32(a, b, c) __builtin_amdgcn_mfma_f32_32x32x16_bf16((a), (b), (c), 0, 0, 0)
#define ATT32_LOAD(SET, PPX) do { const int n_ = -128 + 32 * (PPX); \
    _Pragma("unroll") for (int c = 0; c < 4; ++c) { int tok = t0 + D * (n_ + 8 * c + lrow); tok = min(max(tok, 0), SEQ - 1); const bf16* rp = base + 512 + (size_t)tok * 1536 + 8 * lch; \
        kr[SET][c] = *(const v4u*)rp; vr[SET][c] = *(const v4u*)(rp + 512); } } while (0)
template <int STAGE> __device__ __forceinline__ void attn32_unit(const bf16* base, bf16* yrow0, int blk0, int u, LAS unsigned char* xtab, LAS unsigned char* kbuf, LAS unsigned char* vbuf, int lane) {
    constexpr int SH = STAGE == 0 ? 0 : (STAGE == 1 ? 2 : 4), D = 1 << SH;
    const int qoff = STAGE == 0 ? 32 * u : (STAGE == 1 ? (u & 3) + 128 * (u >> 2) : u);
    const int t0 = blk0 + qoff;
    const int qi = lane & 31, h = lane >> 5, lrow = lane >> 3, lch = lane & 7;
    const int G = lane >> 4, trq = (lane >> 2) & 3, trp = lane & 3;
    const int tr_off = (4 * (G >> 1) + trq) * 160 + (16 * (G & 1) + 4 * trp) * 2;
    const int tq = t0 + D * qi;
    bf16x8 qb[4];
#pragma unroll
    for (int ks = 0; ks < 4; ++ks) qb[ks] = *(const bf16x8*)(base + (size_t)tq * 1536 + 16 * ks + 8 * h);
    LAS unsigned char* xrow = xtab + (qoff + D * qi) * 144;
    f32x16 o[2]; float m, l;
    if (STAGE == 0) {
#pragma unroll
        for (int i = 0; i < 16; ++i) { o[0][i] = 0.f; o[1][i] = 0.f; }
        m = -1e30f; l = 0.f;
    } else {
#pragma unroll
        for (int mb = 0; mb < 2; ++mb)
#pragma unroll
            for (int gq = 0; gq < 4; ++gq) { const v2u w = *(const LAS v2u*)(xrow + 2 * (32 * mb + 8 * gq + 4 * h)); o[mb][4 * gq] = bf_lo(w.x); o[mb][4 * gq + 1] = bf_hi(w.x); o[mb][4 * gq + 2] = bf_lo(w.y); o[mb][4 * gq + 3] = bf_hi(w.y); }
        m = *(const LAS float*)(xrow + 128); l = h == 0 ? *(const LAS float*)(xrow + 132) : 0.f;
    }
    const int hi = qi, lo = max(qi - 128, -(t0 >> SH));
    const unsigned mspan = (unsigned)(hi - lo);
    v4u kr[3][4], vr[3][4];
    ATT32_LOAD(0, 0); ATT32_LOAD(1, 1); ATT32_LOAD(2, 2);
#pragma unroll
    for (int pp = 0; pp < 5; ++pp) {
        const int set = pp % 3, n0 = -128 + 32 * pp;
#pragma unroll
        for (int c = 0; c < 4; ++c) { *(LAS v4u*)(kbuf + (8 * c + lrow) * 144 + lch * 16) = kr[set][c]; *(LAS v4u*)(vbuf + (8 * c + lrow) * 160 + lch * 16) = vr[set][c]; }
        if (pp + 3 < 5) ATT32_LOAD(set, pp + 3);
        f32x16 sc;
#pragma unroll
        for (int i = 0; i < 16; ++i) sc[i] = 0.f;
#pragma unroll
        for (int ks = 0; ks < 4; ++ks) { const bf16x8 ka = *(const LAS bf16x8*)(kbuf + qi * 144 + 32 * ks + 16 * h); sc = MFMA32(ka, qb[ks], sc); }
        const int mbase = n0 + 4 * h - lo; float mx = -INFINITY;
#pragma unroll
        for (int rg = 0; rg < 16; ++rg) { sc[rg] = ((unsigned)(mbase + (rg & 3) + 8 * (rg >> 2)) <= mspan) ? sc[rg] : -INFINITY; mx = fmaxf(mx, sc[rg]); }
        mx = fmaxf(mx, __shfl_xor(mx, 32));
        if (__any(mx > m)) {
            const float mn = fmaxf(m, mx), alpha = __builtin_amdgcn_exp2f(m - mn); m = mn; l *= alpha;
#pragma unroll
            for (int i = 0; i < 16; ++i) { o[0][i] *= alpha; o[1][i] *= alpha; }
        }
        float ps = 0.f;
#pragma unroll
        for (int rg = 0; rg < 16; ++rg) { sc[rg] = __builtin_amdgcn_exp2f(sc[rg] - m); ps += sc[rg]; }
        l += ps;
        bf16x8 pb[2];
#pragma unroll
        for (int s2 = 0; s2 < 2; ++s2) { v4u w; w.x = pg8::cvt_pk_bf16(sc[8 * s2], sc[8 * s2 + 1]); w.y = pg8::cvt_pk_bf16(sc[8 * s2 + 2], sc[8 * s2 + 3]); w.z = pg8::cvt_pk_bf16(sc[8 * s2 + 4], sc[8 * s2 + 5]); w.w = pg8::cvt_pk_bf16(sc[8 * s2 + 6], sc[8 * s2 + 7]); pb[s2] = __builtin_bit_cast(bf16x8, w); }
#pragma unroll
        for (int mb = 0; mb < 2; ++mb)
#pragma unroll
            for (int s2 = 0; s2 < 2; ++s2) {
                LAS unsigned char* vp = vbuf + tr_off + (16 * s2) * 160 + 64 * mb;
                const v4i16 a0 = __builtin_amdgcn_ds_read_tr16_b64_v4i16((LAS v4i16*)vp), a1 = __builtin_amdgcn_ds_read_tr16_b64_v4i16((LAS v4i16*)(vp + 8 * 160));
                const bf16x8 va = __builtin_shufflevector(a0, a1, 0, 1, 2, 3, 4, 5, 6, 7);
                o[mb] = MFMA32(va, pb[s2], o[mb]);
            }
    }
    l += __shfl_xor(l, 32);
    if (STAGE < 2) {
#pragma unroll
        for (int mb = 0; mb < 2; ++mb)
#pragma unroll
            for (int gq = 0; gq < 4; ++gq) { v2u w; w.x = pk2(o[mb][4 * gq], o[mb][4 * gq + 1]); w.y = pk2(o[mb][4 * gq + 2], o[mb][4 * gq + 3]); *(LAS v2u*)(xrow + 2 * (32 * mb + 8 * gq + 4 * h)) = w; }
        if (h == 0) { *(LAS float*)(xrow + 128) = m; *(LAS float*)(xrow + 132) = l; }
    } else {
        const float inv = __builtin_amdgcn_rcpf(l);
        bf16* yo = yrow0 + (size_t)tq * 1024 + 4 * h;
#pragma unroll
        for (int mb = 0; mb < 2; ++mb)
#pragma unroll
            for (int gq = 0; gq < 4; ++gq) { uint2 w; w.x = pk2(o[mb][4 * gq] * inv, o[mb][4 * gq + 1] * inv); w.y = pk2(o[mb][4 * gq + 2] * inv, o[mb][4 * gq + 3] * inv); *(uint2*)(yo + 32 * mb + 8 * gq) = w; }
    }
}
__device__ __forceinline__ void p2_attention(const Params& P, LAS unsigned char* lds, int lane, int wave, int vb) {
    const bf16* QKVA = (const bf16*)(P.ws + WS_QKVA); bf16* YA = (bf16*)(P.ws + WS_YA);
    LAS unsigned char* kbuf = lds + wave * 9728;
    LAS unsigned char* vbuf = kbuf + 4608;
    LAS unsigned char* xtab = lds + 8 * 9728;
    for (int wi = vb; wi < 512; wi += gridDim.x) {
        const int bh = wi >> 5, tb = wi & 31, b = bh >> 3, h = bh & 7;
        const bf16* base = QKVA + (size_t)b * SEQ * 1536 + h * 64;
        bf16* yrow0 = YA + (size_t)b * SEQ * 1024 + h * 64;
#pragma unroll 1
        for (int uu = 0; uu < 2; ++uu) attn32_unit<0>(base, yrow0, tb * 512, wave * 2 + uu, xtab, kbuf, vbuf, lane);
        __syncthreads();
#pragma unroll 1
        for (int uu = 0; uu < 2; ++uu) attn32_unit<1>(base, yrow0, tb * 512, wave * 2 + uu, xtab, kbuf, vbuf, lane);
        __syncthreads();
#pragma unroll 1
        for (int uu = 0; uu < 2; ++uu) attn32_unit<2>(base, yrow0, tb * 512, wave * 2 + uu, xtab, kbuf, vbuf, lane);
        __syncthreads();
    }
}

__device__ __forceinline__ float conv_silu(const bf16* QKM, const float* cw, int b, int t, int ch) {
    float a = 0.f;
#pragma unroll
    for (int j = 0; j < 4; ++j) { const int tt = t - 3 + j; if (tt >= 0) a += cw[j * 1024 + ch] * bf2f(QKM[((size_t)b * SEQ + tt) * 1024 + ch]); }
    return silu(a);
}

__device__ __forceinline__ float scan_add(float v, int lane) {
#pragma unroll
    for (int o = 1; o < 64; o <<= 1) { const float u = __shfl_up(v, o); if (lane >= o) v += u; }
    return v;
}
__device__ __forceinline__ float scan_max(float v, int lane) {
#pragma unroll
    for (int o = 1; o < 64; o <<= 1) { const float u = __shfl_up(v, o); if (lane >= o) v = fmaxf(v, u); }
    return v;
}
__device__ __forceinline__ void conv16(const bf16* QKM, const float* cw, int b, int t0, int chan, float* out) {
    const bf16* src = QKM + (size_t)b * SEQ * 1024 + chan;
    const float w0 = cw[chan], w1 = cw[1024 + chan], w2 = cw[2048 + chan], w3 = cw[3072 + chan];
    float x0 = t0 >= 3 ? bf2f(src[(size_t)(t0 - 3) * 1024]) : 0.f, x1 = t0 >= 2 ? bf2f(src[(size_t)(t0 - 2) * 1024]) : 0.f, x2 = t0 >= 1 ? bf2f(src[(size_t)(t0 - 1) * 1024]) : 0.f;
#pragma unroll
    for (int i = 0; i < 16; ++i) { const float x3 = bf2f(src[(size_t)(t0 + i) * 1024]); out[i] = silu(w0 * x0 + w1 * x1 + w2 * x2 + w3 * x3); x0 = x1; x1 = x2; x2 = x3; }
}

__device__ __forceinline__ void p2_mlstm_local(const Params& P, LAS unsigned char* lds, int tid, int lane, int wave, int vb) {
    const bf16* QKM = (const bf16*)(P.ws + WS_QKM); const bf16* VM = (const bf16*)(P.ws + WS_VM); const float* IFb = (const float*)(P.ws + WS_IF);
    const float* cw = P.in[4];
    bf16* DC = (bf16*)((unsigned char*)P.out + OUT_DC); float* DN = (float*)(P.ws + WS_DN); float* SC = (float*)(P.ws + WS_SC);
    LAS bf16* KWT = (LAS bf16*)lds; LAS bf16* VT = (LAS bf16*)(lds + 18432); LAS float* sw = (LAS float*)(lds + 36864);
    const int r = lane & 15, g = lane >> 4;
    for (int item = vb; item < 2048; item += gridDim.x) {
        const int bh = item >> 8, c = item & 255, b = bh >> 2, h = bh & 3;
        if (wave == 0) {
            const size_t row = (size_t)b * SEQ + c * 64 + lane;
            const float lf = logsigmoid(IFb[row * 8 + 4 + h]), ip = IFb[row * 8 + h];
            const float bc = scan_add(lf, lane), gg = __shfl(bc, 63), ds = gg - bc + ip, ml = wave_max(ds);
            sw[lane] = __expf(ds - ml);
            if (lane == 0) { SC[item] = ml; SC[2048 + item] = gg; }
        }
        __syncthreads();
        { const int ch = tid & 127, sq = tid >> 7, s0 = sq * 16; float o[16];
          conv16(QKM, cw, b, c * 64 + s0, 512 + h * 128 + ch, o);
#pragma unroll
          for (int i = 0; i < 16; i += 2) *(LAS unsigned*)(KWT + ch * 72 + s0 + i) = pk2(o[i] * 0.08838834764831845f * sw[s0 + i], o[i + 1] * 0.08838834764831845f * sw[s0 + i + 1]);
          const bf16* vsrc = VM + ((size_t)b * SEQ + c * 64 + s0) * 512 + h * 128 + ch;
#pragma unroll
          for (int i = 0; i < 16; i += 2) *(LAS unsigned*)(VT + ch * 72 + s0 + i) = (unsigned)vsrc[(size_t)i * 512] | ((unsigned)vsrc[(size_t)(i + 1) * 512] << 16);
        }
        __syncthreads();
        {
          const bf16x8 vb0 = *(const LAS bf16x8*)(VT + (16 * wave + r) * 72 + 8 * g), vb1 = *(const LAS bf16x8*)(VT + (16 * wave + r) * 72 + 32 + 8 * g);
          bf16* dst = DC + (size_t)item * 16384 + (size_t)(16 * wave + r) * 128 + 4 * g;
#pragma unroll
          for (int eb = 0; eb < 8; ++eb) {
              const bf16x8 ka0 = *(const LAS bf16x8*)(KWT + (16 * eb + r) * 72 + 8 * g), ka1 = *(const LAS bf16x8*)(KWT + (16 * eb + r) * 72 + 32 + 8 * g);
              f32x4 acc = {0.f, 0.f, 0.f, 0.f};
              acc = MFMA16(ka0, vb0, acc); acc = MFMA16(ka1, vb1, acc);
              uint2 o; o.x = pk2(acc[0], acc[1]); o.y = pk2(acc[2], acc[3]); *(uint2*)(dst + 16 * eb) = o;
          }
        }
        if (tid < 128) { float a = 0.f;
#pragma unroll
            for (int cc = 0; cc < 8; ++cc) { float f[8]; unpk8(*(const LAS v4u*)(KWT + tid * 72 + 8 * cc), f);
#pragma unroll
                for (int k = 0; k < 8; ++k) a += f[k]; }
            DN[(size_t)item * 128 + tid] = a; }
        __syncthreads();
    }
}

__device__ __forceinline__ void p3_mlstm_scan(const Params& P, int tid, int vb) {
    const unsigned* __restrict__ DC = (const unsigned*)((unsigned char*)P.out + OUT_DC); unsigned* __restrict__ CS = (unsigned*)((unsigned char*)P.out + OUT_CS);
    const float* __restrict__ DN = (const float*)(P.ws + WS_DN); float* __restrict__ NS = (float*)(P.ws + WS_NS); float* SC = (float*)(P.ws + WS_SC);
    for (int gid = vb * 512 + tid; gid < 8 * 8192; gid += gridDim.x * 512) {
        const int bh = gid >> 13, idx = gid & 8191; const bool hasn = idx < 64;
        float C0 = 0.f, C1 = 0.f, n0 = 0.f, n1 = 0.f, m = 0.f;
        for (int j0 = 0; j0 < 256; j0 += 16) {
            unsigned d[16]; float ml[16], gg[16]; float2 dn[16];
#pragma unroll
            for (int u = 0; u < 16; ++u) { const int item = bh * 256 + j0 + u; d[u] = DC[(size_t)item * 8192 + idx]; ml[u] = SC[item]; gg[u] = SC[2048 + item];
                dn[u] = hasn ? *(const float2*)(DN + (size_t)item * 128 + 2 * idx) : make_float2(0.f, 0.f); }
#pragma unroll
            for (int u = 0; u < 16; ++u) { const int item = bh * 256 + j0 + u;
                CS[(size_t)item * 8192 + idx] = pk2(C0, C1);
                if (hasn) *(float2*)(NS + (size_t)item * 128 + 2 * idx) = make_float2(n0, n1);
                if (idx == 0) SC[4096 + item] = m;
                const float mn = fmaxf(gg[u] + m, ml[u]), a = __expf(gg[u] + m - mn), bb = __expf(ml[u] - mn);
                C0 = a * C0 + bb * bf_lo(d[u]); C1 = a * C1 + bb * bf_hi(d[u]); n0 = a * n0 + bb * dn[u].x; n1 = a * n1 + bb * dn[u].y; m = mn; }
        }
    }
}

struct P4Pref { v4u raw[7]; v4u cs[4]; uint2 om[4]; f32x4 gn; float ifa, ifb, nsv; };
__device__ __forceinline__ void p4_prefetch_raw(P4Pref& pf, const Params& P, int item, int tid, int lane) {
    const bf16* QKM = (const bf16*)(P.ws + WS_QKM); const bf16* VM = (const bf16*)(P.ws + WS_VM); const float* IFb = (const float*)(P.ws + WS_IF); const float* NS = (const float*)(P.ws + WS_NS);
    const int bh = item >> 8, c = item & 255, b = bh >> 2, h = bh & 3;
#pragma unroll
    for (int i = 0; i < 7; ++i) { const int v = tid + 512 * i; const int rr = v / 48, rem = v - rr * 48, seg = rem >> 4, c16 = rem & 15; const int t = c * 64 + rr - 3;
        v4u val = {0u, 0u, 0u, 0u};
        if (v < 3216 && t >= 0) val = (seg < 2) ? *(const v4u*)(QKM + ((size_t)b * SEQ + t) * 1024 + seg * 512 + h * 128 + 8 * c16) : *(const v4u*)(VM + ((size_t)b * SEQ + t) * 512 + h * 128 + 8 * c16);
        pf.raw[i] = val; }
    const size_t row = (size_t)b * SEQ + c * 64 + lane;
    pf.ifa = IFb[row * 8 + 4 + h]; pf.ifb = IFb[row * 8 + h];
    pf.nsv = NS[(size_t)item * 128 + (tid & 127)];
}
__device__ __forceinline__ void p4_prefetch_cs(P4Pref& pf, const Params& P, int item, int lane, int wave) {
    const bf16* CS = (const bf16*)((unsigned char*)P.out + OUT_CS);
    const bf16* crow = CS + (size_t)item * 16384 + (size_t)(16 * wave + (lane & 15)) * 128 + 8 * (lane >> 4);
#pragma unroll
    for (int ks = 0; ks < 4; ++ks) pf.cs[ks] = *(const v4u*)(crow + 32 * ks);
}
__device__ __forceinline__ void p4_prefetch_om(P4Pref& pf, const Params& P, int item, int lane, int wave) {
    const bf16* OM = (const bf16*)(P.ws + WS_OM);
    const int bh = item >> 8, c = item & 255, b = bh >> 2, h = bh & 3, r = lane & 15, g = lane >> 4;
#pragma unroll
    for (int tb = 0; tb < 4; ++tb) pf.om[tb] = *(const uint2*)(OM + ((size_t)b * SEQ + c * 64 + 16 * tb + r) * 512 + h * 128 + 16 * wave + 4 * g);
    pf.gn = *(const f32x4*)(P.in[6] + h * 128 + 16 * wave + 4 * g);
}
__device__ __forceinline__ void p4_mlstm_out(const Params& P, LAS unsigned char* lds, int tid, int lane, int wave, int vb) {
    const float* cw = P.in[4]; const float* SC = (const float*)(P.ws + WS_SC); bf16* YM = (bf16*)(P.ws + WS_YA);
    LAS float* CW = (LAS float*)lds;
    LAS unsigned char* RAW = lds + 16384;
    LAS bf16* Qs = (LAS bf16*)(lds + 68912); LAS bf16* Ks = (LAS bf16*)(lds + 86320); LAS bf16* VT = (LAS bf16*)(lds + 103728); LAS bf16* PT = (LAS bf16*)(lds + 122160);
    LAS float* sm = (LAS float*)(lds + 131376);
    LAS bf16* NSB = (LAS bf16*)(lds + 135728);
    const int r = lane & 15, g = lane >> 4;
    for (int i = tid; i < 1024; i += 512) ((LAS f32x4*)CW)[i] = ((const f32x4*)cw)[i];
    P4Pref pf;
    if (vb < 2048) { p4_prefetch_raw(pf, P, vb, tid, lane); p4_prefetch_cs(pf, P, vb, lane, wave); p4_prefetch_om(pf, P, vb, lane, wave); }
    for (int item = vb; item < 2048; item += gridDim.x) {
        const int bh = item >> 8, c = item & 255, b = bh >> 2, h = bh & 3;
#pragma unroll
        for (int i = 0; i < 7; ++i) { const int v = tid + 512 * i; if (v < 3216) { const int rr = v / 48, rem = v - rr * 48; *(LAS v4u*)(RAW + rr * 784 + rem * 16) = pf.raw[i]; } }
        if (tid < 128) NSB[tid] = (bf16)f2bf(pf.nsv);
        if (wave == 0) {
            const float lf = logsigmoid(pf.ifa), ip = pf.ifb;
            const float bc = scan_add(lf, lane), a = ip - bc, pm = scan_max(a, lane), ms = SC[4096 + item], M = fmaxf(ms, pm);
            sm[lane] = a; sm[64 + lane] = M; sm[128 + lane] = __expf(ms - M); sm[192 + lane] = __expf(-bc - M);
        }
        __syncthreads();
        { const int g4 = tid & 31, s0 = (tid >> 5) * 4;
#pragma unroll
          for (int tile = 0; tile < 2; ++tile) {
              float x[7][4];
#pragma unroll
              for (int j = 0; j < 7; ++j) { const v2u rv = *(const LAS v2u*)(RAW + (s0 + j) * 784 + tile * 256 + g4 * 8); x[j][0] = bf_lo(rv.x); x[j][1] = bf_hi(rv.x); x[j][2] = bf_lo(rv.y); x[j][3] = bf_hi(rv.y); }
              f32x4 w[4];
#pragma unroll
              for (int tp = 0; tp < 4; ++tp) w[tp] = *(const LAS f32x4*)(CW + tp * 1024 + tile * 512 + h * 128 + 4 * g4);
              const float sc = tile ? 0.08838834764831845f : 1.0f; LAS bf16* dst = tile ? Ks : Qs;
#pragma unroll
              for (int j = 0; j < 4; ++j) { float y[4];
#pragma unroll
                  for (int i = 0; i < 4; ++i) y[i] = silu(w[0][i] * x[j][i] + w[1][i] * x[j + 1][i] + w[2][i] * x[j + 2][i] + w[3][i] * x[j + 3][i]) * sc;
                  v2u o; o.x = pk2(y[0], y[1]); o.y = pk2(y[2], y[3]); *(LAS v2u*)(dst + (s0 + j) * 136 + 4 * g4) = o; }
          }
          const int ch = tid & 127, sv = (tid >> 7) * 16;
#pragma unroll
          for (int i = 0; i < 16; i += 2) { const unsigned lo = *(const LAS bf16*)(RAW + (3 + sv + i) * 784 + 512 + ch * 2), hi = *(const LAS bf16*)(RAW + (4 + sv + i) * 784 + 512 + ch * 2);
              *(LAS unsigned*)(VT + ch * 72 + sv + i) = lo | (hi << 16); }
        }
        asm volatile("" ::: "memory");
        if (item + (int)gridDim.x < 2048) p4_prefetch_raw(pf, P, item + gridDim.x, tid, lane);
        __syncthreads();
        { const int sb = wave >> 1;
          bf16x8 ka[4];
#pragma unroll
          for (int ks = 0; ks < 4; ++ks) ka[ks] = *(const LAS bf16x8*)(Ks + (16 * sb + r) * 136 + 32 * ks + 8 * g);
#pragma unroll
          for (int tt = 0; tt < 2; ++tt) { const int tb = 2 * (wave & 1) + tt, t = 16 * tb + r;
              f32x4 acc = {0.f, 0.f, 0.f, 0.f};
#pragma unroll
              for (int ks = 0; ks < 4; ++ks) { const bf16x8 qb = *(const LAS bf16x8*)(Qs + t * 136 + 32 * ks + 8 * g); acc = MFMA16(ka[ks], qb, acc); }
              const float Mt = sm[64 + t]; float p[4], ps = 0.f;
#pragma unroll
              for (int k = 0; k < 4; ++k) { const int s = 16 * sb + 4 * g + k; p[k] = (s <= t) ? acc[k] * __expf(sm[s] - Mt) : 0.f; ps += p[k]; }
              v2u o; o.x = pk2(p[0], p[1]); o.y = pk2(p[2], p[3]); *(LAS v2u*)(PT + t * 72 + 16 * sb + 4 * g) = o;
              ps += __shfl_xor(ps, 16); ps += __shfl_xor(ps, 32);
              if (g == 0) sm[320 + sb * 64 + t] = ps; }
        }
        __syncthreads();
        f32x4 ai[4], ac[4], an[4];
#pragma unroll
        for (int tb = 0; tb < 4; ++tb) { ai[tb] = (f32x4){0.f, 0.f, 0.f, 0.f}; ac[tb] = (f32x4){0.f, 0.f, 0.f, 0.f}; an[tb] = (f32x4){0.f, 0.f, 0.f, 0.f}; }
        { const bf16x8 va0 = *(const LAS bf16x8*)(VT + (16 * wave + r) * 72 + 8 * g), va1 = *(const LAS bf16x8*)(VT + (16 * wave + r) * 72 + 32 + 8 * g);
          const bf16x8 ca0 = __builtin_bit_cast(bf16x8, pf.cs[0]), ca1 = __builtin_bit_cast(bf16x8, pf.cs[1]), ca2 = __builtin_bit_cast(bf16x8, pf.cs[2]), ca3 = __builtin_bit_cast(bf16x8, pf.cs[3]);
          const bf16x8 zero8 = {0, 0, 0, 0, 0, 0, 0, 0};
#pragma unroll
          for (int tb = 0; tb < 4; ++tb) { const int t = 16 * tb + r;
              const bf16x8 pb0 = *(const LAS bf16x8*)(PT + t * 72 + 8 * g), pb1 = *(const LAS bf16x8*)(PT + t * 72 + 32 + 8 * g);
              ai[tb] = MFMA16(va0, pb0, ai[tb]); ai[tb] = MFMA16(va1, pb1, ai[tb]);
              const bf16x8 q0 = *(const LAS bf16x8*)(Qs + t * 136 + 8 * g), q1 = *(const LAS bf16x8*)(Qs + t * 136 + 32 + 8 * g), q2 = *(const LAS bf16x8*)(Qs + t * 136 + 64 + 8 * g), q3 = *(const LAS bf16x8*)(Qs + t * 136 + 96 + 8 * g);
              ac[tb] = MFMA16(ca0, q0, ac[tb]); ac[tb] = MFMA16(ca1, q1, ac[tb]); ac[tb] = MFMA16(ca2, q2, ac[tb]); ac[tb] = MFMA16(ca3, q3, ac[tb]);
              if (wave == 0) {
                  const bf16x8 n0 = r == 0 ? *(const LAS bf16x8*)(NSB + 8 * g) : zero8, n1 = r == 0 ? *(const LAS bf16x8*)(NSB + 32 + 8 * g) : zero8, n2 = r == 0 ? *(const LAS bf16x8*)(NSB + 64 + 8 * g) : zero8, n3 = r == 0 ? *(const LAS bf16x8*)(NSB + 96 + 8 * g) : zero8;
                  an[tb] = MFMA16(n0, q0, an[tb]); an[tb] = MFMA16(n1, q1, an[tb]); an[tb] = MFMA16(n2, q2, an[tb]); an[tb] = MFMA16(n3, q3, an[tb]);
                  if (g == 0) { const float den = sm[128 + t] * an[tb][0] + (sm[320 + t] + sm[384 + t]) + (sm[448 + t] + sm[512 + t]); sm[256 + t] = fmaxf(fabsf(den), sm[192 + t]); } } }
        }
        asm volatile("" ::: "memory");
        if (item + (int)gridDim.x < 2048) p4_prefetch_cs(pf, P, item + gridDim.x, lane, wave);
#pragma unroll
        for (int tb = 0; tb < 4; ++tb) { const int t = 16 * tb + r; const float wi = sm[128 + t]; float s2 = 0.f;
#pragma unroll
            for (int k = 0; k < 4; ++k) { ai[tb][k] = wi * ac[tb][k] + ai[tb][k]; s2 += ai[tb][k] * ai[tb][k]; }
            s2 += __shfl_xor(s2, 16); s2 += __shfl_xor(s2, 32);
            if (g == 0) sm[576 + wave * 64 + t] = s2; }
        __syncthreads();
        {
#pragma unroll
          for (int tb = 0; tb < 4; ++tb) { const int t = 16 * tb + r; float tot = 0.f;
#pragma unroll
              for (int w = 0; w < 8; ++w) tot += sm[576 + w * 64 + t];
              const float inv = __builtin_amdgcn_rcpf(sm[256 + t]), rs = inv * rsqrtf(tot * inv * inv * (1.f / 128.f) + EPS);
              const size_t row = (size_t)b * SEQ + c * 64 + t; const int col = h * 128 + 16 * wave + 4 * g;
              uint2 o; o.x = pk2(ai[tb][0] * rs * pf.gn[0] * bf_lo(pf.om[tb].x), ai[tb][1] * rs * pf.gn[1] * bf_hi(pf.om[tb].x)); o.y = pk2(ai[tb][2] * rs * pf.gn[2] * bf_lo(pf.om[tb].y), ai[tb][3] * rs * pf.gn[3] * bf_hi(pf.om[tb].y));
              *(uint2*)(YM + row * 1024 + 512 + col) = o; }
        }
        asm volatile("" ::: "memory");
        if (item + (int)gridDim.x < 2048) p4_prefetch_om(pf, P, item + gridDim.x, lane, wave);
        __syncthreads();
    }
}

__device__ __forceinline__ int f2ord(float f) { const int b = __float_as_int(f); return b ^ ((b >> 31) & 0x7fffffff); }
__device__ __forceinline__ float ord2f(int o) { return __int_as_float(o ^ ((o >> 31) & 0x7fffffff)); }
#define CE_DESC(a, i, j) { const int _h = max(a[i], a[j]), _l = min(a[i], a[j]); a[i] = _h; a[j] = _l; }
__device__ __forceinline__ void sort16_desc(int (&a)[16]) {
#pragma unroll
    for (int k = 2; k <= 16; k <<= 1) {
#pragma unroll
        for (int j = k >> 1; j > 0; j >>= 1) {
#pragma unroll
            for (int i = 0; i < 16; ++i) { const int l = i ^ j; if (l > i) { if ((i & k) == 0) CE_DESC(a, i, l) else CE_DESC(a, l, i) } }
        }
    }
}
__device__ __forceinline__ void merge16_desc(int (&a)[16], const int (&b)[16]) {
#pragma unroll
    for (int i = 0; i < 16; ++i) a[i] = max(a[i], b[15 - i]);
#pragma unroll
    for (int j = 8; j > 0; j >>= 1) {
#pragma unroll
        for (int i = 0; i < 16; ++i) { const int l = i ^ j; if (l > i) CE_DESC(a, i, l) }
    }
}
__device__ __forceinline__ void xmerge16(int (&a)[16], int mask) {
    int b[16];
#pragma unroll
    for (int i = 0; i < 16; ++i) b[i] = __shfl_xor(a[i], mask);
    merge16_desc(a, b);
}
__device__ __forceinline__ void p10_quant_rows(const Params& P, int lane, int wave, int vb) {
    const bf16* HN = (const bf16*)(P.ws + WS_HN); unsigned* HQH = (unsigned*)(P.ws + WS_HQH); unsigned* HQL = (unsigned*)(P.ws + WS_HQL); float* HS = (float*)(P.ws + WS_HS);
    for (int t = vb * NW + wave; t < NTOK; t += gridDim.x * NW) {
        float y[16]; unpk8(((const v4u*)(HN + (size_t)t * 1024))[2 * lane], y); unpk8(((const v4u*)(HN + (size_t)t * 1024))[2 * lane + 1], y + 8);
        float cm = 0.f;
#pragma unroll
        for (int i = 0; i < 16; ++i) cm = fmaxf(cm, fabsf(y[i]));
        cm = fmaxf(cm, __shfl_xor(cm, 1));
        const float sc = cm > 0.f ? cm * (1.0f / 119.0f) : 1.0f, inv = 1.0f / sc; unsigned dh[2] = {0u, 0u}, dl[2] = {0u, 0u};
#pragma unroll
        for (int i = 0; i < 16; ++i) { const int h = (int)rintf(y[i] * inv), lo = ((h + 8) & 15) - 8;
            dl[i >> 3] |= ((unsigned)lo & 15u) << (4 * (i & 7)); dh[i >> 3] |= ((unsigned)((h - lo) >> 4) & 15u) << (4 * (i & 7)); }
        *(uint2*)(HQH + (size_t)t * 128 + 2 * lane) = make_uint2(dh[0], dh[1]); *(uint2*)(HQL + (size_t)t * 128 + 2 * lane) = make_uint2(dl[0], dl[1]);
        if ((lane & 1) == 0) HS[(size_t)t * 32 + (lane >> 1)] = sc;
    }
}
__device__ __forceinline__ void p10_topk(const Params& P, LAS unsigned char* lds, int tid, int lane, int wave, int vb) {
    const bf16* Q2 = (const bf16*)(P.ws + WS_Q2); const bf16* K1B = (const bf16*)(P.ws + WS_K1B); const bf16* K2B = (const bf16*)(P.ws + WS_K2B);
    int* IDX = (int*)(P.ws + WS_IDX); float* GATE = (float*)(P.ws + WS_GATE); const float* SSQ1 = (const float*)(P.ws + WS_SSQ1);
    LAS bf16* Kl = (LAS bf16*)lds;
    LAS int* Tb = (LAS int*)(lds + 69632 + wave * 2048);
    const int r = lane & 15, g = lane >> 4;
    const int h = vb & 7, wgx = vb >> 3, nwg = gridDim.x >> 3;
    __syncthreads();
    for (int i = tid; i < 4096; i += 512) { const int half = i >> 11, rem = i & 2047, n = rem >> 4, c = rem & 15;
        *(LAS v4u*)(Kl + half * 17408 + n * 136 + c * 8) = *(const v4u*)((half ? K2B : K1B) + (size_t)h * 16384 + n * 128 + c * 8); }
    __syncthreads();
    for (int tile = wgx * NW + wave; tile < NTOK / 16; tile += nwg * NW) {
        const size_t row = (size_t)tile * 16 + r;
        int R[2][16];
#pragma unroll
        for (int half = 0; half < 2; ++half) {
            bf16x8 qb[4];
#pragma unroll
            for (int ks = 0; ks < 4; ++ks) qb[ks] = *(const bf16x8*)(Q2 + row * 2048 + h * 256 + half * 128 + 32 * ks + 8 * g);
            int X[16], Y[16];
#pragma unroll
            for (int nb = 0; nb < 8; ++nb) {
                f32x4 acc = {0.f, 0.f, 0.f, 0.f};
#pragma unroll
                for (int ks = 0; ks < 4; ++ks) acc = MFMA16(*(const LAS bf16x8*)(Kl + half * 17408 + (16 * nb + r) * 136 + 32 * ks + 8 * g), qb[ks], acc);
#pragma unroll
                for (int k = 0; k < 4; ++k) { const int key = (f2ord(acc[k]) & ~0x7f) | (16 * nb + 4 * g + k); if (nb < 4) X[4 * nb + k] = key; else Y[4 * (nb - 4) + k] = key; }
            }
            sort16_desc(X); sort16_desc(Y); merge16_desc(X, Y);
            xmerge16(X, 16); xmerge16(X, 32);
#pragma unroll
            for (int i = 0; i < 16; ++i) R[half][i] = X[i];
        }
        if (g == 0) {
#pragma unroll
            for (int i = 0; i < 16; ++i) { Tb[r * 32 + i] = R[0][i] & 0x7f; Tb[r * 32 + 16 + i] = R[1][i] & 0x7f; }
        }
        float F1[16], F2[16];
#pragma unroll
        for (int i = 0; i < 16; ++i) { F1[i] = ord2f(R[0][i] & ~0x7f); F2[i] = ord2f(R[1][i] & ~0x7f); }
        int C[16];
#pragma unroll
        for (int sl = 0; sl < 16; ++sl) {
            const int a1 = sl < 8 ? 1 : (sl < 13 ? 2 : -1), b1 = sl < 8 ? sl : sl - 8;
            const int a2 = sl < 4 ? 3 : (sl < 7 ? 4 : (sl < 9 ? 5 : (sl < 11 ? 6 : (sl < 13 ? 7 : -1)))), b2 = sl < 4 ? sl : (sl < 7 ? sl - 4 : (sl < 9 ? sl - 7 : (sl < 11 ? sl - 9 : sl - 11)));
            const int a3 = sl < 8 ? 8 + sl : -1;
            const int k0 = (f2ord(F1[0] + F2[sl]) & ~0xff) | (0 << 4) | sl;
            const int k1 = a1 >= 0 ? ((f2ord(F1[a1 < 0 ? 0 : a1] + F2[b1 & 15]) & ~0xff) | (a1 << 4) | (b1 & 15)) : (int)0x80000000;
            const int k2 = a2 >= 0 ? ((f2ord(F1[a2 < 0 ? 0 : a2] + F2[b2 & 15]) & ~0xff) | (a2 << 4) | (b2 & 15)) : (int)0x80000000;
            const int k3 = a3 >= 0 ? ((f2ord(F1[a3 < 0 ? 0 : a3] + F2[0]) & ~0xff) | (a3 << 4)) : (int)0x80000000;
            C[sl] = g == 0 ? k0 : (g == 1 ? k1 : (g == 2 ? k2 : k3));
        }
        sort16_desc(C); xmerge16(C, 16); xmerge16(C, 32);
        const float rstd1 = rsqrtf(SSQ1[row] * (1.0f / 1024.0f) + EPS);
        float e[16], sum = 0.f; const float mx = ord2f(C[0] & ~0xff);
#pragma unroll
        for (int i = 0; i < 16; ++i) { e[i] = __expf((ord2f(C[i] & ~0xff) - mx) * rstd1); sum += e[i]; }
        const float inv = __builtin_amdgcn_rcpf(sum);
        int oi[4]; float og[4];
#pragma unroll
        for (int kk = 0; kk < 4; ++kk) {
            const int key = g == 0 ? C[kk] : (g == 1 ? C[4 + kk] : (g == 2 ? C[8 + kk] : C[12 + kk]));
            const float ev = g == 0 ? e[kk] : (g == 1 ? e[4 + kk] : (g == 2 ? e[8 + kk] : e[12 + kk]));
            const int a = (key >> 4) & 15, bq = key & 15;
            oi[kk] = Tb[r * 32 + a] * 128 + Tb[r * 32 + 16 + bq]; og[kk] = ev * inv;
        }
#pragma unroll
        for (int kk = 0; kk < 4; ++kk) { const int pos = (4 * (g & 1) + kk) * 16 + 2 * h + (g >> 1); IDX[row * 128 + pos] = oi[kk]; GATE[row * 128 + pos] = og[kk]; }
    }
}

typedef _Float16 f16x2 __attribute__((ext_vector_type(2)));
__device__ __forceinline__ f16x2 bfpair_to_h2(unsigned w) { return __builtin_bit_cast(f16x2, __builtin_amdgcn_cvt_pkrtz(bf_lo(w), bf_hi(w))); }
template <int B> __device__ __forceinline__ f16x2 fp4_to_h2(unsigned w) { return __builtin_bit_cast(f16x2, __builtin_amdgcn_cvt_scalef32_pk_f16_fp4(w, 1.0f, B)); }
__device__ __forceinline__ void p11a_reduce_store(const v4u (&ud)[16], const v4u hh, const v4u hl, const float hsc, float* PART, int t, int x, int rg, int ch) {
    float z[16];
#pragma unroll
    for (int gq = 0; gq < 16; ++gq) {
        int ah = __builtin_amdgcn_sdot8((int)ud[gq].x, (int)hh.x, 0, false), al = __builtin_amdgcn_sdot8((int)ud[gq].x, (int)hl.x, 0, false);
        ah = __builtin_amdgcn_sdot8((int)ud[gq].y, (int)hh.y, ah, false); al = __builtin_amdgcn_sdot8((int)ud[gq].y, (int)hl.y, al, false);
        ah = __builtin_amdgcn_sdot8((int)ud[gq].z, (int)hh.z, ah, false); al = __builtin_amdgcn_sdot8((int)ud[gq].z, (int)hl.z, al, false);
        ah = __builtin_amdgcn_sdot8((int)ud[gq].w, (int)hh.w, ah, false); al = __builtin_amdgcn_sdot8((int)ud[gq].w, (int)hl.w, al, false);
        z[gq] = (float)(16 * ah + al) * hsc; }
    float z8[8], z4[4], z2[2];
    { const bool b = ch & 4;
#pragma unroll
      for (int i = 0; i < 8; ++i) { const float keep = b ? z[8 + i] : z[i], send = b ? z[i] : z[8 + i]; z8[i] = keep + __shfl_xor(send, 4); } }
    { const bool b = ch & 2;
#pragma unroll
      for (int i = 0; i < 4; ++i) { const float keep = b ? z8[4 + i] : z8[i], send = b ? z8[i] : z8[4 + i]; z4[i] = keep + __shfl_xor(send, 2); } }
    { const bool b = ch & 1;
#pragma unroll
      for (int i = 0; i < 2; ++i) { const float keep = b ? z4[2 + i] : z4[i], send = b ? z4[i] : z4[2 + i]; z2[i] = keep + __shfl_xor(send, 1); } }
    *(float2*)(PART + ((size_t)t * 4 + x) * 128 + rg * 16 + 2 * ch) = make_float2(z2[0], z2[1]);
}
__device__ __forceinline__ void p11a_udot(const Params& P, int lane, int wave, int vb) {
    const unsigned* HQH = (const unsigned*)(P.ws + WS_HQH); const unsigned* HQL = (const unsigned*)(P.ws + WS_HQL); const float* HS = (const float*)(P.ws + WS_HS);
    const unsigned char* U4 = P.ws + WS_U4; const int* IDX = (const int*)(P.ws + WS_IDX); float* PART = (float*)(P.ws + WS_PART);
    const int x = vb & 3, wgx = vb >> 2, nwg = gridDim.x >> 2, rg = lane >> 3, ch = lane & 7;
    const int tstep = nwg * NW;
    for (int t = wgx * NW + wave; t < NTOK; t += 2 * tstep) {
        const int tB = t + tstep;
        int eA[16], eB[16];
#pragma unroll
        for (int q = 0; q < 4; ++q) { const int4 v = *(const int4*)(IDX + (size_t)t * 128 + rg * 16 + 4 * q); eA[4 * q] = v.x; eA[4 * q + 1] = v.y; eA[4 * q + 2] = v.z; eA[4 * q + 3] = v.w;
            const int4 w = *(const int4*)(IDX + (size_t)tB * 128 + rg * 16 + 4 * q); eB[4 * q] = w.x; eB[4 * q + 1] = w.y; eB[4 * q + 2] = w.z; eB[4 * q + 3] = w.w; }
        const v4u hhA = *(const v4u*)(HQH + (size_t)t * 128 + 32 * x + 4 * ch), hlA = *(const v4u*)(HQL + (size_t)t * 128 + 32 * x + 4 * ch);
        const v4u hhB = *(const v4u*)(HQH + (size_t)tB * 128 + 32 * x + 4 * ch), hlB = *(const v4u*)(HQL + (size_t)tB * 128 + 32 * x + 4 * ch);
        const float hsA = HS[(size_t)t * 32 + 8 * x + ch], hsB = HS[(size_t)tB * 32 + 8 * x + ch];
        v4u udA[16], udB[16];
#pragma unroll
        for (int gq = 0; gq < 16; ++gq) udA[gq] = *(const v4u*)(U4 + (size_t)eA[gq] * 512 + 128 * x + 16 * ch);
#pragma unroll
        for (int gq = 0; gq < 16; ++gq) udB[gq] = *(const v4u*)(U4 + (size_t)eB[gq] * 512 + 128 * x + 16 * ch);
        p11a_reduce_store(udA, hhA, hlA, hsA, PART, t, x, rg, ch);
        p11a_reduce_store(udB, hhB, hlB, hsB, PART, tB, x, rg, ch);
    }
}
__device__ __forceinline__ void p11b_weights(const Params& P, int tid, int vb) {
    const float* PART = (const float*)(P.ws + WS_PART); float* GW = (float*)(P.ws + WS_GATE); const float* SSQ1 = (const float*)(P.ws + WS_SSQ1);
    const int* IDX = (const int*)(P.ws + WS_IDX); const float* SU = (const float*)(P.ws + WS_SU); const float* SV = (const float*)(P.ws + WS_SV);
    for (size_t i = (size_t)vb * 512 + tid; i < (size_t)NTOK * 128; i += (size_t)gridDim.x * 512) {
        const size_t t = i >> 7, pos = i & 127; float zs = 0.f;
#pragma unroll
        for (int x = 0; x < 4; ++x) zs += PART[(t * 4 + x) * 128 + pos];
        const int e = IDX[i];
        const float zv = zs * SU[e] * rsqrtf(SSQ1[t] * (1.0f / 1024.0f) + EPS);
        GW[i] = GW[i] * 0.5f * zv * (1.0f + erff(zv * 0.70710678118654752f)) * SV[e];
    }
}
__device__ __forceinline__ void p11c_vacc(const Params& P, int lane, int wave, int vb) {
    const unsigned char* V4 = P.ws + WS_V4; const int* IDX = (const int*)(P.ws + WS_IDX); const float* GW = (const float*)(P.ws + WS_GATE);
    bf16* XB = (bf16*)(P.ws + WS_HN); float* SSQ = (float*)(P.ws + WS_SSQ);
    const int x = vb & 3, wgx = vb >> 2, nwg = gridDim.x >> 2, rg = lane >> 3, ch = lane & 7;
    for (int t = wgx * NW + wave; t < NTOK; t += nwg * NW) {
        int e[16]; float w[16];
#pragma unroll
        for (int q = 0; q < 4; ++q) { const int4 v = *(const int4*)(IDX + (size_t)t * 128 + rg * 16 + 4 * q); e[4 * q] = v.x; e[4 * q + 1] = v.y; e[4 * q + 2] = v.z; e[4 * q + 3] = v.w;
            const float4 wv = *(const float4*)(GW + (size_t)t * 128 + rg * 16 + 4 * q); w[4 * q] = wv.x; w[4 * q + 1] = wv.y; w[4 * q + 2] = wv.z; w[4 * q + 3] = wv.w; }
        v4u vd[16];
#pragma unroll
        for (int gq = 0; gq < 16; ++gq) vd[gq] = *(const v4u*)(V4 + (size_t)e[gq] * 512 + 128 * x + 16 * ch);
        bf16* xp = XB + (size_t)t * 1024 + 256 * x + 32 * ch + 4 * rg;
        const uint2 xo = *(const uint2*)xp;
        f16x2 acc[16];
#pragma unroll
        for (int i = 0; i < 16; ++i) acc[i] = (f16x2){(_Float16)0.f, (_Float16)0.f};
#pragma unroll
        for (int gq = 0; gq < 16; ++gq) { const f16x2 ww = __builtin_bit_cast(f16x2, __builtin_amdgcn_cvt_pkrtz(w[gq], w[gq])); const unsigned w4[4] = {vd[gq].x, vd[gq].y, vd[gq].z, vd[gq].w};
#pragma unroll
            for (int q = 0; q < 4; ++q) { acc[4 * q] = __builtin_elementwise_fma(fp4_to_h2<0>(w4[q]), ww, acc[4 * q]); acc[4 * q + 1] = __builtin_elementwise_fma(fp4_to_h2<1>(w4[q]), ww, acc[4 * q + 1]);
                acc[4 * q + 2] = __builtin_elementwise_fma(fp4_to_h2<2>(w4[q]), ww, acc[4 * q + 2]); acc[4 * q + 3] = __builtin_elementwise_fma(fp4_to_h2<3>(w4[q]), ww, acc[4 * q + 3]); } }
        f16x2 a8[8], a4[4], a2[2];
        { const bool b = rg & 4;
#pragma unroll
          for (int i = 0; i < 8; ++i) { const f16x2 keep = b ? acc[8 + i] : acc[i], send = b ? acc[i] : acc[8 + i]; a8[i] = keep + __builtin_bit_cast(f16x2, __shfl_xor(__builtin_bit_cast(int, send), 32)); } }
        { const bool b = rg & 2;
#pragma unroll
          for (int i = 0; i < 4; ++i) { const f16x2 keep = b ? a8[4 + i] : a8[i], send = b ? a8[i] : a8[4 + i]; a4[i] = keep + __builtin_bit_cast(f16x2, __shfl_xor(__builtin_bit_cast(int, send), 16)); } }
        { const bool b = rg & 1;
#pragma unroll
          for (int i = 0; i < 2; ++i) { const f16x2 keep = b ? a4[2 + i] : a4[i], send = b ? a4[i] : a4[2 + i]; a2[i] = keep + __builtin_bit_cast(f16x2, __shfl_xor(__builtin_bit_cast(int, send), 8)); } }
        f32x4 xn; xn[0] = bf_lo(xo.x) + (float)a2[0][0]; xn[1] = bf_hi(xo.x) + (float)a2[0][1]; xn[2] = bf_lo(xo.y) + (float)a2[1][0]; xn[3] = bf_hi(xo.y) + (float)a2[1][1];
        uint2 xg; xg.x = pk2(xn[0], xn[1]); xg.y = pk2(xn[2], xn[3]);
        *(uint2*)xp = xg;
        { int p8 = __builtin_amdgcn_cvt_pk_fp8_f32(xn[0], xn[1], 0, false); p8 = __builtin_amdgcn_cvt_pk_fp8_f32(xn[2], xn[3], p8, true); *(int*)(P.ws + WS_X2B8 + (size_t)t * 1024 + 256 * x + 32 * ch + 4 * rg) = p8; }
        const float ss = wave_sum((xn[0] * xn[0] + xn[1] * xn[1]) + (xn[2] * xn[2] + xn[3] * xn[3]));
        if (lane == 0) atomicAdd(SSQ + t, ss);
    }
}

__global__ void __launch_bounds__(512, 2) mk_fwd(Params P) {
    extern __shared__ __attribute__((aligned(16))) unsigned char lds_raw[];
    cg::grid_group grid = cg::this_grid();
    LAS unsigned char* lds = (LAS unsigned char*)lds_raw;
    const int tid = threadIdx.x, lane = tid & 63, wave = __builtin_amdgcn_readfirstlane(tid >> 6);
    const int lo = P.ph_lo, hi = P.ph_hi, G = gridDim.x, bx = blockIdx.x;
    unsigned char* ws = P.ws;
    const int gw = bx * NW + wave, NGW = G * NW;
#ifndef PH_MASK
#define PH_MASK 0xffff
#endif
#define IN(k) (((PH_MASK >> (k)) & 1) && lo <= (k) && (k) < hi)
    volatile LAS unsigned* xst = (volatile LAS unsigned*)(lds + LDS_BYTES - 16);
    if (tid < 4) xst[tid] = 0u;
    __syncthreads();
    const XcdBarrier bar = xcd_barrier_post((unsigned*)(ws + WS_BAR), xst);
    unsigned* vctl = (unsigned*)(ws + WS_BAR) + 4096;
    if (tid == 0) { const unsigned xcc = xb_xcc_id() & 7u; xst[2] = xcc; xst[3] = xb_add(&vctl[16 * xcc], 1u); }
#ifdef USE_CG
#define GRID_BAR() grid.sync()
#else
#define GRID_BAR() xcd_barrier(bar)
#endif
#define SYNC_AFTER(k) do { if (IN(k) && IN((k) + 1)) { GRID_BAR(); } } while (0)
    typedef pg8::bf16_t pb;
    if (IN(0)) p0_prologue(P, lds, tid, lane, wave);
    SYNC_AFTER(0);
    if (tid == 0) {
        const unsigned xcc = xst[2], sl = xst[3], cap = (unsigned)G >> 3; unsigned v;
        if (sl < cap) v = sl * 8u + xcc;
        else { unsigned o = xb_add(&vctl[160], 1u); v = 0u;
            for (unsigned x = 0; x < 8u; ++x) { const unsigned c = min(xb_ld(&vctl[16 * x]), cap), fr = cap - c; if (o < fr) { v = (c + o) * 8u + x; break; } o -= fr; } }
        xst[2] = v;
    }
    __syncthreads();
    const int vb = (int)xst[2];
    if (IN(1)) {
        { pg8::Gemm g{(const pb*)(ws + WS_XN), (const pb*)(ws + WS_W1T), NTOK, 3584, 1024}; pg8::StaticOrder S; S.init(NTOK, 3584, G, vb);
          pg8::EpiProj E{(pb*)(ws + WS_QKVA), (pb*)(ws + WS_QKM), (pb*)(ws + WS_VM), (pb*)(ws + WS_OM), (pb*)(ws + WS_G), C2};
          pg8::gemm_phase<pg8::EpiProj, pg8::StaticOrder, true, true>(lds, g, S, E); }
        { pg8::Gemm g{(const pb*)P.out, (const pb*)(ws + WS_W1G8), NTOK, 2048, 512}; pg8::StaticOrder S; S.init(NTOK, 2048, G, vb);
          pg8::EpiGateF8 E{(pb*)(ws + WS_G)};
          pg8::gemm_phase<pg8::EpiGateF8, pg8::StaticOrder, true, true>(lds, g, S, E); }
    }
    SYNC_AFTER(1);
    if (IN(2)) { p2_attention(P, lds, lane, wave, vb); __syncthreads(); p2_mlstm_local(P, lds, tid, lane, wave, vb); }
    SYNC_AFTER(2);
    if (IN(3)) p3_mlstm_scan(P, tid, vb);
    SYNC_AFTER(3);
    if (IN(4)) p4_mlstm_out(P, lds, tid, lane, wave, vb);
    SYNC_AFTER(4);
    if (IN(5)) {
        pg8::Gemm g{(const pb*)(ws + WS_YA), (const pb*)(ws + WS_WAT), NTOK, 1024, 1024}; pg8::StaticOrder S; S.init(NTOK, 1024, G, vb);
        pg8::EpiMerged E{(pb*)(ws + WS_MERGED), (const pb*)(ws + WS_G)};
        pg8::gemm_phase<pg8::EpiMerged, pg8::StaticOrder, true, true>(lds, g, S, E);
    }
    if (IN(5) && IN(7)) GRID_BAR();
    if (IN(7)) {
        pg8::Gemm g{(const pb*)(ws + WS_MERGED), (const pb*)(ws + WS_WOT), NTOK, 1024, 1024}; pg8::StaticOrder S; S.init(NTOK, 1024, G, vb);
        pg8::EpiResidual E{P.in[0], (pb*)(ws + WS_HN), (float*)(ws + WS_SSQ1)};
        pg8::gemm_phase<pg8::EpiResidual, pg8::StaticOrder, true, true>(lds, g, S, E);
    }
    if (IN(7) && IN(9)) GRID_BAR();
    if (IN(9)) {
        pg8::Gemm g{(const pb*)(ws + WS_HN), (const pb*)(ws + WS_WQT), NTOK, 2048, 1024}; pg8::StaticOrder S; S.init(NTOK, 2048, G, vb);
        pg8::EpiStore E{(pb*)(ws + WS_Q2), 2048};
        pg8::gemm_phase<pg8::EpiStore, pg8::StaticOrder, true, true>(lds, g, S, E);
    }
    SYNC_AFTER(9);
    if (IN(10)) { p10_quant_rows(P, lane, wave, vb); p10_topk(P, lds, tid, lane, wave, vb); }
    SYNC_AFTER(10);
    if (IN(11)) { p11a_udot(P, lane, wave, vb); GRID_BAR(); p11b_weights(P, tid, vb); GRID_BAR(); p11c_vacc(P, lane, wave, vb); }
    SYNC_AFTER(11);
    if (IN(12)) {
        pg8::Gemm g{(const pb*)(ws + WS_PB), (const pb*)(ws + WS_WPT), NTOK, 1024, 256}; pg8::StaticOrder S; S.init(NTOK, 1024, G, vb);
        pg8::EpiStore E{(pb*)(ws + WS_E), 1024};
        pg8::gemm_phase<pg8::EpiStore, pg8::StaticOrder, true, true>(lds, g, S, E);
    }
    if (IN(12) && IN(13)) { asm volatile("s_waitcnt vmcnt(0)" ::: "memory"); __syncthreads(); }
    if (IN(13)) {
        pg8::Gemm g{(const pb*)(ws + WS_X2B8), (const pb*)(ws + WS_WG8), NTOK, 1024, 512}; pg8::StaticOrder S; S.init(NTOK, 1024, G, vb);
        pg8::EpiPle E{(const pb*)(ws + WS_HN), (pb*)(ws + WS_X3B), (const pb*)(ws + WS_E), (const float*)(ws + WS_SSQ)};
        pg8::gemm_phase<pg8::EpiPle, pg8::StaticOrder, true, true>(lds, g, S, E);
    }
    SYNC_AFTER(13);
    if (IN(14)) {
        const float* gf = P.in[19];
        for (int m = gw; m < NTOK; m += NGW) {
            const bf16* xr = (const bf16*)(ws + WS_X3B) + (size_t)m * 1024; float v[16]; float s = 0.f;
            unpk8(((const v4u*)xr)[2 * lane], v); unpk8(((const v4u*)xr)[2 * lane + 1], v + 8);
#pragma unroll
            for (int i = 0; i < 16; ++i) s += v[i] * v[i];
            const float rstd = rsqrtf(wave_sum(s) * (1.f / 1024.f) + EPS);
            float* orow = P.out + (size_t)m * 1024 + 16 * lane;
#pragma unroll
            for (int j = 0; j < 4; ++j) { const f32x4 g = ((const f32x4*)(gf + 16 * lane))[j]; f32x4 o; o[0] = v[4 * j] * rstd * g[0]; o[1] = v[4 * j + 1] * rstd * g[1]; o[2] = v[4 * j + 2] * rstd * g[2]; o[3] = v[4 * j + 3] * rstd * g[3]; ((f32x4*)orow)[j] = o; }
        }
    }
}

extern "C" void kernel_launch(void* const* d_in, const int* in_sizes, int n_in, void* d_out, int out_size, void* d_ws, size_t ws_size, hipStream_t stream) {
    static int grid_blocks = 0;
    if (!grid_blocks) {
        int dev = 0, cus = 0, per_cu = 0;
        (void)hipGetDevice(&dev);
        (void)hipDeviceGetAttribute(&cus, hipDeviceAttributeMultiprocessorCount, dev);
        (void)hipFuncSetAttribute((const void*)mk_fwd, hipFuncAttributeMaxDynamicSharedMemorySize, LDS_BYTES);
        (void)hipOccupancyMaxActiveBlocksPerMultiprocessor(&per_cu, mk_fwd, 512, LDS_BYTES);
        if (per_cu > 1) per_cu = 1;
        grid_blocks = cus * per_cu;
    }
    if (n_in < 20 || ws_size < WS_NEED || grid_blocks <= 0) { fprintf(stderr, "kernel_launch: bad setup (n_in %d ws %zu grid %d)\n", n_in, ws_size, grid_blocks); return; }
    Params p{};
    for (int i = 0; i < 20; ++i) p.in[i] = (const float*)d_in[i];
    p.out = (float*)d_out; p.ws = (unsigned char*)d_ws; p.ph_lo = 0; p.ph_hi = 15;
    (void)hipMemsetAsync((unsigned char*)d_ws + WS_BAR, 0, BAR_BYTES, stream);
    void* args[] = {&p};
    hipError_t e = hipLaunchCooperativeKernel((void*)mk_fwd, dim3(grid_blocks), dim3(512), args, LDS_BYTES, stream);
    if (e != hipSuccess) fprintf(stderr, "cooperative launch failed: %s (grid %d)\n", hipGetErrorString(e), grid_blocks);
}
```

```cpp
#include <hip/hip_runtime.h>
#include <cstdio>
#include <cstdint>
namespace pg8 {
#define PG8_LAS __attribute__((address_space(3)))
typedef unsigned short bf16_t;
typedef short bf16x8 __attribute__((ext_vector_type(8)));
typedef float f32x4 __attribute__((ext_vector_type(4)));
typedef unsigned u32x4 __attribute__((ext_vector_type(4)));
constexpr int BM = 256, BK = 64, HALF = 128, HTB = HALF * BK * 2  , STAGE_BYTES = 8 * HTB, NXCD = 8, WGM = 8;

__host__ __device__ __forceinline__ int lds_byte(int r, int c) { const int st = (r >> 4) * 2 + (c >> 5), rr = r & 15, cc = c & 31, ob = rr * 64 + cc * 2; return st * 1024 + (ob ^ (((ob >> 9) & 1) << 5)); }
__host__ __device__ __forceinline__ void stage_rc(int b, int& R, int& C) { const int st = b / 1024, sb = b % 1024, swz = sb ^ (((sb >> 9) & 1) << 5); R = (st >> 1) * 16 + swz / 64; C = (st & 1) * 32 + (swz % 64) / 2; }
__host__ __device__ __forceinline__ int perm32(int rho) { const int n = rho >> 4, i = rho & 15; return 8 * (i >> 2) + 4 * n + (i & 3); }

struct Unit { int pm, pn; };
struct Gemm { const bf16_t* A; const bf16_t* Bt; int M, N, K; };

struct StaticOrder {
    int nM, nN, nwg, G, c;
    __host__ __device__ void init(int M, int N, int G_, int c_) { nM = M / BM; nN = N / BM; nwg = nM * nN; G = G_; c = c_; }
    __host__ __device__ bool next(int i, Unit& u) const {
        const long L = (long)i * G + c; if (L >= nwg) return false;
        int wgid = (int)L; { const int q = nwg / NXCD, r = nwg % NXCD, xcd = wgid % NXCD, off = wgid / NXCD; wgid = (xcd < r ? xcd * (q + 1) : r * (q + 1) + (xcd - r) * q) + off; }
        const int nig = WGM * nN, gid = wgid / nig, fm = gid * WGM, gsz = (nM - fm) < WGM ? (nM - fm) : WGM;
        u.pm = fm + ((wgid % nig) % gsz); u.pn = (wgid % nig) / gsz; return true;
    }
    __device__ __forceinline__ void a_ready(const Unit&) const {}
    __device__ __forceinline__ void done(const Unit&) const {}
};

__device__ __forceinline__ unsigned cvt_pk_bf16(float lo, float hi) { unsigned r; asm volatile("v_cvt_pk_bf16_f32 %0, %1, %2" : "=v"(r) : "v"(lo), "v"(hi)); return r; }
typedef float f32x2 __attribute__((ext_vector_type(2)));

__device__ __forceinline__ float sigm(float x) { return __builtin_amdgcn_rcpf(1.0f + __builtin_amdgcn_exp2f(-1.4426950408889634f * x)); }
__device__ __forceinline__ float bf_lo(unsigned w) { return __uint_as_float(w << 16); }
__device__ __forceinline__ float bf_hi(unsigned w) { return __uint_as_float(w & 0xffff0000u); }
__device__ __forceinline__ u32x4 pack8(const f32x4& v0, const f32x4& v1) { u32x4 w; w.x = cvt_pk_bf16(v0[0], v0[1]); w.y = cvt_pk_bf16(v0[2], v0[3]); w.z = cvt_pk_bf16(v1[0], v1[1]); w.w = cvt_pk_bf16(v1[2], v1[3]); return w; }
__device__ __forceinline__ void unpack8(const u32x4& w, f32x4& v0, f32x4& v1) { v0[0] = bf_lo(w.x); v0[1] = bf_hi(w.x); v0[2] = bf_lo(w.y); v0[3] = bf_hi(w.y); v1[0] = bf_lo(w.z); v1[1] = bf_hi(w.z); v1[2] = bf_lo(w.w); v1[3] = bf_hi(w.w); }

#define PG8_EPI_WALK(...) \
    _Pragma("unroll") for (int ai = 0; ai < 2; ++ai) _Pragma("unroll") for (int m = 0; m < 4; ++m) { const int row = u.pm * BM + wr * 64 + fr + ai * HALF + m * 16; \
        _Pragma("unroll") for (int bj = 0; bj < 2; ++bj) { const int ct = wc * 64 + bj * 32 + 8 * fq; f32x4 v0 = acc[ai][bj][m][0], v1 = acc[ai][bj][m][1]; __VA_ARGS__ } }

__device__ __forceinline__ u32x4 xor8_16B(u32x4 v) { u32x4 r; r.x = (unsigned)__shfl_xor((int)v.x, 8); r.y = (unsigned)__shfl_xor((int)v.y, 8); r.z = (unsigned)__shfl_xor((int)v.z, 8); r.w = (unsigned)__shfl_xor((int)v.w, 8); return r; }
__device__ __forceinline__ u32x4 bperm_16B(int src_byte, u32x4 v) { u32x4 r; r.x = (unsigned)__builtin_amdgcn_ds_bpermute(src_byte, (int)v.x); r.y = (unsigned)__builtin_amdgcn_ds_bpermute(src_byte, (int)v.y); r.z = (unsigned)__builtin_amdgcn_ds_bpermute(src_byte, (int)v.z); r.w = (unsigned)__builtin_amdgcn_ds_bpermute(src_byte, (int)v.w); return r; }
__device__ __forceinline__ void store_rows_bf16(bf16_t* O, size_t ldc, int r0, int c0, int fr, int fq, u32x4 w0, u32x4 w1) {
    const bool h = fr & 8; const u32x4 recv = xor8_16B(h ? w0 : w1);
    const u32x4 d1 = h ? recv : w0, d2 = h ? w1 : recv;
    const int lane = fr + 16 * fq, src = ((lane >> 3) + 8 * ((lane >> 2) & 1) + 16 * (lane & 3)) * 4;
    const u32x4 e1 = bperm_16B(src, d1), e2 = bperm_16B(src, d2);
    bf16_t* p = O + (size_t)(r0 + (lane >> 3)) * ldc + c0 + 8 * (lane & 7);
    *(u32x4*)p = e1; *(u32x4*)(p + 8 * ldc) = e2;
}
struct EpiProj {
    static constexpr bool PERM = true, AFTER_DRAIN = false, MIDK = false, FP8 = true, FINAL = false; static constexpr int SCALE_B = 0x7b;
    bf16_t *qkva, *qkm, *vm, *om; unsigned char* g8; float c2;
    __device__ __forceinline__ void operator()(const f32x4 (&acc)[2][2][4][2], const Unit& u, int wr, int wc, int fr, int fq) const {
        const int pn = u.pn; bf16_t* base; int ldc, colt, mode = 0; float sc = 1.f;
        if (pn < 6) { base = qkva; ldc = 1536; colt = pn * 256; if (pn < 2) sc = c2; }
        else if (pn < 10) { base = qkm; ldc = 1024; colt = (pn - 6) * 256; }
        else if (pn < 12) { base = vm; ldc = 512; colt = (pn - 10) * 256; }
        else if (pn < 14) { base = om; ldc = 512; colt = (pn - 12) * 256; mode = 1; }
        else {
            const int colt8 = (pn - 14) * 256;
#pragma unroll
            for (int ai = 0; ai < 2; ++ai)
#pragma unroll
                for (int m = 0; m < 4; ++m)
#pragma unroll
                    for (int bj = 0; bj < 2; ++bj) { unsigned p[2] = {0u, 0u};
#pragma unroll
                        for (int n = 0; n < 2; ++n)
#pragma unroll
                            for (int i = 0; i < 4; ++i) p[n] = __builtin_amdgcn_cvt_pk_u8_f32(fmaxf(sigm(acc[ai][bj][m][n][i]) * 255.0f, 1.0f), i, p[n]);
                        uint2 pv; pv.x = p[0]; pv.y = p[1];
                        *(uint2*)(g8 + (size_t)(u.pm * BM + wr * 64 + ai * HALF + m * 16 + fr) * 2048 + colt8 + wc * 64 + bj * 32 + 8 * fq) = pv; }
            return; }
#pragma unroll
        for (int ai = 0; ai < 2; ++ai)
#pragma unroll
            for (int m = 0; m < 4; ++m) { u32x4 w[2];
#pragma unroll
                for (int bj = 0; bj < 2; ++bj) { f32x4 v0 = acc[ai][bj][m][0], v1 = acc[ai][bj][m][1];
                    if (mode == 1) { _Pragma("unroll") for (int i = 0; i < 4; ++i) { v0[i] = sigm(v0[i]); v1[i] = sigm(v1[i]); } }
                    else { v0 = v0 * sc; v1 = v1 * sc; }
                    w[bj] = pack8(v0, v1); }
                store_rows_bf16(base, (size_t)ldc, u.pm * BM + wr * 64 + ai * HALF + m * 16, colt + wc * 64, fr, fq, w[0], w[1]); }
    }
};
struct EpiGateF8 {
    static constexpr bool PERM = true, AFTER_DRAIN = false, MIDK = false, FP8 = true, FINAL = false; static constexpr int SCALE_B = 0x7b;
    bf16_t* g;
    __device__ __forceinline__ void operator()(const f32x4 (&acc)[2][2][4][2], const Unit& u, int wr, int wc, int fr, int fq) const {
#pragma unroll
        for (int ai = 0; ai < 2; ++ai)
#pragma unroll
            for (int m = 0; m < 4; ++m) { u32x4 w[2];
#pragma unroll
                for (int bj = 0; bj < 2; ++bj) { f32x4 v0 = acc[ai][bj][m][0], v1 = acc[ai][bj][m][1];
                    _Pragma("unroll") for (int i = 0; i < 4; ++i) { v0[i] = sigm(v0[i]); v1[i] = sigm(v1[i]); }
                    w[bj] = pack8(v0, v1); }
                store_rows_bf16(g, 2048, u.pm * BM + wr * 64 + ai * HALF + m * 16, u.pn * BM + wc * 64, fr, fq, w[0], w[1]); }
    }
};
struct EpiStore {
    static constexpr bool PERM = true, AFTER_DRAIN = false, MIDK = false, FP8 = false, FINAL = false; static constexpr int SCALE_B = 0x7f;
    bf16_t* O; int ldc;
    __device__ __forceinline__ void operator()(const f32x4 (&acc)[2][2][4][2], const Unit& u, int wr, int wc, int fr, int fq) const {
#pragma unroll
        for (int ai = 0; ai < 2; ++ai)
#pragma unroll
            for (int m = 0; m < 4; ++m) store_rows_bf16(O, (size_t)ldc, u.pm * BM + wr * 64 + ai * HALF + m * 16, u.pn * BM + wc * 64, fr, fq, pack8(acc[ai][0][m][0], acc[ai][0][m][1]), pack8(acc[ai][1][m][0], acc[ai][1][m][1]));
    }
};
struct EpiMerged {
    static constexpr bool PERM = true, AFTER_DRAIN = false, MIDK = true, FP8 = false, FINAL = false; static constexpr int SCALE_B = 0x7f;
    bf16_t* O; const unsigned char* gate;
    static __device__ __forceinline__ void ub4(unsigned w, f32x4& v) { v[0] = (float)(w & 0xffu); v[1] = (float)((w >> 8) & 0xffu); v[2] = (float)((w >> 16) & 0xffu); v[3] = (float)(w >> 24); }
    __device__ __forceinline__ void mid(f32x4 (&acc)[2][2][4][2], const Unit& u, int wr, int wc, int fr, int fq) const {
#pragma unroll
        for (int ai = 0; ai < 2; ++ai)
#pragma unroll
            for (int mp = 0; mp < 2; ++mp) {
                uint2 ga[2][2], gm[2][2];
#pragma unroll
                for (int mm = 0; mm < 2; ++mm)
#pragma unroll
                    for (int bj = 0; bj < 2; ++bj) { const size_t o = (size_t)(u.pm * BM + wr * 64 + fr + ai * HALF + (2 * mp + mm) * 16) * 2048 + u.pn * BM + wc * 64 + bj * 32 + 8 * fq;
                        ga[mm][bj] = *(const uint2*)(gate + o); gm[mm][bj] = *(const uint2*)(gate + o + 1024); }
#pragma unroll
                for (int mm = 0; mm < 2; ++mm)
#pragma unroll
                    for (int bj = 0; bj < 2; ++bj) { f32x4 a0, a1, m0, m1; ub4(ga[mm][bj].x, a0); ub4(ga[mm][bj].y, a1); ub4(gm[mm][bj].x, m0); ub4(gm[mm][bj].y, m1);
#pragma unroll
                        for (int i = 0; i < 4; ++i) { acc[ai][bj][2 * mp + mm][0][i] *= a0[i] * __builtin_amdgcn_rcpf(m0[i]); acc[ai][bj][2 * mp + mm][1][i] *= a1[i] * __builtin_amdgcn_rcpf(m1[i]); } }
            }
    }
    __device__ __forceinline__ void operator()(const f32x4 (&acc)[2][2][4][2], const Unit& u, int wr, int wc, int fr, int fq) const {
#pragma unroll
        for (int ai = 0; ai < 2; ++ai)
#pragma unroll
            for (int mp = 0; mp < 2; ++mp) {
                uint2 gm[2][2];
#pragma unroll
                for (int mm = 0; mm < 2; ++mm)
#pragma unroll
                    for (int bj = 0; bj < 2; ++bj) gm[mm][bj] = *(const uint2*)(gate + (size_t)(u.pm * BM + wr * 64 + fr + ai * HALF + (2 * mp + mm) * 16) * 2048 + 1024 + u.pn * BM + wc * 64 + bj * 32 + 8 * fq);
#pragma unroll
                for (int mm = 0; mm < 2; ++mm) { const int m = 2 * mp + mm; u32x4 w[2];
#pragma unroll
                    for (int bj = 0; bj < 2; ++bj) { f32x4 m0, m1; ub4(gm[mm][bj].x, m0); ub4(gm[mm][bj].y, m1); w[bj] = pack8(acc[ai][bj][m][0] * (m0 * (1.0f / 255.0f)), acc[ai][bj][m][1] * (m1 * (1.0f / 255.0f))); }
                    store_rows_bf16(O, 1024, u.pm * BM + wr * 64 + ai * HALF + m * 16, u.pn * BM + wc * 64, fr, fq, w[0], w[1]); }
            }
    }
};
struct EpiResidual {
    static constexpr bool PERM = true, AFTER_DRAIN = false, MIDK = false, FP8 = false, FINAL = false; static constexpr int SCALE_B = 0x7f;
    const float* res; bf16_t* xb; float* ssq;
    __device__ __forceinline__ void operator()(f32x4 (&acc)[2][2][4][2], const Unit& u, int wr, int wc, int fr, int fq) const {
        const float* rbase = res + (size_t)(u.pm * BM + wr * 64 + fr) * 1024 + u.pn * BM + wc * 64 + 8 * fq;
        f32x4 rg[8][4];
#define PG8_RLD(k) do { const float* p_ = rbase + (size_t)(((k) >> 2) * HALF + ((k) & 3) * 16) * 1024; rg[k][0] = *(const f32x4*)p_; rg[k][1] = *(const f32x4*)(p_ + 4); rg[k][2] = *(const f32x4*)(p_ + 32); rg[k][3] = *(const f32x4*)(p_ + 36); } while (0)
        PG8_RLD(0); PG8_RLD(1);
#pragma unroll
        for (int k = 0; k < 8; ++k) { const int ai = k >> 2, m = k & 3;
            if (k + 2 < 8) PG8_RLD(k + 2);
            acc[ai][0][m][0] += rg[k][0]; acc[ai][0][m][1] += rg[k][1]; acc[ai][1][m][0] += rg[k][2]; acc[ai][1][m][1] += rg[k][3];
            asm volatile("" : "+v"(acc[ai][0][m][0]), "+v"(acc[ai][0][m][1]), "+v"(acc[ai][1][m][0]), "+v"(acc[ai][1][m][1]) :: "memory"); }
#undef PG8_RLD
#pragma unroll
        for (int ai = 0; ai < 2; ++ai)
#pragma unroll
            for (int m = 0; m < 4; ++m) { const int row = u.pm * BM + wr * 64 + fr + ai * HALF + m * 16; float s = 0.f; u32x4 wx[2];
#pragma unroll
                for (int bj = 0; bj < 2; ++bj) { const f32x4 v0 = acc[ai][bj][m][0], v1 = acc[ai][bj][m][1];
                    s += (v0[0] * v0[0] + v0[1] * v0[1]) + (v0[2] * v0[2] + v0[3] * v0[3]) + (v1[0] * v1[0] + v1[1] * v1[1]) + (v1[2] * v1[2] + v1[3] * v1[3]);
                    wx[bj] = pack8(v0, v1); }
                store_rows_bf16(xb, 1024, u.pm * BM + wr * 64 + ai * HALF + m * 16, u.pn * BM + wc * 64, fr, fq, wx[0], wx[1]);
                s += __shfl_xor(s, 16); s += __shfl_xor(s, 32);
                if (fq == 0) atomicAdd(ssq + row, s);
                asm volatile("" ::: "memory"); }
    }
};
struct EpiPle {
    static constexpr bool PERM = true, AFTER_DRAIN = false, MIDK = false, FP8 = true, FINAL = false; static constexpr int SCALE_B = 0x7b;
    const bf16_t* x2; bf16_t* x3; const bf16_t* e; const float* ssq;
    __device__ __forceinline__ void operator()(const f32x4 (&acc)[2][2][4][2], const Unit& u, int wr, int wc, int fr, int fq) const {
        const int row0 = u.pm * BM + wr * 64 + fr;
        float sq_next = ssq[row0];
#pragma unroll
        for (int ai = 0; ai < 2; ++ai)
#pragma unroll
            for (int m = 0; m < 4; ++m) { const int row = row0 + ai * HALF + m * 16; const float sq = sq_next; u32x4 wx[2];
                if (!(ai == 1 && m == 3)) sq_next = ssq[row0 + (m == 3 ? HALF : ai * HALF + (m + 1) * 16)];
                const float rstd = rsqrtf(sq * (1.0f / 1024.0f) + 1e-6f);
#pragma unroll
                for (int bj = 0; bj < 2; ++bj) { const int ct = wc * 64 + bj * 32 + 8 * fq; f32x4 v0 = acc[ai][bj][m][0] * rstd, v1 = acc[ai][bj][m][1] * rstd;
                    const size_t o = (size_t)row * 1024 + u.pn * BM + ct; f32x4 e0, e1, r0, r1; unpack8(*(const u32x4*)(e + o), e0, e1); unpack8(*(const u32x4*)(x2 + o), r0, r1);
#pragma unroll
                    for (int i = 0; i < 4; ++i) { v0[i] = r0[i] + sigm(v0[i]) * e0[i]; v1[i] = r1[i] + sigm(v1[i]) * e1[i]; }
                    wx[bj] = pack8(v0, v1); }
                store_rows_bf16(x3, 1024, u.pm * BM + wr * 64 + ai * HALF + m * 16, u.pn * BM + wc * 64, fr, fq, wx[0], wx[1]); }
    }
};

struct EpiPleFinal {
    static constexpr bool PERM = true, AFTER_DRAIN = false, MIDK = false, FP8 = true, FINAL = true; static constexpr int SCALE_B = 0x7b;
    const bf16_t* x2; const bf16_t* e; const float* ssq; float* ssq3; unsigned* cnt; unsigned* tmo; const float* gf; float* out;
    __device__ __forceinline__ void operator()(const f32x4 (&)[2][2][4][2], const Unit&, int, int, int, int) const {}
    __device__ __forceinline__ void run(f32x4 (&acc)[2][2][4][2], const Unit& u, int wr, int wc, int fr, int fq, PG8_LAS unsigned char* lds, int wid) const {
        const int row0 = u.pm * BM + wr * 64 + fr;
        float sq8[8], sv[8];
#pragma unroll
        for (int k = 0; k < 8; ++k) sq8[k] = ssq[row0 + (k >> 2) * HALF + (k & 3) * 16];
        const size_t ob = (size_t)row0 * 1024 + u.pn * BM + wc * 64 + 8 * fq;
        u32x4 eq[8][2], xq[8][2];
#define PG8_ELD(k) do { const size_t o_ = ob + (size_t)(((k) >> 2) * HALF + ((k) & 3) * 16) * 1024; eq[k][0] = *(const u32x4*)(e + o_); xq[k][0] = *(const u32x4*)(x2 + o_); eq[k][1] = *(const u32x4*)(e + o_ + 32); xq[k][1] = *(const u32x4*)(x2 + o_ + 32); } while (0)
        PG8_ELD(0); PG8_ELD(1);
#pragma unroll
        for (int k = 0; k < 8; ++k) { const int ai = k >> 2, m = k & 3; float s = 0.f;
            if (k + 2 < 8) PG8_ELD(k + 2);
            const float rstd = rsqrtf(sq8[k] * (1.0f / 1024.0f) + 1e-6f);
#pragma unroll
            for (int bj = 0; bj < 2; ++bj) { f32x4 v0 = acc[ai][bj][m][0] * rstd, v1 = acc[ai][bj][m][1] * rstd, e0, e1, r0, r1; unpack8(eq[k][bj], e0, e1); unpack8(xq[k][bj], r0, r1);
#pragma unroll
                for (int i = 0; i < 4; ++i) { v0[i] = r0[i] + sigm(v0[i]) * e0[i]; v1[i] = r1[i] + sigm(v1[i]) * e1[i]; }
                s += (v0[0] * v0[0] + v0[1] * v0[1]) + (v0[2] * v0[2] + v0[3] * v0[3]) + (v1[0] * v1[0] + v1[1] * v1[1]) + (v1[2] * v1[2] + v1[3] * v1[3]);
                acc[ai][bj][m][0] = v0; acc[ai][bj][m][1] = v1; }
            s += __shfl_xor(s, 16); s += __shfl_xor(s, 32); sv[k] = s;
            asm volatile("" : "+v"(acc[ai][0][m][0]), "+v"(acc[ai][0][m][1]), "+v"(acc[ai][1][m][0]), "+v"(acc[ai][1][m][1]), "+v"(sv[k]) :: "memory"); }
#undef PG8_ELD
        if (fq == 0) {
#pragma unroll
            for (int k = 0; k < 8; ++k) atomicAdd(ssq3 + row0 + (k >> 2) * HALF + (k & 3) * 16, sv[k]); }
        asm volatile("s_waitcnt vmcnt(0)" ::: "memory");
        __builtin_amdgcn_s_barrier();
        if (threadIdx.x == 0) {
            (void)__hip_atomic_fetch_add(cnt + u.pm, 1u, __ATOMIC_RELAXED, __HIP_MEMORY_SCOPE_AGENT);
            unsigned sp = 0u;
            while (__hip_atomic_load(cnt + u.pm, __ATOMIC_RELAXED, __HIP_MEMORY_SCOPE_AGENT) < 4u) { __builtin_amdgcn_s_sleep(1);
                if ((++sp & 255u) == 0u) { if (__hip_atomic_load(tmo, __ATOMIC_RELAXED, __HIP_MEMORY_SCOPE_AGENT)) break; if (sp > (1u << 18)) { atomicAdd(tmo, 1u); break; } } }
        }
        __builtin_amdgcn_s_barrier();
        asm volatile("" ::: "memory");
        const int lane = fr + 16 * fq, rr = lane >> 3, c = lane & 7;
        PG8_LAS float* tb = (PG8_LAS float*)(lds + 131072 + wid * 2048);
        PG8_LAS float* wp0 = tb + fr * 32 + (((2 * fq) ^ (fr & 7)) << 2); PG8_LAS float* wp1 = tb + fr * 32 + (((2 * fq + 1) ^ (fr & 7)) << 2);
        const PG8_LAS float* rp = tb + rr * 32 + ((c ^ rr) << 2);
        const float* gp = gf + u.pn * BM + wc * 64 + 4 * c; const f32x4 g0 = *(const f32x4*)gp, g1 = *(const f32x4*)(gp + 32);
        float q8[8];
#pragma unroll
        for (int k = 0; k < 8; ++k) q8[k] = __hip_atomic_load(ssq3 + row0 + (k >> 2) * HALF + (k & 3) * 16, __ATOMIC_RELAXED, __HIP_MEMORY_SCOPE_AGENT);
#pragma unroll
        for (int ai = 0; ai < 2; ++ai)
#pragma unroll
            for (int m = 0; m < 4; ++m) {
                const float rstd3 = rsqrtf(q8[4 * ai + m] * (1.0f / 1024.0f) + 1e-6f);
#pragma unroll
                for (int bj = 0; bj < 2; ++bj) {
                    *(PG8_LAS f32x4*)wp0 = acc[ai][bj][m][0] * rstd3; *(PG8_LAS f32x4*)wp1 = acc[ai][bj][m][1] * rstd3;
                    asm volatile("s_waitcnt lgkmcnt(0)" ::: "memory");
                    const f32x4 a = *(const PG8_LAS f32x4*)rp, b = *(const PG8_LAS f32x4*)(rp + 256);
                    asm volatile("s_waitcnt lgkmcnt(0)" ::: "memory");
                    float* p = out + (size_t)(u.pm * BM + wr * 64 + ai * HALF + m * 16 + rr) * 1024 + u.pn * BM + wc * 64 + bj * 32 + 4 * c;
                    const f32x4 gg = bj ? g1 : g0;
                    *(f32x4*)p = a * gg; *(f32x4*)(p + 8 * 1024) = b * gg; }
            }
    }
};

typedef int i32x8 __attribute__((ext_vector_type(8))); typedef int i32x4 __attribute__((ext_vector_type(4)));
__device__ __forceinline__ i32x8 cat8(bf16x8 a, bf16x8 b) { return __builtin_shufflevector(__builtin_bit_cast(i32x4, a), __builtin_bit_cast(i32x4, b), 0, 1, 2, 3, 4, 5, 6, 7); }
template <bool F8> struct Frag { bf16x8 v4[2]; i32x8 v8; __device__ __forceinline__ void set(bf16x8 a, bf16x8 b) { if constexpr (F8) v8 = cat8(a, b); else { v4[0] = a; v4[1] = b; } } };
template <class Epi, class Sched, bool ALIGN_EPI = false, bool SP2 = false>
__device__ __forceinline__ void gemm_phase(PG8_LAS unsigned char* lds, const Gemm g, const Sched& S, const Epi& E) {
    int tid_ = threadIdx.x; asm volatile("" : "+v"(tid_));
    const int tid = tid_, wid = __builtin_amdgcn_readfirstlane(tid >> 6), lane = tid & 63, wr = wid >> 2, wc = wid & 3, fr = lane & 15, fq = lane >> 4;
    int K_ = g.K; asm volatile("" : "+s"(K_));
    const int K = K_, nt = K / BK;
    unsigned voffA[2], voffB[2];
#pragma unroll
    for (int i = 0; i < 2; ++i) { int R, C; stage_rc(tid * 16 + i * 8192, R, C); const int Rb = Epi::PERM ? (2 * (R & ~31) + perm32(R & 31)) : R;
        voffA[i] = (unsigned)(R * K + C) * 2u; voffB[i] = (unsigned)(Rb * K + C) * 2u; }
    const size_t kstep = (size_t)(BK * 2);
    const size_t hstep = (size_t)HALF * K * 2;
    const size_t hstepB = Epi::PERM ? (size_t)32 * K * 2 : hstep;
    const size_t tstep = 2 * hstep;
    const unsigned ldsw = (unsigned)wid * 1024u;
    const int aoff = lds_byte(wr * 64 + fr, fq * 8), boff = lds_byte(wc * 32 + fr, fq * 8);
#define PG8_SA(b, h) (((b) * 2 + (h)) * HTB)
#define PG8_SB(b, h) ((4 + (b) * 2 + (h)) * HTB)
#define PG8_STAGE(bufoff, gbase, voff) do { _Pragma("unroll") for (int _i = 0; _i < 2; ++_i) \
        __builtin_amdgcn_global_load_lds((const unsigned*)((const char*)(gbase) + (voff)[_i]), (PG8_LAS unsigned*)(lds + (bufoff) + ldsw + _i * 8192), 16, 0, 0); } while (0)
#define PG8_LDA(dst, b, h) do { _Pragma("unroll") for (int m = 0; m < 4; ++m) { const bf16x8 f0_ = *(const PG8_LAS bf16x8*)(lds + PG8_SA(b, h) + aoff + m * 2048), f1_ = *(const PG8_LAS bf16x8*)(lds + PG8_SA(b, h) + aoff + m * 2048 + 1024); dst[m].set(f0_, f1_); } } while (0)
#define PG8_LDB(dst, b, h) do { _Pragma("unroll") for (int n = 0; n < 2; ++n) { const bf16x8 f0_ = *(const PG8_LAS bf16x8*)(lds + PG8_SB(b, h) + boff + n * 2048), f1_ = *(const PG8_LAS bf16x8*)(lds + PG8_SB(b, h) + boff + n * 2048 + 1024); dst[n].set(f0_, f1_); } } while (0)
#define PG8_MMA(ai, bj, At, Bt) do { __builtin_amdgcn_s_setprio(1); \
        if constexpr (Epi::FP8) { _Pragma("unroll") for (int m = 0; m < 4; ++m) _Pragma("unroll") for (int n = 0; n < 2; ++n) \
            asm volatile("v_mfma_scale_f32_16x16x128_f8f6f4 %0, %1, %2, %0, %3, %4 op_sel_hi:[0,0,0]" : "+v"(acc[ai][bj][m][n]) : "v"(Bt[n].v8), "v"(At[m].v8), "v"(sclB), "v"(sclA)); } \
        else { _Pragma("unroll") for (int m = 0; m < 4; ++m) _Pragma("unroll") for (int n = 0; n < 2; ++n) _Pragma("unroll") for (int k = 0; k < 2; ++k) \
            acc[ai][bj][m][n] = __builtin_amdgcn_mfma_f32_16x16x32_bf16(Bt[n].v4[k], At[m].v4[k], acc[ai][bj][m][n], 0, 0, 0); } \
        __builtin_amdgcn_s_setprio(0); } while (0)
#define PG8_WAIT_V(n) asm volatile("s_waitcnt vmcnt(" #n ")" ::: "memory")
#define PG8_WAIT_L(n) asm volatile("s_waitcnt lgkmcnt(" #n ")" ::: "memory")
#define PG8_BAR __builtin_amdgcn_s_barrier()
#define PG8_SCHED __builtin_amdgcn_sched_barrier(0)
    Unit cur, nxt; int ui = 0;
    if (!S.next(0, cur)) return;
    f32x4 acc[2][2][4][2];
#pragma unroll
    for (int a = 0; a < 2; ++a)
#pragma unroll
        for (int b = 0; b < 2; ++b)
#pragma unroll
            for (int m = 0; m < 4; ++m)
#pragma unroll
                for (int n = 0; n < 2; ++n) acc[a][b][m][n] = (f32x4){0.f, 0.f, 0.f, 0.f};
    Frag<Epi::FP8> At[4], B0[2], B1[2];
    const int sclB = Epi::SCALE_B, sclA = 0x7f;
    const char* cA = (const char*)g.A + (size_t)cur.pm * tstep; const char* cB = (const char*)g.Bt + (size_t)cur.pn * tstep;
    S.a_ready(cur);
    if constexpr (SP2) {
        PG8_STAGE(PG8_SB(0, 0), cB, voffB); PG8_STAGE(PG8_SB(0, 1), cB + hstepB, voffB); PG8_STAGE(PG8_SA(0, 0), cA, voffA); PG8_STAGE(PG8_SA(0, 1), cA + hstep, voffA);
        if (wr == 1) PG8_BAR;
        PG8_WAIT_V(2); PG8_BAR;
        PG8_STAGE(PG8_SB(1, 0), cB + kstep, voffB); PG8_STAGE(PG8_SA(1, 0), cA + kstep, voffA); PG8_STAGE(PG8_SB(1, 1), cB + hstepB + kstep, voffB);
        PG8_WAIT_V(6); PG8_BAR;
    } else {
        PG8_STAGE(PG8_SB(0, 0), cB, voffB); PG8_STAGE(PG8_SA(0, 0), cA, voffA); PG8_STAGE(PG8_SB(0, 1), cB + hstepB, voffB); PG8_STAGE(PG8_SA(0, 1), cA + hstep, voffA);
        if (wr == 1) PG8_BAR;
        PG8_WAIT_V(4); PG8_BAR;
        PG8_STAGE(PG8_SB(1, 0), cB + kstep, voffB); PG8_STAGE(PG8_SA(1, 0), cA + kstep, voffA); PG8_STAGE(PG8_SB(1, 1), cB + hstepB + kstep, voffB);
        PG8_WAIT_V(6); PG8_BAR;
    }
    for (;;) {
        const bool has_next = S.next(ui + 1, nxt);
        const char* nA = has_next ? (const char*)g.A + (size_t)nxt.pm * tstep : cA; const char* nB = has_next ? (const char*)g.Bt + (size_t)nxt.pn * tstep : cB;
        for (int t = 0; t < nt; t += 2) {
            if constexpr (Epi::MIDK) { if (t == (nt >> 1)) E.mid(acc, cur, wr, wc, fr, fq); }
            const bool last = (t == nt - 2);
            const char* a1 = cA + (size_t)(t + 1) * kstep;
            const char* a2 = last ? nA : cA + (size_t)(t + 2) * kstep; const char* b2 = last ? nB : cB + (size_t)(t + 2) * kstep;
            const char* a3 = a2 + kstep; const char* b3 = b2 + kstep;
            if (last && has_next) S.a_ready(nxt);
            if constexpr (SP2) {
            PG8_LDB(B0, 0, 0); PG8_LDB(B1, 0, 1); PG8_SCHED; PG8_LDA(At, 0, 0); PG8_STAGE(PG8_SA(1, 1), a1 + hstep, voffA);
            PG8_WAIT_V(8); PG8_WAIT_L(0); PG8_BAR; PG8_MMA(0, 0, At, B0); PG8_MMA(0, 1, At, B1); PG8_BAR; PG8_SCHED;
            PG8_LDA(At, 0, 1); PG8_STAGE(PG8_SB(0, 0), b2, voffB); PG8_STAGE(PG8_SB(0, 1), b2 + hstepB, voffB); PG8_STAGE(PG8_SA(0, 0), a2, voffA);
            PG8_WAIT_V(8); PG8_WAIT_L(0); PG8_BAR; PG8_MMA(1, 0, At, B0); PG8_MMA(1, 1, At, B1); PG8_BAR; PG8_SCHED;
            PG8_LDB(B0, 1, 0); PG8_LDB(B1, 1, 1); PG8_SCHED; PG8_LDA(At, 1, 0); PG8_STAGE(PG8_SA(0, 1), a2 + hstep, voffA);
            PG8_WAIT_V(8); PG8_WAIT_L(0); PG8_BAR; PG8_MMA(0, 0, At, B0); PG8_MMA(0, 1, At, B1); PG8_BAR; PG8_SCHED;
            PG8_LDA(At, 1, 1); PG8_STAGE(PG8_SB(1, 0), b3, voffB); PG8_STAGE(PG8_SB(1, 1), b3 + hstepB, voffB); PG8_STAGE(PG8_SA(1, 0), a3, voffA);
            PG8_WAIT_V(8); PG8_WAIT_L(0); PG8_BAR; PG8_MMA(1, 0, At, B0); PG8_MMA(1, 1, At, B1); PG8_BAR; PG8_SCHED;
            } else {
            PG8_LDB(B0, 0, 0); PG8_SCHED; PG8_LDA(At, 0, 0); PG8_STAGE(PG8_SA(1, 1), a1 + hstep, voffA);
            PG8_WAIT_L(8); PG8_BAR; PG8_WAIT_L(0); PG8_MMA(0, 0, At, B0); PG8_BAR; PG8_SCHED;
            PG8_LDB(B1, 0, 1); PG8_STAGE(PG8_SB(0, 0), b2, voffB);
            PG8_BAR; PG8_WAIT_L(0); PG8_MMA(0, 1, At, B1); PG8_BAR;
            PG8_LDA(At, 0, 1); PG8_STAGE(PG8_SA(0, 0), a2, voffA);
            PG8_BAR; PG8_WAIT_L(0); PG8_MMA(1, 0, At, B0); PG8_BAR; PG8_SCHED;
            PG8_STAGE(PG8_SB(0, 1), b2 + hstepB, voffB);
            PG8_WAIT_V(6); PG8_BAR; PG8_MMA(1, 1, At, B1); PG8_BAR;
            PG8_LDB(B0, 1, 0); PG8_SCHED; PG8_LDA(At, 1, 0); PG8_STAGE(PG8_SA(0, 1), a2 + hstep, voffA);
            PG8_WAIT_L(8); PG8_BAR; PG8_WAIT_L(0); PG8_MMA(0, 0, At, B0); PG8_BAR; PG8_SCHED;
            PG8_LDB(B1, 1, 1); PG8_STAGE(PG8_SB(1, 0), b3, voffB);
            PG8_BAR; PG8_WAIT_L(0); PG8_MMA(0, 1, At, B1); PG8_BAR;
            PG8_LDA(At, 1, 1); PG8_STAGE(PG8_SA(1, 0), a3, voffA);
            PG8_BAR; PG8_WAIT_L(0); PG8_MMA(1, 0, At, B0); PG8_BAR; PG8_SCHED;
            PG8_STAGE(PG8_SB(1, 1), b3 + hstepB, voffB);
            PG8_WAIT_V(6); PG8_BAR; PG8_MMA(1, 1, At, B1); PG8_BAR;
            }
        }
        if constexpr (ALIGN_EPI) { if (wr == 0) PG8_BAR; }
        if constexpr (Epi::FINAL) { E.run(acc, cur, wr, wc, fr, fq, lds, wid); S.done(cur); }
        else if constexpr (!Epi::AFTER_DRAIN) { E(acc, cur, wr, wc, fr, fq); S.done(cur); }
        if (!has_next) break;
#pragma unroll
        for (int a = 0; a < 2; ++a)
#pragma unroll
            for (int b = 0; b < 2; ++b)
#pragma unroll
                for (int m = 0; m < 4; ++m)
#pragma unroll
                    for (int n = 0; n < 2; ++n) acc[a][b][m][n] = (f32x4){0.f, 0.f, 0.f, 0.f};
        cur = nxt; cA = nA; cB = nB; ++ui;
        if constexpr (ALIGN_EPI) { if (wr == 1) PG8_BAR; }
    }
    PG8_WAIT_V(0);
    if constexpr (!ALIGN_EPI) { if (wr == 0) PG8_BAR; }
    PG8_BAR;
    if constexpr (Epi::AFTER_DRAIN) { E.fused(acc, cur, wr, wc, fr, fq, lds, wid, lane); S.done(cur); }
#undef PG8_SA
#undef PG8_SB
#undef PG8_STAGE
#undef PG8_LDA
#undef PG8_LDB
#undef PG8_MMA
#undef PG8_WAIT_V
#undef PG8_WAIT_L
#undef PG8_BAR
#undef PG8_SCHED
}
}

#define GAS __attribute__((address_space(1)))
#define LAS __attribute__((address_space(3)))
typedef unsigned short bf16;
typedef unsigned v4u __attribute__((ext_vector_type(4)));
typedef unsigned v2u __attribute__((ext_vector_type(2)));
typedef float f32x4 __attribute__((ext_vector_type(4)));
using pg8::bf_lo; using pg8::bf_hi; using pg8::sigm;

constexpr int NTOK = 32768, SEQ = 16384, DM = 1024, NW = 8;
constexpr float EPS = 1e-6f;
constexpr float C2 = 0.125f * 1.4426950408889634f;
constexpr size_t MiB = 1u << 20;
constexpr size_t WS_W1T = 1 * MiB, WS_WAT = 12 * MiB, WS_WMT = 13 * MiB, WS_WOT = 14 * MiB, WS_WQT = 16 * MiB, WS_WGT = 20 * MiB, WS_WPT = 22 * MiB;
constexpr size_t WS_K1B = 22 * MiB + 512 * 1024, WS_K2B = 22 * MiB + 768 * 1024, WS_IF = 23 * MiB, WS_UB = 24 * MiB, WS_VB = 56 * MiB;
constexpr size_t WS_XN = 88 * MiB, WS_YA = 88 * MiB, WS_YM = 120 * MiB, WS_HN = 88 * MiB;
constexpr size_t WS_QKVA = 152 * MiB, WS_QKM = 248 * MiB, WS_VM = 312 * MiB, WS_OM = 344 * MiB, WS_G = 376 * MiB;
constexpr size_t WS_DN = 504 * MiB, WS_NS = 505 * MiB, WS_SC = 506 * MiB;
constexpr size_t WS_MERGED = 152 * MiB, WS_TMP = 216 * MiB, WS_Q2 = 376 * MiB, WS_IDX = 152 * MiB, WS_GATE = 168 * MiB, WS_HN2 = 184 * MiB, WS_PB = 56 * MiB, WS_E = 264 * MiB;
constexpr size_t WS_NEED = 507 * MiB;
constexpr size_t WS_U8 = 24 * MiB, WS_V8 = 40 * MiB, WS_PART = 376 * MiB, WS_SSQ = 506 * MiB + 512 * 1024;
constexpr size_t WS_XQ8 = 280 * MiB;
constexpr size_t WS_W1F8 = 1 * MiB;
constexpr size_t WS_X2B8 = 184 * MiB, WS_WG8 = 72 * MiB;
constexpr size_t WS_SUR = 240 * MiB, WS_SVR = 256 * MiB;
constexpr size_t WS_REC = 216 * MiB;
constexpr size_t WS_X3B = 376 * MiB;
constexpr size_t WS_U4 = 24 * MiB, WS_V4 = 32 * MiB, WS_SU = 40 * MiB, WS_SV = 40 * MiB + 65536;
constexpr size_t WS_SSQ1 = 506 * MiB + 768 * 1024, WS_SSQ3 = 506 * MiB + 640 * 1024, WS_BAR = 0, BAR_BYTES = 32768;
constexpr int BAR_CNT13 = 5120;
constexpr size_t OUT_DC = 0, OUT_CS = 64 * MiB;
constexpr int LDS_BYTES = 152576;

__device__ __forceinline__ unsigned f2bf(float f) { unsigned u = __float_as_uint(f); return (u + 0x7fffu + ((u >> 16) & 1u)) >> 16; }
__device__ __forceinline__ unsigned pk2(float lo, float hi) { return f2bf(lo) | (f2bf(hi) << 16); }
__device__ __forceinline__ float bf2f(bf16 b) { return __uint_as_float((unsigned)b << 16); }
__device__ __forceinline__ float wave_sum(float v) {
#pragma unroll
    for (int o = 1; o < 64; o <<= 1) v += __shfl_xor(v, o);
    return v;
}
__device__ __forceinline__ float wave_max(float v) {
#pragma unroll
    for (int o = 1; o < 64; o <<= 1) v = fmaxf(v, __shfl_xor(v, o));
    return v;
}
__device__ __forceinline__ void unpk8(const v4u w, float* f) { f[0] = bf_lo(w.x); f[1] = bf_hi(w.x); f[2] = bf_lo(w.y); f[3] = bf_hi(w.y); f[4] = bf_lo(w.z); f[5] = bf_hi(w.z); f[6] = bf_lo(w.w); f[7] = bf_hi(w.w); }
__device__ __forceinline__ v4u pk8(const float* f) { v4u w; w.x = pk2(f[0], f[1]); w.y = pk2(f[2], f[3]); w.z = pk2(f[4], f[5]); w.w = pk2(f[6], f[7]); return w; }
typedef __bf16 bf16x2_t __attribute__((ext_vector_type(2)));
__device__ __forceinline__ float dot2bf(unsigned a, unsigned b, float c) { return __builtin_amdgcn_fdot2_f32_bf16(__builtin_bit_cast(bf16x2_t, a), __builtin_bit_cast(bf16x2_t, b), c, false); }
__device__ __forceinline__ float logsigmoid(float x) { return fminf(x, 0.f) - log1pf(__expf(-fabsf(x))); }
__device__ __forceinline__ float silu(float x) { return x * __builtin_amdgcn_rcpf(1.0f + __builtin_amdgcn_exp2f(-1.4426950408889634f * x)); }

#define XB_TMO      128
#define XB_XCNT(j)  (256  + 64 * (j))
#define XB_XSUB(j)  (1280 + 64 * (j))
#define XB_XGEN(j)  (2304 + 64 * (j))
#define XB_TOP      3328
#define XB_TOPGEN   3392
#define XCD_BAR_WORDS 3456
#define XB_SPIN_CAP (1u << 18)

__device__ __forceinline__ unsigned xb_ld(unsigned* p)              { return __hip_atomic_load(p, __ATOMIC_RELAXED, __HIP_MEMORY_SCOPE_AGENT); }
__device__ __forceinline__ unsigned xb_add(unsigned* p, unsigned v) { return __hip_atomic_fetch_add(p, v, __ATOMIC_RELAXED, __HIP_MEMORY_SCOPE_AGENT); }
__device__ __forceinline__ unsigned xb_xcc_id() { return (unsigned)__builtin_amdgcn_s_getreg((3 << 11) | 20) & 0xFu; }
#define XB_SPIN(cond, bar) do { unsigned _sp = 0; while (cond) { __builtin_amdgcn_s_sleep(1); \
    if ((++_sp & 255u) == 0u) { if (xb_ld(&(bar)[XB_TMO])) break; if (_sp > XB_SPIN_CAP) { atomicAdd(&(bar)[XB_TMO], 1u); break; } } } } while (0)

struct XcdBarrier {
    unsigned* bar; unsigned x;
    volatile LAS unsigned* st;
};

__device__ __forceinline__ XcdBarrier xcd_barrier_post(unsigned* bar, volatile LAS unsigned* st) {
    XcdBarrier b; b.bar = bar; b.x = xb_xcc_id(); b.st = st;
    if (threadIdx.x == 0) (void)xb_add(&bar[XB_XCNT(b.x)], 1u);
    return b;
}
__device__ __forceinline__ void xcd_barrier_complete(unsigned* bar, unsigned x, unsigned& nloc, unsigned& nx) {
    const unsigned G = gridDim.x * gridDim.y * gridDim.z;
    unsigned sum, cnt, mine, sp = 0u;
    for (;;) {
        sum = 0u; cnt = 0u; mine = 0u;
#pragma unroll
        for (unsigned j = 0; j < 16; ++j) { const unsigned c = xb_ld(&bar[XB_XCNT(j)]); sum += c; cnt += (c > 0u) ? 1u : 0u; mine = (j == x) ? c : mine; }
        if (sum == G) break;
        __builtin_amdgcn_s_sleep(1);
        if ((++sp & 255u) == 0u) { if (xb_ld(&bar[XB_TMO])) break; if (sp > XB_SPIN_CAP) { atomicAdd(&bar[XB_TMO], 1u); break; } }
    }
    nloc = mine > 0u ? mine : 1u; nx = cnt > 0u ? cnt : 1u;
}

__device__ __forceinline__ void xcd_barrier(const XcdBarrier& b) {
    asm volatile("s_waitcnt vmcnt(0)" ::: "memory");
    __syncthreads();
    if (threadIdx.x == 0) {
        unsigned* bar = b.bar;
        __builtin_amdgcn_s_waitcnt(0);
        unsigned nloc = b.st[0], nx = b.st[1];
        if (nloc == 0u) { xcd_barrier_complete(bar, b.x, nloc, nx); b.st[0] = nloc; b.st[1] = nx; }
        const unsigned old = xb_add(&bar[XB_XSUB(b.x)], 1u);
        const unsigned gen = old / nloc;
        if (old + 1u == (gen + 1u) * nloc) {
            __builtin_amdgcn_fence(__ATOMIC_RELEASE, "agent");
            asm volatile("s_waitcnt vmcnt(0)" ::: "memory");
            const unsigned og = xb_add(&bar[XB_TOP], 1u);
            const unsigned tg = og / nx;
            if (og + 1u == (tg + 1u) * nx) xb_add(&bar[XB_TOPGEN], 1u);
            else XB_SPIN(xb_ld(&bar[XB_TOPGEN]) == tg, bar);
            __builtin_amdgcn_fence(__ATOMIC_ACQUIRE, "agent");
            xb_add(&bar[XB_XGEN(b.x)], 1u);
            asm volatile("s_waitcnt vmcnt(0)" ::: "memory");
        } else {
            XB_SPIN(xb_ld(&bar[XB_XGEN(b.x)]) == gen, bar);
            __builtin_amdgcn_fence(__ATOMIC_ACQUIRE, "agent");
            asm volatile("s_waitcnt vmcnt(0)" ::: "memory");
        }
    }
    __syncthreads();
}


struct Params { const float* in[20]; float* out; unsigned char* ws; int ph_lo, ph_hi; };

__device__ __forceinline__ void transpose_item(const float* W, int ldw, int col0, int K, bf16* WT, int row0, LAS float* scr, int item, int nblk, int lane, int koff = 0, const float* kgain = nullptr, unsigned char* WT8 = nullptr, float sc8 = 1.0f) {
    const int kb = item / nblk, nb = item % nblk, k0 = 64 * kb, n0 = 32 * nb;
    f32x4 tv[8];
#pragma unroll
    for (int i = 0; i < 8; ++i) tv[i] = *(const f32x4*)(W + (size_t)(k0 + 8 * i + (lane >> 3)) * ldw + col0 + n0 + 4 * (lane & 7));
#pragma unroll
    for (int i = 0; i < 8; ++i) { const int kk = 8 * i + (lane >> 3); const float gk = kgain ? kgain[k0 + kk] : 1.0f; LAS float* d = scr + kk * 33 + 4 * (lane & 7);
        d[0] = tv[i][0] * gk; d[1] = tv[i][1] * gk; d[2] = tv[i][2] * gk; d[3] = tv[i][3] * gk; }
    asm volatile("s_waitcnt lgkmcnt(0)" ::: "memory");
    const int c = lane & 7;
#pragma unroll
    for (int j = 0; j < 4; ++j) { const int n = (lane >> 3) + 8 * j; const LAS float* s = scr + (8 * c) * 33 + n;
        v4u o; o.x = pk2(s[0 * 33], s[1 * 33]); o.y = pk2(s[2 * 33], s[3 * 33]); o.z = pk2(s[4 * 33], s[5 * 33]); o.w = pk2(s[6 * 33], s[7 * 33]);
        if (WT) *(v4u*)(WT + (size_t)(row0 + n0 + n) * K + koff + k0 + 8 * c) = o;
        if (WT8) { int p0 = __builtin_amdgcn_cvt_pk_fp8_f32(s[0 * 33] * sc8, s[1 * 33] * sc8, 0, false); p0 = __builtin_amdgcn_cvt_pk_fp8_f32(s[2 * 33] * sc8, s[3 * 33] * sc8, p0, true);
            int p1 = __builtin_amdgcn_cvt_pk_fp8_f32(s[4 * 33] * sc8, s[5 * 33] * sc8, 0, false); p1 = __builtin_amdgcn_cvt_pk_fp8_f32(s[6 * 33] * sc8, s[7 * 33] * sc8, p1, true);
            *(uint2*)(WT8 + (size_t)(row0 + n0 + n) * K + koff + k0 + 8 * c) = make_uint2((unsigned)p0, (unsigned)p1); } }
    asm volatile("s_waitcnt lgkmcnt(0)" ::: "memory");
}
__device__ __forceinline__ void cvt_f32_bf16(const float* src, bf16* dst, size_t n4, size_t gtid, size_t gsz) {
    for (size_t i = gtid; i < n4; i += gsz) { const f32x4 v = ((const f32x4*)src)[i]; uint2 o; o.x = pk2(v[0], v[1]); o.y = pk2(v[2], v[3]); ((uint2*)dst)[i] = o; }
}
__device__ __forceinline__ void p0_prologue(const Params& P, LAS unsigned char* lds, int tid, int lane, int wave) {
    unsigned char* ws = P.ws;
    const int gw = blockIdx.x * NW + wave, NGW = gridDim.x * NW;
    LAS float* scr = (LAS float*)(lds + wave * 8448);
    LAS float* wif = (LAS float*)(lds + 69632);
    const float* w_in = P.in[3];
    for (int i = tid; i < 8192; i += 512) wif[i] = w_in[(size_t)(i >> 3) * 5640 + 3584 + (i & 7)];
    __syncthreads();
    constexpr int I1A = 16 * 112, I1B = 16 * 64, IUP = 8 * 32, IOUT = 16 * 32, IQ = 16 * 64, IPL = 4 * 32;
    constexpr int NITEMS = I1A + I1B + 2 * IUP + IOUT + IQ + IOUT + IPL;
    for (int it = gw; it < NITEMS; it += NGW) {
        int r = it;
        if (r < I1A) { transpose_item(w_in, 5640, 0, 1024, nullptr, 0, scr, r, 112, lane, 0, nullptr, ws + WS_W1F8, 16.0f); continue; } r -= I1A;
        if (r < I1B) { transpose_item(w_in, 5640, 3592, 1024, nullptr, 3584, scr, r, 64, lane, 0, nullptr, ws + WS_W1F8, 16.0f); continue; } r -= I1B;
        if (r < IUP) { transpose_item(P.in[7], 1024, 0, 1024, (bf16*)(ws + WS_WAT), 0, scr, r, 32, lane, 0); continue; } r -= IUP;
        if (r < IUP) { transpose_item(P.in[8], 1024, 0, 1024, (bf16*)(ws + WS_WAT), 0, scr, r, 32, lane, 512); continue; } r -= IUP;
        if (r < IOUT) { transpose_item(P.in[9], 1024, 0, 1024, (bf16*)(ws + WS_WOT), 0, scr, r, 32, lane); continue; } r -= IOUT;
        if (r < IQ) { transpose_item(P.in[11], 2048, 0, 1024, (bf16*)(ws + WS_WQT), 0, scr, r, 64, lane, 0, P.in[10]); continue; } r -= IQ;
        if (r < IOUT) { transpose_item(P.in[17], 1024, 0, 1024, (bf16*)(ws + WS_WGT), 0, scr, r, 32, lane, 0, P.in[16], ws + WS_WG8, 16.0f); continue; } r -= IOUT;
        transpose_item(P.in[18], 1024, 0, 256, (bf16*)(ws + WS_WPT), 0, scr, r, 32, lane);
    }
    const size_t gtid = (size_t)blockIdx.x * 512 + tid, gsz = (size_t)gridDim.x * 512;
    cvt_f32_bf16(P.in[12], (bf16*)(ws + WS_K1B), 8 * 128 * 128 / 4, gtid, gsz);
    cvt_f32_bf16(P.in[13], (bf16*)(ws + WS_K2B), 8 * 128 * 128 / 4, gtid, gsz);
    for (size_t i = gtid; i < (size_t)NTOK; i += gsz) { ((float*)(ws + WS_SSQ))[i] = 0.f; ((float*)(ws + WS_SSQ1))[i] = 0.f; ((float*)(ws + WS_SSQ3))[i] = 0.f; }
    const float* x = P.in[0]; const float* gmix = P.in[2]; const float* gbias = P.in[5];
    float* IFb = (float*)(ws + WS_IF);
    f32x4 xgn[4], xnx[4], xny[4], xnz[4];
#pragma unroll
    for (int j = 0; j < 4; ++j) { xgn[j] = ((const f32x4*)gmix)[lane + 64 * j]; if (gw < NTOK) xnx[j] = ((const f32x4*)(x + (size_t)gw * 1024))[lane + 64 * j]; if (gw + NGW < NTOK) xny[j] = ((const f32x4*)(x + (size_t)(gw + NGW) * 1024))[lane + 64 * j]; if (gw + 2 * NGW < NTOK) xnz[j] = ((const f32x4*)(x + (size_t)(gw + 2 * NGW) * 1024))[lane + 64 * j]; }
    for (int m = gw; m < NTOK; m += NGW) {
        f32x4 v[4];
#pragma unroll
        for (int j = 0; j < 4; ++j) { v[j] = xnx[j]; xnx[j] = xny[j]; xny[j] = xnz[j]; }
        if (m + 3 * NGW < NTOK) {
#pragma unroll
            for (int j = 0; j < 4; ++j) xnz[j] = ((const f32x4*)(x + (size_t)(m + 3 * NGW) * 1024))[lane + 64 * j];
        }
        float a16[16];
#pragma unroll
        for (int i = 0; i < 16; ++i) a16[i] = 0.f;
#pragma unroll
        for (int j = 0; j < 4; ++j) {
            const f32x4 g = xgn[j];
#pragma unroll
            for (int i = 0; i < 4; ++i) { a16[0] += v[j][i] * v[j][i]; v[j][i] *= g[i]; const int d = 4 * (lane + 64 * j) + i; const f32x4 wa = *(const LAS f32x4*)(wif + d * 8), wb = *(const LAS f32x4*)(wif + d * 8 + 4);
                a16[1] += v[j][i] * wa[0]; a16[2] += v[j][i] * wa[1]; a16[3] += v[j][i] * wa[2]; a16[4] += v[j][i] * wa[3]; a16[5] += v[j][i] * wb[0]; a16[6] += v[j][i] * wb[1]; a16[7] += v[j][i] * wb[2]; a16[8] += v[j][i] * wb[3]; }
        }
        float r8[8], r4[4], r2[2], r1;
        { const bool b = lane & 32;
#pragma unroll
          for (int i = 0; i < 8; ++i) { const float keep = b ? a16[8 + i] : a16[i], send = b ? a16[i] : a16[8 + i]; r8[i] = keep + __shfl_xor(send, 32); } }
        { const bool b = lane & 16;
#pragma unroll
          for (int i = 0; i < 4; ++i) { const float keep = b ? r8[4 + i] : r8[i], send = b ? r8[i] : r8[4 + i]; r4[i] = keep + __shfl_xor(send, 16); } }
        { const bool b = lane & 8;
#pragma unroll
          for (int i = 0; i < 2; ++i) { const float keep = b ? r4[2 + i] : r4[i], send = b ? r4[i] : r4[2 + i]; r2[i] = keep + __shfl_xor(send, 8); } }
        { const bool b = lane & 4; const float keep = b ? r2[1] : r2[0], send = b ? r2[0] : r2[1]; r1 = keep + __shfl_xor(send, 4); }
        r1 += __shfl_xor(r1, 2); r1 += __shfl_xor(r1, 1);
        const float rstd = rsqrtf(__shfl(r1, 0) * (1.f / 1024.f) + EPS);
#pragma unroll
        for (int j = 0; j < 4; ++j) {
            int p8 = __builtin_amdgcn_cvt_pk_fp8_f32(v[j][0] * rstd, v[j][1] * rstd, 0, false); p8 = __builtin_amdgcn_cvt_pk_fp8_f32(v[j][2] * rstd, v[j][3] * rstd, p8, true); ((int*)((unsigned char*)P.out + (size_t)m * 1024))[lane + 64 * j] = p8; }
        const int which = ((lane >> 5) & 1) * 8 + ((lane >> 4) & 1) * 4 + ((lane >> 3) & 1) * 2 + ((lane >> 2) & 1);
        if ((lane & 3) == 0 && which >= 1 && which <= 8) IFb[(size_t)m * 8 + which - 1] = r1 * rstd + gbias[which - 1];
    }
}

__device__ __forceinline__ void p3_side_tables(const Params& P, LAS unsigned char* lds, int tid, int lane, int wave, int sb, int nsb) {
    unsigned char* ws = P.ws;
    const int gw = sb * NW + wave, NGW = nsb * NW;
    LAS float* scr = (LAS float*)(lds + wave * 8448);
    f32x4 egn[4]; { const float* gf = P.in[10]; egn[0] = ((const f32x4*)gf)[2 * lane]; egn[1] = ((const f32x4*)gf)[2 * lane + 1]; egn[2] = ((const f32x4*)gf)[128 + 2 * lane]; egn[3] = ((const f32x4*)gf)[128 + 2 * lane + 1]; }
    f32x4 vnx[4], vny[4], vnz[4];
#define P0_TROW(dst, rn_) do { const int rn = (rn_); const float* src = P.in[14 + (rn >> 14)] + (size_t)(rn & 16383) * 1024; dst[0] = ((const f32x4*)src)[2 * lane]; dst[1] = ((const f32x4*)src)[2 * lane + 1]; dst[2] = ((const f32x4*)src)[128 + 2 * lane]; dst[3] = ((const f32x4*)src)[128 + 2 * lane + 1]; } while (0)
    if (gw < 2 * 16384) P0_TROW(vnx, gw);
    if (gw + NGW < 2 * 16384) P0_TROW(vny, gw + NGW);
    if (gw + 2 * NGW < 2 * 16384) P0_TROW(vnz, gw + 2 * NGW);
    for (int rw = gw; rw < 2 * 16384; rw += NGW) {
        const int tb_ = rw >> 14, e = rw & 16383;
        f32x4 v[4]; v[0] = vnx[0]; v[1] = vnx[1]; v[2] = vnx[2]; v[3] = vnx[3];
        vnx[0] = vny[0]; vnx[1] = vny[1]; vnx[2] = vny[2]; vnx[3] = vny[3]; vny[0] = vnz[0]; vny[1] = vnz[1]; vny[2] = vnz[2]; vny[3] = vnz[3];
        if (rw + 3 * NGW < 2 * 16384) P0_TROW(vnz, rw + 3 * NGW);
        if (!tb_) { v[0] = v[0] * egn[0]; v[1] = v[1] * egn[1]; v[2] = v[2] * egn[2]; v[3] = v[3] * egn[3]; }
        float mx = 0.f, sq = 0.f;
#pragma unroll
        for (int j = 0; j < 4; ++j)
#pragma unroll
            for (int i = 0; i < 4; ++i) { mx = fmaxf(mx, fabsf(v[j][i])); sq += v[j][i] * v[j][i]; }
        mx = wave_max(mx);
        unsigned w0 = 0u, w1 = 0u; float sc;
        {
            sc = mx > 0.f ? mx * (1.0f / 6.0f) : 1.0f; const float inv = 1.0f / sc;
            w0 = __builtin_amdgcn_cvt_scalef32_pk_fp4_f32(w0, v[0][0] * inv, v[0][1] * inv, 1.0f, 0); w0 = __builtin_amdgcn_cvt_scalef32_pk_fp4_f32(w0, v[0][2] * inv, v[0][3] * inv, 1.0f, 1);
            w0 = __builtin_amdgcn_cvt_scalef32_pk_fp4_f32(w0, v[1][0] * inv, v[1][1] * inv, 1.0f, 2); w0 = __builtin_amdgcn_cvt_scalef32_pk_fp4_f32(w0, v[1][2] * inv, v[1][3] * inv, 1.0f, 3);
            w1 = __builtin_amdgcn_cvt_scalef32_pk_fp4_f32(w1, v[2][0] * inv, v[2][1] * inv, 1.0f, 0); w1 = __builtin_amdgcn_cvt_scalef32_pk_fp4_f32(w1, v[2][2] * inv, v[2][3] * inv, 1.0f, 1);
            w1 = __builtin_amdgcn_cvt_scalef32_pk_fp4_f32(w1, v[3][0] * inv, v[3][1] * inv, 1.0f, 2); w1 = __builtin_amdgcn_cvt_scalef32_pk_fp4_f32(w1, v[3][2] * inv, v[3][3] * inv, 1.0f, 3);
        }
        unsigned* dst = (unsigned*)(ws + (tb_ ? WS_V4 : WS_U4)) + (size_t)(lane >> 5) * 524288 + (size_t)e * 32 + (lane & 31);
        if (tb_) {
            LAS unsigned char* sb = (LAS unsigned char*)scr; const int l5 = lane & 31, s0 = (lane >> 5) * 128, bp = 32 * (l5 & 3) + (l5 >> 2);
            asm volatile("s_waitcnt lgkmcnt(0)" ::: "memory");
#pragma unroll
            for (int b = 0; b < 4; ++b) { sb[s0 + bp + 8 * b] = (unsigned char)(w0 >> (8 * b)); sb[256 + s0 + bp + 8 * b] = (unsigned char)(w1 >> (8 * b)); }
            asm volatile("s_waitcnt lgkmcnt(0)" ::: "memory");
            w0 = *(LAS unsigned*)(sb + 4 * lane); w1 = *(LAS unsigned*)(sb + 256 + 4 * lane);
            asm volatile("s_waitcnt lgkmcnt(0)" ::: "memory");
        }
        dst[0] = w0; dst[2 * 524288] = w1;
        if (lane == 0) ((float*)(ws + WS_SU))[2 * e + tb_] = sc;
    }
}

typedef short bf16x8 __attribute__((ext_vector_type(8)));
typedef short v4i16 __attribute__((ext_vector_type(4)));
#define MFMA16(a, b, c) __builtin_amdgcn_mfma_f32_16x16x32_bf16((a), (b), (c), 0, 0, 0)
typedef float f32x16 __attribute__((ext_vector_type(16)));
#define MFMA32(a, b, c) __builtin_amdgcn_mfma_f32_32x32x16_bf16((a), (b), (c), 0, 0, 0)
#define ATT32_LOAD(SET, PPX, T0, SHX) do { const int n_ = -128 + 32 * (PPX); \
    _Pragma("unroll") for (int c = 0; c < 4; ++c) { int tok = (T0) + ((n_ + 8 * c + lrow) << (SHX)); tok = min(max(tok, 0), SEQ - 1); const unsigned off_ = (unsigned)tok * 3072u + 1024u + (unsigned)lch * 16u; \
        kr[SET][c] = *(const v4u*)((const unsigned char*)base + off_); vr[SET][c] = *(const v4u*)((const unsigned char*)base + off_ + 1024u); } } while (0)
__device__ __forceinline__ int attn32_qoff(int stage, int u) { return stage == 0 ? 32 * u : (stage == 1 ? (u & 3) + 128 * (u >> 2) : u); }
template <int STAGE, int OFF> __device__ __forceinline__ void attn32_unit(const bf16* base, bf16* yrow0, int blk0, int u, LAS unsigned char* xtab, LAS unsigned char* kbuf, LAS unsigned char* vbuf, int lane,
                                                                         v4u (&kr)[2][4], v4u (&vr)[2][4], bf16x8 (&qb)[4], const bf16* nbase, int nt0, int nsh) {
    constexpr int SH = STAGE == 0 ? 0 : (STAGE == 1 ? 2 : 4), D = 1 << SH;
    const int qoff = attn32_qoff(STAGE, u);
    const int t0 = blk0 + qoff;
    const int qi = lane & 31, h = lane >> 5, lrow = lane >> 3, lch = lane & 7;
    const int G = lane >> 4, trq = (lane >> 2) & 3, trp = lane & 3;
    const int tr_off = (4 * (G >> 1) + trq) * 160 + (16 * (G & 1) + 4 * trp) * 2;
    const int tq = t0 + D * qi;
    LAS unsigned char* xrow = xtab + (qoff + D * qi) * 144;
    f32x16 o[2]; float m, l;
    if (STAGE == 0) {
#pragma unroll
        for (int i = 0; i < 16; ++i) { o[0][i] = 0.f; o[1][i] = 0.f; }
        m = -1e30f; l = 0.f;
    } else {
#pragma unroll
        for (int mb = 0; mb < 2; ++mb)
#pragma unroll
            for (int gq = 0; gq < 4; ++gq) { const v2u w = *(const LAS v2u*)(xrow + 2 * (32 * mb + 8 * gq + 4 * h)); o[mb][4 * gq] = bf_lo(w.x); o[mb][4 * gq + 1] = bf_hi(w.x); o[mb][4 * gq + 2] = bf_lo(w.y); o[mb][4 * gq + 3] = bf_hi(w.y); }
        m = *(const LAS float*)(xrow + 128); l = h == 0 ? *(const LAS float*)(xrow + 132) : 0.f;
    }
    const int hi = qi, lo = max(qi - 128, -(t0 >> SH));
    const unsigned mspan = (unsigned)(hi - lo);
#pragma unroll
    for (int pp = 0; pp < 5; ++pp) {
        constexpr int dummy = 0; (void)dummy;
        const int set = (pp + OFF) % 2, n0 = -128 + 32 * pp;
#pragma unroll
        for (int c = 0; c < 4; ++c) { *(LAS v4u*)(kbuf + (8 * c + lrow) * 144 + lch * 16) = kr[set][c]; *(LAS v4u*)(vbuf + (8 * c + lrow) * 160 + lch * 16) = vr[set][c]; }
        if (pp + 2 < 5) { ATT32_LOAD(set, pp + 2, t0, SH); }
        else { const bf16* base_ = base; { const bf16* base = nbase; ATT32_LOAD(set, pp + 2 - 5, nt0, nsh); } (void)base_; }
        f32x16 sc;
#pragma unroll
        for (int i = 0; i < 16; ++i) sc[i] = 0.f;
#pragma unroll
        for (int ks = 0; ks < 4; ++ks) { const bf16x8 ka = *(const LAS bf16x8*)(kbuf + qi * 144 + 32 * ks + 16 * h); sc = MFMA32(ka, qb[ks], sc); }
        if (pp == 4) {
#pragma unroll
            for (int ks = 0; ks < 4; ++ks) qb[ks] = *(const bf16x8*)(nbase + (size_t)min(nt0 + (qi << nsh), SEQ - 1) * 1536 + 16 * ks + 8 * h);
        }
        const int mbase = n0 + 4 * h - lo; float mx = -INFINITY;
#pragma unroll
        for (int rg = 0; rg < 16; ++rg) { sc[rg] = ((unsigned)(mbase + (rg & 3) + 8 * (rg >> 2)) <= mspan) ? sc[rg] : -INFINITY; mx = fmaxf(mx, sc[rg]); }
        mx = fmaxf(mx, __shfl_xor(mx, 32));
        if (__any(mx > m)) {
            const float mn = fmaxf(m, mx), alpha = __builtin_amdgcn_exp2f(m - mn); m = mn; l *= alpha;
#pragma unroll
            for (int i = 0; i < 16; ++i) { o[0][i] *= alpha; o[1][i] *= alpha; }
        }
        float ps = 0.f;
#pragma unroll
        for (int rg = 0; rg < 16; ++rg) { sc[rg] = __builtin_amdgcn_exp2f(sc[rg] - m); ps += sc[rg]; }
        l += ps;
        bf16x8 pb[2];
#pragma unroll
        for (int s2 = 0; s2 < 2; ++s2) { v4u w; w.x = pg8::cvt_pk_bf16(sc[8 * s2], sc[8 * s2 + 1]); w.y = pg8::cvt_pk_bf16(sc[8 * s2 + 2], sc[8 * s2 + 3]); w.z = pg8::cvt_pk_bf16(sc[8 * s2 + 4], sc[8 * s2 + 5]); w.w = pg8::cvt_pk_bf16(sc[8 * s2 + 6], sc[8 * s2 + 7]); pb[s2] = __builtin_bit_cast(bf16x8, w); }
#pragma unroll
        for (int mb = 0; mb < 2; ++mb)
#pragma unroll
            for (int s2 = 0; s2 < 2; ++s2) {
                LAS unsigned char* vp = vbuf + tr_off + (16 * s2) * 160 + 64 * mb;
                const v4i16 a0 = __builtin_amdgcn_ds_read_tr16_b64_v4i16((LAS v4i16*)vp), a1 = __builtin_amdgcn_ds_read_tr16_b64_v4i16((LAS v4i16*)(vp + 8 * 160));
                const bf16x8 va = __builtin_shufflevector(a0, a1, 0, 1, 2, 3, 4, 5, 6, 7);
                o[mb] = MFMA32(va, pb[s2], o[mb]);
            }
        asm volatile("" ::: "memory");
    }
    l += __shfl_xor(l, 32);
    if (STAGE < 2) {
#pragma unroll
        for (int mb = 0; mb < 2; ++mb)
#pragma unroll
            for (int gq = 0; gq < 4; ++gq) { v2u w; w.x = pk2(o[mb][4 * gq], o[mb][4 * gq + 1]); w.y = pk2(o[mb][4 * gq + 2], o[mb][4 * gq + 3]); *(LAS v2u*)(xrow + 2 * (32 * mb + 8 * gq + 4 * h)) = w; }
        if (h == 0) { *(LAS float*)(xrow + 128) = m; *(LAS float*)(xrow + 132) = l; }
    } else {
        const float inv = __builtin_amdgcn_rcpf(l);
        bf16* yo = yrow0 + (size_t)tq * 1024 + 4 * h;
#pragma unroll
        for (int mb = 0; mb < 2; ++mb)
#pragma unroll
            for (int gq = 0; gq < 4; ++gq) { uint2 w; w.x = pk2(o[mb][4 * gq] * inv, o[mb][4 * gq + 1] * inv); w.y = pk2(o[mb][4 * gq + 2] * inv, o[mb][4 * gq + 3] * inv); *(uint2*)(yo + 32 * mb + 8 * gq) = w; }
    }
}
__device__ __forceinline__ void p2_attention(const Params& P, LAS unsigned char* lds, int lane, int wave, int vb) {
    const bf16* QKVA = (const bf16*)(P.ws + WS_QKVA); bf16* YA = (bf16*)(P.ws + WS_YA);
    LAS unsigned char* kbuf = lds + wave * 9728;
    LAS unsigned char* vbuf = kbuf + 4608;
    LAS unsigned char* xtab = lds + 8 * 9728;
    const int qi = lane & 31, h = lane >> 5, lrow = lane >> 3, lch = lane & 7;
    v4u kr[2][4], vr[2][4]; bf16x8 qb[4];
    const int u0 = wave * 2, u1 = wave * 2 + 1;
    if (vb < 512) {
        const int bh = vb >> 5, tb = vb & 31, b = bh >> 3, hh = bh & 7; const bf16* base = QKVA + (size_t)b * SEQ * 1536 + hh * 64; const int t0 = tb * 512 + attn32_qoff(0, u0);
        ATT32_LOAD(0, 0, t0, 0); ATT32_LOAD(1, 1, t0, 0);
#pragma unroll
        for (int ks = 0; ks < 4; ++ks) qb[ks] = *(const bf16x8*)(base + (size_t)(t0 + qi) * 1536 + 16 * ks + 8 * h);
    }
    for (int wi = vb; wi < 512; wi += gridDim.x) {
        const int bh = wi >> 5, tb = wi & 31, b = bh >> 3, hh = bh & 7, blk0 = tb * 512;
        const bf16* base = QKVA + (size_t)b * SEQ * 1536 + hh * 64;
        bf16* yrow0 = YA + (size_t)b * SEQ * 1024 + hh * 64;
        const int wn = wi + gridDim.x < 512 ? wi + gridDim.x : wi; const int bhn = wn >> 5, tbn = wn & 31;
        const bf16* nb = QKVA + (size_t)(bhn >> 3) * SEQ * 1536 + (bhn & 7) * 64;
        attn32_unit<0, 0>(base, yrow0, blk0, u0, xtab, kbuf, vbuf, lane, kr, vr, qb, base, blk0 + attn32_qoff(0, u1), 0);
        attn32_unit<0, 1>(base, yrow0, blk0, u1, xtab, kbuf, vbuf, lane, kr, vr, qb, base, blk0 + attn32_qoff(1, u0), 2);
        __syncthreads();
        attn32_unit<1, 0>(base, yrow0, blk0, u0, xtab, kbuf, vbuf, lane, kr, vr, qb, base, blk0 + attn32_qoff(1, u1), 2);
        attn32_unit<1, 1>(base, yrow0, blk0, u1, xtab, kbuf, vbuf, lane, kr, vr, qb, base, blk0 + attn32_qoff(2, u0), 4);
        __syncthreads();
        attn32_unit<2, 0>(base, yrow0, blk0, u0, xtab, kbuf, vbuf, lane, kr, vr, qb, base, blk0 + attn32_qoff(2, u1), 4);
        attn32_unit<2, 1>(base, yrow0, blk0, u1, xtab, kbuf, vbuf, lane, kr, vr, qb, nb, tbn * 512 + attn32_qoff(0, u0), 0);
        __syncthreads();
    }
}

__device__ __forceinline__ float scan_add(float v, int lane) {
#pragma unroll
    for (int o = 1; o < 64; o <<= 1) { const float u = __shfl_up(v, o); if (lane >= o) v += u; }
    return v;
}
__device__ __forceinline__ float scan_max(float v, int lane) {
#pragma unroll
    for (int o = 1; o < 64; o <<= 1) { const float u = __shfl_up(v, o); if (lane >= o) v = fmaxf(v, u); }
    return v;
}
__device__ __forceinline__ void conv16(const bf16* QKM, const float* cw, int b, int t0, int chan, float* out) {
    const bf16* src = QKM + (size_t)b * SEQ * 1024 + chan;
    const float w0 = cw[chan], w1 = cw[1024 + chan], w2 = cw[2048 + chan], w3 = cw[3072 + chan];
    float x0 = t0 >= 3 ? bf2f(src[(size_t)(t0 - 3) * 1024]) : 0.f, x1 = t0 >= 2 ? bf2f(src[(size_t)(t0 - 2) * 1024]) : 0.f, x2 = t0 >= 1 ? bf2f(src[(size_t)(t0 - 1) * 1024]) : 0.f;
#pragma unroll
    for (int i = 0; i < 16; ++i) { const float x3 = bf2f(src[(size_t)(t0 + i) * 1024]); out[i] = silu(w0 * x0 + w1 * x1 + w2 * x2 + w3 * x3); x0 = x1; x1 = x2; x2 = x3; }
}

struct P2Raw { unsigned short qk[19], vv[16]; float w[4], lfi, ipi; };
__device__ __forceinline__ void p2_load_raw(P2Raw& R, const bf16* QKM, const bf16* VM, const float* IFb, const float* cw, int item, int tid, int lane, int wave) {
    const int bh = item >> 8, c = item & 255, b = bh >> 2, h = bh & 3, ch = tid & 127, s0 = (tid >> 7) * 16, t0 = c * 64 + s0, chan = 512 + h * 128 + ch;
    const bf16* src = QKM + (size_t)b * SEQ * 1024 + chan;
#pragma unroll
    for (int i = 0; i < 19; ++i) { const int tt = t0 - 3 + i; R.qk[i] = tt >= 0 ? src[(size_t)tt * 1024] : (unsigned short)0; }
    const bf16* vsrc = VM + ((size_t)b * SEQ + t0) * 512 + h * 128 + ch;
#pragma unroll
    for (int i = 0; i < 16; ++i) R.vv[i] = vsrc[(size_t)i * 512];
    R.w[0] = cw[chan]; R.w[1] = cw[1024 + chan]; R.w[2] = cw[2048 + chan]; R.w[3] = cw[3072 + chan];
    if (wave == 0) { const size_t row = (size_t)b * SEQ + c * 64 + lane; R.lfi = IFb[row * 8 + 4 + h]; R.ipi = IFb[row * 8 + h]; }
}
__device__ __forceinline__ void p2_mlstm_local(const Params& P, LAS unsigned char* lds, int tid, int lane, int wave, int vb) {
    const bf16* QKM = (const bf16*)(P.ws + WS_QKM); const bf16* VM = (const bf16*)(P.ws + WS_VM); const float* IFb = (const float*)(P.ws + WS_IF);
    const float* cw = P.in[4];
    bf16* DC = (bf16*)((unsigned char*)P.out + OUT_DC); float* DN = (float*)(P.ws + WS_DN); float* SC = (float*)(P.ws + WS_SC);
    LAS bf16* KWT = (LAS bf16*)lds; LAS bf16* VT = (LAS bf16*)(lds + 18432); LAS float* sw = (LAS float*)(lds + 36864);
    const int r = lane & 15, g = lane >> 4;
    P2Raw pre; pre.lfi = 0.f; pre.ipi = 0.f;
    if (vb < 2048) p2_load_raw(pre, QKM, VM, IFb, cw, vb, tid, lane, wave);
    for (int item = vb; item < 2048; item += gridDim.x) {
        const P2Raw cur = pre;
        if (wave == 0) {
            const float lf = logsigmoid(cur.lfi), ip = cur.ipi;
            const float bc = scan_add(lf, lane), gg = __shfl(bc, 63), ds = gg - bc + ip, ml = wave_max(ds);
            sw[lane] = __expf(ds - ml);
            if (lane == 0) { SC[item] = ml; SC[2048 + item] = gg; }
        }
        __syncthreads();
        if (item + (int)gridDim.x < 2048) p2_load_raw(pre, QKM, VM, IFb, cw, item + gridDim.x, tid, lane, wave);
        { const int ch = tid & 127, sq = tid >> 7, s0 = sq * 16; float o[16];
          { float x0 = bf2f(cur.qk[0]), x1 = bf2f(cur.qk[1]), x2 = bf2f(cur.qk[2]);
#pragma unroll
            for (int i = 0; i < 16; ++i) { const float x3 = bf2f(cur.qk[3 + i]); o[i] = silu(cur.w[0] * x0 + cur.w[1] * x1 + cur.w[2] * x2 + cur.w[3] * x3); x0 = x1; x1 = x2; x2 = x3; } }
#pragma unroll
          for (int i = 0; i < 16; i += 2) *(LAS unsigned*)(KWT + ch * 72 + s0 + i) = pk2(o[i] * 0.08838834764831845f * sw[s0 + i], o[i + 1] * 0.08838834764831845f * sw[s0 + i + 1]);
#pragma unroll
          for (int i = 0; i < 16; i += 2) *(LAS unsigned*)(VT + ch * 72 + s0 + i) = (unsigned)cur.vv[i] | ((unsigned)cur.vv[i + 1] << 16);
        }
        __syncthreads();
        {
          const bf16x8 vb0 = *(const LAS bf16x8*)(VT + (16 * wave + r) * 72 + 8 * g), vb1 = *(const LAS bf16x8*)(VT + (16 * wave + r) * 72 + 32 + 8 * g);
          bf16* dst = DC + (size_t)item * 16384 + (size_t)(16 * wave + r) * 128 + 4 * g;
#pragma unroll
          for (int eb = 0; eb < 8; ++eb) {
              const bf16x8 ka0 = *(const LAS bf16x8*)(KWT + (16 * eb + r) * 72 + 8 * g), ka1 = *(const LAS bf16x8*)(KWT + (16 * eb + r) * 72 + 32 + 8 * g);
              f32x4 acc = {0.f, 0.f, 0.f, 0.f};
              acc = MFMA16(ka0, vb0, acc); acc = MFMA16(ka1, vb1, acc);
              uint2 o; o.x = pk2(acc[0], acc[1]); o.y = pk2(acc[2], acc[3]); *(uint2*)(dst + 16 * eb) = o;
          }
        }
        if (tid < 128) { float a = 0.f;
#pragma unroll
            for (int cc = 0; cc < 8; ++cc) { float f[8]; unpk8(*(const LAS v4u*)(KWT + tid * 72 + 8 * cc), f);
#pragma unroll
                for (int k = 0; k < 8; ++k) a += f[k]; }
            DN[(size_t)item * 128 + tid] = a; }
        __syncthreads();
    }
}

__device__ __forceinline__ void p3_mlstm_scan(const Params& P, int tid, int vb) {
    const unsigned* __restrict__ DC = (const unsigned*)((unsigned char*)P.out + OUT_DC); unsigned* __restrict__ CS = (unsigned*)((unsigned char*)P.out + OUT_CS);
    const float* __restrict__ DN = (const float*)(P.ws + WS_DN); float* __restrict__ NS = (float*)(P.ws + WS_NS); float* SC = (float*)(P.ws + WS_SC);
    for (int gid = vb * 512 + tid; gid < 8 * 8192; gid += gridDim.x * 512) {
        const int bh = gid >> 13, idx = gid & 8191; const bool hasn = idx < 64;
        float C0 = 0.f, C1 = 0.f, n0 = 0.f, n1 = 0.f, m = 0.f;
        for (int j0 = 0; j0 < 256; j0 += 16) {
            unsigned d[16]; float ml[16], gg[16]; float2 dn[16];
#pragma unroll
            for (int u = 0; u < 16; ++u) { const int item = bh * 256 + j0 + u; d[u] = DC[(size_t)item * 8192 + idx]; ml[u] = SC[item]; gg[u] = SC[2048 + item];
                dn[u] = hasn ? *(const float2*)(DN + (size_t)item * 128 + 2 * idx) : make_float2(0.f, 0.f); }
#pragma unroll
            for (int u = 0; u < 16; ++u) { const int item = bh * 256 + j0 + u;
                CS[(size_t)item * 8192 + idx] = pk2(C0, C1);
                if (hasn) *(float2*)(NS + (size_t)item * 128 + 2 * idx) = make_float2(n0, n1);
                if (idx == 0) SC[4096 + item] = m;
                const float mn = fmaxf(gg[u] + m, ml[u]), a = __expf(gg[u] + m - mn), bb = __expf(ml[u] - mn);
                C0 = a * C0 + bb * bf_lo(d[u]); C1 = a * C1 + bb * bf_hi(d[u]); n0 = a * n0 + bb * dn[u].x; n1 = a * n1 + bb * dn[u].y; m = mn; }
        }
    }
}

struct P4Pref { v4u raw[7]; v4u cs[4]; uint2 om[4]; f32x4 gn; float ifa, ifb, nsv; };
__device__ __forceinline__ void p4_prefetch_raw(P4Pref& pf, const Params& P, int item, int tid, int lane) {
    const bf16* QKM = (const bf16*)(P.ws + WS_QKM); const bf16* VM = (const bf16*)(P.ws + WS_VM); const float* IFb = (const float*)(P.ws + WS_IF); const float* NS = (const float*)(P.ws + WS_NS);
    const int bh = item >> 8, c = item & 255, b = bh >> 2, h = bh & 3;
#pragma unroll
    for (int i = 0; i < 7; ++i) { const int v = tid + 512 * i; const int rr = v / 48, rem = v - rr * 48, seg = rem >> 4, c16 = rem & 15; const int t = c * 64 + rr - 3;
        v4u val = {0u, 0u, 0u, 0u};
        if (v < 3216 && t >= 0) val = (seg < 2) ? *(const v4u*)(QKM + ((size_t)b * SEQ + t) * 1024 + seg * 512 + h * 128 + 8 * c16) : *(const v4u*)(VM + ((size_t)b * SEQ + t) * 512 + h * 128 + 8 * c16);
        pf.raw[i] = val; }
    const size_t row = (size_t)b * SEQ + c * 64 + lane;
    pf.ifa = IFb[row * 8 + 4 + h]; pf.ifb = IFb[row * 8 + h];
    pf.nsv = NS[(size_t)item * 128 + (tid & 127)];
}
__device__ __forceinline__ void p4_prefetch_cs(P4Pref& pf, const Params& P, int item, int lane, int wave) {
    const bf16* CS = (const bf16*)((unsigned char*)P.out + OUT_CS);
    const bf16* crow = CS + (size_t)item * 16384 + (size_t)(16 * wave + (lane & 15)) * 128 + 8 * (lane >> 4);
#pragma unroll
    for (int ks = 0; ks < 4; ++ks) pf.cs[ks] = *(const v4u*)(crow + 32 * ks);
}
__device__ __forceinline__ void p4_prefetch_om(P4Pref& pf, const Params& P, int item, int lane, int wave) {
    const bf16* OM = (const bf16*)(P.ws + WS_OM);
    const int bh = item >> 8, c = item & 255, b = bh >> 2, h = bh & 3, r = lane & 15, g = lane >> 4;
#pragma unroll
    for (int tb = 0; tb < 4; ++tb) pf.om[tb] = *(const uint2*)(OM + ((size_t)b * SEQ + c * 64 + 16 * tb + r) * 512 + h * 128 + 16 * wave + 4 * g);
    pf.gn = *(const f32x4*)(P.in[6] + h * 128 + 16 * wave + 4 * g);
}
__device__ __forceinline__ void p4_mlstm_out(const Params& P, LAS unsigned char* lds, int tid, int lane, int wave, int vb) {
    const float* cw = P.in[4]; const float* SC = (const float*)(P.ws + WS_SC); bf16* YM = (bf16*)(P.ws + WS_YA);
    LAS float* CW = (LAS float*)lds;
    LAS unsigned char* RAW = lds + 16384;
    LAS bf16* Qs = (LAS bf16*)(lds + 68912); LAS bf16* Ks = (LAS bf16*)(lds + 86320); LAS bf16* VT = (LAS bf16*)(lds + 103728); LAS bf16* PT = (LAS bf16*)(lds + 122160);
    LAS float* sm = (LAS float*)(lds + 131376);
    LAS bf16* NSB = (LAS bf16*)(lds + 135728);
    const int r = lane & 15, g = lane >> 4;
    for (int i = tid; i < 1024; i += 512) ((LAS f32x4*)CW)[i] = ((const f32x4*)cw)[i];
    P4Pref pf;
    if (vb < 2048) { p4_prefetch_raw(pf, P, vb, tid, lane); p4_prefetch_cs(pf, P, vb, lane, wave); p4_prefetch_om(pf, P, vb, lane, wave); }
    for (int item = vb; item < 2048; item += gridDim.x) {
        const int bh = item >> 8, c = item & 255, b = bh >> 2, h = bh & 3;
#pragma unroll
        for (int i = 0; i < 7; ++i) { const int v = tid + 512 * i; if (v < 3216) { const int rr = v / 48, rem = v - rr * 48; *(LAS v4u*)(RAW + rr * 784 + rem * 16) = pf.raw[i]; } }
        if (tid < 128) NSB[tid] = (bf16)f2bf(pf.nsv);
        if (wave == 0) {
            const float lf = logsigmoid(pf.ifa), ip = pf.ifb;
            const float bc = scan_add(lf, lane), a = ip - bc, pm = scan_max(a, lane), ms = SC[4096 + item], M = fmaxf(ms, pm);
            sm[lane] = a; sm[64 + lane] = M; sm[128 + lane] = __expf(ms - M); sm[192 + lane] = __expf(-bc - M);
        }
        __syncthreads();
        { const int g4 = tid & 31, s0 = (tid >> 5) * 4;
#pragma unroll
          for (int tile = 0; tile < 2; ++tile) {
              float x[7][4];
#pragma unroll
              for (int j = 0; j < 7; ++j) { const v2u rv = *(const LAS v2u*)(RAW + (s0 + j) * 784 + tile * 256 + g4 * 8); x[j][0] = bf_lo(rv.x); x[j][1] = bf_hi(rv.x); x[j][2] = bf_lo(rv.y); x[j][3] = bf_hi(rv.y); }
              f32x4 w[4];
#pragma unroll
              for (int tp = 0; tp < 4; ++tp) w[tp] = *(const LAS f32x4*)(CW + tp * 1024 + tile * 512 + h * 128 + 4 * g4);
              const float sc = tile ? 0.08838834764831845f : 1.0f; LAS bf16* dst = tile ? Ks : Qs;
#pragma unroll
              for (int j = 0; j < 4; ++j) { float y[4];
#pragma unroll
                  for (int i = 0; i < 4; ++i) y[i] = silu(w[0][i] * x[j][i] + w[1][i] * x[j + 1][i] + w[2][i] * x[j + 2][i] + w[3][i] * x[j + 3][i]) * sc;
                  v2u o; o.x = pk2(y[0], y[1]); o.y = pk2(y[2], y[3]); *(LAS v2u*)(dst + (s0 + j) * 136 + 4 * g4) = o; }
          }
          const int ch = tid & 127, sv = (tid >> 7) * 16;
#pragma unroll
          for (int i = 0; i < 16; i += 2) { const unsigned lo = *(const LAS bf16*)(RAW + (3 + sv + i) * 784 + 512 + ch * 2), hi = *(const LAS bf16*)(RAW + (4 + sv + i) * 784 + 512 + ch * 2);
              *(LAS unsigned*)(VT + ch * 72 + sv + i) = lo | (hi << 16); }
        }
        asm volatile("" ::: "memory");
        if (item + (int)gridDim.x < 2048) p4_prefetch_raw(pf, P, item + gridDim.x, tid, lane);
        __syncthreads();
        { const int sb = wave >> 1;
          bf16x8 ka[4];
#pragma unroll
          for (int ks = 0; ks < 4; ++ks) ka[ks] = *(const LAS bf16x8*)(Ks + (16 * sb + r) * 136 + 32 * ks + 8 * g);
#pragma unroll
          for (int tt = 0; tt < 2; ++tt) { const int tb = 2 * (wave & 1) + tt, t = 16 * tb + r;
              f32x4 acc = {0.f, 0.f, 0.f, 0.f};
#pragma unroll
              for (int ks = 0; ks < 4; ++ks) { const bf16x8 qb = *(const LAS bf16x8*)(Qs + t * 136 + 32 * ks + 8 * g); acc = MFMA16(ka[ks], qb, acc); }
              const float Mt = sm[64 + t]; float p[4], ps = 0.f;
#pragma unroll
              for (int k = 0; k < 4; ++k) { const int s = 16 * sb + 4 * g + k; p[k] = (s <= t) ? acc[k] * __expf(sm[s] - Mt) : 0.f; ps += p[k]; }
              v2u o; o.x = pk2(p[0], p[1]); o.y = pk2(p[2], p[3]); *(LAS v2u*)(PT + t * 72 + 16 * sb + 4 * g) = o;
              ps += __shfl_xor(ps, 16); ps += __shfl_xor(ps, 32);
              if (g == 0) sm[320 + sb * 64 + t] = ps; }
        }
        __syncthreads();
        f32x4 ai[4], ac[4], an[4];
#pragma unroll
        for (int tb = 0; tb < 4; ++tb) { ai[tb] = (f32x4){0.f, 0.f, 0.f, 0.f}; ac[tb] = (f32x4){0.f, 0.f, 0.f, 0.f}; an[tb] = (f32x4){0.f, 0.f, 0.f, 0.f}; }
        { const bf16x8 va0 = *(const LAS bf16x8*)(VT + (16 * wave + r) * 72 + 8 * g), va1 = *(const LAS bf16x8*)(VT + (16 * wave + r) * 72 + 32 + 8 * g);
          const bf16x8 ca0 = __builtin_bit_cast(bf16x8, pf.cs[0]), ca1 = __builtin_bit_cast(bf16x8, pf.cs[1]), ca2 = __builtin_bit_cast(bf16x8, pf.cs[2]), ca3 = __builtin_bit_cast(bf16x8, pf.cs[3]);
          const bf16x8 zero8 = {0, 0, 0, 0, 0, 0, 0, 0};
#pragma unroll
          for (int tb = 0; tb < 4; ++tb) { const int t = 16 * tb + r;
              const bf16x8 pb0 = *(const LAS bf16x8*)(PT + t * 72 + 8 * g), pb1 = *(const LAS bf16x8*)(PT + t * 72 + 32 + 8 * g);
              ai[tb] = MFMA16(va0, pb0, ai[tb]); ai[tb] = MFMA16(va1, pb1, ai[tb]);
              const bf16x8 q0 = *(const LAS bf16x8*)(Qs + t * 136 + 8 * g), q1 = *(const LAS bf16x8*)(Qs + t * 136 + 32 + 8 * g), q2 = *(const LAS bf16x8*)(Qs + t * 136 + 64 + 8 * g), q3 = *(const LAS bf16x8*)(Qs + t * 136 + 96 + 8 * g);
              ac[tb] = MFMA16(ca0, q0, ac[tb]); ac[tb] = MFMA16(ca1, q1, ac[tb]); ac[tb] = MFMA16(ca2, q2, ac[tb]); ac[tb] = MFMA16(ca3, q3, ac[tb]);
              if (wave == 0) {
                  const bf16x8 n0 = r == 0 ? *(const LAS bf16x8*)(NSB + 8 * g) : zero8, n1 = r == 0 ? *(const LAS bf16x8*)(NSB + 32 + 8 * g) : zero8, n2 = r == 0 ? *(const LAS bf16x8*)(NSB + 64 + 8 * g) : zero8, n3 = r == 0 ? *(const LAS bf16x8*)(NSB + 96 + 8 * g) : zero8;
                  an[tb] = MFMA16(n0, q0, an[tb]); an[tb] = MFMA16(n1, q1, an[tb]); an[tb] = MFMA16(n2, q2, an[tb]); an[tb] = MFMA16(n3, q3, an[tb]);
                  if (g == 0) { const float den = sm[128 + t] * an[tb][0] + (sm[320 + t] + sm[384 + t]) + (sm[448 + t] + sm[512 + t]); sm[256 + t] = fmaxf(fabsf(den), sm[192 + t]); } } }
        }
        asm volatile("" ::: "memory");
        if (item + (int)gridDim.x < 2048) p4_prefetch_cs(pf, P, item + gridDim.x, lane, wave);
#pragma unroll
        for (int tb = 0; tb < 4; ++tb) { const int t = 16 * tb + r; const float wi = sm[128 + t]; float s2 = 0.f;
#pragma unroll
            for (int k = 0; k < 4; ++k) { ai[tb][k] = wi * ac[tb][k] + ai[tb][k]; s2 += ai[tb][k] * ai[tb][k]; }
            s2 += __shfl_xor(s2, 16); s2 += __shfl_xor(s2, 32);
            if (g == 0) sm[576 + wave * 64 + t] = s2; }
        __syncthreads();
        {
#pragma unroll
          for (int tb = 0; tb < 4; ++tb) { const int t = 16 * tb + r; float tot = 0.f;
#pragma unroll
              for (int w = 0; w < 8; ++w) tot += sm[576 + w * 64 + t];
              const float inv = __builtin_amdgcn_rcpf(sm[256 + t]), rs = inv * rsqrtf(tot * inv * inv * (1.f / 128.f) + EPS);
              const size_t row = (size_t)b * SEQ + c * 64 + t; const int col = h * 128 + 16 * wave + 4 * g;
              uint2 o; o.x = pk2(ai[tb][0] * rs * pf.gn[0] * bf_lo(pf.om[tb].x), ai[tb][1] * rs * pf.gn[1] * bf_hi(pf.om[tb].x)); o.y = pk2(ai[tb][2] * rs * pf.gn[2] * bf_lo(pf.om[tb].y), ai[tb][3] * rs * pf.gn[3] * bf_hi(pf.om[tb].y));
              *(uint2*)(YM + row * 1024 + 512 + col) = o; }
        }
        asm volatile("" ::: "memory");
        if (item + (int)gridDim.x < 2048) p4_prefetch_om(pf, P, item + gridDim.x, lane, wave);
        __syncthreads();
    }
}

__device__ __forceinline__ int f2ord(float f) { const int b = __float_as_int(f); return b ^ ((b >> 31) & 0x7fffffff); }
__device__ __forceinline__ float ord2f(int o) { return __int_as_float(o ^ ((o >> 31) & 0x7fffffff)); }
#define CE_DESC(a, i, j) { const int _h = max(a[i], a[j]), _l = min(a[i], a[j]); a[i] = _h; a[j] = _l; }
__device__ __forceinline__ void sort16_desc(int (&a)[16]) {
#pragma unroll
    for (int k = 2; k <= 16; k <<= 1) {
#pragma unroll
        for (int j = k >> 1; j > 0; j >>= 1) {
#pragma unroll
            for (int i = 0; i < 16; ++i) { const int l = i ^ j; if (l > i) { if ((i & k) == 0) CE_DESC(a, i, l) else CE_DESC(a, l, i) } }
        }
    }
}
__device__ __forceinline__ void merge16_desc(int (&a)[16], const int (&b)[16]) {
#pragma unroll
    for (int i = 0; i < 16; ++i) a[i] = max(a[i], b[15 - i]);
#pragma unroll
    for (int j = 8; j > 0; j >>= 1) {
#pragma unroll
        for (int i = 0; i < 16; ++i) { const int l = i ^ j; if (l > i) CE_DESC(a, i, l) }
    }
}
__device__ __forceinline__ void xmerge16(int (&a)[16], int mask) {
    int b[16];
#pragma unroll
    for (int i = 0; i < 16; ++i) b[i] = __shfl_xor(a[i], mask);
    merge16_desc(a, b);
}
__device__ __forceinline__ void p10_quant_store(unsigned char* XQ, int t, int lane, const v4u ra, const v4u rb) {
    float y[16]; unpk8(ra, y); unpk8(rb, y + 8);
    unsigned hi[4], lo[4];
#pragma unroll
    for (int q = 0; q < 4; ++q) {
        int h = __builtin_amdgcn_cvt_pk_fp8_f32(y[4 * q], y[4 * q + 1], 0, false); h = __builtin_amdgcn_cvt_pk_fp8_f32(y[4 * q + 2], y[4 * q + 3], h, true);
        const float r0 = (y[4 * q] - __builtin_amdgcn_cvt_f32_fp8(h, 0)) * 16.f, r1 = (y[4 * q + 1] - __builtin_amdgcn_cvt_f32_fp8(h, 1)) * 16.f, r2 = (y[4 * q + 2] - __builtin_amdgcn_cvt_f32_fp8(h, 2)) * 16.f, r3 = (y[4 * q + 3] - __builtin_amdgcn_cvt_f32_fp8(h, 3)) * 16.f;
        int l = __builtin_amdgcn_cvt_pk_fp8_f32(r0, r1, 0, false); l = __builtin_amdgcn_cvt_pk_fp8_f32(r2, r3, l, true);
        hi[q] = (unsigned)h; lo[q] = (unsigned)l; }
    v4u vh; vh.x = hi[0]; vh.y = hi[1]; vh.z = hi[2]; vh.w = hi[3]; v4u vl; vl.x = lo[0]; vl.y = lo[1]; vl.z = lo[2]; vl.w = lo[3];
    *(v4u*)(XQ + (size_t)t * 2048 + 16 * lane) = vh; *(v4u*)(XQ + (size_t)t * 2048 + 1024 + 16 * lane) = vl;
}
__device__ __forceinline__ void p10_topk(const Params& P, LAS unsigned char* lds, int tid, int lane, int wave, int vb) {
    const bf16* Q2 = (const bf16*)(P.ws + WS_Q2); const bf16* K1B = (const bf16*)(P.ws + WS_K1B); const bf16* K2B = (const bf16*)(P.ws + WS_K2B);
    unsigned char* REC = P.ws + WS_REC; float* GATE = (float*)(P.ws + WS_GATE); const float* SSQ1 = (const float*)(P.ws + WS_SSQ1);
    LAS bf16* Kl = (LAS bf16*)lds;
    LAS int* Tb = (LAS int*)(lds + 69632 + wave * 2048);
    const int r = lane & 15, g = lane >> 4;
    const int h = vb & 7, wgx = vb >> 3, nwg = gridDim.x >> 3;
    __syncthreads();
    for (int i = tid; i < 4096; i += 512) { const int half = i >> 11, rem = i & 2047, n = rem >> 4, c = rem & 15;
        *(LAS v4u*)(Kl + half * 17408 + n * 136 + c * 8) = *(const v4u*)((half ? K2B : K1B) + (size_t)h * 16384 + n * 128 + c * 8); }
    __syncthreads();
    bf16x8 qn[4];
    { const int tile0 = wgx * NW + wave;
      if (tile0 < NTOK / 16) {
#pragma unroll
          for (int ks = 0; ks < 4; ++ks) qn[ks] = *(const bf16x8*)(Q2 + ((size_t)tile0 * 16 + r) * 2048 + h * 256 + 32 * ks + 8 * g); } }
    const bf16* HNq = (const bf16*)(P.ws + WS_HN); unsigned char* XQq = P.ws + WS_XQ8; int tq = vb * NW + wave; const int tqs = (int)gridDim.x * NW;
    const float* SUVt = (const float*)(P.ws + WS_SU); float* SUR = (float*)(P.ws + WS_SUR); float* SVR = (float*)(P.ws + WS_SVR);
    const f32x4* psrc = (const f32x4*)P.in[1]; uint2* pdst = (uint2*)(P.ws + WS_PB); const size_t pn4 = (size_t)NTOK * 256 / 4; const int pgw = vb * NW + wave, pnw = (int)gridDim.x * NW; int pit = 0;
    float2 puv[4]; size_t poff = 0; bool pvalid = false;
    for (int tile = wgx * NW + wave; tile < NTOK / 16; tile += nwg * NW) {
        v4u qra0 = {0u, 0u, 0u, 0u}, qrb0 = qra0, qra1 = qra0, qrb1 = qra0;
        const size_t pi0 = ((size_t)(2 * pit) * pnw + pgw) * 64 + lane, pi1 = pi0 + (size_t)pnw * 64; f32x4 pv0 = {0.f, 0.f, 0.f, 0.f}, pv1 = pv0;
        if (pi0 < pn4) pv0 = psrc[pi0]; if (pi1 < pn4) pv1 = psrc[pi1];
        if (tq < NTOK) { qra0 = ((const v4u*)(HNq + (size_t)tq * 1024))[2 * lane]; qrb0 = ((const v4u*)(HNq + (size_t)tq * 1024))[2 * lane + 1]; }
        if (tq + tqs < NTOK) { qra1 = ((const v4u*)(HNq + (size_t)(tq + tqs) * 1024))[2 * lane]; qrb1 = ((const v4u*)(HNq + (size_t)(tq + tqs) * 1024))[2 * lane + 1]; }
        const size_t row = (size_t)tile * 16 + r;
        int R[2][16];
#pragma unroll
        for (int half = 0; half < 2; ++half) {
            bf16x8 qb[4];
#pragma unroll
            for (int ks = 0; ks < 4; ++ks) qb[ks] = qn[ks];
            { const int tnx = half == 0 ? tile : tile + nwg * NW;
              if (tnx < NTOK / 16) {
#pragma unroll
                  for (int ks = 0; ks < 4; ++ks) qn[ks] = *(const bf16x8*)(Q2 + ((size_t)tnx * 16 + r) * 2048 + h * 256 + (1 - half) * 128 + 32 * ks + 8 * g); } }
            int X[16], Y[16];
#pragma unroll
            for (int nb = 0; nb < 8; ++nb) {
                f32x4 acc = {0.f, 0.f, 0.f, 0.f};
#pragma unroll
                for (int ks = 0; ks < 4; ++ks) acc = MFMA16(*(const LAS bf16x8*)(Kl + half * 17408 + (16 * nb + r) * 136 + 32 * ks + 8 * g), qb[ks], acc);
#pragma unroll
                for (int k = 0; k < 4; ++k) { const int key = (f2ord(acc[k]) & ~0x7f) | (16 * nb + 4 * g + k); if (nb < 4) X[4 * nb + k] = key; else Y[4 * (nb - 4) + k] = key; }
            }
            sort16_desc(X); sort16_desc(Y); merge16_desc(X, Y);
            xmerge16(X, 16); xmerge16(X, 32);
#pragma unroll
            for (int i = 0; i < 16; ++i) R[half][i] = X[i];
        }
        if (g == 0) {
#pragma unroll
            for (int i = 0; i < 16; ++i) { Tb[r * 32 + i] = R[0][i] & 0x7f; Tb[r * 32 + 16 + i] = R[1][i] & 0x7f; }
        }
        float F1[16], F2[16];
#pragma unroll
        for (int i = 0; i < 16; ++i) { F1[i] = ord2f(R[0][i] & ~0x7f); F2[i] = ord2f(R[1][i] & ~0x7f); }
        int C[16];
#pragma unroll
        for (int sl = 0; sl < 16; ++sl) {
            const int a1 = sl < 8 ? 1 : (sl < 13 ? 2 : -1), b1 = sl < 8 ? sl : sl - 8;
            const int a2 = sl < 4 ? 3 : (sl < 7 ? 4 : (sl < 9 ? 5 : (sl < 11 ? 6 : (sl < 13 ? 7 : -1)))), b2 = sl < 4 ? sl : (sl < 7 ? sl - 4 : (sl < 9 ? sl - 7 : (sl < 11 ? sl - 9 : sl - 11)));
            const int a3 = sl < 8 ? 8 + sl : -1;
            const int k0 = (f2ord(F1[0] + F2[sl]) & ~0xff) | (0 << 4) | sl;
            const int k1 = a1 >= 0 ? ((f2ord(F1[a1 < 0 ? 0 : a1] + F2[b1 & 15]) & ~0xff) | (a1 << 4) | (b1 & 15)) : (int)0x80000000;
            const int k2 = a2 >= 0 ? ((f2ord(F1[a2 < 0 ? 0 : a2] + F2[b2 & 15]) & ~0xff) | (a2 << 4) | (b2 & 15)) : (int)0x80000000;
            const int k3 = a3 >= 0 ? ((f2ord(F1[a3 < 0 ? 0 : a3] + F2[0]) & ~0xff) | (a3 << 4)) : (int)0x80000000;
            C[sl] = g == 0 ? k0 : (g == 1 ? k1 : (g == 2 ? k2 : k3));
        }
        sort16_desc(C); xmerge16(C, 16); xmerge16(C, 32);
        const float rstd1 = rsqrtf(SSQ1[row] * (1.0f / 1024.0f) + EPS);
        float e[16], sum = 0.f; const float mx = ord2f(C[0] & ~0xff);
#pragma unroll
        for (int i = 0; i < 16; ++i) { e[i] = __expf((ord2f(C[i] & ~0xff) - mx) * rstd1); sum += e[i]; }
        const float inv = __builtin_amdgcn_rcpf(sum);
        int oi[4]; float og[4];
#pragma unroll
        for (int kk = 0; kk < 4; ++kk) {
            const int key = g == 0 ? C[kk] : (g == 1 ? C[4 + kk] : (g == 2 ? C[8 + kk] : C[12 + kk]));
            const float ev = g == 0 ? e[kk] : (g == 1 ? e[4 + kk] : (g == 2 ? e[8 + kk] : e[12 + kk]));
            const int a = (key >> 4) & 15, bq = key & 15;
            oi[kk] = Tb[r * 32 + a] * 128 + Tb[r * 32 + 16 + bq]; og[kk] = ev * inv;
        }
        { const int R0 = 8 * (2 * h + (g >> 1)) + 4 * (g & 1);
          *(int4*)(REC + row * 768 + 4 * R0) = make_int4(oi[0], oi[1], oi[2], oi[3]); *(float4*)(GATE + row * 128 + R0) = make_float4(og[0], og[1], og[2], og[3]);
          if (pvalid) { *(float4*)(SUR + poff) = make_float4(puv[0].x, puv[1].x, puv[2].x, puv[3].x); *(float4*)(SVR + poff) = make_float4(puv[0].y, puv[1].y, puv[2].y, puv[3].y); }
#pragma unroll
          for (int kk = 0; kk < 4; ++kk) puv[kk] = *(const float2*)(SUVt + 2 * oi[kk]);
          poff = row * 128 + R0; pvalid = true; }
        if (tq < NTOK) p10_quant_store(XQq, tq, lane, qra0, qrb0);
        if (tq + tqs < NTOK) p10_quant_store(XQq, tq + tqs, lane, qra1, qrb1);
        tq += 2 * tqs;
        if (pi0 < pn4) { uint2 o; o.x = pk2(pv0[0], pv0[1]); o.y = pk2(pv0[2], pv0[3]); pdst[pi0] = o; }
        if (pi1 < pn4) { uint2 o; o.x = pk2(pv1[0], pv1[1]); o.y = pk2(pv1[2], pv1[3]); pdst[pi1] = o; }
        ++pit;
    }
    for (size_t i = ((size_t)(2 * pit) * pnw + pgw) * 64 + lane; i < pn4; i += (size_t)pnw * 64) { const f32x4 v = psrc[i]; uint2 o; o.x = pk2(v[0], v[1]); o.y = pk2(v[2], v[3]); pdst[i] = o; }
    if (pvalid) { *(float4*)(SUR + poff) = make_float4(puv[0].x, puv[1].x, puv[2].x, puv[3].x); *(float4*)(SVR + poff) = make_float4(puv[0].y, puv[1].y, puv[2].y, puv[3].y); }
    for (; tq < NTOK; tq += tqs) p10_quant_store(XQq, tq, lane, ((const v4u*)(HNq + (size_t)tq * 1024))[2 * lane], ((const v4u*)(HNq + (size_t)tq * 1024))[2 * lane + 1]);
}

typedef _Float16 f16x2 __attribute__((ext_vector_type(2)));
__device__ __forceinline__ f16x2 bfpair_to_h2(unsigned w) { return __builtin_bit_cast(f16x2, __builtin_amdgcn_cvt_pkrtz(bf_lo(w), bf_hi(w))); }
template <int B> __device__ __forceinline__ f16x2 fp4_to_h2(unsigned w) { return __builtin_bit_cast(f16x2, __builtin_amdgcn_cvt_scalef32_pk_f16_fp4(w, 1.0f, B)); }
typedef int i32x8v __attribute__((ext_vector_type(8)));
#define U_MFMA0(acc, A, B) asm volatile("v_mfma_scale_f32_16x16x128_f8f6f4 %0, %1, %2, 0, %3, %3 op_sel_hi:[0,0,0] cbsz:4 blgp:0" : "=&v"(acc) : "v"(A), "v"(B), "v"(sc1))
#define U_MFMA1(acc, A, B) asm volatile("v_mfma_scale_f32_16x16x128_f8f6f4 %0, %1, %2, %0, %3, %3 op_sel_hi:[0,0,0] cbsz:4 blgp:0" : "+v"(acc) : "v"(A), "v"(B), "v"(sc1))
#define U_DMA(q, E) __builtin_amdgcn_global_load_lds((const unsigned*)(tbl + (((unsigned)(E)[q] << 7) + (((q) & 1) ? o1 : o0))), (LAS unsigned*)(vbuf + (q) * 1024), 16, 0, 0)
#define U_LDSR(dst, addr, off) asm volatile("ds_read_b128 %0, %1 offset:%2" : "=&v"(dst) : "v"(addr), "n"(off) : "memory")
__device__ __forceinline__ void p11a_udot(const Params& P, LAS unsigned char* lds, int lane, int wave, int vb) {
    const unsigned char* XQ = P.ws + WS_XQ8; const unsigned char* U4 = P.ws + WS_U4; const unsigned char* REC = P.ws + WS_REC; _Float16* PART = (_Float16*)(P.ws + WS_PART);
    const int x = vb & 3, wgx = vb >> 2, nwg = gridDim.x >> 2, i16 = lane & 15, kb = lane >> 4, rg = lane >> 3, c = lane & 7;
    const int tstep = nwg * NW; const int sc1 = 0x7f;
    LAS unsigned char* vbuf = lds + wave * 18688;
    LAS unsigned char* ibuf = vbuf + 16384; LAS unsigned char* pbuf = vbuf + 16384 + 512;
    const unsigned char* tbl = U4 + (size_t)x * 2097152;
    const unsigned o0 = (unsigned)((c ^ ((rg >> 1) & 7)) << 4), o1 = (unsigned)((c ^ ((4 + (rg >> 1)) & 7)) << 4);
    const unsigned sw = (unsigned)(i16 >> 1) & 7u;
    const unsigned ra0v = (unsigned)(size_t)(vbuf + i16 * 128 + (((unsigned)kb ^ sw) << 4)), ra1v = (unsigned)(size_t)(vbuf + i16 * 128 + (((unsigned)(4 + kb) ^ sw) << 4));
    const bool pl = i16 < 2, lo32 = lane < 32;
    const unsigned iav = (unsigned)(size_t)ibuf + 4u * rg, pav = (unsigned)(size_t)pbuf + 256u * (pl ? i16 : 0) + 16u * kb;
    const unsigned zwv = (unsigned)(size_t)(vbuf + 18432) + 8u * kb, zrv = (unsigned)(size_t)(vbuf + 18432) + 16u * (lane & 15);
    const unsigned psrc = ((lane & 31) < 16 ? 0u : 1024u - 256u) + 256u * x + 16u * (lane & 31);
    const int t0 = wgx * NW + wave;
#define U_DMA_IDX(tok, par) do { if (lo32) __builtin_amdgcn_global_load_lds((const unsigned*)(REC + (size_t)(tok) * 768 + 16 * lane), (LAS unsigned*)(ibuf + (par) * 1024), 16, 0, 0); } while (0)
#define U_DMA_IP(tokI, tokP, par) __builtin_amdgcn_global_load_lds((const unsigned*)(lo32 ? REC + (size_t)(tokI) * 768 + 16 * lane : XQ + (size_t)(tokP) * 2048 + psrc), (LAS unsigned*)(ibuf + (par) * 1024), 16, 0, 0)
#define U_LDSR32(dst, addr, off) asm volatile("ds_read_b32 %0, %1 offset:%2" : "=&v"(dst) : "v"(addr), "n"(off) : "memory")
#define U_READ_IDX(E, par) do { const unsigned a_ = iav + (par) * 1024u; _Pragma("unroll") for (int q_ = 0; q_ < 16; ++q_) U_LDSR32(E[q_], a_, 32 * q_); asm volatile("s_waitcnt lgkmcnt(0)" ::: "memory"); } while (0)
    int en[16];
    U_DMA_IDX(t0, 0);
    asm volatile("s_waitcnt vmcnt(0)" ::: "memory");
    U_READ_IDX(en, 0);
    U_DMA_IP(t0 + tstep, t0, 1);
#pragma unroll
    for (int q = 0; q < 16; ++q) U_DMA(q, en);
    int par = 0;
    for (int t = t0; t < NTOK; t += tstep, par ^= 1) {
        const int tn = t + tstep < NTOK ? t + tstep : t0, tnn = t + 2 * tstep < NTOK ? t + 2 * tstep : t0;
        U_DMA_IP(tnn, tn, par);
        asm volatile("s_waitcnt vmcnt(15)" ::: "memory");
        U_READ_IDX(en, par ^ 1);
        i32x8v B[2];
        { v4u b0, b1, b2, b3; const unsigned a_ = pav + (unsigned)(par ^ 1) * 1024u; U_LDSR(b0, a_, 0); U_LDSR(b1, a_, 64); U_LDSR(b2, a_, 128); U_LDSR(b3, a_, 192); asm volatile("s_waitcnt lgkmcnt(0)" ::: "memory");
          B[0][0] = pl ? (int)b0.x : 0; B[0][1] = pl ? (int)b0.y : 0; B[0][2] = pl ? (int)b0.z : 0; B[0][3] = pl ? (int)b0.w : 0; B[0][4] = pl ? (int)b1.x : 0; B[0][5] = pl ? (int)b1.y : 0; B[0][6] = pl ? (int)b1.z : 0; B[0][7] = pl ? (int)b1.w : 0;
          B[1][0] = pl ? (int)b2.x : 0; B[1][1] = pl ? (int)b2.y : 0; B[1][2] = pl ? (int)b2.z : 0; B[1][3] = pl ? (int)b2.w : 0; B[1][4] = pl ? (int)b3.x : 0; B[1][5] = pl ? (int)b3.y : 0; B[1][6] = pl ? (int)b3.z : 0; B[1][7] = pl ? (int)b3.w : 0; }
        f32x4 acc[8];
#pragma unroll
        for (int g = 0; g < 8; ++g) {
            if (g > 0) asm volatile("s_waitcnt vmcnt(15)" ::: "memory");
            v4u a0, a1;
            asm volatile("ds_read_b128 %0, %2 offset:%4\n ds_read_b128 %1, %3 offset:%4\n s_waitcnt lgkmcnt(0)" : "=&v"(a0), "=&v"(a1) : "v"(ra0v), "v"(ra1v), "n"(g * 2048) : "memory");
            U_MFMA0(acc[g], a0, B[0]); U_MFMA1(acc[g], a1, B[1]);
            U_DMA(2 * g, en); U_DMA(2 * g + 1, en);
        }
        asm volatile("s_nop 7\n s_nop 7\n s_nop 7" : "+v"(acc[0]), "+v"(acc[1]), "+v"(acc[2]), "+v"(acc[3]), "+v"(acc[4]), "+v"(acc[5]), "+v"(acc[6]), "+v"(acc[7]) :: "memory");
#pragma unroll
        for (int g = 0; g < 8; ++g) { float z[4];
#pragma unroll
            for (int r = 0; r < 4; ++r) { const float lo = __builtin_bit_cast(float, __builtin_amdgcn_mov_dpp(__builtin_bit_cast(int, acc[g][r]), 0xF5, 0xf, 0xf, true)); z[r] = acc[g][r] + lo * 0.0625f; }
            uint2 zz; zz.x = __builtin_bit_cast(unsigned, __builtin_amdgcn_cvt_pkrtz(z[0], z[1])); zz.y = __builtin_bit_cast(unsigned, __builtin_amdgcn_cvt_pkrtz(z[2], z[3]));
            if (i16 == 0) asm volatile("ds_write_b64 %0, %1 offset:%2" :: "v"(zwv), "v"(zz), "n"(32 * g) : "memory"); }
        { v4u zo;
          asm volatile("s_waitcnt lgkmcnt(0)\n ds_read_b128 %0, %1\n s_waitcnt lgkmcnt(0)" : "=&v"(zo) : "v"(zrv) : "memory");
          if (lane < 16) *(v4u*)(PART + ((size_t)t * 4 + x) * 128 + 8 * lane) = zo; }
    }
    asm volatile("s_waitcnt vmcnt(0)" ::: "memory");
#undef U_DMA_IDX
#undef U_DMA_IP
#undef U_READ_IDX
}
struct WIn { float4 gv, su, sv; uint2 pv[4]; float ssq; };
__device__ __forceinline__ void p11b_load(WIn& w, const float* SUR, const float* SVR, const float* GATE, const _Float16* PART, const float* SSQ1, size_t i) {
    const size_t t = i >> 5; const int R0 = 4 * ((int)i & 31);
    w.gv = *(const float4*)(GATE + t * 128 + R0); w.su = *(const float4*)(SUR + t * 128 + R0); w.sv = *(const float4*)(SVR + t * 128 + R0); w.ssq = SSQ1[t];
#pragma unroll
    for (int x = 0; x < 4; ++x) w.pv[x] = *(const uint2*)(PART + (t * 4 + x) * 128 + R0);
}
__device__ __forceinline__ void p11b_finish(const WIn& wi, unsigned char* REC, size_t i) {
    const size_t t = i >> 5; const int R0 = 4 * ((int)i & 31);
    const float rstd = rsqrtf(wi.ssq * (1.0f / 1024.0f) + EPS);
    const float g4[4] = {wi.gv.x, wi.gv.y, wi.gv.z, wi.gv.w}, su[4] = {wi.su.x, wi.su.y, wi.su.z, wi.su.w}, sv[4] = {wi.sv.x, wi.sv.y, wi.sv.z, wi.sv.w};
    float zs[4] = {0.f, 0.f, 0.f, 0.f};
#pragma unroll
    for (int x = 0; x < 4; ++x) { const f16x2 p0 = __builtin_bit_cast(f16x2, wi.pv[x].x), p1 = __builtin_bit_cast(f16x2, wi.pv[x].y); zs[0] += (float)p0[0]; zs[1] += (float)p0[1]; zs[2] += (float)p1[0]; zs[3] += (float)p1[1]; }
    float w[4];
#pragma unroll
    for (int j = 0; j < 4; ++j) { const float zv = zs[j] * su[j] * rstd; w[j] = g4[j] * 32.0f * zv * (1.0f + erff(zv * 0.70710678118654752f)) * sv[j]; }
    int h = __builtin_amdgcn_cvt_pk_fp8_f32(w[0], w[1], 0, false); h = __builtin_amdgcn_cvt_pk_fp8_f32(w[2], w[3], h, true);
    const float r0 = (w[0] - __builtin_amdgcn_cvt_f32_fp8(h, 0)) * 16.f, r1 = (w[1] - __builtin_amdgcn_cvt_f32_fp8(h, 1)) * 16.f, r2 = (w[2] - __builtin_amdgcn_cvt_f32_fp8(h, 2)) * 16.f, r3 = (w[3] - __builtin_amdgcn_cvt_f32_fp8(h, 3)) * 16.f;
    int l = __builtin_amdgcn_cvt_pk_fp8_f32(r0, r1, 0, false); l = __builtin_amdgcn_cvt_pk_fp8_f32(r2, r3, l, true);
    *(int*)(REC + t * 768 + 512 + R0) = h; *(int*)(REC + t * 768 + 640 + R0) = l;
}
__device__ __forceinline__ void p11b_weights(const Params& P, int tid, int vb) {
    const _Float16* PART = (const _Float16*)(P.ws + WS_PART); const float* GATE = (const float*)(P.ws + WS_GATE); const float* SSQ1 = (const float*)(P.ws + WS_SSQ1);
    unsigned char* REC = P.ws + WS_REC; const float* SUR = (const float*)(P.ws + WS_SUR); const float* SVR = (const float*)(P.ws + WS_SVR);
    const size_t n = (size_t)NTOK * 32, st = (size_t)gridDim.x * 512;
    for (size_t i = (size_t)vb * 512 + tid; i < n; i += 2 * st) {
        WIn a, b; p11b_load(a, SUR, SVR, GATE, PART, SSQ1, i); const bool hb = i + st < n; if (hb) p11b_load(b, SUR, SVR, GATE, PART, SSQ1, i + st);
        p11b_finish(a, REC, i); if (hb) p11b_finish(b, REC, i + st);
    }
}
typedef int v2iv __attribute__((ext_vector_type(2))); typedef int i32x4v __attribute__((ext_vector_type(4))); typedef int i32x8w __attribute__((ext_vector_type(8)));
struct VCtx { const unsigned char* tbl; const unsigned char* REC; LAS unsigned char* wr0; LAS unsigned char* wr1; const LAS unsigned char* rdb; LAS unsigned char* ring; unsigned swr; int rg, n16, kb, lane; bool pl; };
__device__ __forceinline__ void p11c_step(const VCtx& C, v4u (&vd)[16], v4u& rraw, float (&inc)[4], int tn3, int scur, int snew) {
    const unsigned char* tbl = C.tbl; LAS unsigned char* wr0 = C.wr0; LAS unsigned char* wr1 = C.wr1; const LAS unsigned char* rdb = C.rdb;
    const unsigned swr = C.swr; const int rg = C.rg, n16 = C.n16, kb = C.kb, lane = C.lane; const bool pl = C.pl; const int scw = 0x79, sc1 = 0x7f;
    if (lane < 48) *(LAS v4u*)(C.ring + snew * 768 + 16 * lane) = rraw;
    if (lane < 48) rraw = *(const v4u*)(C.REC + (size_t)tn3 * 768 + 16 * lane);
    int en[16];
#pragma unroll
    for (int q = 0; q < 16; ++q) en[q] = *(const LAS int*)(C.ring + snew * 768 + 4 * (8 * q + rg));
    const v4u w0r = *(const LAS v4u*)(C.ring + scur * 768 + 512 + (n16 & 1) * 128 + 16 * kb), w1r = *(const LAS v4u*)(C.ring + scur * 768 + 512 + (n16 & 1) * 128 + 64 + 16 * kb);
#pragma unroll
    for (int q = 0; q < 16; ++q) { *(LAS v4u*)(((q & 1) ? wr1 : wr0) + q * 1024) = vd[q]; vd[q] = *(const v4u*)(tbl + ((unsigned)en[q] << 7)); }
    i32x8w W8; W8[0] = pl ? (int)w0r.x : 0; W8[1] = pl ? (int)w0r.y : 0; W8[2] = pl ? (int)w0r.z : 0; W8[3] = pl ? (int)w0r.w : 0; W8[4] = pl ? (int)w1r.x : 0; W8[5] = pl ? (int)w1r.y : 0; W8[6] = pl ? (int)w1r.z : 0; W8[7] = pl ? (int)w1r.w : 0;
    asm volatile("s_waitcnt lgkmcnt(0)" ::: "memory");
    float sv[2][2] = {{0.f, 0.f}, {0.f, 0.f}};
    const bool hh = kb >> 1;
#pragma unroll
    for (int b4 = 0; b4 < 16; b4 += 4) {
        i32x4v B4[4]; f32x4 acc[4];
#pragma unroll
        for (int u = 0; u < 4; ++u) { const int blk = b4 + u;
            const LAS unsigned char* a = rdb + ((((unsigned)(blk >> 1)) ^ swr) << 4) + (blk & 1) * 8;
            const v2iv t0 = __builtin_amdgcn_ds_read_tr4_b64_v2i32((LAS v2iv*)a), t1 = __builtin_amdgcn_ds_read_tr4_b64_v2i32((LAS v2iv*)(a + 2048));
            B4[u][0] = t0[0]; B4[u][1] = t0[1]; B4[u][2] = t1[0]; B4[u][3] = t1[1]; }
#pragma unroll
        for (int u = 0; u < 4; ++u)
            asm volatile("v_mfma_scale_f32_16x16x128_f8f6f4 %0, %1, %2, 0, %3, %4 op_sel_hi:[0,0,0] cbsz:0 blgp:4" : "=&v"(acc[u]) : "v"(W8), "v"(B4[u]), "v"(scw), "v"(sc1));
        asm volatile("s_nop 7\n s_nop 7\n s_nop 7" : "+v"(acc[0]), "+v"(acc[1]), "+v"(acc[2]), "+v"(acc[3]) :: "memory");
        if ((kb & 1) == (b4 >> 3)) {
            const float v0 = hh ? acc[2][0] + acc[2][1] * 0.0625f : acc[0][0] + acc[0][1] * 0.0625f, v1 = hh ? acc[3][0] + acc[3][1] * 0.0625f : acc[1][0] + acc[1][1] * 0.0625f;
            sv[(b4 >> 2) & 1][0] = v0; sv[(b4 >> 2) & 1][1] = v1; }
    }
    const bool odd = lane & 1;
    const float s0 = odd ? sv[0][0] : sv[1][0], s1 = odd ? sv[0][1] : sv[1][1];
    const float r0 = __builtin_bit_cast(float, __builtin_amdgcn_mov_dpp(__builtin_bit_cast(int, s0), 0xB1, 0xf, 0xf, true)), r1 = __builtin_bit_cast(float, __builtin_amdgcn_mov_dpp(__builtin_bit_cast(int, s1), 0xB1, 0xf, 0xf, true));
    inc[0] = odd ? r0 : sv[0][0]; inc[1] = odd ? sv[1][0] : r0; inc[2] = odd ? r1 : sv[0][1]; inc[3] = odd ? sv[1][1] : r1;
}
typedef unsigned v2uw __attribute__((ext_vector_type(2)));
__device__ __forceinline__ void p11c_pair_out(const Params& P, bf16* XB, float* SSQ, const float (&incA)[4], const float (&incB)[4], const v4u xo, int tA, int tB, int x, int D, int lane) {
    float e[8];
#pragma unroll
    for (int j = 0; j < 4; ++j) { const auto r = __builtin_amdgcn_permlane32_swap(__builtin_bit_cast(unsigned, incA[j]), __builtin_bit_cast(unsigned, incB[j]), false, false);
        const unsigned r0_ = r[0], r1_ = r[1]; e[j] = __uint_as_float(r0_); e[4 + j] = __uint_as_float(r1_); }
    const int tok = lane < 32 ? tA : tB;
    float xv[8]; unpk8(xo, xv);
    float ss = 0.f;
#pragma unroll
    for (int k = 0; k < 8; ++k) { xv[k] += e[k]; ss += xv[k] * xv[k]; }
    *(v4u*)(XB + (size_t)tok * 1024 + 256 * x + D) = pk8(xv);
    uint2 f8;
    { int p8 = __builtin_amdgcn_cvt_pk_fp8_f32(xv[0], xv[1], 0, false); p8 = __builtin_amdgcn_cvt_pk_fp8_f32(xv[2], xv[3], p8, true); f8.x = (unsigned)p8; }
    { int p8 = __builtin_amdgcn_cvt_pk_fp8_f32(xv[4], xv[5], 0, false); p8 = __builtin_amdgcn_cvt_pk_fp8_f32(xv[6], xv[7], p8, true); f8.y = (unsigned)p8; }
    *(uint2*)(P.ws + WS_X2B8 + (size_t)tok * 1024 + 256 * x + D) = f8;
    ss += __shfl_xor(ss, 16); ss += __shfl_xor(ss, 8); ss += __shfl_xor(ss, 4); ss += __shfl_xor(ss, 2); ss += __shfl_xor(ss, 1);
    if ((lane & 31) == 0) atomicAdd(SSQ + tok, ss);
}
__device__ __forceinline__ void p11c_vacc(const Params& P, LAS unsigned char* lds, int lane, int wave, int vb) {
    const unsigned char* V4 = P.ws + WS_V4; const unsigned char* REC = P.ws + WS_REC;
    bf16* XB = (bf16*)(P.ws + WS_HN); float* SSQ = (float*)(P.ws + WS_SSQ);
    const int x = vb & 3, wgx = vb >> 2, nwg = gridDim.x >> 2, rg = lane >> 3, ch = lane & 7, n16 = lane & 15, kb = lane >> 4;
    const int tstep = nwg * NW;
    LAS unsigned char* vbuf = lds + wave * 16384;
    LAS unsigned char* ring = lds + 131072 + wave * 2304;
    const unsigned char* tbl = V4 + (size_t)x * 2097152 + 16 * ch;
    LAS unsigned char* wr0 = vbuf + rg * 128 + ((ch ^ ((rg >> 1) & 7)) << 4); LAS unsigned char* wr1 = vbuf + rg * 128 + ((ch ^ ((4 + (rg >> 1)) & 7)) << 4);
    const unsigned swr = (unsigned)(n16 >> 1) & 7u;
    const LAS unsigned char* rdb = vbuf + (kb * 32 + n16) * 128;
    const bool pl = (n16 & 3) < 2;
    const int D = 32 * (n16 >> 1) + 8 * (2 * (kb & 1) + (n16 & 1));
    VCtx C{tbl, REC, wr0, wr1, rdb, ring, swr, rg, n16, kb, lane, pl};
    const int t0 = wgx * NW + wave;
    v4u vdA[16], vdB[16], rraw = {0u, 0u, 0u, 0u};
    { v4u r0 = {0u, 0u, 0u, 0u}, r1 = {0u, 0u, 0u, 0u};
      if (lane < 48) { r0 = *(const v4u*)(REC + (size_t)t0 * 768 + 16 * lane); r1 = *(const v4u*)(REC + (size_t)(t0 + tstep) * 768 + 16 * lane); rraw = *(const v4u*)(REC + (size_t)(t0 + 2 * tstep) * 768 + 16 * lane);
          *(LAS v4u*)(ring + 16 * lane) = r0; *(LAS v4u*)(ring + 768 + 16 * lane) = r1; }
      asm volatile("s_waitcnt lgkmcnt(0)" ::: "memory");
#pragma unroll
      for (int q = 0; q < 16; ++q) vdA[q] = *(const v4u*)(tbl + ((unsigned)*(const LAS int*)(ring + 4 * (8 * q + rg)) << 7));
#pragma unroll
      for (int q = 0; q < 16; ++q) vdB[q] = *(const v4u*)(tbl + ((unsigned)*(const LAS int*)(ring + 768 + 4 * (8 * q + rg)) << 7)); }
    int sc = 0;
    for (int t = t0; t < NTOK; t += 2 * tstep) {
        const int ta = t + 3 * tstep, tb = t + 4 * tstep;
        const int s1 = sc == 2 ? 0 : sc + 1, s2 = s1 == 2 ? 0 : s1 + 1;
        const v4u xo = *(const v4u*)(XB + (size_t)(lane < 32 ? t : t + tstep) * 1024 + 256 * x + D);
        float incA[4], incB[4];
        p11c_step(C, vdA, rraw, incA, ta < NTOK ? ta : t0, sc, s2);
        p11c_step(C, vdB, rraw, incB, tb < NTOK ? tb : t0, s1, sc);
        p11c_pair_out(P, XB, SSQ, incA, incB, xo, t, t + tstep, x, D, lane);
        sc = s2;
    }
}

__global__ void __launch_bounds__(512, 2) mk_fwd(Params P) {
    extern __shared__ __attribute__((aligned(16))) unsigned char lds_raw[];
    LAS unsigned char* lds = (LAS unsigned char*)lds_raw;
    const int tid = threadIdx.x, lane = tid & 63, wave = __builtin_amdgcn_readfirstlane(tid >> 6);
    const int lo = P.ph_lo, hi = P.ph_hi, G = gridDim.x, bx = blockIdx.x;
    unsigned char* ws = P.ws;
    const int gw = bx * NW + wave, NGW = G * NW;
#ifndef PH_MASK
#define PH_MASK 0xffff
#endif
#define IN(k) (((PH_MASK >> (k)) & 1) && lo <= (k) && (k) < hi)
    volatile LAS unsigned* xst = (volatile LAS unsigned*)(lds + LDS_BYTES - 16);
    if (tid < 4) xst[tid] = 0u;
    __syncthreads();
    const XcdBarrier bar = xcd_barrier_post((unsigned*)(ws + WS_BAR), xst);
    unsigned* vctl = (unsigned*)(ws + WS_BAR) + 4096;
    if (tid == 0) { const unsigned xcc = xb_xcc_id() & 7u; xst[2] = xcc; xst[3] = xb_add(&vctl[16 * xcc], 1u); }
#define GRID_BAR() xcd_barrier(bar)
#define SYNC_AFTER(k) do { if (IN(k) && IN((k) + 1)) { GRID_BAR(); } } while (0)
    typedef pg8::bf16_t pb;
    if (IN(0)) p0_prologue(P, lds, tid, lane, wave);
    SYNC_AFTER(0);
    if (tid == 0) {
        const unsigned xcc = xst[2], sl = xst[3], cap = (unsigned)G >> 3; unsigned v;
        if (sl < cap) v = sl * 8u + xcc;
        else { unsigned o = xb_add(&vctl[160], 1u); v = 0u;
            for (unsigned x = 0; x < 8u; ++x) { const unsigned c = min(xb_ld(&vctl[16 * x]), cap), fr = cap - c; if (o < fr) { v = (c + o) * 8u + x; break; } o -= fr; } }
        xst[2] = v;
    }
    __syncthreads();
    const int vb = (int)xst[2];
    if (IN(1)) {
        pg8::Gemm g{(const pb*)P.out, (const pb*)(ws + WS_W1F8), NTOK, 5632, 512}; pg8::StaticOrder S; S.init(NTOK, 5632, G, vb);
        pg8::EpiProj E{(pb*)(ws + WS_QKVA), (pb*)(ws + WS_QKM), (pb*)(ws + WS_VM), (pb*)(ws + WS_OM), ws + WS_G, C2};
        pg8::gemm_phase<pg8::EpiProj, pg8::StaticOrder, true, true>(lds, g, S, E);
    }
    SYNC_AFTER(1);
    if (IN(2)) { p2_attention(P, lds, lane, wave, vb); __syncthreads(); p2_mlstm_local(P, lds, tid, lane, wave, vb); }
    SYNC_AFTER(2);
    if (IN(3)) { const int nscan = G > 128 ? 128 : 0;
        if (vb >= nscan) p3_side_tables(P, lds, tid, lane, wave, vb - nscan, G - nscan);
        p3_mlstm_scan(P, tid, vb); }
    SYNC_AFTER(3);
    if (IN(4)) p4_mlstm_out(P, lds, tid, lane, wave, vb);
    SYNC_AFTER(4);
    if (IN(5)) {
        pg8::Gemm g{(const pb*)(ws + WS_YA), (const pb*)(ws + WS_WAT), NTOK, 1024, 1024}; pg8::StaticOrder S; S.init(NTOK, 1024, G, vb);
        pg8::EpiMerged E{(pb*)(ws + WS_MERGED), ws + WS_G};
        pg8::gemm_phase<pg8::EpiMerged, pg8::StaticOrder, true, true>(lds, g, S, E);
    }
    if (IN(5) && IN(7)) GRID_BAR();
    if (IN(7)) {
        pg8::Gemm g{(const pb*)(ws + WS_MERGED), (const pb*)(ws + WS_WOT), NTOK, 1024, 1024}; pg8::StaticOrder S; S.init(NTOK, 1024, G, vb);
        pg8::EpiResidual E{P.in[0], (pb*)(ws + WS_HN), (float*)(ws + WS_SSQ1)};
        pg8::gemm_phase<pg8::EpiResidual, pg8::StaticOrder, true, true>(lds, g, S, E);
    }
    if (IN(7) && IN(9)) GRID_BAR();
    if (IN(9)) {
        pg8::Gemm g{(const pb*)(ws + WS_HN), (const pb*)(ws + WS_WQT), NTOK, 2048, 1024}; pg8::StaticOrder S; S.init(NTOK, 2048, G, vb);
        pg8::EpiStore E{(pb*)(ws + WS_Q2), 2048};
        pg8::gemm_phase<pg8::EpiStore, pg8::StaticOrder, true, true>(lds, g, S, E);
    }
    SYNC_AFTER(9);
#define LAUNDER_TID() int tid_ = tid; asm volatile("" : "+v"(tid_)); const int lane_ = tid_ & 63
    if (IN(10)) { { LAUNDER_TID(); p10_topk(P, lds, tid_, lane_, wave, vb); } }
    SYNC_AFTER(10);
    if (IN(11)) { { LAUNDER_TID(); p11a_udot(P, lds, lane_, wave, vb); } GRID_BAR(); { LAUNDER_TID(); p11b_weights(P, tid_, vb); } GRID_BAR(); { LAUNDER_TID(); p11c_vacc(P, lds, lane_, wave, vb); } }
    SYNC_AFTER(11);
    if (IN(12)) {
        pg8::Gemm g{(const pb*)(ws + WS_PB), (const pb*)(ws + WS_WPT), NTOK, 1024, 256}; pg8::StaticOrder S; S.init(NTOK, 1024, G, vb);
        pg8::EpiStore E{(pb*)(ws + WS_E), 1024};
        pg8::gemm_phase<pg8::EpiStore, pg8::StaticOrder, true, true>(lds, g, S, E);
    }
    if (IN(12) && IN(13)) { asm volatile("s_waitcnt vmcnt(0)" ::: "memory"); __syncthreads(); }
    if (IN(13)) {
        pg8::Gemm g{(const pb*)(ws + WS_X2B8), (const pb*)(ws + WS_WG8), NTOK, 1024, 512}; pg8::StaticOrder S; S.init(NTOK, 1024, G, vb);
        if (G == 256) {
            pg8::EpiPleFinal E{(const pb*)(ws + WS_HN), (const pb*)(ws + WS_E), (const float*)(ws + WS_SSQ), (float*)(ws + WS_SSQ3), (unsigned*)(ws + WS_BAR) + BAR_CNT13, (unsigned*)(ws + WS_BAR) + XB_TMO, P.in[19], P.out};
            pg8::gemm_phase<pg8::EpiPleFinal, pg8::StaticOrder, true, true>(lds, g, S, E);
        } else {
            pg8::EpiPle E{(const pb*)(ws + WS_HN), (pb*)(ws + WS_X3B), (const pb*)(ws + WS_E), (const float*)(ws + WS_SSQ)};
            pg8::gemm_phase<pg8::EpiPle, pg8::StaticOrder, true, true>(lds, g, S, E);
        }
    }
    if (G != 256) SYNC_AFTER(13);
    if (IN(14) && G != 256) {
        const float* gf = P.in[19];
        for (int m = gw; m < NTOK; m += NGW) {
            const bf16* xr = (const bf16*)(ws + WS_X3B) + (size_t)m * 1024; float v[16]; float s = 0.f;
            unpk8(((const v4u*)xr)[2 * lane], v); unpk8(((const v4u*)xr)[2 * lane + 1], v + 8);
#pragma unroll
            for (int i = 0; i < 16; ++i) s += v[i] * v[i];
            const float rstd = rsqrtf(wave_sum(s) * (1.f / 1024.f) + EPS);
            float* orow = P.out + (size_t)m * 1024 + 16 * lane;
#pragma unroll
            for (int j = 0; j < 4; ++j) { const f32x4 g = ((const f32x4*)(gf + 16 * lane))[j]; f32x4 o; o[0] = v[4 * j] * rstd * g[0]; o[1] = v[4 * j + 1] * rstd * g[1]; o[2] = v[4 * j + 2] * rstd * g[2]; o[3] = v[4 * j + 3] * rstd * g[3]; ((f32x4*)orow)[j] = o; }
        }
    }
}

extern "C" void kernel_launch(void* const* d_in, const int* in_sizes, int n_in, void* d_out, int out_size, void* d_ws, size_t ws_size, hipStream_t stream) {
    static int grid_blocks = 0;
    if (!grid_blocks) {
        int dev = 0, cus = 0, per_cu = 0;
        (void)hipGetDevice(&dev);
        (void)hipDeviceGetAttribute(&cus, hipDeviceAttributeMultiprocessorCount, dev);
        (void)hipFuncSetAttribute((const void*)mk_fwd, hipFuncAttributeMaxDynamicSharedMemorySize, LDS_BYTES);
        (void)hipOccupancyMaxActiveBlocksPerMultiprocessor(&per_cu, mk_fwd, 512, LDS_BYTES);
        if (per_cu > 1) per_cu = 1;
        grid_blocks = cus * per_cu;
    }
    if (n_in < 20 || ws_size < WS_NEED || grid_blocks <= 0) { fprintf(stderr, "kernel_launch: bad setup (n_in %d ws %zu grid %d)\n", n_in, ws_size, grid_blocks); return; }
    Params p{};
    for (int i = 0; i < 20; ++i) p.in[i] = (const float*)d_in[i];
    p.out = (float*)d_out; p.ws = (unsigned char*)d_ws; p.ph_lo = 0; p.ph_hi = 15;
    (void)hipMemsetAsync((unsigned char*)d_ws + WS_BAR, 0, BAR_BYTES, stream);
    void* args[] = {&p};
    hipError_t e = hipLaunchCooperativeKernel((void*)mk_fwd, dim3(grid_blocks), dim3(512), args, LDS_BYTES, stream);
    if (e != hipSuccess) fprintf(stderr, "cooperative launch failed: %s (grid %d)\n", hipGetErrorString(e), grid_blocks);
}
```

```cpp
#include <hip/hip_runtime.h>
#include <cstdio>
#include <cstdint>
namespace pg8 {
#define PG8_LAS __attribute__((address_space(3)))
typedef unsigned short bf16_t;
typedef short bf16x8 __attribute__((ext_vector_type(8)));
typedef float f32x4 __attribute__((ext_vector_type(4)));
typedef unsigned u32x4 __attribute__((ext_vector_type(4)));
constexpr int BM = 256, BK = 64, HALF = 128, HTB = HALF * BK * 2  , STAGE_BYTES = 8 * HTB, NXCD = 8, WGM = 8;

__host__ __device__ __forceinline__ int lds_byte(int r, int c) { const int st = (r >> 4) * 2 + (c >> 5), rr = r & 15, cc = c & 31, ob = rr * 64 + cc * 2; return st * 1024 + (ob ^ (((ob >> 9) & 1) << 5)); }
__host__ __device__ __forceinline__ void stage_rc(int b, int& R, int& C) { const int st = b / 1024, sb = b % 1024, swz = sb ^ (((sb >> 9) & 1) << 5); R = (st >> 1) * 16 + swz / 64; C = (st & 1) * 32 + (swz % 64) / 2; }
__host__ __device__ __forceinline__ int perm32(int rho) { const int n = rho >> 4, i = rho & 15; return 8 * (i >> 2) + 4 * n + (i & 3); }

struct Unit { int pm, pn; };
struct Gemm { const bf16_t* A; const bf16_t* Bt; int M, N, K; };

struct StaticOrder {
    int nM, nN, nwg, G, c;
    __host__ __device__ void init(int M, int N, int G_, int c_) { nM = M / BM; nN = N / BM; nwg = nM * nN; G = G_; c = c_; }
    __host__ __device__ bool next(int i, Unit& u) const {
        const long L = (long)i * G + c; if (L >= nwg) return false;
        int wgid = (int)L; { const int q = nwg / NXCD, r = nwg % NXCD, xcd = wgid % NXCD, off = wgid / NXCD; wgid = (xcd < r ? xcd * (q + 1) : r * (q + 1) + (xcd - r) * q) + off; }
        const int nig = WGM * nN, gid = wgid / nig, fm = gid * WGM, gsz = (nM - fm) < WGM ? (nM - fm) : WGM;
        u.pm = fm + ((wgid % nig) % gsz); u.pn = (wgid % nig) / gsz; return true;
    }
    __device__ __forceinline__ void a_ready(const Unit&) const {}
    __device__ __forceinline__ void done(const Unit&) const {}
};

__device__ __forceinline__ unsigned cvt_pk_bf16(float lo, float hi) { unsigned r; asm volatile("v_cvt_pk_bf16_f32 %0, %1, %2" : "=v"(r) : "v"(lo), "v"(hi)); return r; }
typedef float f32x2 __attribute__((ext_vector_type(2)));

__device__ __forceinline__ float sigm(float x) { return __builtin_amdgcn_rcpf(1.0f + __builtin_amdgcn_exp2f(-1.4426950408889634f * x)); }
__device__ __forceinline__ float bf_lo(unsigned w) { return __uint_as_float(w << 16); }
__device__ __forceinline__ float bf_hi(unsigned w) { return __uint_as_float(w & 0xffff0000u); }
__device__ __forceinline__ u32x4 pack8(const f32x4& v0, const f32x4& v1) { u32x4 w; w.x = cvt_pk_bf16(v0[0], v0[1]); w.y = cvt_pk_bf16(v0[2], v0[3]); w.z = cvt_pk_bf16(v1[0], v1[1]); w.w = cvt_pk_bf16(v1[2], v1[3]); return w; }
__device__ __forceinline__ void unpack8(const u32x4& w, f32x4& v0, f32x4& v1) { v0[0] = bf_lo(w.x); v0[1] = bf_hi(w.x); v0[2] = bf_lo(w.y); v0[3] = bf_hi(w.y); v1[0] = bf_lo(w.z); v1[1] = bf_hi(w.z); v1[2] = bf_lo(w.w); v1[3] = bf_hi(w.w); }

#define PG8_EPI_WALK(...) \
    _Pragma("unroll") for (int ai = 0; ai < 2; ++ai) _Pragma("unroll") for (int m = 0; m < 4; ++m) { const int row = u.pm * BM + wr * 64 + fr + ai * HALF + m * 16; \
        _Pragma("unroll") for (int bj = 0; bj < 2; ++bj) { const int ct = wc * 64 + bj * 32 + 8 * fq; f32x4 v0 = acc[ai][bj][m][0], v1 = acc[ai][bj][m][1]; __VA_ARGS__ } }

__device__ __forceinline__ u32x4 xor8_16B(u32x4 v) { u32x4 r; r.x = (unsigned)__shfl_xor((int)v.x, 8); r.y = (unsigned)__shfl_xor((int)v.y, 8); r.z = (unsigned)__shfl_xor((int)v.z, 8); r.w = (unsigned)__shfl_xor((int)v.w, 8); return r; }
__device__ __forceinline__ u32x4 bperm_16B(int src_byte, u32x4 v) { u32x4 r; r.x = (unsigned)__builtin_amdgcn_ds_bpermute(src_byte, (int)v.x); r.y = (unsigned)__builtin_amdgcn_ds_bpermute(src_byte, (int)v.y); r.z = (unsigned)__builtin_amdgcn_ds_bpermute(src_byte, (int)v.z); r.w = (unsigned)__builtin_amdgcn_ds_bpermute(src_byte, (int)v.w); return r; }
__device__ __forceinline__ void store_rows_bf16(bf16_t* O, size_t ldc, int r0, int c0, int fr, int fq, u32x4 w0, u32x4 w1) {
    const bool h = fr & 8; const u32x4 recv = xor8_16B(h ? w0 : w1);
    const u32x4 d1 = h ? recv : w0, d2 = h ? w1 : recv;
    const int lane = fr + 16 * fq, src = ((lane >> 3) + 8 * ((lane >> 2) & 1) + 16 * (lane & 3)) * 4;
    const u32x4 e1 = bperm_16B(src, d1), e2 = bperm_16B(src, d2);
    bf16_t* p = O + (size_t)(r0 + (lane >> 3)) * ldc + c0 + 8 * (lane & 7);
    *(u32x4*)p = e1; *(u32x4*)(p + 8 * ldc) = e2;
}
struct EpiProj {
    static constexpr bool PERM = true, AFTER_DRAIN = false, MIDK = false, FP8 = true, FINAL = false; static constexpr int SCALE_B = 0x7b;
    bf16_t *qkva, *qkm, *vm, *om; unsigned char* g8; float c2;
    __device__ __forceinline__ void operator()(const f32x4 (&acc)[2][2][4][2], const Unit& u, int wr, int wc, int fr, int fq) const {
        const int pn = u.pn; bf16_t* base; int ldc, colt, mode = 0; float sc = 1.f;
        if (pn < 6) { base = qkva; ldc = 1536; colt = pn * 256; if (pn < 2) sc = c2; }
        else if (pn < 10) { base = qkm; ldc = 1024; colt = (pn - 6) * 256; }
        else if (pn < 12) { base = vm; ldc = 512; colt = (pn - 10) * 256; }
        else if (pn < 14) { base = om; ldc = 512; colt = (pn - 12) * 256; mode = 1; }
        else {
            const int colt8 = (pn - 14) * 256;
#pragma unroll
            for (int ai = 0; ai < 2; ++ai)
#pragma unroll
                for (int m = 0; m < 4; ++m)
#pragma unroll
                    for (int bj = 0; bj < 2; ++bj) { unsigned p[2] = {0u, 0u};
#pragma unroll
                        for (int n = 0; n < 2; ++n)
#pragma unroll
                            for (int i = 0; i < 4; ++i) p[n] = __builtin_amdgcn_cvt_pk_u8_f32(fmaxf(sigm(acc[ai][bj][m][n][i]) * 255.0f, 1.0f), i, p[n]);
                        uint2 pv; pv.x = p[0]; pv.y = p[1];
                        *(uint2*)(g8 + (size_t)(u.pm * BM + wr * 64 + ai * HALF + m * 16 + fr) * 2048 + colt8 + wc * 64 + bj * 32 + 8 * fq) = pv; }
            return; }
#pragma unroll
        for (int ai = 0; ai < 2; ++ai)
#pragma unroll
            for (int m = 0; m < 4; ++m) { u32x4 w[2];
#pragma unroll
                for (int bj = 0; bj < 2; ++bj) { f32x4 v0 = acc[ai][bj][m][0], v1 = acc[ai][bj][m][1];
                    if (mode == 1) { _Pragma("unroll") for (int i = 0; i < 4; ++i) { v0[i] = sigm(v0[i]); v1[i] = sigm(v1[i]); } }
                    else { v0 = v0 * sc; v1 = v1 * sc; }
                    w[bj] = pack8(v0, v1); }
                store_rows_bf16(base, (size_t)ldc, u.pm * BM + wr * 64 + ai * HALF + m * 16, colt + wc * 64, fr, fq, w[0], w[1]); }
    }
};
struct EpiGateF8 {
    static constexpr bool PERM = true, AFTER_DRAIN = false, MIDK = false, FP8 = true, FINAL = false; static constexpr int SCALE_B = 0x7b;
    bf16_t* g;
    __device__ __forceinline__ void operator()(const f32x4 (&acc)[2][2][4][2], const Unit& u, int wr, int wc, int fr, int fq) const {
#pragma unroll
        for (int ai = 0; ai < 2; ++ai)
#pragma unroll
            for (int m = 0; m < 4; ++m) { u32x4 w[2];
#pragma unroll
                for (int bj = 0; bj < 2; ++bj) { f32x4 v0 = acc[ai][bj][m][0], v1 = acc[ai][bj][m][1];
                    _Pragma("unroll") for (int i = 0; i < 4; ++i) { v0[i] = sigm(v0[i]); v1[i] = sigm(v1[i]); }
                    w[bj] = pack8(v0, v1); }
                store_rows_bf16(g, 2048, u.pm * BM + wr * 64 + ai * HALF + m * 16, u.pn * BM + wc * 64, fr, fq, w[0], w[1]); }
    }
};
struct EpiStore {
    static constexpr bool PERM = true, AFTER_DRAIN = false, MIDK = false, FP8 = false, FINAL = false; static constexpr int SCALE_B = 0x7f;
    bf16_t* O; int ldc;
    __device__ __forceinline__ void operator()(const f32x4 (&acc)[2][2][4][2], const Unit& u, int wr, int wc, int fr, int fq) const {
#pragma unroll
        for (int ai = 0; ai < 2; ++ai)
#pragma unroll
            for (int m = 0; m < 4; ++m) store_rows_bf16(O, (size_t)ldc, u.pm * BM + wr * 64 + ai * HALF + m * 16, u.pn * BM + wc * 64, fr, fq, pack8(acc[ai][0][m][0], acc[ai][0][m][1]), pack8(acc[ai][1][m][0], acc[ai][1][m][1]));
    }
};
struct EpiMerged {
    static constexpr bool PERM = true, AFTER_DRAIN = false, MIDK = true, FP8 = false, FINAL = false; static constexpr int SCALE_B = 0x7f;
    bf16_t* O; const unsigned char* gate;
    static __device__ __forceinline__ void ub4(unsigned w, f32x4& v) { v[0] = (float)(w & 0xffu); v[1] = (float)((w >> 8) & 0xffu); v[2] = (float)((w >> 16) & 0xffu); v[3] = (float)(w >> 24); }
    __device__ __forceinline__ void mid(f32x4 (&acc)[2][2][4][2], const Unit& u, int wr, int wc, int fr, int fq) const {
#pragma unroll
        for (int ai = 0; ai < 2; ++ai)
#pragma unroll
            for (int mp = 0; mp < 2; ++mp) {
                uint2 ga[2][2], gm[2][2];
#pragma unroll
                for (int mm = 0; mm < 2; ++mm)
#pragma unroll
                    for (int bj = 0; bj < 2; ++bj) { const size_t o = (size_t)(u.pm * BM + wr * 64 + fr + ai * HALF + (2 * mp + mm) * 16) * 2048 + u.pn * BM + wc * 64 + bj * 32 + 8 * fq;
                        ga[mm][bj] = *(const uint2*)(gate + o); gm[mm][bj] = *(const uint2*)(gate + o + 1024); }
#pragma unroll
                for (int mm = 0; mm < 2; ++mm)
#pragma unroll
                    for (int bj = 0; bj < 2; ++bj) { f32x4 a0, a1, m0, m1; ub4(ga[mm][bj].x, a0); ub4(ga[mm][bj].y, a1); ub4(gm[mm][bj].x, m0); ub4(gm[mm][bj].y, m1);
#pragma unroll
                        for (int i = 0; i < 4; ++i) { acc[ai][bj][2 * mp + mm][0][i] *= a0[i] * __builtin_amdgcn_rcpf(m0[i]); acc[ai][bj][2 * mp + mm][1][i] *= a1[i] * __builtin_amdgcn_rcpf(m1[i]); } }
            }
    }
    __device__ __forceinline__ void operator()(const f32x4 (&acc)[2][2][4][2], const Unit& u, int wr, int wc, int fr, int fq) const {
#pragma unroll
        for (int ai = 0; ai < 2; ++ai)
#pragma unroll
            for (int mp = 0; mp < 2; ++mp) {
                uint2 gm[2][2];
#pragma unroll
                for (int mm = 0; mm < 2; ++mm)
#pragma unroll
                    for (int bj = 0; bj < 2; ++bj) gm[mm][bj] = *(const uint2*)(gate + (size_t)(u.pm * BM + wr * 64 + fr + ai * HALF + (2 * mp + mm) * 16) * 2048 + 1024 + u.pn * BM + wc * 64 + bj * 32 + 8 * fq);
#pragma unroll
                for (int mm = 0; mm < 2; ++mm) { const int m = 2 * mp + mm; u32x4 w[2];
#pragma unroll
                    for (int bj = 0; bj < 2; ++bj) { f32x4 m0, m1; ub4(gm[mm][bj].x, m0); ub4(gm[mm][bj].y, m1); w[bj] = pack8(acc[ai][bj][m][0] * (m0 * (1.0f / 255.0f)), acc[ai][bj][m][1] * (m1 * (1.0f / 255.0f))); }
                    store_rows_bf16(O, 1024, u.pm * BM + wr * 64 + ai * HALF + m * 16, u.pn * BM + wc * 64, fr, fq, w[0], w[1]); }
            }
    }
};
struct EpiResidual {
    static constexpr bool PERM = true, AFTER_DRAIN = false, MIDK = false, FP8 = false, FINAL = false; static constexpr int SCALE_B = 0x7f;
    const float* res; bf16_t* xb; float* ssq;
    __device__ __forceinline__ void operator()(f32x4 (&acc)[2][2][4][2], const Unit& u, int wr, int wc, int fr, int fq) const {
        const float* rbase = res + (size_t)(u.pm * BM + wr * 64 + fr) * 1024 + u.pn * BM + wc * 64 + 8 * fq;
        f32x4 rg[8][4];
#define PG8_RLD(k) do { const float* p_ = rbase + (size_t)(((k) >> 2) * HALF + ((k) & 3) * 16) * 1024; rg[k][0] = *(const f32x4*)p_; rg[k][1] = *(const f32x4*)(p_ + 4); rg[k][2] = *(const f32x4*)(p_ + 32); rg[k][3] = *(const f32x4*)(p_ + 36); } while (0)
        PG8_RLD(0); PG8_RLD(1);
#pragma unroll
        for (int k = 0; k < 8; ++k) { const int ai = k >> 2, m = k & 3;
            if (k + 2 < 8) PG8_RLD(k + 2);
            acc[ai][0][m][0] += rg[k][0]; acc[ai][0][m][1] += rg[k][1]; acc[ai][1][m][0] += rg[k][2]; acc[ai][1][m][1] += rg[k][3];
            asm volatile("" : "+v"(acc[ai][0][m][0]), "+v"(acc[ai][0][m][1]), "+v"(acc[ai][1][m][0]), "+v"(acc[ai][1][m][1]) :: "memory"); }
#undef PG8_RLD
#pragma unroll
        for (int ai = 0; ai < 2; ++ai)
#pragma unroll
            for (int m = 0; m < 4; ++m) { const int row = u.pm * BM + wr * 64 + fr + ai * HALF + m * 16; float s = 0.f; u32x4 wx[2];
#pragma unroll
                for (int bj = 0; bj < 2; ++bj) { const f32x4 v0 = acc[ai][bj][m][0], v1 = acc[ai][bj][m][1];
                    s += (v0[0] * v0[0] + v0[1] * v0[1]) + (v0[2] * v0[2] + v0[3] * v0[3]) + (v1[0] * v1[0] + v1[1] * v1[1]) + (v1[2] * v1[2] + v1[3] * v1[3]);
                    wx[bj] = pack8(v0, v1); }
                store_rows_bf16(xb, 1024, u.pm * BM + wr * 64 + ai * HALF + m * 16, u.pn * BM + wc * 64, fr, fq, wx[0], wx[1]);
                s += __shfl_xor(s, 16); s += __shfl_xor(s, 32);
                if (fq == 0) atomicAdd(ssq + row, s);
                asm volatile("" ::: "memory"); }
    }
};
struct EpiPle {
    static constexpr bool PERM = true, AFTER_DRAIN = false, MIDK = false, FP8 = true, FINAL = false; static constexpr int SCALE_B = 0x7b;
    const bf16_t* x2; bf16_t* x3; const bf16_t* e; const float* ssq;
    __device__ __forceinline__ void operator()(const f32x4 (&acc)[2][2][4][2], const Unit& u, int wr, int wc, int fr, int fq) const {
        const int row0 = u.pm * BM + wr * 64 + fr;
        float sq_next = ssq[row0];
#pragma unroll
        for (int ai = 0; ai < 2; ++ai)
#pragma unroll
            for (int m = 0; m < 4; ++m) { const int row = row0 + ai * HALF + m * 16; const float sq = sq_next; u32x4 wx[2];
                if (!(ai == 1 && m == 3)) sq_next = ssq[row0 + (m == 3 ? HALF : ai * HALF + (m + 1) * 16)];
                const float rstd = rsqrtf(sq * (1.0f / 1024.0f) + 1e-6f);
#pragma unroll
                for (int bj = 0; bj < 2; ++bj) { const int ct = wc * 64 + bj * 32 + 8 * fq; f32x4 v0 = acc[ai][bj][m][0] * rstd, v1 = acc[ai][bj][m][1] * rstd;
                    const size_t o = (size_t)row * 1024 + u.pn * BM + ct; f32x4 e0, e1, r0, r1; unpack8(*(const u32x4*)(e + o), e0, e1); unpack8(*(const u32x4*)(x2 + o), r0, r1);
#pragma unroll
                    for (int i = 0; i < 4; ++i) { v0[i] = r0[i] + sigm(v0[i]) * e0[i]; v1[i] = r1[i] + sigm(v1[i]) * e1[i]; }
                    wx[bj] = pack8(v0, v1); }
                store_rows_bf16(x3, 1024, u.pm * BM + wr * 64 + ai * HALF + m * 16, u.pn * BM + wc * 64, fr, fq, wx[0], wx[1]); }
    }
};

struct EpiPleFinal {
    static constexpr bool PERM = true, AFTER_DRAIN = false, MIDK = false, FP8 = true, FINAL = true; static constexpr int SCALE_B = 0x7b;
    const bf16_t* x2; const bf16_t* e; const float* ssq; float* ssq3; unsigned* cnt; unsigned* tmo; const float* gf; float* out;
    __device__ __forceinline__ void operator()(const f32x4 (&)[2][2][4][2], const Unit&, int, int, int, int) const {}
    __device__ __forceinline__ void run(f32x4 (&acc)[2][2][4][2], const Unit& u, int wr, int wc, int fr, int fq, PG8_LAS unsigned char* lds, int wid) const {
        const int row0 = u.pm * BM + wr * 64 + fr;
        float sq8[8], sv[8];
#pragma unroll
        for (int k = 0; k < 8; ++k) sq8[k] = ssq[row0 + (k >> 2) * HALF + (k & 3) * 16];
        const size_t ob = (size_t)row0 * 1024 + u.pn * BM + wc * 64 + 8 * fq;
        u32x4 eq[8][2], xq[8][2];
#define PG8_ELD(k) do { const size_t o_ = ob + (size_t)(((k) >> 2) * HALF + ((k) & 3) * 16) * 1024; eq[k][0] = *(const u32x4*)(e + o_); xq[k][0] = *(const u32x4*)(x2 + o_); eq[k][1] = *(const u32x4*)(e + o_ + 32); xq[k][1] = *(const u32x4*)(x2 + o_ + 32); } while (0)
        PG8_ELD(0); PG8_ELD(1);
#pragma unroll
        for (int k = 0; k < 8; ++k) { const int ai = k >> 2, m = k & 3; float s = 0.f;
            if (k + 2 < 8) PG8_ELD(k + 2);
            const float rstd = rsqrtf(sq8[k] * (1.0f / 1024.0f) + 1e-6f);
#pragma unroll
            for (int bj = 0; bj < 2; ++bj) { f32x4 v0 = acc[ai][bj][m][0] * rstd, v1 = acc[ai][bj][m][1] * rstd, e0, e1, r0, r1; unpack8(eq[k][bj], e0, e1); unpack8(xq[k][bj], r0, r1);
#pragma unroll
                for (int i = 0; i < 4; ++i) { v0[i] = r0[i] + sigm(v0[i]) * e0[i]; v1[i] = r1[i] + sigm(v1[i]) * e1[i]; }
                s += (v0[0] * v0[0] + v0[1] * v0[1]) + (v0[2] * v0[2] + v0[3] * v0[3]) + (v1[0] * v1[0] + v1[1] * v1[1]) + (v1[2] * v1[2] + v1[3] * v1[3]);
                acc[ai][bj][m][0] = v0; acc[ai][bj][m][1] = v1; }
            s += __shfl_xor(s, 16); s += __shfl_xor(s, 32); sv[k] = s;
            asm volatile("" : "+v"(acc[ai][0][m][0]), "+v"(acc[ai][0][m][1]), "+v"(acc[ai][1][m][0]), "+v"(acc[ai][1][m][1]), "+v"(sv[k]) :: "memory"); }
#undef PG8_ELD
        if (fq == 0) {
#pragma unroll
            for (int k = 0; k < 8; ++k) atomicAdd(ssq3 + row0 + (k >> 2) * HALF + (k & 3) * 16, sv[k]); }
        asm volatile("s_waitcnt vmcnt(0)" ::: "memory");
        __builtin_amdgcn_s_barrier();
        if (threadIdx.x == 0) {
            (void)__hip_atomic_fetch_add(cnt + u.pm, 1u, __ATOMIC_RELAXED, __HIP_MEMORY_SCOPE_AGENT);
            unsigned sp = 0u;
            while (__hip_atomic_load(cnt + u.pm, __ATOMIC_RELAXED, __HIP_MEMORY_SCOPE_AGENT) < 4u) { __builtin_amdgcn_s_sleep(1);
                if ((++sp & 255u) == 0u) { if (__hip_atomic_load(tmo, __ATOMIC_RELAXED, __HIP_MEMORY_SCOPE_AGENT)) break; if (sp > (1u << 18)) { atomicAdd(tmo, 1u); break; } } }
        }
        __builtin_amdgcn_s_barrier();
        asm volatile("" ::: "memory");
        const int lane = fr + 16 * fq, rr = lane >> 3, c = lane & 7;
        PG8_LAS float* tb = (PG8_LAS float*)(lds + 131072 + wid * 2048);
        PG8_LAS float* wp0 = tb + fr * 32 + (((2 * fq) ^ (fr & 7)) << 2); PG8_LAS float* wp1 = tb + fr * 32 + (((2 * fq + 1) ^ (fr & 7)) << 2);
        const PG8_LAS float* rp = tb + rr * 32 + ((c ^ rr) << 2);
        const float* gp = gf + u.pn * BM + wc * 64 + 4 * c; const f32x4 g0 = *(const f32x4*)gp, g1 = *(const f32x4*)(gp + 32);
        float q8[8];
#pragma unroll
        for (int k = 0; k < 8; ++k) q8[k] = __hip_atomic_load(ssq3 + row0 + (k >> 2) * HALF + (k & 3) * 16, __ATOMIC_RELAXED, __HIP_MEMORY_SCOPE_AGENT);
#pragma unroll
        for (int ai = 0; ai < 2; ++ai)
#pragma unroll
            for (int m = 0; m < 4; ++m) {
                const float rstd3 = rsqrtf(q8[4 * ai + m] * (1.0f / 1024.0f) + 1e-6f);
#pragma unroll
                for (int bj = 0; bj < 2; ++bj) {
                    *(PG8_LAS f32x4*)wp0 = acc[ai][bj][m][0] * rstd3; *(PG8_LAS f32x4*)wp1 = acc[ai][bj][m][1] * rstd3;
                    asm volatile("s_waitcnt lgkmcnt(0)" ::: "memory");
                    const f32x4 a = *(const PG8_LAS f32x4*)rp, b = *(const PG8_LAS f32x4*)(rp + 256);
                    asm volatile("s_waitcnt lgkmcnt(0)" ::: "memory");
                    float* p = out + (size_t)(u.pm * BM + wr * 64 + ai * HALF + m * 16 + rr) * 1024 + u.pn * BM + wc * 64 + bj * 32 + 4 * c;
                    const f32x4 gg = bj ? g1 : g0;
                    *(f32x4*)p = a * gg; *(f32x4*)(p + 8 * 1024) = b * gg; }
            }
    }
};

typedef int i32x8 __attribute__((ext_vector_type(8))); typedef int i32x4 __attribute__((ext_vector_type(4)));
__device__ __forceinline__ i32x8 cat8(bf16x8 a, bf16x8 b) { return __builtin_shufflevector(__builtin_bit_cast(i32x4, a), __builtin_bit_cast(i32x4, b), 0, 1, 2, 3, 4, 5, 6, 7); }
template <bool F8> struct Frag { bf16x8 v4[2]; i32x8 v8; __device__ __forceinline__ void set(bf16x8 a, bf16x8 b) { if constexpr (F8) v8 = cat8(a, b); else { v4[0] = a; v4[1] = b; } } };
template <class Epi, class Sched, bool ALIGN_EPI = false, bool SP2 = false>
__device__ __forceinline__ void gemm_phase(PG8_LAS unsigned char* lds, const Gemm g, const Sched& S, const Epi& E) {
    int tid_ = threadIdx.x; asm volatile("" : "+v"(tid_));
    const int tid = tid_, wid = __builtin_amdgcn_readfirstlane(tid >> 6), lane = tid & 63, wr = wid >> 2, wc = wid & 3, fr = lane & 15, fq = lane >> 4;
    int K_ = g.K; asm volatile("" : "+s"(K_));
    const int K = K_, nt = K / BK;
    unsigned voffA[2], voffB[2];
#pragma unroll
    for (int i = 0; i < 2; ++i) { int R, C; stage_rc(tid * 16 + i * 8192, R, C); const int Rb = Epi::PERM ? (2 * (R & ~31) + perm32(R & 31)) : R;
        voffA[i] = (unsigned)(R * K + C) * 2u; voffB[i] = (unsigned)(Rb * K + C) * 2u; }
    const size_t kstep = (size_t)(BK * 2);
    const size_t hstep = (size_t)HALF * K * 2;
    const size_t hstepB = Epi::PERM ? (size_t)32 * K * 2 : hstep;
    const size_t tstep = 2 * hstep;
    const unsigned ldsw = (unsigned)wid * 1024u;
    const int aoff = lds_byte(wr * 64 + fr, fq * 8), boff = lds_byte(wc * 32 + fr, fq * 8);
#define PG8_SA(b, h) (((b) * 2 + (h)) * HTB)
#define PG8_SB(b, h) ((4 + (b) * 2 + (h)) * HTB)
#define PG8_STAGE(bufoff, gbase, voff) do { _Pragma("unroll") for (int _i = 0; _i < 2; ++_i) \
        __builtin_amdgcn_global_load_lds((const unsigned*)((const char*)(gbase) + (voff)[_i]), (PG8_LAS unsigned*)(lds + (bufoff) + ldsw + _i * 8192), 16, 0, 0); } while (0)
#define PG8_LDA(dst, b, h) do { _Pragma("unroll") for (int m = 0; m < 4; ++m) { const bf16x8 f0_ = *(const PG8_LAS bf16x8*)(lds + PG8_SA(b, h) + aoff + m * 2048), f1_ = *(const PG8_LAS bf16x8*)(lds + PG8_SA(b, h) + aoff + m * 2048 + 1024); dst[m].set(f0_, f1_); } } while (0)
#define PG8_LDB(dst, b, h) do { _Pragma("unroll") for (int n = 0; n < 2; ++n) { const bf16x8 f0_ = *(const PG8_LAS bf16x8*)(lds + PG8_SB(b, h) + boff + n * 2048), f1_ = *(const PG8_LAS bf16x8*)(lds + PG8_SB(b, h) + boff + n * 2048 + 1024); dst[n].set(f0_, f1_); } } while (0)
#define PG8_MMA(ai, bj, At, Bt) do { __builtin_amdgcn_s_setprio(1); \
        if constexpr (Epi::FP8) { _Pragma("unroll") for (int m = 0; m < 4; ++m) _Pragma("unroll") for (int n = 0; n < 2; ++n) \
            asm volatile("v_mfma_scale_f32_16x16x128_f8f6f4 %0, %1, %2, %0, %3, %4 op_sel_hi:[0,0,0]" : "+v"(acc[ai][bj][m][n]) : "v"(Bt[n].v8), "v"(At[m].v8), "v"(sclB), "v"(sclA)); } \
        else { _Pragma("unroll") for (int m = 0; m < 4; ++m) _Pragma("unroll") for (int n = 0; n < 2; ++n) _Pragma("unroll") for (int k = 0; k < 2; ++k) \
            acc[ai][bj][m][n] = __builtin_amdgcn_mfma_f32_16x16x32_bf16(Bt[n].v4[k], At[m].v4[k], acc[ai][bj][m][n], 0, 0, 0); } \
        __builtin_amdgcn_s_setprio(0); } while (0)
#define PG8_WAIT_V(n) asm volatile("s_waitcnt vmcnt(" #n ")" ::: "memory")
#define PG8_WAIT_L(n) asm volatile("s_waitcnt lgkmcnt(" #n ")" ::: "memory")
#define PG8_BAR __builtin_amdgcn_s_barrier()
#define PG8_SCHED __builtin_amdgcn_sched_barrier(0)
    Unit cur, nxt; int ui = 0;
    if (!S.next(0, cur)) return;
    f32x4 acc[2][2][4][2];
#pragma unroll
    for (int a = 0; a < 2; ++a)
#pragma unroll
        for (int b = 0; b < 2; ++b)
#pragma unroll
            for (int m = 0; m < 4; ++m)
#pragma unroll
                for (int n = 0; n < 2; ++n) acc[a][b][m][n] = (f32x4){0.f, 0.f, 0.f, 0.f};
    Frag<Epi::FP8> At[4], B0[2], B1[2];
    const int sclB = Epi::SCALE_B, sclA = 0x7f;
    const char* cA = (const char*)g.A + (size_t)cur.pm * tstep; const char* cB = (const char*)g.Bt + (size_t)cur.pn * tstep;
    S.a_ready(cur);
    if constexpr (SP2) {
        PG8_STAGE(PG8_SB(0, 0), cB, voffB); PG8_STAGE(PG8_SB(0, 1), cB + hstepB, voffB); PG8_STAGE(PG8_SA(0, 0), cA, voffA); PG8_STAGE(PG8_SA(0, 1), cA + hstep, voffA);
        if (wr == 1) PG8_BAR;
        PG8_WAIT_V(2); PG8_BAR;
        PG8_STAGE(PG8_SB(1, 0), cB + kstep, voffB); PG8_STAGE(PG8_SA(1, 0), cA + kstep, voffA); PG8_STAGE(PG8_SB(1, 1), cB + hstepB + kstep, voffB);
        PG8_WAIT_V(6); PG8_BAR;
    } else {
        PG8_STAGE(PG8_SB(0, 0), cB, voffB); PG8_STAGE(PG8_SA(0, 0), cA, voffA); PG8_STAGE(PG8_SB(0, 1), cB + hstepB, voffB); PG8_STAGE(PG8_SA(0, 1), cA + hstep, voffA);
        if (wr == 1) PG8_BAR;
        PG8_WAIT_V(4); PG8_BAR;
        PG8_STAGE(PG8_SB(1, 0), cB + kstep, voffB); PG8_STAGE(PG8_SA(1, 0), cA + kstep, voffA); PG8_STAGE(PG8_SB(1, 1), cB + hstepB + kstep, voffB);
        PG8_WAIT_V(6); PG8_BAR;
    }
    for (;;) {
        const bool has_next = S.next(ui + 1, nxt);
        const char* nA = has_next ? (const char*)g.A + (size_t)nxt.pm * tstep : cA; const char* nB = has_next ? (const char*)g.Bt + (size_t)nxt.pn * tstep : cB;
        for (int t = 0; t < nt; t += 2) {
            if constexpr (Epi::MIDK) { if (t == (nt >> 1)) E.mid(acc, cur, wr, wc, fr, fq); }
            const bool last = (t == nt - 2);
            const char* a1 = cA + (size_t)(t + 1) * kstep;
            const char* a2 = last ? nA : cA + (size_t)(t + 2) * kstep; const char* b2 = last ? nB : cB + (size_t)(t + 2) * kstep;
            const char* a3 = a2 + kstep; const char* b3 = b2 + kstep;
            if (last && has_next) S.a_ready(nxt);
            if constexpr (SP2) {
            PG8_LDB(B0, 0, 0); PG8_LDB(B1, 0, 1); PG8_SCHED; PG8_LDA(At, 0, 0); PG8_STAGE(PG8_SA(1, 1), a1 + hstep, voffA);
            PG8_WAIT_V(8); PG8_WAIT_L(0); PG8_BAR; PG8_MMA(0, 0, At, B0); PG8_MMA(0, 1, At, B1); PG8_BAR; PG8_SCHED;
            PG8_LDA(At, 0, 1); PG8_STAGE(PG8_SB(0, 0), b2, voffB); PG8_STAGE(PG8_SB(0, 1), b2 + hstepB, voffB); PG8_STAGE(PG8_SA(0, 0), a2, voffA);
            PG8_WAIT_V(8); PG8_WAIT_L(0); PG8_BAR; PG8_MMA(1, 0, At, B0); PG8_MMA(1, 1, At, B1); PG8_BAR; PG8_SCHED;
            PG8_LDB(B0, 1, 0); PG8_LDB(B1, 1, 1); PG8_SCHED; PG8_LDA(At, 1, 0); PG8_STAGE(PG8_SA(0, 1), a2 + hstep, voffA);
            PG8_WAIT_V(8); PG8_WAIT_L(0); PG8_BAR; PG8_MMA(0, 0, At, B0); PG8_MMA(0, 1, At, B1); PG8_BAR; PG8_SCHED;
            PG8_LDA(At, 1, 1); PG8_STAGE(PG8_SB(1, 0), b3, voffB); PG8_STAGE(PG8_SB(1, 1), b3 + hstepB, voffB); PG8_STAGE(PG8_SA(1, 0), a3, voffA);
            PG8_WAIT_V(8); PG8_WAIT_L(0); PG8_BAR; PG8_MMA(1, 0, At, B0); PG8_MMA(1, 1, At, B1); PG8_BAR; PG8_SCHED;
            } else {
            PG8_LDB(B0, 0, 0); PG8_SCHED; PG8_LDA(At, 0, 0); PG8_STAGE(PG8_SA(1, 1), a1 + hstep, voffA);
            PG8_WAIT_L(8); PG8_BAR; PG8_WAIT_L(0); PG8_MMA(0, 0, At, B0); PG8_BAR; PG8_SCHED;
            PG8_LDB(B1, 0, 1); PG8_STAGE(PG8_SB(0, 0), b2, voffB);
            PG8_BAR; PG8_WAIT_L(0); PG8_MMA(0, 1, At, B1); PG8_BAR;
            PG8_LDA(At, 0, 1); PG8_STAGE(PG8_SA(0, 0), a2, voffA);
            PG8_BAR; PG8_WAIT_L(0); PG8_MMA(1, 0, At, B0); PG8_BAR; PG8_SCHED;
            PG8_STAGE(PG8_SB(0, 1), b2 + hstepB, voffB);
            PG8_WAIT_V(6); PG8_BAR; PG8_MMA(1, 1, At, B1); PG8_BAR;
            PG8_LDB(B0, 1, 0); PG8_SCHED; PG8_LDA(At, 1, 0); PG8_STAGE(PG8_SA(0, 1), a2 + hstep, voffA);
            PG8_WAIT_L(8); PG8_BAR; PG8_WAIT_L(0); PG8_MMA(0, 0, At, B0); PG8_BAR; PG8_SCHED;
            PG8_LDB(B1, 1, 1); PG8_STAGE(PG8_SB(1, 0), b3, voffB);
            PG8_BAR; PG8_WAIT_L(0); PG8_MMA(0, 1, At, B1); PG8_BAR;
            PG8_LDA(At, 1, 1); PG8_STAGE(PG8_SA(1, 0), a3, voffA);
            PG8_BAR; PG8_WAIT_L(0); PG8_MMA(1, 0, At, B0); PG8_BAR; PG8_SCHED;
            PG8_STAGE(PG8_SB(1, 1), b3 + hstepB, voffB);
            PG8_WAIT_V(6); PG8_BAR; PG8_MMA(1, 1, At, B1); PG8_BAR;
            }
        }
        if constexpr (ALIGN_EPI) { if (wr == 0) PG8_BAR; }
        if constexpr (Epi::FINAL) { E.run(acc, cur, wr, wc, fr, fq, lds, wid); S.done(cur); }
        else if constexpr (!Epi::AFTER_DRAIN) { E(acc, cur, wr, wc, fr, fq); S.done(cur); }
        if (!has_next) break;
#pragma unroll
        for (int a = 0; a < 2; ++a)
#pragma unroll
            for (int b = 0; b < 2; ++b)
#pragma unroll
                for (int m = 0; m < 4; ++m)
#pragma unroll
                    for (int n = 0; n < 2; ++n) acc[a][b][m][n] = (f32x4){0.f, 0.f, 0.f, 0.f};
        cur = nxt; cA = nA; cB = nB; ++ui;
        if constexpr (ALIGN_EPI) { if (wr == 1) PG8_BAR; }
    }
    PG8_WAIT_V(0);
    if constexpr (!ALIGN_EPI) { if (wr == 0) PG8_BAR; }
    PG8_BAR;
    if constexpr (Epi::AFTER_DRAIN) { E.fused(acc, cur, wr, wc, fr, fq, lds, wid, lane); S.done(cur); }
#undef PG8_SA
#undef PG8_SB
#undef PG8_STAGE
#undef PG8_LDA
#undef PG8_LDB
#undef PG8_MMA
#undef PG8_WAIT_V
#undef PG8_WAIT_L
#undef PG8_BAR
#undef PG8_SCHED
}
}

#define GAS __attribute__((address_space(1)))
#define LAS __attribute__((address_space(3)))
typedef unsigned short bf16;
typedef unsigned v4u __attribute__((ext_vector_type(4)));
typedef unsigned v2u __attribute__((ext_vector_type(2)));
typedef float f32x4 __attribute__((ext_vector_type(4)));
using pg8::bf_lo; using pg8::bf_hi; using pg8::sigm;

constexpr int NTOK = 32768, SEQ = 16384, DM = 1024, NW = 8;
constexpr float EPS = 1e-6f;
constexpr float C2 = 0.125f * 1.4426950408889634f;
constexpr size_t MiB = 1u << 20;
constexpr size_t WS_W1T = 1 * MiB, WS_WAT = 12 * MiB, WS_WMT = 13 * MiB, WS_WOT = 14 * MiB, WS_WQT = 16 * MiB, WS_WGT = 20 * MiB, WS_WPT = 22 * MiB;
constexpr size_t WS_K1B = 22 * MiB + 512 * 1024, WS_K2B = 22 * MiB + 768 * 1024, WS_IF = 23 * MiB, WS_UB = 24 * MiB, WS_VB = 56 * MiB;
constexpr size_t WS_XN = 88 * MiB, WS_YA = 88 * MiB, WS_YM = 120 * MiB, WS_HN = 88 * MiB;
constexpr size_t WS_QKVA = 152 * MiB, WS_QKM = 248 * MiB, WS_VM = 312 * MiB, WS_OM = 344 * MiB, WS_G = 376 * MiB;
constexpr size_t WS_DN = 504 * MiB, WS_NS = 505 * MiB, WS_SC = 506 * MiB;
constexpr size_t WS_MERGED = 152 * MiB, WS_TMP = 216 * MiB, WS_Q2 = 376 * MiB, WS_IDX = 152 * MiB, WS_GATE = 168 * MiB, WS_HN2 = 184 * MiB, WS_PB = 56 * MiB, WS_E = 264 * MiB;
constexpr size_t WS_NEED = 507 * MiB;
constexpr size_t WS_U8 = 24 * MiB, WS_V8 = 40 * MiB, WS_PART = 376 * MiB, WS_SSQ = 506 * MiB + 512 * 1024;
constexpr size_t WS_XQ8 = 280 * MiB;
constexpr size_t WS_W1F8 = 1 * MiB;
constexpr size_t WS_X2B8 = 184 * MiB, WS_WG8 = 72 * MiB;
constexpr size_t WS_SUR = 240 * MiB, WS_SVR = 256 * MiB;
constexpr size_t WS_REC = 216 * MiB;
constexpr size_t WS_X3B = 376 * MiB;
constexpr size_t WS_U4 = 24 * MiB, WS_V4 = 32 * MiB, WS_SU = 40 * MiB, WS_SV = 40 * MiB + 65536;
constexpr size_t WS_SSQ1 = 506 * MiB + 768 * 1024, WS_SSQ3 = 506 * MiB + 640 * 1024, WS_BAR = 0, BAR_BYTES = 32768;
constexpr int BAR_CNT13 = 5120;
constexpr size_t OUT_DC = 0, OUT_CS = 64 * MiB;
constexpr int LDS_BYTES = 152576;

__device__ __forceinline__ unsigned f2bf(float f) { unsigned u = __float_as_uint(f); return (u + 0x7fffu + ((u >> 16) & 1u)) >> 16; }
__device__ __forceinline__ unsigned pk2(float lo, float hi) { return f2bf(lo) | (f2bf(hi) << 16); }
__device__ __forceinline__ float bf2f(bf16 b) { return __uint_as_float((unsigned)b << 16); }
__device__ __forceinline__ float wave_sum(float v) {
#pragma unroll
    for (int o = 1; o < 64; o <<= 1) v += __shfl_xor(v, o);
    return v;
}
__device__ __forceinline__ float wave_max(float v) {
#pragma unroll
    for (int o = 1; o < 64; o <<= 1) v = fmaxf(v, __shfl_xor(v, o));
    return v;
}
__device__ __forceinline__ void unpk8(const v4u w, float* f) { f[0] = bf_lo(w.x); f[1] = bf_hi(w.x); f[2] = bf_lo(w.y); f[3] = bf_hi(w.y); f[4] = bf_lo(w.z); f[5] = bf_hi(w.z); f[6] = bf_lo(w.w); f[7] = bf_hi(w.w); }
__device__ __forceinline__ v4u pk8(const float* f) { v4u w; w.x = pk2(f[0], f[1]); w.y = pk2(f[2], f[3]); w.z = pk2(f[4], f[5]); w.w = pk2(f[6], f[7]); return w; }
typedef __bf16 bf16x2_t __attribute__((ext_vector_type(2)));
__device__ __forceinline__ float dot2bf(unsigned a, unsigned b, float c) { return __builtin_amdgcn_fdot2_f32_bf16(__builtin_bit_cast(bf16x2_t, a), __builtin_bit_cast(bf16x2_t, b), c, false); }
__device__ __forceinline__ float logsigmoid(float x) { return fminf(x, 0.f) - log1pf(__expf(-fabsf(x))); }
__device__ __forceinline__ float silu(float x) { return x * __builtin_amdgcn_rcpf(1.0f + __builtin_amdgcn_exp2f(-1.4426950408889634f * x)); }

#define XB_TMO      128
#define XB_XCNT(j)  (256  + 64 * (j))
#define XB_XSUB(j)  (1280 + 64 * (j))
#define XB_XGEN(j)  (2304 + 64 * (j))
#define XB_TOP      3328
#define XB_TOPGEN   3392
#define XCD_BAR_WORDS 3456
#define XB_SPIN_CAP (1u << 18)

__device__ __forceinline__ unsigned xb_ld(unsigned* p)              { return __hip_atomic_load(p, __ATOMIC_RELAXED, __HIP_MEMORY_SCOPE_AGENT); }
__device__ __forceinline__ unsigned xb_add(unsigned* p, unsigned v) { return __hip_atomic_fetch_add(p, v, __ATOMIC_RELAXED, __HIP_MEMORY_SCOPE_AGENT); }
__device__ __forceinline__ unsigned xb_xcc_id() { return (unsigned)__builtin_amdgcn_s_getreg((3 << 11) | 20) & 0xFu; }
#define XB_SPIN(cond, bar) do { unsigned _sp = 0; while (cond) { __builtin_amdgcn_s_sleep(1); \
    if ((++_sp & 255u) == 0u) { if (xb_ld(&(bar)[XB_TMO])) break; if (_sp > XB_SPIN_CAP) { atomicAdd(&(bar)[XB_TMO], 1u); break; } } } } while (0)

struct XcdBarrier {
    unsigned* bar; unsigned x;
    volatile LAS unsigned* st;
};

__device__ __forceinline__ XcdBarrier xcd_barrier_post(unsigned* bar, volatile LAS unsigned* st) {
    XcdBarrier b; b.bar = bar; b.x = xb_xcc_id(); b.st = st;
    if (threadIdx.x == 0) (void)xb_add(&bar[XB_XCNT(b.x)], 1u);
    return b;
}
__device__ __forceinline__ void xcd_barrier_complete(unsigned* bar, unsigned x, unsigned& nloc, unsigned& nx) {
    const unsigned G = gridDim.x * gridDim.y * gridDim.z;
    unsigned sum, cnt, mine, sp = 0u;
    for (;;) {
        sum = 0u; cnt = 0u; mine = 0u;
#pragma unroll
        for (unsigned j = 0; j < 16; ++j) { const unsigned c = xb_ld(&bar[XB_XCNT(j)]); sum += c; cnt += (c > 0u) ? 1u : 0u; mine = (j == x) ? c : mine; }
        if (sum == G) break;
        __builtin_amdgcn_s_sleep(1);
        if ((++sp & 255u) == 0u) { if (xb_ld(&bar[XB_TMO])) break; if (sp > XB_SPIN_CAP) { atomicAdd(&bar[XB_TMO], 1u); break; } }
    }
    nloc = mine > 0u ? mine : 1u; nx = cnt > 0u ? cnt : 1u;
}

__device__ __forceinline__ void xcd_barrier(const XcdBarrier& b) {
    asm volatile("s_waitcnt vmcnt(0)" ::: "memory");
    __syncthreads();
    if (threadIdx.x == 0) {
        unsigned* bar = b.bar;
        __builtin_amdgcn_s_waitcnt(0);
        unsigned nloc = b.st[0], nx = b.st[1];
        if (nloc == 0u) { xcd_barrier_complete(bar, b.x, nloc, nx); b.st[0] = nloc; b.st[1] = nx; }
        const unsigned old = xb_add(&bar[XB_XSUB(b.x)], 1u);
        const unsigned gen = old / nloc;
        if (old + 1u == (gen + 1u) * nloc) {
            __builtin_amdgcn_fence(__ATOMIC_RELEASE, "agent");
            asm volatile("s_waitcnt vmcnt(0)" ::: "memory");
            const unsigned og = xb_add(&bar[XB_TOP], 1u);
            const unsigned tg = og / nx;
            if (og + 1u == (tg + 1u) * nx) xb_add(&bar[XB_TOPGEN], 1u);
            else XB_SPIN(xb_ld(&bar[XB_TOPGEN]) == tg, bar);
            __builtin_amdgcn_fence(__ATOMIC_ACQUIRE, "agent");
            xb_add(&bar[XB_XGEN(b.x)], 1u);
            asm volatile("s_waitcnt vmcnt(0)" ::: "memory");
        } else {
            XB_SPIN(xb_ld(&bar[XB_XGEN(b.x)]) == gen, bar);
            __builtin_amdgcn_fence(__ATOMIC_ACQUIRE, "agent");
            asm volatile("s_waitcnt vmcnt(0)" ::: "memory");
        }
    }
    __syncthreads();
}


struct Params { const float* in[20]; float* out; unsigned char* ws; int ph_lo, ph_hi; };

__device__ __forceinline__ void transpose_item(const float* W, int ldw, int col0, int K, bf16* WT, int row0, LAS float* scr, int item, int nblk, int lane, int koff = 0, const float* kgain = nullptr, unsigned char* WT8 = nullptr, float sc8 = 1.0f) {
    const int kb = item / nblk, nb = item % nblk, k0 = 64 * kb, n0 = 32 * nb;
    f32x4 tv[8];
#pragma unroll
    for (int i = 0; i < 8; ++i) tv[i] = *(const f32x4*)(W + (size_t)(k0 + 8 * i + (lane >> 3)) * ldw + col0 + n0 + 4 * (lane & 7));
#pragma unroll
    for (int i = 0; i < 8; ++i) { const int kk = 8 * i + (lane >> 3); const float gk = kgain ? kgain[k0 + kk] : 1.0f; LAS float* d = scr + kk * 33 + 4 * (lane & 7);
        d[0] = tv[i][0] * gk; d[1] = tv[i][1] * gk; d[2] = tv[i][2] * gk; d[3] = tv[i][3] * gk; }
    asm volatile("s_waitcnt lgkmcnt(0)" ::: "memory");
    const int c = lane & 7;
#pragma unroll
    for (int j = 0; j < 4; ++j) { const int n = (lane >> 3) + 8 * j; const LAS float* s = scr + (8 * c) * 33 + n;
        v4u o; o.x = pk2(s[0 * 33], s[1 * 33]); o.y = pk2(s[2 * 33], s[3 * 33]); o.z = pk2(s[4 * 33], s[5 * 33]); o.w = pk2(s[6 * 33], s[7 * 33]);
        if (WT) *(v4u*)(WT + (size_t)(row0 + n0 + n) * K + koff + k0 + 8 * c) = o;
        if (WT8) { int p0 = __builtin_amdgcn_cvt_pk_fp8_f32(s[0 * 33] * sc8, s[1 * 33] * sc8, 0, false); p0 = __builtin_amdgcn_cvt_pk_fp8_f32(s[2 * 33] * sc8, s[3 * 33] * sc8, p0, true);
            int p1 = __builtin_amdgcn_cvt_pk_fp8_f32(s[4 * 33] * sc8, s[5 * 33] * sc8, 0, false); p1 = __builtin_amdgcn_cvt_pk_fp8_f32(s[6 * 33] * sc8, s[7 * 33] * sc8, p1, true);
            *(uint2*)(WT8 + (size_t)(row0 + n0 + n) * K + koff + k0 + 8 * c) = make_uint2((unsigned)p0, (unsigned)p1); } }
    asm volatile("s_waitcnt lgkmcnt(0)" ::: "memory");
}
__device__ __forceinline__ void cvt_f32_bf16(const float* src, bf16* dst, size_t n4, size_t gtid, size_t gsz) {
    for (size_t i = gtid; i < n4; i += gsz) { const f32x4 v = ((const f32x4*)src)[i]; uint2 o; o.x = pk2(v[0], v[1]); o.y = pk2(v[2], v[3]); ((uint2*)dst)[i] = o; }
}
__device__ __forceinline__ void p0_prologue(const Params& P, LAS unsigned char* lds, int tid, int lane, int wave) {
    unsigned char* ws = P.ws;
    const int gw = blockIdx.x * NW + wave, NGW = gridDim.x * NW;
    LAS float* scr = (LAS float*)(lds + wave * 8448);
    LAS float* wif = (LAS float*)(lds + 69632);
    const float* w_in = P.in[3];
    for (int i = tid; i < 8192; i += 512) wif[i] = w_in[(size_t)(i >> 3) * 5640 + 3584 + (i & 7)];
    __syncthreads();
    constexpr int I1A = 16 * 112, I1B = 16 * 64, IUP = 8 * 32, IOUT = 16 * 32, IQ = 16 * 64, IPL = 4 * 32;
    constexpr int NITEMS = I1A + I1B + 2 * IUP + IOUT + IQ + IOUT + IPL;
    for (int it = gw; it < NITEMS; it += NGW) {
        int r = it;
        if (r < I1A) { transpose_item(w_in, 5640, 0, 1024, nullptr, 0, scr, r, 112, lane, 0, nullptr, ws + WS_W1F8, 16.0f); continue; } r -= I1A;
        if (r < I1B) { transpose_item(w_in, 5640, 3592, 1024, nullptr, 3584, scr, r, 64, lane, 0, nullptr, ws + WS_W1F8, 16.0f); continue; } r -= I1B;
        if (r < IUP) { transpose_item(P.in[7], 1024, 0, 1024, (bf16*)(ws + WS_WAT), 0, scr, r, 32, lane, 0); continue; } r -= IUP;
        if (r < IUP) { transpose_item(P.in[8], 1024, 0, 1024, (bf16*)(ws + WS_WAT), 0, scr, r, 32, lane, 512); continue; } r -= IUP;
        if (r < IOUT) { transpose_item(P.in[9], 1024, 0, 1024, (bf16*)(ws + WS_WOT), 0, scr, r, 32, lane); continue; } r -= IOUT;
        if (r < IQ) { transpose_item(P.in[11], 2048, 0, 1024, (bf16*)(ws + WS_WQT), 0, scr, r, 64, lane, 0, P.in[10]); continue; } r -= IQ;
        if (r < IOUT) { transpose_item(P.in[17], 1024, 0, 1024, (bf16*)(ws + WS_WGT), 0, scr, r, 32, lane, 0, P.in[16], ws + WS_WG8, 16.0f); continue; } r -= IOUT;
        transpose_item(P.in[18], 1024, 0, 256, (bf16*)(ws + WS_WPT), 0, scr, r, 32, lane);
    }
    const size_t gtid = (size_t)blockIdx.x * 512 + tid, gsz = (size_t)gridDim.x * 512;
    cvt_f32_bf16(P.in[12], (bf16*)(ws + WS_K1B), 8 * 128 * 128 / 4, gtid, gsz);
    cvt_f32_bf16(P.in[13], (bf16*)(ws + WS_K2B), 8 * 128 * 128 / 4, gtid, gsz);
    for (size_t i = gtid; i < (size_t)NTOK; i += gsz) { ((float*)(ws + WS_SSQ))[i] = 0.f; ((float*)(ws + WS_SSQ1))[i] = 0.f; ((float*)(ws + WS_SSQ3))[i] = 0.f; }
    const float* x = P.in[0]; const float* gmix = P.in[2]; const float* gbias = P.in[5];
    float* IFb = (float*)(ws + WS_IF);
    f32x4 xgn[4], xnx[4], xny[4], xnz[4];
#pragma unroll
    for (int j = 0; j < 4; ++j) { xgn[j] = ((const f32x4*)gmix)[lane + 64 * j]; if (gw < NTOK) xnx[j] = ((const f32x4*)(x + (size_t)gw * 1024))[lane + 64 * j]; if (gw + NGW < NTOK) xny[j] = ((const f32x4*)(x + (size_t)(gw + NGW) * 1024))[lane + 64 * j]; if (gw + 2 * NGW < NTOK) xnz[j] = ((const f32x4*)(x + (size_t)(gw + 2 * NGW) * 1024))[lane + 64 * j]; }
    for (int m = gw; m < NTOK; m += NGW) {
        f32x4 v[4];
#pragma unroll
        for (int j = 0; j < 4; ++j) { v[j] = xnx[j]; xnx[j] = xny[j]; xny[j] = xnz[j]; }
        if (m + 3 * NGW < NTOK) {
#pragma unroll
            for (int j = 0; j < 4; ++j) xnz[j] = ((const f32x4*)(x + (size_t)(m + 3 * NGW) * 1024))[lane + 64 * j];
        }
        float a16[16];
#pragma unroll
        for (int i = 0; i < 16; ++i) a16[i] = 0.f;
#pragma unroll
        for (int j = 0; j < 4; ++j) {
            const f32x4 g = xgn[j];
#pragma unroll
            for (int i = 0; i < 4; ++i) { a16[0] += v[j][i] * v[j][i]; v[j][i] *= g[i]; const int d = 4 * (lane + 64 * j) + i; const f32x4 wa = *(const LAS f32x4*)(wif + d * 8), wb = *(const LAS f32x4*)(wif + d * 8 + 4);
                a16[1] += v[j][i] * wa[0]; a16[2] += v[j][i] * wa[1]; a16[3] += v[j][i] * wa[2]; a16[4] += v[j][i] * wa[3]; a16[5] += v[j][i] * wb[0]; a16[6] += v[j][i] * wb[1]; a16[7] += v[j][i] * wb[2]; a16[8] += v[j][i] * wb[3]; }
        }
        float r8[8], r4[4], r2[2], r1;
        { const bool b = lane & 32;
#pragma unroll
          for (int i = 0; i < 8; ++i) { const float keep = b ? a16[8 + i] : a16[i], send = b ? a16[i] : a16[8 + i]; r8[i] = keep + __shfl_xor(send, 32); } }
        { const bool b = lane & 16;
#pragma unroll
          for (int i = 0; i < 4; ++i) { const float keep = b ? r8[4 + i] : r8[i], send = b ? r8[i] : r8[4 + i]; r4[i] = keep + __shfl_xor(send, 16); } }
        { const bool b = lane & 8;
#pragma unroll
          for (int i = 0; i < 2; ++i) { const float keep = b ? r4[2 + i] : r4[i], send = b ? r4[i] : r4[2 + i]; r2[i] = keep + __shfl_xor(send, 8); } }
        { const bool b = lane & 4; const float keep = b ? r2[1] : r2[0], send = b ? r2[0] : r2[1]; r1 = keep + __shfl_xor(send, 4); }
        r1 += __shfl_xor(r1, 2); r1 += __shfl_xor(r1, 1);
        const float rstd = rsqrtf(__shfl(r1, 0) * (1.f / 1024.f) + EPS);
#pragma unroll
        for (int j = 0; j < 4; ++j) {
            int p8 = __builtin_amdgcn_cvt_pk_fp8_f32(v[j][0] * rstd, v[j][1] * rstd, 0, false); p8 = __builtin_amdgcn_cvt_pk_fp8_f32(v[j][2] * rstd, v[j][3] * rstd, p8, true); ((int*)((unsigned char*)P.out + (size_t)m * 1024))[lane + 64 * j] = p8; }
        const int which = ((lane >> 5) & 1) * 8 + ((lane >> 4) & 1) * 4 + ((lane >> 3) & 1) * 2 + ((lane >> 2) & 1);
        if ((lane & 3) == 0 && which >= 1 && which <= 8) IFb[(size_t)m * 8 + which - 1] = r1 * rstd + gbias[which - 1];
    }
}

__device__ __forceinline__ void p3_side_tables(const Params& P, LAS unsigned char* lds, int tid, int lane, int wave, int sb, int nsb) {
    unsigned char* ws = P.ws;
    const int gw = sb * NW + wave, NGW = nsb * NW;
    LAS float* scr = (LAS float*)(lds + wave * 8448);
    f32x4 egn[4]; { const float* gf = P.in[10]; egn[0] = ((const f32x4*)gf)[2 * lane]; egn[1] = ((const f32x4*)gf)[2 * lane + 1]; egn[2] = ((const f32x4*)gf)[128 + 2 * lane]; egn[3] = ((const f32x4*)gf)[128 + 2 * lane + 1]; }
    f32x4 vnx[4], vny[4], vnz[4];
#define P0_TROW(dst, rn_) do { const int rn = (rn_); const float* src = P.in[14 + (rn >> 14)] + (size_t)(rn & 16383) * 1024; dst[0] = ((const f32x4*)src)[2 * lane]; dst[1] = ((const f32x4*)src)[2 * lane + 1]; dst[2] = ((const f32x4*)src)[128 + 2 * lane]; dst[3] = ((const f32x4*)src)[128 + 2 * lane + 1]; } while (0)
    if (gw < 2 * 16384) P0_TROW(vnx, gw);
    if (gw + NGW < 2 * 16384) P0_TROW(vny, gw + NGW);
    if (gw + 2 * NGW < 2 * 16384) P0_TROW(vnz, gw + 2 * NGW);
    for (int rw = gw; rw < 2 * 16384; rw += NGW) {
        const int tb_ = rw >> 14, e = rw & 16383;
        f32x4 v[4]; v[0] = vnx[0]; v[1] = vnx[1]; v[2] = vnx[2]; v[3] = vnx[3];
        vnx[0] = vny[0]; vnx[1] = vny[1]; vnx[2] = vny[2]; vnx[3] = vny[3]; vny[0] = vnz[0]; vny[1] = vnz[1]; vny[2] = vnz[2]; vny[3] = vnz[3];
        if (rw + 3 * NGW < 2 * 16384) P0_TROW(vnz, rw + 3 * NGW);
        if (!tb_) { v[0] = v[0] * egn[0]; v[1] = v[1] * egn[1]; v[2] = v[2] * egn[2]; v[3] = v[3] * egn[3]; }
        float mx = 0.f, sq = 0.f;
#pragma unroll
        for (int j = 0; j < 4; ++j)
#pragma unroll
            for (int i = 0; i < 4; ++i) { mx = fmaxf(mx, fabsf(v[j][i])); sq += v[j][i] * v[j][i]; }
        mx = wave_max(mx);
        unsigned w0 = 0u, w1 = 0u; float sc;
        {
            sc = mx > 0.f ? mx * (1.0f / 6.0f) : 1.0f; const float inv = 1.0f / sc;
            w0 = __builtin_amdgcn_cvt_scalef32_pk_fp4_f32(w0, v[0][0] * inv, v[0][1] * inv, 1.0f, 0); w0 = __builtin_amdgcn_cvt_scalef32_pk_fp4_f32(w0, v[0][2] * inv, v[0][3] * inv, 1.0f, 1);
            w0 = __builtin_amdgcn_cvt_scalef32_pk_fp4_f32(w0, v[1][0] * inv, v[1][1] * inv, 1.0f, 2); w0 = __builtin_amdgcn_cvt_scalef32_pk_fp4_f32(w0, v[1][2] * inv, v[1][3] * inv, 1.0f, 3);
            w1 = __builtin_amdgcn_cvt_scalef32_pk_fp4_f32(w1, v[2][0] * inv, v[2][1] * inv, 1.0f, 0); w1 = __builtin_amdgcn_cvt_scalef32_pk_fp4_f32(w1, v[2][2] * inv, v[2][3] * inv, 1.0f, 1);
            w1 = __builtin_amdgcn_cvt_scalef32_pk_fp4_f32(w1, v[3][0] * inv, v[3][1] * inv, 1.0f, 2); w1 = __builtin_amdgcn_cvt_scalef32_pk_fp4_f32(w1, v[3][2] * inv, v[3][3] * inv, 1.0f, 3);
        }
        unsigned* dst = (unsigned*)(ws + (tb_ ? WS_V4 : WS_U4)) + (size_t)(lane >> 5) * 524288 + (size_t)e * 32 + (lane & 31);
        if (tb_) {
            LAS unsigned char* sb = (LAS unsigned char*)scr; const int l5 = lane & 31, s0 = (lane >> 5) * 128, bp = 32 * (l5 & 3) + (l5 >> 2);
            asm volatile("s_waitcnt lgkmcnt(0)" ::: "memory");
#pragma unroll
            for (int b = 0; b < 4; ++b) { sb[s0 + bp + 8 * b] = (unsigned char)(w0 >> (8 * b)); sb[256 + s0 + bp + 8 * b] = (unsigned char)(w1 >> (8 * b)); }
            asm volatile("s_waitcnt lgkmcnt(0)" ::: "memory");
            w0 = *(LAS unsigned*)(sb + 4 * lane); w1 = *(LAS unsigned*)(sb + 256 + 4 * lane);
            asm volatile("s_waitcnt lgkmcnt(0)" ::: "memory");
        }
        dst[0] = w0; dst[2 * 524288] = w1;
        if (lane == 0) ((float*)(ws + WS_SU))[2 * e + tb_] = sc;
    }
}

typedef short bf16x8 __attribute__((ext_vector_type(8)));
typedef short v4i16 __attribute__((ext_vector_type(4)));
#define MFMA16(a, b, c) __builtin_amdgcn_mfma_f32_16x16x32_bf16((a), (b), (c), 0, 0, 0)
typedef float f32x16 __attribute__((ext_vector_type(16)));
#define MFMA32(a, b, c) __builtin_amdgcn_mfma_f32_32x32x16_bf16((a), (b), (c), 0, 0, 0)
#define ATT32_LOAD(SET, PPX, T0, SHX) do { const int n_ = -128 + 32 * (PPX); \
    _Pragma("unroll") for (int c = 0; c < 4; ++c) { int tok = (T0) + ((n_ + 8 * c + lrow) << (SHX)); tok = min(max(tok, 0), SEQ - 1); const unsigned off_ = (unsigned)tok * 3072u + 1024u + (unsigned)lch * 16u; \
        kr[SET][c] = *(const v4u*)((const unsigned char*)base + off_); vr[SET][c] = *(const v4u*)((const unsigned char*)base + off_ + 1024u); } } while (0)
__device__ __forceinline__ int attn32_qoff(int stage, int u) { return stage == 0 ? 32 * u : (stage == 1 ? (u & 3) + 128 * (u >> 2) : u); }
template <int STAGE, int OFF> __device__ __forceinline__ void attn32_unit(const bf16* base, bf16* yrow0, int blk0, int u, LAS unsigned char* xtab, LAS unsigned char* kbuf, LAS unsigned char* vbuf, int lane,
                                                                         v4u (&kr)[2][4], v4u (&vr)[2][4], bf16x8 (&qb)[4], const bf16* nbase, int nt0, int nsh) {
    constexpr int SH = STAGE == 0 ? 0 : (STAGE == 1 ? 2 : 4), D = 1 << SH;
    const int qoff = attn32_qoff(STAGE, u);
    const int t0 = blk0 + qoff;
    const int qi = lane & 31, h = lane >> 5, lrow = lane >> 3, lch = lane & 7;
    const int G = lane >> 4, trq = (lane >> 2) & 3, trp = lane & 3;
    const int tr_off = (4 * (G >> 1) + trq) * 160 + (16 * (G & 1) + 4 * trp) * 2;
    const int tq = t0 + D * qi;
    LAS unsigned char* xrow = xtab + (qoff + D * qi) * 144;
    f32x16 o[2]; float m, l;
    if (STAGE == 0) {
#pragma unroll
        for (int i = 0; i < 16; ++i) { o[0][i] = 0.f; o[1][i] = 0.f; }
        m = -1e30f; l = 0.f;
    } else {
#pragma unroll
        for (int mb = 0; mb < 2; ++mb)
#pragma unroll
            for (int gq = 0; gq < 4; ++gq) { const v2u w = *(const LAS v2u*)(xrow + 2 * (32 * mb + 8 * gq + 4 * h)); o[mb][4 * gq] = bf_lo(w.x); o[mb][4 * gq + 1] = bf_hi(w.x); o[mb][4 * gq + 2] = bf_lo(w.y); o[mb][4 * gq + 3] = bf_hi(w.y); }
        m = *(const LAS float*)(xrow + 128); l = h == 0 ? *(const LAS float*)(xrow + 132) : 0.f;
    }
    const int hi = qi, lo = max(qi - 128, -(t0 >> SH));
    const unsigned mspan = (unsigned)(hi - lo);
#pragma unroll
    for (int pp = 0; pp < 5; ++pp) {
        constexpr int dummy = 0; (void)dummy;
        const int set = (pp + OFF) % 2, n0 = -128 + 32 * pp;
#pragma unroll
        for (int c = 0; c < 4; ++c) { *(LAS v4u*)(kbuf + (8 * c + lrow) * 144 + lch * 16) = kr[set][c]; *(LAS v4u*)(vbuf + (8 * c + lrow) * 160 + lch * 16) = vr[set][c]; }
        if (pp + 2 < 5) { ATT32_LOAD(set, pp + 2, t0, SH); }
        else { const bf16* base_ = base; { const bf16* base = nbase; ATT32_LOAD(set, pp + 2 - 5, nt0, nsh); } (void)base_; }
        f32x16 sc;
#pragma unroll
        for (int i = 0; i < 16; ++i) sc[i] = 0.f;
#pragma unroll
        for (int ks = 0; ks < 4; ++ks) { const bf16x8 ka = *(const LAS bf16x8*)(kbuf + qi * 144 + 32 * ks + 16 * h); sc = MFMA32(ka, qb[ks], sc); }
        if (pp == 4) {
#pragma unroll
            for (int ks = 0; ks < 4; ++ks) qb[ks] = *(const bf16x8*)(nbase + (size_t)min(nt0 + (qi << nsh), SEQ - 1) * 1536 + 16 * ks + 8 * h);
        }
        const int mbase = n0 + 4 * h - lo; float mx = -INFINITY;
#pragma unroll
        for (int rg = 0; rg < 16; ++rg) { sc[rg] = ((unsigned)(mbase + (rg & 3) + 8 * (rg >> 2)) <= mspan) ? sc[rg] : -INFINITY; mx = fmaxf(mx, sc[rg]); }
        mx = fmaxf(mx, __shfl_xor(mx, 32));
        if (__any(mx > m)) {
            const float mn = fmaxf(m, mx), alpha = __builtin_amdgcn_exp2f(m - mn); m = mn; l *= alpha;
#pragma unroll
            for (int i = 0; i < 16; ++i) { o[0][i] *= alpha; o[1][i] *= alpha; }
        }
        float ps = 0.f;
#pragma unroll
        for (int rg = 0; rg < 16; ++rg) { sc[rg] = __builtin_amdgcn_exp2f(sc[rg] - m); ps += sc[rg]; }
        l += ps;
        bf16x8 pb[2];
#pragma unroll
        for (int s2 = 0; s2 < 2; ++s2) { v4u w; w.x = pg8::cvt_pk_bf16(sc[8 * s2], sc[8 * s2 + 1]); w.y = pg8::cvt_pk_bf16(sc[8 * s2 + 2], sc[8 * s2 + 3]); w.z = pg8::cvt_pk_bf16(sc[8 * s2 + 4], sc[8 * s2 + 5]); w.w = pg8::cvt_pk_bf16(sc[8 * s2 + 6], sc[8 * s2 + 7]); pb[s2] = __builtin_bit_cast(bf16x8, w); }
#pragma unroll
        for (int mb = 0; mb < 2; ++mb)
#pragma unroll
            for (int s2 = 0; s2 < 2; ++s2) {
                LAS unsigned char* vp = vbuf + tr_off + (16 * s2) * 160 + 64 * mb;
                const v4i16 a0 = __builtin_amdgcn_ds_read_tr16_b64_v4i16((LAS v4i16*)vp), a1 = __builtin_amdgcn_ds_read_tr16_b64_v4i16((LAS v4i16*)(vp + 8 * 160));
                const bf16x8 va = __builtin_shufflevector(a0, a1, 0, 1, 2, 3, 4, 5, 6, 7);
                o[mb] = MFMA32(va, pb[s2], o[mb]);
            }
        asm volatile("" ::: "memory");
    }
    l += __shfl_xor(l, 32);
    if (STAGE < 2) {
#pragma unroll
        for (int mb = 0; mb < 2; ++mb)
#pragma unroll
            for (int gq = 0; gq < 4; ++gq) { v2u w; w.x = pk2(o[mb][4 * gq], o[mb][4 * gq + 1]); w.y = pk2(o[mb][4 * gq + 2], o[mb][4 * gq + 3]); *(LAS v2u*)(xrow + 2 * (32 * mb + 8 * gq + 4 * h)) = w; }
        if (h == 0) { *(LAS float*)(xrow + 128) = m; *(LAS float*)(xrow + 132) = l; }
    } else {
        const float inv = __builtin_amdgcn_rcpf(l);
        bf16* yo = yrow0 + (size_t)tq * 1024 + 4 * h;
#pragma unroll
        for (int mb = 0; mb < 2; ++mb)
#pragma unroll
            for (int gq = 0; gq < 4; ++gq) { uint2 w; w.x = pk2(o[mb][4 * gq] * inv, o[mb][4 * gq + 1] * inv); w.y = pk2(o[mb][4 * gq + 2] * inv, o[mb][4 * gq + 3] * inv); *(uint2*)(yo + 32 * mb + 8 * gq) = w; }
    }
}
__device__ __forceinline__ int attn_item(int idx, int G) { return G == 256 ? ((2 * (idx & 7) + (idx >> 8)) * 32 + ((idx & 255) >> 3)) : idx; }
__device__ __forceinline__ void p2_attention(const Params& P, LAS unsigned char* lds, int lane, int wave, int vb) {
    const bf16* QKVA = (const bf16*)(P.ws + WS_QKVA); bf16* YA = (bf16*)(P.ws + WS_YA);
    LAS unsigned char* kbuf = lds + wave * 9728;
    LAS unsigned char* vbuf = kbuf + 4608;
    LAS unsigned char* xtab = lds + 8 * 9728;
    const int qi = lane & 31, h = lane >> 5, lrow = lane >> 3, lch = lane & 7;
    v4u kr[2][4], vr[2][4]; bf16x8 qb[4];
    const int u0 = wave * 2, u1 = wave * 2 + 1;
    if (vb < 512) {
        const int it0 = attn_item(vb, (int)gridDim.x); const int bh = it0 >> 5, tb = it0 & 31, b = bh >> 3, hh = bh & 7; const bf16* base = QKVA + (size_t)b * SEQ * 1536 + hh * 64; const int t0 = tb * 512 + attn32_qoff(0, u0);
        ATT32_LOAD(0, 0, t0, 0); ATT32_LOAD(1, 1, t0, 0);
#pragma unroll
        for (int ks = 0; ks < 4; ++ks) qb[ks] = *(const bf16x8*)(base + (size_t)(t0 + qi) * 1536 + 16 * ks + 8 * h);
    }
    for (int wj = vb; wj < 512; wj += gridDim.x) {
        const int wi = attn_item(wj, (int)gridDim.x);
        const int bh = wi >> 5, tb = wi & 31, b = bh >> 3, hh = bh & 7, blk0 = tb * 512;
        const bf16* base = QKVA + (size_t)b * SEQ * 1536 + hh * 64;
        bf16* yrow0 = YA + (size_t)b * SEQ * 1024 + hh * 64;
        const int wn = wj + (int)gridDim.x < 512 ? attn_item(wj + (int)gridDim.x, (int)gridDim.x) : wi; const int bhn = wn >> 5, tbn = wn & 31;
        const bf16* nb = QKVA + (size_t)(bhn >> 3) * SEQ * 1536 + (bhn & 7) * 64;
        attn32_unit<0, 0>(base, yrow0, blk0, u0, xtab, kbuf, vbuf, lane, kr, vr, qb, base, blk0 + attn32_qoff(0, u1), 0);
        attn32_unit<0, 1>(base, yrow0, blk0, u1, xtab, kbuf, vbuf, lane, kr, vr, qb, base, blk0 + attn32_qoff(1, u0), 2);
        __syncthreads();
        attn32_unit<1, 0>(base, yrow0, blk0, u0, xtab, kbuf, vbuf, lane, kr, vr, qb, base, blk0 + attn32_qoff(1, u1), 2);
        attn32_unit<1, 1>(base, yrow0, blk0, u1, xtab, kbuf, vbuf, lane, kr, vr, qb, base, blk0 + attn32_qoff(2, u0), 4);
        __syncthreads();
        attn32_unit<2, 0>(base, yrow0, blk0, u0, xtab, kbuf, vbuf, lane, kr, vr, qb, base, blk0 + attn32_qoff(2, u1), 4);
        attn32_unit<2, 1>(base, yrow0, blk0, u1, xtab, kbuf, vbuf, lane, kr, vr, qb, nb, tbn * 512 + attn32_qoff(0, u0), 0);
        __syncthreads();
    }
}

__device__ __forceinline__ float scan_add(float v, int lane) {
#pragma unroll
    for (int o = 1; o < 64; o <<= 1) { const float u = __shfl_up(v, o); if (lane >= o) v += u; }
    return v;
}
__device__ __forceinline__ float scan_max(float v, int lane) {
#pragma unroll
    for (int o = 1; o < 64; o <<= 1) { const float u = __shfl_up(v, o); if (lane >= o) v = fmaxf(v, u); }
    return v;
}
__device__ __forceinline__ void conv16(const bf16* QKM, const float* cw, int b, int t0, int chan, float* out) {
    const bf16* src = QKM + (size_t)b * SEQ * 1024 + chan;
    const float w0 = cw[chan], w1 = cw[1024 + chan], w2 = cw[2048 + chan], w3 = cw[3072 + chan];
    float x0 = t0 >= 3 ? bf2f(src[(size_t)(t0 - 3) * 1024]) : 0.f, x1 = t0 >= 2 ? bf2f(src[(size_t)(t0 - 2) * 1024]) : 0.f, x2 = t0 >= 1 ? bf2f(src[(size_t)(t0 - 1) * 1024]) : 0.f;
#pragma unroll
    for (int i = 0; i < 16; ++i) { const float x3 = bf2f(src[(size_t)(t0 + i) * 1024]); out[i] = silu(w0 * x0 + w1 * x1 + w2 * x2 + w3 * x3); x0 = x1; x1 = x2; x2 = x3; }
}

struct P2Raw { v4u raw[5]; float lfi, ipi; };
__device__ __forceinline__ void p2_load_raw(P2Raw& R, const bf16* QKM, const bf16* VM, const float* IFb, const float* cw, int item, int tid, int lane, int wave) {
    const int bh = item >> 8, c = item & 255, b = bh >> 2, h = bh & 3, ch = tid & 127, chan = 512 + h * 128 + ch;
#pragma unroll
    for (int i = 0; i < 5; ++i) { const int v = tid + 512 * i, rr = v >> 5, pc = v & 31, t = c * 64 + rr - 3;
        v4u val = {0u, 0u, 0u, 0u};
        if (v < 2144 && t >= 0) val = pc < 16 ? *(const v4u*)(QKM + ((size_t)b * SEQ + t) * 1024 + 512 + h * 128 + 8 * pc) : *(const v4u*)(VM + ((size_t)b * SEQ + t) * 512 + h * 128 + 8 * (pc - 16));
        R.raw[i] = val; }
    if (wave == 0) { const size_t row = (size_t)b * SEQ + c * 64 + lane; R.lfi = IFb[row * 8 + 4 + h]; R.ipi = IFb[row * 8 + h]; }
}
__device__ __forceinline__ void p2_mlstm_local(const Params& P, LAS unsigned char* lds, int tid, int lane, int wave, int vb) {
    const bf16* QKM = (const bf16*)(P.ws + WS_QKM); const bf16* VM = (const bf16*)(P.ws + WS_VM); const float* IFb = (const float*)(P.ws + WS_IF);
    const float* cw = P.in[4];
    bf16* DC = (bf16*)((unsigned char*)P.out + OUT_DC); float* DN = (float*)(P.ws + WS_DN); float* SC = (float*)(P.ws + WS_SC);
    LAS bf16* KWT = (LAS bf16*)lds; LAS bf16* VT = (LAS bf16*)(lds + 18432); LAS float* sw = (LAS float*)(lds + 36864);
    LAS unsigned char* RAW = lds + 40960;
    LAS float* CWl = (LAS float*)(lds + 75776);
    for (int i = tid; i < 1024; i += 512) ((LAS f32x4*)CWl)[i] = ((const f32x4*)cw)[i];
    __syncthreads();
    const int r = lane & 15, g = lane >> 4;
    P2Raw pre; pre.lfi = 0.f; pre.ipi = 0.f;
    if (vb < 2048) p2_load_raw(pre, QKM, VM, IFb, cw, vb, tid, lane, wave);
    for (int item = vb; item < 2048; item += gridDim.x) {
        const P2Raw cur = pre;
#pragma unroll
        for (int i = 0; i < 5; ++i) { const int v = tid + 512 * i; if (v < 2144) *(LAS v4u*)(RAW + (v >> 5) * 512 + (v & 31) * 16) = cur.raw[i]; }
        if (wave == 0) {
            const float lf = logsigmoid(cur.lfi), ip = cur.ipi;
            const float bc = scan_add(lf, lane), gg = __shfl(bc, 63), ds = gg - bc + ip, ml = wave_max(ds);
            sw[lane] = __expf(ds - ml);
            if (lane == 0) { SC[item] = ml; SC[2048 + item] = gg; }
        }
        __syncthreads();
        if (item + (int)gridDim.x < 2048) p2_load_raw(pre, QKM, VM, IFb, cw, item + gridDim.x, tid, lane, wave);
        { const int ch = tid & 127, sq = tid >> 7, s0 = sq * 16; float o[16];
          const int chan = 512 + ((item >> 8) & 3) * 128 + ch; const float w0 = CWl[chan], w1 = CWl[1024 + chan], w2 = CWl[2048 + chan], w3 = CWl[3072 + chan];
          unsigned short qk[19], vv[16];
#pragma unroll
          for (int i = 0; i < 19; ++i) qk[i] = *(const LAS unsigned short*)(RAW + (s0 + i) * 512 + ch * 2);
#pragma unroll
          for (int i = 0; i < 16; ++i) vv[i] = *(const LAS unsigned short*)(RAW + (s0 + 3 + i) * 512 + 256 + ch * 2);
          { float x0 = bf2f(qk[0]), x1 = bf2f(qk[1]), x2 = bf2f(qk[2]);
#pragma unroll
            for (int i = 0; i < 16; ++i) { const float x3 = bf2f(qk[3 + i]); o[i] = silu(w0 * x0 + w1 * x1 + w2 * x2 + w3 * x3); x0 = x1; x1 = x2; x2 = x3; } }
#pragma unroll
          for (int i = 0; i < 16; i += 2) *(LAS unsigned*)(KWT + ch * 72 + s0 + i) = pk2(o[i] * 0.08838834764831845f * sw[s0 + i], o[i + 1] * 0.08838834764831845f * sw[s0 + i + 1]);
#pragma unroll
          for (int i = 0; i < 16; i += 2) *(LAS unsigned*)(VT + ch * 72 + s0 + i) = (unsigned)vv[i] | ((unsigned)vv[i + 1] << 16);
        }
        __syncthreads();
        {
          const bf16x8 vb0 = *(const LAS bf16x8*)(VT + (16 * wave + r) * 72 + 8 * g), vb1 = *(const LAS bf16x8*)(VT + (16 * wave + r) * 72 + 32 + 8 * g);
          bf16* dst = DC + (size_t)item * 16384 + (size_t)(16 * wave + r) * 128 + 4 * g;
#pragma unroll
          for (int eb = 0; eb < 8; ++eb) {
              const bf16x8 ka0 = *(const LAS bf16x8*)(KWT + (16 * eb + r) * 72 + 8 * g), ka1 = *(const LAS bf16x8*)(KWT + (16 * eb + r) * 72 + 32 + 8 * g);
              f32x4 acc = {0.f, 0.f, 0.f, 0.f};
              acc = MFMA16(ka0, vb0, acc); acc = MFMA16(ka1, vb1, acc);
              uint2 o; o.x = pk2(acc[0], acc[1]); o.y = pk2(acc[2], acc[3]); *(uint2*)(dst + 16 * eb) = o;
          }
        }
        if (tid < 128) { float a = 0.f;
#pragma unroll
            for (int cc = 0; cc < 8; ++cc) { float f[8]; unpk8(*(const LAS v4u*)(KWT + tid * 72 + 8 * cc), f);
#pragma unroll
                for (int k = 0; k < 8; ++k) a += f[k]; }
            DN[(size_t)item * 128 + tid] = a; }
        __syncthreads();
    }
}

__device__ __forceinline__ void p3_mlstm_scan(const Params& P, int tid, int vb) {
    const unsigned* __restrict__ DC = (const unsigned*)((unsigned char*)P.out + OUT_DC); unsigned* __restrict__ CS = (unsigned*)((unsigned char*)P.out + OUT_CS);
    const float* __restrict__ DN = (const float*)(P.ws + WS_DN); float* __restrict__ NS = (float*)(P.ws + WS_NS); float* SC = (float*)(P.ws + WS_SC);
    for (int gid = vb * 512 + tid; gid < 8 * 8192; gid += gridDim.x * 512) {
        const int bh = gid >> 13, idx = gid & 8191; const bool hasn = idx < 64;
        float C0 = 0.f, C1 = 0.f, n0 = 0.f, n1 = 0.f, m = 0.f;
        for (int j0 = 0; j0 < 256; j0 += 16) {
            unsigned d[16]; float ml[16], gg[16]; float2 dn[16];
#pragma unroll
            for (int u = 0; u < 16; ++u) { const int item = bh * 256 + j0 + u; d[u] = DC[(size_t)item * 8192 + idx]; ml[u] = SC[item]; gg[u] = SC[2048 + item];
                dn[u] = hasn ? *(const float2*)(DN + (size_t)item * 128 + 2 * idx) : make_float2(0.f, 0.f); }
#pragma unroll
            for (int u = 0; u < 16; ++u) { const int item = bh * 256 + j0 + u;
                CS[(size_t)item * 8192 + idx] = pk2(C0, C1);
                if (hasn) *(float2*)(NS + (size_t)item * 128 + 2 * idx) = make_float2(n0, n1);
                if (idx == 0) SC[4096 + item] = m;
                const float mn = fmaxf(gg[u] + m, ml[u]), a = __expf(gg[u] + m - mn), bb = __expf(ml[u] - mn);
                C0 = a * C0 + bb * bf_lo(d[u]); C1 = a * C1 + bb * bf_hi(d[u]); n0 = a * n0 + bb * dn[u].x; n1 = a * n1 + bb * dn[u].y; m = mn; }
        }
    }
}

struct P4Pref { v4u raw[7]; v4u cs[4]; uint2 om[4]; f32x4 gn; float ifa, ifb, nsv; };
__device__ __forceinline__ void p4_prefetch_raw(P4Pref& pf, const Params& P, int item, int tid, int lane) {
    const bf16* QKM = (const bf16*)(P.ws + WS_QKM); const bf16* VM = (const bf16*)(P.ws + WS_VM); const float* IFb = (const float*)(P.ws + WS_IF); const float* NS = (const float*)(P.ws + WS_NS);
    const int bh = item >> 8, c = item & 255, b = bh >> 2, h = bh & 3;
#pragma unroll
    for (int i = 0; i < 7; ++i) { const int v = tid + 512 * i; const int rr = v / 48, rem = v - rr * 48, seg = rem >> 4, c16 = rem & 15; const int t = c * 64 + rr - 3;
        v4u val = {0u, 0u, 0u, 0u};
        if (v < 3216 && t >= 0) val = (seg < 2) ? *(const v4u*)(QKM + ((size_t)b * SEQ + t) * 1024 + seg * 512 + h * 128 + 8 * c16) : *(const v4u*)(VM + ((size_t)b * SEQ + t) * 512 + h * 128 + 8 * c16);
        pf.raw[i] = val; }
    const size_t row = (size_t)b * SEQ + c * 64 + lane;
    pf.ifa = IFb[row * 8 + 4 + h]; pf.ifb = IFb[row * 8 + h];
    pf.nsv = NS[(size_t)item * 128 + (tid & 127)];
}
__device__ __forceinline__ void p4_prefetch_cs(P4Pref& pf, const Params& P, int item, int lane, int wave) {
    const bf16* CS = (const bf16*)((unsigned char*)P.out + OUT_CS);
    const bf16* crow = CS + (size_t)item * 16384 + (size_t)(16 * wave + (lane & 15)) * 128 + 8 * (lane >> 4);
#pragma unroll
    for (int ks = 0; ks < 4; ++ks) pf.cs[ks] = *(const v4u*)(crow + 32 * ks);
}
__device__ __forceinline__ void p4_prefetch_om(P4Pref& pf, const Params& P, int item, int lane, int wave) {
    const bf16* OM = (const bf16*)(P.ws + WS_OM);
    const int bh = item >> 8, c = item & 255, b = bh >> 2, h = bh & 3, r = lane & 15, g = lane >> 4;
#pragma unroll
    for (int tb = 0; tb < 4; ++tb) pf.om[tb] = *(const uint2*)(OM + ((size_t)b * SEQ + c * 64 + 16 * tb + r) * 512 + h * 128 + 16 * wave + 4 * g);
    pf.gn = *(const f32x4*)(P.in[6] + h * 128 + 16 * wave + 4 * g);
}
__device__ __forceinline__ void p4_mlstm_out(const Params& P, LAS unsigned char* lds, int tid, int lane, int wave, int vb) {
    const float* cw = P.in[4]; const float* SC = (const float*)(P.ws + WS_SC); bf16* YM = (bf16*)(P.ws + WS_YA);
    LAS float* CW = (LAS float*)lds;
    LAS unsigned char* RAW = lds + 16384;
    LAS bf16* Qs = (LAS bf16*)(lds + 68912); LAS bf16* Ks = (LAS bf16*)(lds + 86320); LAS bf16* VT = (LAS bf16*)(lds + 103728); LAS bf16* PT = (LAS bf16*)(lds + 122160);
    LAS float* sm = (LAS float*)(lds + 131376);
    LAS bf16* NSB = (LAS bf16*)(lds + 135728);
    const int r = lane & 15, g = lane >> 4;
    for (int i = tid; i < 1024; i += 512) ((LAS f32x4*)CW)[i] = ((const f32x4*)cw)[i];
    P4Pref pf;
    if (vb < 2048) { p4_prefetch_raw(pf, P, vb, tid, lane); p4_prefetch_cs(pf, P, vb, lane, wave); p4_prefetch_om(pf, P, vb, lane, wave); }
    for (int item = vb; item < 2048; item += gridDim.x) {
        const int bh = item >> 8, c = item & 255, b = bh >> 2, h = bh & 3;
#pragma unroll
        for (int i = 0; i < 7; ++i) { const int v = tid + 512 * i; if (v < 3216) { const int rr = v / 48, rem = v - rr * 48; *(LAS v4u*)(RAW + rr * 784 + rem * 16) = pf.raw[i]; } }
        if (tid < 128) NSB[tid] = (bf16)f2bf(pf.nsv);
        if (wave == 0) {
            const float lf = logsigmoid(pf.ifa), ip = pf.ifb;
            const float bc = scan_add(lf, lane), a = ip - bc, pm = scan_max(a, lane), ms = SC[4096 + item], M = fmaxf(ms, pm);
            sm[lane] = a; sm[64 + lane] = M; sm[128 + lane] = __expf(ms - M); sm[192 + lane] = __expf(-bc - M);
        }
        __syncthreads();
        { const int g4 = tid & 31, s0 = (tid >> 5) * 4;
#pragma unroll
          for (int tile = 0; tile < 2; ++tile) {
              float x[7][4];
#pragma unroll
              for (int j = 0; j < 7; ++j) { const v2u rv = *(const LAS v2u*)(RAW + (s0 + j) * 784 + tile * 256 + g4 * 8); x[j][0] = bf_lo(rv.x); x[j][1] = bf_hi(rv.x); x[j][2] = bf_lo(rv.y); x[j][3] = bf_hi(rv.y); }
              f32x4 w[4];
#pragma unroll
              for (int tp = 0; tp < 4; ++tp) w[tp] = *(const LAS f32x4*)(CW + tp * 1024 + tile * 512 + h * 128 + 4 * g4);
              const float sc = tile ? 0.08838834764831845f : 1.0f; LAS bf16* dst = tile ? Ks : Qs;
#pragma unroll
              for (int j = 0; j < 4; ++j) { float y[4];
#pragma unroll
                  for (int i = 0; i < 4; ++i) y[i] = silu(w[0][i] * x[j][i] + w[1][i] * x[j + 1][i] + w[2][i] * x[j + 2][i] + w[3][i] * x[j + 3][i]) * sc;
                  v2u o; o.x = pk2(y[0], y[1]); o.y = pk2(y[2], y[3]); *(LAS v2u*)(dst + (s0 + j) * 136 + 4 * g4) = o; }
          }
          const int ch = tid & 127, sv = (tid >> 7) * 16;
#pragma unroll
          for (int i = 0; i < 16; i += 2) { const unsigned lo = *(const LAS bf16*)(RAW + (3 + sv + i) * 784 + 512 + ch * 2), hi = *(const LAS bf16*)(RAW + (4 + sv + i) * 784 + 512 + ch * 2);
              *(LAS unsigned*)(VT + ch * 72 + sv + i) = lo | (hi << 16); }
        }
        asm volatile("" ::: "memory");
        if (item + (int)gridDim.x < 2048) p4_prefetch_raw(pf, P, item + gridDim.x, tid, lane);
        __syncthreads();
        { const int sb = wave >> 1;
          bf16x8 ka[4];
#pragma unroll
          for (int ks = 0; ks < 4; ++ks) ka[ks] = *(const LAS bf16x8*)(Ks + (16 * sb + r) * 136 + 32 * ks + 8 * g);
#pragma unroll
          for (int tt = 0; tt < 2; ++tt) { const int tb = 2 * (wave & 1) + tt, t = 16 * tb + r;
              f32x4 acc = {0.f, 0.f, 0.f, 0.f};
#pragma unroll
              for (int ks = 0; ks < 4; ++ks) { const bf16x8 qb = *(const LAS bf16x8*)(Qs + t * 136 + 32 * ks + 8 * g); acc = MFMA16(ka[ks], qb, acc); }
              const float Mt = sm[64 + t]; float p[4], ps = 0.f;
#pragma unroll
              for (int k = 0; k < 4; ++k) { const int s = 16 * sb + 4 * g + k; p[k] = (s <= t) ? acc[k] * __expf(sm[s] - Mt) : 0.f; ps += p[k]; }
              v2u o; o.x = pk2(p[0], p[1]); o.y = pk2(p[2], p[3]); *(LAS v2u*)(PT + t * 72 + 16 * sb + 4 * g) = o;
              ps += __shfl_xor(ps, 16); ps += __shfl_xor(ps, 32);
              if (g == 0) sm[320 + sb * 64 + t] = ps; }
        }
        __syncthreads();
        f32x4 ai[4], ac[4], an[4];
#pragma unroll
        for (int tb = 0; tb < 4; ++tb) { ai[tb] = (f32x4){0.f, 0.f, 0.f, 0.f}; ac[tb] = (f32x4){0.f, 0.f, 0.f, 0.f}; an[tb] = (f32x4){0.f, 0.f, 0.f, 0.f}; }
        { const bf16x8 va0 = *(const LAS bf16x8*)(VT + (16 * wave + r) * 72 + 8 * g), va1 = *(const LAS bf16x8*)(VT + (16 * wave + r) * 72 + 32 + 8 * g);
          const bf16x8 ca0 = __builtin_bit_cast(bf16x8, pf.cs[0]), ca1 = __builtin_bit_cast(bf16x8, pf.cs[1]), ca2 = __builtin_bit_cast(bf16x8, pf.cs[2]), ca3 = __builtin_bit_cast(bf16x8, pf.cs[3]);
          const bf16x8 zero8 = {0, 0, 0, 0, 0, 0, 0, 0};
#pragma unroll
          for (int tb = 0; tb < 4; ++tb) { const int t = 16 * tb + r;
              const bf16x8 pb0 = *(const LAS bf16x8*)(PT + t * 72 + 8 * g), pb1 = *(const LAS bf16x8*)(PT + t * 72 + 32 + 8 * g);
              ai[tb] = MFMA16(va0, pb0, ai[tb]); ai[tb] = MFMA16(va1, pb1, ai[tb]);
              const bf16x8 q0 = *(const LAS bf16x8*)(Qs + t * 136 + 8 * g), q1 = *(const LAS bf16x8*)(Qs + t * 136 + 32 + 8 * g), q2 = *(const LAS bf16x8*)(Qs + t * 136 + 64 + 8 * g), q3 = *(const LAS bf16x8*)(Qs + t * 136 + 96 + 8 * g);
              ac[tb] = MFMA16(ca0, q0, ac[tb]); ac[tb] = MFMA16(ca1, q1, ac[tb]); ac[tb] = MFMA16(ca2, q2, ac[tb]); ac[tb] = MFMA16(ca3, q3, ac[tb]);
              if (wave == 0) {
                  const bf16x8 n0 = r == 0 ? *(const LAS bf16x8*)(NSB + 8 * g) : zero8, n1 = r == 0 ? *(const LAS bf16x8*)(NSB + 32 + 8 * g) : zero8, n2 = r == 0 ? *(const LAS bf16x8*)(NSB + 64 + 8 * g) : zero8, n3 = r == 0 ? *(const LAS bf16x8*)(NSB + 96 + 8 * g) : zero8;
                  an[tb] = MFMA16(n0, q0, an[tb]); an[tb] = MFMA16(n1, q1, an[tb]); an[tb] = MFMA16(n2, q2, an[tb]); an[tb] = MFMA16(n3, q3, an[tb]);
                  if (g == 0) { const float den = sm[128 + t] * an[tb][0] + (sm[320 + t] + sm[384 + t]) + (sm[448 + t] + sm[512 + t]); sm[256 + t] = fmaxf(fabsf(den), sm[192 + t]); } } }
        }
        asm volatile("" ::: "memory");
        if (item + (int)gridDim.x < 2048) p4_prefetch_cs(pf, P, item + gridDim.x, lane, wave);
#pragma unroll
        for (int tb = 0; tb < 4; ++tb) { const int t = 16 * tb + r; const float wi = sm[128 + t]; float s2 = 0.f;
#pragma unroll
            for (int k = 0; k < 4; ++k) { ai[tb][k] = wi * ac[tb][k] + ai[tb][k]; s2 += ai[tb][k] * ai[tb][k]; }
            s2 += __shfl_xor(s2, 16); s2 += __shfl_xor(s2, 32);
            if (g == 0) sm[576 + wave * 64 + t] = s2; }
        __syncthreads();
        {
#pragma unroll
          for (int tb = 0; tb < 4; ++tb) { const int t = 16 * tb + r; float tot = 0.f;
#pragma unroll
              for (int w = 0; w < 8; ++w) tot += sm[576 + w * 64 + t];
              const float inv = __builtin_amdgcn_rcpf(sm[256 + t]), rs = inv * rsqrtf(tot * inv * inv * (1.f / 128.f) + EPS);
              const size_t row = (size_t)b * SEQ + c * 64 + t; const int col = h * 128 + 16 * wave + 4 * g;
              uint2 o; o.x = pk2(ai[tb][0] * rs * pf.gn[0] * bf_lo(pf.om[tb].x), ai[tb][1] * rs * pf.gn[1] * bf_hi(pf.om[tb].x)); o.y = pk2(ai[tb][2] * rs * pf.gn[2] * bf_lo(pf.om[tb].y), ai[tb][3] * rs * pf.gn[3] * bf_hi(pf.om[tb].y));
              *(uint2*)(YM + row * 1024 + 512 + col) = o; }
        }
        asm volatile("" ::: "memory");
        if (item + (int)gridDim.x < 2048) p4_prefetch_om(pf, P, item + gridDim.x, lane, wave);
        __syncthreads();
    }
}

__device__ __forceinline__ int f2ord(float f) { const int b = __float_as_int(f); return b ^ ((b >> 31) & 0x7fffffff); }
__device__ __forceinline__ float ord2f(int o) { return __int_as_float(o ^ ((o >> 31) & 0x7fffffff)); }
#define CE_DESC(a, i, j) { const int _h = max(a[i], a[j]), _l = min(a[i], a[j]); a[i] = _h; a[j] = _l; }
__device__ __forceinline__ void sort16_desc(int (&a)[16]) {
    CE_DESC(a, 0, 13) CE_DESC(a, 1, 12) CE_DESC(a, 2, 15) CE_DESC(a, 3, 14) CE_DESC(a, 4, 8) CE_DESC(a, 5, 6) CE_DESC(a, 7, 11) CE_DESC(a, 9, 10)
    CE_DESC(a, 0, 5) CE_DESC(a, 1, 7) CE_DESC(a, 2, 9) CE_DESC(a, 3, 4) CE_DESC(a, 6, 13) CE_DESC(a, 8, 14) CE_DESC(a, 10, 15) CE_DESC(a, 11, 12)
    CE_DESC(a, 0, 1) CE_DESC(a, 2, 3) CE_DESC(a, 4, 5) CE_DESC(a, 6, 8) CE_DESC(a, 7, 9) CE_DESC(a, 10, 11) CE_DESC(a, 12, 13) CE_DESC(a, 14, 15)
    CE_DESC(a, 0, 2) CE_DESC(a, 1, 3) CE_DESC(a, 4, 10) CE_DESC(a, 5, 11) CE_DESC(a, 6, 7) CE_DESC(a, 8, 9) CE_DESC(a, 12, 14) CE_DESC(a, 13, 15)
    CE_DESC(a, 1, 2) CE_DESC(a, 3, 12) CE_DESC(a, 4, 6) CE_DESC(a, 5, 7) CE_DESC(a, 8, 10) CE_DESC(a, 9, 11) CE_DESC(a, 13, 14)
    CE_DESC(a, 1, 4) CE_DESC(a, 2, 6) CE_DESC(a, 5, 8) CE_DESC(a, 7, 10) CE_DESC(a, 9, 13) CE_DESC(a, 11, 14)
    CE_DESC(a, 2, 4) CE_DESC(a, 3, 6) CE_DESC(a, 9, 12) CE_DESC(a, 11, 13)
    CE_DESC(a, 3, 5) CE_DESC(a, 6, 8) CE_DESC(a, 7, 9) CE_DESC(a, 10, 12)
    CE_DESC(a, 3, 4) CE_DESC(a, 5, 6) CE_DESC(a, 7, 8) CE_DESC(a, 9, 10) CE_DESC(a, 11, 12)
    CE_DESC(a, 6, 7) CE_DESC(a, 8, 9)
}
__device__ __forceinline__ void merge16_desc(int (&a)[16], const int (&b)[16]) {
#pragma unroll
    for (int i = 0; i < 16; ++i) a[i] = max(a[i], b[15 - i]);
#pragma unroll
    for (int j = 8; j > 0; j >>= 1) {
#pragma unroll
        for (int i = 0; i < 16; ++i) { const int l = i ^ j; if (l > i) CE_DESC(a, i, l) }
    }
}
__device__ __forceinline__ void xmerge16(int (&a)[16], int mask) {
    int b[16];
#pragma unroll
    for (int i = 0; i < 16; ++i) b[i] = __shfl_xor(a[i], mask);
    merge16_desc(a, b);
}
__device__ __forceinline__ void p10_quant_store(unsigned char* XQ, int t, int lane, const v4u ra, const v4u rb) {
    float y[16]; unpk8(ra, y); unpk8(rb, y + 8);
    unsigned hi[4], lo[4];
#pragma unroll
    for (int q = 0; q < 4; ++q) {
        int h = __builtin_amdgcn_cvt_pk_fp8_f32(y[4 * q], y[4 * q + 1], 0, false); h = __builtin_amdgcn_cvt_pk_fp8_f32(y[4 * q + 2], y[4 * q + 3], h, true);
        const float r0 = (y[4 * q] - __builtin_amdgcn_cvt_f32_fp8(h, 0)) * 16.f, r1 = (y[4 * q + 1] - __builtin_amdgcn_cvt_f32_fp8(h, 1)) * 16.f, r2 = (y[4 * q + 2] - __builtin_amdgcn_cvt_f32_fp8(h, 2)) * 16.f, r3 = (y[4 * q + 3] - __builtin_amdgcn_cvt_f32_fp8(h, 3)) * 16.f;
        int l = __builtin_amdgcn_cvt_pk_fp8_f32(r0, r1, 0, false); l = __builtin_amdgcn_cvt_pk_fp8_f32(r2, r3, l, true);
        hi[q] = (unsigned)h; lo[q] = (unsigned)l; }
    v4u vh; vh.x = hi[0]; vh.y = hi[1]; vh.z = hi[2]; vh.w = hi[3]; v4u vl; vl.x = lo[0]; vl.y = lo[1]; vl.z = lo[2]; vl.w = lo[3];
    *(v4u*)(XQ + (size_t)t * 2048 + 16 * lane) = vh; *(v4u*)(XQ + (size_t)t * 2048 + 1024 + 16 * lane) = vl;
}
__device__ __forceinline__ void p10_topk(const Params& P, LAS unsigned char* lds, int tid, int lane, int wave, int vb) {
    const bf16* Q2 = (const bf16*)(P.ws + WS_Q2); const bf16* K1B = (const bf16*)(P.ws + WS_K1B); const bf16* K2B = (const bf16*)(P.ws + WS_K2B);
    unsigned char* REC = P.ws + WS_REC; float* GATE = (float*)(P.ws + WS_GATE); const float* SSQ1 = (const float*)(P.ws + WS_SSQ1);
    LAS bf16* Kl = (LAS bf16*)lds;
    LAS int* Tb = (LAS int*)(lds + 69632 + wave * 2048);
    const int r = lane & 15, g = lane >> 4;
    const int h = vb & 7, wgx = vb >> 3, nwg = gridDim.x >> 3;
    __syncthreads();
    for (int i = tid; i < 4096; i += 512) { const int half = i >> 11, rem = i & 2047, n = rem >> 4, c = rem & 15;
        *(LAS v4u*)(Kl + half * 17408 + n * 136 + c * 8) = *(const v4u*)((half ? K2B : K1B) + (size_t)h * 16384 + n * 128 + c * 8); }
    __syncthreads();
    bf16x8 qn[4];
    { const int tile0 = wgx * NW + wave;
      if (tile0 < NTOK / 16) {
#pragma unroll
          for (int ks = 0; ks < 4; ++ks) qn[ks] = *(const bf16x8*)(Q2 + ((size_t)tile0 * 16 + r) * 2048 + h * 256 + 32 * ks + 8 * g); } }
    const bf16* HNq = (const bf16*)(P.ws + WS_HN); unsigned char* XQq = P.ws + WS_XQ8; int tq = vb * NW + wave; const int tqs = (int)gridDim.x * NW;
    const float* SUVt = (const float*)(P.ws + WS_SU); float* SUR = (float*)(P.ws + WS_SUR); float* SVR = (float*)(P.ws + WS_SVR);
    const f32x4* psrc = (const f32x4*)P.in[1]; uint2* pdst = (uint2*)(P.ws + WS_PB); const size_t pn4 = (size_t)NTOK * 256 / 4; const int pgw = vb * NW + wave, pnw = (int)gridDim.x * NW; int pit = 0;
    float2 puv[4]; size_t poff = 0; bool pvalid = false;
    for (int tile = wgx * NW + wave; tile < NTOK / 16; tile += nwg * NW) {
        v4u qra0 = {0u, 0u, 0u, 0u}, qrb0 = qra0, qra1 = qra0, qrb1 = qra0;
        const size_t pi0 = ((size_t)(2 * pit) * pnw + pgw) * 64 + lane, pi1 = pi0 + (size_t)pnw * 64; f32x4 pv0 = {0.f, 0.f, 0.f, 0.f}, pv1 = pv0;
        if (pi0 < pn4) pv0 = psrc[pi0]; if (pi1 < pn4) pv1 = psrc[pi1];
        if (tq < NTOK) { qra0 = ((const v4u*)(HNq + (size_t)tq * 1024))[2 * lane]; qrb0 = ((const v4u*)(HNq + (size_t)tq * 1024))[2 * lane + 1]; }
        if (tq + tqs < NTOK) { qra1 = ((const v4u*)(HNq + (size_t)(tq + tqs) * 1024))[2 * lane]; qrb1 = ((const v4u*)(HNq + (size_t)(tq + tqs) * 1024))[2 * lane + 1]; }
        const size_t row = (size_t)tile * 16 + r;
        int R[2][16];
#pragma unroll
        for (int half = 0; half < 2; ++half) {
            bf16x8 qb[4];
#pragma unroll
            for (int ks = 0; ks < 4; ++ks) qb[ks] = qn[ks];
            { const int tnx = half == 0 ? tile : tile + nwg * NW;
              if (tnx < NTOK / 16) {
#pragma unroll
                  for (int ks = 0; ks < 4; ++ks) qn[ks] = *(const bf16x8*)(Q2 + ((size_t)tnx * 16 + r) * 2048 + h * 256 + (1 - half) * 128 + 32 * ks + 8 * g); } }
            int X[16], Y[16];
#pragma unroll
            for (int nb = 0; nb < 8; ++nb) {
                f32x4 acc = {0.f, 0.f, 0.f, 0.f};
#pragma unroll
                for (int ks = 0; ks < 4; ++ks) acc = MFMA16(*(const LAS bf16x8*)(Kl + half * 17408 + (16 * nb + r) * 136 + 32 * ks + 8 * g), qb[ks], acc);
#pragma unroll
                for (int k = 0; k < 4; ++k) { const int key = (f2ord(acc[k]) & ~0x7f) | (16 * nb + 4 * g + k); if (nb < 4) X[4 * nb + k] = key; else Y[4 * (nb - 4) + k] = key; }
            }
            sort16_desc(X); sort16_desc(Y); merge16_desc(X, Y);
            xmerge16(X, 16); xmerge16(X, 32);
#pragma unroll
            for (int i = 0; i < 16; ++i) R[half][i] = X[i];
        }
        if (g == 0) {
#pragma unroll
            for (int i = 0; i < 16; ++i) { Tb[r * 32 + i] = R[0][i] & 0x7f; Tb[r * 32 + 16 + i] = R[1][i] & 0x7f; }
        }
        const float f1_0 = ord2f(R[0][0] & ~0x7f); const float f1_1 = ord2f(R[0][1] & ~0x7f); const float f1_2 = ord2f(R[0][2] & ~0x7f); const float f1_3 = ord2f(R[0][3] & ~0x7f); const float f1_4 = ord2f(R[0][4] & ~0x7f); const float f1_5 = ord2f(R[0][5] & ~0x7f); const float f1_6 = ord2f(R[0][6] & ~0x7f); const float f1_7 = ord2f(R[0][7] & ~0x7f); const float f1_8 = ord2f(R[0][8] & ~0x7f); const float f1_9 = ord2f(R[0][9] & ~0x7f); const float f1_10 = ord2f(R[0][10] & ~0x7f); const float f1_11 = ord2f(R[0][11] & ~0x7f); const float f1_12 = ord2f(R[0][12] & ~0x7f); const float f1_13 = ord2f(R[0][13] & ~0x7f); const float f1_14 = ord2f(R[0][14] & ~0x7f); const float f1_15 = ord2f(R[0][15] & ~0x7f);
        const float f2_0 = ord2f(R[1][0] & ~0x7f); const float f2_1 = ord2f(R[1][1] & ~0x7f); const float f2_2 = ord2f(R[1][2] & ~0x7f); const float f2_3 = ord2f(R[1][3] & ~0x7f); const float f2_4 = ord2f(R[1][4] & ~0x7f); const float f2_5 = ord2f(R[1][5] & ~0x7f); const float f2_6 = ord2f(R[1][6] & ~0x7f); const float f2_7 = ord2f(R[1][7] & ~0x7f); const float f2_8 = ord2f(R[1][8] & ~0x7f); const float f2_9 = ord2f(R[1][9] & ~0x7f); const float f2_10 = ord2f(R[1][10] & ~0x7f); const float f2_11 = ord2f(R[1][11] & ~0x7f); const float f2_12 = ord2f(R[1][12] & ~0x7f); const float f2_13 = ord2f(R[1][13] & ~0x7f); const float f2_14 = ord2f(R[1][14] & ~0x7f); const float f2_15 = ord2f(R[1][15] & ~0x7f);
        int C[16];
        { const bool g0 = g == 0, g1 = g == 1, g2 = g == 2;
          { const float fa = g0 ? f1_0 : (g1 ? f1_1 : (g2 ? f1_3 : f1_8)), fb = g0 ? f2_0 : (g1 ? f2_0 : (g2 ? f2_0 : f2_0)); const int ab = g0 ? 0 : (g1 ? 16 : (g2 ? 48 : 128)); int key = (f2ord(fa + fb) & ~0xff) | ab; C[0] = key; }
          { const float fa = g0 ? f1_0 : (g1 ? f1_1 : (g2 ? f1_3 : f1_9)), fb = g0 ? f2_1 : (g1 ? f2_1 : (g2 ? f2_1 : f2_0)); const int ab = g0 ? 1 : (g1 ? 17 : (g2 ? 49 : 144)); int key = (f2ord(fa + fb) & ~0xff) | ab; C[1] = key; }
          { const float fa = g0 ? f1_0 : (g1 ? f1_1 : (g2 ? f1_3 : f1_10)), fb = g0 ? f2_2 : (g1 ? f2_2 : (g2 ? f2_2 : f2_0)); const int ab = g0 ? 2 : (g1 ? 18 : (g2 ? 50 : 160)); int key = (f2ord(fa + fb) & ~0xff) | ab; C[2] = key; }
          { const float fa = g0 ? f1_0 : (g1 ? f1_1 : (g2 ? f1_3 : f1_11)), fb = g0 ? f2_3 : (g1 ? f2_3 : (g2 ? f2_3 : f2_0)); const int ab = g0 ? 3 : (g1 ? 19 : (g2 ? 51 : 176)); int key = (f2ord(fa + fb) & ~0xff) | ab; C[3] = key; }
          { const float fa = g0 ? f1_0 : (g1 ? f1_1 : (g2 ? f1_4 : f1_12)), fb = g0 ? f2_4 : (g1 ? f2_4 : (g2 ? f2_0 : f2_0)); const int ab = g0 ? 4 : (g1 ? 20 : (g2 ? 64 : 192)); int key = (f2ord(fa + fb) & ~0xff) | ab; C[4] = key; }
          { const float fa = g0 ? f1_0 : (g1 ? f1_1 : (g2 ? f1_4 : f1_13)), fb = g0 ? f2_5 : (g1 ? f2_5 : (g2 ? f2_1 : f2_0)); const int ab = g0 ? 5 : (g1 ? 21 : (g2 ? 65 : 208)); int key = (f2ord(fa + fb) & ~0xff) | ab; C[5] = key; }
          { const float fa = g0 ? f1_0 : (g1 ? f1_1 : (g2 ? f1_4 : f1_14)), fb = g0 ? f2_6 : (g1 ? f2_6 : (g2 ? f2_2 : f2_0)); const int ab = g0 ? 6 : (g1 ? 22 : (g2 ? 66 : 224)); int key = (f2ord(fa + fb) & ~0xff) | ab; C[6] = key; }
          { const float fa = g0 ? f1_0 : (g1 ? f1_1 : (g2 ? f1_5 : f1_15)), fb = g0 ? f2_7 : (g1 ? f2_7 : (g2 ? f2_0 : f2_0)); const int ab = g0 ? 7 : (g1 ? 23 : (g2 ? 80 : 240)); int key = (f2ord(fa + fb) & ~0xff) | ab; C[7] = key; }
          { const float fa = g0 ? f1_0 : (g1 ? f1_2 : (g2 ? f1_5 : f1_8)), fb = g0 ? f2_8 : (g1 ? f2_0 : (g2 ? f2_1 : f2_0)); const int ab = g0 ? 8 : (g1 ? 32 : (g2 ? 81 : 128)); int key = (f2ord(fa + fb) & ~0xff) | ab; key = (g0 || g1 || g2) ? key : (int)0x80000000; C[8] = key; }
          { const float fa = g0 ? f1_0 : (g1 ? f1_2 : (g2 ? f1_6 : f1_9)), fb = g0 ? f2_9 : (g1 ? f2_1 : (g2 ? f2_0 : f2_0)); const int ab = g0 ? 9 : (g1 ? 33 : (g2 ? 96 : 144)); int key = (f2ord(fa + fb) & ~0xff) | ab; key = (g0 || g1 || g2) ? key : (int)0x80000000; C[9] = key; }
          { const float fa = g0 ? f1_0 : (g1 ? f1_2 : (g2 ? f1_6 : f1_10)), fb = g0 ? f2_10 : (g1 ? f2_2 : (g2 ? f2_1 : f2_0)); const int ab = g0 ? 10 : (g1 ? 34 : (g2 ? 97 : 160)); int key = (f2ord(fa + fb) & ~0xff) | ab; key = (g0 || g1 || g2) ? key : (int)0x80000000; C[10] = key; }
          { const float fa = g0 ? f1_0 : (g1 ? f1_2 : (g2 ? f1_7 : f1_11)), fb = g0 ? f2_11 : (g1 ? f2_3 : (g2 ? f2_0 : f2_0)); const int ab = g0 ? 11 : (g1 ? 35 : (g2 ? 112 : 176)); int key = (f2ord(fa + fb) & ~0xff) | ab; key = (g0 || g1 || g2) ? key : (int)0x80000000; C[11] = key; }
          { const float fa = g0 ? f1_0 : (g1 ? f1_2 : (g2 ? f1_7 : f1_12)), fb = g0 ? f2_12 : (g1 ? f2_4 : (g2 ? f2_1 : f2_0)); const int ab = g0 ? 12 : (g1 ? 36 : (g2 ? 113 : 192)); int key = (f2ord(fa + fb) & ~0xff) | ab; key = (g0 || g1 || g2) ? key : (int)0x80000000; C[12] = key; }
          { const float fa = g0 ? f1_0 : (g1 ? f1_2 : (g2 ? f1_7 : f1_13)), fb = g0 ? f2_13 : (g1 ? f2_5 : (g2 ? f2_2 : f2_0)); const int ab = g0 ? 13 : (g1 ? 37 : (g2 ? 114 : 208)); int key = (f2ord(fa + fb) & ~0xff) | ab; key = g0 ? key : (int)0x80000000; C[13] = key; }
          { const float fa = g0 ? f1_0 : (g1 ? f1_2 : (g2 ? f1_7 : f1_14)), fb = g0 ? f2_14 : (g1 ? f2_6 : (g2 ? f2_3 : f2_0)); const int ab = g0 ? 14 : (g1 ? 38 : (g2 ? 115 : 224)); int key = (f2ord(fa + fb) & ~0xff) | ab; key = g0 ? key : (int)0x80000000; C[14] = key; }
          { const float fa = g0 ? f1_0 : (g1 ? f1_2 : (g2 ? f1_7 : f1_15)), fb = g0 ? f2_15 : (g1 ? f2_7 : (g2 ? f2_4 : f2_0)); const int ab = g0 ? 15 : (g1 ? 39 : (g2 ? 116 : 240)); int key = (f2ord(fa + fb) & ~0xff) | ab; key = g0 ? key : (int)0x80000000; C[15] = key; }
        }
        sort16_desc(C); xmerge16(C, 16);
        int T8[8]; const int c0x = __shfl_xor(C[0], 32);
#pragma unroll
        for (int i = 0; i < 8; ++i) T8[i] = max(C[i], __shfl_xor(C[15 - i], 32));
        const float rstd1 = rsqrtf(SSQ1[row] * (1.0f / 1024.0f) + EPS);
        const float mx = ord2f(max(C[0], c0x) & ~0xff);
        const bool outer = (g == 0) || (g == 3);
        int oi[4]; float og[4], s4 = 0.f;
#pragma unroll
        for (int kk = 0; kk < 4; ++kk) {
            const int key = outer ? T8[kk] : T8[4 + kk];
            og[kk] = __expf((ord2f(key & ~0xff) - mx) * rstd1); s4 += og[kk];
            const int a = (key >> 4) & 15, bq = key & 15;
            oi[kk] = Tb[r * 32 + a] * 128 + Tb[r * 32 + 16 + bq];
        }
        s4 += __shfl_xor(s4, 16); s4 += __shfl_xor(s4, 32);
        { const float inv = __builtin_amdgcn_rcpf(s4);
#pragma unroll
          for (int kk = 0; kk < 4; ++kk) og[kk] *= inv; }
        { const int R0 = 8 * (2 * h + (g >> 1)) + 4 * (g & 1);
          *(int4*)(REC + row * 768 + 4 * R0) = make_int4(oi[0], oi[1], oi[2], oi[3]); *(float4*)(GATE + row * 128 + R0) = make_float4(og[0], og[1], og[2], og[3]);
          if (pvalid) { *(float4*)(SUR + poff) = make_float4(puv[0].x, puv[1].x, puv[2].x, puv[3].x); *(float4*)(SVR + poff) = make_float4(puv[0].y, puv[1].y, puv[2].y, puv[3].y); }
#pragma unroll
          for (int kk = 0; kk < 4; ++kk) puv[kk] = *(const float2*)(SUVt + 2 * oi[kk]);
          poff = row * 128 + R0; pvalid = true; }
        if (tq < NTOK) p10_quant_store(XQq, tq, lane, qra0, qrb0);
        if (tq + tqs < NTOK) p10_quant_store(XQq, tq + tqs, lane, qra1, qrb1);
        tq += 2 * tqs;
        if (pi0 < pn4) { uint2 o; o.x = pk2(pv0[0], pv0[1]); o.y = pk2(pv0[2], pv0[3]); pdst[pi0] = o; }
        if (pi1 < pn4) { uint2 o; o.x = pk2(pv1[0], pv1[1]); o.y = pk2(pv1[2], pv1[3]); pdst[pi1] = o; }
        ++pit;
    }
    for (size_t i = ((size_t)(2 * pit) * pnw + pgw) * 64 + lane; i < pn4; i += (size_t)pnw * 64) { const f32x4 v = psrc[i]; uint2 o; o.x = pk2(v[0], v[1]); o.y = pk2(v[2], v[3]); pdst[i] = o; }
    if (pvalid) { *(float4*)(SUR + poff) = make_float4(puv[0].x, puv[1].x, puv[2].x, puv[3].x); *(float4*)(SVR + poff) = make_float4(puv[0].y, puv[1].y, puv[2].y, puv[3].y); }
    for (; tq < NTOK; tq += tqs) p10_quant_store(XQq, tq, lane, ((const v4u*)(HNq + (size_t)tq * 1024))[2 * lane], ((const v4u*)(HNq + (size_t)tq * 1024))[2 * lane + 1]);
}

typedef _Float16 f16x2 __attribute__((ext_vector_type(2)));
__device__ __forceinline__ f16x2 bfpair_to_h2(unsigned w) { return __builtin_bit_cast(f16x2, __builtin_amdgcn_cvt_pkrtz(bf_lo(w), bf_hi(w))); }
template <int B> __device__ __forceinline__ f16x2 fp4_to_h2(unsigned w) { return __builtin_bit_cast(f16x2, __builtin_amdgcn_cvt_scalef32_pk_f16_fp4(w, 1.0f, B)); }
typedef int i32x8v __attribute__((ext_vector_type(8)));
#define U_MFMA0(acc, A, B) asm volatile("v_mfma_scale_f32_16x16x128_f8f6f4 %0, %1, %2, 0, %3, %3 op_sel_hi:[0,0,0] cbsz:4 blgp:0" : "=&v"(acc) : "v"(A), "v"(B), "v"(sc1))
#define U_MFMA1(acc, A, B) asm volatile("v_mfma_scale_f32_16x16x128_f8f6f4 %0, %1, %2, %0, %3, %3 op_sel_hi:[0,0,0] cbsz:4 blgp:0" : "+v"(acc) : "v"(A), "v"(B), "v"(sc1))
#define U_DMA(q, E) __builtin_amdgcn_global_load_lds((const unsigned*)(tbl + (((unsigned)(E)[q] << 7) + (((q) & 1) ? o1 : o0))), (LAS unsigned*)(vbuf + (q) * 1024), 16, 0, 0)
#define U_LDSR(dst, addr, off) asm volatile("ds_read_b128 %0, %1 offset:%2" : "=&v"(dst) : "v"(addr), "n"(off) : "memory")
__device__ __forceinline__ void p11a_udot(const Params& P, LAS unsigned char* lds, int lane, int wave, int vb) {
    const unsigned char* XQ = P.ws + WS_XQ8; const unsigned char* U4 = P.ws + WS_U4; const unsigned char* REC = P.ws + WS_REC; _Float16* PART = (_Float16*)(P.ws + WS_PART);
    const int x = vb & 3, wgx = vb >> 2, nwg = gridDim.x >> 2, i16 = lane & 15, kb = lane >> 4, rg = lane >> 3, c = lane & 7;
    const int tstep = nwg * NW; const int sc1 = 0x7f;
    LAS unsigned char* vbuf = lds + wave * 18688;
    LAS unsigned char* ibuf = vbuf + 16384; LAS unsigned char* pbuf = vbuf + 16384 + 512;
    const unsigned char* tbl = U4 + (size_t)x * 2097152;
    const unsigned o0 = (unsigned)((c ^ ((rg >> 1) & 7)) << 4), o1 = (unsigned)((c ^ ((4 + (rg >> 1)) & 7)) << 4);
    const unsigned sw = (unsigned)(i16 >> 1) & 7u;
    const unsigned ra0v = (unsigned)(size_t)(vbuf + i16 * 128 + (((unsigned)kb ^ sw) << 4)), ra1v = (unsigned)(size_t)(vbuf + i16 * 128 + (((unsigned)(4 + kb) ^ sw) << 4));
    const bool pl = i16 < 2, lo32 = lane < 32;
    const unsigned iav = (unsigned)(size_t)ibuf + 4u * rg, pav = (unsigned)(size_t)pbuf + 256u * (pl ? i16 : 0) + 16u * kb;
    const unsigned zwv = (unsigned)(size_t)(vbuf + 18432) + 8u * kb, zrv = (unsigned)(size_t)(vbuf + 18432) + 16u * (lane & 15);
    const unsigned psrc = ((lane & 31) < 16 ? 0u : 1024u - 256u) + 256u * x + 16u * (lane & 31);
    const int t0 = wgx * NW + wave;
#define U_DMA_IDX(tok, par) do { if (lo32) __builtin_amdgcn_global_load_lds((const unsigned*)(REC + (size_t)(tok) * 768 + 16 * lane), (LAS unsigned*)(ibuf + (par) * 1024), 16, 0, 0); } while (0)
#define U_DMA_IP(tokI, tokP, par) __builtin_amdgcn_global_load_lds((const unsigned*)(lo32 ? REC + (size_t)(tokI) * 768 + 16 * lane : XQ + (size_t)(tokP) * 2048 + psrc), (LAS unsigned*)(ibuf + (par) * 1024), 16, 0, 0)
#define U_LDSR32(dst, addr, off) asm volatile("ds_read_b32 %0, %1 offset:%2" : "=&v"(dst) : "v"(addr), "n"(off) : "memory")
#define U_READ_IDX(E, par) do { const unsigned a_ = iav + (par) * 1024u; _Pragma("unroll") for (int q_ = 0; q_ < 16; ++q_) U_LDSR32(E[q_], a_, 32 * q_); asm volatile("s_waitcnt lgkmcnt(0)" ::: "memory"); } while (0)
    int en[16];
    U_DMA_IDX(t0, 0);
    asm volatile("s_waitcnt vmcnt(0)" ::: "memory");
    U_READ_IDX(en, 0);
    U_DMA_IP(t0 + tstep, t0, 1);
#pragma unroll
    for (int q = 0; q < 16; ++q) U_DMA(q, en);
    int par = 0;
    for (int t = t0; t < NTOK; t += tstep, par ^= 1) {
        const int tn = t + tstep < NTOK ? t + tstep : t0, tnn = t + 2 * tstep < NTOK ? t + 2 * tstep : t0;
        U_DMA_IP(tnn, tn, par);
        asm volatile("s_waitcnt vmcnt(15)" ::: "memory");
        U_READ_IDX(en, par ^ 1);
        i32x8v B[2];
        { v4u b0, b1, b2, b3; const unsigned a_ = pav + (unsigned)(par ^ 1) * 1024u; U_LDSR(b0, a_, 0); U_LDSR(b1, a_, 64); U_LDSR(b2, a_, 128); U_LDSR(b3, a_, 192); asm volatile("s_waitcnt lgkmcnt(0)" ::: "memory");
          B[0][0] = pl ? (int)b0.x : 0; B[0][1] = pl ? (int)b0.y : 0; B[0][2] = pl ? (int)b0.z : 0; B[0][3] = pl ? (int)b0.w : 0; B[0][4] = pl ? (int)b1.x : 0; B[0][5] = pl ? (int)b1.y : 0; B[0][6] = pl ? (int)b1.z : 0; B[0][7] = pl ? (int)b1.w : 0;
          B[1][0] = pl ? (int)b2.x : 0; B[1][1] = pl ? (int)b2.y : 0; B[1][2] = pl ? (int)b2.z : 0; B[1][3] = pl ? (int)b2.w : 0; B[1][4] = pl ? (int)b3.x : 0; B[1][5] = pl ? (int)b3.y : 0; B[1][6] = pl ? (int)b3.z : 0; B[1][7] = pl ? (int)b3.w : 0; }
        f32x4 acc[8];
#pragma unroll
        for (int g = 0; g < 8; ++g) {
            if (g > 0) asm volatile("s_waitcnt vmcnt(15)" ::: "memory");
            v4u a0, a1;
            asm volatile("ds_read_b128 %0, %2 offset:%4\n ds_read_b128 %1, %3 offset:%4\n s_waitcnt lgkmcnt(0)" : "=&v"(a0), "=&v"(a1) : "v"(ra0v), "v"(ra1v), "n"(g * 2048) : "memory");
            U_MFMA0(acc[g], a0, B[0]); U_MFMA1(acc[g], a1, B[1]);
            U_DMA(2 * g, en); U_DMA(2 * g + 1, en);
        }
        asm volatile("s_nop 7\n s_nop 7\n s_nop 7" : "+v"(acc[0]), "+v"(acc[1]), "+v"(acc[2]), "+v"(acc[3]), "+v"(acc[4]), "+v"(acc[5]), "+v"(acc[6]), "+v"(acc[7]) :: "memory");
#pragma unroll
        for (int g = 0; g < 8; ++g) { float z[4];
#pragma unroll
            for (int r = 0; r < 4; ++r) { const float lo = __builtin_bit_cast(float, __builtin_amdgcn_mov_dpp(__builtin_bit_cast(int, acc[g][r]), 0xF5, 0xf, 0xf, true)); z[r] = acc[g][r] + lo * 0.0625f; }
            uint2 zz; zz.x = __builtin_bit_cast(unsigned, __builtin_amdgcn_cvt_pkrtz(z[0], z[1])); zz.y = __builtin_bit_cast(unsigned, __builtin_amdgcn_cvt_pkrtz(z[2], z[3]));
            if (i16 == 0) asm volatile("ds_write_b64 %0, %1 offset:%2" :: "v"(zwv), "v"(zz), "n"(32 * g) : "memory"); }
        { v4u zo;
          asm volatile("s_waitcnt lgkmcnt(0)\n ds_read_b128 %0, %1\n s_waitcnt lgkmcnt(0)" : "=&v"(zo) : "v"(zrv) : "memory");
          if (lane < 16) *(v4u*)(PART + ((size_t)t * 4 + x) * 128 + 8 * lane) = zo; }
    }
    asm volatile("s_waitcnt vmcnt(0)" ::: "memory");
#undef U_DMA_IDX
#undef U_DMA_IP
#undef U_READ_IDX
}
struct WIn { float4 gv, su, sv; uint2 pv[4]; float ssq; };
__device__ __forceinline__ void p11b_load(WIn& w, const float* SUR, const float* SVR, const float* GATE, const _Float16* PART, const float* SSQ1, size_t i) {
    const size_t t = i >> 5; const int R0 = 4 * ((int)i & 31);
    w.gv = *(const float4*)(GATE + t * 128 + R0); w.su = *(const float4*)(SUR + t * 128 + R0); w.sv = *(const float4*)(SVR + t * 128 + R0); w.ssq = SSQ1[t];
#pragma unroll
    for (int x = 0; x < 4; ++x) w.pv[x] = *(const uint2*)(PART + (t * 4 + x) * 128 + R0);
}
__device__ __forceinline__ void p11b_finish(const WIn& wi, unsigned char* REC, size_t i) {
    const size_t t = i >> 5; const int R0 = 4 * ((int)i & 31);
    const float rstd = rsqrtf(wi.ssq * (1.0f / 1024.0f) + EPS);
    const float g4[4] = {wi.gv.x, wi.gv.y, wi.gv.z, wi.gv.w}, su[4] = {wi.su.x, wi.su.y, wi.su.z, wi.su.w}, sv[4] = {wi.sv.x, wi.sv.y, wi.sv.z, wi.sv.w};
    float zs[4] = {0.f, 0.f, 0.f, 0.f};
#pragma unroll
    for (int x = 0; x < 4; ++x) { const f16x2 p0 = __builtin_bit_cast(f16x2, wi.pv[x].x), p1 = __builtin_bit_cast(f16x2, wi.pv[x].y); zs[0] += (float)p0[0]; zs[1] += (float)p0[1]; zs[2] += (float)p1[0]; zs[3] += (float)p1[1]; }
    float w[4];
#pragma unroll
    for (int j = 0; j < 4; ++j) { const float zv = zs[j] * su[j] * rstd; w[j] = g4[j] * 32.0f * zv * (1.0f + erff(zv * 0.70710678118654752f)) * sv[j]; }
    int h = __builtin_amdgcn_cvt_pk_fp8_f32(w[0], w[1], 0, false); h = __builtin_amdgcn_cvt_pk_fp8_f32(w[2], w[3], h, true);
    const float r0 = (w[0] - __builtin_amdgcn_cvt_f32_fp8(h, 0)) * 16.f, r1 = (w[1] - __builtin_amdgcn_cvt_f32_fp8(h, 1)) * 16.f, r2 = (w[2] - __builtin_amdgcn_cvt_f32_fp8(h, 2)) * 16.f, r3 = (w[3] - __builtin_amdgcn_cvt_f32_fp8(h, 3)) * 16.f;
    int l = __builtin_amdgcn_cvt_pk_fp8_f32(r0, r1, 0, false); l = __builtin_amdgcn_cvt_pk_fp8_f32(r2, r3, l, true);
    *(int*)(REC + t * 768 + 512 + R0) = h; *(int*)(REC + t * 768 + 640 + R0) = l;
}
__device__ __forceinline__ void p11b_weights(const Params& P, int tid, int vb) {
    const _Float16* PART = (const _Float16*)(P.ws + WS_PART); const float* GATE = (const float*)(P.ws + WS_GATE); const float* SSQ1 = (const float*)(P.ws + WS_SSQ1);
    unsigned char* REC = P.ws + WS_REC; const float* SUR = (const float*)(P.ws + WS_SUR); const float* SVR = (const float*)(P.ws + WS_SVR);
    const size_t n = (size_t)NTOK * 32, st = (size_t)gridDim.x * 512;
    for (size_t i = (size_t)vb * 512 + tid; i < n; i += 2 * st) {
        WIn a, b; p11b_load(a, SUR, SVR, GATE, PART, SSQ1, i); const bool hb = i + st < n; if (hb) p11b_load(b, SUR, SVR, GATE, PART, SSQ1, i + st);
        p11b_finish(a, REC, i); if (hb) p11b_finish(b, REC, i + st);
    }
}
typedef int v2iv __attribute__((ext_vector_type(2))); typedef int i32x4v __attribute__((ext_vector_type(4))); typedef int i32x8w __attribute__((ext_vector_type(8)));
struct VCtx { const unsigned char* tbl; const unsigned char* REC; LAS unsigned char* wr0; LAS unsigned char* wr1; const LAS unsigned char* rdb; LAS unsigned char* ring; unsigned swr; int rg, n16, kb, lane; bool pl; };
__device__ __forceinline__ void p11c_step(const VCtx& C, v4u (&vd)[16], v4u& rraw, float (&inc)[4], int tn3, int scur, int snew) {
    const unsigned char* tbl = C.tbl; LAS unsigned char* wr0 = C.wr0; LAS unsigned char* wr1 = C.wr1; const LAS unsigned char* rdb = C.rdb;
    const unsigned swr = C.swr; const int rg = C.rg, n16 = C.n16, kb = C.kb, lane = C.lane; const bool pl = C.pl; const int scw = 0x79, sc1 = 0x7f;
    if (lane < 48) *(LAS v4u*)(C.ring + snew * 768 + 16 * lane) = rraw;
    if (lane < 48) rraw = *(const v4u*)(C.REC + (size_t)tn3 * 768 + 16 * lane);
    int en[16];
#pragma unroll
    for (int q = 0; q < 16; ++q) en[q] = *(const LAS int*)(C.ring + snew * 768 + 4 * (8 * q + rg));
    const v4u w0r = *(const LAS v4u*)(C.ring + scur * 768 + 512 + (n16 & 1) * 128 + 16 * kb), w1r = *(const LAS v4u*)(C.ring + scur * 768 + 512 + (n16 & 1) * 128 + 64 + 16 * kb);
#pragma unroll
    for (int q = 0; q < 16; ++q) { *(LAS v4u*)(((q & 1) ? wr1 : wr0) + q * 1024) = vd[q]; vd[q] = *(const v4u*)(tbl + ((unsigned)en[q] << 7)); }
    i32x8w W8; W8[0] = pl ? (int)w0r.x : 0; W8[1] = pl ? (int)w0r.y : 0; W8[2] = pl ? (int)w0r.z : 0; W8[3] = pl ? (int)w0r.w : 0; W8[4] = pl ? (int)w1r.x : 0; W8[5] = pl ? (int)w1r.y : 0; W8[6] = pl ? (int)w1r.z : 0; W8[7] = pl ? (int)w1r.w : 0;
    asm volatile("s_waitcnt lgkmcnt(0)" ::: "memory");
    float sv[2][2] = {{0.f, 0.f}, {0.f, 0.f}};
    const bool hh = kb >> 1;
#pragma unroll
    for (int b4 = 0; b4 < 16; b4 += 4) {
        i32x4v B4[4]; f32x4 acc[4];
#pragma unroll
        for (int u = 0; u < 4; ++u) { const int blk = b4 + u;
            const LAS unsigned char* a = rdb + ((((unsigned)(blk >> 1)) ^ swr) << 4) + (blk & 1) * 8;
            const v2iv t0 = __builtin_amdgcn_ds_read_tr4_b64_v2i32((LAS v2iv*)a), t1 = __builtin_amdgcn_ds_read_tr4_b64_v2i32((LAS v2iv*)(a + 2048));
            B4[u][0] = t0[0]; B4[u][1] = t0[1]; B4[u][2] = t1[0]; B4[u][3] = t1[1]; }
#pragma unroll
        for (int u = 0; u < 4; ++u)
            asm volatile("v_mfma_scale_f32_16x16x128_f8f6f4 %0, %1, %2, 0, %3, %4 op_sel_hi:[0,0,0] cbsz:0 blgp:4" : "=&v"(acc[u]) : "v"(W8), "v"(B4[u]), "v"(scw), "v"(sc1));
        asm volatile("s_nop 7\n s_nop 7\n s_nop 7" : "+v"(acc[0]), "+v"(acc[1]), "+v"(acc[2]), "+v"(acc[3]) :: "memory");
        if ((kb & 1) == (b4 >> 3)) {
            const float v0 = hh ? acc[2][0] + acc[2][1] * 0.0625f : acc[0][0] + acc[0][1] * 0.0625f, v1 = hh ? acc[3][0] + acc[3][1] * 0.0625f : acc[1][0] + acc[1][1] * 0.0625f;
            sv[(b4 >> 2) & 1][0] = v0; sv[(b4 >> 2) & 1][1] = v1; }
    }
    const bool odd = lane & 1;
    const float s0 = odd ? sv[0][0] : sv[1][0], s1 = odd ? sv[0][1] : sv[1][1];
    const float r0 = __builtin_bit_cast(float, __builtin_amdgcn_mov_dpp(__builtin_bit_cast(int, s0), 0xB1, 0xf, 0xf, true)), r1 = __builtin_bit_cast(float, __builtin_amdgcn_mov_dpp(__builtin_bit_cast(int, s1), 0xB1, 0xf, 0xf, true));
    inc[0] = odd ? r0 : sv[0][0]; inc[1] = odd ? sv[1][0] : r0; inc[2] = odd ? r1 : sv[0][1]; inc[3] = odd ? sv[1][1] : r1;
}
typedef unsigned v2uw __attribute__((ext_vector_type(2)));
__device__ __forceinline__ void p11c_pair_out(const Params& P, bf16* XB, float* SSQ, const float (&incA)[4], const float (&incB)[4], const v4u xo, int tA, int tB, int x, int D, int lane) {
    float e[8];
#pragma unroll
    for (int j = 0; j < 4; ++j) { const auto r = __builtin_amdgcn_permlane32_swap(__builtin_bit_cast(unsigned, incA[j]), __builtin_bit_cast(unsigned, incB[j]), false, false);
        const unsigned r0_ = r[0], r1_ = r[1]; e[j] = __uint_as_float(r0_); e[4 + j] = __uint_as_float(r1_); }
    const int tok = lane < 32 ? tA : tB;
    float xv[8]; unpk8(xo, xv);
    float ss = 0.f;
#pragma unroll
    for (int k = 0; k < 8; ++k) { xv[k] += e[k]; ss += xv[k] * xv[k]; }
    *(v4u*)(XB + (size_t)tok * 1024 + 256 * x + D) = pk8(xv);
    uint2 f8;
    { int p8 = __builtin_amdgcn_cvt_pk_fp8_f32(xv[0], xv[1], 0, false); p8 = __builtin_amdgcn_cvt_pk_fp8_f32(xv[2], xv[3], p8, true); f8.x = (unsigned)p8; }
    { int p8 = __builtin_amdgcn_cvt_pk_fp8_f32(xv[4], xv[5], 0, false); p8 = __builtin_amdgcn_cvt_pk_fp8_f32(xv[6], xv[7], p8, true); f8.y = (unsigned)p8; }
    *(uint2*)(P.ws + WS_X2B8 + (size_t)tok * 1024 + 256 * x + D) = f8;
    ss += __shfl_xor(ss, 16); ss += __shfl_xor(ss, 8); ss += __shfl_xor(ss, 4); ss += __shfl_xor(ss, 2); ss += __shfl_xor(ss, 1);
    if ((lane & 31) == 0) atomicAdd(SSQ + tok, ss);
}
__device__ __forceinline__ void p11c_vacc(const Params& P, LAS unsigned char* lds, int lane, int wave, int vb) {
    const unsigned char* V4 = P.ws + WS_V4; const unsigned char* REC = P.ws + WS_REC;
    bf16* XB = (bf16*)(P.ws + WS_HN); float* SSQ = (float*)(P.ws + WS_SSQ);
    const int x = vb & 3, wgx = vb >> 2, nwg = gridDim.x >> 2, rg = lane >> 3, ch = lane & 7, n16 = lane & 15, kb = lane >> 4;
    const int tstep = nwg * NW;
    LAS unsigned char* vbuf = lds + wave * 16384;
    LAS unsigned char* ring = lds + 131072 + wave * 2304;
    const unsigned char* tbl = V4 + (size_t)x * 2097152 + 16 * ch;
    LAS unsigned char* wr0 = vbuf + rg * 128 + ((ch ^ ((rg >> 1) & 7)) << 4); LAS unsigned char* wr1 = vbuf + rg * 128 + ((ch ^ ((4 + (rg >> 1)) & 7)) << 4);
    const unsigned swr = (unsigned)(n16 >> 1) & 7u;
    const LAS unsigned char* rdb = vbuf + (kb * 32 + n16) * 128;
    const bool pl = (n16 & 3) < 2;
    const int D = 32 * (n16 >> 1) + 8 * (2 * (kb & 1) + (n16 & 1));
    VCtx C{tbl, REC, wr0, wr1, rdb, ring, swr, rg, n16, kb, lane, pl};
    const int t0 = wgx * NW + wave;
    v4u vdA[16], vdB[16], rraw = {0u, 0u, 0u, 0u};
    { v4u r0 = {0u, 0u, 0u, 0u}, r1 = {0u, 0u, 0u, 0u};
      if (lane < 48) { r0 = *(const v4u*)(REC + (size_t)t0 * 768 + 16 * lane); r1 = *(const v4u*)(REC + (size_t)(t0 + tstep) * 768 + 16 * lane); rraw = *(const v4u*)(REC + (size_t)(t0 + 2 * tstep) * 768 + 16 * lane);
          *(LAS v4u*)(ring + 16 * lane) = r0; *(LAS v4u*)(ring + 768 + 16 * lane) = r1; }
      asm volatile("s_waitcnt lgkmcnt(0)" ::: "memory");
#pragma unroll
      for (int q = 0; q < 16; ++q) vdA[q] = *(const v4u*)(tbl + ((unsigned)*(const LAS int*)(ring + 4 * (8 * q + rg)) << 7));
#pragma unroll
      for (int q = 0; q < 16; ++q) vdB[q] = *(const v4u*)(tbl + ((unsigned)*(const LAS int*)(ring + 768 + 4 * (8 * q + rg)) << 7)); }
    int sc = 0;
    for (int t = t0; t < NTOK; t += 2 * tstep) {
        const int ta = t + 3 * tstep, tb = t + 4 * tstep;
        const int s1 = sc == 2 ? 0 : sc + 1, s2 = s1 == 2 ? 0 : s1 + 1;
        const v4u xo = *(const v4u*)(XB + (size_t)(lane < 32 ? t : t + tstep) * 1024 + 256 * x + D);
        float incA[4], incB[4];
        p11c_step(C, vdA, rraw, incA, ta < NTOK ? ta : t0, sc, s2);
        p11c_step(C, vdB, rraw, incB, tb < NTOK ? tb : t0, s1, sc);
        p11c_pair_out(P, XB, SSQ, incA, incB, xo, t, t + tstep, x, D, lane);
        sc = s2;
    }
}

__global__ void __launch_bounds__(512, 2) mk_fwd(Params P) {
    extern __shared__ __attribute__((aligned(16))) unsigned char lds_raw[];
    LAS unsigned char* lds = (LAS unsigned char*)lds_raw;
    const int tid = threadIdx.x, lane = tid & 63, wave = __builtin_amdgcn_readfirstlane(tid >> 6);
    const int lo = P.ph_lo, hi = P.ph_hi, G = gridDim.x, bx = blockIdx.x;
    unsigned char* ws = P.ws;
    const int gw = bx * NW + wave, NGW = G * NW;
#ifndef PH_MASK
#define PH_MASK 0xffff
#endif
#define IN(k) (((PH_MASK >> (k)) & 1) && lo <= (k) && (k) < hi)
    volatile LAS unsigned* xst = (volatile LAS unsigned*)(lds + LDS_BYTES - 16);
    if (tid < 4) xst[tid] = 0u;
    __syncthreads();
    const XcdBarrier bar = xcd_barrier_post((unsigned*)(ws + WS_BAR), xst);
    unsigned* vctl = (unsigned*)(ws + WS_BAR) + 4096;
    if (tid == 0) { const unsigned xcc = xb_xcc_id() & 7u; xst[2] = xcc; xst[3] = xb_add(&vctl[16 * xcc], 1u); }
#define GRID_BAR() xcd_barrier(bar)
#define SYNC_AFTER(k) do { if (IN(k) && IN((k) + 1)) { GRID_BAR(); } } while (0)
    typedef pg8::bf16_t pb;
    if (IN(0)) p0_prologue(P, lds, tid, lane, wave);
    SYNC_AFTER(0);
    if (tid == 0) {
        const unsigned xcc = xst[2], sl = xst[3], cap = (unsigned)G >> 3; unsigned v;
        if (sl < cap) v = sl * 8u + xcc;
        else { unsigned o = xb_add(&vctl[160], 1u); v = 0u;
            for (unsigned x = 0; x < 8u; ++x) { const unsigned c = min(xb_ld(&vctl[16 * x]), cap), fr = cap - c; if (o < fr) { v = (c + o) * 8u + x; break; } o -= fr; } }
        xst[2] = v;
    }
    __syncthreads();
    const int vb = (int)xst[2];
    if (IN(1)) {
        pg8::Gemm g{(const pb*)P.out, (const pb*)(ws + WS_W1F8), NTOK, 5632, 512}; pg8::StaticOrder S; S.init(NTOK, 5632, G, vb);
        pg8::EpiProj E{(pb*)(ws + WS_QKVA), (pb*)(ws + WS_QKM), (pb*)(ws + WS_VM), (pb*)(ws + WS_OM), ws + WS_G, C2};
        pg8::gemm_phase<pg8::EpiProj, pg8::StaticOrder, true, true>(lds, g, S, E);
    }
    SYNC_AFTER(1);
    if (IN(2)) { p2_attention(P, lds, lane, wave, vb); __syncthreads(); p2_mlstm_local(P, lds, tid, lane, wave, vb); }
    SYNC_AFTER(2);
    if (IN(3)) { const int nscan = G > 128 ? 128 : 0;
        if (vb >= nscan) p3_side_tables(P, lds, tid, lane, wave, vb - nscan, G - nscan);
        p3_mlstm_scan(P, tid, vb); }
    SYNC_AFTER(3);
    if (IN(4)) p4_mlstm_out(P, lds, tid, lane, wave, vb);
    SYNC_AFTER(4);
    if (IN(5)) {
        pg8::Gemm g{(const pb*)(ws + WS_YA), (const pb*)(ws + WS_WAT), NTOK, 1024, 1024}; pg8::StaticOrder S; S.init(NTOK, 1024, G, vb);
        pg8::EpiMerged E{(pb*)(ws + WS_MERGED), ws + WS_G};
        pg8::gemm_phase<pg8::EpiMerged, pg8::StaticOrder, true, true>(lds, g, S, E);
    }
    if (IN(5) && IN(7)) GRID_BAR();
    if (IN(7)) {
        pg8::Gemm g{(const pb*)(ws + WS_MERGED), (const pb*)(ws + WS_WOT), NTOK, 1024, 1024}; pg8::StaticOrder S; S.init(NTOK, 1024, G, vb);
        pg8::EpiResidual E{P.in[0], (pb*)(ws + WS_HN), (float*)(ws + WS_SSQ1)};
        pg8::gemm_phase<pg8::EpiResidual, pg8::StaticOrder, true, true>(lds, g, S, E);
    }
    if (IN(7) && IN(9)) GRID_BAR();
    if (IN(9)) {
        pg8::Gemm g{(const pb*)(ws + WS_HN), (const pb*)(ws + WS_WQT), NTOK, 2048, 1024}; pg8::StaticOrder S; S.init(NTOK, 2048, G, vb);
        pg8::EpiStore E{(pb*)(ws + WS_Q2), 2048};
        pg8::gemm_phase<pg8::EpiStore, pg8::StaticOrder, true, true>(lds, g, S, E);
    }
    SYNC_AFTER(9);
#define LAUNDER_TID() int tid_ = tid; asm volatile("" : "+v"(tid_)); const int lane_ = tid_ & 63
    if (IN(10)) { { LAUNDER_TID(); p10_topk(P, lds, tid_, lane_, wave, vb); } }
    SYNC_AFTER(10);
    if (IN(11)) { { LAUNDER_TID(); p11a_udot(P, lds, lane_, wave, vb); } GRID_BAR(); { LAUNDER_TID(); p11b_weights(P, tid_, vb); } GRID_BAR(); { LAUNDER_TID(); p11c_vacc(P, lds, lane_, wave, vb); } }
    SYNC_AFTER(11);
    if (IN(12)) {
        pg8::Gemm g{(const pb*)(ws + WS_PB), (const pb*)(ws + WS_WPT), NTOK, 1024, 256}; pg8::StaticOrder S; S.init(NTOK, 1024, G, vb);
        pg8::EpiStore E{(pb*)(ws + WS_E), 1024};
        pg8::gemm_phase<pg8::EpiStore, pg8::StaticOrder, true, true>(lds, g, S, E);
    }
    if (IN(12) && IN(13)) { asm volatile("s_waitcnt vmcnt(0)" ::: "memory"); __syncthreads(); }
    if (IN(13)) {
        pg8::Gemm g{(const pb*)(ws + WS_X2B8), (const pb*)(ws + WS_WG8), NTOK, 1024, 512}; pg8::StaticOrder S; S.init(NTOK, 1024, G, vb);
        if (G == 256) {
            pg8::EpiPleFinal E{(const pb*)(ws + WS_HN), (const pb*)(ws + WS_E), (const float*)(ws + WS_SSQ), (float*)(ws + WS_SSQ3), (unsigned*)(ws + WS_BAR) + BAR_CNT13, (unsigned*)(ws + WS_BAR) + XB_TMO, P.in[19], P.out};
            pg8::gemm_phase<pg8::EpiPleFinal, pg8::StaticOrder, true, true>(lds, g, S, E);
        } else {
            pg8::EpiPle E{(const pb*)(ws + WS_HN), (pb*)(ws + WS_X3B), (const pb*)(ws + WS_E), (const float*)(ws + WS_SSQ)};
            pg8::gemm_phase<pg8::EpiPle, pg8::StaticOrder, true, true>(lds, g, S, E);
        }
    }
    if (G != 256) SYNC_AFTER(13);
    if (IN(14) && G != 256) {
        const float* gf = P.in[19];
        for (int m = gw; m < NTOK; m += NGW) {
            const bf16* xr = (const bf16*)(ws + WS_X3B) + (size_t)m * 1024; float v[16]; float s = 0.f;
            unpk8(((const v4u*)xr)[2 * lane], v); unpk8(((const v4u*)xr)[2 * lane + 1], v + 8);
#pragma unroll
            for (int i = 0; i < 16; ++i) s += v[i] * v[i];
            const float rstd = rsqrtf(wave_sum(s) * (1.f / 1024.f) + EPS);
            float* orow = P.out + (size_t)m * 1024 + 16 * lane;
#pragma unroll
            for (int j = 0; j < 4; ++j) { const f32x4 g = ((const f32x4*)(gf + 16 * lane))[j]; f32x4 o; o[0] = v[4 * j] * rstd * g[0]; o[1] = v[4 * j + 1] * rstd * g[1]; o[2] = v[4 * j + 2] * rstd * g[2]; o[3] = v[4 * j + 3] * rstd * g[3]; ((f32x4*)orow)[j] = o; }
        }
    }
}

extern "C" void kernel_launch(void* const* d_in, const int* in_sizes, int n_in, void* d_out, int out_size, void* d_ws, size_t ws_size, hipStream_t stream) {
    static int grid_blocks = 0;
    if (!grid_blocks) {
        int dev = 0, cus = 0, per_cu = 0;
        (void)hipGetDevice(&dev);
        (void)hipDeviceGetAttribute(&cus, hipDeviceAttributeMultiprocessorCount, dev);
        (void)hipFuncSetAttribute((const void*)mk_fwd, hipFuncAttributeMaxDynamicSharedMemorySize, LDS_BYTES);
        (void)hipOccupancyMaxActiveBlocksPerMultiprocessor(&per_cu, mk_fwd, 512, LDS_BYTES);
        if (per_cu > 1) per_cu = 1;
        grid_blocks = cus * per_cu;
    }
    if (n_in < 20 || ws_size < WS_NEED || grid_blocks <= 0) { fprintf(stderr, "kernel_launch: bad setup (n_in %d ws %zu grid %d)\n", n_in, ws_size, grid_blocks); return; }
    Params p{};
    for (int i = 0; i < 20; ++i) p.in[i] = (const float*)d_in[i];
    p.out = (float*)d_out; p.ws = (unsigned char*)d_ws; p.ph_lo = 0; p.ph_hi = 15;
    (void)hipMemsetAsync((unsigned char*)d_ws + WS_BAR, 0, BAR_BYTES, stream);
    void* args[] = {&p};
    hipError_t e = hipLaunchCooperativeKernel((void*)mk_fwd, dim3(grid_blocks), dim3(512), args, LDS_BYTES, stream);
    if (e != hipSuccess) fprintf(stderr, "cooperative launch failed: %s (grid %d)\n", hipGetErrorString(e), grid_blocks);
}
```
